# Optimizing an MI355X kernel written in HIP

```python
import math
import jax, jax.numpy as jnp
from jax import lax
import numpy as np

D_MODEL = 1024
BATCH = 4
SEQ = 4096
DEPTH = 1

D_SSM = D_MODEL // 2
SSM_GROUP = 16
N_SSM_GROUPS = D_SSM // SSM_GROUP
SSM_STATE = 64
DT_MIN = 1e-3
DT_MAX = 1e-1
N_HEADS = 8
N_KV_HEADS = 2
HEAD_DIM = 64
D_ATTN = N_HEADS * HEAD_DIM
D_KV = N_KV_HEADS * HEAD_DIM
IDX_HEADS = 16
IDX_DIM = 64
TOPK = 256
Q_BLOCK = 128
ROPE_THETA = 10000.0
N_EXPERTS = 32
TOP_K_EXPERTS = 4
D_EXPERT = D_MODEL
SWIGLU_LIMIT = 7.0
SWIGLU_ALPHA = 1.702
RMS_EPS = 1e-5
NEG = -1e30
N_BRANCHES = 2
IN_SPLITS = (D_SSM, D_ATTN, D_KV, D_KV, IDX_HEADS * IDX_DIM, IDX_DIM, IDX_HEADS, D_MODEL, D_MODEL)
D_IN = sum(IN_SPLITS)
IN_OFFSETS = tuple(sum(IN_SPLITS[:i + 1]) for i in range(len(IN_SPLITS) - 1))

kernel_name = "hybrid_s5_dsa_moe_block"


def rms_norm(x, g):
    xf = x.astype(jnp.float32)
    out = xf * lax.rsqrt(jnp.mean(xf * xf, axis=-1, keepdims=True) + RMS_EPS) * g.astype(jnp.float32)
    return out.astype(x.dtype)


def rope(x, pos):
    d = x.shape[-1]
    half = d // 2
    inv = ROPE_THETA ** (-jnp.arange(half, dtype=jnp.float32) / half)
    ang = pos[:, None] * inv[None, :]
    cos = jnp.cos(ang)[:, None, :]
    sin = jnp.sin(ang)[:, None, :]
    xf = x.astype(jnp.float32)
    x1, x2 = xf[..., :half], xf[..., half:]
    out = jnp.concatenate([x1 * cos - x2 * sin, x2 * cos + x1 * sin], axis=-1)
    return out.astype(x.dtype)


def _complex_scan_op(e1, e2):
    a1r, a1i, b1r, b1i = e1
    a2r, a2i, b2r, b2i = e2
    ar = a2r * a1r - a2i * a1i
    ai = a2r * a1i + a2i * a1r
    br = a2r * b1r - a2i * b1i + b2r
    bi = a2r * b1i + a2i * b1r + b2i
    return (ar, ai, br, bi)


def s5_mixer(u, lam_re, lam_im, log_dt, b_re, b_im, c_re, c_im, d_skip, w_glu, b_glu):
    f32 = jnp.float32
    bsz, L, _ = u.shape
    uf = u.astype(f32).reshape(bsz, L, N_SSM_GROUPS, SSM_GROUP)
    lr, li = lam_re.astype(f32), lam_im.astype(f32)
    dt = jnp.exp(log_dt.astype(f32))[:, None]
    mag = jnp.exp(lr * dt)
    ar = mag * jnp.cos(li * dt)
    ai = mag * jnp.sin(li * dt)
    nr, ni = ar - 1.0, ai
    den = lr * lr + li * li
    zr = (nr * lr + ni * li) / den
    zi = (ni * lr - nr * li) / den
    br, bi = b_re.astype(f32), b_im.astype(f32)
    bbar_re = zr[:, :, None] * br - zi[:, :, None] * bi
    bbar_im = zr[:, :, None] * bi + zi[:, :, None] * br
    bu_re = jnp.einsum('blgh,gph->blgp', uf, bbar_re)
    bu_im = jnp.einsum('blgh,gph->blgp', uf, bbar_im)
    a_re = jnp.broadcast_to(ar, bu_re.shape)
    a_im = jnp.broadcast_to(ai, bu_re.shape)
    _, _, xr, xi = lax.associative_scan(_complex_scan_op, (a_re, a_im, bu_re, bu_im), axis=1)
    y = (jnp.einsum('blgp,ghp->blgh', xr, c_re.astype(f32))
         - jnp.einsum('blgp,ghp->blgh', xi, c_im.astype(f32))
         + d_skip.astype(f32) * uf)
    y = jax.nn.gelu(y.reshape(bsz, L, D_SSM))
    y = y * jax.nn.sigmoid(y @ w_glu.astype(f32) + b_glu.astype(f32))
    return y.astype(u.dtype)


def dsa_attention(q, k, v, q_idx, k_idx, w_idx):
    f32 = jnp.float32
    bsz, L = q.shape[0], q.shape[1]
    n_sel = min(TOPK, L // 4)
    n_blk = L // Q_BLOCK
    rep = N_HEADS // N_KV_HEADS
    q5 = q.reshape(bsz, L, N_KV_HEADS, rep, HEAD_DIM)
    kif = k_idx.astype(f32)
    key_pos = jnp.arange(L)
    bidx = jnp.arange(bsz)[:, None, None]

    def block(i):
        start = i * Q_BLOCK
        qb = lax.dynamic_slice_in_dim(q5, start, Q_BLOCK, axis=1).astype(f32)
        qib = lax.dynamic_slice_in_dim(q_idx, start, Q_BLOCK, axis=1).astype(f32)
        wib = lax.dynamic_slice_in_dim(w_idx, start, Q_BLOCK, axis=1).astype(f32) * (IDX_HEADS ** -0.5)
        qpos = start + jnp.arange(Q_BLOCK)
        s = jnp.einsum('bthd,bsd->bths', qib, kif) * (IDX_DIM ** -0.5)
        score = jnp.einsum('bths,bth->bts', jax.nn.relu(s), wib)
        causal = key_pos[None, :] <= qpos[:, None]
        score = jnp.where(causal[None], score, NEG)
        _, sel = lax.top_k(score, n_sel)
        valid = sel <= qpos[None, :, None]
        ks = k[bidx, sel].astype(f32)
        vs = v[bidx, sel].astype(f32)
        logits = jnp.einsum('btgrd,btkgd->btgrk', qb, ks) * (HEAD_DIM ** -0.5)
        logits = jnp.where(valid[:, :, None, None, :], logits, NEG)
        p = jax.nn.softmax(logits, axis=-1)
        o = jnp.einsum('btgrk,btkgd->btgrd', p, vs)
        return o.reshape(bsz, Q_BLOCK, D_ATTN).astype(q.dtype)

    out = lax.map(block, jnp.arange(n_blk))
    return out.transpose(1, 0, 2, 3).reshape(bsz, L, D_ATTN)


def moe(h, w_router, b_router, w_moe_in, b_moe_in, w_moe_out, b_moe_out):
    f32 = jnp.float32
    hf = h.reshape(-1, D_MODEL)
    logits = (hf @ w_router + b_router).astype(f32)
    vals, idx = lax.top_k(logits, TOP_K_EXPERTS)
    wts = jax.nn.softmax(vals, axis=-1)
    gates = jnp.sum(jax.nn.one_hot(idx, N_EXPERTS, dtype=f32) * wts[..., None], axis=1)
    out = jnp.zeros(hf.shape, f32)
    for e in range(N_EXPERTS):
        z = hf @ w_moe_in[e] + b_moe_in[e]
        zg = jnp.minimum(z[:, ::2], SWIGLU_LIMIT)
        zl = jnp.clip(z[:, 1::2], -SWIGLU_LIMIT, SWIGLU_LIMIT)
        act = zg * jax.nn.sigmoid(SWIGLU_ALPHA * zg) * (zl + 1.0)
        out = out + gates[:, e:e + 1] * (act @ w_moe_out[e] + b_moe_out[e]).astype(f32)
    return out.reshape(h.shape).astype(h.dtype)


def hybrid_layer(x, norm1_g, w_in, b_gate, ssm_lam_re, ssm_lam_im, ssm_log_dt, ssm_b_re, ssm_b_im,
                 ssm_c_re, ssm_c_im, ssm_d, w_glu, b_glu, w_proj_ssm, w_proj_attn, w_out,
                 norm2_g, w_router, b_router, w_moe_in, b_moe_in, w_moe_out, b_moe_out):
    bsz, L, _ = x.shape
    xn = rms_norm(x, norm1_g)
    proj = xn @ w_in
    u, q, k, v, qi, ki, wi, gs, ga = jnp.split(proj, IN_OFFSETS, axis=-1)
    pos = jnp.arange(L, dtype=jnp.float32)
    q = rope(q.reshape(bsz, L, N_HEADS, HEAD_DIM), pos)
    k = rope(k.reshape(bsz, L, N_KV_HEADS, HEAD_DIM), pos)
    v = v.reshape(bsz, L, N_KV_HEADS, HEAD_DIM)
    qi = rope(qi.reshape(bsz, L, IDX_HEADS, IDX_DIM), pos)
    ki = rope(ki.reshape(bsz, L, 1, IDX_DIM), pos)[:, :, 0]
    y_ssm = s5_mixer(u, ssm_lam_re, ssm_lam_im, ssm_log_dt, ssm_b_re, ssm_b_im,
                     ssm_c_re, ssm_c_im, ssm_d, w_glu, b_glu)
    y_att = dsa_attention(q, k, v, qi, ki, wi)
    g_ssm = jax.nn.sigmoid(gs + b_gate[0])
    g_att = jax.nn.sigmoid(ga + b_gate[1])
    mixed = g_ssm * (y_ssm @ w_proj_ssm) + g_att * (y_att @ w_proj_attn)
    x = x + mixed @ w_out
    x = x + moe(rms_norm(x, norm2_g), w_router, b_router, w_moe_in, b_moe_in, w_moe_out, b_moe_out)
    return x


def setup_inputs(seed: int = 0) -> dict:
    key = jax.random.key(seed)
    ks = jax.random.split(key, 32)
    f32 = jnp.float32

    def nrm(k, shape, scale):
        return jax.random.normal(k, shape, f32) * scale

    G, P, H = N_SSM_GROUPS, SSM_STATE, SSM_GROUP
    n = jnp.arange(P, dtype=f32)
    x = nrm(ks[0], (BATCH, SEQ, D_MODEL), 1.0)
    norm1_g = 1.0 + nrm(ks[1], (DEPTH, D_MODEL), 0.02)
    w_in = nrm(ks[2], (DEPTH, D_MODEL, D_IN), D_MODEL ** -0.5)
    b_gate = nrm(ks[3], (DEPTH, N_BRANCHES, D_MODEL), 0.02)
    ssm_lam_re = -0.5 + nrm(ks[4], (DEPTH, G, P), 0.01)
    ssm_lam_im = math.pi * n[None, None, :] + nrm(ks[5], (DEPTH, G, P), 0.01)
    ssm_log_dt = jax.random.uniform(ks[6], (DEPTH, G), f32, math.log(DT_MIN), math.log(DT_MAX))
    ssm_b_re = nrm(ks[7], (DEPTH, G, P, H), (2.0 * H) ** -0.5)
    ssm_b_im = nrm(ks[8], (DEPTH, G, P, H), (2.0 * H) ** -0.5)
    ssm_c_re = nrm(ks[9], (DEPTH, G, H, P), (2.0 * P) ** -0.5)
    ssm_c_im = nrm(ks[10], (DEPTH, G, H, P), (2.0 * P) ** -0.5)
    ssm_d = nrm(ks[11], (DEPTH, G, H), 1.0)
    w_glu = nrm(ks[12], (DEPTH, D_SSM, D_SSM), D_SSM ** -0.5)
    b_glu = nrm(ks[13], (DEPTH, D_SSM), 0.02)
    w_proj_ssm = nrm(ks[14], (DEPTH, D_SSM, D_MODEL), D_SSM ** -0.5)
    w_proj_attn = nrm(ks[15], (DEPTH, D_ATTN, D_MODEL), D_ATTN ** -0.5)
    w_out = nrm(ks[16], (DEPTH, D_MODEL, D_MODEL), D_MODEL ** -0.5)
    norm2_g = 1.0 + nrm(ks[17], (DEPTH, D_MODEL), 0.02)
    w_router = nrm(ks[18], (DEPTH, D_MODEL, N_EXPERTS), D_MODEL ** -0.5)
    b_router = nrm(ks[19], (DEPTH, N_EXPERTS), 0.01)
    w_moe_in = nrm(ks[20], (DEPTH, N_EXPERTS, D_MODEL, 2 * D_EXPERT), D_MODEL ** -0.5)
    b_moe_in = nrm(ks[21], (DEPTH, N_EXPERTS, 2 * D_EXPERT), 0.01)
    w_moe_out = nrm(ks[22], (DEPTH, N_EXPERTS, D_EXPERT, D_MODEL), D_EXPERT ** -0.5)
    b_moe_out = nrm(ks[23], (DEPTH, N_EXPERTS, D_MODEL), 0.01)
    norm_f_g = 1.0 + nrm(ks[24], (D_MODEL,), 0.02)
    return {"x": x, "norm1_g": norm1_g, "w_in": w_in, "b_gate": b_gate,
            "ssm_lam_re": ssm_lam_re, "ssm_lam_im": ssm_lam_im, "ssm_log_dt": ssm_log_dt,
            "ssm_b_re": ssm_b_re, "ssm_b_im": ssm_b_im, "ssm_c_re": ssm_c_re, "ssm_c_im": ssm_c_im,
            "ssm_d": ssm_d, "w_glu": w_glu, "b_glu": b_glu, "w_proj_ssm": w_proj_ssm,
            "w_proj_attn": w_proj_attn, "w_out": w_out, "norm2_g": norm2_g,
            "w_router": w_router, "b_router": b_router, "w_moe_in": w_moe_in, "b_moe_in": b_moe_in,
            "w_moe_out": w_moe_out, "b_moe_out": b_moe_out, "norm_f_g": norm_f_g}


def reference(x, norm1_g, w_in, b_gate, ssm_lam_re, ssm_lam_im, ssm_log_dt, ssm_b_re, ssm_b_im,
              ssm_c_re, ssm_c_im, ssm_d, w_glu, b_glu, w_proj_ssm, w_proj_attn, w_out,
              norm2_g, w_router, b_router, w_moe_in, b_moe_in, w_moe_out, b_moe_out, norm_f_g):
    h = x
    for l in range(DEPTH):
        h = hybrid_layer(h, norm1_g[l], w_in[l], b_gate[l], ssm_lam_re[l], ssm_lam_im[l], ssm_log_dt[l],
                         ssm_b_re[l], ssm_b_im[l], ssm_c_re[l], ssm_c_im[l], ssm_d[l], w_glu[l], b_glu[l],
                         w_proj_ssm[l], w_proj_attn[l], w_out[l], norm2_g[l], w_router[l], b_router[l],
                         w_moe_in[l], b_moe_in[l], w_moe_out[l], b_moe_out[l])
    return rms_norm(h, norm_f_g)
```

```cpp
#include <hip/hip_runtime.h>
#include <cstdio>
#include <cstdint>

#ifndef MK_N_LAUNCHES
#define MK_N_LAUNCHES 1
#endif

namespace pg8 {
#define PG8_LAS __attribute__((address_space(3)))
typedef unsigned short bf16_t;
typedef short bf16x8 __attribute__((ext_vector_type(8)));
typedef float f32x4 __attribute__((ext_vector_type(4)));
typedef float f32x2 __attribute__((ext_vector_type(2)));
typedef unsigned u32x4 __attribute__((ext_vector_type(4)));
typedef unsigned u32x2 __attribute__((ext_vector_type(2)));
constexpr int BM = 256, BK = 64, HALF = 128, HTB = HALF * BK * 2, STAGE_BYTES = 8 * HTB, NXCD = 8, WGM = 8;

__host__ __device__ __forceinline__ int lds_byte(int r, int c) { const int st = (r >> 4) * 2 + (c >> 5), rr = r & 15, cc = c & 31, ob = rr * 64 + cc * 2; return st * 1024 + (ob ^ (((ob >> 9) & 1) << 5)); }
__host__ __device__ __forceinline__ void stage_rc(int b, int& R, int& C) { const int st = b / 1024, sb = b % 1024, swz = sb ^ (((sb >> 9) & 1) << 5); R = (st >> 1) * 16 + swz / 64; C = (st & 1) * 32 + (swz % 64) / 2; }
__host__ __device__ __forceinline__ int perm32(int rho) { const int n = rho >> 4, i = rho & 15; return 8 * (i >> 2) + 4 * n + (i & 3); }

struct Unit { int pm, pn, pa, pb, e; };
struct Gemm { const bf16_t* A; const bf16_t* Bt; int lda, ldb, K; };

__device__ __forceinline__ unsigned cvt_pk_bf16(float lo, float hi) { unsigned r; asm volatile("v_cvt_pk_bf16_f32 %0, %1, %2" : "=v"(r) : "v"(lo), "v"(hi)); return r; }
__device__ __forceinline__ u32x4 pack8(const f32x4& v0, const f32x4& v1) { u32x4 w; w.x = cvt_pk_bf16(v0[0], v0[1]); w.y = cvt_pk_bf16(v0[2], v0[3]); w.z = cvt_pk_bf16(v1[0], v1[1]); w.w = cvt_pk_bf16(v1[2], v1[3]); return w; }

template <class Epi, class Sched, bool ALIGN_EPI = true>
__device__ __forceinline__ void gemm_phase(PG8_LAS unsigned char* lds, const Gemm g, const Sched& S, const Epi& E) {
    const int tid = threadIdx.x, wid = __builtin_amdgcn_readfirstlane(tid >> 6), lane = tid & 63, wr = wid >> 2, wc = wid & 3, fr = lane & 15, fq = lane >> 4;
    const int K = g.K, nt = K / BK;
    unsigned voffA[2], voffB[2];
#pragma unroll
    for (int i = 0; i < 2; ++i) { int R, C; stage_rc(tid * 16 + i * 8192, R, C); const int Rb = (R & ~31) + perm32(R & 31);
        voffA[i] = (unsigned)(R * g.lda + C) * 2u; voffB[i] = (unsigned)(Rb * g.ldb + C) * 2u; }
    const size_t kstep = (size_t)(BK * 2);
    const size_t hstepA = (size_t)HALF * g.lda * 2, hstepB = (size_t)HALF * g.ldb * 2;
    const size_t tstepA = 2 * hstepA, tstepB = 2 * hstepB;
    const unsigned ldsw = (unsigned)wid * 1024u;
    const int aoff = lds_byte(wr * 64 + fr, fq * 8), boff = lds_byte(wc * 32 + fr, fq * 8);
#define PG8_SA(b, h) (((b) * 2 + (h)) * HTB)
#define PG8_SB(b, h) ((4 + (b) * 2 + (h)) * HTB)
#define PG8_STAGE(bufoff, gbase, voff) do { _Pragma("unroll") for (int _i = 0; _i < 2; ++_i) \
        __builtin_amdgcn_global_load_lds((const unsigned*)((const char*)(gbase) + (voff)[_i]), (PG8_LAS unsigned*)(lds + (bufoff) + ldsw + _i * 8192), 16, 0, 0); } while (0)
#define PG8_LDA(dst, b, h) do { _Pragma("unroll") for (int m = 0; m < 4; ++m) _Pragma("unroll") for (int k = 0; k < 2; ++k) dst[m][k] = *(const PG8_LAS bf16x8*)(lds + PG8_SA(b, h) + aoff + m * 2048 + k * 1024); } while (0)
#define PG8_LDB(dst, b, h) do { _Pragma("unroll") for (int n = 0; n < 2; ++n) _Pragma("unroll") for (int k = 0; k < 2; ++k) dst[n][k] = *(const PG8_LAS bf16x8*)(lds + PG8_SB(b, h) + boff + n * 2048 + k * 1024); } while (0)
#define PG8_MMA(ai, bj, At, Bt) do { __builtin_amdgcn_s_setprio(1); _Pragma("unroll") for (int m = 0; m < 4; ++m) _Pragma("unroll") for (int n = 0; n < 2; ++n) _Pragma("unroll") for (int k = 0; k < 2; ++k) \
        acc[ai][bj][m][n] = __builtin_amdgcn_mfma_f32_16x16x32_bf16(Bt[n][k], At[m][k], acc[ai][bj][m][n], 0, 0, 0); __builtin_amdgcn_s_setprio(0); } while (0)
#define PG8_WAIT_V(n) asm volatile("s_waitcnt vmcnt(" #n ")" ::: "memory")
#define PG8_WAIT_L(n) asm volatile("s_waitcnt lgkmcnt(" #n ")" ::: "memory")
#define PG8_BAR __builtin_amdgcn_s_barrier()
#define PG8_SCHED __builtin_amdgcn_sched_barrier(0)
    Unit cur, nxt; int ui = 0;
    if (!S.next(0, cur)) return;
    f32x4 acc[2][2][4][2];
#pragma unroll
    for (int a = 0; a < 2; ++a)
#pragma unroll
        for (int b = 0; b < 2; ++b)
#pragma unroll
            for (int m = 0; m < 4; ++m)
#pragma unroll
                for (int n = 0; n < 2; ++n) acc[a][b][m][n] = (f32x4){0.f, 0.f, 0.f, 0.f};
    bf16x8 At[4][2], B0[2][2], B1[2][2];
    const char* cA = (const char*)g.A + (size_t)cur.pa * tstepA; const char* cB = (const char*)g.Bt + (size_t)cur.pb * tstepB;
    PG8_STAGE(PG8_SB(0, 0), cB, voffB); PG8_STAGE(PG8_SB(0, 1), cB + hstepB, voffB); PG8_STAGE(PG8_SA(0, 0), cA, voffA); PG8_STAGE(PG8_SA(0, 1), cA + hstepA, voffA);
    if (wr == 1) PG8_BAR;
    PG8_WAIT_V(2); PG8_BAR;
    PG8_STAGE(PG8_SB(1, 0), cB + kstep, voffB); PG8_STAGE(PG8_SA(1, 0), cA + kstep, voffA); PG8_STAGE(PG8_SB(1, 1), cB + hstepB + kstep, voffB);
    PG8_WAIT_V(6); PG8_BAR;
    for (;;) {
        const bool has_next = S.next(ui + 1, nxt);
        const char* nA = has_next ? (const char*)g.A + (size_t)nxt.pa * tstepA : cA; const char* nB = has_next ? (const char*)g.Bt + (size_t)nxt.pb * tstepB : cB;
        for (int t = 0; t < nt; t += 2) {
            const bool last = (t == nt - 2);
            const char* a1 = cA + (size_t)(t + 1) * kstep;
            const char* a2 = last ? nA : cA + (size_t)(t + 2) * kstep; const char* b2 = last ? nB : cB + (size_t)(t + 2) * kstep;
            const char* a3 = a2 + kstep; const char* b3 = b2 + kstep;
            PG8_LDB(B0, 0, 0); PG8_LDB(B1, 0, 1); PG8_SCHED; PG8_LDA(At, 0, 0); PG8_STAGE(PG8_SA(1, 1), a1 + hstepA, voffA);
            PG8_WAIT_V(8); PG8_WAIT_L(0); PG8_BAR; PG8_MMA(0, 0, At, B0); PG8_MMA(0, 1, At, B1); PG8_BAR; PG8_SCHED;
            PG8_LDA(At, 0, 1); PG8_STAGE(PG8_SB(0, 0), b2, voffB); PG8_STAGE(PG8_SB(0, 1), b2 + hstepB, voffB); PG8_STAGE(PG8_SA(0, 0), a2, voffA);
            PG8_WAIT_V(8); PG8_WAIT_L(0); PG8_BAR; PG8_MMA(1, 0, At, B0); PG8_MMA(1, 1, At, B1); PG8_BAR; PG8_SCHED;
            PG8_LDB(B0, 1, 0); PG8_LDB(B1, 1, 1); PG8_SCHED; PG8_LDA(At, 1, 0); PG8_STAGE(PG8_SA(0, 1), a2 + hstepA, voffA);
            PG8_WAIT_V(8); PG8_WAIT_L(0); PG8_BAR; PG8_MMA(0, 0, At, B0); PG8_MMA(0, 1, At, B1); PG8_BAR; PG8_SCHED;
            PG8_LDA(At, 1, 1); PG8_STAGE(PG8_SB(1, 0), b3, voffB); PG8_STAGE(PG8_SB(1, 1), b3 + hstepB, voffB); PG8_STAGE(PG8_SA(1, 0), a3, voffA);
            PG8_WAIT_V(8); PG8_WAIT_L(0); PG8_BAR; PG8_MMA(1, 0, At, B0); PG8_MMA(1, 1, At, B1); PG8_BAR; PG8_SCHED;
        }
        if constexpr (ALIGN_EPI) { if (wr == 0) PG8_BAR; }
        E(acc, cur, wr, wc, fr, fq);
        if (!has_next) break;
#pragma unroll
        for (int a = 0; a < 2; ++a)
#pragma unroll
            for (int b = 0; b < 2; ++b)
#pragma unroll
                for (int m = 0; m < 4; ++m)
#pragma unroll
                    for (int n = 0; n < 2; ++n) acc[a][b][m][n] = (f32x4){0.f, 0.f, 0.f, 0.f};
        cur = nxt; cA = nA; cB = nB; ++ui;
        if constexpr (ALIGN_EPI) { if (wr == 1) PG8_BAR; }
    }
    PG8_WAIT_V(0);
    if constexpr (!ALIGN_EPI) { if (wr == 0) PG8_BAR; }
    PG8_BAR;
#undef PG8_SA
#undef PG8_SB
#undef PG8_STAGE
#undef PG8_LDA
#undef PG8_LDB
#undef PG8_MMA
#undef PG8_WAIT_V
#undef PG8_WAIT_L
#undef PG8_BAR
#undef PG8_SCHED
}
}

constexpr int NB = 4, SEQ = 4096, NTOK = NB * SEQ, DM = 1024;
constexpr int NWAVES = 8, NTHR = 512;
constexpr int D_SSM = 512, NGRP = 32, NSTATE = 64, CH = 32  , NCH = SEQ / CH  , UGX_LD = 640, S5_ROWS = NB * NCH  ;
constexpr int NIN_PAD = 4608;
constexpr int NEXP = 32, TOPK_E = 4, DFF = 1024;
constexpr int NSEL = 256;
constexpr int MAX_MT = 288;
constexpr float RMS_EPS = 1e-5f;

constexpr size_t MiB = 1u << 20;
constexpr size_t WS_CTL = 0, CTL_ZERO_BYTES = 1 * MiB;
constexpr size_t WS_ROPE = 1 * MiB;
constexpr size_t WS_WIN = 2 * MiB;
constexpr size_t WS_WGLU = 11 * MiB;
constexpr size_t WS_WPS = 12 * MiB;
constexpr size_t WS_WPA = 13 * MiB;
constexpr size_t WS_WOUT = 14 * MiB;
constexpr size_t WS_MT = 16 * MiB;
constexpr size_t WS_WS = 36 * MiB;
constexpr size_t WS_A32 = 44 * MiB;
constexpr size_t WS_SBUF = 45 * MiB;
constexpr size_t WS_WI = 53 * MiB;
constexpr size_t WS_KI = 54 * MiB;
constexpr size_t WS_K = 56 * MiB;
constexpr size_t WS_V = 60 * MiB;
constexpr size_t WS_UGX = 64 * MiB;
constexpr size_t WS_Q = 84 * MiB;
constexpr size_t WS_QI = 100 * MiB;
constexpr size_t WS_GS = 132 * MiB;
constexpr size_t WS_GA = 164 * MiB;
constexpr size_t WS_XN = 196 * MiB;
constexpr size_t WS_YG = 228 * MiB;
constexpr size_t WS_YSSM = 244 * MiB;
constexpr size_t WS_YATT = 260 * MiB;
constexpr size_t WS_SEL = 276 * MiB;
constexpr size_t WS_MIXED = 284 * MiB;
constexpr size_t WS_X1 = 316 * MiB;
constexpr size_t WS_H2 = 380 * MiB;
constexpr size_t WS_TOPE = 412 * MiB;
constexpr size_t WS_TOPW = WS_TOPE + 256 * 1024;
constexpr size_t WS_TOPPOS = WS_TOPW + 256 * 1024;
constexpr size_t WS_ROWMAP = 413 * MiB;
constexpr size_t WS_WMI = 416 * MiB;
constexpr size_t WS_WMO = 544 * MiB;
constexpr size_t WS_ACT = 608 * MiB;
constexpr size_t WS_XP = 64 * MiB;
constexpr size_t WS_Y2 = 64 * MiB;
constexpr size_t WS_END = 752 * MiB;
static_assert(WS_XP + (size_t)MAX_MT * 256 * 1024 * 2 <= WS_YG, "XP overlay");
constexpr int CW_TMO = 0, CW_CODE = 1;
constexpr int CW_BAR = 4096;
constexpr int CW_ECNT = 16384;

constexpr int LDS_BYTES = 163840;
constexpr int MISC_OFF = 163840 - 2048;

#define GAS __attribute__((address_space(1)))
#define LAS __attribute__((address_space(3)))
typedef unsigned short bf16;
typedef unsigned short u16;
typedef unsigned v4u __attribute__((ext_vector_type(4)));
typedef unsigned v2u __attribute__((ext_vector_type(2)));
typedef float f32x4 __attribute__((ext_vector_type(4)));
typedef float f32x16 __attribute__((ext_vector_type(16)));
typedef short bf16x8 __attribute__((ext_vector_type(8)));
typedef GAS unsigned gu32;
#define RLX_AGENT __ATOMIC_RELAXED, __HIP_MEMORY_SCOPE_AGENT
#define LDS_WAIT() asm volatile("s_waitcnt lgkmcnt(0)" ::: "memory")
#define VM_WAIT() asm volatile("s_waitcnt vmcnt(0)" ::: "memory")
__device__ __forceinline__ unsigned f2bf(float f) { unsigned u = __builtin_bit_cast(unsigned, f); return (u + 0x7fffu + ((u >> 16) & 1u)) >> 16; }
__device__ __forceinline__ unsigned pk2(float lo, float hi) { return f2bf(lo) | (f2bf(hi) << 16); }
__device__ __forceinline__ float bf2f(unsigned b) { return __builtin_bit_cast(float, b << 16); }
__device__ __forceinline__ float bflo(unsigned w) { return __builtin_bit_cast(float, w << 16); }
__device__ __forceinline__ float bfhi(unsigned w) { return __builtin_bit_cast(float, w & 0xffff0000u); }
__device__ __forceinline__ float sigmoidf_(float x) { return 1.0f / (1.0f + __expf(-x)); }
__device__ __forceinline__ float gelu_tanh(float x) { const float u = 0.7978845608028654f * (x + 0.044715f * x * x * x); const float e = __expf(2.0f * u); const float t = 1.0f - 2.0f / (e + 1.0f); return 0.5f * x * (1.0f + t); }

#define XB_TMO      128
#define XB_XCNT(j)  (256  + 64 * (j))
#define XB_XSUB(j)  (1280 + 64 * (j))
#define XB_XGEN(j)  (2304 + 64 * (j))
#define XB_TOP      3328
#define XB_TOPGEN   3392
#define XCD_BAR_WORDS 3456
#define XB_SPIN_CAP (1u << 18)
__device__ __forceinline__ unsigned xb_ld(unsigned* p)              { return __hip_atomic_load(p, __ATOMIC_RELAXED, __HIP_MEMORY_SCOPE_AGENT); }
__device__ __forceinline__ unsigned xb_add(unsigned* p, unsigned v) { return __hip_atomic_fetch_add(p, v, __ATOMIC_RELAXED, __HIP_MEMORY_SCOPE_AGENT); }
__device__ __forceinline__ unsigned xb_xcc_id() { return (unsigned)__builtin_amdgcn_s_getreg((3 << 11) | 20) & 0xFu; }
#define XB_SPIN(cond, bar) do { unsigned _sp = 0; while (cond) { __builtin_amdgcn_s_sleep(1); \
    if ((++_sp & 255u) == 0u) { if (xb_ld(&(bar)[XB_TMO])) break; if (_sp > XB_SPIN_CAP) { atomicAdd(&(bar)[XB_TMO], 1u); break; } } } } while (0)
struct XcdBarrier { unsigned* bar; unsigned x; volatile LAS unsigned* st; };
__device__ __forceinline__ XcdBarrier xcd_barrier_post(unsigned* bar, volatile LAS unsigned* st) {
    XcdBarrier b; b.bar = bar; b.x = xb_xcc_id(); b.st = st;
    if (threadIdx.x == 0) (void)xb_add(&bar[XB_XCNT(b.x)], 1u);
    return b;
}
__device__ __forceinline__ void xcd_barrier_complete(unsigned* bar, unsigned x, unsigned& nloc, unsigned& nx) {
    const unsigned G = gridDim.x * gridDim.y * gridDim.z;
    unsigned sum, cnt, mine, sp = 0u;
    for (;;) {
        sum = 0u; cnt = 0u; mine = 0u;
#pragma unroll
        for (unsigned j = 0; j < 16; ++j) { const unsigned c = xb_ld(&bar[XB_XCNT(j)]); sum += c; cnt += (c > 0u) ? 1u : 0u; mine = (j == x) ? c : mine; }
        if (sum == G) break;
        __builtin_amdgcn_s_sleep(1);
        if ((++sp & 255u) == 0u) { if (xb_ld(&bar[XB_TMO])) break; if (sp > XB_SPIN_CAP) { atomicAdd(&bar[XB_TMO], 1u); break; } }
    }
    nloc = mine > 0u ? mine : 1u; nx = cnt > 0u ? cnt : 1u;
}
__device__ __forceinline__ void xcd_barrier(const XcdBarrier& b) {
    asm volatile("s_waitcnt vmcnt(0)" ::: "memory");
    __syncthreads();
    if (threadIdx.x == 0) {
        unsigned* bar = b.bar;
        __builtin_amdgcn_s_waitcnt(0);
        unsigned nloc = b.st[0], nx = b.st[1];
        if (nloc == 0u) { xcd_barrier_complete(bar, b.x, nloc, nx); b.st[0] = nloc; b.st[1] = nx; }
        const unsigned old = xb_add(&bar[XB_XSUB(b.x)], 1u);
        const unsigned gen = old / nloc;
        if (old + 1u == (gen + 1u) * nloc) {
            __builtin_amdgcn_fence(__ATOMIC_RELEASE, "agent");
            asm volatile("s_waitcnt vmcnt(0)" ::: "memory");
            const unsigned og = xb_add(&bar[XB_TOP], 1u);
            const unsigned tg = og / nx;
            if (og + 1u == (tg + 1u) * nx) xb_add(&bar[XB_TOPGEN], 1u);
            else XB_SPIN(xb_ld(&bar[XB_TOPGEN]) == tg, bar);
            __builtin_amdgcn_fence(__ATOMIC_ACQUIRE, "agent");
            xb_add(&bar[XB_XGEN(b.x)], 1u);
            asm volatile("s_waitcnt vmcnt(0)" ::: "memory");
        } else {
            XB_SPIN(xb_ld(&bar[XB_XGEN(b.x)]) == gen, bar);
            __builtin_amdgcn_fence(__ATOMIC_ACQUIRE, "agent");
            asm volatile("s_waitcnt vmcnt(0)" ::: "memory");
        }
    }
    __syncthreads();
}

struct Frame {
    LAS unsigned char* lds;
    volatile LAS unsigned* MISC;
    gu32* ctl;
    int tid, lane, wave, G;
    unsigned char* ws;
    const float* in[25];
    float* out;
};
enum { I_X = 0, I_N1G, I_WIN, I_BGATE, I_LRE, I_LIM, I_LOGDT, I_BRE, I_BIM, I_CRE, I_CIM, I_SD, I_WGLU, I_BGLU, I_WPS, I_WPA, I_WOUT, I_N2G, I_WR, I_BR, I_WMI, I_BMI, I_WMO, I_BMO, I_NFG };

__device__ __forceinline__ float wave_sum(float v) {
#pragma unroll
    for (int o = 1; o < 64; o <<= 1) v += __shfl_xor(v, o);
    return v;
}

__device__ __forceinline__ int ropeperm(int p) { const int a = p >> 3, bb = p & 7; return bb < 4 ? 4 * a + bb : 32 + 4 * a + (bb - 4); }
__device__ __forceinline__ int win_src(int nd) {
    const int pn = nd >> 8, j = nd & 255;
    if (pn < 2) return nd;
    if (pn < 4) { const int i = nd - 512; return 512 + (i & ~63) + ropeperm(i & 63); }
    if (pn == 4) { if (j < 128) return 1024 + (j & ~63) + ropeperm(j & 63); return 1152 + (j - 128); }
    if (pn < 9) { const int i = nd - 1280; return 1280 + (i & ~63) + ropeperm(i & 63); }
    if (pn == 9) { if (j < 64) return 2304 + ropeperm(j); if (j < 80) return 2368 + (j - 64); return -1; }
    if (pn < 14) return 2384 + (nd - 2560);
    return 3408 + (nd - 3584);
}
template <int MAP>
__device__ __forceinline__ void p0_transpose_item(const float* W, int K, int N, bf16* WT, int NdBlocks, LAS float* scr, int item, int lane) {
    const int kb = item / NdBlocks, nb = item % NdBlocks, k0 = 64 * kb, n0 = 32 * nb;
    int sc = n0 + (lane & 31);
    if (MAP == 1) sc = win_src(sc);
#pragma unroll 8
    for (int i = 0; i < 32; ++i) { const int kk = 2 * i + (lane >> 5); scr[kk * 33 + (lane & 31)] = (sc >= 0) ? W[(size_t)(k0 + kk) * N + sc] : 0.f; }
    LDS_WAIT(); asm volatile("" ::: "memory");
    const int c = lane & 7;
#pragma unroll
    for (int j = 0; j < 4; ++j) { const int n = (lane >> 3) + 8 * j; const LAS float* s = scr + (8 * c) * 33 + n;
        v4u o; o.x = pk2(s[0 * 33], s[1 * 33]); o.y = pk2(s[2 * 33], s[3 * 33]); o.z = pk2(s[4 * 33], s[5 * 33]); o.w = pk2(s[6 * 33], s[7 * 33]);
        *(GAS v4u*)(WT + (size_t)(n0 + n) * K + k0 + 8 * c) = o; }
    LDS_WAIT(); asm volatile("" ::: "memory");
}
__device__ __forceinline__ void rms_row_to_bf16(int lane, const float* xrow, const float* g, bf16* orow) {
    const GAS f32x4* xr = (const GAS f32x4*)xrow + lane; const GAS f32x4* gr = (const GAS f32x4*)g + lane;
    f32x4 v[4]; float s2 = 0.f;
#pragma unroll
    for (int j = 0; j < 4; ++j) { v[j] = xr[64 * j]; s2 += (v[j].x * v[j].x + v[j].y * v[j].y) + (v[j].z * v[j].z + v[j].w * v[j].w); }
    const float rstd = 1.0f / sqrtf(wave_sum(s2) * (1.f / DM) + RMS_EPS);
    GAS unsigned long long* o8 = (GAS unsigned long long*)orow + lane;
#pragma unroll
    for (int j = 0; j < 4; ++j) { const f32x4 gg = gr[64 * j];
        o8[64 * j] = (unsigned long long)pk2(v[j].x * rstd * gg.x, v[j].y * rstd * gg.y) | ((unsigned long long)pk2(v[j].z * rstd * gg.z, v[j].w * rstd * gg.w) << 32); }
}
__device__ __forceinline__ void p0_s5_group(Frame& F, int g) {
    LAS float* AP = (LAS float*)(F.lds);
    LAS float* BB = (LAS float*)(F.lds + 16896);
    LAS float* CC = (LAS float*)(F.lds + 25088);
    LAS float* KJ = (LAS float*)(F.lds + 33280);
    const float* lre = F.in[I_LRE] + g * 64; const float* lim = F.in[I_LIM] + g * 64;
    const double dt = exp((double)F.in[I_LOGDT][g]);
    __syncthreads();
    for (int idx = F.tid; idx < 33 * 64; idx += NTHR) { const int p = idx & 63, j = idx >> 6;
        const double lr = lre[p], li = lim[p]; const double mag = exp(j * lr * dt), ang = j * li * dt;
        AP[idx * 2] = (float)(mag * cos(ang)); AP[idx * 2 + 1] = (float)(mag * sin(ang)); }
    for (int idx = F.tid; idx < 1024; idx += NTHR) { const int p = idx >> 4;
        const double lr = lre[p], li = lim[p]; const double mag = exp(lr * dt), ang = li * dt; const double ar = mag * cos(ang), ai = mag * sin(ang);
        const double nr = ar - 1.0, ni = ai, den = lr * lr + li * li; const double zr = (nr * lr + ni * li) / den, zi = (ni * lr - nr * li) / den;
        const double br = F.in[I_BRE][g * 1024 + idx], bi = F.in[I_BIM][g * 1024 + idx];
        BB[idx * 2] = (float)(zr * br - zi * bi); BB[idx * 2 + 1] = (float)(zr * bi + zi * br); }
    for (int idx = F.tid; idx < 1024; idx += NTHR) { CC[idx * 2] = F.in[I_CRE][g * 1024 + idx]; CC[idx * 2 + 1] = F.in[I_CIM][g * 1024 + idx]; }
    __syncthreads();
    for (int idx = F.tid; idx < 32 * 256; idx += NTHR) { const int j = idx >> 8, hp = (idx >> 4) & 15, h = idx & 15; float s = 0.f;
        for (int p = 0; p < 64; ++p) { const float cr = CC[(hp * 64 + p) * 2], ci = CC[(hp * 64 + p) * 2 + 1], ar = AP[(j * 64 + p) * 2], ai = AP[(j * 64 + p) * 2 + 1];
            const float er = cr * ar - ci * ai, ei = cr * ai + ci * ar; s += er * BB[(p * 16 + h) * 2] - ei * BB[(p * 16 + h) * 2 + 1]; }
        KJ[idx] = s; }
    __syncthreads();
    bf16* MT = (bf16*)(F.ws + WS_MT) + (size_t)g * 512 * 640;
    for (int ch = F.tid; ch < 512 * 80; ch += NTHR) { const int n = ch / 80, k0 = (ch % 80) * 8, tp = n >> 4, hp = n & 15; float v[8];
        if (k0 < 512) { const int sp = k0 >> 4, h0 = k0 & 15;
#pragma unroll
            for (int j = 0; j < 8; ++j) v[j] = (sp <= tp) ? KJ[((tp - sp) * 16 + hp) * 16 + h0 + j] : 0.f; }
        else { const bool im = k0 >= 576; const int p0 = k0 - (im ? 576 : 512);
#pragma unroll
            for (int j = 0; j < 8; ++j) { const int p = p0 + j; const float cr = CC[(hp * 64 + p) * 2], ci = CC[(hp * 64 + p) * 2 + 1], ar = AP[((tp + 1) * 64 + p) * 2], ai = AP[((tp + 1) * 64 + p) * 2 + 1];
                v[j] = im ? -(cr * ai + ci * ar) : (cr * ar - ci * ai); } }
        v4u o; o.x = pk2(v[0], v[1]); o.y = pk2(v[2], v[3]); o.z = pk2(v[4], v[5]); o.w = pk2(v[6], v[7]);
        *(GAS v4u*)(MT + (size_t)n * 640 + k0) = o; }
    bf16* WS = (bf16*)(F.ws + WS_WS) + (size_t)g * 256 * 512;
    for (int ch = F.tid; ch < 256 * 64; ch += NTHR) { const int n = ch >> 6, k0 = (ch & 63) * 8, sp = k0 >> 4, h0 = k0 & 15; float v[8];
#pragma unroll
        for (int j = 0; j < 8; ++j) { if (n < 128) { const int p = n & 63; const float ar = AP[((31 - sp) * 64 + p) * 2], ai = AP[((31 - sp) * 64 + p) * 2 + 1], br = BB[(p * 16 + h0 + j) * 2], bi = BB[(p * 16 + h0 + j) * 2 + 1];
                v[j] = (n < 64) ? (ar * br - ai * bi) : (ar * bi + ai * br); } else v[j] = 0.f; }
        v4u o; o.x = pk2(v[0], v[1]); o.y = pk2(v[2], v[3]); o.z = pk2(v[4], v[5]); o.w = pk2(v[6], v[7]);
        *(GAS v4u*)(WS + (size_t)n * 512 + k0) = o; }
    float* A32 = (float*)(F.ws + WS_A32) + g * 128;
    if (F.tid < 128) A32[F.tid] = AP[32 * 128 + F.tid];
    __syncthreads();
}
__device__ __forceinline__ void p0_prologue(Frame& F) {
    if ((int)blockIdx.x >= F.G - NGRP) p0_s5_group(F, (int)blockIdx.x - (F.G - NGRP));
    LAS float* scr = (LAS float*)(F.lds + F.wave * 16384);
    const int gw = blockIdx.x * NWAVES + F.wave, NGW = F.G * NWAVES;
    { float* cosT = (float*)(F.ws + WS_ROPE); float* sinT = cosT + SEQ * 32;
      for (int i = blockIdx.x * NTHR + F.tid; i < SEQ * 32; i += F.G * NTHR) { const int pos = i >> 5, k = i & 31;
          const double inv = pow(10000.0, -(double)k / 32.0); const double ang = (double)pos * (double)(float)inv;
          cosT[i] = (float)cos(ang); sinT[i] = (float)sin(ang); } }
    for (int m = gw; m < NTOK; m += NGW) rms_row_to_bf16(F.lane, F.in[I_X] + (size_t)m * DM, F.in[I_N1G], (bf16*)(F.ws + WS_XN) + (size_t)m * DM);
    constexpr int I_IN = 16 * (NIN_PAD / 32), I_GLU = 8 * 16, I_PS = 8 * 32, I_PA = 8 * 32, I_OUT = 16 * 32, I_MI1 = 16 * 64, I_MO1 = 16 * 32;
    constexpr int NITEMS = I_IN + I_GLU + I_PS + I_PA + I_OUT + NEXP * I_MI1 + NEXP * I_MO1;
    for (int it = gw; it < NITEMS; it += NGW) {
        int r = it;
        if (r < I_IN) { p0_transpose_item<1>(F.in[I_WIN], DM, 4432, (bf16*)(F.ws + WS_WIN), NIN_PAD / 32, scr, r, F.lane); continue; } r -= I_IN;
        if (r < I_GLU) { p0_transpose_item<0>(F.in[I_WGLU], 512, 512, (bf16*)(F.ws + WS_WGLU), 16, scr, r, F.lane); continue; } r -= I_GLU;
        if (r < I_PS) { p0_transpose_item<0>(F.in[I_WPS], 512, 1024, (bf16*)(F.ws + WS_WPS), 32, scr, r, F.lane); continue; } r -= I_PS;
        if (r < I_PA) { p0_transpose_item<0>(F.in[I_WPA], 512, 1024, (bf16*)(F.ws + WS_WPA), 32, scr, r, F.lane); continue; } r -= I_PA;
        if (r < I_OUT) { p0_transpose_item<0>(F.in[I_WOUT], 1024, 1024, (bf16*)(F.ws + WS_WOUT), 32, scr, r, F.lane); continue; } r -= I_OUT;
        if (r < NEXP * I_MI1) { const int e = r / I_MI1; p0_transpose_item<0>(F.in[I_WMI] + (size_t)e * 1024 * 2048, 1024, 2048, (bf16*)(F.ws + WS_WMI) + (size_t)e * 2048 * 1024, 64, scr, r % I_MI1, F.lane); continue; } r -= NEXP * I_MI1;
        { const int e = r / I_MO1; p0_transpose_item<0>(F.in[I_WMO] + (size_t)e * 1024 * 1024, 1024, 1024, (bf16*)(F.ws + WS_WMO) + (size_t)e * 1024 * 1024, 32, scr, r % I_MO1, F.lane); }
    }
}

struct StaticOrder {
    int nM, nN, nwg, G, c;
    __device__ void init(int nM_, int nN_, int G_, int c_) { nM = nM_; nN = nN_; nwg = nM * nN; G = G_; c = c_; }
    __device__ bool tile(int i, int& pm, int& pn) const {
        const long L = (long)i * G + c; if (L >= nwg) return false;
        int wgid = (int)L; { const int q = nwg / pg8::NXCD, r = nwg % pg8::NXCD, xcd = wgid % pg8::NXCD, off = wgid / pg8::NXCD; wgid = (xcd < r ? xcd * (q + 1) : r * (q + 1) + (xcd - r) * q) + off; }
        const int nig = pg8::WGM * nN, gid = wgid / nig, fm = gid * pg8::WGM, gsz = (nM - fm) < pg8::WGM ? (nM - fm) : pg8::WGM;
        pm = fm + ((wgid % nig) % gsz); pn = (wgid % nig) / gsz; return true;
    }
    __device__ bool next(int i, pg8::Unit& u) const { int pm, pn; if (!tile(i, pm, pn)) return false; u.pm = pm; u.pn = pn; u.pa = pm; u.pb = pn; u.e = 0; return true; }
};
struct S5StateOrder {
    int c;
    __device__ bool next(int i, pg8::Unit& u) const { if (i > 0 || c >= 64) return false; const int g = c >> 1, pm = c & 1; u.pm = pm; u.pn = 0; u.pa = g * 2 + pm; u.pb = g; u.e = g; return true; }
};
struct S5YOrder {
    int c;
    __device__ bool next(int i, pg8::Unit& u) const { if (i > 0 || c >= 128) return false; const int g = c >> 2, pm = (c >> 1) & 1, pn = c & 1; u.pm = pm; u.pn = pn; u.pa = g * 2 + pm; u.pb = g * 2 + pn; u.e = g; return true; }
};
struct MixOrder {
    StaticOrder so;
    __device__ bool next(int i, pg8::Unit& u) const { int pm, pn; if (!so.tile(i >> 1, pm, pn)) return false; const int h = i & 1; u.pm = pm; u.pn = pn; u.pa = pm + 64 * h; u.pb = pn + 4 * h; u.e = h; return true; }
};
struct MoeOrder {
    const volatile LAS int* te; int TT, NTN, c;
    __device__ bool next(int i, pg8::Unit& u) const {
        const int xcd = c & 7, j = c >> 3, mpx = 32 / NTN; const int mt = i * (8 * mpx) + xcd * mpx + j / NTN, pn = j % NTN;
        if (mt >= TT) return false; const int e = te[mt]; u.pm = mt; u.pn = pn; u.pa = mt; u.pb = e * NTN + pn; u.e = e; return true; }
};

using pg8::f32x2; using pg8::u32x2; using pg8::pack8; using pg8::cvt_pk_bf16;
#define EPI_ROWS_BEGIN _Pragma("unroll") for (int ai = 0; ai < 2; ++ai) _Pragma("unroll") for (int m = 0; m < 4; ++m) { const int row = u.pm * 256 + ai * 128 + wr * 64 + m * 16 + fr; (void)row;
#define EPI_COLS_BEGIN _Pragma("unroll") for (int bj = 0; bj < 2; ++bj) { const int ct = bj * 128 + wc * 32 + fq * 8; (void)ct; f32x4 v0 = acc[ai][bj][m][0], v1 = acc[ai][bj][m][1];
#define EPI_END } }
struct EpiInProj {
    static constexpr bool PERM = true;
    unsigned char* ws; const float* bgate;
    __device__ __forceinline__ void rope(f32x4& v0, f32x4& v1, int pos, int a, float sc) const {
        const float* cosT = (const float*)(ws + WS_ROPE); const float* sinT = cosT + SEQ * 32;
        const f32x4 c = *(const GAS f32x4*)(cosT + pos * 32 + 4 * a), s = *(const GAS f32x4*)(sinT + pos * 32 + 4 * a);
        const f32x4 o1 = (v0 * c - v1 * s) * sc, o2 = (v1 * c + v0 * s) * sc; v0 = o1; v1 = o2;
    }
    __device__ __forceinline__ void store_rope(bf16* dst, const f32x4& o1, const f32x4& o2) const {
        u32x2 a, b; a.x = cvt_pk_bf16(o1[0], o1[1]); a.y = cvt_pk_bf16(o1[2], o1[3]); b.x = cvt_pk_bf16(o2[0], o2[1]); b.y = cvt_pk_bf16(o2[2], o2[3]);
        *(GAS u32x2*)dst = a; *(GAS u32x2*)(dst + 32) = b;
    }
    __device__ __forceinline__ void operator()(const f32x4 (&acc)[2][2][4][2], const pg8::Unit& u, int wr, int wc, int fr, int fq) const {
        const int pn = u.pn;
        if (pn < 2) {
            bf16* UGX = (bf16*)(ws + WS_UGX);
            EPI_ROWS_BEGIN const int bb = row >> 12, cc = (row >> 5) & 127, sp = row & 31;
            EPI_COLS_BEGIN const int col = pn * 256 + ct, g = col >> 4, h0 = col & 15;
                *(GAS v4u*)(UGX + ((size_t)(g * 512 + bb * 128 + cc)) * UGX_LD + sp * 16 + h0) = pack8(v0, v1);
            EPI_END
        } else if (pn < 4) {
            bf16* Q = (bf16*)(ws + WS_Q);
            EPI_ROWS_BEGIN const int pos = row & 4095;
            EPI_COLS_BEGIN const int j = (pn - 2) * 256 + ct, head = j >> 6, a = (j & 63) >> 3;
                rope(v0, v1, pos, a, 0.125f); store_rope(Q + (size_t)row * 512 + head * 64 + 4 * a, v0, v1);
            EPI_END
        } else if (pn == 4) {
            bf16* Kb = (bf16*)(ws + WS_K); bf16* Vb = (bf16*)(ws + WS_V);
            EPI_ROWS_BEGIN const int pos = row & 4095;
            EPI_COLS_BEGIN
                if (bj == 0) { const int head = ct >> 6, a = (ct & 63) >> 3; rope(v0, v1, pos, a, 1.0f); store_rope(Kb + (size_t)row * 128 + head * 64 + 4 * a, v0, v1); }
                else *(GAS v4u*)(Vb + (size_t)row * 128 + (ct - 128)) = pack8(v0, v1);
            EPI_END
        } else if (pn < 9) {
            bf16* QI = (bf16*)(ws + WS_QI);
            EPI_ROWS_BEGIN const int pos = row & 4095;
            EPI_COLS_BEGIN const int j = (pn - 5) * 256 + ct, head = j >> 6, a = (j & 63) >> 3;
                rope(v0, v1, pos, a, 1.0f); store_rope(QI + (size_t)row * 1024 + head * 64 + 4 * a, v0, v1);
            EPI_END
        } else if (pn == 9) {
            bf16* KI = (bf16*)(ws + WS_KI); float* WI = (float*)(ws + WS_WI);
            EPI_ROWS_BEGIN const int pos = row & 4095;
            EPI_COLS_BEGIN
                if (bj == 0) { if (ct < 64) { const int a = ct >> 3; rope(v0, v1, pos, a, 1.0f); store_rope(KI + (size_t)row * 64 + 4 * a, v0, v1); }
                    else if (ct < 80) { float* d = WI + (size_t)row * 16 + (ct - 64); *(GAS f32x4*)d = v0 * 0.03125f; *(GAS f32x4*)(d + 4) = v1 * 0.03125f; } }
            EPI_END
        } else {
            const int br = pn >= 14; bf16* Gd = (bf16*)(ws + (br ? WS_GA : WS_GS)); const float* bgp = bgate + br * 1024;
            EPI_ROWS_BEGIN
            EPI_COLS_BEGIN const int col = (pn - (br ? 14 : 10)) * 256 + ct;
                const f32x4 b0 = *(const GAS f32x4*)(bgp + col), b1 = *(const GAS f32x4*)(bgp + col + 4);
#pragma unroll
                for (int j = 0; j < 4; ++j) { v0[j] = sigmoidf_(v0[j] + b0[j]); v1[j] = sigmoidf_(v1[j] + b1[j]); }
                *(GAS v4u*)(Gd + (size_t)row * 1024 + col) = pack8(v0, v1);
            EPI_END
        }
    }
};
struct EpiS5State {
    static constexpr bool PERM = true;
    float* SB;
    __device__ __forceinline__ void operator()(const f32x4 (&acc)[2][2][4][2], const pg8::Unit& u, int wr, int wc, int fr, int fq) const {
        EPI_ROWS_BEGIN
        EPI_COLS_BEGIN
            if (bj == 0) { float* d = SB + ((size_t)u.e * 512 + row) * 128 + ct; *(GAS f32x4*)d = v0; *(GAS f32x4*)(d + 4) = v1; }
        EPI_END
    }
};
struct EpiS5Y {
    static constexpr bool PERM = true;
    const bf16* UGX; const float* Dsk; bf16* YG;
    __device__ __forceinline__ void operator()(const f32x4 (&acc)[2][2][4][2], const pg8::Unit& u, int wr, int wc, int fr, int fq) const {
        const int g = u.e;
        EPI_ROWS_BEGIN const int bb = row >> 7, cc = row & 127;
        EPI_COLS_BEGIN const int n = u.pn * 256 + ct, tp = n >> 4, h0 = n & 15;
            const v4u uu = *(const GAS v4u*)(UGX + ((size_t)g * 512 + row) * UGX_LD + n);
            const f32x4 d0 = *(const GAS f32x4*)(Dsk + g * 16 + h0), d1 = *(const GAS f32x4*)(Dsk + g * 16 + h0 + 4);
            v0[0] += d0[0] * bflo(uu.x); v0[1] += d0[1] * bfhi(uu.x); v0[2] += d0[2] * bflo(uu.y); v0[3] += d0[3] * bfhi(uu.y);
            v1[0] += d1[0] * bflo(uu.z); v1[1] += d1[1] * bfhi(uu.z); v1[2] += d1[2] * bflo(uu.w); v1[3] += d1[3] * bfhi(uu.w);
#pragma unroll
            for (int j = 0; j < 4; ++j) { v0[j] = gelu_tanh(v0[j]); v1[j] = gelu_tanh(v1[j]); }
            const int tok = bb * 4096 + cc * 32 + tp;
            *(GAS v4u*)(YG + (size_t)tok * 512 + g * 16 + h0) = pack8(v0, v1);
        EPI_END
    }
};
struct EpiGlu {
    static constexpr bool PERM = true;
    const bf16* YG; const float* bglu; bf16* YS;
    __device__ __forceinline__ void operator()(const f32x4 (&acc)[2][2][4][2], const pg8::Unit& u, int wr, int wc, int fr, int fq) const {
        EPI_ROWS_BEGIN
        EPI_COLS_BEGIN const int col = u.pn * 256 + ct;
            const v4u yy = *(const GAS v4u*)(YG + (size_t)row * 512 + col);
            const f32x4 b0 = *(const GAS f32x4*)(bglu + col), b1 = *(const GAS f32x4*)(bglu + col + 4);
            v0[0] = bflo(yy.x) * sigmoidf_(v0[0] + b0[0]); v0[1] = bfhi(yy.x) * sigmoidf_(v0[1] + b0[1]); v0[2] = bflo(yy.y) * sigmoidf_(v0[2] + b0[2]); v0[3] = bfhi(yy.y) * sigmoidf_(v0[3] + b0[3]);
            v1[0] = bflo(yy.z) * sigmoidf_(v1[0] + b1[0]); v1[1] = bfhi(yy.z) * sigmoidf_(v1[1] + b1[1]); v1[2] = bflo(yy.w) * sigmoidf_(v1[2] + b1[2]); v1[3] = bfhi(yy.w) * sigmoidf_(v1[3] + b1[3]);
            *(GAS v4u*)(YS + (size_t)row * 512 + col) = pack8(v0, v1);
        EPI_END
    }
};
struct EpiMix {
    static constexpr bool PERM = true;
    const bf16* GS; const bf16* GA; bf16* MX;
    __device__ __forceinline__ void operator()(const f32x4 (&acc)[2][2][4][2], const pg8::Unit& u, int wr, int wc, int fr, int fq) const {
        const bf16* Gp = u.e ? GA : GS;
        EPI_ROWS_BEGIN
        EPI_COLS_BEGIN const size_t off = (size_t)row * 1024 + u.pn * 256 + ct;
            const v4u gg = *(const GAS v4u*)(Gp + off);
            v0[0] *= bflo(gg.x); v0[1] *= bfhi(gg.x); v0[2] *= bflo(gg.y); v0[3] *= bfhi(gg.y); v1[0] *= bflo(gg.z); v1[1] *= bfhi(gg.z); v1[2] *= bflo(gg.w); v1[3] *= bfhi(gg.w);
            if (u.e) { const v4u pp = *(const GAS v4u*)(MX + off);
                v0[0] += bflo(pp.x); v0[1] += bfhi(pp.x); v0[2] += bflo(pp.y); v0[3] += bfhi(pp.y); v1[0] += bflo(pp.z); v1[1] += bfhi(pp.z); v1[2] += bflo(pp.w); v1[3] += bfhi(pp.w); }
            *(GAS v4u*)(MX + off) = pack8(v0, v1);
        EPI_END
    }
};
struct EpiOut {
    static constexpr bool PERM = true;
    const float* X; float* X1;
    __device__ __forceinline__ void operator()(const f32x4 (&acc)[2][2][4][2], const pg8::Unit& u, int wr, int wc, int fr, int fq) const {
        EPI_ROWS_BEGIN
        EPI_COLS_BEGIN const size_t off = (size_t)row * 1024 + u.pn * 256 + ct;
            const f32x4 x0 = *(const GAS f32x4*)(X + off), x1 = *(const GAS f32x4*)(X + off + 4);
            *(GAS f32x4*)(X1 + off) = v0 + x0; *(GAS f32x4*)(X1 + off + 4) = v1 + x1;
        EPI_END
    }
};
struct EpiMoe1 {
    static constexpr bool PERM = true;
    const float* bmi; bf16* ACT;
    __device__ __forceinline__ void operator()(const f32x4 (&acc)[2][2][4][2], const pg8::Unit& u, int wr, int wc, int fr, int fq) const {
        const float* bp = bmi + (size_t)u.e * 2048;
        EPI_ROWS_BEGIN
        EPI_COLS_BEGIN const int col = u.pn * 256 + ct;
            const f32x4 b0 = *(const GAS f32x4*)(bp + col), b1 = *(const GAS f32x4*)(bp + col + 4);
            v0 += b0; v1 += b1; float o[4];
#pragma unroll
            for (int j = 0; j < 4; ++j) { const float zg0 = (j < 2) ? v0[2 * j] : v1[2 * j - 4], zl0 = (j < 2) ? v0[2 * j + 1] : v1[2 * j - 3];
                const float zg = fminf(zg0, 7.0f), zl = fminf(fmaxf(zl0, -7.0f), 7.0f); o[j] = zg * sigmoidf_(1.702f * zg) * (zl + 1.0f); }
            u32x2 w; w.x = cvt_pk_bf16(o[0], o[1]); w.y = cvt_pk_bf16(o[2], o[3]);
            *(GAS u32x2*)(ACT + (size_t)row * 1024 + (col >> 1)) = w;
        EPI_END
    }
};
struct EpiMoe2 {
    static constexpr bool PERM = true;
    const float* bmo; bf16* Y2;
    __device__ __forceinline__ void operator()(const f32x4 (&acc)[2][2][4][2], const pg8::Unit& u, int wr, int wc, int fr, int fq) const {
        const float* bp = bmo + (size_t)u.e * 1024;
        EPI_ROWS_BEGIN
        EPI_COLS_BEGIN const int col = u.pn * 256 + ct;
            const f32x4 b0 = *(const GAS f32x4*)(bp + col), b1 = *(const GAS f32x4*)(bp + col + 4);
            v0 += b0; v1 += b1;
            *(GAS v4u*)(Y2 + (size_t)row * 1024 + col) = pack8(v0, v1);
        EPI_END
    }
};

__device__ __forceinline__ unsigned f16key(unsigned bits) { return (bits & 0x8000u) ? (bits ^ 0xffffu) : (bits | 0x8000u); }
__device__ __forceinline__ void idx_phase(Frame& F) {
    LAS unsigned char* lds = F.lds;
    LAS u16* SC = (LAS u16*)lds;
    LAS unsigned char* KT = lds + 131072;
    LAS unsigned* H1 = (LAS unsigned*)(lds + 131072);
    LAS unsigned char* OLB = lds + 131072 + 16384;
    LAS unsigned* CN = (LAS unsigned*)(lds + MISC_OFF + 256);
    const bf16* QI = (const bf16*)(F.ws + WS_QI); const bf16* KI = (const bf16*)(F.ws + WS_KI); const float* WI = (const float*)(F.ws + WS_WI);
    u16* SEL = (u16*)(F.ws + WS_SEL);
    const int tid = F.tid, lane = F.lane, wave = F.wave, hh = lane >> 5;
    for (int r = 0; r < 4; ++r) {
        const int b = r, tile = (r & 1) ? 255 - (int)blockIdx.x : (int)blockIdx.x, t0 = tile * 16;
        __syncthreads();
        const int ql = tid >> 5, jj = tid & 31, t = t0 + ql; const size_t tok = (size_t)b * SEQ + t;
        if (tile < 16) {
#pragma unroll
            for (int i = 0; i < 8; ++i) { const int k = jj * 8 + i; SEL[tok * NSEL + k] = (u16)(k <= t ? k : 0); }
            continue;
        }
        bf16x8 qa[4]; float w[16];
        { const int rho = lane & 31, qq = (rho >> 2) & 1, head = (rho & 3) + 4 * (rho >> 3);
          const bf16* qp = QI + ((size_t)b * SEQ + t0 + 2 * wave + qq) * 1024 + head * 64 + 8 * hh;
#pragma unroll
          for (int ks = 0; ks < 4; ++ks) qa[ks] = *(const GAS bf16x8*)(qp + ks * 16);
          const float* wp = WI + ((size_t)b * SEQ + t0 + 2 * wave + hh) * 16;
#pragma unroll
          for (int i = 0; i < 4; ++i) { const f32x4 x = *(const GAS f32x4*)(wp + 4 * i); w[4 * i] = x[0]; w[4 * i + 1] = x[1]; w[4 * i + 2] = x[2]; w[4 * i + 3] = x[3]; } }
        const int nkt = (t0 + 15) / 64 + 1;
        const int srow = tid >> 3, sch = tid & 7; const int sdst = srow * 128 + ((sch ^ ((srow >> 1) & 7)) << 4);
        const bf16* kbase = KI + (size_t)b * SEQ * 64 + srow * 64 + sch * 8;
        { const v4u x = *(const GAS v4u*)(kbase); *(LAS v4u*)(KT + sdst) = x; }
        for (int kt = 0; kt < nkt; ++kt) {
            __syncthreads();
            v4u pf = (v4u){0u, 0u, 0u, 0u};
            if (kt + 1 < nkt) pf = *(const GAS v4u*)(kbase + (size_t)(kt + 1) * 64 * 64);
            const LAS unsigned char* kb = KT + (kt & 1) * 8192;
#pragma unroll
            for (int sub = 0; sub < 2; ++sub) {
                const int key = sub * 32 + (lane & 31);
                f32x16 acc = {0.f, 0.f, 0.f, 0.f, 0.f, 0.f, 0.f, 0.f, 0.f, 0.f, 0.f, 0.f, 0.f, 0.f, 0.f, 0.f};
#pragma unroll
                for (int ks = 0; ks < 4; ++ks) { const bf16x8 bfr = *(const LAS bf16x8*)(kb + key * 128 + (((ks * 2 + hh) ^ ((key >> 1) & 7)) << 4));
                    acc = __builtin_amdgcn_mfma_f32_32x32x16_bf16(qa[ks], bfr, acc, 0, 0, 0); }
                float s = 0.f;
#pragma unroll
                for (int i = 0; i < 16; ++i) s += w[i] * fmaxf(acc[i], 0.f);
                const _Float16 hs = (_Float16)s;
                SC[(2 * wave + hh) * 4096 + kt * 64 + key] = __builtin_bit_cast(unsigned short, hs);
            }
            if (kt + 1 < nkt) *(LAS v4u*)(KT + ((kt + 1) & 1) * 8192 + sdst) = pf;
        }
        __syncthreads();
        for (int i = tid; i < 4096; i += NTHR) H1[i] = 0u;
        if (tid < 32) CN[tid] = 0u;
        __syncthreads();
        const int n = t + 1;
        const LAS u16* sc = SC + ql * 4096;
        for (int i = jj; i < n; i += 32) atomicAdd((unsigned*)&H1[ql * 256 + (f16key(sc[i]) >> 8)], 1u);
        LDS_WAIT(); __builtin_amdgcn_wave_barrier();
        unsigned b1, need1;
        { unsigned s8 = 0; unsigned hb[8];
#pragma unroll
          for (int i = 0; i < 8; ++i) { hb[i] = H1[ql * 256 + 255 - (jj * 8 + i)]; s8 += hb[i]; }
          unsigned pre = s8;
#pragma unroll
          for (int o = 1; o < 32; o <<= 1) { const unsigned x = __shfl_up(pre, o, 32); if (jj >= o) pre += x; }
          const unsigned long long bal = __ballot(pre >= 256u); const unsigned m32 = (unsigned)(bal >> (32 * hh)); const int js = __builtin_ctz(m32);
          unsigned above = pre - s8, bb1 = 0, nd1 = 0; bool found = false;
#pragma unroll
          for (int i = 0; i < 8; ++i) { if (!found) { if (above + hb[i] >= 256u) { bb1 = 255 - (jj * 8 + i); nd1 = 256u - above; found = true; } else above += hb[i]; } }
          b1 = __shfl(bb1, js + 32 * hh); need1 = __shfl(nd1, js + 32 * hh); }
#pragma unroll
        for (int i = 0; i < 8; ++i) H1[ql * 256 + jj * 8 + i] = 0u;
        LDS_WAIT(); __builtin_amdgcn_wave_barrier();
        for (int i = jj; i < n; i += 32) { const unsigned k = f16key(sc[i]); if ((k >> 8) == b1) atomicAdd((unsigned*)&H1[ql * 256 + (k & 255u)], 1u); }
        LDS_WAIT(); __builtin_amdgcn_wave_barrier();
        unsigned T, need2;
        { unsigned s8 = 0; unsigned hb[8];
#pragma unroll
          for (int i = 0; i < 8; ++i) { hb[i] = H1[ql * 256 + 255 - (jj * 8 + i)]; s8 += hb[i]; }
          unsigned pre = s8;
#pragma unroll
          for (int o = 1; o < 32; o <<= 1) { const unsigned x = __shfl_up(pre, o, 32); if (jj >= o) pre += x; }
          const unsigned long long bal = __ballot(pre >= need1); const unsigned m32 = (unsigned)(bal >> (32 * hh)); const int js = __builtin_ctz(m32);
          unsigned above = pre - s8, bb2 = 0, nd2 = 0; bool found = false;
#pragma unroll
          for (int i = 0; i < 8; ++i) { if (!found) { if (above + hb[i] >= need1) { bb2 = 255 - (jj * 8 + i); nd2 = need1 - above; found = true; } else above += hb[i]; } }
          const unsigned b2 = __shfl(bb2, js + 32 * hh); need2 = __shfl(nd2, js + 32 * hh); T = (b1 << 8) | b2; }
        LAS u16* OL = (LAS u16*)(OLB + ql * 512);
        for (int i = jj; i < n; i += 32) { const unsigned k = f16key(sc[i]); bool take = k > T;
            if (k == T) { const unsigned tp = atomicAdd((unsigned*)&CN[ql * 2 + 1], 1u); take = tp < need2; }
            if (take) { const unsigned pos = atomicAdd((unsigned*)&CN[ql * 2], 1u); if (pos < 256u) OL[pos] = (u16)i; } }
        LDS_WAIT(); __builtin_amdgcn_wave_barrier();
        { const v4u x = *(const LAS v4u*)(OL + jj * 8); *(GAS v4u*)(SEL + tok * NSEL + jj * 8) = x; }
    }
}

__device__ __forceinline__ void carry_phase(Frame& F) {
    const int gid = blockIdx.x * NTHR + F.tid; if (gid >= NGRP * NB * 64) return;
    const int p = gid & 63, b = (gid >> 6) & 3, g = gid >> 8;
    const float* A32 = (const float*)(F.ws + WS_A32) + g * 128; const float ar = A32[p * 2], ai = A32[p * 2 + 1];
    const float* SB = (const float*)(F.ws + WS_SBUF) + ((size_t)g * 512 + b * 128) * 128; bf16* UX = (bf16*)(F.ws + WS_UGX) + ((size_t)g * 512 + b * 128) * UGX_LD;
    float xr = 0.f, xi = 0.f;
    for (int c = 0; c < NCH; ++c) {
        UX[(size_t)c * UGX_LD + 512 + p] = (bf16)f2bf(xr); UX[(size_t)c * UGX_LD + 576 + p] = (bf16)f2bf(xi);
        const float sr = SB[c * 128 + p], si = SB[c * 128 + 64 + p];
        const float nr = ar * xr - ai * xi + sr, ni = ar * xi + ai * xr + si; xr = nr; xi = ni;
    }
}

__device__ __forceinline__ void attn_phase(Frame& F) {
    LAS unsigned char* wl = F.lds + F.wave * 16384;
    LAS unsigned char* KB = wl;
    LAS float* PB = (LAS float*)(wl + 9216);
    LAS u16* SL = (LAS u16*)(wl + 13312);
    const bf16* Q = (const bf16*)(F.ws + WS_Q); const bf16* Kg = (const bf16*)(F.ws + WS_K); const bf16* Vg = (const bf16*)(F.ws + WS_V);
    const u16* SEL = (const u16*)(F.ws + WS_SEL); bf16* YA = (bf16*)(F.ws + WS_YATT);
    const int lane = F.lane, gw = blockIdx.x * NWAVES + F.wave, NGW = F.G * NWAVES;
    const int hd = lane & 15, kg = lane >> 4;
    for (int it = gw; it < NTOK * 2; it += NGW) {
        const int tok = it >> 1, kvh = it & 1, t = tok & 4095; const size_t bbase = (size_t)(tok >> 12) * SEQ;
        const int nsel = (t + 1 < NSEL) ? t + 1 : NSEL;
        { const v2u x = *(const GAS v2u*)(SEL + (size_t)tok * NSEL + lane * 4); *(LAS v2u*)(SL + lane * 4) = x; }
        bf16x8 qf[2];
#pragma unroll
        for (int ks = 0; ks < 2; ++ks) { if (hd < 4) qf[ks] = *(const GAS bf16x8*)(Q + (size_t)tok * 512 + (kvh * 4 + hd) * 64 + ks * 32 + kg * 8); else qf[ks] = (bf16x8){0, 0, 0, 0, 0, 0, 0, 0}; }
        LDS_WAIT(); __builtin_amdgcn_wave_barrier();
#pragma unroll 1
        for (int ch = 0; ch < 4; ++ch) {
            if (ch * 64 < nsel) {
                f32x4 sc[4];
#pragma unroll
                for (int tl = 0; tl < 4; ++tl) sc[tl] = (f32x4){0.f, 0.f, 0.f, 0.f};
#pragma unroll
                for (int i8 = 0; i8 < 8; ++i8) { const int pc = i8 * 64 + lane, row = pc >> 3, c16 = pc & 7, ki = ch * 64 + row; const int s = (ki < nsel) ? (int)SL[ki] : 0;
                    const v4u x = *(const GAS v4u*)(Kg + (bbase + s) * 128 + kvh * 64 + c16 * 8); *(LAS v4u*)(KB + row * 144 + c16 * 16) = x; }
                LDS_WAIT(); __builtin_amdgcn_wave_barrier();
#pragma unroll
                for (int tl = 0; tl < 4; ++tl)
#pragma unroll
                    for (int ks = 0; ks < 2; ++ks) { const bf16x8 af = *(const LAS bf16x8*)(KB + (tl * 16 + hd) * 144 + ks * 64 + kg * 16);
                        sc[tl] = __builtin_amdgcn_mfma_f32_16x16x32_bf16(af, qf[ks], sc[tl], 0, 0, 0); }
                if (hd < 4) {
#pragma unroll
                    for (int tl = 0; tl < 4; ++tl)
#pragma unroll
                        for (int r = 0; r < 4; ++r) PB[(ch * 64 + tl * 16 + kg * 4 + r) * 4 + hd] = sc[tl][r];
                }
                LDS_WAIT(); __builtin_amdgcn_wave_barrier();
            }
        }
        {
            f32x4 pv[4]; f32x4 mx = (f32x4){-3.0e38f, -3.0e38f, -3.0e38f, -3.0e38f};
#pragma unroll
            for (int i = 0; i < 4; ++i) { const int key = lane + 64 * i; pv[i] = (f32x4){-3.0e38f, -3.0e38f, -3.0e38f, -3.0e38f};
                if (key < nsel) pv[i] = *(const LAS f32x4*)(PB + key * 4);
#pragma unroll
                for (int h = 0; h < 4; ++h) mx[h] = fmaxf(mx[h], pv[i][h]); }
#pragma unroll
            for (int o = 1; o < 64; o <<= 1)
#pragma unroll
                for (int h = 0; h < 4; ++h) mx[h] = fmaxf(mx[h], __shfl_xor(mx[h], o));
            f32x4 sm = (f32x4){0.f, 0.f, 0.f, 0.f};
#pragma unroll
            for (int i = 0; i < 4; ++i) { const int key = lane + 64 * i;
#pragma unroll
                for (int h = 0; h < 4; ++h) { const float e = (key < nsel) ? __expf(pv[i][h] - mx[h]) : 0.f; pv[i][h] = e; sm[h] += e; } }
#pragma unroll
            for (int o = 1; o < 64; o <<= 1)
#pragma unroll
                for (int h = 0; h < 4; ++h) sm[h] += __shfl_xor(sm[h], o);
#pragma unroll
            for (int i = 0; i < 4; ++i) { const int key = lane + 64 * i;
                if (key < nsel) { f32x4 p;
#pragma unroll
                    for (int h = 0; h < 4; ++h) p[h] = pv[i][h] / sm[h];
                    *(LAS f32x4*)(PB + key * 4) = p; } }
        }
        LDS_WAIT(); __builtin_amdgcn_wave_barrier();
        float o0 = 0.f, o1 = 0.f, o2 = 0.f, o3 = 0.f;
        const bf16* vb = Vg + bbase * 128 + kvh * 64 + lane;
#pragma unroll 4
        for (int k = 0; k < nsel; ++k) { const int s = SL[k]; const float v = bf2f(vb[(size_t)s * 128]); const f32x4 p = *(const LAS f32x4*)(PB + k * 4);
            o0 += p[0] * v; o1 += p[1] * v; o2 += p[2] * v; o3 += p[3] * v; }
        bf16* yo = YA + (size_t)tok * 512 + kvh * 256 + lane;
        yo[0] = (bf16)f2bf(o0); yo[64] = (bf16)f2bf(o1); yo[128] = (bf16)f2bf(o2); yo[192] = (bf16)f2bf(o3);
        LDS_WAIT(); __builtin_amdgcn_wave_barrier();
    }
}

__device__ __forceinline__ void router_phase(Frame& F) {
    LAS float* HR = (LAS float*)(F.lds);
    LAS float* PT = (LAS float*)(F.lds + 65536);
    LAS int* LE = (LAS int*)(F.lds + 81920);
    LAS int* LP = (LAS int*)(F.lds + 82944);
    LAS unsigned* LC = (LAS unsigned*)(F.lds + 83968);
    const float* X1 = (const float*)(F.ws + WS_X1); bf16* H2 = (bf16*)(F.ws + WS_H2);
    const float* WR = F.in[I_WR]; const float* BR = F.in[I_BR]; const float* G2 = F.in[I_N2G];
    int* TOPE = (int*)(F.ws + WS_TOPE); float* TOPW = (float*)(F.ws + WS_TOPW); int* TOPPOS = (int*)(F.ws + WS_TOPPOS); int* ROWMAP = (int*)(F.ws + WS_ROWMAP);
    const int tid = F.tid, lane = F.lane, wave = F.wave, e = lane & 31, dh = lane >> 5;
    float wr[64];
#pragma unroll
    for (int i = 0; i < 64; ++i) wr[i] = WR[(size_t)(128 * wave + dh * 64 + i) * 32 + e];
    if (tid < 64) LC[tid] = 0u;
    const int tok0 = blockIdx.x * 64;
    for (int bt = 0; bt < 4; ++bt) {
        __syncthreads();
#pragma unroll
        for (int rr = 0; rr < 2; ++rr) { const int lr = 2 * wave + rr, tok = tok0 + bt * 16 + lr;
            const GAS f32x4* xr = (const GAS f32x4*)(X1 + (size_t)tok * DM) + lane; const GAS f32x4* gr = (const GAS f32x4*)G2 + lane;
            f32x4 v[4]; float s2 = 0.f;
#pragma unroll
            for (int j = 0; j < 4; ++j) { v[j] = xr[64 * j]; s2 += (v[j].x * v[j].x + v[j].y * v[j].y) + (v[j].z * v[j].z + v[j].w * v[j].w); }
            const float rstd = 1.0f / sqrtf(wave_sum(s2) * (1.f / DM) + RMS_EPS);
            GAS unsigned long long* o8 = (GAS unsigned long long*)(H2 + (size_t)tok * DM) + lane;
#pragma unroll
            for (int j = 0; j < 4; ++j) { const f32x4 gg = gr[64 * j]; const f32x4 h = v[j] * rstd * gg;
                *(LAS f32x4*)(HR + lr * 1024 + 256 * j + 4 * lane) = h;
                o8[64 * j] = (unsigned long long)pk2(h.x, h.y) | ((unsigned long long)pk2(h.z, h.w) << 32); } }
        __syncthreads();
#pragma unroll 2
        for (int lr = 0; lr < 16; ++lr) { const LAS float* hp = HR + lr * 1024 + 128 * wave + dh * 64; float s = 0.f;
#pragma unroll
            for (int i = 0; i < 16; ++i) { const f32x4 h = *(const LAS f32x4*)(hp + 4 * i); s += h[0] * wr[4 * i] + h[1] * wr[4 * i + 1] + h[2] * wr[4 * i + 2] + h[3] * wr[4 * i + 3]; }
            s += __shfl_xor(s, 32);
            if (dh == 0) PT[(lr * 8 + wave) * 32 + e] = s; }
        __syncthreads();
        { const int lr = 2 * wave + dh, tl = bt * 16 + lr, tok = tok0 + tl; float lg = BR[e];
#pragma unroll
          for (int w8 = 0; w8 < 8; ++w8) lg += PT[(lr * 8 + w8) * 32 + e];
          float cur = lg; float tv[4]; int te[4];
#pragma unroll
          for (int k = 0; k < 4; ++k) { float mv = cur; int mi = e;
#pragma unroll
              for (int o = 1; o < 32; o <<= 1) { const float ov = __shfl_xor(mv, o); const int oi = __shfl_xor(mi, o); if (ov > mv || (ov == mv && oi < mi)) { mv = ov; mi = oi; } }
              tv[k] = mv; te[k] = mi; if (e == mi) cur = -3.0e38f; }
          const float e1 = __expf(tv[1] - tv[0]), e2 = __expf(tv[2] - tv[0]), e3 = __expf(tv[3] - tv[0]); const float inv = 1.0f / (1.0f + e1 + e2 + e3);
          if (e < 4) { const int ex = (e == 0) ? te[0] : (e == 1) ? te[1] : (e == 2) ? te[2] : te[3]; const float wv = ((e == 0) ? 1.0f : (e == 1) ? e1 : (e == 2) ? e2 : e3) * inv;
              TOPE[(size_t)tok * 4 + e] = ex; TOPW[(size_t)tok * 4 + e] = wv; LE[tl * 4 + e] = ex; LP[tl * 4 + e] = (int)atomicAdd((unsigned*)&LC[ex], 1u); } }
    }
    __syncthreads();
    if (tid < 32) LC[32 + tid] = __hip_atomic_fetch_add((unsigned*)(F.ctl + CW_ECNT) + tid, LC[tid], RLX_AGENT);
    __syncthreads();
    if (tid < 256) { const int ex = LE[tid], pos = (int)LC[32 + ex] + LP[tid], tok = tok0 + (tid >> 2); TOPPOS[(size_t)tok * 4 + (tid & 3)] = pos; ROWMAP[(size_t)ex * NTOK + pos] = tok; }
}

__device__ __forceinline__ int moe_tables(Frame& F, LAS int* OFF, LAS int* TE) {
    __syncthreads();
    if (F.tid == 0) { int acc = 0; for (int e = 0; e < NEXP; ++e) { const int c = (int)__hip_atomic_load((unsigned*)(F.ctl + CW_ECNT) + e, RLX_AGENT); const int nt = (c + 255) >> 8; OFF[e] = acc * 256; for (int i = 0; i < nt; ++i) TE[acc + i] = e; acc += nt; } OFF[NEXP] = acc; }
    __syncthreads();
    return OFF[NEXP];
}
__device__ __forceinline__ void dispatch_phase(Frame& F) {
    LAS int* OFF = (LAS int*)(F.lds + MISC_OFF + 512); LAS int* TE = OFF + 40;
    (void)moe_tables(F, OFF, TE);
    const int* TOPE = (const int*)(F.ws + WS_TOPE); const int* TOPPOS = (const int*)(F.ws + WS_TOPPOS);
    const bf16* H2 = (const bf16*)(F.ws + WS_H2); bf16* XP = (bf16*)(F.ws + WS_XP);
    const int gw = blockIdx.x * NWAVES + F.wave, NGW = F.G * NWAVES;
    for (int pr = gw; pr < NTOK * 4; pr += NGW) { const int tok = pr >> 2; const int slot = OFF[TOPE[pr]] + TOPPOS[pr];
        const GAS v4u* s = (const GAS v4u*)(H2 + (size_t)tok * DM) + F.lane; GAS v4u* d = (GAS v4u*)(XP + (size_t)slot * DM) + F.lane;
        const v4u a = s[0], b = s[64]; d[0] = a; d[64] = b; }
}
__device__ __forceinline__ void combine_phase(Frame& F) {
    LAS int* OFF = (LAS int*)(F.lds + MISC_OFF + 512); LAS int* TE = OFF + 40;
    (void)moe_tables(F, OFF, TE);
    const int* TOPE = (const int*)(F.ws + WS_TOPE); const int* TOPPOS = (const int*)(F.ws + WS_TOPPOS); const float* TOPW = (const float*)(F.ws + WS_TOPW);
    const float* X1 = (const float*)(F.ws + WS_X1); const bf16* Y2 = (const bf16*)(F.ws + WS_Y2); const float* GF = F.in[I_NFG];
    const int gw = blockIdx.x * NWAVES + F.wave, NGW = F.G * NWAVES, lane = F.lane;
    for (int tok = gw; tok < NTOK; tok += NGW) {
        f32x4 v[4];
#pragma unroll
        for (int j = 0; j < 4; ++j) v[j] = ((const GAS f32x4*)(X1 + (size_t)tok * DM) + lane)[64 * j];
#pragma unroll
        for (int k = 0; k < 4; ++k) { const int slot = OFF[TOPE[tok * 4 + k]] + TOPPOS[tok * 4 + k]; const float wk = TOPW[tok * 4 + k];
            const GAS v2u* yr = (const GAS v2u*)(Y2 + (size_t)slot * DM) + lane;
#pragma unroll
            for (int j = 0; j < 4; ++j) { const v2u y = yr[64 * j]; v[j].x += wk * bflo(y.x); v[j].y += wk * bfhi(y.x); v[j].z += wk * bflo(y.y); v[j].w += wk * bfhi(y.y); } }
        float s2 = 0.f;
#pragma unroll
        for (int j = 0; j < 4; ++j) s2 += (v[j].x * v[j].x + v[j].y * v[j].y) + (v[j].z * v[j].z + v[j].w * v[j].w);
        const float rstd = 1.0f / sqrtf(wave_sum(s2) * (1.f / DM) + RMS_EPS);
#pragma unroll
        for (int j = 0; j < 4; ++j) { const f32x4 gg = ((const GAS f32x4*)GF + lane)[64 * j]; ((GAS f32x4*)(F.out + (size_t)tok * DM) + lane)[64 * j] = v[j] * rstd * gg; }
    }
}

constexpr int NPHASE = 13;
struct Args { const float* in[25]; float* out; unsigned char* ws; int ph_lo, ph_hi; };
__global__ void __launch_bounds__(NTHR, 2) fwd_kernel(Args args) {
    extern __shared__ __attribute__((aligned(16))) unsigned char lds[];
    Frame F;
    F.lds = (LAS unsigned char*)lds;
    F.MISC = (volatile LAS unsigned*)(F.lds + MISC_OFF);
    F.tid = threadIdx.x; F.lane = F.tid & 63; F.wave = __builtin_amdgcn_readfirstlane(F.tid >> 6); F.G = gridDim.x;
    F.ws = args.ws; F.ctl = (gu32*)(args.ws + WS_CTL); F.out = args.out;
#pragma unroll
    for (int i = 0; i < 25; ++i) F.in[i] = args.in[i];
    for (int u = F.tid; u < 2048 / 4; u += NTHR) ((LAS unsigned*)(F.lds + MISC_OFF))[u] = 0u;
    __syncthreads();
    XcdBarrier bar; bar.bar = (unsigned*)(F.ctl + CW_BAR); bar.x = 0; bar.st = nullptr;
    if (MK_N_LAUNCHES == 1) bar = xcd_barrier_post((unsigned*)(F.ctl + CW_BAR), F.MISC + 8);
    const int lo = args.ph_lo, hi = args.ph_hi;
#define IN(k) (lo <= (k) && (k) < hi)
#define SEAM(k) do { if (IN(k) && IN((k) + 1)) xcd_barrier(bar); } while (0)
    unsigned char* ws = F.ws; const int c = (int)blockIdx.x;

    if (IN(0)) { p0_prologue(F); } SEAM(0);
    if (IN(1)) {
        pg8::Gemm g{(const bf16*)(ws + WS_XN), (const bf16*)(ws + WS_WIN), 1024, 1024, 1024}; StaticOrder S; S.init(NTOK / 256, NIN_PAD / 256, F.G, c);
        EpiInProj E{ws, F.in[I_BGATE]};
        pg8::gemm_phase<EpiInProj, StaticOrder>(F.lds, g, S, E);
    } SEAM(1);
    if (IN(2)) {
        { pg8::Gemm g{(const bf16*)(ws + WS_UGX), (const bf16*)(ws + WS_WS), UGX_LD, 512, 512}; S5StateOrder S{c}; EpiS5State E{(float*)(ws + WS_SBUF)};
          pg8::gemm_phase<EpiS5State, S5StateOrder>(F.lds, g, S, E); }
        idx_phase(F);
    } SEAM(2);
    if (IN(3)) { carry_phase(F); attn_phase(F); } SEAM(3);
    if (IN(4)) {
        pg8::Gemm g{(const bf16*)(ws + WS_UGX), (const bf16*)(ws + WS_MT), UGX_LD, UGX_LD, 640}; S5YOrder S{c}; EpiS5Y E{(const bf16*)(ws + WS_UGX), F.in[I_SD], (bf16*)(ws + WS_YG)};
        pg8::gemm_phase<EpiS5Y, S5YOrder>(F.lds, g, S, E);
    } SEAM(4);
    if (IN(5)) {
        pg8::Gemm g{(const bf16*)(ws + WS_YG), (const bf16*)(ws + WS_WGLU), 512, 512, 512}; StaticOrder S; S.init(NTOK / 256, 2, F.G, c); EpiGlu E{(const bf16*)(ws + WS_YG), F.in[I_BGLU], (bf16*)(ws + WS_YSSM)};
        pg8::gemm_phase<EpiGlu, StaticOrder>(F.lds, g, S, E);
    } SEAM(5);
    if (IN(6)) {
        pg8::Gemm g{(const bf16*)(ws + WS_YSSM), (const bf16*)(ws + WS_WPS), 512, 512, 512}; MixOrder S; S.so.init(NTOK / 256, 4, F.G, c);
        EpiMix E{(const bf16*)(ws + WS_GS), (const bf16*)(ws + WS_GA), (bf16*)(ws + WS_MIXED)};
        pg8::gemm_phase<EpiMix, MixOrder>(F.lds, g, S, E);
    } SEAM(6);
    if (IN(7)) {
        pg8::Gemm g{(const bf16*)(ws + WS_MIXED), (const bf16*)(ws + WS_WOUT), 1024, 1024, 1024}; StaticOrder S; S.init(NTOK / 256, 4, F.G, c); EpiOut E{F.in[I_X], (float*)(ws + WS_X1)};
        pg8::gemm_phase<EpiOut, StaticOrder>(F.lds, g, S, E);
    } SEAM(7);
    if (IN(8)) { router_phase(F); } SEAM(8);
    if (IN(9)) { dispatch_phase(F); } SEAM(9);
    if (IN(10)) {
        LAS int* OFF = (LAS int*)(F.lds + MISC_OFF + 512); LAS int* TE = OFF + 40; const int TT = moe_tables(F, OFF, TE);
        pg8::Gemm g{(const bf16*)(ws + WS_XP), (const bf16*)(ws + WS_WMI), 1024, 1024, 1024}; MoeOrder S{TE, TT, 8, c}; EpiMoe1 E{F.in[I_BMI], (bf16*)(ws + WS_ACT)};
        pg8::gemm_phase<EpiMoe1, MoeOrder>(F.lds, g, S, E);
    } SEAM(10);
    if (IN(11)) {
        LAS int* OFF = (LAS int*)(F.lds + MISC_OFF + 512); LAS int* TE = OFF + 40; const int TT = moe_tables(F, OFF, TE);
        pg8::Gemm g{(const bf16*)(ws + WS_ACT), (const bf16*)(ws + WS_WMO), 1024, 1024, 1024}; MoeOrder S{TE, TT, 4, c}; EpiMoe2 E{F.in[I_BMO], (bf16*)(ws + WS_Y2)};
        pg8::gemm_phase<EpiMoe2, MoeOrder>(F.lds, g, S, E);
    } SEAM(11);
    if (IN(12)) { combine_phase(F); }
#undef IN
#undef SEAM
}

extern "C" void kernel_launch(void* const* d_in, const int* in_sizes, int n_in, void* d_out, int out_size, void* d_ws, size_t ws_size, hipStream_t stream) {
    static int grid = 0;
    if (grid == 0) {
        if (n_in != 25 || out_size != NTOK * DM || ws_size < WS_END) { fprintf(stderr, "kernel_launch: unexpected problem (n_in %d out %d ws %zu)\n", n_in, out_size, ws_size); grid = -1; return; }
        if (hipFuncSetAttribute((const void*)fwd_kernel, hipFuncAttributeMaxDynamicSharedMemorySize, LDS_BYTES) != hipSuccess) { fprintf(stderr, "kernel_launch: hipFuncSetAttribute failed\n"); grid = -1; return; }
        int per_cu = 0; (void)hipOccupancyMaxActiveBlocksPerMultiprocessor(&per_cu, (const void*)fwd_kernel, NTHR, LDS_BYTES); (void)hipGetLastError();
        grid = 256;
    }
    if (grid < 0) return;
    (void)hipMemsetAsync((char*)d_ws + WS_CTL, 0, CTL_ZERO_BYTES, stream);
    Args a{};
    for (int i = 0; i < 25; ++i) a.in[i] = (const float*)d_in[i];
    a.out = (float*)d_out; a.ws = (unsigned char*)d_ws;
    if (MK_N_LAUNCHES == 1) { a.ph_lo = 0; a.ph_hi = NPHASE; hipLaunchKernelGGL(fwd_kernel, dim3(grid), dim3(NTHR), LDS_BYTES, stream, a); }
    else for (int p = 0; p < NPHASE; ++p) { a.ph_lo = p; a.ph_hi = p + 1; hipLaunchKernelGGL(fwd_kernel, dim3(grid), dim3(NTHR), LDS_BYTES, stream, a); }
}
```

```cpp
#include <hip/hip_runtime.h>
#include <cstdio>
#include <cstdint>

#ifndef MK_N_LAUNCHES
#define MK_N_LAUNCHES 1
#endif
#ifndef PROBE_DUP
#define PROBE_DUP -1
#endif

namespace pg8 {
#define PG8_LAS __attribute__((address_space(3)))
typedef unsigned short bf16_t;
typedef short bf16x8 __attribute__((ext_vector_type(8)));
typedef float f32x4 __attribute__((ext_vector_type(4)));
typedef float f32x2 __attribute__((ext_vector_type(2)));
typedef unsigned u32x4 __attribute__((ext_vector_type(4)));
typedef unsigned u32x2 __attribute__((ext_vector_type(2)));
constexpr int BM = 256, BK = 64, HALF = 128, HTB = HALF * BK * 2, STAGE_BYTES = 8 * HTB, NXCD = 8, WGM = 8;

__host__ __device__ __forceinline__ int lds_byte(int r, int c) { const int st = (r >> 4) * 2 + (c >> 5), rr = r & 15, cc = c & 31, ob = rr * 64 + cc * 2; return st * 1024 + (ob ^ (((ob >> 9) & 1) << 5)); }
__host__ __device__ __forceinline__ void stage_rc(int b, int& R, int& C) { const int st = b / 1024, sb = b % 1024, swz = sb ^ (((sb >> 9) & 1) << 5); R = (st >> 1) * 16 + swz / 64; C = (st & 1) * 32 + (swz % 64) / 2; }
__host__ __device__ __forceinline__ int perm32(int rho) { const int n = rho >> 4, i = rho & 15; return 8 * (i >> 2) + 4 * n + (i & 3); }

struct Unit { int pm, pn, pa, pb, e; };
struct Gemm { const bf16_t* A; const bf16_t* Bt; int lda, ldb, K; };

__device__ __forceinline__ unsigned cvt_pk_bf16(float lo, float hi) { unsigned r; asm volatile("v_cvt_pk_bf16_f32 %0, %1, %2" : "=v"(r) : "v"(lo), "v"(hi)); return r; }
__device__ __forceinline__ u32x4 pack8(const f32x4& v0, const f32x4& v1) { u32x4 w; w.x = cvt_pk_bf16(v0[0], v0[1]); w.y = cvt_pk_bf16(v0[2], v0[3]); w.z = cvt_pk_bf16(v1[0], v1[1]); w.w = cvt_pk_bf16(v1[2], v1[3]); return w; }

template <class Epi, class Sched, bool ALIGN_EPI = true>
__device__ __forceinline__ void gemm_phase(PG8_LAS unsigned char* lds, const Gemm g, const Sched& S, const Epi& E) {
    const int tid = threadIdx.x, wid = __builtin_amdgcn_readfirstlane(tid >> 6), lane = tid & 63, wr = wid >> 2, wc = wid & 3, fr = lane & 15, fq = lane >> 4;
    const int K = g.K, nt = K / BK;
    unsigned voffA[2], voffB[2];
#pragma unroll
    for (int i = 0; i < 2; ++i) { int R, C; stage_rc(tid * 16 + i * 8192, R, C); const int Rb = (R & ~31) + perm32(R & 31);
        voffA[i] = (unsigned)(R * g.lda + C) * 2u; voffB[i] = (unsigned)(Rb * g.ldb + C) * 2u; }
    const size_t kstep = (size_t)(BK * 2);
    const size_t hstepA = (size_t)HALF * g.lda * 2, hstepB = (size_t)HALF * g.ldb * 2;
    const size_t tstepA = 2 * hstepA, tstepB = 2 * hstepB;
    const unsigned ldsw = (unsigned)wid * 1024u;
    const int aoff = lds_byte(wr * 64 + fr, fq * 8), boff = lds_byte(wc * 32 + fr, fq * 8);
#define PG8_SA(b, h) (((b) * 2 + (h)) * HTB)
#define PG8_SB(b, h) ((4 + (b) * 2 + (h)) * HTB)
#define PG8_STAGE(bufoff, gbase, voff) do { _Pragma("unroll") for (int _i = 0; _i < 2; ++_i) \
        __builtin_amdgcn_global_load_lds((const unsigned*)((const char*)(gbase) + (voff)[_i]), (PG8_LAS unsigned*)(lds + (bufoff) + ldsw + _i * 8192), 16, 0, 0); } while (0)
#define PG8_LDA(dst, b, h) do { _Pragma("unroll") for (int m = 0; m < 4; ++m) _Pragma("unroll") for (int k = 0; k < 2; ++k) dst[m][k] = *(const PG8_LAS bf16x8*)(lds + PG8_SA(b, h) + aoff + m * 2048 + k * 1024); } while (0)
#define PG8_LDB(dst, b, h) do { _Pragma("unroll") for (int n = 0; n < 2; ++n) _Pragma("unroll") for (int k = 0; k < 2; ++k) dst[n][k] = *(const PG8_LAS bf16x8*)(lds + PG8_SB(b, h) + boff + n * 2048 + k * 1024); } while (0)
#define PG8_MMA(ai, bj, At, Bt) do { __builtin_amdgcn_s_setprio(1); _Pragma("unroll") for (int m = 0; m < 4; ++m) _Pragma("unroll") for (int n = 0; n < 2; ++n) _Pragma("unroll") for (int k = 0; k < 2; ++k) \
        acc[ai][bj][m][n] = __builtin_amdgcn_mfma_f32_16x16x32_bf16(Bt[n][k], At[m][k], acc[ai][bj][m][n], 0, 0, 0); __builtin_amdgcn_s_setprio(0); } while (0)
#define PG8_WAIT_V(n) asm volatile("s_waitcnt vmcnt(" #n ")" ::: "memory")
#define PG8_WAIT_L(n) asm volatile("s_waitcnt lgkmcnt(" #n ")" ::: "memory")
#define PG8_BAR __builtin_amdgcn_s_barrier()
#define PG8_SCHED __builtin_amdgcn_sched_barrier(0)
    Unit cur, nxt; int ui = 0;
    if (!S.next(0, cur)) return;
    f32x4 acc[2][2][4][2];
#pragma unroll
    for (int a = 0; a < 2; ++a)
#pragma unroll
        for (int b = 0; b < 2; ++b)
#pragma unroll
            for (int m = 0; m < 4; ++m)
#pragma unroll
                for (int n = 0; n < 2; ++n) acc[a][b][m][n] = (f32x4){0.f, 0.f, 0.f, 0.f};
    bf16x8 At[4][2], B0[2][2], B1[2][2];
    const char* cA = (const char*)g.A + (size_t)cur.pa * tstepA; const char* cB = (const char*)g.Bt + (size_t)cur.pb * tstepB;
    PG8_STAGE(PG8_SB(0, 0), cB, voffB); PG8_STAGE(PG8_SB(0, 1), cB + hstepB, voffB); PG8_STAGE(PG8_SA(0, 0), cA, voffA); PG8_STAGE(PG8_SA(0, 1), cA + hstepA, voffA);
    if (wr == 1) PG8_BAR;
    PG8_WAIT_V(2); PG8_BAR;
    PG8_STAGE(PG8_SB(1, 0), cB + kstep, voffB); PG8_STAGE(PG8_SA(1, 0), cA + kstep, voffA); PG8_STAGE(PG8_SB(1, 1), cB + hstepB + kstep, voffB);
    PG8_WAIT_V(6); PG8_BAR;
    for (;;) {
        const bool has_next = S.next(ui + 1, nxt);
        const char* nA = has_next ? (const char*)g.A + (size_t)nxt.pa * tstepA : cA; const char* nB = has_next ? (const char*)g.Bt + (size_t)nxt.pb * tstepB : cB;
        for (int t = 0; t < nt; t += 2) {
            const bool last = (t == nt - 2);
            const char* a1 = cA + (size_t)(t + 1) * kstep;
            const char* a2 = last ? nA : cA + (size_t)(t + 2) * kstep; const char* b2 = last ? nB : cB + (size_t)(t + 2) * kstep;
            const char* a3 = a2 + kstep; const char* b3 = b2 + kstep;
            PG8_LDB(B0, 0, 0); PG8_LDB(B1, 0, 1); PG8_SCHED; PG8_LDA(At, 0, 0); PG8_STAGE(PG8_SA(1, 1), a1 + hstepA, voffA);
            PG8_WAIT_V(8); PG8_WAIT_L(0); PG8_BAR; PG8_MMA(0, 0, At, B0); PG8_MMA(0, 1, At, B1); PG8_BAR; PG8_SCHED;
            PG8_LDA(At, 0, 1); PG8_STAGE(PG8_SB(0, 0), b2, voffB); PG8_STAGE(PG8_SB(0, 1), b2 + hstepB, voffB); PG8_STAGE(PG8_SA(0, 0), a2, voffA);
            PG8_WAIT_V(8); PG8_WAIT_L(0); PG8_BAR; PG8_MMA(1, 0, At, B0); PG8_MMA(1, 1, At, B1); PG8_BAR; PG8_SCHED;
            PG8_LDB(B0, 1, 0); PG8_LDB(B1, 1, 1); PG8_SCHED; PG8_LDA(At, 1, 0); PG8_STAGE(PG8_SA(0, 1), a2 + hstepA, voffA);
            PG8_WAIT_V(8); PG8_WAIT_L(0); PG8_BAR; PG8_MMA(0, 0, At, B0); PG8_MMA(0, 1, At, B1); PG8_BAR; PG8_SCHED;
            PG8_LDA(At, 1, 1); PG8_STAGE(PG8_SB(1, 0), b3, voffB); PG8_STAGE(PG8_SB(1, 1), b3 + hstepB, voffB); PG8_STAGE(PG8_SA(1, 0), a3, voffA);
            PG8_WAIT_V(8); PG8_WAIT_L(0); PG8_BAR; PG8_MMA(1, 0, At, B0); PG8_MMA(1, 1, At, B1); PG8_BAR; PG8_SCHED;
        }
        if constexpr (ALIGN_EPI) { if (wr == 0) PG8_BAR; }
        E(acc, cur, wr, wc, fr, fq);
        if (!has_next) break;
#pragma unroll
        for (int a = 0; a < 2; ++a)
#pragma unroll
            for (int b = 0; b < 2; ++b)
#pragma unroll
                for (int m = 0; m < 4; ++m)
#pragma unroll
                    for (int n = 0; n < 2; ++n) acc[a][b][m][n] = (f32x4){0.f, 0.f, 0.f, 0.f};
        cur = nxt; cA = nA; cB = nB; ++ui;
        if constexpr (ALIGN_EPI) { if (wr == 1) PG8_BAR; }
    }
    PG8_WAIT_V(0);
    if constexpr (!ALIGN_EPI) { if (wr == 0) PG8_BAR; }
    PG8_BAR;
#undef PG8_SA
#undef PG8_SB
#undef PG8_STAGE
#undef PG8_LDA
#undef PG8_LDB
#undef PG8_MMA
#undef PG8_WAIT_V
#undef PG8_WAIT_L
#undef PG8_BAR
#undef PG8_SCHED
}
}

constexpr int NB = 4, SEQ = 4096, NTOK = NB * SEQ, DM = 1024;
constexpr int NWAVES = 8, NTHR = 512;
constexpr int D_SSM = 512, NGRP = 32, NSTATE = 64, CH = 32  , NCH = SEQ / CH  , UGX_LD = 640, S5_ROWS = NB * NCH  ;
constexpr int NIN_PAD = 4608;
constexpr int NEXP = 32, TOPK_E = 4, DFF = 1024;
constexpr int NSEL = 256;
constexpr int MAX_MT = 288;
constexpr float RMS_EPS = 1e-5f;

constexpr size_t MiB = 1u << 20;
constexpr size_t WS_CTL = 0, CTL_ZERO_BYTES = 1 * MiB;
constexpr size_t WS_ROPE = 1 * MiB;
constexpr size_t WS_WIN = 2 * MiB;
constexpr size_t WS_WGLU = 11 * MiB;
constexpr size_t WS_WPS = 12 * MiB;
constexpr size_t WS_WPA = 13 * MiB;
constexpr size_t WS_WOUT = 14 * MiB;
constexpr size_t WS_MT = 16 * MiB;
constexpr size_t WS_WS = 36 * MiB;
constexpr size_t WS_A32 = 44 * MiB;
constexpr size_t WS_SBUF = 45 * MiB;
constexpr size_t WS_WI = 53 * MiB;
constexpr size_t WS_KI = 54 * MiB;
constexpr size_t WS_K = 56 * MiB;
constexpr size_t WS_V = 60 * MiB;
constexpr size_t WS_UGX = 64 * MiB;
constexpr size_t WS_Q = 84 * MiB;
constexpr size_t WS_QI = 100 * MiB;
constexpr size_t WS_GS = 132 * MiB;
constexpr size_t WS_GA = 164 * MiB;
constexpr size_t WS_XN = 196 * MiB;
constexpr size_t WS_YG = 228 * MiB;
constexpr size_t WS_YSSM = 244 * MiB;
constexpr size_t WS_YATT = 260 * MiB;
constexpr size_t WS_SEL = 276 * MiB;
constexpr size_t WS_MIXED = 284 * MiB;
constexpr size_t WS_X1 = 316 * MiB;
constexpr size_t WS_H2 = 380 * MiB;
constexpr size_t WS_TOPE = 412 * MiB;
constexpr size_t WS_TOPW = WS_TOPE + 256 * 1024;
constexpr size_t WS_TOPPOS = WS_TOPW + 256 * 1024;
constexpr size_t WS_ROWMAP = 413 * MiB;
constexpr size_t WS_WMI = 416 * MiB;
constexpr size_t WS_WMO = 544 * MiB;
constexpr size_t WS_ACT = 608 * MiB;
constexpr size_t WS_XP = 64 * MiB;
constexpr size_t WS_Y2 = 64 * MiB;
constexpr size_t WS_END = 752 * MiB;
static_assert(WS_XP + (size_t)MAX_MT * 256 * 1024 * 2 <= WS_YG, "XP overlay");
constexpr int CW_TMO = 0, CW_CODE = 1;
constexpr int CW_BAR = 4096;
constexpr int CW_ECNT = 16384;

constexpr int LDS_BYTES = 163840;
constexpr int MISC_OFF = 163840 - 2048;

#define GAS __attribute__((address_space(1)))
#define LAS __attribute__((address_space(3)))
typedef unsigned short bf16;
typedef unsigned short u16;
typedef unsigned v4u __attribute__((ext_vector_type(4)));
typedef unsigned v2u __attribute__((ext_vector_type(2)));
typedef float f32x4 __attribute__((ext_vector_type(4)));
typedef float f32x16 __attribute__((ext_vector_type(16)));
typedef short bf16x8 __attribute__((ext_vector_type(8)));
typedef GAS unsigned gu32;
#define RLX_AGENT __ATOMIC_RELAXED, __HIP_MEMORY_SCOPE_AGENT
#define LDS_WAIT() asm volatile("s_waitcnt lgkmcnt(0)" ::: "memory")
#define VM_WAIT() asm volatile("s_waitcnt vmcnt(0)" ::: "memory")
__device__ __forceinline__ unsigned f2bf(float f) { unsigned u = __builtin_bit_cast(unsigned, f); return (u + 0x7fffu + ((u >> 16) & 1u)) >> 16; }
__device__ __forceinline__ unsigned pk2(float lo, float hi) { return f2bf(lo) | (f2bf(hi) << 16); }
__device__ __forceinline__ float bf2f(unsigned b) { return __builtin_bit_cast(float, b << 16); }
__device__ __forceinline__ float bflo(unsigned w) { return __builtin_bit_cast(float, w << 16); }
__device__ __forceinline__ float bfhi(unsigned w) { return __builtin_bit_cast(float, w & 0xffff0000u); }
__device__ __forceinline__ float sigmoidf_(float x) { return 1.0f / (1.0f + __expf(-x)); }
__device__ __forceinline__ float gelu_tanh(float x) { const float u = 0.7978845608028654f * (x + 0.044715f * x * x * x); const float e = __expf(2.0f * u); const float t = 1.0f - 2.0f / (e + 1.0f); return 0.5f * x * (1.0f + t); }

#define XB_TMO      128
#define XB_XCNT(j)  (256  + 64 * (j))
#define XB_XSUB(j)  (1280 + 64 * (j))
#define XB_XGEN(j)  (2304 + 64 * (j))
#define XB_TOP      3328
#define XB_TOPGEN   3392
#define XCD_BAR_WORDS 3456
#define XB_SPIN_CAP (1u << 18)
__device__ __forceinline__ unsigned xb_ld(unsigned* p)              { return __hip_atomic_load(p, __ATOMIC_RELAXED, __HIP_MEMORY_SCOPE_AGENT); }
__device__ __forceinline__ unsigned xb_add(unsigned* p, unsigned v) { return __hip_atomic_fetch_add(p, v, __ATOMIC_RELAXED, __HIP_MEMORY_SCOPE_AGENT); }
__device__ __forceinline__ unsigned xb_xcc_id() { return (unsigned)__builtin_amdgcn_s_getreg((3 << 11) | 20) & 0xFu; }
#define XB_SPIN(cond, bar) do { unsigned _sp = 0; while (cond) { __builtin_amdgcn_s_sleep(1); \
    if ((++_sp & 255u) == 0u) { if (xb_ld(&(bar)[XB_TMO])) break; if (_sp > XB_SPIN_CAP) { atomicAdd(&(bar)[XB_TMO], 1u); break; } } } } while (0)
struct XcdBarrier { unsigned* bar; unsigned x; volatile LAS unsigned* st; };
__device__ __forceinline__ XcdBarrier xcd_barrier_post(unsigned* bar, volatile LAS unsigned* st) {
    XcdBarrier b; b.bar = bar; b.x = xb_xcc_id(); b.st = st;
    if (threadIdx.x == 0) (void)xb_add(&bar[XB_XCNT(b.x)], 1u);
    return b;
}
__device__ __forceinline__ void xcd_barrier_complete(unsigned* bar, unsigned x, unsigned& nloc, unsigned& nx) {
    const unsigned G = gridDim.x * gridDim.y * gridDim.z;
    unsigned sum, cnt, mine, sp = 0u;
    for (;;) {
        sum = 0u; cnt = 0u; mine = 0u;
#pragma unroll
        for (unsigned j = 0; j < 16; ++j) { const unsigned c = xb_ld(&bar[XB_XCNT(j)]); sum += c; cnt += (c > 0u) ? 1u : 0u; mine = (j == x) ? c : mine; }
        if (sum == G) break;
        __builtin_amdgcn_s_sleep(1);
        if ((++sp & 255u) == 0u) { if (xb_ld(&bar[XB_TMO])) break; if (sp > XB_SPIN_CAP) { atomicAdd(&bar[XB_TMO], 1u); break; } }
    }
    nloc = mine > 0u ? mine : 1u; nx = cnt > 0u ? cnt : 1u;
}
__device__ __forceinline__ void xcd_barrier(const XcdBarrier& b) {
    asm volatile("s_waitcnt vmcnt(0)" ::: "memory");
    __syncthreads();
    if (threadIdx.x == 0) {
        unsigned* bar = b.bar;
        __builtin_amdgcn_s_waitcnt(0);
        unsigned nloc = b.st[0], nx = b.st[1];
        if (nloc == 0u) { xcd_barrier_complete(bar, b.x, nloc, nx); b.st[0] = nloc; b.st[1] = nx; }
        const unsigned old = xb_add(&bar[XB_XSUB(b.x)], 1u);
        const unsigned gen = old / nloc;
        if (old + 1u == (gen + 1u) * nloc) {
            __builtin_amdgcn_fence(__ATOMIC_RELEASE, "agent");
            asm volatile("s_waitcnt vmcnt(0)" ::: "memory");
            const unsigned og = xb_add(&bar[XB_TOP], 1u);
            const unsigned tg = og / nx;
            if (og + 1u == (tg + 1u) * nx) xb_add(&bar[XB_TOPGEN], 1u);
            else XB_SPIN(xb_ld(&bar[XB_TOPGEN]) == tg, bar);
            __builtin_amdgcn_fence(__ATOMIC_ACQUIRE, "agent");
            xb_add(&bar[XB_XGEN(b.x)], 1u);
            asm volatile("s_waitcnt vmcnt(0)" ::: "memory");
        } else {
            XB_SPIN(xb_ld(&bar[XB_XGEN(b.x)]) == gen, bar);
            __builtin_amdgcn_fence(__ATOMIC_ACQUIRE, "agent");
            asm volatile("s_waitcnt vmcnt(0)" ::: "memory");
        }
    }
    __syncthreads();
}

struct Frame {
    LAS unsigned char* lds;
    volatile LAS unsigned* MISC;
    gu32* ctl;
    int tid, lane, wave, G;
    unsigned char* ws;
    const float* in[25];
    float* out;
};
enum { I_X = 0, I_N1G, I_WIN, I_BGATE, I_LRE, I_LIM, I_LOGDT, I_BRE, I_BIM, I_CRE, I_CIM, I_SD, I_WGLU, I_BGLU, I_WPS, I_WPA, I_WOUT, I_N2G, I_WR, I_BR, I_WMI, I_BMI, I_WMO, I_BMO, I_NFG };

__device__ __forceinline__ float wave_sum(float v) {
#pragma unroll
    for (int o = 1; o < 64; o <<= 1) v += __shfl_xor(v, o);
    return v;
}

__device__ __forceinline__ int ropeperm(int p) { const int a = p >> 3, bb = p & 7; return bb < 4 ? 4 * a + bb : 32 + 4 * a + (bb - 4); }
__device__ __forceinline__ int win_src(int nd) {
    const int pn = nd >> 8, j = nd & 255;
    if (pn < 2) return nd;
    if (pn < 4) { const int i = nd - 512; return 512 + (i & ~63) + ropeperm(i & 63); }
    if (pn == 4) { if (j < 128) return 1024 + (j & ~63) + ropeperm(j & 63); return 1152 + (j - 128); }
    if (pn < 9) { const int i = nd - 1280; return 1280 + (i & ~63) + ropeperm(i & 63); }
    if (pn == 9) { if (j < 64) return 2304 + ropeperm(j); if (j < 80) return 2368 + (j - 64); return -1; }
    if (pn < 14) return 2384 + (nd - 2560);
    return 3408 + (nd - 3584);
}
template <int MAP>
__device__ __forceinline__ void p0_transpose_item(const float* W, int K, int N, bf16* WT, int NdBlocks, LAS float* scr, int item, int lane) {
    const int kb = item / NdBlocks, nb = item % NdBlocks, k0 = 64 * kb, n0 = 32 * nb;
    int sc = n0 + (lane & 31);
    if (MAP == 1) sc = win_src(sc);
#pragma unroll 8
    for (int i = 0; i < 32; ++i) { const int kk = 2 * i + (lane >> 5); scr[kk * 33 + (lane & 31)] = (sc >= 0) ? W[(size_t)(k0 + kk) * N + sc] : 0.f; }
    LDS_WAIT(); asm volatile("" ::: "memory");
    const int c = lane & 7;
#pragma unroll
    for (int j = 0; j < 4; ++j) { const int n = (lane >> 3) + 8 * j; const LAS float* s = scr + (8 * c) * 33 + n;
        v4u o; o.x = pk2(s[0 * 33], s[1 * 33]); o.y = pk2(s[2 * 33], s[3 * 33]); o.z = pk2(s[4 * 33], s[5 * 33]); o.w = pk2(s[6 * 33], s[7 * 33]);
        *(GAS v4u*)(WT + (size_t)(n0 + n) * K + k0 + 8 * c) = o; }
    LDS_WAIT(); asm volatile("" ::: "memory");
}
__device__ __forceinline__ void rms_row_to_bf16(int lane, const float* xrow, const float* g, bf16* orow) {
    const GAS f32x4* xr = (const GAS f32x4*)xrow + lane; const GAS f32x4* gr = (const GAS f32x4*)g + lane;
    f32x4 v[4]; float s2 = 0.f;
#pragma unroll
    for (int j = 0; j < 4; ++j) { v[j] = xr[64 * j]; s2 += (v[j].x * v[j].x + v[j].y * v[j].y) + (v[j].z * v[j].z + v[j].w * v[j].w); }
    const float rstd = 1.0f / sqrtf(wave_sum(s2) * (1.f / DM) + RMS_EPS);
    GAS unsigned long long* o8 = (GAS unsigned long long*)orow + lane;
#pragma unroll
    for (int j = 0; j < 4; ++j) { const f32x4 gg = gr[64 * j];
        o8[64 * j] = (unsigned long long)pk2(v[j].x * rstd * gg.x, v[j].y * rstd * gg.y) | ((unsigned long long)pk2(v[j].z * rstd * gg.z, v[j].w * rstd * gg.w) << 32); }
}
__device__ __forceinline__ void p0_s5_group(Frame& F, int g) {
    LAS float* AP = (LAS float*)(F.lds);
    LAS float* BB = (LAS float*)(F.lds + 16896);
    LAS float* CC = (LAS float*)(F.lds + 25088);
    LAS float* KJ = (LAS float*)(F.lds + 33280);
    const float* lre = F.in[I_LRE] + g * 64; const float* lim = F.in[I_LIM] + g * 64;
    const double dt = exp((double)F.in[I_LOGDT][g]);
    __syncthreads();
    for (int idx = F.tid; idx < 33 * 64; idx += NTHR) { const int p = idx & 63, j = idx >> 6;
        const double lr = lre[p], li = lim[p]; const double mag = exp(j * lr * dt), ang = j * li * dt;
        AP[idx * 2] = (float)(mag * cos(ang)); AP[idx * 2 + 1] = (float)(mag * sin(ang)); }
    for (int idx = F.tid; idx < 1024; idx += NTHR) { const int p = idx >> 4;
        const double lr = lre[p], li = lim[p]; const double mag = exp(lr * dt), ang = li * dt; const double ar = mag * cos(ang), ai = mag * sin(ang);
        const double nr = ar - 1.0, ni = ai, den = lr * lr + li * li; const double zr = (nr * lr + ni * li) / den, zi = (ni * lr - nr * li) / den;
        const double br = F.in[I_BRE][g * 1024 + idx], bi = F.in[I_BIM][g * 1024 + idx];
        BB[idx * 2] = (float)(zr * br - zi * bi); BB[idx * 2 + 1] = (float)(zr * bi + zi * br); }
    for (int idx = F.tid; idx < 1024; idx += NTHR) { CC[idx * 2] = F.in[I_CRE][g * 1024 + idx]; CC[idx * 2 + 1] = F.in[I_CIM][g * 1024 + idx]; }
    __syncthreads();
    for (int idx = F.tid; idx < 32 * 256; idx += NTHR) { const int j = idx >> 8, hp = (idx >> 4) & 15, h = idx & 15; float s = 0.f;
        for (int p = 0; p < 64; ++p) { const float cr = CC[(hp * 64 + p) * 2], ci = CC[(hp * 64 + p) * 2 + 1], ar = AP[(j * 64 + p) * 2], ai = AP[(j * 64 + p) * 2 + 1];
            const float er = cr * ar - ci * ai, ei = cr * ai + ci * ar; s += er * BB[(p * 16 + h) * 2] - ei * BB[(p * 16 + h) * 2 + 1]; }
        KJ[idx] = s; }
    __syncthreads();
    bf16* MT = (bf16*)(F.ws + WS_MT) + (size_t)g * 512 * 640;
    for (int ch = F.tid; ch < 512 * 80; ch += NTHR) { const int n = ch / 80, k0 = (ch % 80) * 8, tp = n >> 4, hp = n & 15; float v[8];
        if (k0 < 512) { const int sp = k0 >> 4, h0 = k0 & 15;
#pragma unroll
            for (int j = 0; j < 8; ++j) v[j] = (sp <= tp) ? KJ[((tp - sp) * 16 + hp) * 16 + h0 + j] : 0.f; }
        else { const bool im = k0 >= 576; const int p0 = k0 - (im ? 576 : 512);
#pragma unroll
            for (int j = 0; j < 8; ++j) { const int p = p0 + j; const float cr = CC[(hp * 64 + p) * 2], ci = CC[(hp * 64 + p) * 2 + 1], ar = AP[((tp + 1) * 64 + p) * 2], ai = AP[((tp + 1) * 64 + p) * 2 + 1];
                v[j] = im ? -(cr * ai + ci * ar) : (cr * ar - ci * ai); } }
        v4u o; o.x = pk2(v[0], v[1]); o.y = pk2(v[2], v[3]); o.z = pk2(v[4], v[5]); o.w = pk2(v[6], v[7]);
        *(GAS v4u*)(MT + (size_t)n * 640 + k0) = o; }
    bf16* WS = (bf16*)(F.ws + WS_WS) + (size_t)g * 256 * 512;
    for (int ch = F.tid; ch < 256 * 64; ch += NTHR) { const int n = ch >> 6, k0 = (ch & 63) * 8, sp = k0 >> 4, h0 = k0 & 15; float v[8];
#pragma unroll
        for (int j = 0; j < 8; ++j) { if (n < 128) { const int p = n & 63; const float ar = AP[((31 - sp) * 64 + p) * 2], ai = AP[((31 - sp) * 64 + p) * 2 + 1], br = BB[(p * 16 + h0 + j) * 2], bi = BB[(p * 16 + h0 + j) * 2 + 1];
                v[j] = (n < 64) ? (ar * br - ai * bi) : (ar * bi + ai * br); } else v[j] = 0.f; }
        v4u o; o.x = pk2(v[0], v[1]); o.y = pk2(v[2], v[3]); o.z = pk2(v[4], v[5]); o.w = pk2(v[6], v[7]);
        *(GAS v4u*)(WS + (size_t)n * 512 + k0) = o; }
    float* A32 = (float*)(F.ws + WS_A32) + g * 128;
    if (F.tid < 128) A32[F.tid] = AP[32 * 128 + F.tid];
    __syncthreads();
}
__device__ __forceinline__ void p0_prologue(Frame& F) {
    if ((int)blockIdx.x >= F.G - NGRP) p0_s5_group(F, (int)blockIdx.x - (F.G - NGRP));
    LAS float* scr = (LAS float*)(F.lds + F.wave * 16384);
    const int gw = blockIdx.x * NWAVES + F.wave, NGW = F.G * NWAVES;
    { float* cosT = (float*)(F.ws + WS_ROPE); float* sinT = cosT + SEQ * 32;
      for (int i = blockIdx.x * NTHR + F.tid; i < SEQ * 32; i += F.G * NTHR) { const int pos = i >> 5, k = i & 31;
          const double inv = pow(10000.0, -(double)k / 32.0); const double ang = (double)pos * (double)(float)inv;
          cosT[i] = (float)cos(ang); sinT[i] = (float)sin(ang); } }
    for (int m = gw; m < NTOK; m += NGW) rms_row_to_bf16(F.lane, F.in[I_X] + (size_t)m * DM, F.in[I_N1G], (bf16*)(F.ws + WS_XN) + (size_t)m * DM);
    constexpr int I_IN = 16 * (NIN_PAD / 32), I_GLU = 8 * 16, I_PS = 8 * 32, I_PA = 8 * 32, I_OUT = 16 * 32, I_MI1 = 16 * 64, I_MO1 = 16 * 32;
    constexpr int NITEMS = I_IN + I_GLU + I_PS + I_PA + I_OUT + NEXP * I_MI1 + NEXP * I_MO1;
    for (int it = gw; it < NITEMS; it += NGW) {
        int r = it;
        if (r < I_IN) { p0_transpose_item<1>(F.in[I_WIN], DM, 4432, (bf16*)(F.ws + WS_WIN), NIN_PAD / 32, scr, r, F.lane); continue; } r -= I_IN;
        if (r < I_GLU) { p0_transpose_item<0>(F.in[I_WGLU], 512, 512, (bf16*)(F.ws + WS_WGLU), 16, scr, r, F.lane); continue; } r -= I_GLU;
        if (r < I_PS) { p0_transpose_item<0>(F.in[I_WPS], 512, 1024, (bf16*)(F.ws + WS_WPS), 32, scr, r, F.lane); continue; } r -= I_PS;
        if (r < I_PA) { p0_transpose_item<0>(F.in[I_WPA], 512, 1024, (bf16*)(F.ws + WS_WPA), 32, scr, r, F.lane); continue; } r -= I_PA;
        if (r < I_OUT) { p0_transpose_item<0>(F.in[I_WOUT], 1024, 1024, (bf16*)(F.ws + WS_WOUT), 32, scr, r, F.lane); continue; } r -= I_OUT;
        if (r < NEXP * I_MI1) { const int e = r / I_MI1; p0_transpose_item<0>(F.in[I_WMI] + (size_t)e * 1024 * 2048, 1024, 2048, (bf16*)(F.ws + WS_WMI) + (size_t)e * 2048 * 1024, 64, scr, r % I_MI1, F.lane); continue; } r -= NEXP * I_MI1;
        { const int e = r / I_MO1; p0_transpose_item<0>(F.in[I_WMO] + (size_t)e * 1024 * 1024, 1024, 1024, (bf16*)(F.ws + WS_WMO) + (size_t)e * 1024 * 1024, 32, scr, r % I_MO1, F.lane); }
    }
}

struct StaticOrder {
    int nM, nN, nwg, G, c;
    __device__ void init(int nM_, int nN_, int G_, int c_) { nM = nM_; nN = nN_; nwg = nM * nN; G = G_; c = c_; }
    __device__ bool tile(int i, int& pm, int& pn) const {
        const long L = (long)i * G + c; if (L >= nwg) return false;
        int wgid = (int)L; { const int q = nwg / pg8::NXCD, r = nwg % pg8::NXCD, xcd = wgid % pg8::NXCD, off = wgid / pg8::NXCD; wgid = (xcd < r ? xcd * (q + 1) : r * (q + 1) + (xcd - r) * q) + off; }
        const int nig = pg8::WGM * nN, gid = wgid / nig, fm = gid * pg8::WGM, gsz = (nM - fm) < pg8::WGM ? (nM - fm) : pg8::WGM;
        pm = fm + ((wgid % nig) % gsz); pn = (wgid % nig) / gsz; return true;
    }
    __device__ bool next(int i, pg8::Unit& u) const { int pm, pn; if (!tile(i, pm, pn)) return false; u.pm = pm; u.pn = pn; u.pa = pm; u.pb = pn; u.e = 0; return true; }
};
struct S5StateOrder {
    int c;
    __device__ bool next(int i, pg8::Unit& u) const { if (i > 0 || c >= 64) return false; const int g = c >> 1, pm = c & 1; u.pm = pm; u.pn = 0; u.pa = g * 2 + pm; u.pb = g; u.e = g; return true; }
};
struct S5YOrder {
    int c;
    __device__ bool next(int i, pg8::Unit& u) const { if (i > 0 || c >= 128) return false; const int g = c >> 2, pm = (c >> 1) & 1, pn = c & 1; u.pm = pm; u.pn = pn; u.pa = g * 2 + pm; u.pb = g * 2 + pn; u.e = g; return true; }
};
struct MixOrder {
    StaticOrder so;
    __device__ bool next(int i, pg8::Unit& u) const { int pm, pn; if (!so.tile(i >> 1, pm, pn)) return false; const int h = i & 1; u.pm = pm; u.pn = pn; u.pa = pm + 64 * h; u.pb = pn + 4 * h; u.e = h; return true; }
};
struct MoeOrder {
    const volatile LAS int* te; int TT, NTN, c;
    __device__ bool next(int i, pg8::Unit& u) const {
        const int xcd = c & 7, j = c >> 3, mpx = 32 / NTN; const int mt = i * (8 * mpx) + xcd * mpx + j / NTN, pn = j % NTN;
        if (mt >= TT) return false; const int e = te[mt]; u.pm = mt; u.pn = pn; u.pa = mt; u.pb = e * NTN + pn; u.e = e; return true; }
};

using pg8::f32x2; using pg8::u32x2; using pg8::pack8; using pg8::cvt_pk_bf16;
#define EPI_ROWS_BEGIN _Pragma("unroll") for (int ai = 0; ai < 2; ++ai) _Pragma("unroll") for (int m = 0; m < 4; ++m) { const int row = u.pm * 256 + ai * 128 + wr * 64 + m * 16 + fr; (void)row;
#define EPI_COLS_BEGIN _Pragma("unroll") for (int bj = 0; bj < 2; ++bj) { const int ct = bj * 128 + wc * 32 + fq * 8; (void)ct; f32x4 v0 = acc[ai][bj][m][0], v1 = acc[ai][bj][m][1];
#define EPI_END } }
struct EpiInProj {
    static constexpr bool PERM = true;
    unsigned char* ws; const float* bgate;
    __device__ __forceinline__ void rope(f32x4& v0, f32x4& v1, int pos, int a, float sc) const {
        const float* cosT = (const float*)(ws + WS_ROPE); const float* sinT = cosT + SEQ * 32;
        const f32x4 c = *(const GAS f32x4*)(cosT + pos * 32 + 4 * a), s = *(const GAS f32x4*)(sinT + pos * 32 + 4 * a);
        const f32x4 o1 = (v0 * c - v1 * s) * sc, o2 = (v1 * c + v0 * s) * sc; v0 = o1; v1 = o2;
    }
    __device__ __forceinline__ void store_rope(bf16* dst, const f32x4& o1, const f32x4& o2) const {
        u32x2 a, b; a.x = cvt_pk_bf16(o1[0], o1[1]); a.y = cvt_pk_bf16(o1[2], o1[3]); b.x = cvt_pk_bf16(o2[0], o2[1]); b.y = cvt_pk_bf16(o2[2], o2[3]);
        *(GAS u32x2*)dst = a; *(GAS u32x2*)(dst + 32) = b;
    }
    __device__ __forceinline__ void operator()(const f32x4 (&acc)[2][2][4][2], const pg8::Unit& u, int wr, int wc, int fr, int fq) const {
        const int pn = u.pn;
        if (pn < 2) {
            bf16* UGX = (bf16*)(ws + WS_UGX);
            EPI_ROWS_BEGIN const int bb = row >> 12, cc = (row >> 5) & 127, sp = row & 31;
            EPI_COLS_BEGIN const int col = pn * 256 + ct, g = col >> 4, h0 = col & 15;
                *(GAS v4u*)(UGX + ((size_t)(g * 512 + bb * 128 + cc)) * UGX_LD + sp * 16 + h0) = pack8(v0, v1);
            EPI_END
        } else if (pn < 4) {
            bf16* Q = (bf16*)(ws + WS_Q);
            EPI_ROWS_BEGIN const int pos = row & 4095;
            EPI_COLS_BEGIN const int j = (pn - 2) * 256 + ct, head = j >> 6, a = (j & 63) >> 3;
                rope(v0, v1, pos, a, 0.125f); store_rope(Q + (size_t)row * 512 + head * 64 + 4 * a, v0, v1);
            EPI_END
        } else if (pn == 4) {
            bf16* Kb = (bf16*)(ws + WS_K); bf16* Vb = (bf16*)(ws + WS_V);
            EPI_ROWS_BEGIN const int pos = row & 4095;
            EPI_COLS_BEGIN
                if (bj == 0) { const int head = ct >> 6, a = (ct & 63) >> 3; rope(v0, v1, pos, a, 1.0f); store_rope(Kb + (size_t)row * 128 + head * 64 + 4 * a, v0, v1); }
                else *(GAS v4u*)(Vb + (size_t)row * 128 + (ct - 128)) = pack8(v0, v1);
            EPI_END
        } else if (pn < 9) {
            bf16* QI = (bf16*)(ws + WS_QI);
            EPI_ROWS_BEGIN const int pos = row & 4095;
            EPI_COLS_BEGIN const int j = (pn - 5) * 256 + ct, head = j >> 6, a = (j & 63) >> 3;
                rope(v0, v1, pos, a, 1.0f); store_rope(QI + (size_t)row * 1024 + head * 64 + 4 * a, v0, v1);
            EPI_END
        } else if (pn == 9) {
            bf16* KI = (bf16*)(ws + WS_KI); float* WI = (float*)(ws + WS_WI);
            EPI_ROWS_BEGIN const int pos = row & 4095;
            EPI_COLS_BEGIN
                if (bj == 0) { if (ct < 64) { const int a = ct >> 3; rope(v0, v1, pos, a, 1.0f); store_rope(KI + (size_t)row * 64 + 4 * a, v0, v1); }
                    else if (ct < 80) { float* d = WI + (size_t)row * 16 + (ct - 64); *(GAS f32x4*)d = v0 * 0.03125f; *(GAS f32x4*)(d + 4) = v1 * 0.03125f; } }
            EPI_END
        } else {
            const int br = pn >= 14; bf16* Gd = (bf16*)(ws + (br ? WS_GA : WS_GS)); const float* bgp = bgate + br * 1024;
            EPI_ROWS_BEGIN
            EPI_COLS_BEGIN const int col = (pn - (br ? 14 : 10)) * 256 + ct;
                const f32x4 b0 = *(const GAS f32x4*)(bgp + col), b1 = *(const GAS f32x4*)(bgp + col + 4);
#pragma unroll
                for (int j = 0; j < 4; ++j) { v0[j] = sigmoidf_(v0[j] + b0[j]); v1[j] = sigmoidf_(v1[j] + b1[j]); }
                *(GAS v4u*)(Gd + (size_t)row * 1024 + col) = pack8(v0, v1);
            EPI_END
        }
    }
};
struct EpiS5State {
    static constexpr bool PERM = true;
    float* SB;
    __device__ __forceinline__ void operator()(const f32x4 (&acc)[2][2][4][2], const pg8::Unit& u, int wr, int wc, int fr, int fq) const {
        EPI_ROWS_BEGIN
        EPI_COLS_BEGIN
            if (bj == 0) { float* d = SB + ((size_t)u.e * 512 + row) * 128 + ct; *(GAS f32x4*)d = v0; *(GAS f32x4*)(d + 4) = v1; }
        EPI_END
    }
};
struct EpiS5Y {
    static constexpr bool PERM = true;
    const bf16* UGX; const float* Dsk; bf16* YG;
    __device__ __forceinline__ void operator()(const f32x4 (&acc)[2][2][4][2], const pg8::Unit& u, int wr, int wc, int fr, int fq) const {
        const int g = u.e;
        EPI_ROWS_BEGIN const int bb = row >> 7, cc = row & 127;
        EPI_COLS_BEGIN const int n = u.pn * 256 + ct, tp = n >> 4, h0 = n & 15;
            const v4u uu = *(const GAS v4u*)(UGX + ((size_t)g * 512 + row) * UGX_LD + n);
            const f32x4 d0 = *(const GAS f32x4*)(Dsk + g * 16 + h0), d1 = *(const GAS f32x4*)(Dsk + g * 16 + h0 + 4);
            v0[0] += d0[0] * bflo(uu.x); v0[1] += d0[1] * bfhi(uu.x); v0[2] += d0[2] * bflo(uu.y); v0[3] += d0[3] * bfhi(uu.y);
            v1[0] += d1[0] * bflo(uu.z); v1[1] += d1[1] * bfhi(uu.z); v1[2] += d1[2] * bflo(uu.w); v1[3] += d1[3] * bfhi(uu.w);
#pragma unroll
            for (int j = 0; j < 4; ++j) { v0[j] = gelu_tanh(v0[j]); v1[j] = gelu_tanh(v1[j]); }
            const int tok = bb * 4096 + cc * 32 + tp;
            *(GAS v4u*)(YG + (size_t)tok * 512 + g * 16 + h0) = pack8(v0, v1);
        EPI_END
    }
};
struct EpiGlu {
    static constexpr bool PERM = true;
    const bf16* YG; const float* bglu; bf16* YS;
    __device__ __forceinline__ void operator()(const f32x4 (&acc)[2][2][4][2], const pg8::Unit& u, int wr, int wc, int fr, int fq) const {
        EPI_ROWS_BEGIN
        EPI_COLS_BEGIN const int col = u.pn * 256 + ct;
            const v4u yy = *(const GAS v4u*)(YG + (size_t)row * 512 + col);
            const f32x4 b0 = *(const GAS f32x4*)(bglu + col), b1 = *(const GAS f32x4*)(bglu + col + 4);
            v0[0] = bflo(yy.x) * sigmoidf_(v0[0] + b0[0]); v0[1] = bfhi(yy.x) * sigmoidf_(v0[1] + b0[1]); v0[2] = bflo(yy.y) * sigmoidf_(v0[2] + b0[2]); v0[3] = bfhi(yy.y) * sigmoidf_(v0[3] + b0[3]);
            v1[0] = bflo(yy.z) * sigmoidf_(v1[0] + b1[0]); v1[1] = bfhi(yy.z) * sigmoidf_(v1[1] + b1[1]); v1[2] = bflo(yy.w) * sigmoidf_(v1[2] + b1[2]); v1[3] = bfhi(yy.w) * sigmoidf_(v1[3] + b1[3]);
            *(GAS v4u*)(YS + (size_t)row * 512 + col) = pack8(v0, v1);
        EPI_END
    }
};
struct EpiMix {
    static constexpr bool PERM = true;
    const bf16* GS; const bf16* GA; bf16* MX;
    __device__ __forceinline__ void operator()(const f32x4 (&acc)[2][2][4][2], const pg8::Unit& u, int wr, int wc, int fr, int fq) const {
        const bf16* Gp = u.e ? GA : GS;
        EPI_ROWS_BEGIN
        EPI_COLS_BEGIN const size_t off = (size_t)row * 1024 + u.pn * 256 + ct;
            const v4u gg = *(const GAS v4u*)(Gp + off);
            v0[0] *= bflo(gg.x); v0[1] *= bfhi(gg.x); v0[2] *= bflo(gg.y); v0[3] *= bfhi(gg.y); v1[0] *= bflo(gg.z); v1[1] *= bfhi(gg.z); v1[2] *= bflo(gg.w); v1[3] *= bfhi(gg.w);
            if (u.e) { const v4u pp = *(const GAS v4u*)(MX + off);
                v0[0] += bflo(pp.x); v0[1] += bfhi(pp.x); v0[2] += bflo(pp.y); v0[3] += bfhi(pp.y); v1[0] += bflo(pp.z); v1[1] += bfhi(pp.z); v1[2] += bflo(pp.w); v1[3] += bfhi(pp.w); }
            *(GAS v4u*)(MX + off) = pack8(v0, v1);
        EPI_END
    }
};
struct EpiOut {
    static constexpr bool PERM = true;
    const float* X; float* X1;
    __device__ __forceinline__ void operator()(const f32x4 (&acc)[2][2][4][2], const pg8::Unit& u, int wr, int wc, int fr, int fq) const {
        EPI_ROWS_BEGIN
        EPI_COLS_BEGIN const size_t off = (size_t)row * 1024 + u.pn * 256 + ct;
            const f32x4 x0 = *(const GAS f32x4*)(X + off), x1 = *(const GAS f32x4*)(X + off + 4);
            *(GAS f32x4*)(X1 + off) = v0 + x0; *(GAS f32x4*)(X1 + off + 4) = v1 + x1;
        EPI_END
    }
};
struct EpiMoe1 {
    static constexpr bool PERM = true;
    const float* bmi; bf16* ACT;
    __device__ __forceinline__ void operator()(const f32x4 (&acc)[2][2][4][2], const pg8::Unit& u, int wr, int wc, int fr, int fq) const {
        const float* bp = bmi + (size_t)u.e * 2048;
        EPI_ROWS_BEGIN
        EPI_COLS_BEGIN const int col = u.pn * 256 + ct;
            const f32x4 b0 = *(const GAS f32x4*)(bp + col), b1 = *(const GAS f32x4*)(bp + col + 4);
            v0 += b0; v1 += b1; float o[4];
#pragma unroll
            for (int j = 0; j < 4; ++j) { const float zg0 = (j < 2) ? v0[2 * j] : v1[2 * j - 4], zl0 = (j < 2) ? v0[2 * j + 1] : v1[2 * j - 3];
                const float zg = fminf(zg0, 7.0f), zl = fminf(fmaxf(zl0, -7.0f), 7.0f); o[j] = zg * sigmoidf_(1.702f * zg) * (zl + 1.0f); }
            u32x2 w; w.x = cvt_pk_bf16(o[0], o[1]); w.y = cvt_pk_bf16(o[2], o[3]);
            *(GAS u32x2*)(ACT + (size_t)row * 1024 + (col >> 1)) = w;
        EPI_END
    }
};
struct EpiMoe2 {
    static constexpr bool PERM = true;
    const float* bmo; bf16* Y2;
    __device__ __forceinline__ void operator()(const f32x4 (&acc)[2][2][4][2], const pg8::Unit& u, int wr, int wc, int fr, int fq) const {
        const float* bp = bmo + (size_t)u.e * 1024;
        EPI_ROWS_BEGIN
        EPI_COLS_BEGIN const int col = u.pn * 256 + ct;
            const f32x4 b0 = *(const GAS f32x4*)(bp + col), b1 = *(const GAS f32x4*)(bp + col + 4);
            v0 += b0; v1 += b1;
            *(GAS v4u*)(Y2 + (size_t)row * 1024 + col) = pack8(v0, v1);
        EPI_END
    }
};

__device__ __forceinline__ unsigned f16key(unsigned bits) { return (bits & 0x8000u) ? (bits ^ 0xffffu) : (bits | 0x8000u); }
__device__ __forceinline__ void idx_phase(Frame& F) {
    LAS unsigned char* lds = F.lds;
    LAS u16* SC = (LAS u16*)lds;
    LAS unsigned char* KT = lds + 131072;
    LAS unsigned* H1 = (LAS unsigned*)(lds + 131072);
    LAS unsigned char* OLB = lds + 131072 + 16384;
    LAS unsigned* CN = (LAS unsigned*)(lds + MISC_OFF + 256);
    const bf16* QI = (const bf16*)(F.ws + WS_QI); const bf16* KI = (const bf16*)(F.ws + WS_KI); const float* WI = (const float*)(F.ws + WS_WI);
    u16* SEL = (u16*)(F.ws + WS_SEL);
    const int tid = F.tid, lane = F.lane, wave = F.wave, hh = lane >> 5;
    for (int r = 0; r < 4; ++r) {
        const int b = r, tile = (r & 1) ? 255 - (int)blockIdx.x : (int)blockIdx.x, t0 = tile * 16;
        __syncthreads();
        const int ql = tid >> 5, jj = tid & 31, t = t0 + ql; const size_t tok = (size_t)b * SEQ + t;
        if (tile < 16) {
#pragma unroll
            for (int i = 0; i < 8; ++i) { const int k = jj * 8 + i; SEL[tok * NSEL + k] = (u16)(k <= t ? k : 0); }
            continue;
        }
        bf16x8 qa[4]; float w[16];
        { const int rho = lane & 31, qq = (rho >> 2) & 1, head = (rho & 3) + 4 * (rho >> 3);
          const bf16* qp = QI + ((size_t)b * SEQ + t0 + 2 * wave + qq) * 1024 + head * 64 + 8 * hh;
#pragma unroll
          for (int ks = 0; ks < 4; ++ks) qa[ks] = *(const GAS bf16x8*)(qp + ks * 16);
          const float* wp = WI + ((size_t)b * SEQ + t0 + 2 * wave + hh) * 16;
#pragma unroll
          for (int i = 0; i < 4; ++i) { const f32x4 x = *(const GAS f32x4*)(wp + 4 * i); w[4 * i] = x[0]; w[4 * i + 1] = x[1]; w[4 * i + 2] = x[2]; w[4 * i + 3] = x[3]; } }
        const int nkt = (t0 + 15) / 64 + 1;
        const int srow = tid >> 3, sch = tid & 7; const int sdst = srow * 128 + ((sch ^ ((srow >> 1) & 7)) << 4);
        const bf16* kbase = KI + (size_t)b * SEQ * 64 + srow * 64 + sch * 8;
        { const v4u x = *(const GAS v4u*)(kbase); *(LAS v4u*)(KT + sdst) = x; }
        for (int kt = 0; kt < nkt; ++kt) {
            __syncthreads();
            v4u pf = (v4u){0u, 0u, 0u, 0u};
            if (kt + 1 < nkt) pf = *(const GAS v4u*)(kbase + (size_t)(kt + 1) * 64 * 64);
            const LAS unsigned char* kb = KT + (kt & 1) * 8192;
#pragma unroll
            for (int sub = 0; sub < 2; ++sub) {
                const int key = sub * 32 + (lane & 31);
                f32x16 acc = {0.f, 0.f, 0.f, 0.f, 0.f, 0.f, 0.f, 0.f, 0.f, 0.f, 0.f, 0.f, 0.f, 0.f, 0.f, 0.f};
#pragma unroll
                for (int ks = 0; ks < 4; ++ks) { const bf16x8 bfr = *(const LAS bf16x8*)(kb + key * 128 + (((ks * 2 + hh) ^ ((key >> 1) & 7)) << 4));
                    acc = __builtin_amdgcn_mfma_f32_32x32x16_bf16(qa[ks], bfr, acc, 0, 0, 0); }
                float s = 0.f;
#pragma unroll
                for (int i = 0; i < 16; ++i) s += w[i] * fmaxf(acc[i], 0.f);
                const _Float16 hs = (_Float16)s;
                SC[(2 * wave + hh) * 4096 + kt * 64 + key] = __builtin_bit_cast(unsigned short, hs);
            }
            if (kt + 1 < nkt) *(LAS v4u*)(KT + ((kt + 1) & 1) * 8192 + sdst) = pf;
        }
        __syncthreads();
        for (int i = tid; i < 4096; i += NTHR) H1[i] = 0u;
        if (tid < 32) CN[tid] = 0u;
        __syncthreads();
        const int n = t + 1;
        const LAS u16* sc = SC + ql * 4096;
        for (int i = jj; i < n; i += 32) atomicAdd((unsigned*)&H1[ql * 256 + (f16key(sc[i]) >> 8)], 1u);
        LDS_WAIT(); __builtin_amdgcn_wave_barrier();
        unsigned b1, need1;
        { unsigned s8 = 0; unsigned hb[8];
#pragma unroll
          for (int i = 0; i < 8; ++i) { hb[i] = H1[ql * 256 + 255 - (jj * 8 + i)]; s8 += hb[i]; }
          unsigned pre = s8;
#pragma unroll
          for (int o = 1; o < 32; o <<= 1) { const unsigned x = __shfl_up(pre, o, 32); if (jj >= o) pre += x; }
          const unsigned long long bal = __ballot(pre >= 256u); const unsigned m32 = (unsigned)(bal >> (32 * hh)); const int js = __builtin_ctz(m32);
          unsigned above = pre - s8, bb1 = 0, nd1 = 0; bool found = false;
#pragma unroll
          for (int i = 0; i < 8; ++i) { if (!found) { if (above + hb[i] >= 256u) { bb1 = 255 - (jj * 8 + i); nd1 = 256u - above; found = true; } else above += hb[i]; } }
          b1 = __shfl(bb1, js + 32 * hh); need1 = __shfl(nd1, js + 32 * hh); }
#pragma unroll
        for (int i = 0; i < 8; ++i) H1[ql * 256 + jj * 8 + i] = 0u;
        LDS_WAIT(); __builtin_amdgcn_wave_barrier();
        for (int i = jj; i < n; i += 32) { const unsigned k = f16key(sc[i]); if ((k >> 8) == b1) atomicAdd((unsigned*)&H1[ql * 256 + (k & 255u)], 1u); }
        LDS_WAIT(); __builtin_amdgcn_wave_barrier();
        unsigned T, need2;
        { unsigned s8 = 0; unsigned hb[8];
#pragma unroll
          for (int i = 0; i < 8; ++i) { hb[i] = H1[ql * 256 + 255 - (jj * 8 + i)]; s8 += hb[i]; }
          unsigned pre = s8;
#pragma unroll
          for (int o = 1; o < 32; o <<= 1) { const unsigned x = __shfl_up(pre, o, 32); if (jj >= o) pre += x; }
          const unsigned long long bal = __ballot(pre >= need1); const unsigned m32 = (unsigned)(bal >> (32 * hh)); const int js = __builtin_ctz(m32);
          unsigned above = pre - s8, bb2 = 0, nd2 = 0; bool found = false;
#pragma unroll
          for (int i = 0; i < 8; ++i) { if (!found) { if (above + hb[i] >= need1) { bb2 = 255 - (jj * 8 + i); nd2 = need1 - above; found = true; } else above += hb[i]; } }
          const unsigned b2 = __shfl(bb2, js + 32 * hh); need2 = __shfl(nd2, js + 32 * hh); T = (b1 << 8) | b2; }
        LAS u16* OL = (LAS u16*)(OLB + ql * 512);
        for (int i = jj; i < n; i += 32) { const unsigned k = f16key(sc[i]); bool take = k > T;
            if (k == T) { const unsigned tp = atomicAdd((unsigned*)&CN[ql * 2 + 1], 1u); take = tp < need2; }
            if (take) { const unsigned pos = atomicAdd((unsigned*)&CN[ql * 2], 1u); if (pos < 256u) OL[pos] = (u16)i; } }
        LDS_WAIT(); __builtin_amdgcn_wave_barrier();
        { const v4u x = *(const LAS v4u*)(OL + jj * 8); *(GAS v4u*)(SEL + tok * NSEL + jj * 8) = x; }
    }
}

__device__ __forceinline__ void carry_phase(Frame& F) {
    const int gid = blockIdx.x * NTHR + F.tid; if (gid >= NGRP * NB * 64) return;
    const int p = gid & 63, b = (gid >> 6) & 3, g = gid >> 8;
    const float* A32 = (const float*)(F.ws + WS_A32) + g * 128; const float ar = A32[p * 2], ai = A32[p * 2 + 1];
    const float* SB = (const float*)(F.ws + WS_SBUF) + ((size_t)g * 512 + b * 128) * 128; bf16* UX = (bf16*)(F.ws + WS_UGX) + ((size_t)g * 512 + b * 128) * UGX_LD;
    float xr = 0.f, xi = 0.f;
    for (int c = 0; c < NCH; ++c) {
        UX[(size_t)c * UGX_LD + 512 + p] = (bf16)f2bf(xr); UX[(size_t)c * UGX_LD + 576 + p] = (bf16)f2bf(xi);
        const float sr = SB[c * 128 + p], si = SB[c * 128 + 64 + p];
        const float nr = ar * xr - ai * xi + sr, ni = ar * xi + ai * xr + si; xr = nr; xi = ni;
    }
}

template <int N> __device__ __forceinline__ void wait_vm() { asm volatile("s_waitcnt vmcnt(%0)" :: "n"(N) : "memory"); }
typedef short s16x4 __attribute__((ext_vector_type(4)));
__device__ __forceinline__ void attn_phase(Frame& F) {
    constexpr int WSTR = 20224;
    LAS unsigned char* RING = F.lds + F.wave * WSTR;
    LAS u16* SL = (LAS u16*)(RING + 16384);
    const bf16* Q = (const bf16*)(F.ws + WS_Q); const bf16* Kg = (const bf16*)(F.ws + WS_K); const bf16* Vg = (const bf16*)(F.ws + WS_V);
    const u16* SEL = (const u16*)(F.ws + WS_SEL); bf16* YA = (bf16*)(F.ws + WS_YATT);
    const int lane = F.lane, gw = blockIdx.x * NWAVES + F.wave, NGW = F.G * NWAVES;
    const int hd = lane & 15, kg = lane >> 4;
    const int l8 = lane >> 3, cpos = lane & 7;
    unsigned tra[8];
    { const int q4 = hd >> 2, p4 = hd & 3; const unsigned rb = (unsigned)(unsigned long)RING;
#pragma unroll
      for (int mt = 0; mt < 4; ++mt)
#pragma unroll
          for (int tl = 0; tl < 2; ++tl) { const int row = tl * 16 + kg * 4 + q4, cc = 2 * mt + (p4 >> 1), pos = cc ^ (2 * ((row >> 1) & 3)); tra[2 * mt + tl] = rb + row * 128 + pos * 16 + (p4 & 1) * 8; } }
    for (int it = gw; it < NTOK * 2; it += NGW) {
        const int tok = it >> 1, kvh = it & 1, t = tok & 4095; const size_t bbase = (size_t)(tok >> 12) * SEQ;
        const int nsel = (t + 1 < NSEL) ? t + 1 : NSEL;
        { const v2u x = *(const GAS v2u*)(SEL + (size_t)tok * NSEL + lane * 4); *(LAS v2u*)(SL + lane * 4) = x; }
        bf16x8 qf[2];
#pragma unroll
        for (int ks = 0; ks < 2; ++ks) { if (hd < 4) qf[ks] = *(const GAS bf16x8*)(Q + (size_t)tok * 512 + (kvh * 4 + hd) * 64 + ks * 32 + kg * 8); else qf[ks] = (bf16x8){0, 0, 0, 0, 0, 0, 0, 0}; }
        asm volatile("s_waitcnt vmcnt(0)" : "+v"(qf[0]), "+v"(qf[1]) :: "memory");
        LDS_WAIT(); __builtin_amdgcn_wave_barrier();
        const bf16* kbp = Kg + bbase * 128 + kvh * 64; const bf16* vbp = Vg + bbase * 128 + kvh * 64;
        f32x4 sc[8][2]; f32x4 oacc[4];
#pragma unroll
        for (int c = 0; c < 8; ++c) { sc[c][0] = (f32x4){0.f, 0.f, 0.f, 0.f}; sc[c][1] = (f32x4){0.f, 0.f, 0.f, 0.f}; }
#pragma unroll
        for (int m = 0; m < 4; ++m) oacc[m] = (f32x4){0.f, 0.f, 0.f, 0.f};
        float inv = 1.0f;
#define ATT_ISSUE(s) do { const int c_ = (s) & 7; const bool isk_ = (s) < 8; const bf16* gb_ = isk_ ? kbp : vbp; int sel_[4]; \
            _Pragma("unroll") for (int j_ = 0; j_ < 4; ++j_) { const int ki_ = c_ * 32 + j_ * 8 + l8; sel_[j_] = (int)SL[ki_ < nsel ? ki_ : 0]; } \
            _Pragma("unroll") for (int j_ = 0; j_ < 4; ++j_) { const int f_ = isk_ ? ((j_ & 1) * 4 + (lane >> 4)) : (2 * (lane >> 4)); \
                __builtin_amdgcn_global_load_lds((const unsigned*)(gb_ + (size_t)sel_[j_] * 128 + ((cpos ^ f_) << 3)), (LAS unsigned*)(RING + ((s) & 3) * 4096 + j_ * 1024), 16, 0, 0); } } while (0)
        ATT_ISSUE(0); ATT_ISSUE(1); ATT_ISSUE(2);
#pragma unroll
        for (int s = 0; s < 16; ++s) {
            if (s + 3 < 16) ATT_ISSUE(s + 3);
            if (s <= 12) wait_vm<12>(); else if (s == 13) wait_vm<8>(); else if (s == 14) wait_vm<4>(); else wait_vm<0>();
            const LAS unsigned char* buf = RING + (s & 3) * 4096;
            if (s < 8) {
#pragma unroll
                for (int tl = 0; tl < 2; ++tl)
#pragma unroll
                    for (int ks = 0; ks < 2; ++ks) { const bf16x8 af = *(const LAS bf16x8*)(buf + (tl * 16 + hd) * 128 + (((ks * 4 + kg) ^ (hd >> 1)) << 4));
                        sc[s][tl] = __builtin_amdgcn_mfma_f32_16x16x32_bf16(af, qf[ks], sc[s][tl], 0, 0, 0); }
                if (s == 7) {
                    float mx = -3.0e38f;
#pragma unroll
                    for (int c = 0; c < 8; ++c)
#pragma unroll
                        for (int tl = 0; tl < 2; ++tl)
#pragma unroll
                            for (int r = 0; r < 4; ++r) { const int key = c * 32 + tl * 16 + kg * 4 + r; const float v = (key < nsel) ? sc[c][tl][r] : -3.0e38f; sc[c][tl][r] = v; mx = fmaxf(mx, v); }
                    mx = fmaxf(mx, __shfl_xor(mx, 16)); mx = fmaxf(mx, __shfl_xor(mx, 32));
                    float sum = 0.f;
#pragma unroll
                    for (int c = 0; c < 8; ++c)
#pragma unroll
                        for (int tl = 0; tl < 2; ++tl)
#pragma unroll
                            for (int r = 0; r < 4; ++r) { const float e = __expf(sc[c][tl][r] - mx); sc[c][tl][r] = e; sum += e; }
                    sum += __shfl_xor(sum, 16); sum += __shfl_xor(sum, 32);
                    inv = 1.0f / sum;
                }
            } else {
                const int c = s - 8;
                v4u pw; pw.x = pg8::cvt_pk_bf16(sc[c][0][0], sc[c][0][1]); pw.y = pg8::cvt_pk_bf16(sc[c][0][2], sc[c][0][3]); pw.z = pg8::cvt_pk_bf16(sc[c][1][0], sc[c][1][1]); pw.w = pg8::cvt_pk_bf16(sc[c][1][2], sc[c][1][3]);
                const bf16x8 pf = __builtin_bit_cast(bf16x8, pw);
                v2u a[8];
                asm volatile("ds_read_b64_tr_b16 %0, %8 offset:%16\n\tds_read_b64_tr_b16 %1, %9 offset:%16\n\tds_read_b64_tr_b16 %2, %10 offset:%16\n\tds_read_b64_tr_b16 %3, %11 offset:%16\n\t"
                             "ds_read_b64_tr_b16 %4, %12 offset:%16\n\tds_read_b64_tr_b16 %5, %13 offset:%16\n\tds_read_b64_tr_b16 %6, %14 offset:%16\n\tds_read_b64_tr_b16 %7, %15 offset:%16\n\ts_waitcnt lgkmcnt(0)"
                             : "=&v"(a[0]), "=&v"(a[1]), "=&v"(a[2]), "=&v"(a[3]), "=&v"(a[4]), "=&v"(a[5]), "=&v"(a[6]), "=&v"(a[7])
                             : "v"(tra[0]), "v"(tra[1]), "v"(tra[2]), "v"(tra[3]), "v"(tra[4]), "v"(tra[5]), "v"(tra[6]), "v"(tra[7]), "n"((s & 3) * 4096) : "memory");
#pragma unroll
                for (int mt = 0; mt < 4; ++mt) {
                    v4u aw; aw.x = a[2 * mt].x; aw.y = a[2 * mt].y; aw.z = a[2 * mt + 1].x; aw.w = a[2 * mt + 1].y;
                    oacc[mt] = __builtin_amdgcn_mfma_f32_16x16x32_bf16(__builtin_bit_cast(bf16x8, aw), pf, oacc[mt], 0, 0, 0);
                }
            }
        }
#undef ATT_ISSUE
        if (hd < 4) {
            bf16* yo = YA + (size_t)tok * 512 + (kvh * 4 + hd) * 64 + kg * 4;
#pragma unroll
            for (int mt = 0; mt < 4; ++mt) { pg8::u32x2 w; w.x = pg8::cvt_pk_bf16(oacc[mt][0] * inv, oacc[mt][1] * inv); w.y = pg8::cvt_pk_bf16(oacc[mt][2] * inv, oacc[mt][3] * inv); *(GAS pg8::u32x2*)(yo + 16 * mt) = w; }
        }
        LDS_WAIT(); __builtin_amdgcn_wave_barrier();
    }
}

__device__ __forceinline__ void router_phase(Frame& F) {
    LAS float* HR = (LAS float*)(F.lds);
    LAS float* PT = (LAS float*)(F.lds + 65536);
    LAS int* LE = (LAS int*)(F.lds + 81920);
    LAS int* LP = (LAS int*)(F.lds + 82944);
    LAS unsigned* LC = (LAS unsigned*)(F.lds + 83968);
    const float* X1 = (const float*)(F.ws + WS_X1); bf16* H2 = (bf16*)(F.ws + WS_H2);
    const float* WR = F.in[I_WR]; const float* BR = F.in[I_BR]; const float* G2 = F.in[I_N2G];
    int* TOPE = (int*)(F.ws + WS_TOPE); float* TOPW = (float*)(F.ws + WS_TOPW); int* TOPPOS = (int*)(F.ws + WS_TOPPOS); int* ROWMAP = (int*)(F.ws + WS_ROWMAP);
    const int tid = F.tid, lane = F.lane, wave = F.wave, e = lane & 31, dh = lane >> 5;
    float wr[64];
#pragma unroll
    for (int i = 0; i < 64; ++i) wr[i] = WR[(size_t)(128 * wave + dh * 64 + i) * 32 + e];
    if (tid < 64) LC[tid] = 0u;
    const int tok0 = blockIdx.x * 64;
    for (int bt = 0; bt < 4; ++bt) {
        __syncthreads();
#pragma unroll
        for (int rr = 0; rr < 2; ++rr) { const int lr = 2 * wave + rr, tok = tok0 + bt * 16 + lr;
            const GAS f32x4* xr = (const GAS f32x4*)(X1 + (size_t)tok * DM) + lane; const GAS f32x4* gr = (const GAS f32x4*)G2 + lane;
            f32x4 v[4]; float s2 = 0.f;
#pragma unroll
            for (int j = 0; j < 4; ++j) { v[j] = xr[64 * j]; s2 += (v[j].x * v[j].x + v[j].y * v[j].y) + (v[j].z * v[j].z + v[j].w * v[j].w); }
            const float rstd = 1.0f / sqrtf(wave_sum(s2) * (1.f / DM) + RMS_EPS);
            GAS unsigned long long* o8 = (GAS unsigned long long*)(H2 + (size_t)tok * DM) + lane;
#pragma unroll
            for (int j = 0; j < 4; ++j) { const f32x4 gg = gr[64 * j]; const f32x4 h = v[j] * rstd * gg;
                *(LAS f32x4*)(HR + lr * 1024 + 256 * j + 4 * lane) = h;
                o8[64 * j] = (unsigned long long)pk2(h.x, h.y) | ((unsigned long long)pk2(h.z, h.w) << 32); } }
        __syncthreads();
#pragma unroll 2
        for (int lr = 0; lr < 16; ++lr) { const LAS float* hp = HR + lr * 1024 + 128 * wave + dh * 64; float s = 0.f;
#pragma unroll
            for (int i = 0; i < 16; ++i) { const f32x4 h = *(const LAS f32x4*)(hp + 4 * i); s += h[0] * wr[4 * i] + h[1] * wr[4 * i + 1] + h[2] * wr[4 * i + 2] + h[3] * wr[4 * i + 3]; }
            s += __shfl_xor(s, 32);
            if (dh == 0) PT[(lr * 8 + wave) * 32 + e] = s; }
        __syncthreads();
        { const int lr = 2 * wave + dh, tl = bt * 16 + lr, tok = tok0 + tl; float lg = BR[e];
#pragma unroll
          for (int w8 = 0; w8 < 8; ++w8) lg += PT[(lr * 8 + w8) * 32 + e];
          float cur = lg; float tv[4]; int te[4];
#pragma unroll
          for (int k = 0; k < 4; ++k) { float mv = cur; int mi = e;
#pragma unroll
              for (int o = 1; o < 32; o <<= 1) { const float ov = __shfl_xor(mv, o); const int oi = __shfl_xor(mi, o); if (ov > mv || (ov == mv && oi < mi)) { mv = ov; mi = oi; } }
              tv[k] = mv; te[k] = mi; if (e == mi) cur = -3.0e38f; }
          const float e1 = __expf(tv[1] - tv[0]), e2 = __expf(tv[2] - tv[0]), e3 = __expf(tv[3] - tv[0]); const float inv = 1.0f / (1.0f + e1 + e2 + e3);
          if (e < 4) { const int ex = (e == 0) ? te[0] : (e == 1) ? te[1] : (e == 2) ? te[2] : te[3]; const float wv = ((e == 0) ? 1.0f : (e == 1) ? e1 : (e == 2) ? e2 : e3) * inv;
              TOPE[(size_t)tok * 4 + e] = ex; TOPW[(size_t)tok * 4 + e] = wv; LE[tl * 4 + e] = ex; LP[tl * 4 + e] = (int)atomicAdd((unsigned*)&LC[ex], 1u); } }
    }
    __syncthreads();
    if (tid < 32) LC[32 + tid] = __hip_atomic_fetch_add((unsigned*)(F.ctl + CW_ECNT) + tid, LC[tid], RLX_AGENT);
    __syncthreads();
    if (tid < 256) { const int ex = LE[tid], pos = (int)LC[32 + ex] + LP[tid], tok = tok0 + (tid >> 2); TOPPOS[(size_t)tok * 4 + (tid & 3)] = pos; ROWMAP[(size_t)ex * NTOK + pos] = tok; }
}

__device__ __forceinline__ int moe_tables(Frame& F, LAS int* OFF, LAS int* TE) {
    __syncthreads();
    if (F.tid == 0) { int acc = 0; for (int e = 0; e < NEXP; ++e) { const int c = (int)__hip_atomic_load((unsigned*)(F.ctl + CW_ECNT) + e, RLX_AGENT); const int nt = (c + 255) >> 8; OFF[e] = acc * 256; for (int i = 0; i < nt; ++i) TE[acc + i] = e; acc += nt; } OFF[NEXP] = acc; }
    __syncthreads();
    return OFF[NEXP];
}
__device__ __forceinline__ void dispatch_phase(Frame& F) {
    LAS int* OFF = (LAS int*)(F.lds + MISC_OFF + 512); LAS int* TE = OFF + 40;
    (void)moe_tables(F, OFF, TE);
    const int* TOPE = (const int*)(F.ws + WS_TOPE); const int* TOPPOS = (const int*)(F.ws + WS_TOPPOS);
    const bf16* H2 = (const bf16*)(F.ws + WS_H2); bf16* XP = (bf16*)(F.ws + WS_XP);
    const int gw = blockIdx.x * NWAVES + F.wave, NGW = F.G * NWAVES;
    for (int pr = gw; pr < NTOK * 4; pr += NGW) { const int tok = pr >> 2; const int slot = OFF[TOPE[pr]] + TOPPOS[pr];
        const GAS v4u* s = (const GAS v4u*)(H2 + (size_t)tok * DM) + F.lane; GAS v4u* d = (GAS v4u*)(XP + (size_t)slot * DM) + F.lane;
        const v4u a = s[0], b = s[64]; d[0] = a; d[64] = b; }
}
__device__ __forceinline__ void combine_phase(Frame& F) {
    LAS int* OFF = (LAS int*)(F.lds + MISC_OFF + 512); LAS int* TE = OFF + 40;
    (void)moe_tables(F, OFF, TE);
    const int* TOPE = (const int*)(F.ws + WS_TOPE); const int* TOPPOS = (const int*)(F.ws + WS_TOPPOS); const float* TOPW = (const float*)(F.ws + WS_TOPW);
    const float* X1 = (const float*)(F.ws + WS_X1); const bf16* Y2 = (const bf16*)(F.ws + WS_Y2); const float* GF = F.in[I_NFG];
    const int gw = blockIdx.x * NWAVES + F.wave, NGW = F.G * NWAVES, lane = F.lane;
    for (int tok = gw; tok < NTOK; tok += NGW) {
        f32x4 v[4];
#pragma unroll
        for (int j = 0; j < 4; ++j) v[j] = ((const GAS f32x4*)(X1 + (size_t)tok * DM) + lane)[64 * j];
#pragma unroll
        for (int k = 0; k < 4; ++k) { const int slot = OFF[TOPE[tok * 4 + k]] + TOPPOS[tok * 4 + k]; const float wk = TOPW[tok * 4 + k];
            const GAS v2u* yr = (const GAS v2u*)(Y2 + (size_t)slot * DM) + lane;
#pragma unroll
            for (int j = 0; j < 4; ++j) { const v2u y = yr[64 * j]; v[j].x += wk * bflo(y.x); v[j].y += wk * bfhi(y.x); v[j].z += wk * bflo(y.y); v[j].w += wk * bfhi(y.y); } }
        float s2 = 0.f;
#pragma unroll
        for (int j = 0; j < 4; ++j) s2 += (v[j].x * v[j].x + v[j].y * v[j].y) + (v[j].z * v[j].z + v[j].w * v[j].w);
        const float rstd = 1.0f / sqrtf(wave_sum(s2) * (1.f / DM) + RMS_EPS);
#pragma unroll
        for (int j = 0; j < 4; ++j) { const f32x4 gg = ((const GAS f32x4*)GF + lane)[64 * j]; ((GAS f32x4*)(F.out + (size_t)tok * DM) + lane)[64 * j] = v[j] * rstd * gg; }
    }
}

constexpr int NPHASE = 13;
struct Args { const float* in[25]; float* out; unsigned char* ws; int ph_lo, ph_hi; };
__global__ void __launch_bounds__(NTHR, 2) fwd_kernel(Args args) {
    extern __shared__ __attribute__((aligned(16))) unsigned char lds[];
    Frame F;
    F.lds = (LAS unsigned char*)lds;
    F.MISC = (volatile LAS unsigned*)(F.lds + MISC_OFF);
    F.tid = threadIdx.x; F.lane = F.tid & 63; F.wave = __builtin_amdgcn_readfirstlane(F.tid >> 6); F.G = gridDim.x;
    F.ws = args.ws; F.ctl = (gu32*)(args.ws + WS_CTL); F.out = args.out;
#pragma unroll
    for (int i = 0; i < 25; ++i) F.in[i] = args.in[i];
    for (int u = F.tid; u < 2048 / 4; u += NTHR) ((LAS unsigned*)(F.lds + MISC_OFF))[u] = 0u;
    __syncthreads();
    XcdBarrier bar; bar.bar = (unsigned*)(F.ctl + CW_BAR); bar.x = 0; bar.st = nullptr;
    if (MK_N_LAUNCHES == 1) bar = xcd_barrier_post((unsigned*)(F.ctl + CW_BAR), F.MISC + 8);
    const int lo = args.ph_lo, hi = args.ph_hi;
#define IN(k) (lo <= (k) && (k) < hi)
#define SEAM(k) do { if (IN(k) && IN((k) + 1)) xcd_barrier(bar); } while (0)
    unsigned char* ws = F.ws; const int c = (int)blockIdx.x;

#define BODY_P0 { p0_prologue(F); }
#define BODY_P1 { pg8::Gemm g{(const bf16*)(ws + WS_XN), (const bf16*)(ws + WS_WIN), 1024, 1024, 1024}; StaticOrder S; S.init(NTOK / 256, NIN_PAD / 256, F.G, c); \
        EpiInProj E{ws, F.in[I_BGATE]}; pg8::gemm_phase<EpiInProj, StaticOrder>(F.lds, g, S, E); }
#define BODY_P2 { { pg8::Gemm g{(const bf16*)(ws + WS_UGX), (const bf16*)(ws + WS_WS), UGX_LD, 512, 512}; S5StateOrder S{c}; EpiS5State E{(float*)(ws + WS_SBUF)}; \
          pg8::gemm_phase<EpiS5State, S5StateOrder>(F.lds, g, S, E); } idx_phase(F); }
#define BODY_P3 { carry_phase(F); attn_phase(F); }
#define BODY_P4 { pg8::Gemm g{(const bf16*)(ws + WS_UGX), (const bf16*)(ws + WS_MT), UGX_LD, UGX_LD, 640}; S5YOrder S{c}; EpiS5Y E{(const bf16*)(ws + WS_UGX), F.in[I_SD], (bf16*)(ws + WS_YG)}; \
        pg8::gemm_phase<EpiS5Y, S5YOrder>(F.lds, g, S, E); }
#define BODY_P5 { pg8::Gemm g{(const bf16*)(ws + WS_YG), (const bf16*)(ws + WS_WGLU), 512, 512, 512}; StaticOrder S; S.init(NTOK / 256, 2, F.G, c); EpiGlu E{(const bf16*)(ws + WS_YG), F.in[I_BGLU], (bf16*)(ws + WS_YSSM)}; \
        pg8::gemm_phase<EpiGlu, StaticOrder>(F.lds, g, S, E); }
#define BODY_P6 { pg8::Gemm g{(const bf16*)(ws + WS_YSSM), (const bf16*)(ws + WS_WPS), 512, 512, 512}; MixOrder S; S.so.init(NTOK / 256, 4, F.G, c); \
        EpiMix E{(const bf16*)(ws + WS_GS), (const bf16*)(ws + WS_GA), (bf16*)(ws + WS_MIXED)}; pg8::gemm_phase<EpiMix, MixOrder>(F.lds, g, S, E); }
#define BODY_P7 { pg8::Gemm g{(const bf16*)(ws + WS_MIXED), (const bf16*)(ws + WS_WOUT), 1024, 1024, 1024}; StaticOrder S; S.init(NTOK / 256, 4, F.G, c); EpiOut E{F.in[I_X], (float*)(ws + WS_X1)}; \
        pg8::gemm_phase<EpiOut, StaticOrder>(F.lds, g, S, E); }
#define BODY_P8 { router_phase(F); }
#define BODY_P9 { dispatch_phase(F); }
#define BODY_P10 { LAS int* OFF = (LAS int*)(F.lds + MISC_OFF + 512); LAS int* TE = OFF + 40; const int TT = moe_tables(F, OFF, TE); \
        pg8::Gemm g{(const bf16*)(ws + WS_XP), (const bf16*)(ws + WS_WMI), 1024, 1024, 1024}; MoeOrder S{TE, TT, 8, c}; EpiMoe1 E{F.in[I_BMI], (bf16*)(ws + WS_ACT)}; \
        pg8::gemm_phase<EpiMoe1, MoeOrder>(F.lds, g, S, E); }
#define BODY_P11 { LAS int* OFF = (LAS int*)(F.lds + MISC_OFF + 512); LAS int* TE = OFF + 40; const int TT = moe_tables(F, OFF, TE); \
        pg8::Gemm g{(const bf16*)(ws + WS_ACT), (const bf16*)(ws + WS_WMO), 1024, 1024, 1024}; MoeOrder S{TE, TT, 4, c}; EpiMoe2 E{F.in[I_BMO], (bf16*)(ws + WS_Y2)}; \
        pg8::gemm_phase<EpiMoe2, MoeOrder>(F.lds, g, S, E); }
#define BODY_P12 { combine_phase(F); }
#define PHASE(k, BODY) if (IN(k)) { BODY if (PROBE_DUP == (k)) { xcd_barrier(bar); BODY } } SEAM(k);
    PHASE(0, BODY_P0) PHASE(1, BODY_P1) PHASE(2, BODY_P2) PHASE(3, BODY_P3) PHASE(4, BODY_P4) PHASE(5, BODY_P5) PHASE(6, BODY_P6)
    PHASE(7, BODY_P7) PHASE(8, BODY_P8) PHASE(9, BODY_P9) PHASE(10, BODY_P10) PHASE(11, BODY_P11) PHASE(12, BODY_P12)
#undef IN
#undef SEAM
}

extern "C" void kernel_launch(void* const* d_in, const int* in_sizes, int n_in, void* d_out, int out_size, void* d_ws, size_t ws_size, hipStream_t stream) {
    static int grid = 0;
    if (grid == 0) {
        if (n_in != 25 || out_size != NTOK * DM || ws_size < WS_END) { fprintf(stderr, "kernel_launch: unexpected problem (n_in %d out %d ws %zu)\n", n_in, out_size, ws_size); grid = -1; return; }
        if (hipFuncSetAttribute((const void*)fwd_kernel, hipFuncAttributeMaxDynamicSharedMemorySize, LDS_BYTES) != hipSuccess) { fprintf(stderr, "kernel_launch: hipFuncSetAttribute failed\n"); grid = -1; return; }
        int per_cu = 0; (void)hipOccupancyMaxActiveBlocksPerMultiprocessor(&per_cu, (const void*)fwd_kernel, NTHR, LDS_BYTES); (void)hipGetLastError();
        grid = 256;
    }
    if (grid < 0) return;
    (void)hipMemsetAsync((char*)d_ws + WS_CTL, 0, CTL_ZERO_BYTES, stream);
    Args a{};
    for (int i = 0; i < 25; ++i) a.in[i] = (const float*)d_in[i];
    a.out = (float*)d_out; a.ws = (unsigned char*)d_ws;
    if (MK_N_LAUNCHES == 1) { a.ph_lo = 0; a.ph_hi = NPHASE; hipLaunchKernelGGL(fwd_kernel, dim3(grid), dim3(NTHR), LDS_BYTES, stream, a); }
    else for (int p = 0; p < NPHASE; ++p) { a.ph_lo = p; a.ph_hi = p + 1; hipLaunchKernelGGL(fwd_kernel, dim3(grid), dim3(NTHR), LDS_BYTES, stream, a); }
}
```

```cpp
#include <hip/hip_runtime.h>
#include <cstdio>
#include <cstdint>

#ifndef MK_N_LAUNCHES
#define MK_N_LAUNCHES 1
#endif
#ifndef PROBE_DUP
#define PROBE_DUP -1
#endif

namespace pg8 {
#define PG8_LAS __attribute__((address_space(3)))
typedef unsigned short bf16_t;
typedef short bf16x8 __attribute__((ext_vector_type(8)));
typedef float f32x4 __attribute__((ext_vector_type(4)));
typedef float f32x2 __attribute__((ext_vector_type(2)));
typedef unsigned u32x4 __attribute__((ext_vector_type(4)));
typedef unsigned u32x2 __attribute__((ext_vector_type(2)));
constexpr int BM = 256, BK = 64, HALF = 128, HTB = HALF * BK * 2, STAGE_BYTES = 8 * HTB, NXCD = 8, WGM = 8;

__host__ __device__ __forceinline__ int lds_byte(int r, int c) { const int st = (r >> 4) * 2 + (c >> 5), rr = r & 15, cc = c & 31, ob = rr * 64 + cc * 2; return st * 1024 + (ob ^ (((ob >> 9) & 1) << 5)); }
__host__ __device__ __forceinline__ void stage_rc(int b, int& R, int& C) { const int st = b / 1024, sb = b % 1024, swz = sb ^ (((sb >> 9) & 1) << 5); R = (st >> 1) * 16 + swz / 64; C = (st & 1) * 32 + (swz % 64) / 2; }
__host__ __device__ __forceinline__ int perm32(int rho) { const int n = rho >> 4, i = rho & 15; return 8 * (i >> 2) + 4 * n + (i & 3); }

struct Unit { int pm, pn, pa, pb, e; };
struct Gemm { const bf16_t* A; const bf16_t* Bt; int lda, ldb, K; };

__device__ __forceinline__ unsigned cvt_pk_bf16(float lo, float hi) { unsigned r; asm volatile("v_cvt_pk_bf16_f32 %0, %1, %2" : "=v"(r) : "v"(lo), "v"(hi)); return r; }
__device__ __forceinline__ u32x4 pack8(const f32x4& v0, const f32x4& v1) { u32x4 w; w.x = cvt_pk_bf16(v0[0], v0[1]); w.y = cvt_pk_bf16(v0[2], v0[3]); w.z = cvt_pk_bf16(v1[0], v1[1]); w.w = cvt_pk_bf16(v1[2], v1[3]); return w; }

template <class Epi, class Sched, bool ALIGN_EPI = true>
__device__ __forceinline__ void gemm_phase(PG8_LAS unsigned char* lds, const Gemm g, const Sched& S, const Epi& E) {
    const int tid = threadIdx.x, wid = __builtin_amdgcn_readfirstlane(tid >> 6), lane = tid & 63, wr = wid >> 2, wc = wid & 3, fr = lane & 15, fq = lane >> 4;
    const int K = g.K, nt = K / BK;
    unsigned voffB[2];
#pragma unroll
    for (int i = 0; i < 2; ++i) { int R, C; stage_rc(tid * 16 + i * 8192, R, C); const int Rb = (R & ~31) + perm32(R & 31);
        voffB[i] = (unsigned)(Rb * g.ldb + C) * 2u; }
    const size_t kstep = (size_t)(BK * 2);
    const size_t hstepB = (size_t)HALF * g.ldb * 2;
    const size_t tstepB = 2 * hstepB;
#define PG8_AROWS(VV, U) do { _Pragma("unroll") for (int i_ = 0; i_ < 2; ++i_) { int R_, C_; stage_rc((threadIdx.x & 511) * 16 + i_ * 8192, R_, C_); \
        _Pragma("unroll") for (int h_ = 0; h_ < 2; ++h_) VV[h_][i_] = (unsigned)(S.arow(U, h_, R_) * g.lda + C_) * 2u; } } while (0)
    unsigned vA[2][2], vAn[2][2];
    const unsigned ldsw = (unsigned)wid * 1024u;
    const int aoff = lds_byte(wr * 64 + fr, fq * 8), boff = lds_byte(wc * 32 + fr, fq * 8);
#define PG8_SA(b, h) (((b) * 2 + (h)) * HTB)
#define PG8_SB(b, h) ((4 + (b) * 2 + (h)) * HTB)
#define PG8_STAGE(bufoff, gbase, voff) do { _Pragma("unroll") for (int _i = 0; _i < 2; ++_i) \
        __builtin_amdgcn_global_load_lds((const unsigned*)((const char*)(gbase) + (voff)[_i]), (PG8_LAS unsigned*)(lds + (bufoff) + ldsw + _i * 8192), 16, 0, 0); } while (0)
#define PG8_LDA(dst, b, h) do { _Pragma("unroll") for (int m = 0; m < 4; ++m) _Pragma("unroll") for (int k = 0; k < 2; ++k) dst[m][k] = *(const PG8_LAS bf16x8*)(lds + PG8_SA(b, h) + aoff + m * 2048 + k * 1024); } while (0)
#define PG8_LDB(dst, b, h) do { _Pragma("unroll") for (int n = 0; n < 2; ++n) _Pragma("unroll") for (int k = 0; k < 2; ++k) dst[n][k] = *(const PG8_LAS bf16x8*)(lds + PG8_SB(b, h) + boff + n * 2048 + k * 1024); } while (0)
#define PG8_MMA(ai, bj, At, Bt) do { __builtin_amdgcn_s_setprio(1); _Pragma("unroll") for (int m = 0; m < 4; ++m) _Pragma("unroll") for (int n = 0; n < 2; ++n) _Pragma("unroll") for (int k = 0; k < 2; ++k) \
        acc[ai][bj][m][n] = __builtin_amdgcn_mfma_f32_16x16x32_bf16(Bt[n][k], At[m][k], acc[ai][bj][m][n], 0, 0, 0); __builtin_amdgcn_s_setprio(0); } while (0)
#define PG8_WAIT_V(n) asm volatile("s_waitcnt vmcnt(" #n ")" ::: "memory")
#define PG8_WAIT_L(n) asm volatile("s_waitcnt lgkmcnt(" #n ")" ::: "memory")
#define PG8_BAR __builtin_amdgcn_s_barrier()
#define PG8_SCHED __builtin_amdgcn_sched_barrier(0)
    Unit cur, nxt; int ui = 0;
    if (!S.next(0, cur)) return;
    f32x4 acc[2][2][4][2];
#pragma unroll
    for (int a = 0; a < 2; ++a)
#pragma unroll
        for (int b = 0; b < 2; ++b)
#pragma unroll
            for (int m = 0; m < 4; ++m)
#pragma unroll
                for (int n = 0; n < 2; ++n) acc[a][b][m][n] = (f32x4){0.f, 0.f, 0.f, 0.f};
    bf16x8 At[4][2], B0[2][2], B1[2][2];
    const char* const bA = (const char*)g.A; const char* cB = (const char*)g.Bt + (size_t)cur.pb * tstepB;
    PG8_AROWS(vA, cur);
    PG8_STAGE(PG8_SB(0, 0), cB, voffB); PG8_STAGE(PG8_SB(0, 1), cB + hstepB, voffB); PG8_STAGE(PG8_SA(0, 0), bA, vA[0]); PG8_STAGE(PG8_SA(0, 1), bA, vA[1]);
    if (wr == 1) PG8_BAR;
    PG8_WAIT_V(2); PG8_BAR;
    PG8_STAGE(PG8_SB(1, 0), cB + kstep, voffB); PG8_STAGE(PG8_SA(1, 0), bA + kstep, vA[0]); PG8_STAGE(PG8_SB(1, 1), cB + hstepB + kstep, voffB);
    PG8_WAIT_V(6); PG8_BAR;
    for (;;) {
        const bool has_next = S.next(ui + 1, nxt);
        const char* nB = has_next ? (const char*)g.Bt + (size_t)nxt.pb * tstepB : cB;
        if (has_next) PG8_AROWS(vAn, nxt); else { vAn[0][0] = vA[0][0]; vAn[0][1] = vA[0][1]; vAn[1][0] = vA[1][0]; vAn[1][1] = vA[1][1]; }
        for (int t = 0; t < nt; t += 2) {
            const bool last = (t == nt - 2);
            const char* a1 = bA + (size_t)(t + 1) * kstep;
            const char* a2 = last ? bA : bA + (size_t)(t + 2) * kstep; const char* b2 = last ? nB : cB + (size_t)(t + 2) * kstep;
            const char* a3 = a2 + kstep; const char* b3 = b2 + kstep;
            unsigned w0[2], w1[2];
            w0[0] = last ? vAn[0][0] : vA[0][0]; w0[1] = last ? vAn[0][1] : vA[0][1]; w1[0] = last ? vAn[1][0] : vA[1][0]; w1[1] = last ? vAn[1][1] : vA[1][1];
            PG8_LDB(B0, 0, 0); PG8_LDB(B1, 0, 1); PG8_SCHED; PG8_LDA(At, 0, 0); PG8_STAGE(PG8_SA(1, 1), a1, vA[1]);
            PG8_WAIT_V(8); PG8_WAIT_L(0); PG8_BAR; PG8_MMA(0, 0, At, B0); PG8_MMA(0, 1, At, B1); PG8_BAR; PG8_SCHED;
            PG8_LDA(At, 0, 1); PG8_STAGE(PG8_SB(0, 0), b2, voffB); PG8_STAGE(PG8_SB(0, 1), b2 + hstepB, voffB); PG8_STAGE(PG8_SA(0, 0), a2, w0);
            PG8_WAIT_V(8); PG8_WAIT_L(0); PG8_BAR; PG8_MMA(1, 0, At, B0); PG8_MMA(1, 1, At, B1); PG8_BAR; PG8_SCHED;
            PG8_LDB(B0, 1, 0); PG8_LDB(B1, 1, 1); PG8_SCHED; PG8_LDA(At, 1, 0); PG8_STAGE(PG8_SA(0, 1), a2, w1);
            PG8_WAIT_V(8); PG8_WAIT_L(0); PG8_BAR; PG8_MMA(0, 0, At, B0); PG8_MMA(0, 1, At, B1); PG8_BAR; PG8_SCHED;
            PG8_LDA(At, 1, 1); PG8_STAGE(PG8_SB(1, 0), b3, voffB); PG8_STAGE(PG8_SB(1, 1), b3 + hstepB, voffB); PG8_STAGE(PG8_SA(1, 0), a3, w0);
            PG8_WAIT_V(8); PG8_WAIT_L(0); PG8_BAR; PG8_MMA(1, 0, At, B0); PG8_MMA(1, 1, At, B1); PG8_BAR; PG8_SCHED;
        }
        if constexpr (ALIGN_EPI) { if (wr == 0) PG8_BAR; }
        E(acc, cur, wr, wc, fr, fq);
        if (!has_next) break;
#pragma unroll
        for (int a = 0; a < 2; ++a)
#pragma unroll
            for (int b = 0; b < 2; ++b)
#pragma unroll
                for (int m = 0; m < 4; ++m)
#pragma unroll
                    for (int n = 0; n < 2; ++n) acc[a][b][m][n] = (f32x4){0.f, 0.f, 0.f, 0.f};
        cur = nxt; cB = nB; ++ui; vA[0][0] = vAn[0][0]; vA[0][1] = vAn[0][1]; vA[1][0] = vAn[1][0]; vA[1][1] = vAn[1][1];
        if constexpr (ALIGN_EPI) { if (wr == 1) PG8_BAR; }
    }
    PG8_WAIT_V(0);
    if constexpr (!ALIGN_EPI) { if (wr == 0) PG8_BAR; }
    PG8_BAR;
#undef PG8_AROWS
#undef PG8_SA
#undef PG8_SB
#undef PG8_STAGE
#undef PG8_LDA
#undef PG8_LDB
#undef PG8_MMA
#undef PG8_WAIT_V
#undef PG8_WAIT_L
#undef PG8_BAR
#undef PG8_SCHED
}
}

constexpr int NB = 4, SEQ = 4096, NTOK = NB * SEQ, DM = 1024;
constexpr int NWAVES = 8, NTHR = 512;
constexpr int D_SSM = 512, NGRP = 32, NSTATE = 64, CH = 32  , NCH = SEQ / CH  , UGX_LD = 640, S5_ROWS = NB * NCH  ;
constexpr int NIN_PAD = 4608;
constexpr int NEXP = 32, TOPK_E = 4, DFF = 1024;
constexpr int NSEL = 256;
constexpr int MAX_MT = 288;
constexpr float RMS_EPS = 1e-5f;

constexpr size_t MiB = 1u << 20;
constexpr size_t WS_CTL = 0, CTL_ZERO_BYTES = 1 * MiB;
constexpr size_t WS_ROPE = 1 * MiB;
constexpr size_t WS_WIN = 2 * MiB;
constexpr size_t WS_WGLU = 11 * MiB;
constexpr size_t WS_WPS = 12 * MiB;
constexpr size_t WS_WPA = 13 * MiB;
constexpr size_t WS_WOUT = 14 * MiB;
constexpr size_t WS_MT = 16 * MiB;
constexpr size_t WS_WS = 36 * MiB;
constexpr size_t WS_A32 = 44 * MiB;
constexpr size_t WS_SBUF = 45 * MiB;
constexpr size_t WS_WI = 53 * MiB;
constexpr size_t WS_KI = 54 * MiB;
constexpr size_t WS_K = 56 * MiB;
constexpr size_t WS_V = 60 * MiB;
constexpr size_t WS_UGX = 64 * MiB;
constexpr size_t WS_Q = 84 * MiB;
constexpr size_t WS_QI = 100 * MiB;
constexpr size_t WS_GS = 132 * MiB;
constexpr size_t WS_GA = 164 * MiB;
constexpr size_t WS_XN = 196 * MiB;
constexpr size_t WS_YG = 228 * MiB;
constexpr size_t WS_YSSM = 244 * MiB;
constexpr size_t WS_YATT = 260 * MiB;
constexpr size_t WS_SEL = 276 * MiB;
constexpr size_t WS_MIXED = 284 * MiB;
constexpr size_t WS_X1 = 316 * MiB;
constexpr size_t WS_H2 = 380 * MiB;
constexpr size_t WS_TOPE = 412 * MiB;
constexpr size_t WS_TOPW = WS_TOPE + 256 * 1024;
constexpr size_t WS_TOPPOS = WS_TOPW + 256 * 1024;
constexpr size_t WS_ROWMAP = 413 * MiB;
constexpr size_t WS_WMI = 416 * MiB;
constexpr size_t WS_WMO = 544 * MiB;
constexpr size_t WS_ACT = 608 * MiB;
constexpr size_t WS_XP = 64 * MiB;
constexpr size_t WS_Y2 = 64 * MiB;
constexpr size_t WS_END = 752 * MiB;
static_assert(WS_XP + (size_t)MAX_MT * 256 * 1024 * 2 <= WS_YG, "XP overlay");
constexpr int CW_TMO = 0, CW_CODE = 1;
constexpr int CW_BAR = 4096;
constexpr int CW_ECNT = 16384;

constexpr int LDS_BYTES = 163840;
constexpr int MISC_OFF = 163840 - 2048;

#define GAS __attribute__((address_space(1)))
#define LAS __attribute__((address_space(3)))
typedef unsigned short bf16;
typedef unsigned short u16;
typedef unsigned v4u __attribute__((ext_vector_type(4)));
typedef unsigned v2u __attribute__((ext_vector_type(2)));
typedef float f32x4 __attribute__((ext_vector_type(4)));
typedef float f32x16 __attribute__((ext_vector_type(16)));
typedef short bf16x8 __attribute__((ext_vector_type(8)));
typedef GAS unsigned gu32;
#define RLX_AGENT __ATOMIC_RELAXED, __HIP_MEMORY_SCOPE_AGENT
#define LDS_WAIT() asm volatile("s_waitcnt lgkmcnt(0)" ::: "memory")
#define VM_WAIT() asm volatile("s_waitcnt vmcnt(0)" ::: "memory")
__device__ __forceinline__ unsigned f2bf(float f) { unsigned u = __builtin_bit_cast(unsigned, f); return (u + 0x7fffu + ((u >> 16) & 1u)) >> 16; }
__device__ __forceinline__ unsigned pk2(float lo, float hi) { return f2bf(lo) | (f2bf(hi) << 16); }
__device__ __forceinline__ float bf2f(unsigned b) { return __builtin_bit_cast(float, b << 16); }
__device__ __forceinline__ float bflo(unsigned w) { return __builtin_bit_cast(float, w << 16); }
__device__ __forceinline__ float bfhi(unsigned w) { return __builtin_bit_cast(float, w & 0xffff0000u); }
__device__ __forceinline__ float sigmoidf_(float x) { return 1.0f / (1.0f + __expf(-x)); }
__device__ __forceinline__ float gelu_tanh(float x) { const float u = 0.7978845608028654f * (x + 0.044715f * x * x * x); const float e = __expf(2.0f * u); const float t = 1.0f - 2.0f / (e + 1.0f); return 0.5f * x * (1.0f + t); }

#define XB_TMO      128
#define XB_XCNT(j)  (256  + 64 * (j))
#define XB_XSUB(j)  (1280 + 64 * (j))
#define XB_XGEN(j)  (2304 + 64 * (j))
#define XB_TOP      3328
#define XB_TOPGEN   3392
#define XCD_BAR_WORDS 3456
#define XB_SPIN_CAP (1u << 18)
__device__ __forceinline__ unsigned xb_ld(unsigned* p)              { return __hip_atomic_load(p, __ATOMIC_RELAXED, __HIP_MEMORY_SCOPE_AGENT); }
__device__ __forceinline__ unsigned xb_add(unsigned* p, unsigned v) { return __hip_atomic_fetch_add(p, v, __ATOMIC_RELAXED, __HIP_MEMORY_SCOPE_AGENT); }
__device__ __forceinline__ unsigned xb_xcc_id() { return (unsigned)__builtin_amdgcn_s_getreg((3 << 11) | 20) & 0xFu; }
#define XB_SPIN(cond, bar) do { unsigned _sp = 0; while (cond) { __builtin_amdgcn_s_sleep(1); \
    if ((++_sp & 255u) == 0u) { if (xb_ld(&(bar)[XB_TMO])) break; if (_sp > XB_SPIN_CAP) { atomicAdd(&(bar)[XB_TMO], 1u); break; } } } } while (0)
struct XcdBarrier { unsigned* bar; unsigned x; volatile LAS unsigned* st; };
__device__ __forceinline__ XcdBarrier xcd_barrier_post(unsigned* bar, volatile LAS unsigned* st) {
    XcdBarrier b; b.bar = bar; b.x = xb_xcc_id(); b.st = st;
    if (threadIdx.x == 0) (void)xb_add(&bar[XB_XCNT(b.x)], 1u);
    return b;
}
__device__ __forceinline__ void xcd_barrier_complete(unsigned* bar, unsigned x, unsigned& nloc, unsigned& nx) {
    const unsigned G = gridDim.x * gridDim.y * gridDim.z;
    unsigned sum, cnt, mine, sp = 0u;
    for (;;) {
        sum = 0u; cnt = 0u; mine = 0u;
#pragma unroll
        for (unsigned j = 0; j < 16; ++j) { const unsigned c = xb_ld(&bar[XB_XCNT(j)]); sum += c; cnt += (c > 0u) ? 1u : 0u; mine = (j == x) ? c : mine; }
        if (sum == G) break;
        __builtin_amdgcn_s_sleep(1);
        if ((++sp & 255u) == 0u) { if (xb_ld(&bar[XB_TMO])) break; if (sp > XB_SPIN_CAP) { atomicAdd(&bar[XB_TMO], 1u); break; } }
    }
    nloc = mine > 0u ? mine : 1u; nx = cnt > 0u ? cnt : 1u;
}
__device__ __forceinline__ void xcd_barrier(const XcdBarrier& b) {
    asm volatile("s_waitcnt vmcnt(0)" ::: "memory");
    __syncthreads();
    if (threadIdx.x == 0) {
        unsigned* bar = b.bar;
        __builtin_amdgcn_s_waitcnt(0);
        unsigned nloc = b.st[0], nx = b.st[1];
        if (nloc == 0u) { xcd_barrier_complete(bar, b.x, nloc, nx); b.st[0] = nloc; b.st[1] = nx; }
        const unsigned old = xb_add(&bar[XB_XSUB(b.x)], 1u);
        const unsigned gen = old / nloc;
        if (old + 1u == (gen + 1u) * nloc) {
            __builtin_amdgcn_fence(__ATOMIC_RELEASE, "agent");
            asm volatile("s_waitcnt vmcnt(0)" ::: "memory");
            const unsigned og = xb_add(&bar[XB_TOP], 1u);
            const unsigned tg = og / nx;
            if (og + 1u == (tg + 1u) * nx) xb_add(&bar[XB_TOPGEN], 1u);
            else XB_SPIN(xb_ld(&bar[XB_TOPGEN]) == tg, bar);
            __builtin_amdgcn_fence(__ATOMIC_ACQUIRE, "agent");
            xb_add(&bar[XB_XGEN(b.x)], 1u);
            asm volatile("s_waitcnt vmcnt(0)" ::: "memory");
        } else {
            XB_SPIN(xb_ld(&bar[XB_XGEN(b.x)]) == gen, bar);
            __builtin_amdgcn_fence(__ATOMIC_ACQUIRE, "agent");
            asm volatile("s_waitcnt vmcnt(0)" ::: "memory");
        }
    }
    __syncthreads();
}

struct Frame {
    LAS unsigned char* lds;
    volatile LAS unsigned* MISC;
    gu32* ctl;
    int tid, lane, wave, G;
    unsigned char* ws;
    const float* in[25];
    float* out;
};
enum { I_X = 0, I_N1G, I_WIN, I_BGATE, I_LRE, I_LIM, I_LOGDT, I_BRE, I_BIM, I_CRE, I_CIM, I_SD, I_WGLU, I_BGLU, I_WPS, I_WPA, I_WOUT, I_N2G, I_WR, I_BR, I_WMI, I_BMI, I_WMO, I_BMO, I_NFG };

__device__ __forceinline__ float wave_sum(float v) {
#pragma unroll
    for (int o = 1; o < 64; o <<= 1) v += __shfl_xor(v, o);
    return v;
}

__device__ __forceinline__ int ropeperm(int p) { const int a = p >> 3, bb = p & 7; return bb < 4 ? 4 * a + bb : 32 + 4 * a + (bb - 4); }
__device__ __forceinline__ int win_src(int nd) {
    const int pn = nd >> 8, j = nd & 255;
    if (pn < 2) return nd;
    if (pn < 4) { const int i = nd - 512; return 512 + (i & ~63) + ropeperm(i & 63); }
    if (pn == 4) { if (j < 128) return 1024 + (j & ~63) + ropeperm(j & 63); return 1152 + (j - 128); }
    if (pn < 9) { const int i = nd - 1280; return 1280 + (i & ~63) + ropeperm(i & 63); }
    if (pn == 9) { if (j < 64) return 2304 + ropeperm(j); if (j < 80) return 2368 + (j - 64); return -1; }
    if (pn < 14) return 2384 + (nd - 2560);
    return 3408 + (nd - 3584);
}
template <int MAP>
__device__ __forceinline__ void p0_transpose_item(const float* W, int K, int N, bf16* WT, int NdBlocks, LAS float* scr, int item, int lane) {
    const int kb = item / NdBlocks, nb = item % NdBlocks, k0 = 64 * kb, n0 = 32 * nb;
    int sc = n0 + (lane & 31);
    if (MAP == 1) sc = win_src(sc);
    float tv[32];
#pragma unroll
    for (int i = 0; i < 32; ++i) { const int kk = 2 * i + (lane >> 5); tv[i] = (sc >= 0) ? W[(size_t)(k0 + kk) * N + sc] : 0.f; }
#pragma unroll
    for (int i = 0; i < 32; ++i) { const int kk = 2 * i + (lane >> 5); scr[kk * 33 + (lane & 31)] = tv[i]; }
    LDS_WAIT(); asm volatile("" ::: "memory");
    const int c = lane & 7;
#pragma unroll
    for (int j = 0; j < 4; ++j) { const int n = (lane >> 3) + 8 * j; const LAS float* s = scr + (8 * c) * 33 + n;
        v4u o; o.x = pk2(s[0 * 33], s[1 * 33]); o.y = pk2(s[2 * 33], s[3 * 33]); o.z = pk2(s[4 * 33], s[5 * 33]); o.w = pk2(s[6 * 33], s[7 * 33]);
        *(GAS v4u*)(WT + (size_t)(n0 + n) * K + k0 + 8 * c) = o; }
    LDS_WAIT(); asm volatile("" ::: "memory");
}
__device__ __forceinline__ void rms_row_to_bf16(int lane, const float* xrow, const float* g, bf16* orow) {
    const GAS f32x4* xr = (const GAS f32x4*)xrow + lane; const GAS f32x4* gr = (const GAS f32x4*)g + lane;
    f32x4 v[4]; float s2 = 0.f;
#pragma unroll
    for (int j = 0; j < 4; ++j) { v[j] = xr[64 * j]; s2 += (v[j].x * v[j].x + v[j].y * v[j].y) + (v[j].z * v[j].z + v[j].w * v[j].w); }
    const float rstd = 1.0f / sqrtf(wave_sum(s2) * (1.f / DM) + RMS_EPS);
    GAS unsigned long long* o8 = (GAS unsigned long long*)orow + lane;
#pragma unroll
    for (int j = 0; j < 4; ++j) { const f32x4 gg = gr[64 * j];
        o8[64 * j] = (unsigned long long)pk2(v[j].x * rstd * gg.x, v[j].y * rstd * gg.y) | ((unsigned long long)pk2(v[j].z * rstd * gg.z, v[j].w * rstd * gg.w) << 32); }
}
__device__ __forceinline__ void p0_s5_group(Frame& F, int g) {
    LAS float* AP = (LAS float*)(F.lds);
    LAS float* BB = (LAS float*)(F.lds + 16896);
    LAS float* CC = (LAS float*)(F.lds + 25088);
    LAS float* KJ = (LAS float*)(F.lds + 33280);
    const float* lre = F.in[I_LRE] + g * 64; const float* lim = F.in[I_LIM] + g * 64;
    const double dt = exp((double)F.in[I_LOGDT][g]);
    __syncthreads();
    for (int idx = F.tid; idx < 33 * 64; idx += NTHR) { const int p = idx & 63, j = idx >> 6;
        const double lr = lre[p], li = lim[p]; const double mag = exp(j * lr * dt), ang = j * li * dt;
        AP[idx * 2] = (float)(mag * cos(ang)); AP[idx * 2 + 1] = (float)(mag * sin(ang)); }
    for (int idx = F.tid; idx < 1024; idx += NTHR) { const int p = idx >> 4;
        const double lr = lre[p], li = lim[p]; const double mag = exp(lr * dt), ang = li * dt; const double ar = mag * cos(ang), ai = mag * sin(ang);
        const double nr = ar - 1.0, ni = ai, den = lr * lr + li * li; const double zr = (nr * lr + ni * li) / den, zi = (ni * lr - nr * li) / den;
        const double br = F.in[I_BRE][g * 1024 + idx], bi = F.in[I_BIM][g * 1024 + idx];
        BB[idx * 2] = (float)(zr * br - zi * bi); BB[idx * 2 + 1] = (float)(zr * bi + zi * br); }
    for (int idx = F.tid; idx < 1024; idx += NTHR) { CC[idx * 2] = F.in[I_CRE][g * 1024 + idx]; CC[idx * 2 + 1] = F.in[I_CIM][g * 1024 + idx]; }
    __syncthreads();
    for (int idx = F.tid; idx < 32 * 256; idx += NTHR) { const int j = idx >> 8, hp = (idx >> 4) & 15, h = idx & 15; float s = 0.f;
        for (int p = 0; p < 64; ++p) { const float cr = CC[(hp * 64 + p) * 2], ci = CC[(hp * 64 + p) * 2 + 1], ar = AP[(j * 64 + p) * 2], ai = AP[(j * 64 + p) * 2 + 1];
            const float er = cr * ar - ci * ai, ei = cr * ai + ci * ar; s += er * BB[(p * 16 + h) * 2] - ei * BB[(p * 16 + h) * 2 + 1]; }
        KJ[idx] = s; }
    __syncthreads();
    bf16* MT = (bf16*)(F.ws + WS_MT) + (size_t)g * 512 * 640;
    for (int ch = F.tid; ch < 512 * 80; ch += NTHR) { const int n = ch / 80, k0 = (ch % 80) * 8, tp = n >> 4, hp = n & 15; float v[8];
        if (k0 < 512) { const int sp = k0 >> 4, h0 = k0 & 15;
#pragma unroll
            for (int j = 0; j < 8; ++j) v[j] = (sp <= tp) ? KJ[((tp - sp) * 16 + hp) * 16 + h0 + j] : 0.f; }
        else { const bool im = k0 >= 576; const int p0 = k0 - (im ? 576 : 512);
#pragma unroll
            for (int j = 0; j < 8; ++j) { const int p = p0 + j; const float cr = CC[(hp * 64 + p) * 2], ci = CC[(hp * 64 + p) * 2 + 1], ar = AP[((tp + 1) * 64 + p) * 2], ai = AP[((tp + 1) * 64 + p) * 2 + 1];
                v[j] = im ? -(cr * ai + ci * ar) : (cr * ar - ci * ai); } }
        v4u o; o.x = pk2(v[0], v[1]); o.y = pk2(v[2], v[3]); o.z = pk2(v[4], v[5]); o.w = pk2(v[6], v[7]);
        *(GAS v4u*)(MT + (size_t)n * 640 + k0) = o; }
    bf16* WS = (bf16*)(F.ws + WS_WS) + (size_t)g * 256 * 512;
    for (int ch = F.tid; ch < 256 * 64; ch += NTHR) { const int n = ch >> 6, k0 = (ch & 63) * 8, sp = k0 >> 4, h0 = k0 & 15; float v[8];
#pragma unroll
        for (int j = 0; j < 8; ++j) { if (n < 128) { const int p = n & 63; const float ar = AP[((31 - sp) * 64 + p) * 2], ai = AP[((31 - sp) * 64 + p) * 2 + 1], br = BB[(p * 16 + h0 + j) * 2], bi = BB[(p * 16 + h0 + j) * 2 + 1];
                v[j] = (n < 64) ? (ar * br - ai * bi) : (ar * bi + ai * br); } else v[j] = 0.f; }
        v4u o; o.x = pk2(v[0], v[1]); o.y = pk2(v[2], v[3]); o.z = pk2(v[4], v[5]); o.w = pk2(v[6], v[7]);
        *(GAS v4u*)(WS + (size_t)n * 512 + k0) = o; }
    float* A32 = (float*)(F.ws + WS_A32) + g * 128;
    if (F.tid < 128) A32[F.tid] = AP[32 * 128 + F.tid];
    __syncthreads();
}
__device__ __forceinline__ void p0_prologue(Frame& F) {
    if ((int)blockIdx.x >= F.G - NGRP) p0_s5_group(F, (int)blockIdx.x - (F.G - NGRP));
    LAS float* scr = (LAS float*)(F.lds + F.wave * 16384);
    const int gw = blockIdx.x * NWAVES + F.wave, NGW = F.G * NWAVES;
    { float* cosT = (float*)(F.ws + WS_ROPE); float* sinT = cosT + SEQ * 32;
      for (int i = blockIdx.x * NTHR + F.tid; i < SEQ * 32; i += F.G * NTHR) { const int pos = i >> 5, k = i & 31;
          const double inv = pow(10000.0, -(double)k / 32.0); const double ang = (double)pos * (double)(float)inv;
          cosT[i] = (float)cos(ang); sinT[i] = (float)sin(ang); } }
    for (int m = gw; m < NTOK; m += NGW) rms_row_to_bf16(F.lane, F.in[I_X] + (size_t)m * DM, F.in[I_N1G], (bf16*)(F.ws + WS_XN) + (size_t)m * DM);
    constexpr int I_IN = 16 * (NIN_PAD / 32), I_GLU = 8 * 16, I_PS = 8 * 32, I_PA = 8 * 32, I_OUT = 16 * 32, I_MI1 = 16 * 64, I_MO1 = 16 * 32;
    constexpr int NITEMS = I_IN + I_GLU + I_PS + I_PA + I_OUT + NEXP * I_MI1 + NEXP * I_MO1;
    for (int it = gw; it < NITEMS; it += NGW) {
        int r = it;
        if (r < I_IN) { p0_transpose_item<1>(F.in[I_WIN], DM, 4432, (bf16*)(F.ws + WS_WIN), NIN_PAD / 32, scr, r, F.lane); continue; } r -= I_IN;
        if (r < I_GLU) { p0_transpose_item<0>(F.in[I_WGLU], 512, 512, (bf16*)(F.ws + WS_WGLU), 16, scr, r, F.lane); continue; } r -= I_GLU;
        if (r < I_PS) { p0_transpose_item<0>(F.in[I_WPS], 512, 1024, (bf16*)(F.ws + WS_WPS), 32, scr, r, F.lane); continue; } r -= I_PS;
        if (r < I_PA) { p0_transpose_item<0>(F.in[I_WPA], 512, 1024, (bf16*)(F.ws + WS_WPA), 32, scr, r, F.lane); continue; } r -= I_PA;
        if (r < I_OUT) { p0_transpose_item<0>(F.in[I_WOUT], 1024, 1024, (bf16*)(F.ws + WS_WOUT), 32, scr, r, F.lane); continue; } r -= I_OUT;
        if (r < NEXP * I_MI1) { const int e = r / I_MI1; p0_transpose_item<0>(F.in[I_WMI] + (size_t)e * 1024 * 2048, 1024, 2048, (bf16*)(F.ws + WS_WMI) + (size_t)e * 2048 * 1024, 64, scr, r % I_MI1, F.lane); continue; } r -= NEXP * I_MI1;
        { const int e = r / I_MO1; p0_transpose_item<0>(F.in[I_WMO] + (size_t)e * 1024 * 1024, 1024, 1024, (bf16*)(F.ws + WS_WMO) + (size_t)e * 1024 * 1024, 32, scr, r % I_MO1, F.lane); }
    }
}

struct StaticOrder {
    int nM, nN, nwg, G, c;
    __device__ void init(int nM_, int nN_, int G_, int c_) { nM = nM_; nN = nN_; nwg = nM * nN; G = G_; c = c_; }
    __device__ bool tile(int i, int& pm, int& pn) const {
        const long L = (long)i * G + c; if (L >= nwg) return false;
        int wgid = (int)L; { const int q = nwg / pg8::NXCD, r = nwg % pg8::NXCD, xcd = wgid % pg8::NXCD, off = wgid / pg8::NXCD; wgid = (xcd < r ? xcd * (q + 1) : r * (q + 1) + (xcd - r) * q) + off; }
        const int nig = pg8::WGM * nN, gid = wgid / nig, fm = gid * pg8::WGM, gsz = (nM - fm) < pg8::WGM ? (nM - fm) : pg8::WGM;
        pm = fm + ((wgid % nig) % gsz); pn = (wgid % nig) / gsz; return true;
    }
    __device__ bool next(int i, pg8::Unit& u) const { int pm, pn; if (!tile(i, pm, pn)) return false; u.pm = pm; u.pn = pn; u.pa = pm; u.pb = pn; u.e = 0; return true; }
    __device__ __forceinline__ int arow(const pg8::Unit& u, int h, int R) const { return u.pa * 256 + h * 128 + R; }
};
struct S5StateOrder {
    int c;
    __device__ bool next(int i, pg8::Unit& u) const { if (i > 0 || c >= 64) return false; const int g = c >> 1, pm = c & 1; u.pm = pm; u.pn = 0; u.pa = g * 2 + pm; u.pb = g; u.e = g; return true; }
    __device__ __forceinline__ int arow(const pg8::Unit& u, int h, int R) const { return u.pa * 256 + h * 128 + R; }
};
struct S5YOrder {
    int c;
    __device__ bool next(int i, pg8::Unit& u) const { if (i > 0 || c >= 128) return false; const int g = c >> 2, pm = (c >> 1) & 1, pn = c & 1; u.pm = pm; u.pn = pn; u.pa = g * 2 + pm; u.pb = g * 2 + pn; u.e = g; return true; }
    __device__ __forceinline__ int arow(const pg8::Unit& u, int h, int R) const { return u.pa * 256 + h * 128 + R; }
};
struct MixOrder {
    StaticOrder so;
    __device__ bool next(int i, pg8::Unit& u) const { int pm, pn; if (!so.tile(i >> 1, pm, pn)) return false; const int h = i & 1; u.pm = pm; u.pn = pn; u.pa = pm + 64 * h; u.pb = pn + 4 * h; u.e = h; return true; }
    __device__ __forceinline__ int arow(const pg8::Unit& u, int h, int R) const { return u.pa * 256 + h * 128 + R; }
};
struct MoeOrder {
    const volatile LAS int* te; const volatile LAS int* off; const volatile LAS int* cnt; const int* rowmap; int TT, NTN, c;
    __device__ bool next(int i, pg8::Unit& u) const {
        const int xcd = c & 7, j = c >> 3, mpx = 32 / NTN; const int mt = i * (8 * mpx) + xcd * mpx + j / NTN, pn = j % NTN;
        if (mt >= TT) return false; const int e = te[mt]; u.pm = mt; u.pn = pn; u.pa = mt; u.pb = e * NTN + pn; u.e = e; return true; }
    __device__ __forceinline__ int arow(const pg8::Unit& u, int h, int R) const {
        if (!rowmap) return u.pa * 256 + h * 128 + R;
        const int lr = u.pm * 256 - off[u.e] + h * 128 + R;
        return lr < cnt[u.e] ? rowmap[(size_t)u.e * NTOK + lr] : 0; }
};

using pg8::f32x2; using pg8::u32x2; using pg8::pack8; using pg8::cvt_pk_bf16;
#define EPI_ROWS_BEGIN _Pragma("unroll") for (int ai = 0; ai < 2; ++ai) _Pragma("unroll") for (int m = 0; m < 4; ++m) { asm volatile("" ::: "memory"); const int row = u.pm * 256 + ai * 128 + wr * 64 + m * 16 + fr; (void)row;
#define EPI_COLS_BEGIN _Pragma("unroll") for (int bj = 0; bj < 2; ++bj) { const int ct = bj * 128 + wc * 32 + fq * 8; (void)ct; f32x4 v0 = acc[ai][bj][m][0], v1 = acc[ai][bj][m][1];
#define EPI_END } }
struct EpiInProj {
    static constexpr bool PERM = true;
    unsigned char* ws; const float* bgate;
    __device__ __forceinline__ void rope(f32x4& v0, f32x4& v1, int pos, int a, float sc) const {
        const unsigned o = (unsigned)WS_ROPE + (unsigned)(pos * 32 + 4 * a) * 4u;
        const f32x4 c = *(const GAS f32x4*)(ws + o), s = *(const GAS f32x4*)(ws + o + (unsigned)(SEQ * 32 * 4));
        const f32x4 o1 = (v0 * c - v1 * s) * sc, o2 = (v1 * c + v0 * s) * sc; v0 = o1; v1 = o2;
    }
    __device__ __forceinline__ void store_rope(unsigned off, const f32x4& o1, const f32x4& o2) const {
        u32x2 a, b; a.x = cvt_pk_bf16(o1[0], o1[1]); a.y = cvt_pk_bf16(o1[2], o1[3]); b.x = cvt_pk_bf16(o2[0], o2[1]); b.y = cvt_pk_bf16(o2[2], o2[3]);
        *(GAS u32x2*)(ws + off) = a; *(GAS u32x2*)(ws + off + 64u) = b;
    }
    __device__ __forceinline__ void operator()(const f32x4 (&acc)[2][2][4][2], const pg8::Unit& u, int wr, int wc, int fr, int fq) const {
        const int pn = u.pn;
        if (pn < 2) {
            EPI_ROWS_BEGIN const int bb = row >> 12, cc = (row >> 5) & 127, sp = row & 31;
            EPI_COLS_BEGIN const int col = pn * 256 + ct, g = col >> 4, h0 = col & 15;
                *(GAS v4u*)(ws + ((unsigned)WS_UGX + (unsigned)((g * 512 + bb * 128 + cc) * UGX_LD + sp * 16 + h0) * 2u)) = pack8(v0, v1);
            EPI_END
        } else if (pn < 4) {
            EPI_ROWS_BEGIN const int pos = row & 4095;
            EPI_COLS_BEGIN const int j = (pn - 2) * 256 + ct, head = j >> 6, a = (j & 63) >> 3;
                rope(v0, v1, pos, a, 0.125f); store_rope((unsigned)WS_Q + (unsigned)(row * 512 + head * 64 + 4 * a) * 2u, v0, v1);
            EPI_END
        } else if (pn == 4) {
            EPI_ROWS_BEGIN const int pos = row & 4095;
            EPI_COLS_BEGIN
                if (bj == 0) { const int head = ct >> 6, a = (ct & 63) >> 3; rope(v0, v1, pos, a, 1.0f); store_rope((unsigned)WS_K + (unsigned)(row * 128 + head * 64 + 4 * a) * 2u, v0, v1); }
                else *(GAS v4u*)(ws + ((unsigned)WS_V + (unsigned)(row * 128 + (ct - 128)) * 2u)) = pack8(v0, v1);
            EPI_END
        } else if (pn < 9) {
            EPI_ROWS_BEGIN const int pos = row & 4095;
            EPI_COLS_BEGIN const int j = (pn - 5) * 256 + ct, head = j >> 6, a = (j & 63) >> 3;
                rope(v0, v1, pos, a, 1.0f); store_rope((unsigned)WS_QI + (unsigned)(row * 1024 + head * 64 + 4 * a) * 2u, v0, v1);
            EPI_END
        } else if (pn == 9) {
            EPI_ROWS_BEGIN const int pos = row & 4095;
            EPI_COLS_BEGIN
                if (bj == 0) { if (ct < 64) { const int a = ct >> 3; rope(v0, v1, pos, a, 1.0f); store_rope((unsigned)WS_KI + (unsigned)(row * 64 + 4 * a) * 2u, v0, v1); }
                    else if (ct < 80) { const unsigned o = (unsigned)WS_WI + (unsigned)(row * 16 + (ct - 64)) * 4u; *(GAS f32x4*)(ws + o) = v0 * 0.03125f; *(GAS f32x4*)(ws + o + 16u) = v1 * 0.03125f; } }
            EPI_END
        } else {
            const int br = pn >= 14; const unsigned gbase = br ? (unsigned)WS_GA : (unsigned)WS_GS; const float* bgp = bgate + br * 1024;
            EPI_ROWS_BEGIN
            EPI_COLS_BEGIN const int col = (pn - (br ? 14 : 10)) * 256 + ct;
                const f32x4 b0 = *(const GAS f32x4*)(bgp + col), b1 = *(const GAS f32x4*)(bgp + col + 4);
#pragma unroll
                for (int j = 0; j < 4; ++j) { v0[j] = sigmoidf_(v0[j] + b0[j]); v1[j] = sigmoidf_(v1[j] + b1[j]); }
                *(GAS v4u*)(ws + (gbase + (unsigned)(row * 1024 + col) * 2u)) = pack8(v0, v1);
            EPI_END
        }
    }
};
struct EpiS5State {
    static constexpr bool PERM = true;
    float* SB;
    __device__ __forceinline__ void operator()(const f32x4 (&acc)[2][2][4][2], const pg8::Unit& u, int wr, int wc, int fr, int fq) const {
        EPI_ROWS_BEGIN
        EPI_COLS_BEGIN
            if (bj == 0) { float* d = SB + ((size_t)u.e * 512 + row) * 128 + ct; *(GAS f32x4*)d = v0; *(GAS f32x4*)(d + 4) = v1; }
        EPI_END
    }
};
struct EpiS5Y {
    static constexpr bool PERM = true;
    const bf16* UGX; const float* Dsk; bf16* YG;
    __device__ __forceinline__ void operator()(const f32x4 (&acc)[2][2][4][2], const pg8::Unit& u, int wr, int wc, int fr, int fq) const {
        const int g = u.e;
        EPI_ROWS_BEGIN const int bb = row >> 7, cc = row & 127;
        EPI_COLS_BEGIN const int n = u.pn * 256 + ct, tp = n >> 4, h0 = n & 15;
            const v4u uu = *(const GAS v4u*)(UGX + ((size_t)g * 512 + row) * UGX_LD + n);
            const f32x4 d0 = *(const GAS f32x4*)(Dsk + g * 16 + h0), d1 = *(const GAS f32x4*)(Dsk + g * 16 + h0 + 4);
            v0[0] += d0[0] * bflo(uu.x); v0[1] += d0[1] * bfhi(uu.x); v0[2] += d0[2] * bflo(uu.y); v0[3] += d0[3] * bfhi(uu.y);
            v1[0] += d1[0] * bflo(uu.z); v1[1] += d1[1] * bfhi(uu.z); v1[2] += d1[2] * bflo(uu.w); v1[3] += d1[3] * bfhi(uu.w);
#pragma unroll
            for (int j = 0; j < 4; ++j) { v0[j] = gelu_tanh(v0[j]); v1[j] = gelu_tanh(v1[j]); }
            const int tok = bb * 4096 + cc * 32 + tp;
            *(GAS v4u*)(YG + (size_t)tok * 512 + g * 16 + h0) = pack8(v0, v1);
        EPI_END
    }
};
struct EpiGlu {
    static constexpr bool PERM = true;
    const bf16* YG; const float* bglu; bf16* YS;
    __device__ __forceinline__ void operator()(const f32x4 (&acc)[2][2][4][2], const pg8::Unit& u, int wr, int wc, int fr, int fq) const {
        EPI_ROWS_BEGIN
        EPI_COLS_BEGIN const int col = u.pn * 256 + ct;
            const v4u yy = *(const GAS v4u*)(YG + (size_t)row * 512 + col);
            const f32x4 b0 = *(const GAS f32x4*)(bglu + col), b1 = *(const GAS f32x4*)(bglu + col + 4);
            v0[0] = bflo(yy.x) * sigmoidf_(v0[0] + b0[0]); v0[1] = bfhi(yy.x) * sigmoidf_(v0[1] + b0[1]); v0[2] = bflo(yy.y) * sigmoidf_(v0[2] + b0[2]); v0[3] = bfhi(yy.y) * sigmoidf_(v0[3] + b0[3]);
            v1[0] = bflo(yy.z) * sigmoidf_(v1[0] + b1[0]); v1[1] = bfhi(yy.z) * sigmoidf_(v1[1] + b1[1]); v1[2] = bflo(yy.w) * sigmoidf_(v1[2] + b1[2]); v1[3] = bfhi(yy.w) * sigmoidf_(v1[3] + b1[3]);
            *(GAS v4u*)(YS + (size_t)row * 512 + col) = pack8(v0, v1);
        EPI_END
    }
};
struct EpiMix {
    static constexpr bool PERM = true;
    const bf16* GS; const bf16* GA; bf16* MX;
    __device__ __forceinline__ void operator()(const f32x4 (&acc)[2][2][4][2], const pg8::Unit& u, int wr, int wc, int fr, int fq) const {
        const bf16* Gp = u.e ? GA : GS;
        EPI_ROWS_BEGIN
        EPI_COLS_BEGIN const size_t off = (size_t)row * 1024 + u.pn * 256 + ct;
            const v4u gg = *(const GAS v4u*)(Gp + off);
            v0[0] *= bflo(gg.x); v0[1] *= bfhi(gg.x); v0[2] *= bflo(gg.y); v0[3] *= bfhi(gg.y); v1[0] *= bflo(gg.z); v1[1] *= bfhi(gg.z); v1[2] *= bflo(gg.w); v1[3] *= bfhi(gg.w);
            if (u.e) { const v4u pp = *(const GAS v4u*)(MX + off);
                v0[0] += bflo(pp.x); v0[1] += bfhi(pp.x); v0[2] += bflo(pp.y); v0[3] += bfhi(pp.y); v1[0] += bflo(pp.z); v1[1] += bfhi(pp.z); v1[2] += bflo(pp.w); v1[3] += bfhi(pp.w); }
            *(GAS v4u*)(MX + off) = pack8(v0, v1);
        EPI_END
    }
};
struct EpiOut {
    static constexpr bool PERM = true;
    const float* X; float* X1;
    __device__ __forceinline__ void operator()(const f32x4 (&acc)[2][2][4][2], const pg8::Unit& u, int wr, int wc, int fr, int fq) const {
        EPI_ROWS_BEGIN
        EPI_COLS_BEGIN const size_t off = (size_t)row * 1024 + u.pn * 256 + ct;
            const f32x4 x0 = *(const GAS f32x4*)(X + off), x1 = *(const GAS f32x4*)(X + off + 4);
            *(GAS f32x4*)(X1 + off) = v0 + x0; *(GAS f32x4*)(X1 + off + 4) = v1 + x1;
        EPI_END
    }
};
struct EpiMoe1 {
    static constexpr bool PERM = true;
    const float* bmi; bf16* ACT;
    __device__ __forceinline__ void operator()(const f32x4 (&acc)[2][2][4][2], const pg8::Unit& u, int wr, int wc, int fr, int fq) const {
        const float* bp = bmi + (size_t)u.e * 2048;
        EPI_ROWS_BEGIN
        EPI_COLS_BEGIN const int col = u.pn * 256 + ct;
            const f32x4 b0 = *(const GAS f32x4*)(bp + col), b1 = *(const GAS f32x4*)(bp + col + 4);
            v0 += b0; v1 += b1; float o[4];
#pragma unroll
            for (int j = 0; j < 4; ++j) { const float zg0 = (j < 2) ? v0[2 * j] : v1[2 * j - 4], zl0 = (j < 2) ? v0[2 * j + 1] : v1[2 * j - 3];
                const float zg = fminf(zg0, 7.0f), zl = fminf(fmaxf(zl0, -7.0f), 7.0f); o[j] = zg * sigmoidf_(1.702f * zg) * (zl + 1.0f); }
            u32x2 w; w.x = cvt_pk_bf16(o[0], o[1]); w.y = cvt_pk_bf16(o[2], o[3]);
            *(GAS u32x2*)(ACT + (size_t)row * 1024 + (col >> 1)) = w;
        EPI_END
    }
};
struct EpiMoe2 {
    static constexpr bool PERM = true;
    const float* bmo; bf16* Y2;
    __device__ __forceinline__ void operator()(const f32x4 (&acc)[2][2][4][2], const pg8::Unit& u, int wr, int wc, int fr, int fq) const {
        const float* bp = bmo + (size_t)u.e * 1024;
        EPI_ROWS_BEGIN
        EPI_COLS_BEGIN const int col = u.pn * 256 + ct;
            const f32x4 b0 = *(const GAS f32x4*)(bp + col), b1 = *(const GAS f32x4*)(bp + col + 4);
            v0 += b0; v1 += b1;
            *(GAS v4u*)(Y2 + (size_t)row * 1024 + col) = pack8(v0, v1);
        EPI_END
    }
};

__device__ __forceinline__ unsigned f16key(unsigned bits) { return (bits & 0x8000u) ? (bits ^ 0xffffu) : (bits | 0x8000u); }
__device__ __forceinline__ void idx_phase(Frame& F) {
    LAS unsigned char* lds = F.lds;
    LAS u16* SC = (LAS u16*)lds;
    LAS unsigned char* KT = lds + 65536;
    LAS unsigned* HP = (LAS unsigned*)(lds + 147456);
    LAS unsigned char* OLB = lds + 147456 + 4096;
    LAS unsigned* CN = (LAS unsigned*)(lds + MISC_OFF + 256);
    const bf16* QI = (const bf16*)(F.ws + WS_QI); const bf16* KI = (const bf16*)(F.ws + WS_KI); const float* WI = (const float*)(F.ws + WS_WI);
    u16* SEL = (u16*)(F.ws + WS_SEL);
    const int tid = F.tid, lane = F.lane, wave = F.wave, qg = wave & 1, kq = wave >> 1, kgrp = lane >> 4, l15 = lane & 15;
    const int kx = l15 >> 1, cpos = lane & 7;
    const int dsw = ((wave & 1) * 4 + (lane >> 4)) & 7;
    for (int r = 0; r < 8; ++r) {
        const int b = r >> 1, tile = (r & 1) ? 511 - (int)blockIdx.x : (int)blockIdx.x, t0 = tile * 8;
        __syncthreads();
        const int t = t0 + wave; const size_t tok = (size_t)b * SEQ + t;
        if (tile < 32) {
            v2u x; const int k0 = lane * 4;
            x.x = (unsigned)(k0 <= t ? k0 : 0) | ((unsigned)(k0 + 1 <= t ? k0 + 1 : 0) << 16); x.y = (unsigned)(k0 + 2 <= t ? k0 + 2 : 0) | ((unsigned)(k0 + 3 <= t ? k0 + 3 : 0) << 16);
            *(GAS v2u*)(SEL + tok * NSEL + k0) = x;
            continue;
        }
#pragma unroll
        for (int i = 0; i < 2; ++i) HP[tid * 2 + i] = 0u;
        if (tid < 16) CN[tid] = 0u;
        bf16x8 qa[4][2]; float w[16];
        { const int q = l15 >> 2;
          const bf16* qp = QI + ((size_t)b * SEQ + t0 + 4 * qg + q) * 1024 + (l15 & 3) * 64 + kgrp * 8;
#pragma unroll
          for (int i = 0; i < 4; ++i)
#pragma unroll
              for (int ks = 0; ks < 2; ++ks) qa[i][ks] = *(const GAS bf16x8*)(qp + i * 256 + ks * 32);
          const float* wp = WI + ((size_t)b * SEQ + t0 + 4 * qg + kgrp) * 16;
#pragma unroll
          for (int i = 0; i < 4; ++i) { const f32x4 x = *(const GAS f32x4*)(wp + 4 * i); w[4 * i] = x[0]; w[4 * i + 1] = x[1]; w[4 * i + 2] = x[2]; w[4 * i + 3] = x[3]; } }
        asm volatile("s_waitcnt vmcnt(0)" : "+v"(qa[0][0]), "+v"(qa[0][1]), "+v"(qa[1][0]), "+v"(qa[1][1]), "+v"(qa[2][0]), "+v"(qa[2][1]), "+v"(qa[3][0]), "+v"(qa[3][1]) :: "memory");
        const int nst = (t0 + 7) / 128 + 1;
        const int tq = t0 + 4 * qg + kgrp, qrow = 4 * qg + kgrp;
        const bf16* kbat = KI + (size_t)b * SEQ * 64;
        const unsigned hpq = (unsigned)(unsigned long)(HP + qrow * 128);
#define IDX_DMA(st, bufi) do { _Pragma("unroll") for (int j_ = 0; j_ < 2; ++j_) { const int row_ = (j_ * 8 + wave) * 8 + (lane >> 3); \
            __builtin_amdgcn_global_load_lds((const unsigned*)(kbat + ((size_t)(st) * 128 + row_) * 64 + ((cpos ^ dsw) << 3)), (LAS unsigned*)(KT + (bufi) * 16384 + (j_ * 8 + wave) * 1024), 16, 0, 0); \
            if (PROBE_DUP == 306) __builtin_amdgcn_global_load_lds((const unsigned*)(kbat + ((size_t)(st) * 128 + row_) * 64 + ((cpos ^ dsw) << 3)), (LAS unsigned*)(KT + (bufi) * 16384 + (j_ * 8 + wave) * 1024), 16, 0, 0); } } while (0)
#define IDX_EPI1(kgl_, AC) do { float s0 = 0.f; \
            _Pragma("unroll") for (int i = 0; i < 4; ++i) _Pragma("unroll") for (int r_ = 0; r_ < 4; ++r_) { const float a0_ = AC[i][r_]; const int i0 = __builtin_bit_cast(int, a0_); const float m0 = __builtin_bit_cast(float, i0 > 0 ? i0 : 0); s0 += w[4 * i + r_] * m0; } \
            const _Float16 h0_ = (_Float16)s0; const unsigned bits0 = __builtin_bit_cast(unsigned short, h0_); const int kg0 = (kgl_); \
            SC[qrow * 4096 + kg0] = (u16)bits0; \
            if (kg0 <= tq) { const unsigned bin = f16key(bits0) >> 8; const unsigned ha_ = hpq + ((bin >> 1) << 2), hv_ = (bin & 1u) ? 0x10000u : 1u; \
                asm volatile("ds_add_u32 %0, %1" :: "v"(ha_), "v"(hv_) : "memory"); \
                if (PROBE_DUP == 305) { const unsigned z_ = 0u; asm volatile("ds_add_u32 %0, %1" :: "v"(ha_), "v"(z_) : "memory"); } } } while (0)
#define IDX_READ(BQ, kt2) do { _Pragma("unroll") for (int ks = 0; ks < 2; ++ks) BQ[ks] = *(const LAS bf16x8*)(kb + (kq * 32 + (kt2) * 16 + l15) * 128 + (((ks * 4 + kgrp) ^ kx) << 4)); } while (0)
#define IDX_MMA(AC, BQ) do { _Pragma("unroll") for (int i = 0; i < 4; ++i) { AC[i] = (f32x4){0.f, 0.f, 0.f, 0.f}; _Pragma("unroll") for (int ks = 0; ks < 2; ++ks) AC[i] = __builtin_amdgcn_mfma_f32_16x16x32_bf16(qa[i][ks], BQ[ks], AC[i], 0, 0, 0); } } while (0)
        bf16x8 bq0[2], bq1[2];
        f32x4 aA[4], aB[4];
#pragma unroll
        for (int i = 0; i < 4; ++i) { aA[i] = (f32x4){0.f, 0.f, 0.f, 0.f}; aB[i] = aA[i]; }
        for (int rep = 0; rep < ((PROBE_DUP == 302) ? 2 : 1); ++rep) {
        if (rep) { __syncthreads(); HP[tid * 2] = 0u; HP[tid * 2 + 1] = 0u; }
        IDX_DMA(0, 0); if (1 < nst) IDX_DMA(1, 1); if (2 < nst) IDX_DMA(2, 2); if (3 < nst) IDX_DMA(3, 3);
        int bcur = 0, bnew = 4;
        for (int st = 0; st < nst; ++st) {
            if (st + 3 < nst) { if (PROBE_DUP == 306) asm volatile("s_waitcnt vmcnt(12)" ::: "memory"); else asm volatile("s_waitcnt vmcnt(6)" ::: "memory"); } else asm volatile("s_waitcnt vmcnt(0)" ::: "memory");
            __syncthreads();
            if (st + 4 < nst) IDX_DMA(st + 4, bnew);
            const LAS unsigned char* kb = KT + bcur * 16384;
            const int kbase_ = st * 128 + kq * 32 + l15;
            IDX_READ(bq0, 0);
            IDX_READ(bq1, 1); IDX_MMA(aA, bq0); if (st >= 1) IDX_EPI1(kbase_ - 128 + 16, aB);
            IDX_MMA(aB, bq1); IDX_EPI1(kbase_, aA);
            bcur = (bcur == 4) ? 0 : bcur + 1; bnew = (bnew == 4) ? 0 : bnew + 1;
        }
        IDX_EPI1((nst - 1) * 128 + kq * 32 + l15 + 16, aB);
        }
#undef IDX_DMA
#undef IDX_EPI1
#undef IDX_MMA
#undef IDX_READ
        __syncthreads();
        const int n = t + 1, jj = lane, ql = wave;
        const LAS u16* sc = SC + ql * 4096;
        LAS unsigned* hp = HP + ql * 128;
        unsigned b1, need1;
        { const v2u wv = *(const LAS v2u*)(hp + 126 - 2 * jj); unsigned hb[4];
          hb[3] = wv.x & 0xffffu; hb[2] = wv.x >> 16; hb[1] = wv.y & 0xffffu; hb[0] = wv.y >> 16;
          const unsigned s4 = hb[0] + hb[1] + hb[2] + hb[3];
          unsigned pre = s4;
#pragma unroll
          for (int o = 1; o < 64; o <<= 1) { const unsigned x = __shfl_up(pre, o, 64); if (jj >= o) pre += x; }
          const unsigned long long bal = __ballot(pre >= 256u); const int js = __builtin_ctzll(bal);
          unsigned above = pre - s4, bb1 = 0, nd1 = 0; bool found = false;
#pragma unroll
          for (int i = 0; i < 4; ++i) { if (!found) { if (above + hb[i] >= 256u) { bb1 = 255 - (jj * 4 + i); nd1 = 256u - above; found = true; } else above += hb[i]; } }
          b1 = __shfl(bb1, js); need1 = __shfl(nd1, js); }
        LDS_WAIT(); __builtin_amdgcn_wave_barrier();
        hp[jj * 2] = 0u; hp[jj * 2 + 1] = 0u;
        LDS_WAIT(); __builtin_amdgcn_wave_barrier();
        const int nit = (n + 511) >> 9;
        for (int it = 0; it < nit; ++it) { const int base = it * 512 + jj * 8; const v4u x = *(const LAS v4u*)(sc + base);
#pragma unroll
            for (int e = 0; e < 8; ++e) { const unsigned wd = (e < 2) ? x.x : (e < 4) ? x.y : (e < 6) ? x.z : x.w; const unsigned k = f16key((e & 1) ? (wd >> 16) : (wd & 0xffffu));
                if (base + e < n && (k >> 8) == b1) atomicAdd((unsigned*)&hp[(k & 255u) >> 1], (k & 1u) ? 0x10000u : 1u); } }
        LDS_WAIT(); __builtin_amdgcn_wave_barrier();
        unsigned T, need2;
        { const v2u wv = *(const LAS v2u*)(hp + 126 - 2 * jj); unsigned hb[4];
          hb[3] = wv.x & 0xffffu; hb[2] = wv.x >> 16; hb[1] = wv.y & 0xffffu; hb[0] = wv.y >> 16;
          const unsigned s4 = hb[0] + hb[1] + hb[2] + hb[3];
          unsigned pre = s4;
#pragma unroll
          for (int o = 1; o < 64; o <<= 1) { const unsigned x = __shfl_up(pre, o, 64); if (jj >= o) pre += x; }
          const unsigned long long bal = __ballot(pre >= need1); const int js = __builtin_ctzll(bal);
          unsigned above = pre - s4, bb2 = 0, nd2 = 0; bool found = false;
#pragma unroll
          for (int i = 0; i < 4; ++i) { if (!found) { if (above + hb[i] >= need1) { bb2 = 255 - (jj * 4 + i); nd2 = need1 - above; found = true; } else above += hb[i]; } }
          const unsigned b2 = __shfl(bb2, js); need2 = __shfl(nd2, js); T = (b1 << 8) | b2; }
        LAS u16* OL = (LAS u16*)(OLB + ql * 512);
        for (int it = 0; it < nit; ++it) { const int base = it * 512 + jj * 8; const v4u x = *(const LAS v4u*)(sc + base);
#pragma unroll
            for (int e = 0; e < 8; ++e) { const unsigned wd = (e < 2) ? x.x : (e < 4) ? x.y : (e < 6) ? x.z : x.w; const unsigned k = f16key((e & 1) ? (wd >> 16) : (wd & 0xffffu));
                if (base + e < n && k >= T) { bool take = k > T;
                    if (!take) { const unsigned tp = atomicAdd((unsigned*)&CN[ql * 2 + 1], 1u); take = tp < need2; }
                    if (take) { const unsigned pos = atomicAdd((unsigned*)&CN[ql * 2], 1u); if (pos < 256u) OL[pos] = (u16)(base + e); } } } }
        LDS_WAIT(); __builtin_amdgcn_wave_barrier();
        { const v2u x = *(const LAS v2u*)(OL + jj * 4); *(GAS v2u*)(SEL + tok * NSEL + jj * 4) = x; }
    }
}

__device__ __forceinline__ void carry_phase(Frame& F) {
    const int gid = blockIdx.x * NTHR + F.tid; if (gid >= NGRP * NB * 64) return;
    const int p = gid & 63, b = (gid >> 6) & 3, g = gid >> 8;
    const float* A32 = (const float*)(F.ws + WS_A32) + g * 128; const float ar = A32[p * 2], ai = A32[p * 2 + 1];
    const float* SB = (const float*)(F.ws + WS_SBUF) + ((size_t)g * 512 + b * 128) * 128; bf16* UX = (bf16*)(F.ws + WS_UGX) + ((size_t)g * 512 + b * 128) * UGX_LD;
    float xr = 0.f, xi = 0.f;
    for (int c = 0; c < NCH; ++c) {
        UX[(size_t)c * UGX_LD + 512 + p] = (bf16)f2bf(xr); UX[(size_t)c * UGX_LD + 576 + p] = (bf16)f2bf(xi);
        const float sr = SB[c * 128 + p], si = SB[c * 128 + 64 + p];
        const float nr = ar * xr - ai * xi + sr, ni = ar * xi + ai * xr + si; xr = nr; xi = ni;
    }
}

template <int N> __device__ __forceinline__ void wait_vm() { asm volatile("s_waitcnt vmcnt(%0)" :: "n"(N) : "memory"); }
typedef short s16x4 __attribute__((ext_vector_type(4)));
__device__ __forceinline__ void attn_phase(Frame& F) {
    constexpr int WSTR = 20224;
    LAS unsigned char* RING = F.lds + F.wave * WSTR;
    LAS u16* SL = (LAS u16*)(RING + 16384);
    const bf16* Q = (const bf16*)(F.ws + WS_Q); const bf16* Kg = (const bf16*)(F.ws + WS_K); const bf16* Vg = (const bf16*)(F.ws + WS_V);
    const u16* SEL = (const u16*)(F.ws + WS_SEL); bf16* YA = (bf16*)(F.ws + WS_YATT);
    const int lane = F.lane, gw = blockIdx.x * NWAVES + F.wave, NGW = F.G * NWAVES;
    const int hd = lane & 15, kg = lane >> 4;
    const int l8 = lane >> 3, cpos = lane & 7;
    unsigned tra[8];
    { const int q4 = hd >> 2, p4 = hd & 3; const unsigned rb = (unsigned)(unsigned long)RING;
#pragma unroll
      for (int mt = 0; mt < 4; ++mt)
#pragma unroll
          for (int tl = 0; tl < 2; ++tl) { const int row = tl * 16 + kg * 4 + q4, cc = 2 * mt + (p4 >> 1), pos = cc ^ (2 * ((row >> 1) & 3)); tra[2 * mt + tl] = rb + row * 128 + pos * 16 + (p4 & 1) * 8; } }
    for (int it = gw; it < NTOK * 2; it += NGW) {
        const int tok = it >> 1, kvh = it & 1, t = tok & 4095; const size_t bbase = (size_t)(tok >> 12) * SEQ;
        const int nsel = (t + 1 < NSEL) ? t + 1 : NSEL;
        { const v2u x = *(const GAS v2u*)(SEL + (size_t)tok * NSEL + lane * 4); *(LAS v2u*)(SL + lane * 4) = x; }
        bf16x8 qf[2];
#pragma unroll
        for (int ks = 0; ks < 2; ++ks) { if (hd < 4) qf[ks] = *(const GAS bf16x8*)(Q + (size_t)tok * 512 + (kvh * 4 + hd) * 64 + ks * 32 + kg * 8); else qf[ks] = (bf16x8){0, 0, 0, 0, 0, 0, 0, 0}; }
        asm volatile("s_waitcnt vmcnt(0)" : "+v"(qf[0]), "+v"(qf[1]) :: "memory");
        LDS_WAIT(); __builtin_amdgcn_wave_barrier();
        const bf16* kbp = Kg + bbase * 128 + kvh * 64; const bf16* vbp = Vg + bbase * 128 + kvh * 64;
        f32x4 sc[8][2]; f32x4 oacc[4];
#pragma unroll
        for (int c = 0; c < 8; ++c) { sc[c][0] = (f32x4){0.f, 0.f, 0.f, 0.f}; sc[c][1] = (f32x4){0.f, 0.f, 0.f, 0.f}; }
#pragma unroll
        for (int m = 0; m < 4; ++m) oacc[m] = (f32x4){0.f, 0.f, 0.f, 0.f};
        float inv = 1.0f;
#define ATT_ISSUE(s) do { const int c_ = (s) & 7; const bool isk_ = (s) < 8; const bf16* gb_ = isk_ ? kbp : vbp; int sel_[4]; \
            _Pragma("unroll") for (int j_ = 0; j_ < 4; ++j_) { const int ki_ = c_ * 32 + j_ * 8 + l8; sel_[j_] = (int)SL[ki_ < nsel ? ki_ : 0]; } \
            _Pragma("unroll") for (int j_ = 0; j_ < 4; ++j_) { const int f_ = isk_ ? ((j_ & 1) * 4 + (lane >> 4)) : (2 * (lane >> 4)); \
                __builtin_amdgcn_global_load_lds((const unsigned*)(gb_ + (size_t)sel_[j_] * 128 + ((cpos ^ f_) << 3)), (LAS unsigned*)(RING + ((s) & 3) * 4096 + j_ * 1024), 16, 0, 0); } } while (0)
        ATT_ISSUE(0); ATT_ISSUE(1); ATT_ISSUE(2);
#pragma unroll
        for (int s = 0; s < 16; ++s) {
            if (s + 3 < 16) ATT_ISSUE(s + 3);
            if (s <= 12) wait_vm<12>(); else if (s == 13) wait_vm<8>(); else if (s == 14) wait_vm<4>(); else wait_vm<0>();
            const LAS unsigned char* buf = RING + (s & 3) * 4096;
            if (s < 8) {
#pragma unroll
                for (int tl = 0; tl < 2; ++tl)
#pragma unroll
                    for (int ks = 0; ks < 2; ++ks) { const bf16x8 af = *(const LAS bf16x8*)(buf + (tl * 16 + hd) * 128 + (((ks * 4 + kg) ^ (hd >> 1)) << 4));
                        sc[s][tl] = __builtin_amdgcn_mfma_f32_16x16x32_bf16(af, qf[ks], sc[s][tl], 0, 0, 0); }
                if (s == 7) {
                    float mx = -3.0e38f;
#pragma unroll
                    for (int c = 0; c < 8; ++c)
#pragma unroll
                        for (int tl = 0; tl < 2; ++tl)
#pragma unroll
                            for (int r = 0; r < 4; ++r) { const int key = c * 32 + tl * 16 + kg * 4 + r; const float v = (key < nsel) ? sc[c][tl][r] : -3.0e38f; sc[c][tl][r] = v; mx = fmaxf(mx, v); }
                    mx = fmaxf(mx, __shfl_xor(mx, 16)); mx = fmaxf(mx, __shfl_xor(mx, 32));
                    float sum = 0.f;
#pragma unroll
                    for (int c = 0; c < 8; ++c)
#pragma unroll
                        for (int tl = 0; tl < 2; ++tl)
#pragma unroll
                            for (int r = 0; r < 4; ++r) { const float e = __expf(sc[c][tl][r] - mx); sc[c][tl][r] = e; sum += e; }
                    sum += __shfl_xor(sum, 16); sum += __shfl_xor(sum, 32);
                    inv = 1.0f / sum;
                }
            } else {
                const int c = s - 8;
                v4u pw; pw.x = pg8::cvt_pk_bf16(sc[c][0][0], sc[c][0][1]); pw.y = pg8::cvt_pk_bf16(sc[c][0][2], sc[c][0][3]); pw.z = pg8::cvt_pk_bf16(sc[c][1][0], sc[c][1][1]); pw.w = pg8::cvt_pk_bf16(sc[c][1][2], sc[c][1][3]);
                const bf16x8 pf = __builtin_bit_cast(bf16x8, pw);
                v2u a[8];
                asm volatile("ds_read_b64_tr_b16 %0, %8 offset:%16\n\tds_read_b64_tr_b16 %1, %9 offset:%16\n\tds_read_b64_tr_b16 %2, %10 offset:%16\n\tds_read_b64_tr_b16 %3, %11 offset:%16\n\t"
                             "ds_read_b64_tr_b16 %4, %12 offset:%16\n\tds_read_b64_tr_b16 %5, %13 offset:%16\n\tds_read_b64_tr_b16 %6, %14 offset:%16\n\tds_read_b64_tr_b16 %7, %15 offset:%16\n\ts_waitcnt lgkmcnt(0)"
                             : "=&v"(a[0]), "=&v"(a[1]), "=&v"(a[2]), "=&v"(a[3]), "=&v"(a[4]), "=&v"(a[5]), "=&v"(a[6]), "=&v"(a[7])
                             : "v"(tra[0]), "v"(tra[1]), "v"(tra[2]), "v"(tra[3]), "v"(tra[4]), "v"(tra[5]), "v"(tra[6]), "v"(tra[7]), "n"((s & 3) * 4096) : "memory");
#pragma unroll
                for (int mt = 0; mt < 4; ++mt) {
                    v4u aw; aw.x = a[2 * mt].x; aw.y = a[2 * mt].y; aw.z = a[2 * mt + 1].x; aw.w = a[2 * mt + 1].y;
                    oacc[mt] = __builtin_amdgcn_mfma_f32_16x16x32_bf16(__builtin_bit_cast(bf16x8, aw), pf, oacc[mt], 0, 0, 0);
                }
            }
        }
#undef ATT_ISSUE
        if (hd < 4) {
            bf16* yo = YA + (size_t)tok * 512 + (kvh * 4 + hd) * 64 + kg * 4;
#pragma unroll
            for (int mt = 0; mt < 4; ++mt) { pg8::u32x2 w; w.x = pg8::cvt_pk_bf16(oacc[mt][0] * inv, oacc[mt][1] * inv); w.y = pg8::cvt_pk_bf16(oacc[mt][2] * inv, oacc[mt][3] * inv); *(GAS pg8::u32x2*)(yo + 16 * mt) = w; }
        }
        LDS_WAIT(); __builtin_amdgcn_wave_barrier();
    }
}

__device__ __forceinline__ void router_phase(Frame& F) {
    LAS float* HR = (LAS float*)(F.lds);
    LAS float* PT = (LAS float*)(F.lds + 65536);
    LAS int* LE = (LAS int*)(F.lds + 81920);
    LAS int* LP = (LAS int*)(F.lds + 82944);
    LAS unsigned* LC = (LAS unsigned*)(F.lds + 83968);
    const float* X1 = (const float*)(F.ws + WS_X1); bf16* H2 = (bf16*)(F.ws + WS_H2);
    const float* WR = F.in[I_WR]; const float* BR = F.in[I_BR]; const float* G2 = F.in[I_N2G];
    int* TOPE = (int*)(F.ws + WS_TOPE); float* TOPW = (float*)(F.ws + WS_TOPW); int* TOPPOS = (int*)(F.ws + WS_TOPPOS); int* ROWMAP = (int*)(F.ws + WS_ROWMAP);
    const int tid = F.tid, lane = F.lane, wave = F.wave, e = lane & 31, dh = lane >> 5;
    float wr[64];
#pragma unroll
    for (int i = 0; i < 64; ++i) wr[i] = WR[(size_t)(128 * wave + dh * 64 + i) * 32 + e];
    if (tid < 64) LC[tid] = 0u;
    const int tok0 = blockIdx.x * 64;
    for (int bt = 0; bt < 4; ++bt) {
        __syncthreads();
#pragma unroll
        for (int rr = 0; rr < 2; ++rr) { const int lr = 2 * wave + rr, tok = tok0 + bt * 16 + lr;
            const GAS f32x4* xr = (const GAS f32x4*)(X1 + (size_t)tok * DM) + lane; const GAS f32x4* gr = (const GAS f32x4*)G2 + lane;
            f32x4 v[4]; float s2 = 0.f;
#pragma unroll
            for (int j = 0; j < 4; ++j) { v[j] = xr[64 * j]; s2 += (v[j].x * v[j].x + v[j].y * v[j].y) + (v[j].z * v[j].z + v[j].w * v[j].w); }
            const float rstd = 1.0f / sqrtf(wave_sum(s2) * (1.f / DM) + RMS_EPS);
            GAS unsigned long long* o8 = (GAS unsigned long long*)(H2 + (size_t)tok * DM) + lane;
#pragma unroll
            for (int j = 0; j < 4; ++j) { const f32x4 gg = gr[64 * j]; const f32x4 h = v[j] * rstd * gg;
                *(LAS f32x4*)(HR + lr * 1024 + 256 * j + 4 * lane) = h;
                o8[64 * j] = (unsigned long long)pk2(h.x, h.y) | ((unsigned long long)pk2(h.z, h.w) << 32); } }
        __syncthreads();
#pragma unroll 2
        for (int lr = 0; lr < 16; ++lr) { const LAS float* hp = HR + lr * 1024 + 128 * wave + dh * 64; float s = 0.f;
#pragma unroll
            for (int i = 0; i < 16; ++i) { const f32x4 h = *(const LAS f32x4*)(hp + 4 * i); s += h[0] * wr[4 * i] + h[1] * wr[4 * i + 1] + h[2] * wr[4 * i + 2] + h[3] * wr[4 * i + 3]; }
            s += __shfl_xor(s, 32);
            if (dh == 0) PT[(lr * 8 + wave) * 32 + e] = s; }
        __syncthreads();
        { const int lr = 2 * wave + dh, tl = bt * 16 + lr, tok = tok0 + tl; float lg = BR[e];
#pragma unroll
          for (int w8 = 0; w8 < 8; ++w8) lg += PT[(lr * 8 + w8) * 32 + e];
          float cur = lg; float tv[4]; int te[4];
#pragma unroll
          for (int k = 0; k < 4; ++k) { float mv = cur; int mi = e;
#pragma unroll
              for (int o = 1; o < 32; o <<= 1) { const float ov = __shfl_xor(mv, o); const int oi = __shfl_xor(mi, o); if (ov > mv || (ov == mv && oi < mi)) { mv = ov; mi = oi; } }
              tv[k] = mv; te[k] = mi; if (e == mi) cur = -3.0e38f; }
          const float e1 = __expf(tv[1] - tv[0]), e2 = __expf(tv[2] - tv[0]), e3 = __expf(tv[3] - tv[0]); const float inv = 1.0f / (1.0f + e1 + e2 + e3);
          if (e < 4) { const int ex = (e == 0) ? te[0] : (e == 1) ? te[1] : (e == 2) ? te[2] : te[3]; const float wv = ((e == 0) ? 1.0f : (e == 1) ? e1 : (e == 2) ? e2 : e3) * inv;
              TOPE[(size_t)tok * 4 + e] = ex; TOPW[(size_t)tok * 4 + e] = wv; LE[tl * 4 + e] = ex; LP[tl * 4 + e] = (int)atomicAdd((unsigned*)&LC[ex], 1u); } }
    }
    __syncthreads();
    if (tid < 32) LC[32 + tid] = __hip_atomic_fetch_add((unsigned*)(F.ctl + CW_ECNT) + tid, LC[tid], RLX_AGENT);
    __syncthreads();
    if (tid < 256) { const int ex = LE[tid], pos = (int)LC[32 + ex] + LP[tid], tok = tok0 + (tid >> 2); TOPPOS[(size_t)tok * 4 + (tid & 3)] = pos; ROWMAP[(size_t)ex * NTOK + pos] = tok; }
}

__device__ __forceinline__ int moe_tables(Frame& F, LAS int* OFF, LAS int* TE) {
    __syncthreads();
    if (F.tid == 0) { int acc = 0; for (int e = 0; e < NEXP; ++e) { const int c = (int)__hip_atomic_load((unsigned*)(F.ctl + CW_ECNT) + e, RLX_AGENT); const int nt = (c + 255) >> 8; OFF[e] = acc * 256; OFF[33 + e] = c; for (int i = 0; i < nt; ++i) TE[acc + i] = e; acc += nt; } OFF[NEXP] = acc; }
    __syncthreads();
    return OFF[NEXP];
}
__device__ __forceinline__ void combine_phase(Frame& F) {
    LAS int* OFF = (LAS int*)(F.lds + MISC_OFF + 512); LAS int* TE = OFF + 72;
    (void)moe_tables(F, OFF, TE);
    const int* TOPE = (const int*)(F.ws + WS_TOPE); const int* TOPPOS = (const int*)(F.ws + WS_TOPPOS); const float* TOPW = (const float*)(F.ws + WS_TOPW);
    const float* X1 = (const float*)(F.ws + WS_X1); const bf16* Y2 = (const bf16*)(F.ws + WS_Y2); const float* GF = F.in[I_NFG];
    const int gw = blockIdx.x * NWAVES + F.wave, NGW = F.G * NWAVES, lane = F.lane;
    for (int tok = gw; tok < NTOK; tok += NGW) {
        f32x4 v[4];
#pragma unroll
        for (int j = 0; j < 4; ++j) v[j] = ((const GAS f32x4*)(X1 + (size_t)tok * DM) + lane)[64 * j];
#pragma unroll
        for (int k = 0; k < 4; ++k) { const int slot = OFF[TOPE[tok * 4 + k]] + TOPPOS[tok * 4 + k]; const float wk = TOPW[tok * 4 + k];
            const GAS v2u* yr = (const GAS v2u*)(Y2 + (size_t)slot * DM) + lane;
#pragma unroll
            for (int j = 0; j < 4; ++j) { const v2u y = yr[64 * j]; v[j].x += wk * bflo(y.x); v[j].y += wk * bfhi(y.x); v[j].z += wk * bflo(y.y); v[j].w += wk * bfhi(y.y); } }
        float s2 = 0.f;
#pragma unroll
        for (int j = 0; j < 4; ++j) s2 += (v[j].x * v[j].x + v[j].y * v[j].y) + (v[j].z * v[j].z + v[j].w * v[j].w);
        const float rstd = 1.0f / sqrtf(wave_sum(s2) * (1.f / DM) + RMS_EPS);
#pragma unroll
        for (int j = 0; j < 4; ++j) { const f32x4 gg = ((const GAS f32x4*)GF + lane)[64 * j]; ((GAS f32x4*)(F.out + (size_t)tok * DM) + lane)[64 * j] = v[j] * rstd * gg; }
    }
}

__device__ __forceinline__ void ubench(Frame& F) {
    bf16x8 a = (bf16x8){1, 2, 3, 4, 5, 6, 7, 8}, b = (bf16x8){8, 7, 6, 5, 4, 3, 2, 1}; a[0] = (short)F.lane;
    float sink = 0.f;
    if (PROBE_DUP == 900) { f32x16 c0 = {0.f, 0.f, 0.f, 0.f, 0.f, 0.f, 0.f, 0.f, 0.f, 0.f, 0.f, 0.f, 0.f, 0.f, 0.f, 0.f}, c1 = c0;
        for (int i = 0; i < 2000; ++i) { c0 = __builtin_amdgcn_mfma_f32_32x32x16_bf16(a, b, c0, 0, 0, 0); c1 = __builtin_amdgcn_mfma_f32_32x32x16_bf16(a, b, c1, 0, 0, 0); }
        sink = c0[0] + c1[5]; }
    if (PROBE_DUP == 901) { f32x4 c0 = {0.f, 0.f, 0.f, 0.f}, c1 = c0, c2 = c0, c3 = c0;
        for (int i = 0; i < 2000; ++i) { c0 = __builtin_amdgcn_mfma_f32_16x16x32_bf16(a, b, c0, 0, 0, 0); c1 = __builtin_amdgcn_mfma_f32_16x16x32_bf16(a, b, c1, 0, 0, 0); c2 = __builtin_amdgcn_mfma_f32_16x16x32_bf16(a, b, c2, 0, 0, 0); c3 = __builtin_amdgcn_mfma_f32_16x16x32_bf16(a, b, c3, 0, 0, 0); }
        sink = c0[0] + c1[1] + c2[2] + c3[3]; }
    if (PROBE_DUP == 902) { float x0 = F.lane, x1 = 1.f, x2 = 2.f, x3 = 3.f, x4 = 4.f, x5 = 5.f, x6 = 6.f, x7 = 7.f; const float m = 1.0001f, d = 0.5f;
        for (int i = 0; i < 4000; ++i) { x0 = x0 * m + d; x1 = x1 * m + d; x2 = x2 * m + d; x3 = x3 * m + d; x4 = x4 * m + d; x5 = x5 * m + d; x6 = x6 * m + d; x7 = x7 * m + d; }
        sink = x0 + x1 + x2 + x3 + x4 + x5 + x6 + x7; }
    if (PROBE_DUP == 903) {
        f32x4 c[4]; float s = 0.f; float wv[16];
#pragma unroll
        for (int i = 0; i < 4; ++i) c[i] = (f32x4){0.f, 0.f, 0.f, 0.f};
#pragma unroll
        for (int i = 0; i < 16; ++i) wv[i] = 0.001f * (i + F.lane);
        for (int it = 0; it < 275; ++it) { f32x4 d[4];
#pragma unroll
            for (int i = 0; i < 4; ++i) { d[i] = (f32x4){0.f, 0.f, 0.f, 0.f}; d[i] = __builtin_amdgcn_mfma_f32_16x16x32_bf16(a, b, d[i], 0, 0, 0); d[i] = __builtin_amdgcn_mfma_f32_16x16x32_bf16(b, a, d[i], 0, 0, 0); }
            float t = 0.f;
#pragma unroll
            for (int i = 0; i < 4; ++i)
#pragma unroll
                for (int r = 0; r < 4; ++r) { const float x = c[i][r]; const int xi = __builtin_bit_cast(int, x); const float m = __builtin_bit_cast(float, xi > 0 ? xi : 0); t += wv[4 * i + r] * m; }
            float u = t;
#pragma unroll
            for (int k = 0; k < 12; ++k) u = u * 1.0001f + 0.5f;
            s += u; a[1] = (short)(it + (int)s);
#pragma unroll
            for (int i = 0; i < 4; ++i) c[i] = d[i]; }
        sink = s; }
    if (sink == 123.456f) ((float*)(F.ws + WS_SBUF))[F.tid] = sink;
}

constexpr int NPHASE = 12;
struct Args { const float* in[25]; float* out; unsigned char* ws; int ph_lo, ph_hi; };
__global__ void __launch_bounds__(NTHR, 2) fwd_kernel(Args args) {
    extern __shared__ __attribute__((aligned(16))) unsigned char lds[];
    Frame F;
    F.lds = (LAS unsigned char*)lds;
    F.MISC = (volatile LAS unsigned*)(F.lds + MISC_OFF);
    F.tid = threadIdx.x; F.lane = F.tid & 63; F.wave = __builtin_amdgcn_readfirstlane(F.tid >> 6); F.G = gridDim.x;
    F.ws = args.ws; F.ctl = (gu32*)(args.ws + WS_CTL); F.out = args.out;
#pragma unroll
    for (int i = 0; i < 25; ++i) F.in[i] = args.in[i];
    for (int u = F.tid; u < 2048 / 4; u += NTHR) ((LAS unsigned*)(F.lds + MISC_OFF))[u] = 0u;
    __syncthreads();
    XcdBarrier bar; bar.bar = (unsigned*)(F.ctl + CW_BAR); bar.x = 0; bar.st = nullptr;
    if (MK_N_LAUNCHES == 1) bar = xcd_barrier_post((unsigned*)(F.ctl + CW_BAR), F.MISC + 8);
    const int lo = args.ph_lo, hi = args.ph_hi;
#define IN(k) (lo <= (k) && (k) < hi)
#define SEAM(k) do { if (IN(k) && IN((k) + 1)) xcd_barrier(bar); } while (0)
    unsigned char* ws = F.ws; const int c = (int)blockIdx.x;

#define BODY_P0 { p0_prologue(F); if (PROBE_DUP >= 900) ubench(F); }
#define BODY_P1 { pg8::Gemm g{(const bf16*)(ws + WS_XN), (const bf16*)(ws + WS_WIN), 1024, 1024, 1024}; StaticOrder S; S.init(NTOK / 256, NIN_PAD / 256, F.G, c); \
        EpiInProj E{ws, F.in[I_BGATE]}; pg8::gemm_phase<EpiInProj, StaticOrder>(F.lds, g, S, E); }
#define BODY_P2 { { pg8::Gemm g{(const bf16*)(ws + WS_UGX), (const bf16*)(ws + WS_WS), UGX_LD, 512, 512}; S5StateOrder S{c}; EpiS5State E{(float*)(ws + WS_SBUF)}; \
          pg8::gemm_phase<EpiS5State, S5StateOrder>(F.lds, g, S, E); if (PROBE_DUP == 202) { xcd_barrier(bar); pg8::gemm_phase<EpiS5State, S5StateOrder>(F.lds, g, S, E); } } idx_phase(F); if (PROBE_DUP == 102) { xcd_barrier(bar); idx_phase(F); } }
#define BODY_P3 { carry_phase(F); attn_phase(F); }
#define BODY_P4 { pg8::Gemm g{(const bf16*)(ws + WS_UGX), (const bf16*)(ws + WS_MT), UGX_LD, UGX_LD, 640}; S5YOrder S{c}; EpiS5Y E{(const bf16*)(ws + WS_UGX), F.in[I_SD], (bf16*)(ws + WS_YG)}; \
        pg8::gemm_phase<EpiS5Y, S5YOrder>(F.lds, g, S, E); }
#define BODY_P5 { pg8::Gemm g{(const bf16*)(ws + WS_YG), (const bf16*)(ws + WS_WGLU), 512, 512, 512}; StaticOrder S; S.init(NTOK / 256, 2, F.G, c); EpiGlu E{(const bf16*)(ws + WS_YG), F.in[I_BGLU], (bf16*)(ws + WS_YSSM)}; \
        pg8::gemm_phase<EpiGlu, StaticOrder>(F.lds, g, S, E); }
#define BODY_P6 { pg8::Gemm g{(const bf16*)(ws + WS_YSSM), (const bf16*)(ws + WS_WPS), 512, 512, 512}; MixOrder S; S.so.init(NTOK / 256, 4, F.G, c); \
        EpiMix E{(const bf16*)(ws + WS_GS), (const bf16*)(ws + WS_GA), (bf16*)(ws + WS_MIXED)}; pg8::gemm_phase<EpiMix, MixOrder>(F.lds, g, S, E); }
#define BODY_P7 { pg8::Gemm g{(const bf16*)(ws + WS_MIXED), (const bf16*)(ws + WS_WOUT), 1024, 1024, 1024}; StaticOrder S; S.init(NTOK / 256, 4, F.G, c); EpiOut E{F.in[I_X], (float*)(ws + WS_X1)}; \
        pg8::gemm_phase<EpiOut, StaticOrder>(F.lds, g, S, E); }
#define BODY_P8 { router_phase(F); }
#define BODY_P9 { LAS int* OFF = (LAS int*)(F.lds + MISC_OFF + 512); LAS int* TE = OFF + 72; const int TT = moe_tables(F, OFF, TE); \
        pg8::Gemm g{(const bf16*)(ws + WS_H2), (const bf16*)(ws + WS_WMI), 1024, 1024, 1024}; MoeOrder S{TE, OFF, OFF + 33, (const int*)(ws + WS_ROWMAP), TT, 8, c}; EpiMoe1 E{F.in[I_BMI], (bf16*)(ws + WS_ACT)}; \
        pg8::gemm_phase<EpiMoe1, MoeOrder>(F.lds, g, S, E); }
#define BODY_P10 { LAS int* OFF = (LAS int*)(F.lds + MISC_OFF + 512); LAS int* TE = OFF + 72; const int TT = moe_tables(F, OFF, TE); \
        pg8::Gemm g{(const bf16*)(ws + WS_ACT), (const bf16*)(ws + WS_WMO), 1024, 1024, 1024}; MoeOrder S{TE, OFF, OFF + 33, nullptr, TT, 4, c}; EpiMoe2 E{F.in[I_BMO], (bf16*)(ws + WS_Y2)}; \
        pg8::gemm_phase<EpiMoe2, MoeOrder>(F.lds, g, S, E); }
#define BODY_P11 { combine_phase(F); }
#define PHASE(k, BODY) if (IN(k)) { BODY if (PROBE_DUP == (k)) { xcd_barrier(bar); BODY } } SEAM(k);
    PHASE(0, BODY_P0) PHASE(1, BODY_P1) PHASE(2, BODY_P2) PHASE(3, BODY_P3) PHASE(4, BODY_P4) PHASE(5, BODY_P5) PHASE(6, BODY_P6)
    PHASE(7, BODY_P7) PHASE(8, BODY_P8) PHASE(9, BODY_P9) PHASE(10, BODY_P10) PHASE(11, BODY_P11)
#undef IN
#undef SEAM
}

extern "C" void kernel_launch(void* const* d_in, const int* in_sizes, int n_in, void* d_out, int out_size, void* d_ws, size_t ws_size, hipStream_t stream) {
    static int grid = 0;
    if (grid == 0) {
        if (n_in != 25 || out_size != NTOK * DM || ws_size < WS_END) { fprintf(stderr, "kernel_launch: unexpected problem (n_in %d out %d ws %zu)\n", n_in, out_size, ws_size); grid = -1; return; }
        if (hipFuncSetAttribute((const void*)fwd_kernel, hipFuncAttributeMaxDynamicSharedMemorySize, LDS_BYTES) != hipSuccess) { fprintf(stderr, "kernel_launch: hipFuncSetAttribute failed\n"); grid = -1; return; }
        int per_cu = 0; (void)hipOccupancyMaxActiveBlocksPerMultiprocessor(&per_cu, (const void*)fwd_kernel, NTHR, LDS_BYTES); (void)hipGetLastError();
        grid = 256;
    }
    if (grid < 0) return;
    (void)hipMemsetAsync((char*)d_ws + WS_CTL, 0, CTL_ZERO_BYTES, stream);
    Args a{};
    for (int i = 0; i < 25; ++i) a.in[i] = (const float*)d_in[i];
    a.out = (float*)d_out; a.ws = (unsigned char*)d_ws;
    if (MK_N_LAUNCHES == 1) { a.ph_lo = 0; a.ph_hi = NPHASE; hipLaunchKernelGGL(fwd_kernel, dim3(grid), dim3(NTHR), LDS_BYTES, stream, a); }
    else for (int p = 0; p < NPHASE; ++p) { a.ph_lo = p; a.ph_hi = p + 1; hipLaunchKernelGGL(fwd_kernel, dim3(grid), dim3(NTHR), LDS_BYTES, stream, a); }
}
```

```cpp
#include <hip/hip_runtime.h>
#include <cstdio>
#include <cstdint>

#ifndef MK_N_LAUNCHES
#define MK_N_LAUNCHES 1
#endif
#ifndef PROBE_DUP
#define PROBE_DUP -1
#endif
#ifndef PROBE_T
#define PROBE_T -1
#endif
#define TPROBE_BEGIN(id) unsigned long long tpb_##id = (PROBE_T == (id)) ? __builtin_amdgcn_s_memrealtime() : 0ull
#define TPROBE_END(id) do { if (PROBE_T == (id)) { const unsigned long long d_ = __builtin_amdgcn_s_memrealtime() - tpb_##id, t1_ = __builtin_amdgcn_s_memrealtime(); while (__builtin_amdgcn_s_memrealtime() - t1_ < 4ull * d_) __builtin_amdgcn_s_sleep(8); } } while (0)

namespace pg8 {
#define PG8_LAS __attribute__((address_space(3)))
typedef unsigned short bf16_t;
typedef short bf16x8 __attribute__((ext_vector_type(8)));
typedef float f32x4 __attribute__((ext_vector_type(4)));
typedef float f32x2 __attribute__((ext_vector_type(2)));
typedef unsigned u32x4 __attribute__((ext_vector_type(4)));
typedef unsigned u32x2 __attribute__((ext_vector_type(2)));
constexpr int BM = 256, BK = 64, HALF = 128, HTB = HALF * BK * 2, STAGE_BYTES = 8 * HTB, NXCD = 8, WGM = 8;

__host__ __device__ __forceinline__ int lds_byte(int r, int c) { const int st = (r >> 4) * 2 + (c >> 5), rr = r & 15, cc = c & 31, ob = rr * 64 + cc * 2; return st * 1024 + (ob ^ (((ob >> 9) & 1) << 5)); }
__host__ __device__ __forceinline__ void stage_rc(int b, int& R, int& C) { const int st = b / 1024, sb = b % 1024, swz = sb ^ (((sb >> 9) & 1) << 5); R = (st >> 1) * 16 + swz / 64; C = (st & 1) * 32 + (swz % 64) / 2; }
__host__ __device__ __forceinline__ int perm32(int rho) { const int n = rho >> 4, i = rho & 15; return 8 * (i >> 2) + 4 * n + (i & 3); }

struct Unit { int pm, pn, pa, pb, e; };
struct Gemm { const bf16_t* A; const bf16_t* Bt; int lda, ldb, K; };

__device__ __forceinline__ unsigned cvt_pk_bf16(float lo, float hi) { unsigned r; asm volatile("v_cvt_pk_bf16_f32 %0, %1, %2" : "=v"(r) : "v"(lo), "v"(hi)); return r; }
__device__ __forceinline__ u32x4 pack8(const f32x4& v0, const f32x4& v1) { u32x4 w; w.x = cvt_pk_bf16(v0[0], v0[1]); w.y = cvt_pk_bf16(v0[2], v0[3]); w.z = cvt_pk_bf16(v1[0], v1[1]); w.w = cvt_pk_bf16(v1[2], v1[3]); return w; }

template <class Epi, class Sched, bool ALIGN_EPI = true>
__device__ __forceinline__ void gemm_phase(PG8_LAS unsigned char* lds, const Gemm g, const Sched& S, const Epi& E) {
    const int tid = threadIdx.x, wid = __builtin_amdgcn_readfirstlane(tid >> 6), lane = tid & 63, wr = wid >> 2, wc = wid & 3, fr = lane & 15, fq = lane >> 4;
    const int K = g.K, nt = K / BK;
    unsigned voffB[2];
#pragma unroll
    for (int i = 0; i < 2; ++i) { int R, C; stage_rc(tid * 16 + i * 8192, R, C); const int Rb = (R & ~31) + perm32(R & 31);
        voffB[i] = (unsigned)(Rb * g.ldb + C) * 2u; }
    const size_t kstep = (size_t)(BK * 2);
    const size_t hstepB = (size_t)HALF * g.ldb * 2;
    const size_t tstepB = 2 * hstepB;
#define PG8_AROWS(VV, U) do { _Pragma("unroll") for (int i_ = 0; i_ < 2; ++i_) { int R_, C_; stage_rc((threadIdx.x & 511) * 16 + i_ * 8192, R_, C_); \
        _Pragma("unroll") for (int h_ = 0; h_ < 2; ++h_) VV[h_][i_] = (unsigned)(S.arow(U, h_, R_) * g.lda + C_) * 2u; } } while (0)
    unsigned vA[2][2], vAn[2][2];
    const unsigned ldsw = (unsigned)wid * 1024u;
    const int aoff = lds_byte(wr * 64 + fr, fq * 8), boff = lds_byte(wc * 32 + fr, fq * 8);
#define PG8_SA(b, h) (((b) * 2 + (h)) * HTB)
#define PG8_SB(b, h) ((4 + (b) * 2 + (h)) * HTB)
#define PG8_STAGE(bufoff, gbase, voff) do { _Pragma("unroll") for (int _i = 0; _i < 2; ++_i) \
        __builtin_amdgcn_global_load_lds((const unsigned*)((const char*)(gbase) + (voff)[_i]), (PG8_LAS unsigned*)(lds + (bufoff) + ldsw + _i * 8192), 16, 0, 0); } while (0)
#define PG8_LDA(dst, b, h) do { _Pragma("unroll") for (int m = 0; m < 4; ++m) _Pragma("unroll") for (int k = 0; k < 2; ++k) dst[m][k] = *(const PG8_LAS bf16x8*)(lds + PG8_SA(b, h) + aoff + m * 2048 + k * 1024); } while (0)
#define PG8_LDB(dst, b, h) do { _Pragma("unroll") for (int n = 0; n < 2; ++n) _Pragma("unroll") for (int k = 0; k < 2; ++k) dst[n][k] = *(const PG8_LAS bf16x8*)(lds + PG8_SB(b, h) + boff + n * 2048 + k * 1024); } while (0)
#define PG8_MMA(ai, bj, At, Bt) do { __builtin_amdgcn_s_setprio(1); _Pragma("unroll") for (int m = 0; m < 4; ++m) _Pragma("unroll") for (int n = 0; n < 2; ++n) _Pragma("unroll") for (int k = 0; k < 2; ++k) \
        acc[ai][bj][m][n] = __builtin_amdgcn_mfma_f32_16x16x32_bf16(Bt[n][k], At[m][k], acc[ai][bj][m][n], 0, 0, 0); __builtin_amdgcn_s_setprio(0); } while (0)
#define PG8_WAIT_V(n) asm volatile("s_waitcnt vmcnt(" #n ")" ::: "memory")
#define PG8_WAIT_L(n) asm volatile("s_waitcnt lgkmcnt(" #n ")" ::: "memory")
#define PG8_BAR __builtin_amdgcn_s_barrier()
#define PG8_SCHED __builtin_amdgcn_sched_barrier(0)
    Unit cur, nxt; int ui = 0;
    if (!S.next(0, cur)) return;
    f32x4 acc[2][2][4][2];
#pragma unroll
    for (int a = 0; a < 2; ++a)
#pragma unroll
        for (int b = 0; b < 2; ++b)
#pragma unroll
            for (int m = 0; m < 4; ++m)
#pragma unroll
                for (int n = 0; n < 2; ++n) acc[a][b][m][n] = (f32x4){0.f, 0.f, 0.f, 0.f};
    bf16x8 At[4][2], B0[2][2], B1[2][2];
    const char* const bA = (const char*)g.A; const char* cB = (const char*)g.Bt + (size_t)cur.pb * tstepB;
    PG8_AROWS(vA, cur);
    PG8_STAGE(PG8_SB(0, 0), cB, voffB); PG8_STAGE(PG8_SB(0, 1), cB + hstepB, voffB); PG8_STAGE(PG8_SA(0, 0), bA, vA[0]); PG8_STAGE(PG8_SA(0, 1), bA, vA[1]);
    if (wr == 1) PG8_BAR;
    PG8_WAIT_V(2); PG8_BAR;
    PG8_STAGE(PG8_SB(1, 0), cB + kstep, voffB); PG8_STAGE(PG8_SA(1, 0), bA + kstep, vA[0]); PG8_STAGE(PG8_SB(1, 1), cB + hstepB + kstep, voffB);
    PG8_WAIT_V(6); PG8_BAR;
    for (;;) {
        const bool has_next = S.next(ui + 1, nxt);
        const char* nB = has_next ? (const char*)g.Bt + (size_t)nxt.pb * tstepB : cB;
        if (has_next) PG8_AROWS(vAn, nxt); else { vAn[0][0] = vA[0][0]; vAn[0][1] = vA[0][1]; vAn[1][0] = vA[1][0]; vAn[1][1] = vA[1][1]; }
        for (int t = 0; t < nt; t += 2) {
            const bool last = (t == nt - 2);
            const char* a1 = bA + (size_t)(t + 1) * kstep;
            const char* a2 = last ? bA : bA + (size_t)(t + 2) * kstep; const char* b2 = last ? nB : cB + (size_t)(t + 2) * kstep;
            const char* a3 = a2 + kstep; const char* b3 = b2 + kstep;
            unsigned w0[2], w1[2];
            w0[0] = last ? vAn[0][0] : vA[0][0]; w0[1] = last ? vAn[0][1] : vA[0][1]; w1[0] = last ? vAn[1][0] : vA[1][0]; w1[1] = last ? vAn[1][1] : vA[1][1];
            PG8_LDB(B0, 0, 0); PG8_LDB(B1, 0, 1); PG8_SCHED; PG8_LDA(At, 0, 0); PG8_STAGE(PG8_SA(1, 1), a1, vA[1]);
            PG8_WAIT_V(8); PG8_WAIT_L(0); PG8_BAR; PG8_MMA(0, 0, At, B0); PG8_MMA(0, 1, At, B1); PG8_BAR; PG8_SCHED;
            PG8_LDA(At, 0, 1); PG8_STAGE(PG8_SB(0, 0), b2, voffB); PG8_STAGE(PG8_SB(0, 1), b2 + hstepB, voffB); PG8_STAGE(PG8_SA(0, 0), a2, w0);
            PG8_WAIT_V(8); PG8_WAIT_L(0); PG8_BAR; PG8_MMA(1, 0, At, B0); PG8_MMA(1, 1, At, B1); PG8_BAR; PG8_SCHED;
            PG8_LDB(B0, 1, 0); PG8_LDB(B1, 1, 1); PG8_SCHED; PG8_LDA(At, 1, 0); PG8_STAGE(PG8_SA(0, 1), a2, w1);
            PG8_WAIT_V(8); PG8_WAIT_L(0); PG8_BAR; PG8_MMA(0, 0, At, B0); PG8_MMA(0, 1, At, B1); PG8_BAR; PG8_SCHED;
            PG8_LDA(At, 1, 1); PG8_STAGE(PG8_SB(1, 0), b3, voffB); PG8_STAGE(PG8_SB(1, 1), b3 + hstepB, voffB); PG8_STAGE(PG8_SA(1, 0), a3, w0);
            PG8_WAIT_V(8); PG8_WAIT_L(0); PG8_BAR; PG8_MMA(1, 0, At, B0); PG8_MMA(1, 1, At, B1); PG8_BAR; PG8_SCHED;
        }
        if constexpr (ALIGN_EPI) { if (wr == 0) PG8_BAR; }
        E(acc, cur, wr, wc, fr, fq);
        if (!has_next) break;
#pragma unroll
        for (int a = 0; a < 2; ++a)
#pragma unroll
            for (int b = 0; b < 2; ++b)
#pragma unroll
                for (int m = 0; m < 4; ++m)
#pragma unroll
                    for (int n = 0; n < 2; ++n) acc[a][b][m][n] = (f32x4){0.f, 0.f, 0.f, 0.f};
        cur = nxt; cB = nB; ++ui; vA[0][0] = vAn[0][0]; vA[0][1] = vAn[0][1]; vA[1][0] = vAn[1][0]; vA[1][1] = vAn[1][1];
        if constexpr (ALIGN_EPI) { if (wr == 1) PG8_BAR; }
    }
    PG8_WAIT_V(0);
    if constexpr (!ALIGN_EPI) { if (wr == 0) PG8_BAR; }
    PG8_BAR;
#undef PG8_AROWS
#undef PG8_SA
#undef PG8_SB
#undef PG8_STAGE
#undef PG8_LDA
#undef PG8_LDB
#undef PG8_MMA
#undef PG8_WAIT_V
#undef PG8_WAIT_L
#undef PG8_BAR
#undef PG8_SCHED
}
}

constexpr int NB = 4, SEQ = 4096, NTOK = NB * SEQ, DM = 1024;
constexpr int NWAVES = 8, NTHR = 512;
constexpr int D_SSM = 512, NGRP = 32, NSTATE = 64, CH = 32  , NCH = SEQ / CH  , UGX_LD = 640, S5_ROWS = NB * NCH  ;
constexpr int NIN_PAD = 4608;
constexpr int NEXP = 32, TOPK_E = 4, DFF = 1024;
constexpr int NSEL = 256;
constexpr int MAX_MT = 288;
constexpr float RMS_EPS = 1e-5f;

constexpr size_t MiB = 1u << 20;
constexpr size_t WS_CTL = 0, CTL_ZERO_BYTES = 1 * MiB;
constexpr size_t WS_ROPE = 1 * MiB;
constexpr size_t WS_WIN = 2 * MiB;
constexpr size_t WS_WGLU = 11 * MiB;
constexpr size_t WS_WPS = 12 * MiB;
constexpr size_t WS_WPA = 13 * MiB;
constexpr size_t WS_WOUT = 14 * MiB;
constexpr size_t WS_MT = 16 * MiB;
constexpr size_t WS_WS = 36 * MiB;
constexpr size_t WS_A32 = 44 * MiB;
constexpr size_t WS_SBUF = 45 * MiB;
constexpr size_t WS_WI = 53 * MiB;
constexpr size_t WS_KI = 54 * MiB;
constexpr size_t WS_K = 56 * MiB;
constexpr size_t WS_V = 60 * MiB;
constexpr size_t WS_UGX = 64 * MiB;
constexpr size_t WS_Q = 84 * MiB;
constexpr size_t WS_QI = 100 * MiB;
constexpr size_t WS_GS = 132 * MiB;
constexpr size_t WS_GA = 164 * MiB;
constexpr size_t WS_XN = 196 * MiB;
constexpr size_t WS_YG = 228 * MiB;
constexpr size_t WS_YSSM = 244 * MiB;
constexpr size_t WS_YATT = 260 * MiB;
constexpr size_t WS_SEL = 276 * MiB;
constexpr size_t WS_MIXED = 284 * MiB;
constexpr size_t WS_X1 = 316 * MiB;
constexpr size_t WS_H2 = 380 * MiB;
constexpr size_t WS_TOPE = 412 * MiB;
constexpr size_t WS_TOPW = WS_TOPE + 256 * 1024;
constexpr size_t WS_TOPPOS = WS_TOPW + 256 * 1024;
constexpr size_t WS_ROWMAP = 413 * MiB;
constexpr size_t WS_WMI = 416 * MiB;
constexpr size_t WS_WMO = 544 * MiB;
constexpr size_t WS_ACT = 608 * MiB;
constexpr size_t WS_XP = 64 * MiB;
constexpr size_t WS_Y2 = 64 * MiB;
constexpr size_t WS_END = 752 * MiB;
static_assert(WS_XP + (size_t)MAX_MT * 256 * 1024 * 2 <= WS_YG, "XP overlay");
constexpr int CW_TMO = 0, CW_CODE = 1;
constexpr int CW_BAR = 4096;
constexpr int CW_ECNT = 16384;

constexpr int LDS_BYTES = 163840;
constexpr int MISC_OFF = 163840 - 2048;

#define GAS __attribute__((address_space(1)))
#define LAS __attribute__((address_space(3)))
typedef unsigned short bf16;
typedef unsigned short u16;
typedef unsigned v4u __attribute__((ext_vector_type(4)));
typedef unsigned v2u __attribute__((ext_vector_type(2)));
typedef float f32x4 __attribute__((ext_vector_type(4)));
typedef float f32x16 __attribute__((ext_vector_type(16)));
typedef short bf16x8 __attribute__((ext_vector_type(8)));
typedef GAS unsigned gu32;
#define RLX_AGENT __ATOMIC_RELAXED, __HIP_MEMORY_SCOPE_AGENT
#define LDS_WAIT() asm volatile("s_waitcnt lgkmcnt(0)" ::: "memory")
#define VM_WAIT() asm volatile("s_waitcnt vmcnt(0)" ::: "memory")
__device__ __forceinline__ unsigned f2bf(float f) { unsigned u = __builtin_bit_cast(unsigned, f); return (u + 0x7fffu + ((u >> 16) & 1u)) >> 16; }
__device__ __forceinline__ unsigned pk2(float lo, float hi) { return f2bf(lo) | (f2bf(hi) << 16); }
__device__ __forceinline__ float bf2f(unsigned b) { return __builtin_bit_cast(float, b << 16); }
__device__ __forceinline__ float bflo(unsigned w) { return __builtin_bit_cast(float, w << 16); }
__device__ __forceinline__ float bfhi(unsigned w) { return __builtin_bit_cast(float, w & 0xffff0000u); }
__device__ __forceinline__ float sigmoidf_(float x) { return 1.0f / (1.0f + __expf(-x)); }
__device__ __forceinline__ float gelu_tanh(float x) { const float u = 0.7978845608028654f * (x + 0.044715f * x * x * x); const float e = __expf(2.0f * u); const float t = 1.0f - 2.0f / (e + 1.0f); return 0.5f * x * (1.0f + t); }

#define XB_TMO      128
#define XB_XCNT(j)  (256  + 64 * (j))
#define XB_XSUB(j)  (1280 + 64 * (j))
#define XB_XGEN(j)  (2304 + 64 * (j))
#define XB_TOP      3328
#define XB_TOPGEN   3392
#define XCD_BAR_WORDS 3456
#define XB_SPIN_CAP (1u << 18)
__device__ __forceinline__ unsigned xb_ld(unsigned* p)              { return __hip_atomic_load(p, __ATOMIC_RELAXED, __HIP_MEMORY_SCOPE_AGENT); }
__device__ __forceinline__ unsigned xb_add(unsigned* p, unsigned v) { return __hip_atomic_fetch_add(p, v, __ATOMIC_RELAXED, __HIP_MEMORY_SCOPE_AGENT); }
__device__ __forceinline__ unsigned xb_xcc_id() { return (unsigned)__builtin_amdgcn_s_getreg((3 << 11) | 20) & 0xFu; }
#define XB_SPIN(cond, bar) do { unsigned _sp = 0; while (cond) { __builtin_amdgcn_s_sleep(1); \
    if ((++_sp & 255u) == 0u) { if (xb_ld(&(bar)[XB_TMO])) break; if (_sp > XB_SPIN_CAP) { atomicAdd(&(bar)[XB_TMO], 1u); break; } } } } while (0)
struct XcdBarrier { unsigned* bar; unsigned x; volatile LAS unsigned* st; };
__device__ __forceinline__ XcdBarrier xcd_barrier_post(unsigned* bar, volatile LAS unsigned* st) {
    XcdBarrier b; b.bar = bar; b.x = xb_xcc_id(); b.st = st;
    if (threadIdx.x == 0) (void)xb_add(&bar[XB_XCNT(b.x)], 1u);
    return b;
}
__device__ __forceinline__ void xcd_barrier_complete(unsigned* bar, unsigned x, unsigned& nloc, unsigned& nx) {
    const unsigned G = gridDim.x * gridDim.y * gridDim.z;
    unsigned sum, cnt, mine, sp = 0u;
    for (;;) {
        sum = 0u; cnt = 0u; mine = 0u;
#pragma unroll
        for (unsigned j = 0; j < 16; ++j) { const unsigned c = xb_ld(&bar[XB_XCNT(j)]); sum += c; cnt += (c > 0u) ? 1u : 0u; mine = (j == x) ? c : mine; }
        if (sum == G) break;
        __builtin_amdgcn_s_sleep(1);
        if ((++sp & 255u) == 0u) { if (xb_ld(&bar[XB_TMO])) break; if (sp > XB_SPIN_CAP) { atomicAdd(&bar[XB_TMO], 1u); break; } }
    }
    nloc = mine > 0u ? mine : 1u; nx = cnt > 0u ? cnt : 1u;
}
__device__ __forceinline__ void xcd_barrier(const XcdBarrier& b) {
    asm volatile("s_waitcnt vmcnt(0)" ::: "memory");
    __syncthreads();
    if (threadIdx.x == 0) {
        unsigned* bar = b.bar;
        __builtin_amdgcn_s_waitcnt(0);
        unsigned nloc = b.st[0], nx = b.st[1];
        if (nloc == 0u) { xcd_barrier_complete(bar, b.x, nloc, nx); b.st[0] = nloc; b.st[1] = nx; }
        const unsigned old = xb_add(&bar[XB_XSUB(b.x)], 1u);
        const unsigned gen = old / nloc;
        if (old + 1u == (gen + 1u) * nloc) {
            __builtin_amdgcn_fence(__ATOMIC_RELEASE, "agent");
            asm volatile("s_waitcnt vmcnt(0)" ::: "memory");
            const unsigned og = xb_add(&bar[XB_TOP], 1u);
            const unsigned tg = og / nx;
            if (og + 1u == (tg + 1u) * nx) xb_add(&bar[XB_TOPGEN], 1u);
            else XB_SPIN(xb_ld(&bar[XB_TOPGEN]) == tg, bar);
            __builtin_amdgcn_fence(__ATOMIC_ACQUIRE, "agent");
            xb_add(&bar[XB_XGEN(b.x)], 1u);
            asm volatile("s_waitcnt vmcnt(0)" ::: "memory");
        } else {
            XB_SPIN(xb_ld(&bar[XB_XGEN(b.x)]) == gen, bar);
            __builtin_amdgcn_fence(__ATOMIC_ACQUIRE, "agent");
            asm volatile("s_waitcnt vmcnt(0)" ::: "memory");
        }
    }
    __syncthreads();
}

struct Frame {
    LAS unsigned char* lds;
    volatile LAS unsigned* MISC;
    gu32* ctl;
    int tid, lane, wave, G;
    unsigned char* ws;
    const float* in[25];
    float* out;
};
enum { I_X = 0, I_N1G, I_WIN, I_BGATE, I_LRE, I_LIM, I_LOGDT, I_BRE, I_BIM, I_CRE, I_CIM, I_SD, I_WGLU, I_BGLU, I_WPS, I_WPA, I_WOUT, I_N2G, I_WR, I_BR, I_WMI, I_BMI, I_WMO, I_BMO, I_NFG };

__device__ __forceinline__ float wave_sum(float v) {
#pragma unroll
    for (int o = 1; o < 64; o <<= 1) v += __shfl_xor(v, o);
    return v;
}

__device__ __forceinline__ int ropeperm(int p) { const int a = p >> 3, bb = p & 7; return bb < 4 ? 4 * a + bb : 32 + 4 * a + (bb - 4); }
__device__ __forceinline__ int win_src(int nd) {
    const int pn = nd >> 8, j = nd & 255;
    if (pn < 2) return nd;
    if (pn < 4) { const int i = nd - 512; return 512 + (i & ~63) + ropeperm(i & 63); }
    if (pn == 4) { if (j < 128) return 1024 + (j & ~63) + ropeperm(j & 63); return 1152 + (j - 128); }
    if (pn < 9) { const int i = nd - 1280; return 1280 + (i & ~63) + ropeperm(i & 63); }
    if (pn == 9) { if (j < 64) return 2304 + ropeperm(j); if (j < 80) return 2368 + (j - 64); return -1; }
    if (pn < 14) return 2384 + (nd - 2560);
    return 3408 + (nd - 3584);
}
struct TItem { const float* src; bf16* dst; int N, K; };
__device__ __forceinline__ void titem_load(const TItem& T, float (&tv)[32], int lane) {
#pragma unroll
    for (int i = 0; i < 32; ++i) { const int kk = 2 * i + (lane >> 5); tv[i] = T.src ? __builtin_nontemporal_load(T.src + (size_t)kk * T.N) : 0.f; }
}
__device__ __forceinline__ void titem_store(const TItem& T, const float (&tv)[32], LAS float* scr, int lane) {
#pragma unroll
    for (int i = 0; i < 32; ++i) { const int kk = 2 * i + (lane >> 5); scr[kk * 33 + (lane & 31)] = tv[i]; }
    LDS_WAIT(); asm volatile("" ::: "memory");
    const int c = lane & 7;
#pragma unroll
    for (int j = 0; j < 4; ++j) { const int n = (lane >> 3) + 8 * j; const LAS float* s = scr + (8 * c) * 33 + n;
        v4u o; o.x = pk2(s[0 * 33], s[1 * 33]); o.y = pk2(s[2 * 33], s[3 * 33]); o.z = pk2(s[4 * 33], s[5 * 33]); o.w = pk2(s[6 * 33], s[7 * 33]);
        *(GAS v4u*)(T.dst + (size_t)n * T.K + 8 * c) = o; }
    LDS_WAIT(); asm volatile("" ::: "memory");
}
__device__ __forceinline__ void rms_row_to_bf16(int lane, const float* xrow, const float* g, bf16* orow) {
    const GAS f32x4* xr = (const GAS f32x4*)xrow + lane; const GAS f32x4* gr = (const GAS f32x4*)g + lane;
    f32x4 v[4]; float s2 = 0.f;
#pragma unroll
    for (int j = 0; j < 4; ++j) { v[j] = xr[64 * j]; s2 += (v[j].x * v[j].x + v[j].y * v[j].y) + (v[j].z * v[j].z + v[j].w * v[j].w); }
    const float rstd = 1.0f / sqrtf(wave_sum(s2) * (1.f / DM) + RMS_EPS);
    GAS unsigned long long* o8 = (GAS unsigned long long*)orow + lane;
#pragma unroll
    for (int j = 0; j < 4; ++j) { const f32x4 gg = gr[64 * j];
        o8[64 * j] = (unsigned long long)pk2(v[j].x * rstd * gg.x, v[j].y * rstd * gg.y) | ((unsigned long long)pk2(v[j].z * rstd * gg.z, v[j].w * rstd * gg.w) << 32); }
}
__device__ __forceinline__ void p0_s5_group(Frame& F, int g) {
    LAS float* AP = (LAS float*)(F.lds);
    LAS float* BB = (LAS float*)(F.lds + 16896);
    LAS float* CC = (LAS float*)(F.lds + 25088);
    LAS float* KJ = (LAS float*)(F.lds + 33280);
    const float* lre = F.in[I_LRE] + g * 64; const float* lim = F.in[I_LIM] + g * 64;
    const double dt = exp((double)F.in[I_LOGDT][g]);
    __syncthreads();
    for (int idx = F.tid; idx < 33 * 64; idx += NTHR) { const int p = idx & 63, j = idx >> 6;
        const double lr = lre[p], li = lim[p]; const double mag = exp(j * lr * dt), ang = j * li * dt;
        AP[idx * 2] = (float)(mag * cos(ang)); AP[idx * 2 + 1] = (float)(mag * sin(ang)); }
    for (int idx = F.tid; idx < 1024; idx += NTHR) { const int p = idx >> 4;
        const double lr = lre[p], li = lim[p]; const double mag = exp(lr * dt), ang = li * dt; const double ar = mag * cos(ang), ai = mag * sin(ang);
        const double nr = ar - 1.0, ni = ai, den = lr * lr + li * li; const double zr = (nr * lr + ni * li) / den, zi = (ni * lr - nr * li) / den;
        const double br = F.in[I_BRE][g * 1024 + idx], bi = F.in[I_BIM][g * 1024 + idx];
        BB[idx * 2] = (float)(zr * br - zi * bi); BB[idx * 2 + 1] = (float)(zr * bi + zi * br); }
    for (int idx = F.tid; idx < 1024; idx += NTHR) { CC[idx * 2] = F.in[I_CRE][g * 1024 + idx]; CC[idx * 2 + 1] = F.in[I_CIM][g * 1024 + idx]; }
    __syncthreads();
    for (int idx = F.tid; idx < 32 * 256; idx += NTHR) { const int j = idx >> 8, hp = (idx >> 4) & 15, h = idx & 15; float s = 0.f;
        for (int p = 0; p < 64; ++p) { const float cr = CC[(hp * 64 + p) * 2], ci = CC[(hp * 64 + p) * 2 + 1], ar = AP[(j * 64 + p) * 2], ai = AP[(j * 64 + p) * 2 + 1];
            const float er = cr * ar - ci * ai, ei = cr * ai + ci * ar; s += er * BB[(p * 16 + h) * 2] - ei * BB[(p * 16 + h) * 2 + 1]; }
        KJ[idx] = s; }
    __syncthreads();
    bf16* MT = (bf16*)(F.ws + WS_MT) + (size_t)g * 512 * 640;
    for (int ch = F.tid; ch < 512 * 80; ch += NTHR) { const int n = ch / 80, k0 = (ch % 80) * 8, tp = n >> 4, hp = n & 15; float v[8];
        if (k0 < 512) { const int sp = k0 >> 4, h0 = k0 & 15;
#pragma unroll
            for (int j = 0; j < 8; ++j) v[j] = (sp <= tp) ? KJ[((tp - sp) * 16 + hp) * 16 + h0 + j] : 0.f; }
        else { const bool im = k0 >= 576; const int p0 = k0 - (im ? 576 : 512);
#pragma unroll
            for (int j = 0; j < 8; ++j) { const int p = p0 + j; const float cr = CC[(hp * 64 + p) * 2], ci = CC[(hp * 64 + p) * 2 + 1], ar = AP[((tp + 1) * 64 + p) * 2], ai = AP[((tp + 1) * 64 + p) * 2 + 1];
                v[j] = im ? -(cr * ai + ci * ar) : (cr * ar - ci * ai); } }
        v4u o; o.x = pk2(v[0], v[1]); o.y = pk2(v[2], v[3]); o.z = pk2(v[4], v[5]); o.w = pk2(v[6], v[7]);
        *(GAS v4u*)(MT + (size_t)n * 640 + k0) = o; }
    bf16* WS = (bf16*)(F.ws + WS_WS) + (size_t)g * 256 * 512;
    for (int ch = F.tid; ch < 256 * 64; ch += NTHR) { const int n = ch >> 6, k0 = (ch & 63) * 8, sp = k0 >> 4, h0 = k0 & 15; float v[8];
#pragma unroll
        for (int j = 0; j < 8; ++j) { if (n < 128) { const int p = n & 63; const float ar = AP[((31 - sp) * 64 + p) * 2], ai = AP[((31 - sp) * 64 + p) * 2 + 1], br = BB[(p * 16 + h0 + j) * 2], bi = BB[(p * 16 + h0 + j) * 2 + 1];
                v[j] = (n < 64) ? (ar * br - ai * bi) : (ar * bi + ai * br); } else v[j] = 0.f; }
        v4u o; o.x = pk2(v[0], v[1]); o.y = pk2(v[2], v[3]); o.z = pk2(v[4], v[5]); o.w = pk2(v[6], v[7]);
        *(GAS v4u*)(WS + (size_t)n * 512 + k0) = o; }
    float* A32 = (float*)(F.ws + WS_A32) + g * 128;
    if (F.tid < 128) A32[F.tid] = AP[32 * 128 + F.tid];
    __syncthreads();
}
__device__ __forceinline__ void p0_prologue(Frame& F) {
    if ((int)blockIdx.x >= F.G - NGRP) p0_s5_group(F, (int)blockIdx.x - (F.G - NGRP));
    LAS float* scr = (LAS float*)(F.lds + F.wave * 16384);
    const int gw = blockIdx.x * NWAVES + F.wave, NGW = F.G * NWAVES;
    { float* cosT = (float*)(F.ws + WS_ROPE); float* sinT = cosT + SEQ * 32;
      for (int i = blockIdx.x * NTHR + F.tid; i < SEQ * 32; i += F.G * NTHR) { const int pos = i >> 5, k = i & 31;
          const double inv = pow(10000.0, -(double)k / 32.0); const double ang = (double)pos * (double)(float)inv;
          cosT[i] = (float)cos(ang); sinT[i] = (float)sin(ang); } }
    for (int m = gw; m < NTOK; m += NGW) rms_row_to_bf16(F.lane, F.in[I_X] + (size_t)m * DM, F.in[I_N1G], (bf16*)(F.ws + WS_XN) + (size_t)m * DM);
    constexpr int I_IN = 16 * (NIN_PAD / 32), I_GLU = 8 * 16, I_PS = 8 * 32, I_PA = 8 * 32, I_OUT = 16 * 32, I_MI1 = 16 * 64, I_MO1 = 16 * 32;
    constexpr int NITEMS = I_IN + I_GLU + I_PS + I_PA + I_OUT + NEXP * I_MI1 + NEXP * I_MO1;
    auto decode = [&](int it) -> TItem {
        int r = it; const float* W; bf16* WT; int K, N, ndb, map = 0;
        if (r < I_IN) { W = F.in[I_WIN]; K = DM; N = 4432; WT = (bf16*)(F.ws + WS_WIN); ndb = NIN_PAD / 32; map = 1; }
        else if ((r -= I_IN) < I_GLU) { W = F.in[I_WGLU]; K = 512; N = 512; WT = (bf16*)(F.ws + WS_WGLU); ndb = 16; }
        else if ((r -= I_GLU) < I_PS) { W = F.in[I_WPS]; K = 512; N = 1024; WT = (bf16*)(F.ws + WS_WPS); ndb = 32; }
        else if ((r -= I_PS) < I_PA) { W = F.in[I_WPA]; K = 512; N = 1024; WT = (bf16*)(F.ws + WS_WPA); ndb = 32; }
        else if ((r -= I_PA) < I_OUT) { W = F.in[I_WOUT]; K = 1024; N = 1024; WT = (bf16*)(F.ws + WS_WOUT); ndb = 32; }
        else if ((r -= I_OUT) < NEXP * I_MI1) { const int e = r / I_MI1; r -= e * I_MI1; W = F.in[I_WMI] + (size_t)e * 1024 * 2048; K = 1024; N = 2048; WT = (bf16*)(F.ws + WS_WMI) + (size_t)e * 2048 * 1024; ndb = 64; }
        else { r -= NEXP * I_MI1; const int e = r / I_MO1; r -= e * I_MO1; W = F.in[I_WMO] + (size_t)e * 1024 * 1024; K = 1024; N = 1024; WT = (bf16*)(F.ws + WS_WMO) + (size_t)e * 1024 * 1024; ndb = 32; }
        const int kb = r / ndb, nb = r % ndb, k0 = 64 * kb, n0 = 32 * nb; int sc = n0 + (F.lane & 31); if (map) sc = win_src(sc);
        TItem T; T.src = (sc >= 0) ? W + (size_t)k0 * N + sc : nullptr; T.dst = WT + (size_t)n0 * K + k0; T.N = N; T.K = K; return T; };
    { float tvA[32], tvB[32]; int it = gw;
      if (it < NITEMS) { TItem TA = decode(it); titem_load(TA, tvA, F.lane);
        for (;;) {
            const int it1 = it + NGW; const bool h1 = it1 < NITEMS; TItem TB = TA; if (h1) { TB = decode(it1); titem_load(TB, tvB, F.lane); }
            titem_store(TA, tvA, scr, F.lane); if (!h1) break;
            const int it2 = it1 + NGW; const bool h2 = it2 < NITEMS; if (h2) { TA = decode(it2); titem_load(TA, tvA, F.lane); }
            titem_store(TB, tvB, scr, F.lane); if (!h2) break;
            it = it2; } } }
}

struct StaticOrder {
    int nM, nN, nwg, G, c;
    __device__ void init(int nM_, int nN_, int G_, int c_) { nM = nM_; nN = nN_; nwg = nM * nN; G = G_; c = c_; }
    __device__ bool tile(int i, int& pm, int& pn) const {
        const long L = (long)i * G + c; if (L >= nwg) return false;
        int wgid = (int)L; { const int q = nwg / pg8::NXCD, r = nwg % pg8::NXCD, xcd = wgid % pg8::NXCD, off = wgid / pg8::NXCD; wgid = (xcd < r ? xcd * (q + 1) : r * (q + 1) + (xcd - r) * q) + off; }
        const int nig = pg8::WGM * nN, gid = wgid / nig, fm = gid * pg8::WGM, gsz = (nM - fm) < pg8::WGM ? (nM - fm) : pg8::WGM;
        pm = fm + ((wgid % nig) % gsz); pn = (wgid % nig) / gsz; return true;
    }
    __device__ bool next(int i, pg8::Unit& u) const { int pm, pn; if (!tile(i, pm, pn)) return false; u.pm = pm; u.pn = pn; u.pa = pm; u.pb = pn; u.e = 0; return true; }
    __device__ __forceinline__ int arow(const pg8::Unit& u, int h, int R) const { return u.pa * 256 + h * 128 + R; }
};
struct S5StateOrder {
    int c;
    __device__ bool next(int i, pg8::Unit& u) const { if (i > 0 || c >= 64) return false; const int g = c >> 1, pm = c & 1; u.pm = pm; u.pn = 0; u.pa = g * 2 + pm; u.pb = g; u.e = g; return true; }
    __device__ __forceinline__ int arow(const pg8::Unit& u, int h, int R) const { return u.pa * 256 + h * 128 + R; }
};
struct S5YOrder {
    int c;
    __device__ bool next(int i, pg8::Unit& u) const { if (i > 0 || c >= 128) return false; const int g = c >> 2, pm = (c >> 1) & 1, pn = c & 1; u.pm = pm; u.pn = pn; u.pa = g * 2 + pm; u.pb = g * 2 + pn; u.e = g; return true; }
    __device__ __forceinline__ int arow(const pg8::Unit& u, int h, int R) const { return u.pa * 256 + h * 128 + R; }
};
struct MixOrder {
    StaticOrder so;
    __device__ bool next(int i, pg8::Unit& u) const { int pm, pn; if (!so.tile(i >> 1, pm, pn)) return false; const int h = i & 1; u.pm = pm; u.pn = pn; u.pa = pm + 64 * h; u.pb = pn + 4 * h; u.e = h; return true; }
    __device__ __forceinline__ int arow(const pg8::Unit& u, int h, int R) const { return u.pa * 256 + h * 128 + R; }
};
struct MoeOrder {
    const volatile LAS int* te; const volatile LAS int* off; const volatile LAS int* cnt; const int* rowmap; int TT, NTN, c;
    __device__ bool next(int i, pg8::Unit& u) const {
        const int xcd = c & 7, j = c >> 3, mpx = 32 / NTN; const int mt = i * (8 * mpx) + xcd * mpx + j / NTN, pn = j % NTN;
        if (mt >= TT) return false; const int e = te[mt]; u.pm = mt; u.pn = pn; u.pa = mt; u.pb = e * NTN + pn; u.e = e; return true; }
    __device__ __forceinline__ int arow(const pg8::Unit& u, int h, int R) const {
        if (!rowmap) return u.pa * 256 + h * 128 + R;
        const int lr = u.pm * 256 - off[u.e] + h * 128 + R;
        return lr < cnt[u.e] ? rowmap[(size_t)u.e * NTOK + lr] : 0; }
};

using pg8::f32x2; using pg8::u32x2; using pg8::pack8; using pg8::cvt_pk_bf16;
#define EPI_ROWS_BEGIN _Pragma("unroll") for (int ai = 0; ai < 2; ++ai) _Pragma("unroll") for (int m = 0; m < 4; ++m) { asm volatile("" ::: "memory"); const int row = u.pm * 256 + ai * 128 + wr * 64 + m * 16 + fr; (void)row;
#define EPI_COLS_BEGIN _Pragma("unroll") for (int bj = 0; bj < 2; ++bj) { const int ct = bj * 128 + wc * 32 + fq * 8; (void)ct; f32x4 v0 = acc[ai][bj][m][0], v1 = acc[ai][bj][m][1];
#define EPI_END } }
struct EpiInProj {
    static constexpr bool PERM = true;
    unsigned char* ws; const float* bgate;
    __device__ __forceinline__ void rope(f32x4& v0, f32x4& v1, int pos, int a, float sc) const {
        const unsigned o = (unsigned)WS_ROPE + (unsigned)(pos * 32 + 4 * a) * 4u;
        const f32x4 c = *(const GAS f32x4*)(ws + o), s = *(const GAS f32x4*)(ws + o + (unsigned)(SEQ * 32 * 4));
        const f32x4 o1 = (v0 * c - v1 * s) * sc, o2 = (v1 * c + v0 * s) * sc; v0 = o1; v1 = o2;
    }
    __device__ __forceinline__ void store_rope(unsigned off, const f32x4& o1, const f32x4& o2) const {
        u32x2 a, b; a.x = cvt_pk_bf16(o1[0], o1[1]); a.y = cvt_pk_bf16(o1[2], o1[3]); b.x = cvt_pk_bf16(o2[0], o2[1]); b.y = cvt_pk_bf16(o2[2], o2[3]);
        *(GAS u32x2*)(ws + off) = a; *(GAS u32x2*)(ws + off + 64u) = b;
    }
    __device__ __forceinline__ void operator()(const f32x4 (&acc)[2][2][4][2], const pg8::Unit& u, int wr, int wc, int fr, int fq) const {
        const int pn = u.pn;
        if (pn < 2) {
            EPI_ROWS_BEGIN const int bb = row >> 12, cc = (row >> 5) & 127, sp = row & 31;
            EPI_COLS_BEGIN const int col = pn * 256 + ct, g = col >> 4, h0 = col & 15;
                *(GAS v4u*)(ws + ((unsigned)WS_UGX + (unsigned)((g * 512 + bb * 128 + cc) * UGX_LD + sp * 16 + h0) * 2u)) = pack8(v0, v1);
            EPI_END
        } else if (pn < 4) {
            EPI_ROWS_BEGIN const int pos = row & 4095;
            EPI_COLS_BEGIN const int j = (pn - 2) * 256 + ct, head = j >> 6, a = (j & 63) >> 3;
                rope(v0, v1, pos, a, 0.125f); store_rope((unsigned)WS_Q + (unsigned)(row * 512 + head * 64 + 4 * a) * 2u, v0, v1);
            EPI_END
        } else if (pn == 4) {
            EPI_ROWS_BEGIN const int pos = row & 4095;
            EPI_COLS_BEGIN
                if (bj == 0) { const int head = ct >> 6, a = (ct & 63) >> 3; rope(v0, v1, pos, a, 1.0f); store_rope((unsigned)WS_K + (unsigned)(row * 128 + head * 64 + 4 * a) * 2u, v0, v1); }
                else *(GAS v4u*)(ws + ((unsigned)WS_V + (unsigned)(row * 128 + (ct - 128)) * 2u)) = pack8(v0, v1);
            EPI_END
        } else if (pn < 9) {
            EPI_ROWS_BEGIN const int pos = row & 4095;
            EPI_COLS_BEGIN const int j = (pn - 5) * 256 + ct, head = j >> 6, a = (j & 63) >> 3;
                rope(v0, v1, pos, a, 1.0f); store_rope((unsigned)WS_QI + (unsigned)(row * 1024 + head * 64 + 4 * a) * 2u, v0, v1);
            EPI_END
        } else if (pn == 9) {
            EPI_ROWS_BEGIN const int pos = row & 4095;
            EPI_COLS_BEGIN
                if (bj == 0) { if (ct < 64) { const int a = ct >> 3; rope(v0, v1, pos, a, 1.0f); store_rope((unsigned)WS_KI + (unsigned)(row * 64 + 4 * a) * 2u, v0, v1); }
                    else if (ct < 80) { const unsigned o = (unsigned)WS_WI + (unsigned)(row * 16 + (ct - 64)) * 4u; *(GAS f32x4*)(ws + o) = v0 * 0.03125f; *(GAS f32x4*)(ws + o + 16u) = v1 * 0.03125f; } }
            EPI_END
        } else {
            const int br = pn >= 14; const unsigned gbase = br ? (unsigned)WS_GA : (unsigned)WS_GS; const float* bgp = bgate + br * 1024;
            EPI_ROWS_BEGIN
            EPI_COLS_BEGIN const int col = (pn - (br ? 14 : 10)) * 256 + ct;
                const f32x4 b0 = *(const GAS f32x4*)(bgp + col), b1 = *(const GAS f32x4*)(bgp + col + 4);
#pragma unroll
                for (int j = 0; j < 4; ++j) { v0[j] = sigmoidf_(v0[j] + b0[j]); v1[j] = sigmoidf_(v1[j] + b1[j]); }
                *(GAS v4u*)(ws + (gbase + (unsigned)(row * 1024 + col) * 2u)) = pack8(v0, v1);
            EPI_END
        }
    }
};
struct EpiS5State {
    static constexpr bool PERM = true;
    float* SB;
    __device__ __forceinline__ void operator()(const f32x4 (&acc)[2][2][4][2], const pg8::Unit& u, int wr, int wc, int fr, int fq) const {
        EPI_ROWS_BEGIN
        EPI_COLS_BEGIN
            if (bj == 0) { float* d = SB + ((size_t)u.e * 512 + row) * 128 + ct; *(GAS f32x4*)d = v0; *(GAS f32x4*)(d + 4) = v1; }
        EPI_END
    }
};
struct EpiS5Y {
    static constexpr bool PERM = true;
    const bf16* UGX; const float* Dsk; bf16* YG;
    __device__ __forceinline__ void operator()(const f32x4 (&acc)[2][2][4][2], const pg8::Unit& u, int wr, int wc, int fr, int fq) const {
        const int g = u.e;
        EPI_ROWS_BEGIN const int bb = row >> 7, cc = row & 127;
        EPI_COLS_BEGIN const int n = u.pn * 256 + ct, tp = n >> 4, h0 = n & 15;
            const v4u uu = *(const GAS v4u*)(UGX + ((size_t)g * 512 + row) * UGX_LD + n);
            const f32x4 d0 = *(const GAS f32x4*)(Dsk + g * 16 + h0), d1 = *(const GAS f32x4*)(Dsk + g * 16 + h0 + 4);
            v0[0] += d0[0] * bflo(uu.x); v0[1] += d0[1] * bfhi(uu.x); v0[2] += d0[2] * bflo(uu.y); v0[3] += d0[3] * bfhi(uu.y);
            v1[0] += d1[0] * bflo(uu.z); v1[1] += d1[1] * bfhi(uu.z); v1[2] += d1[2] * bflo(uu.w); v1[3] += d1[3] * bfhi(uu.w);
#pragma unroll
            for (int j = 0; j < 4; ++j) { v0[j] = gelu_tanh(v0[j]); v1[j] = gelu_tanh(v1[j]); }
            const int tok = bb * 4096 + cc * 32 + tp;
            *(GAS v4u*)(YG + (size_t)tok * 512 + g * 16 + h0) = pack8(v0, v1);
        EPI_END
    }
};
struct EpiGlu {
    static constexpr bool PERM = true;
    const bf16* YG; const float* bglu; bf16* YS;
    __device__ __forceinline__ void operator()(const f32x4 (&acc)[2][2][4][2], const pg8::Unit& u, int wr, int wc, int fr, int fq) const {
        EPI_ROWS_BEGIN
        EPI_COLS_BEGIN const int col = u.pn * 256 + ct;
            const v4u yy = *(const GAS v4u*)(YG + (size_t)row * 512 + col);
            const f32x4 b0 = *(const GAS f32x4*)(bglu + col), b1 = *(const GAS f32x4*)(bglu + col + 4);
            v0[0] = bflo(yy.x) * sigmoidf_(v0[0] + b0[0]); v0[1] = bfhi(yy.x) * sigmoidf_(v0[1] + b0[1]); v0[2] = bflo(yy.y) * sigmoidf_(v0[2] + b0[2]); v0[3] = bfhi(yy.y) * sigmoidf_(v0[3] + b0[3]);
            v1[0] = bflo(yy.z) * sigmoidf_(v1[0] + b1[0]); v1[1] = bfhi(yy.z) * sigmoidf_(v1[1] + b1[1]); v1[2] = bflo(yy.w) * sigmoidf_(v1[2] + b1[2]); v1[3] = bfhi(yy.w) * sigmoidf_(v1[3] + b1[3]);
            *(GAS v4u*)(YS + (size_t)row * 512 + col) = pack8(v0, v1);
        EPI_END
    }
};
struct EpiMix {
    static constexpr bool PERM = true;
    const bf16* GS; const bf16* GA; bf16* MX;
    __device__ __forceinline__ void operator()(const f32x4 (&acc)[2][2][4][2], const pg8::Unit& u, int wr, int wc, int fr, int fq) const {
        const bf16* Gp = u.e ? GA : GS;
        EPI_ROWS_BEGIN
        EPI_COLS_BEGIN const size_t off = (size_t)row * 1024 + u.pn * 256 + ct;
            const v4u gg = *(const GAS v4u*)(Gp + off);
            v0[0] *= bflo(gg.x); v0[1] *= bfhi(gg.x); v0[2] *= bflo(gg.y); v0[3] *= bfhi(gg.y); v1[0] *= bflo(gg.z); v1[1] *= bfhi(gg.z); v1[2] *= bflo(gg.w); v1[3] *= bfhi(gg.w);
            if (u.e) { const v4u pp = *(const GAS v4u*)(MX + off);
                v0[0] += bflo(pp.x); v0[1] += bfhi(pp.x); v0[2] += bflo(pp.y); v0[3] += bfhi(pp.y); v1[0] += bflo(pp.z); v1[1] += bfhi(pp.z); v1[2] += bflo(pp.w); v1[3] += bfhi(pp.w); }
            *(GAS v4u*)(MX + off) = pack8(v0, v1);
        EPI_END
    }
};
struct EpiOut {
    static constexpr bool PERM = true;
    const float* X; float* X1;
    __device__ __forceinline__ void operator()(const f32x4 (&acc)[2][2][4][2], const pg8::Unit& u, int wr, int wc, int fr, int fq) const {
        EPI_ROWS_BEGIN
        EPI_COLS_BEGIN const size_t off = (size_t)row * 1024 + u.pn * 256 + ct;
            const f32x4 x0 = *(const GAS f32x4*)(X + off), x1 = *(const GAS f32x4*)(X + off + 4);
            *(GAS f32x4*)(X1 + off) = v0 + x0; *(GAS f32x4*)(X1 + off + 4) = v1 + x1;
        EPI_END
    }
};
struct EpiMoe1 {
    static constexpr bool PERM = true;
    const float* bmi; bf16* ACT;
    __device__ __forceinline__ void operator()(const f32x4 (&acc)[2][2][4][2], const pg8::Unit& u, int wr, int wc, int fr, int fq) const {
        const float* bp = bmi + (size_t)u.e * 2048;
        EPI_ROWS_BEGIN
        EPI_COLS_BEGIN const int col = u.pn * 256 + ct;
            const f32x4 b0 = *(const GAS f32x4*)(bp + col), b1 = *(const GAS f32x4*)(bp + col + 4);
            v0 += b0; v1 += b1; float o[4];
#pragma unroll
            for (int j = 0; j < 4; ++j) { const float zg0 = (j < 2) ? v0[2 * j] : v1[2 * j - 4], zl0 = (j < 2) ? v0[2 * j + 1] : v1[2 * j - 3];
                const float zg = fminf(zg0, 7.0f), zl = fminf(fmaxf(zl0, -7.0f), 7.0f); o[j] = zg * sigmoidf_(1.702f * zg) * (zl + 1.0f); }
            u32x2 w; w.x = cvt_pk_bf16(o[0], o[1]); w.y = cvt_pk_bf16(o[2], o[3]);
            *(GAS u32x2*)(ACT + (size_t)row * 1024 + (col >> 1)) = w;
        EPI_END
    }
};
struct EpiMoe2 {
    static constexpr bool PERM = true;
    const float* bmo; bf16* Y2;
    __device__ __forceinline__ void operator()(const f32x4 (&acc)[2][2][4][2], const pg8::Unit& u, int wr, int wc, int fr, int fq) const {
        const float* bp = bmo + (size_t)u.e * 1024;
        EPI_ROWS_BEGIN
        EPI_COLS_BEGIN const int col = u.pn * 256 + ct;
            const f32x4 b0 = *(const GAS f32x4*)(bp + col), b1 = *(const GAS f32x4*)(bp + col + 4);
            v0 += b0; v1 += b1;
            *(GAS v4u*)(Y2 + (size_t)row * 1024 + col) = pack8(v0, v1);
        EPI_END
    }
};

__device__ __forceinline__ unsigned f16key(unsigned bits) { return (bits & 0x8000u) ? (bits ^ 0xffffu) : (bits | 0x8000u); }
__device__ __forceinline__ void idx_phase(Frame& F) {
    LAS unsigned char* lds = F.lds;
    LAS u16* SC = (LAS u16*)lds;
    LAS unsigned char* KT = lds + 65536;
    LAS unsigned* HP = (LAS unsigned*)(lds + 147456);
    LAS unsigned char* OLB = lds + 147456 + 4096;
    const bf16* QI = (const bf16*)(F.ws + WS_QI); const bf16* KI = (const bf16*)(F.ws + WS_KI); const float* WI = (const float*)(F.ws + WS_WI);
    u16* SEL = (u16*)(F.ws + WS_SEL);
    const int tid = F.tid, lane = F.lane, wave = F.wave, qg = wave & 1, kq = wave >> 1, kgrp = lane >> 4, l15 = lane & 15;
    const int kx = l15 >> 1, cpos = lane & 7;
    const int dsw = ((wave & 1) * 4 + (lane >> 4)) & 7;
    bf16x8 qa[4][2]; float w[16];
#define IDX_UNIT(r_, b_, t0_) const int b_ = (r_) >> 1, t0_ = (((r_) & 1) ? 511 - (int)blockIdx.x : (int)blockIdx.x) * 8
#define IDX_DMA(kb_, st, bufi) do { _Pragma("unroll") for (int j_ = 0; j_ < 2; ++j_) { const int row_ = (j_ * 8 + wave) * 8 + (lane >> 3); \
        __builtin_amdgcn_global_load_lds((const unsigned*)((kb_) + ((size_t)(st) * 128 + row_) * 64 + ((cpos ^ dsw) << 3)), (LAS unsigned*)(KT + (bufi) * 16384 + (j_ * 8 + wave) * 1024), 16, 0, 0); } } while (0)
#define IDX_PREFETCH(r_) do { IDX_UNIT(r_, pb_, pt0_); if (pt0_ >= 256) { \
        const bf16* qp_ = QI + ((size_t)pb_ * SEQ + pt0_ + 4 * qg + (l15 >> 2)) * 1024 + (l15 & 3) * 64 + kgrp * 8; \
        _Pragma("unroll") for (int i = 0; i < 4; ++i) _Pragma("unroll") for (int ks = 0; ks < 2; ++ks) qa[i][ks] = *(const GAS bf16x8*)(qp_ + i * 256 + ks * 32); \
        const float* wp_ = WI + ((size_t)pb_ * SEQ + pt0_ + 4 * qg + kgrp) * 16; \
        _Pragma("unroll") for (int i = 0; i < 4; ++i) { const f32x4 x = *(const GAS f32x4*)(wp_ + 4 * i); w[4 * i] = x[0]; w[4 * i + 1] = x[1]; w[4 * i + 2] = x[2]; w[4 * i + 3] = x[3]; } \
        const bf16* pk_ = KI + (size_t)pb_ * SEQ * 64; const int pn_ = (pt0_ + 7) / 128 + 1; \
        IDX_DMA(pk_, 0, 0); if (1 < pn_) IDX_DMA(pk_, 1, 1); if (2 < pn_) IDX_DMA(pk_, 2, 2); if (3 < pn_) IDX_DMA(pk_, 3, 3); } } while (0)
    IDX_PREFETCH(0);
    for (int r = 0; r < 8; ++r) {
        IDX_UNIT(r, b, t0);
        __syncthreads();
        const int t = t0 + wave; const size_t tok = (size_t)b * SEQ + t;
        if (t0 < 256) {
            v2u x; const int k0 = lane * 4;
            x.x = (unsigned)(k0 <= t ? k0 : 0) | ((unsigned)(k0 + 1 <= t ? k0 + 1 : 0) << 16); x.y = (unsigned)(k0 + 2 <= t ? k0 + 2 : 0) | ((unsigned)(k0 + 3 <= t ? k0 + 3 : 0) << 16);
            *(GAS v2u*)(SEL + tok * NSEL + k0) = x;
            if (r + 1 < 8) IDX_PREFETCH(r + 1);
            continue;
        }
        HP[tid * 2] = 0u; HP[tid * 2 + 1] = 0u;
        const int nst = (t0 + 7) / 128 + 1;
        const int tq = t0 + 4 * qg + kgrp, qrow = 4 * qg + kgrp;
        const bf16* kbat = KI + (size_t)b * SEQ * 64;
        const unsigned hpq = (unsigned)(unsigned long)(HP + qrow * 128);
#define IDX_EPI1(kgl_, AC) do { float s0 = 0.f; \
            _Pragma("unroll") for (int i = 0; i < 4; ++i) _Pragma("unroll") for (int r_ = 0; r_ < 4; ++r_) { const float a0_ = AC[i][r_]; const int i0 = __builtin_bit_cast(int, a0_); const float m0 = __builtin_bit_cast(float, i0 > 0 ? i0 : 0); s0 += w[4 * i + r_] * m0; } \
            const _Float16 h0_ = (_Float16)s0; const unsigned key0_ = f16key(__builtin_bit_cast(unsigned short, h0_)); const int kg0 = (kgl_); \
            SC[qrow * 4096 + kg0] = (u16)key0_; \
            if (kg0 <= tq) { const unsigned bin = key0_ >> 8; const unsigned ha_ = hpq + ((bin >> 1) << 2), hv_ = (bin & 1u) ? 0x10000u : 1u; \
                asm volatile("ds_add_u32 %0, %1" :: "v"(ha_), "v"(hv_) : "memory"); } } while (0)
#define IDX_READ(BQ, kt2) do { _Pragma("unroll") for (int ks = 0; ks < 2; ++ks) BQ[ks] = *(const LAS bf16x8*)(kb + (kq * 32 + (kt2) * 16 + l15) * 128 + (((ks * 4 + kgrp) ^ kx) << 4)); } while (0)
#define IDX_MMA(AC, BQ) do { _Pragma("unroll") for (int i = 0; i < 4; ++i) { AC[i] = (f32x4){0.f, 0.f, 0.f, 0.f}; _Pragma("unroll") for (int ks = 0; ks < 2; ++ks) AC[i] = __builtin_amdgcn_mfma_f32_16x16x32_bf16(qa[i][ks], BQ[ks], AC[i], 0, 0, 0); } } while (0)
        bf16x8 bq0[2], bq1[2];
        f32x4 aA[4], aB[4];
#pragma unroll
        for (int i = 0; i < 4; ++i) { aA[i] = (f32x4){0.f, 0.f, 0.f, 0.f}; aB[i] = aA[i]; }
        int bcur = 0, bnew = 4;
        TPROBE_BEGIN(100);
        for (int st = 0; st < nst; ++st) {
            if (st + 3 < nst) asm volatile("s_waitcnt vmcnt(6)" ::: "memory"); else asm volatile("s_waitcnt vmcnt(0)" ::: "memory");
            __syncthreads();
            if (st + 4 < nst) IDX_DMA(kbat, st + 4, bnew);
            const LAS unsigned char* kb = KT + bcur * 16384;
            const int kbase_ = st * 128 + kq * 32 + l15;
            IDX_READ(bq0, 0);
            IDX_READ(bq1, 1); IDX_MMA(aA, bq0); if (st >= 1) IDX_EPI1(kbase_ - 128 + 16, aB);
            IDX_MMA(aB, bq1); IDX_EPI1(kbase_, aA);
            bcur = (bcur == 4) ? 0 : bcur + 1; bnew = (bnew == 4) ? 0 : bnew + 1;
        }
        IDX_EPI1((nst - 1) * 128 + kq * 32 + l15 + 16, aB);
#undef IDX_EPI1
#undef IDX_MMA
#undef IDX_READ
        __syncthreads();
        TPROBE_END(100);
        TPROBE_BEGIN(101);
        TPROBE_BEGIN(110);
        if (r + 1 < 8) IDX_PREFETCH(r + 1);
        const int n = t + 1, jj = lane, ql = wave;
        const LAS u16* sc = SC + ql * 4096;
        LAS unsigned* hp = HP + ql * 128;
        unsigned b1, need1;
        { const v2u wv = *(const LAS v2u*)(hp + 126 - 2 * jj); unsigned hb[4];
          hb[3] = wv.x & 0xffffu; hb[2] = wv.x >> 16; hb[1] = wv.y & 0xffffu; hb[0] = wv.y >> 16;
          const unsigned s4 = hb[0] + hb[1] + hb[2] + hb[3];
          unsigned pre = s4;
#pragma unroll
          for (int o = 1; o < 64; o <<= 1) { const unsigned x = __shfl_up(pre, o, 64); if (jj >= o) pre += x; }
          const unsigned long long bal = __ballot(pre >= 256u); const int js = __builtin_ctzll(bal);
          unsigned above = pre - s4, bb1 = 0, nd1 = 0; bool found = false;
#pragma unroll
          for (int i = 0; i < 4; ++i) { if (!found) { if (above + hb[i] >= 256u) { bb1 = 255 - (jj * 4 + i); nd1 = 256u - above; found = true; } else above += hb[i]; } }
          b1 = __shfl(bb1, js); need1 = __shfl(nd1, js); }
        TPROBE_END(110);
        TPROBE_BEGIN(111);
        LDS_WAIT(); __builtin_amdgcn_wave_barrier();
#define LDS_ST32(addr_, val_) asm volatile("ds_write_b32 %0, %1" :: "v"((unsigned)(addr_)), "v"((unsigned)(val_)) : "memory")
#define LDS_ST16(addr_, val_) asm volatile("ds_write_b16 %0, %1" :: "v"((unsigned)(addr_)), "v"((unsigned)(val_)) : "memory")
#define LDS_ADD32(addr_, val_) asm volatile("ds_add_u32 %0, %1" :: "v"((unsigned)(addr_)), "v"((unsigned)(val_)) : "memory")
        const unsigned hpw = (unsigned)(unsigned long)hp, scw = (unsigned)(unsigned long)sc;
        LDS_ST32(hpw + jj * 8, 0u); LDS_ST32(hpw + jj * 8 + 4, 0u);
        const int nit = (n + 511) >> 9;
        { const int base = (nit - 1) * 512 + jj * 8;
#pragma unroll
          for (int e = 0; e < 8; ++e) if (base + e >= n) LDS_ST16(scw + (base + e) * 2, 0u); }
        LDS_WAIT(); __builtin_amdgcn_wave_barrier();
        const unsigned B1 = b1 | (b1 << 16);
#pragma unroll 4
        for (int it = 0; it < nit; ++it) { const int base = it * 512 + jj * 8; const v4u x = *(const LAS v4u*)(sc + base);
#pragma unroll
            for (int i = 0; i < 4; ++i) { const unsigned d = (i == 0) ? x.x : (i == 1) ? x.y : (i == 2) ? x.z : x.w; const unsigned m = ((d >> 8) & 0x00ff00ffu) ^ B1;
                const unsigned l0 = d & 255u, l1 = (d >> 16) & 255u;
                LDS_ADD32(hpw + ((l0 >> 1) << 2), ((m & 0xffffu) == 0u) ? ((l0 & 1u) ? 0x10000u : 1u) : 0u);
                LDS_ADD32(hpw + ((l1 >> 1) << 2), ((m >> 16) == 0u) ? ((l1 & 1u) ? 0x10000u : 1u) : 0u); } }
        LDS_WAIT(); __builtin_amdgcn_wave_barrier();
        TPROBE_END(111);
        TPROBE_BEGIN(112);
        unsigned T, need2;
        { const v2u wv = *(const LAS v2u*)(hp + 126 - 2 * jj); unsigned hb[4];
          hb[3] = wv.x & 0xffffu; hb[2] = wv.x >> 16; hb[1] = wv.y & 0xffffu; hb[0] = wv.y >> 16;
          const unsigned s4 = hb[0] + hb[1] + hb[2] + hb[3];
          unsigned pre = s4;
#pragma unroll
          for (int o = 1; o < 64; o <<= 1) { const unsigned x = __shfl_up(pre, o, 64); if (jj >= o) pre += x; }
          const unsigned long long bal = __ballot(pre >= need1); const int js = __builtin_ctzll(bal);
          unsigned above = pre - s4, bb2 = 0, nd2 = 0; bool found = false;
#pragma unroll
          for (int i = 0; i < 4; ++i) { if (!found) { if (above + hb[i] >= need1) { bb2 = 255 - (jj * 4 + i); nd2 = need1 - above; found = true; } else above += hb[i]; } }
          const unsigned b2 = __shfl(bb2, js); need2 = __shfl(nd2, js); T = (b1 << 8) | b2; }
        TPROBE_END(112);
        TPROBE_BEGIN(113);
        const unsigned olw = (unsigned)(unsigned long)(OLB + ql * 512);
        const unsigned G = 256u - need2, Tp = T | (T << 16); unsigned cg = 0, tc = 0;
#pragma unroll 2
        for (int it = 0; it < nit; ++it) { const int base = it * 512 + jj * 8; const v4u x = *(const LAS v4u*)(sc + base);
            unsigned g[8], c = 0, anyeq = 0;
#pragma unroll
            for (int i = 0; i < 4; ++i) { const unsigned d = (i == 0) ? x.x : (i == 1) ? x.y : (i == 2) ? x.z : x.w;
                g[2 * i] = ((d & 0xffffu) > T) ? 1u : 0u; g[2 * i + 1] = ((d >> 16) > T) ? 1u : 0u; c += g[2 * i] + g[2 * i + 1];
                const unsigned q = d ^ Tp; anyeq |= (((q & 0xffffu) == 0u) || ((q >> 16) == 0u)) ? 1u : 0u; }
            const unsigned long long m0 = __ballot(c & 1u), m1 = __ballot(c & 2u), m2 = __ballot(c & 4u), m3 = __ballot(c & 8u);
            unsigned pos = cg + __builtin_amdgcn_mbcnt_hi((unsigned)(m0 >> 32), __builtin_amdgcn_mbcnt_lo((unsigned)m0, 0u)) + 2u * __builtin_amdgcn_mbcnt_hi((unsigned)(m1 >> 32), __builtin_amdgcn_mbcnt_lo((unsigned)m1, 0u))
                         + 4u * __builtin_amdgcn_mbcnt_hi((unsigned)(m2 >> 32), __builtin_amdgcn_mbcnt_lo((unsigned)m2, 0u)) + 8u * __builtin_amdgcn_mbcnt_hi((unsigned)(m3 >> 32), __builtin_amdgcn_mbcnt_lo((unsigned)m3, 0u));
            cg += (unsigned)__builtin_popcountll(m0) + 2u * (unsigned)__builtin_popcountll(m1) + 4u * (unsigned)__builtin_popcountll(m2) + 8u * (unsigned)__builtin_popcountll(m3);
#pragma unroll
            for (int e = 0; e < 8; ++e) { const unsigned a_ = olw + ((pos < 256u ? pos : 255u) << 1); if (g[e]) LDS_ST16(a_, base + e); pos += g[e]; }
            if (__ballot(anyeq) != 0ull) {
#pragma unroll
                for (int e = 0; e < 8; ++e) { const unsigned wd = (e < 2) ? x.x : (e < 4) ? x.y : (e < 6) ? x.z : x.w; const unsigned k = (e & 1) ? (wd >> 16) : (wd & 0xffffu);
                    const bool eq = k == T; const unsigned long long me = __ballot(eq);
                    const unsigned pe = tc + __builtin_amdgcn_mbcnt_hi((unsigned)(me >> 32), __builtin_amdgcn_mbcnt_lo((unsigned)me, 0u));
                    if (eq && pe < need2) LDS_ST16(olw + ((G + pe) << 1), base + e);
                    tc += (unsigned)__builtin_popcountll(me); } } }
#undef LDS_ST32
#undef LDS_ST16
#undef LDS_ADD32
        LDS_WAIT(); __builtin_amdgcn_wave_barrier();
        { const v2u x = *(const LAS v2u*)((LAS u16*)(OLB + ql * 512) + jj * 4); *(GAS v2u*)(SEL + tok * NSEL + jj * 4) = x; }
        TPROBE_END(113);
        TPROBE_END(101);
    }
#undef IDX_DMA
#undef IDX_PREFETCH
#undef IDX_UNIT
}

__device__ __forceinline__ void carry_phase(Frame& F) {
    const int gid = blockIdx.x * NTHR + F.tid; if (gid >= NGRP * NB * 64) return;
    const int p = gid & 63, b = (gid >> 6) & 3, g = gid >> 8;
    const float* A32 = (const float*)(F.ws + WS_A32) + g * 128; const float ar = A32[p * 2], ai = A32[p * 2 + 1];
    const float* SB = (const float*)(F.ws + WS_SBUF) + ((size_t)g * 512 + b * 128) * 128; bf16* UX = (bf16*)(F.ws + WS_UGX) + ((size_t)g * 512 + b * 128) * UGX_LD;
    float xr = 0.f, xi = 0.f;
    for (int c = 0; c < NCH; ++c) {
        UX[(size_t)c * UGX_LD + 512 + p] = (bf16)f2bf(xr); UX[(size_t)c * UGX_LD + 576 + p] = (bf16)f2bf(xi);
        const float sr = SB[c * 128 + p], si = SB[c * 128 + 64 + p];
        const float nr = ar * xr - ai * xi + sr, ni = ar * xi + ai * xr + si; xr = nr; xi = ni;
    }
}

template <int N> __device__ __forceinline__ void wait_vm() { asm volatile("s_waitcnt vmcnt(%0)" :: "n"(N) : "memory"); }
typedef short s16x4 __attribute__((ext_vector_type(4)));
__device__ __forceinline__ void attn_phase(Frame& F) {
    constexpr int WSTR = 20224;
    LAS unsigned char* RING = F.lds + F.wave * WSTR;
    LAS u16* SL = (LAS u16*)(RING + 16384);
    const bf16* Q = (const bf16*)(F.ws + WS_Q); const bf16* Kg = (const bf16*)(F.ws + WS_K); const bf16* Vg = (const bf16*)(F.ws + WS_V);
    const u16* SEL = (const u16*)(F.ws + WS_SEL); bf16* YA = (bf16*)(F.ws + WS_YATT);
    const int lane = F.lane, gw = blockIdx.x * NWAVES + F.wave, NGW = F.G * NWAVES;
    const int hd = lane & 15, kg = lane >> 4;
    const int l8 = lane >> 3, cpos = lane & 7;
    unsigned tra[8];
    { const int q4 = hd >> 2, p4 = hd & 3; const unsigned rb = (unsigned)(unsigned long)RING;
#pragma unroll
      for (int mt = 0; mt < 4; ++mt)
#pragma unroll
          for (int tl = 0; tl < 2; ++tl) { const int row = tl * 16 + kg * 4 + q4, cc = 2 * mt + (p4 >> 1), pos = cc ^ (2 * ((row >> 1) & 3)); tra[2 * mt + tl] = rb + row * 128 + pos * 16 + (p4 & 1) * 8; } }
    for (int it = gw; it < NTOK * 2; it += NGW) {
        const int tok = it >> 1, kvh = it & 1, t = tok & 4095; const size_t bbase = (size_t)(tok >> 12) * SEQ;
        const int nsel = (t + 1 < NSEL) ? t + 1 : NSEL;
        { const v2u x = *(const GAS v2u*)(SEL + (size_t)tok * NSEL + lane * 4); *(LAS v2u*)(SL + lane * 4) = x; }
        bf16x8 qf[2];
#pragma unroll
        for (int ks = 0; ks < 2; ++ks) { if (hd < 4) qf[ks] = *(const GAS bf16x8*)(Q + (size_t)tok * 512 + (kvh * 4 + hd) * 64 + ks * 32 + kg * 8); else qf[ks] = (bf16x8){0, 0, 0, 0, 0, 0, 0, 0}; }
        asm volatile("s_waitcnt vmcnt(0)" : "+v"(qf[0]), "+v"(qf[1]) :: "memory");
        LDS_WAIT(); __builtin_amdgcn_wave_barrier();
        const bf16* kbp = Kg + bbase * 128 + kvh * 64; const bf16* vbp = Vg + bbase * 128 + kvh * 64;
        f32x4 sc[8][2]; f32x4 oacc[4];
#pragma unroll
        for (int c = 0; c < 8; ++c) { sc[c][0] = (f32x4){0.f, 0.f, 0.f, 0.f}; sc[c][1] = (f32x4){0.f, 0.f, 0.f, 0.f}; }
#pragma unroll
        for (int m = 0; m < 4; ++m) oacc[m] = (f32x4){0.f, 0.f, 0.f, 0.f};
        float inv = 1.0f;
#define ATT_ISSUE(s) do { const int c_ = (s) & 7; const bool isk_ = (s) < 8; const bf16* gb_ = isk_ ? kbp : vbp; int sel_[4]; \
            _Pragma("unroll") for (int j_ = 0; j_ < 4; ++j_) { const int ki_ = c_ * 32 + j_ * 8 + l8; sel_[j_] = (int)SL[ki_ < nsel ? ki_ : 0]; } \
            _Pragma("unroll") for (int j_ = 0; j_ < 4; ++j_) { const int f_ = isk_ ? ((j_ & 1) * 4 + (lane >> 4)) : (2 * (lane >> 4)); \
                __builtin_amdgcn_global_load_lds((const unsigned*)(gb_ + (size_t)sel_[j_] * 128 + ((cpos ^ f_) << 3)), (LAS unsigned*)(RING + ((s) & 3) * 4096 + j_ * 1024), 16, 0, 0); } } while (0)
        ATT_ISSUE(0); ATT_ISSUE(1); ATT_ISSUE(2);
#pragma unroll
        for (int s = 0; s < 16; ++s) {
            if (s + 3 < 16) ATT_ISSUE(s + 3);
            if (s <= 12) wait_vm<12>(); else if (s == 13) wait_vm<8>(); else if (s == 14) wait_vm<4>(); else wait_vm<0>();
            const LAS unsigned char* buf = RING + (s & 3) * 4096;
            if (s < 8) {
#pragma unroll
                for (int tl = 0; tl < 2; ++tl)
#pragma unroll
                    for (int ks = 0; ks < 2; ++ks) { const bf16x8 af = *(const LAS bf16x8*)(buf + (tl * 16 + hd) * 128 + (((ks * 4 + kg) ^ (hd >> 1)) << 4));
                        sc[s][tl] = __builtin_amdgcn_mfma_f32_16x16x32_bf16(af, qf[ks], sc[s][tl], 0, 0, 0); }
                if (s == 7) {
                    float mx = -3.0e38f;
#pragma unroll
                    for (int c = 0; c < 8; ++c)
#pragma unroll
                        for (int tl = 0; tl < 2; ++tl)
#pragma unroll
                            for (int r = 0; r < 4; ++r) { const int key = c * 32 + tl * 16 + kg * 4 + r; const float v = (key < nsel) ? sc[c][tl][r] : -3.0e38f; sc[c][tl][r] = v; mx = fmaxf(mx, v); }
                    mx = fmaxf(mx, __shfl_xor(mx, 16)); mx = fmaxf(mx, __shfl_xor(mx, 32));
                    float sum = 0.f;
#pragma unroll
                    for (int c = 0; c < 8; ++c)
#pragma unroll
                        for (int tl = 0; tl < 2; ++tl)
#pragma unroll
                            for (int r = 0; r < 4; ++r) { const float e = __expf(sc[c][tl][r] - mx); sc[c][tl][r] = e; sum += e; }
                    sum += __shfl_xor(sum, 16); sum += __shfl_xor(sum, 32);
                    inv = 1.0f / sum;
                }
            } else {
                const int c = s - 8;
                v4u pw; pw.x = pg8::cvt_pk_bf16(sc[c][0][0], sc[c][0][1]); pw.y = pg8::cvt_pk_bf16(sc[c][0][2], sc[c][0][3]); pw.z = pg8::cvt_pk_bf16(sc[c][1][0], sc[c][1][1]); pw.w = pg8::cvt_pk_bf16(sc[c][1][2], sc[c][1][3]);
                const bf16x8 pf = __builtin_bit_cast(bf16x8, pw);
                v2u a[8];
                asm volatile("ds_read_b64_tr_b16 %0, %8 offset:%16\n\tds_read_b64_tr_b16 %1, %9 offset:%16\n\tds_read_b64_tr_b16 %2, %10 offset:%16\n\tds_read_b64_tr_b16 %3, %11 offset:%16\n\t"
                             "ds_read_b64_tr_b16 %4, %12 offset:%16\n\tds_read_b64_tr_b16 %5, %13 offset:%16\n\tds_read_b64_tr_b16 %6, %14 offset:%16\n\tds_read_b64_tr_b16 %7, %15 offset:%16\n\ts_waitcnt lgkmcnt(0)"
                             : "=&v"(a[0]), "=&v"(a[1]), "=&v"(a[2]), "=&v"(a[3]), "=&v"(a[4]), "=&v"(a[5]), "=&v"(a[6]), "=&v"(a[7])
                             : "v"(tra[0]), "v"(tra[1]), "v"(tra[2]), "v"(tra[3]), "v"(tra[4]), "v"(tra[5]), "v"(tra[6]), "v"(tra[7]), "n"((s & 3) * 4096) : "memory");
#pragma unroll
                for (int mt = 0; mt < 4; ++mt) {
                    v4u aw; aw.x = a[2 * mt].x; aw.y = a[2 * mt].y; aw.z = a[2 * mt + 1].x; aw.w = a[2 * mt + 1].y;
                    oacc[mt] = __builtin_amdgcn_mfma_f32_16x16x32_bf16(__builtin_bit_cast(bf16x8, aw), pf, oacc[mt], 0, 0, 0);
                }
            }
        }
#undef ATT_ISSUE
        if (hd < 4) {
            bf16* yo = YA + (size_t)tok * 512 + (kvh * 4 + hd) * 64 + kg * 4;
#pragma unroll
            for (int mt = 0; mt < 4; ++mt) { pg8::u32x2 w; w.x = pg8::cvt_pk_bf16(oacc[mt][0] * inv, oacc[mt][1] * inv); w.y = pg8::cvt_pk_bf16(oacc[mt][2] * inv, oacc[mt][3] * inv); *(GAS pg8::u32x2*)(yo + 16 * mt) = w; }
        }
        LDS_WAIT(); __builtin_amdgcn_wave_barrier();
    }
}

__device__ __forceinline__ void router_phase(Frame& F) {
    LAS float* HR = (LAS float*)(F.lds);
    LAS float* PT = (LAS float*)(F.lds + 65536);
    LAS int* LE = (LAS int*)(F.lds + 81920);
    LAS int* LP = (LAS int*)(F.lds + 82944);
    LAS unsigned* LC = (LAS unsigned*)(F.lds + 83968);
    const float* X1 = (const float*)(F.ws + WS_X1); bf16* H2 = (bf16*)(F.ws + WS_H2);
    const float* WR = F.in[I_WR]; const float* BR = F.in[I_BR]; const float* G2 = F.in[I_N2G];
    int* TOPE = (int*)(F.ws + WS_TOPE); float* TOPW = (float*)(F.ws + WS_TOPW); int* TOPPOS = (int*)(F.ws + WS_TOPPOS); int* ROWMAP = (int*)(F.ws + WS_ROWMAP);
    const int tid = F.tid, lane = F.lane, wave = F.wave, e = lane & 31, dh = lane >> 5;
    float wr[64];
#pragma unroll
    for (int i = 0; i < 64; ++i) wr[i] = WR[(size_t)(128 * wave + dh * 64 + i) * 32 + e];
    if (tid < 64) LC[tid] = 0u;
    const int tok0 = blockIdx.x * 64;
    f32x4 nv[2][4];
#pragma unroll
    for (int rr = 0; rr < 2; ++rr)
#pragma unroll
        for (int j = 0; j < 4; ++j) nv[rr][j] = ((const GAS f32x4*)(X1 + (size_t)(tok0 + 2 * wave + rr) * DM) + lane)[64 * j];
    for (int bt = 0; bt < 4; ++bt) {
        __syncthreads();
#pragma unroll
        for (int rr = 0; rr < 2; ++rr) { const int lr = 2 * wave + rr, tok = tok0 + bt * 16 + lr;
            const GAS f32x4* gr = (const GAS f32x4*)G2 + lane;
            f32x4 v[4]; float s2 = 0.f;
#pragma unroll
            for (int j = 0; j < 4; ++j) { v[j] = nv[rr][j]; s2 += (v[j].x * v[j].x + v[j].y * v[j].y) + (v[j].z * v[j].z + v[j].w * v[j].w); }
            const float rstd = 1.0f / sqrtf(wave_sum(s2) * (1.f / DM) + RMS_EPS);
            GAS unsigned long long* o8 = (GAS unsigned long long*)(H2 + (size_t)tok * DM) + lane;
#pragma unroll
            for (int j = 0; j < 4; ++j) { const f32x4 gg = gr[64 * j]; const f32x4 h = v[j] * rstd * gg;
                *(LAS f32x4*)(HR + lr * 1024 + 256 * j + 4 * lane) = h;
                o8[64 * j] = (unsigned long long)pk2(h.x, h.y) | ((unsigned long long)pk2(h.z, h.w) << 32); } }
        if (bt + 1 < 4) {
#pragma unroll
            for (int rr = 0; rr < 2; ++rr)
#pragma unroll
                for (int j = 0; j < 4; ++j) nv[rr][j] = ((const GAS f32x4*)(X1 + (size_t)(tok0 + (bt + 1) * 16 + 2 * wave + rr) * DM) + lane)[64 * j];
        }
        __syncthreads();
#pragma unroll 2
        for (int lr = 0; lr < 16; ++lr) { const LAS float* hp = HR + lr * 1024 + 128 * wave + dh * 64; float s = 0.f;
#pragma unroll
            for (int i = 0; i < 16; ++i) { const f32x4 h = *(const LAS f32x4*)(hp + 4 * i); s += h[0] * wr[4 * i] + h[1] * wr[4 * i + 1] + h[2] * wr[4 * i + 2] + h[3] * wr[4 * i + 3]; }
            s += __shfl_xor(s, 32);
            if (dh == 0) PT[(lr * 8 + wave) * 32 + e] = s; }
        __syncthreads();
        { const int lr = 2 * wave + dh, tl = bt * 16 + lr, tok = tok0 + tl; float lg = BR[e];
#pragma unroll
          for (int w8 = 0; w8 < 8; ++w8) lg += PT[(lr * 8 + w8) * 32 + e];
          float cur = lg; float tv[4]; int te[4];
#pragma unroll
          for (int k = 0; k < 4; ++k) { float mv = cur; int mi = e;
#pragma unroll
              for (int o = 1; o < 32; o <<= 1) { const float ov = __shfl_xor(mv, o); const int oi = __shfl_xor(mi, o); if (ov > mv || (ov == mv && oi < mi)) { mv = ov; mi = oi; } }
              tv[k] = mv; te[k] = mi; if (e == mi) cur = -3.0e38f; }
          const float e1 = __expf(tv[1] - tv[0]), e2 = __expf(tv[2] - tv[0]), e3 = __expf(tv[3] - tv[0]); const float inv = 1.0f / (1.0f + e1 + e2 + e3);
          if (e < 4) { const int ex = (e == 0) ? te[0] : (e == 1) ? te[1] : (e == 2) ? te[2] : te[3]; const float wv = ((e == 0) ? 1.0f : (e == 1) ? e1 : (e == 2) ? e2 : e3) * inv;
              TOPE[(size_t)tok * 4 + e] = ex; TOPW[(size_t)tok * 4 + e] = wv; LE[tl * 4 + e] = ex; LP[tl * 4 + e] = (int)atomicAdd((unsigned*)&LC[ex], 1u); } }
    }
    __syncthreads();
    if (tid < 32) LC[32 + tid] = __hip_atomic_fetch_add((unsigned*)(F.ctl + CW_ECNT) + tid, LC[tid], RLX_AGENT);
    __syncthreads();
    if (tid < 256) { const int ex = LE[tid], pos = (int)LC[32 + ex] + LP[tid], tok = tok0 + (tid >> 2); TOPPOS[(size_t)tok * 4 + (tid & 3)] = pos; ROWMAP[(size_t)ex * NTOK + pos] = tok; }
}

__device__ __forceinline__ int moe_tables(Frame& F, LAS int* OFF, LAS int* TE) {
    __syncthreads();
    if (F.tid == 0) { int acc = 0; for (int e = 0; e < NEXP; ++e) { const int c = (int)__hip_atomic_load((unsigned*)(F.ctl + CW_ECNT) + e, RLX_AGENT); const int nt = (c + 255) >> 8; OFF[e] = acc * 256; OFF[33 + e] = c; for (int i = 0; i < nt; ++i) TE[acc + i] = e; acc += nt; } OFF[NEXP] = acc; }
    __syncthreads();
    return OFF[NEXP];
}
__device__ __forceinline__ void combine_phase(Frame& F) {
    LAS int* OFF = (LAS int*)(F.lds + MISC_OFF + 512); LAS int* TE = OFF + 72;
    (void)moe_tables(F, OFF, TE);
    const int* TOPE = (const int*)(F.ws + WS_TOPE); const int* TOPPOS = (const int*)(F.ws + WS_TOPPOS); const float* TOPW = (const float*)(F.ws + WS_TOPW);
    const float* X1 = (const float*)(F.ws + WS_X1); const bf16* Y2 = (const bf16*)(F.ws + WS_Y2); const float* GF = F.in[I_NFG];
    const int gw = blockIdx.x * NWAVES + F.wave, NGW = F.G * NWAVES, lane = F.lane;
    for (int tok = gw; tok < NTOK; tok += NGW) {
        f32x4 v[4];
#pragma unroll
        for (int j = 0; j < 4; ++j) v[j] = ((const GAS f32x4*)(X1 + (size_t)tok * DM) + lane)[64 * j];
#pragma unroll
        for (int k = 0; k < 4; ++k) { const int slot = OFF[TOPE[tok * 4 + k]] + TOPPOS[tok * 4 + k]; const float wk = TOPW[tok * 4 + k];
            const GAS v2u* yr = (const GAS v2u*)(Y2 + (size_t)slot * DM) + lane;
#pragma unroll
            for (int j = 0; j < 4; ++j) { const v2u y = yr[64 * j]; v[j].x += wk * bflo(y.x); v[j].y += wk * bfhi(y.x); v[j].z += wk * bflo(y.y); v[j].w += wk * bfhi(y.y); } }
        float s2 = 0.f;
#pragma unroll
        for (int j = 0; j < 4; ++j) s2 += (v[j].x * v[j].x + v[j].y * v[j].y) + (v[j].z * v[j].z + v[j].w * v[j].w);
        const float rstd = 1.0f / sqrtf(wave_sum(s2) * (1.f / DM) + RMS_EPS);
#pragma unroll
        for (int j = 0; j < 4; ++j) { const f32x4 gg = ((const GAS f32x4*)GF + lane)[64 * j]; ((GAS f32x4*)(F.out + (size_t)tok * DM) + lane)[64 * j] = v[j] * rstd * gg; }
    }
}

__device__ __forceinline__ void ubench(Frame& F) {
    bf16x8 a = (bf16x8){1, 2, 3, 4, 5, 6, 7, 8}, b = (bf16x8){8, 7, 6, 5, 4, 3, 2, 1}; a[0] = (short)F.lane;
    float sink = 0.f;
    if (PROBE_DUP == 900) { f32x16 c0 = {0.f, 0.f, 0.f, 0.f, 0.f, 0.f, 0.f, 0.f, 0.f, 0.f, 0.f, 0.f, 0.f, 0.f, 0.f, 0.f}, c1 = c0;
        for (int i = 0; i < 2000; ++i) { c0 = __builtin_amdgcn_mfma_f32_32x32x16_bf16(a, b, c0, 0, 0, 0); c1 = __builtin_amdgcn_mfma_f32_32x32x16_bf16(a, b, c1, 0, 0, 0); }
        sink = c0[0] + c1[5]; }
    if (PROBE_DUP == 901) { f32x4 c0 = {0.f, 0.f, 0.f, 0.f}, c1 = c0, c2 = c0, c3 = c0;
        for (int i = 0; i < 2000; ++i) { c0 = __builtin_amdgcn_mfma_f32_16x16x32_bf16(a, b, c0, 0, 0, 0); c1 = __builtin_amdgcn_mfma_f32_16x16x32_bf16(a, b, c1, 0, 0, 0); c2 = __builtin_amdgcn_mfma_f32_16x16x32_bf16(a, b, c2, 0, 0, 0); c3 = __builtin_amdgcn_mfma_f32_16x16x32_bf16(a, b, c3, 0, 0, 0); }
        sink = c0[0] + c1[1] + c2[2] + c3[3]; }
    if (PROBE_DUP == 902) { float x0 = F.lane, x1 = 1.f, x2 = 2.f, x3 = 3.f, x4 = 4.f, x5 = 5.f, x6 = 6.f, x7 = 7.f; const float m = 1.0001f, d = 0.5f;
        for (int i = 0; i < 4000; ++i) { x0 = x0 * m + d; x1 = x1 * m + d; x2 = x2 * m + d; x3 = x3 * m + d; x4 = x4 * m + d; x5 = x5 * m + d; x6 = x6 * m + d; x7 = x7 * m + d; }
        sink = x0 + x1 + x2 + x3 + x4 + x5 + x6 + x7; }
    if (PROBE_DUP == 903) {
        f32x4 c[4]; float s = 0.f; float wv[16];
#pragma unroll
        for (int i = 0; i < 4; ++i) c[i] = (f32x4){0.f, 0.f, 0.f, 0.f};
#pragma unroll
        for (int i = 0; i < 16; ++i) wv[i] = 0.001f * (i + F.lane);
        for (int it = 0; it < 275; ++it) { f32x4 d[4];
#pragma unroll
            for (int i = 0; i < 4; ++i) { d[i] = (f32x4){0.f, 0.f, 0.f, 0.f}; d[i] = __builtin_amdgcn_mfma_f32_16x16x32_bf16(a, b, d[i], 0, 0, 0); d[i] = __builtin_amdgcn_mfma_f32_16x16x32_bf16(b, a, d[i], 0, 0, 0); }
            float t = 0.f;
#pragma unroll
            for (int i = 0; i < 4; ++i)
#pragma unroll
                for (int r = 0; r < 4; ++r) { const float x = c[i][r]; const int xi = __builtin_bit_cast(int, x); const float m = __builtin_bit_cast(float, xi > 0 ? xi : 0); t += wv[4 * i + r] * m; }
            float u = t;
#pragma unroll
            for (int k = 0; k < 12; ++k) u = u * 1.0001f + 0.5f;
            s += u; a[1] = (short)(it + (int)s);
#pragma unroll
            for (int i = 0; i < 4; ++i) c[i] = d[i]; }
        sink = s; }
    if (sink == 123.456f) ((float*)(F.ws + WS_SBUF))[F.tid] = sink;
}

constexpr int NPHASE = 12;
struct Args { const float* in[25]; float* out; unsigned char* ws; int ph_lo, ph_hi; };
__global__ void __launch_bounds__(NTHR, 2) fwd_kernel(Args args) {
    extern __shared__ __attribute__((aligned(16))) unsigned char lds[];
    Frame F;
    F.lds = (LAS unsigned char*)lds;
    F.MISC = (volatile LAS unsigned*)(F.lds + MISC_OFF);
    F.tid = threadIdx.x; F.lane = F.tid & 63; F.wave = __builtin_amdgcn_readfirstlane(F.tid >> 6); F.G = gridDim.x;
    F.ws = args.ws; F.ctl = (gu32*)(args.ws + WS_CTL); F.out = args.out;
#pragma unroll
    for (int i = 0; i < 25; ++i) F.in[i] = args.in[i];
    for (int u = F.tid; u < 2048 / 4; u += NTHR) ((LAS unsigned*)(F.lds + MISC_OFF))[u] = 0u;
    __syncthreads();
    XcdBarrier bar; bar.bar = (unsigned*)(F.ctl + CW_BAR); bar.x = 0; bar.st = nullptr;
    if (MK_N_LAUNCHES == 1) bar = xcd_barrier_post((unsigned*)(F.ctl + CW_BAR), F.MISC + 8);
    const int lo = args.ph_lo, hi = args.ph_hi;
#define IN(k) (lo <= (k) && (k) < hi)
#define SEAM(k) do { if (IN(k) && IN((k) + 1)) xcd_barrier(bar); } while (0)
    unsigned char* ws = F.ws; const int c = (int)blockIdx.x;

#define BODY_P0 { p0_prologue(F); if (PROBE_DUP >= 900) ubench(F); }
#define BODY_P1 { pg8::Gemm g{(const bf16*)(ws + WS_XN), (const bf16*)(ws + WS_WIN), 1024, 1024, 1024}; StaticOrder S; S.init(NTOK / 256, NIN_PAD / 256, F.G, c); \
        EpiInProj E{ws, F.in[I_BGATE]}; pg8::gemm_phase<EpiInProj, StaticOrder>(F.lds, g, S, E); }
#define BODY_P2 { { pg8::Gemm g{(const bf16*)(ws + WS_UGX), (const bf16*)(ws + WS_WS), UGX_LD, 512, 512}; S5StateOrder S{c}; EpiS5State E{(float*)(ws + WS_SBUF)}; \
          pg8::gemm_phase<EpiS5State, S5StateOrder>(F.lds, g, S, E); if (PROBE_DUP == 202) { xcd_barrier(bar); pg8::gemm_phase<EpiS5State, S5StateOrder>(F.lds, g, S, E); } } idx_phase(F); if (PROBE_DUP == 102) { xcd_barrier(bar); idx_phase(F); } }
#define BODY_P3 { carry_phase(F); attn_phase(F); }
#define BODY_P4 { pg8::Gemm g{(const bf16*)(ws + WS_UGX), (const bf16*)(ws + WS_MT), UGX_LD, UGX_LD, 640}; S5YOrder S{c}; EpiS5Y E{(const bf16*)(ws + WS_UGX), F.in[I_SD], (bf16*)(ws + WS_YG)}; \
        pg8::gemm_phase<EpiS5Y, S5YOrder>(F.lds, g, S, E); }
#define BODY_P5 { pg8::Gemm g{(const bf16*)(ws + WS_YG), (const bf16*)(ws + WS_WGLU), 512, 512, 512}; StaticOrder S; S.init(NTOK / 256, 2, F.G, c); EpiGlu E{(const bf16*)(ws + WS_YG), F.in[I_BGLU], (bf16*)(ws + WS_YSSM)}; \
        pg8::gemm_phase<EpiGlu, StaticOrder>(F.lds, g, S, E); }
#define BODY_P6 { pg8::Gemm g{(const bf16*)(ws + WS_YSSM), (const bf16*)(ws + WS_WPS), 512, 512, 512}; MixOrder S; S.so.init(NTOK / 256, 4, F.G, c); \
        EpiMix E{(const bf16*)(ws + WS_GS), (const bf16*)(ws + WS_GA), (bf16*)(ws + WS_MIXED)}; pg8::gemm_phase<EpiMix, MixOrder>(F.lds, g, S, E); }
#define BODY_P7 { pg8::Gemm g{(const bf16*)(ws + WS_MIXED), (const bf16*)(ws + WS_WOUT), 1024, 1024, 1024}; StaticOrder S; S.init(NTOK / 256, 4, F.G, c); EpiOut E{F.in[I_X], (float*)(ws + WS_X1)}; \
        pg8::gemm_phase<EpiOut, StaticOrder>(F.lds, g, S, E); }
#define BODY_P8 { router_phase(F); }
#define BODY_P9 { LAS int* OFF = (LAS int*)(F.lds + MISC_OFF + 512); LAS int* TE = OFF + 72; const int TT = moe_tables(F, OFF, TE); \
        pg8::Gemm g{(const bf16*)(ws + WS_H2), (const bf16*)(ws + WS_WMI), 1024, 1024, 1024}; MoeOrder S{TE, OFF, OFF + 33, (const int*)(ws + WS_ROWMAP), TT, 8, c}; EpiMoe1 E{F.in[I_BMI], (bf16*)(ws + WS_ACT)}; \
        pg8::gemm_phase<EpiMoe1, MoeOrder>(F.lds, g, S, E); }
#define BODY_P10 { LAS int* OFF = (LAS int*)(F.lds + MISC_OFF + 512); LAS int* TE = OFF + 72; const int TT = moe_tables(F, OFF, TE); \
        pg8::Gemm g{(const bf16*)(ws + WS_ACT), (const bf16*)(ws + WS_WMO), 1024, 1024, 1024}; MoeOrder S{TE, OFF, OFF + 33, nullptr, TT, 4, c}; EpiMoe2 E{F.in[I_BMO], (bf16*)(ws + WS_Y2)}; \
        pg8::gemm_phase<EpiMoe2, MoeOrder>(F.lds, g, S, E); }
#define BODY_P11 { combine_phase(F); }
#define PHASE(k, BODY) if (IN(k)) { TPROBE_BEGIN(k); BODY TPROBE_END(k); if (PROBE_DUP == (k)) { xcd_barrier(bar); BODY } } SEAM(k);
    PHASE(0, BODY_P0) PHASE(1, BODY_P1) PHASE(2, BODY_P2) PHASE(3, BODY_P3) PHASE(4, BODY_P4) PHASE(5, BODY_P5) PHASE(6, BODY_P6)
    PHASE(7, BODY_P7) PHASE(8, BODY_P8) PHASE(9, BODY_P9) PHASE(10, BODY_P10) PHASE(11, BODY_P11)
#undef IN
#undef SEAM
}

extern "C" void kernel_launch(void* const* d_in, const int* in_sizes, int n_in, void* d_out, int out_size, void* d_ws, size_t ws_size, hipStream_t stream) {
    static int grid = 0;
    if (grid == 0) {
        if (n_in != 25 || out_size != NTOK * DM || ws_size < WS_END) { fprintf(stderr, "kernel_launch: unexpected problem (n_in %d out %d ws %zu)\n", n_in, out_size, ws_size); grid = -1; return; }
        if (hipFuncSetAttribute((const void*)fwd_kernel, hipFuncAttributeMaxDynamicSharedMemorySize, LDS_BYTES) != hipSuccess) { fprintf(stderr, "kernel_launch: hipFuncSetAttribute failed\n"); grid = -1; return; }
        int per_cu = 0; (void)hipOccupancyMaxActiveBlocksPerMultiprocessor(&per_cu, (const void*)fwd_kernel, NTHR, LDS_BYTES); (void)hipGetLastError();
        grid = 256;
    }
    if (grid < 0) return;
    (void)hipMemsetAsync((char*)d_ws + WS_CTL, 0, CTL_ZERO_BYTES, stream);
    Args a{};
    for (int i = 0; i < 25; ++i) a.in[i] = (const float*)d_in[i];
    a.out = (float*)d_out; a.ws = (unsigned char*)d_ws;
    if (MK_N_LAUNCHES == 1) { a.ph_lo = 0; a.ph_hi = NPHASE; hipLaunchKernelGGL(fwd_kernel, dim3(grid), dim3(NTHR), LDS_BYTES, stream, a); }
    else for (int p = 0; p < NPHASE; ++p) { a.ph_lo = p; a.ph_hi = p + 1; hipLaunchKernelGGL(fwd_kernel, dim3(grid), dim3(NTHR), LDS_BYTES, stream, a); }
}
```

```cpp
#include <hip/hip_runtime.h>
#include <cstdio>
#include <cstdint>

#ifndef MK_N_LAUNCHES
#define MK_N_LAUNCHES 1
#endif
#ifndef PROBE_DUP
#define PROBE_DUP -1
#endif
#ifndef PROBE_T
#define PROBE_T -1
#endif
#define TPROBE_BEGIN(id) unsigned long long tpb_##id = (PROBE_T == (id)) ? __builtin_amdgcn_s_memrealtime() : 0ull
#define TPROBE_END(id) do { if (PROBE_T == (id)) { const unsigned long long d_ = __builtin_amdgcn_s_memrealtime() - tpb_##id, t1_ = __builtin_amdgcn_s_memrealtime(); while (__builtin_amdgcn_s_memrealtime() - t1_ < 4ull * d_) __builtin_amdgcn_s_sleep(8); } } while (0)

namespace pg8 {
#define PG8_LAS __attribute__((address_space(3)))
typedef unsigned short bf16_t;
typedef short bf16x8 __attribute__((ext_vector_type(8)));
typedef float f32x4 __attribute__((ext_vector_type(4)));
typedef float f32x2 __attribute__((ext_vector_type(2)));
typedef unsigned u32x4 __attribute__((ext_vector_type(4)));
typedef unsigned u32x2 __attribute__((ext_vector_type(2)));
constexpr int BM = 256, BK = 64, HALF = 128, HTB = HALF * BK * 2, STAGE_BYTES = 8 * HTB, NXCD = 8, WGM = 8;

__host__ __device__ __forceinline__ int lds_byte(int r, int c) { const int st = (r >> 4) * 2 + (c >> 5), rr = r & 15, cc = c & 31, ob = rr * 64 + cc * 2; return st * 1024 + (ob ^ (((ob >> 9) & 1) << 5)); }
__host__ __device__ __forceinline__ void stage_rc(int b, int& R, int& C) { const int st = b / 1024, sb = b % 1024, swz = sb ^ (((sb >> 9) & 1) << 5); R = (st >> 1) * 16 + swz / 64; C = (st & 1) * 32 + (swz % 64) / 2; }
__host__ __device__ __forceinline__ int perm32(int rho) { const int n = rho >> 4, i = rho & 15; return 8 * (i >> 2) + 4 * n + (i & 3); }

struct Unit { int pm, pn, pa, pb, e; };
struct Gemm { const bf16_t* A; const bf16_t* Bt; int lda, ldb, K; size_t bexp; };

__device__ __forceinline__ unsigned cvt_pk_bf16(float lo, float hi) { unsigned r; asm volatile("v_cvt_pk_bf16_f32 %0, %1, %2" : "=v"(r) : "v"(lo), "v"(hi)); return r; }
__device__ __forceinline__ u32x4 pack8(const f32x4& v0, const f32x4& v1) { u32x4 w; w.x = cvt_pk_bf16(v0[0], v0[1]); w.y = cvt_pk_bf16(v0[2], v0[3]); w.z = cvt_pk_bf16(v1[0], v1[1]); w.w = cvt_pk_bf16(v1[2], v1[3]); return w; }

template <class Epi, class Sched, bool ALIGN_EPI = true, bool BKN = false>
__device__ __forceinline__ void gemm_phase(PG8_LAS unsigned char* lds, const Gemm g, const Sched& S, const Epi& E) {
    const int tid = threadIdx.x, wid = __builtin_amdgcn_readfirstlane(tid >> 6), lane = tid & 63, wr = wid >> 2, wc = wid & 3, fr = lane & 15, fq = lane >> 4;
    const int K = g.K, nt = K / BK;
    unsigned voffB[2];
#pragma unroll
    for (int i = 0; i < 2; ++i) {
        if constexpr (BKN) { const int krow = (tid >> 4) + 32 * i, cp = tid & 15, fk = ((krow & 3) << 1) | (((krow >> 3) & 1) << 3); voffB[i] = (unsigned)(krow * g.ldb) * 2u + (unsigned)((cp ^ fk) << 4); }
        else { int R, C; stage_rc(tid * 16 + i * 8192, R, C); const int Rb = (R & ~31) + perm32(R & 31); voffB[i] = (unsigned)(Rb * g.ldb + C) * 2u; } }
    const size_t kstep = (size_t)(BK * 2);
    const size_t kstepB = BKN ? (size_t)BK * g.ldb * 2 : kstep;
    const size_t hstepB = BKN ? (size_t)256 : (size_t)HALF * g.ldb * 2;
    const size_t tstepB = BKN ? (size_t)512 : 2 * hstepB;
    const unsigned tbase = (unsigned)(unsigned long)lds + (unsigned)((8 * fq + (fr >> 2)) * 256 + (((4 * wc + (fr & 3)) ^ (((fr >> 2) << 1) | ((fq & 1) << 3))) << 4));
#define PG8_AROWS(VV, U) do { _Pragma("unroll") for (int i_ = 0; i_ < 2; ++i_) { int R_, C_; stage_rc((threadIdx.x & 511) * 16 + i_ * 8192, R_, C_); \
        _Pragma("unroll") for (int h_ = 0; h_ < 2; ++h_) VV[h_][i_] = (unsigned)(S.arow(U, h_, R_) * g.lda + C_) * 2u; } } while (0)
    unsigned vA[2][2], vAn[2][2];
    const unsigned ldsw = (unsigned)wid * 1024u;
    const int aoff = lds_byte(wr * 64 + fr, fq * 8), boff = lds_byte(wc * 32 + fr, fq * 8);
#define PG8_SA(b, h) (((b) * 2 + (h)) * HTB)
#define PG8_SB(b, h) ((4 + (b) * 2 + (h)) * HTB)
#define PG8_STAGE(bufoff, gbase, voff) do { _Pragma("unroll") for (int _i = 0; _i < 2; ++_i) \
        __builtin_amdgcn_global_load_lds((const unsigned*)((const char*)(gbase) + (voff)[_i]), (PG8_LAS unsigned*)(lds + (bufoff) + ldsw + _i * 8192), 16, 0, 0); } while (0)
#define PG8_LDA(dst, b, h) do { _Pragma("unroll") for (int m = 0; m < 4; ++m) _Pragma("unroll") for (int k = 0; k < 2; ++k) dst[m][k] = *(const PG8_LAS bf16x8*)(lds + PG8_SA(b, h) + aoff + m * 2048 + k * 1024); } while (0)
#define PG8_LDB(dst, b, h) do { if constexpr (BKN) { const unsigned ab_ = tbase + PG8_SB(b, h); _Pragma("unroll") for (int n = 0; n < 2; ++n) _Pragma("unroll") for (int k = 0; k < 2; ++k) { u32x2 lo_, hi_; \
            asm volatile("ds_read_b64_tr_b16 %0, %2 offset:%3\n\tds_read_b64_tr_b16 %1, %2 offset:%4" : "=&v"(lo_), "=&v"(hi_) : "v"(ab_), "n"(k * 8192 + n * 8), "n"(k * 8192 + n * 8 + 1024) : "memory"); \
            u32x4 w_; w_.x = lo_.x; w_.y = lo_.y; w_.z = hi_.x; w_.w = hi_.y; dst[n][k] = __builtin_bit_cast(bf16x8, w_); } } \
        else { _Pragma("unroll") for (int n = 0; n < 2; ++n) _Pragma("unroll") for (int k = 0; k < 2; ++k) dst[n][k] = *(const PG8_LAS bf16x8*)(lds + PG8_SB(b, h) + boff + n * 2048 + k * 1024); } } while (0)
#define PG8_WAIT_LB() do { if constexpr (BKN) asm volatile("s_waitcnt lgkmcnt(0)" : "+v"(B0[0][0]), "+v"(B0[0][1]), "+v"(B0[1][0]), "+v"(B0[1][1]), "+v"(B1[0][0]), "+v"(B1[0][1]), "+v"(B1[1][0]), "+v"(B1[1][1]) :: "memory"); \
        else asm volatile("s_waitcnt lgkmcnt(0)" ::: "memory"); } while (0)
#define PG8_MMA(ai, bj, At, Bt) do { __builtin_amdgcn_s_setprio(1); _Pragma("unroll") for (int m = 0; m < 4; ++m) _Pragma("unroll") for (int n = 0; n < 2; ++n) _Pragma("unroll") for (int k = 0; k < 2; ++k) \
        acc[ai][bj][m][n] = __builtin_amdgcn_mfma_f32_16x16x32_bf16(Bt[n][k], At[m][k], acc[ai][bj][m][n], 0, 0, 0); __builtin_amdgcn_s_setprio(0); } while (0)
#define PG8_WAIT_V(n) asm volatile("s_waitcnt vmcnt(" #n ")" ::: "memory")
#define PG8_WAIT_L(n) asm volatile("s_waitcnt lgkmcnt(" #n ")" ::: "memory")
#define PG8_BAR __builtin_amdgcn_s_barrier()
#define PG8_SCHED __builtin_amdgcn_sched_barrier(0)
    Unit cur, nxt; int ui = 0;
    if (!S.next(0, cur)) return;
    f32x4 acc[2][2][4][2];
#pragma unroll
    for (int a = 0; a < 2; ++a)
#pragma unroll
        for (int b = 0; b < 2; ++b)
#pragma unroll
            for (int m = 0; m < 4; ++m)
#pragma unroll
                for (int n = 0; n < 2; ++n) acc[a][b][m][n] = (f32x4){0.f, 0.f, 0.f, 0.f};
    bf16x8 At[4][2], B0[2][2], B1[2][2];
    const char* const bA = (const char*)g.A; const char* cB = BKN ? (const char*)g.Bt + (size_t)cur.e * g.bexp + (size_t)cur.pn * tstepB : (const char*)g.Bt + (size_t)cur.pb * tstepB;
    PG8_AROWS(vA, cur);
    PG8_STAGE(PG8_SB(0, 0), cB, voffB); PG8_STAGE(PG8_SB(0, 1), cB + hstepB, voffB); PG8_STAGE(PG8_SA(0, 0), bA, vA[0]); PG8_STAGE(PG8_SA(0, 1), bA, vA[1]);
    if (wr == 1) PG8_BAR;
    PG8_WAIT_V(2); PG8_BAR;
    PG8_STAGE(PG8_SB(1, 0), cB + kstepB, voffB); PG8_STAGE(PG8_SA(1, 0), bA + kstep, vA[0]); PG8_STAGE(PG8_SB(1, 1), cB + hstepB + kstepB, voffB);
    PG8_WAIT_V(6); PG8_BAR;
    for (;;) {
        const bool has_next = S.next(ui + 1, nxt);
        const char* nB = has_next ? (BKN ? (const char*)g.Bt + (size_t)nxt.e * g.bexp + (size_t)nxt.pn * tstepB : (const char*)g.Bt + (size_t)nxt.pb * tstepB) : cB;
        if (has_next) PG8_AROWS(vAn, nxt); else { vAn[0][0] = vA[0][0]; vAn[0][1] = vA[0][1]; vAn[1][0] = vA[1][0]; vAn[1][1] = vA[1][1]; }
        for (int t = 0; t < nt; t += 2) {
            const bool last = (t == nt - 2);
            const char* a1 = bA + (size_t)(t + 1) * kstep;
            const char* a2 = last ? bA : bA + (size_t)(t + 2) * kstep; const char* b2 = last ? nB : cB + (size_t)(t + 2) * kstepB;
            const char* a3 = a2 + kstep; const char* b3 = b2 + kstepB;
            unsigned w0[2], w1[2];
            w0[0] = last ? vAn[0][0] : vA[0][0]; w0[1] = last ? vAn[0][1] : vA[0][1]; w1[0] = last ? vAn[1][0] : vA[1][0]; w1[1] = last ? vAn[1][1] : vA[1][1];
            PG8_LDB(B0, 0, 0); PG8_LDB(B1, 0, 1); PG8_SCHED; PG8_LDA(At, 0, 0); PG8_STAGE(PG8_SA(1, 1), a1, vA[1]);
            PG8_WAIT_V(8); PG8_WAIT_LB(); PG8_BAR; PG8_MMA(0, 0, At, B0); PG8_MMA(0, 1, At, B1); PG8_BAR; PG8_SCHED;
            PG8_LDA(At, 0, 1); PG8_STAGE(PG8_SB(0, 0), b2, voffB); PG8_STAGE(PG8_SB(0, 1), b2 + hstepB, voffB); PG8_STAGE(PG8_SA(0, 0), a2, w0);
            PG8_WAIT_V(8); PG8_WAIT_L(0); PG8_BAR; PG8_MMA(1, 0, At, B0); PG8_MMA(1, 1, At, B1); PG8_BAR; PG8_SCHED;
            PG8_LDB(B0, 1, 0); PG8_LDB(B1, 1, 1); PG8_SCHED; PG8_LDA(At, 1, 0); PG8_STAGE(PG8_SA(0, 1), a2, w1);
            PG8_WAIT_V(8); PG8_WAIT_LB(); PG8_BAR; PG8_MMA(0, 0, At, B0); PG8_MMA(0, 1, At, B1); PG8_BAR; PG8_SCHED;
            PG8_LDA(At, 1, 1); PG8_STAGE(PG8_SB(1, 0), b3, voffB); PG8_STAGE(PG8_SB(1, 1), b3 + hstepB, voffB); PG8_STAGE(PG8_SA(1, 0), a3, w0);
            PG8_WAIT_V(8); PG8_WAIT_L(0); PG8_BAR; PG8_MMA(1, 0, At, B0); PG8_MMA(1, 1, At, B1); PG8_BAR; PG8_SCHED;
        }
        if constexpr (ALIGN_EPI) { if (wr == 0) PG8_BAR; }
        E(acc, cur, wr, wc, fr, fq);
        if (!has_next) break;
#pragma unroll
        for (int a = 0; a < 2; ++a)
#pragma unroll
            for (int b = 0; b < 2; ++b)
#pragma unroll
                for (int m = 0; m < 4; ++m)
#pragma unroll
                    for (int n = 0; n < 2; ++n) acc[a][b][m][n] = (f32x4){0.f, 0.f, 0.f, 0.f};
        cur = nxt; cB = nB; ++ui; vA[0][0] = vAn[0][0]; vA[0][1] = vAn[0][1]; vA[1][0] = vAn[1][0]; vA[1][1] = vAn[1][1];
        if constexpr (ALIGN_EPI) { if (wr == 1) PG8_BAR; }
    }
    PG8_WAIT_V(0);
    if constexpr (!ALIGN_EPI) { if (wr == 0) PG8_BAR; }
    PG8_BAR;
#undef PG8_AROWS
#undef PG8_SA
#undef PG8_SB
#undef PG8_STAGE
#undef PG8_LDA
#undef PG8_LDB
#undef PG8_WAIT_LB
#undef PG8_MMA
#undef PG8_WAIT_V
#undef PG8_WAIT_L
#undef PG8_BAR
#undef PG8_SCHED
}
}

constexpr int NB = 4, SEQ = 4096, NTOK = NB * SEQ, DM = 1024;
constexpr int NWAVES = 8, NTHR = 512;
constexpr int D_SSM = 512, NGRP = 32, NSTATE = 64, CH = 32  , NCH = SEQ / CH  , UGX_LD = 640, S5_ROWS = NB * NCH  ;
constexpr int NIN_PAD = 4608;
constexpr int NEXP = 32, TOPK_E = 4, DFF = 1024;
constexpr int NSEL = 256;
constexpr int MAX_MT = 288;
constexpr float RMS_EPS = 1e-5f;

constexpr size_t MiB = 1u << 20;
constexpr size_t WS_CTL = 0, CTL_ZERO_BYTES = 1 * MiB;
constexpr size_t WS_ROPE = 1 * MiB;
constexpr size_t WS_WIN = 2 * MiB;
constexpr size_t WS_WGLU = 11 * MiB;
constexpr size_t WS_WPS = 12 * MiB;
constexpr size_t WS_WPA = 13 * MiB;
constexpr size_t WS_WOUT = 14 * MiB;
constexpr size_t WS_MT = 16 * MiB;
constexpr size_t WS_WS = 36 * MiB;
constexpr size_t WS_A32 = 44 * MiB;
constexpr size_t WS_SBUF = 45 * MiB;
constexpr size_t WS_WI = 53 * MiB;
constexpr size_t WS_KI = 54 * MiB;
constexpr size_t WS_K = 56 * MiB;
constexpr size_t WS_V = 60 * MiB;
constexpr size_t WS_UGX = 64 * MiB;
constexpr size_t WS_Q = 84 * MiB;
constexpr size_t WS_QI = 100 * MiB;
constexpr size_t WS_GS = 132 * MiB;
constexpr size_t WS_GA = 164 * MiB;
constexpr size_t WS_XN = 196 * MiB;
constexpr size_t WS_YG = 228 * MiB;
constexpr size_t WS_YSSM = 244 * MiB;
constexpr size_t WS_YATT = 260 * MiB;
constexpr size_t WS_SEL = 276 * MiB;
constexpr size_t WS_MIXED = 284 * MiB;
constexpr size_t WS_X1 = 316 * MiB;
constexpr size_t WS_H2 = 380 * MiB;
constexpr size_t WS_TOPE = 412 * MiB;
constexpr size_t WS_TOPW = WS_TOPE + 256 * 1024;
constexpr size_t WS_TOPPOS = WS_TOPW + 256 * 1024;
constexpr size_t WS_ROWMAP = 413 * MiB;
constexpr size_t WS_WMI = 416 * MiB;
constexpr size_t WS_WMO = 544 * MiB;
constexpr size_t WS_ACT = 608 * MiB;
constexpr size_t WS_XP = 64 * MiB;
constexpr size_t WS_Y2 = 64 * MiB;
constexpr size_t WS_END = 752 * MiB;
static_assert(WS_XP + (size_t)MAX_MT * 256 * 1024 * 2 <= WS_YG, "XP overlay");
constexpr int CW_TMO = 0, CW_CODE = 1;
constexpr int CW_BAR = 4096;
constexpr int CW_ECNT = 16384;
constexpr int CW_WORK0 = 16384 + 64;

constexpr int LDS_BYTES = 163840;
constexpr int MISC_OFF = 163840 - 2048;

#define GAS __attribute__((address_space(1)))
#define LAS __attribute__((address_space(3)))
typedef unsigned short bf16;
typedef unsigned short u16;
typedef unsigned v4u __attribute__((ext_vector_type(4)));
typedef unsigned v2u __attribute__((ext_vector_type(2)));
typedef float f32x4 __attribute__((ext_vector_type(4)));
typedef float f32x16 __attribute__((ext_vector_type(16)));
typedef short bf16x8 __attribute__((ext_vector_type(8)));
typedef GAS unsigned gu32;
#define RLX_AGENT __ATOMIC_RELAXED, __HIP_MEMORY_SCOPE_AGENT
#define LDS_WAIT() asm volatile("s_waitcnt lgkmcnt(0)" ::: "memory")
#define VM_WAIT() asm volatile("s_waitcnt vmcnt(0)" ::: "memory")
__device__ __forceinline__ unsigned f2bf(float f) { unsigned u = __builtin_bit_cast(unsigned, f); return (u + 0x7fffu + ((u >> 16) & 1u)) >> 16; }
__device__ __forceinline__ unsigned pk2(float lo, float hi) { return f2bf(lo) | (f2bf(hi) << 16); }
__device__ __forceinline__ float bf2f(unsigned b) { return __builtin_bit_cast(float, b << 16); }
__device__ __forceinline__ float bflo(unsigned w) { return __builtin_bit_cast(float, w << 16); }
__device__ __forceinline__ float bfhi(unsigned w) { return __builtin_bit_cast(float, w & 0xffff0000u); }
__device__ __forceinline__ float sigmoidf_(float x) { return 1.0f / (1.0f + __expf(-x)); }
__device__ __forceinline__ float gelu_tanh(float x) { const float u = 0.7978845608028654f * (x + 0.044715f * x * x * x); const float e = __expf(2.0f * u); const float t = 1.0f - 2.0f / (e + 1.0f); return 0.5f * x * (1.0f + t); }

#define XB_TMO      128
#define XB_XCNT(j)  (256  + 64 * (j))
#define XB_XSUB(j)  (1280 + 64 * (j))
#define XB_XGEN(j)  (2304 + 64 * (j))
#define XB_TOP      3328
#define XB_TOPGEN   3392
#define XCD_BAR_WORDS 3456
#define XB_SPIN_CAP (1u << 18)
__device__ __forceinline__ unsigned xb_ld(unsigned* p)              { return __hip_atomic_load(p, __ATOMIC_RELAXED, __HIP_MEMORY_SCOPE_AGENT); }
__device__ __forceinline__ unsigned xb_add(unsigned* p, unsigned v) { return __hip_atomic_fetch_add(p, v, __ATOMIC_RELAXED, __HIP_MEMORY_SCOPE_AGENT); }
__device__ __forceinline__ unsigned xb_xcc_id() { return (unsigned)__builtin_amdgcn_s_getreg((3 << 11) | 20) & 0xFu; }
#define XB_SPIN(cond, bar) do { unsigned _sp = 0; while (cond) { __builtin_amdgcn_s_sleep(1); \
    if ((++_sp & 255u) == 0u) { if (xb_ld(&(bar)[XB_TMO])) break; if (_sp > XB_SPIN_CAP) { atomicAdd(&(bar)[XB_TMO], 1u); break; } } } } while (0)
struct XcdBarrier { unsigned* bar; unsigned x; volatile LAS unsigned* st; };
__device__ __forceinline__ XcdBarrier xcd_barrier_post(unsigned* bar, volatile LAS unsigned* st) {
    XcdBarrier b; b.bar = bar; b.x = xb_xcc_id(); b.st = st;
    if (threadIdx.x == 0) (void)xb_add(&bar[XB_XCNT(b.x)], 1u);
    return b;
}
__device__ __forceinline__ void xcd_barrier_complete(unsigned* bar, unsigned x, unsigned& nloc, unsigned& nx) {
    const unsigned G = gridDim.x * gridDim.y * gridDim.z;
    unsigned sum, cnt, mine, sp = 0u;
    for (;;) {
        sum = 0u; cnt = 0u; mine = 0u;
#pragma unroll
        for (unsigned j = 0; j < 16; ++j) { const unsigned c = xb_ld(&bar[XB_XCNT(j)]); sum += c; cnt += (c > 0u) ? 1u : 0u; mine = (j == x) ? c : mine; }
        if (sum == G) break;
        __builtin_amdgcn_s_sleep(1);
        if ((++sp & 255u) == 0u) { if (xb_ld(&bar[XB_TMO])) break; if (sp > XB_SPIN_CAP) { atomicAdd(&bar[XB_TMO], 1u); break; } }
    }
    nloc = mine > 0u ? mine : 1u; nx = cnt > 0u ? cnt : 1u;
}
__device__ __forceinline__ void xcd_barrier(const XcdBarrier& b) {
    asm volatile("s_waitcnt vmcnt(0)" ::: "memory");
    __syncthreads();
    if (threadIdx.x == 0) {
        unsigned* bar = b.bar;
        __builtin_amdgcn_s_waitcnt(0);
        unsigned nloc = b.st[0], nx = b.st[1];
        if (nloc == 0u) { xcd_barrier_complete(bar, b.x, nloc, nx); b.st[0] = nloc; b.st[1] = nx; }
        const unsigned old = xb_add(&bar[XB_XSUB(b.x)], 1u);
        const unsigned gen = old / nloc;
        if (old + 1u == (gen + 1u) * nloc) {
            __builtin_amdgcn_fence(__ATOMIC_RELEASE, "agent");
            asm volatile("s_waitcnt vmcnt(0)" ::: "memory");
            const unsigned og = xb_add(&bar[XB_TOP], 1u);
            const unsigned tg = og / nx;
            if (og + 1u == (tg + 1u) * nx) xb_add(&bar[XB_TOPGEN], 1u);
            else XB_SPIN(xb_ld(&bar[XB_TOPGEN]) == tg, bar);
            __builtin_amdgcn_fence(__ATOMIC_ACQUIRE, "agent");
            xb_add(&bar[XB_XGEN(b.x)], 1u);
            asm volatile("s_waitcnt vmcnt(0)" ::: "memory");
        } else {
            XB_SPIN(xb_ld(&bar[XB_XGEN(b.x)]) == gen, bar);
            __builtin_amdgcn_fence(__ATOMIC_ACQUIRE, "agent");
            asm volatile("s_waitcnt vmcnt(0)" ::: "memory");
        }
    }
    __syncthreads();
}

struct Frame {
    LAS unsigned char* lds;
    volatile LAS unsigned* MISC;
    gu32* ctl;
    int tid, lane, wave, G;
    unsigned char* ws;
    const float* in[25];
    float* out;
};
enum { I_X = 0, I_N1G, I_WIN, I_BGATE, I_LRE, I_LIM, I_LOGDT, I_BRE, I_BIM, I_CRE, I_CIM, I_SD, I_WGLU, I_BGLU, I_WPS, I_WPA, I_WOUT, I_N2G, I_WR, I_BR, I_WMI, I_BMI, I_WMO, I_BMO, I_NFG };

__device__ __forceinline__ float wave_sum(float v) {
#pragma unroll
    for (int o = 1; o < 64; o <<= 1) v += __shfl_xor(v, o);
    return v;
}

__device__ __forceinline__ int ropeperm(int p) { const int a = p >> 3, bb = p & 7; return bb < 4 ? 4 * a + bb : 32 + 4 * a + (bb - 4); }
__device__ __forceinline__ int win_src(int nd) {
    const int pn = nd >> 8, j = nd & 255;
    if (pn < 2) return nd;
    if (pn < 4) { const int i = nd - 512; return 512 + (i & ~63) + ropeperm(i & 63); }
    if (pn == 4) { if (j < 128) return 1024 + (j & ~63) + ropeperm(j & 63); return 1152 + (j - 128); }
    if (pn < 9) { const int i = nd - 1280; return 1280 + (i & ~63) + ropeperm(i & 63); }
    if (pn == 9) { if (j < 64) return 2304 + ropeperm(j); if (j < 80) return 2368 + (j - 64); return -1; }
    if (pn < 14) return 2384 + (nd - 2560);
    return 3408 + (nd - 3584);
}
struct TItem { const float* src; bf16* dst; int N, K; };
__device__ __forceinline__ void titem_load(const TItem& T, float (&tv)[32], int lane) {
#pragma unroll
    for (int i = 0; i < 32; ++i) { const int kk = 2 * i + (lane >> 5); tv[i] = T.src ? __builtin_nontemporal_load(T.src + (size_t)kk * T.N) : 0.f; }
}
__device__ __forceinline__ void titem_store(const TItem& T, const float (&tv)[32], LAS float* scr, int lane) {
#pragma unroll
    for (int i = 0; i < 32; ++i) { const int kk = 2 * i + (lane >> 5); scr[kk * 33 + (lane & 31)] = tv[i]; }
    LDS_WAIT(); asm volatile("" ::: "memory");
    const int c = lane & 7;
#pragma unroll
    for (int j = 0; j < 4; ++j) { const int n = (lane >> 3) + 8 * j; const LAS float* s = scr + (8 * c) * 33 + n;
        v4u o; o.x = pk2(s[0 * 33], s[1 * 33]); o.y = pk2(s[2 * 33], s[3 * 33]); o.z = pk2(s[4 * 33], s[5 * 33]); o.w = pk2(s[6 * 33], s[7 * 33]);
        *(GAS v4u*)(T.dst + (size_t)n * T.K + 8 * c) = o; }
    LDS_WAIT(); asm volatile("" ::: "memory");
}
__device__ __forceinline__ void rms_row_to_bf16(int lane, const float* xrow, const float* g, bf16* orow) {
    const GAS f32x4* xr = (const GAS f32x4*)xrow + lane; const GAS f32x4* gr = (const GAS f32x4*)g + lane;
    f32x4 v[4]; float s2 = 0.f;
#pragma unroll
    for (int j = 0; j < 4; ++j) { v[j] = xr[64 * j]; s2 += (v[j].x * v[j].x + v[j].y * v[j].y) + (v[j].z * v[j].z + v[j].w * v[j].w); }
    const float rstd = 1.0f / sqrtf(wave_sum(s2) * (1.f / DM) + RMS_EPS);
    GAS unsigned long long* o8 = (GAS unsigned long long*)orow + lane;
#pragma unroll
    for (int j = 0; j < 4; ++j) { const f32x4 gg = gr[64 * j];
        o8[64 * j] = (unsigned long long)pk2(v[j].x * rstd * gg.x, v[j].y * rstd * gg.y) | ((unsigned long long)pk2(v[j].z * rstd * gg.z, v[j].w * rstd * gg.w) << 32); }
}
__device__ __forceinline__ void p0_s5_group(Frame& F, int g) {
    LAS float* AP = (LAS float*)(F.lds);
    LAS float* BB = (LAS float*)(F.lds + 16896);
    LAS float* CC = (LAS float*)(F.lds + 25088);
    LAS float* KJ = (LAS float*)(F.lds + 33280);
    const float* lre = F.in[I_LRE] + g * 64; const float* lim = F.in[I_LIM] + g * 64;
    const double dt = exp((double)F.in[I_LOGDT][g]);
    __syncthreads();
    for (int idx = F.tid; idx < 33 * 64; idx += NTHR) { const int p = idx & 63, j = idx >> 6;
        const double lr = lre[p], li = lim[p]; const double mag = exp(j * lr * dt), ang = j * li * dt;
        AP[idx * 2] = (float)(mag * cos(ang)); AP[idx * 2 + 1] = (float)(mag * sin(ang)); }
    for (int idx = F.tid; idx < 1024; idx += NTHR) { const int p = idx >> 4;
        const double lr = lre[p], li = lim[p]; const double mag = exp(lr * dt), ang = li * dt; const double ar = mag * cos(ang), ai = mag * sin(ang);
        const double nr = ar - 1.0, ni = ai, den = lr * lr + li * li; const double zr = (nr * lr + ni * li) / den, zi = (ni * lr - nr * li) / den;
        const double br = F.in[I_BRE][g * 1024 + idx], bi = F.in[I_BIM][g * 1024 + idx];
        BB[idx * 2] = (float)(zr * br - zi * bi); BB[idx * 2 + 1] = (float)(zr * bi + zi * br); }
    for (int idx = F.tid; idx < 1024; idx += NTHR) { CC[idx * 2] = F.in[I_CRE][g * 1024 + idx]; CC[idx * 2 + 1] = F.in[I_CIM][g * 1024 + idx]; }
    __syncthreads();
    { const int j = F.tid >> 4, hp = F.tid & 15; float s[16];
#pragma unroll
      for (int h = 0; h < 16; ++h) s[h] = 0.f;
      for (int p = 0; p < 64; ++p) { const float cr = CC[(hp * 64 + p) * 2], ci = CC[(hp * 64 + p) * 2 + 1], ar = AP[(j * 64 + p) * 2], ai = AP[(j * 64 + p) * 2 + 1];
          const float er = cr * ar - ci * ai, ei = cr * ai + ci * ar;
#pragma unroll
          for (int h4 = 0; h4 < 8; ++h4) { const f32x4 bb = *(const LAS f32x4*)(BB + (p * 16 + 2 * h4) * 2); s[2 * h4] += er * bb[0] - ei * bb[1]; s[2 * h4 + 1] += er * bb[2] - ei * bb[3]; } }
#pragma unroll
      for (int h = 0; h < 16; ++h) KJ[(j * 16 + hp) * 16 + h] = s[h]; }
    __syncthreads();
    bf16* MT = (bf16*)(F.ws + WS_MT) + (size_t)g * 512 * 640;
    for (int ch = F.tid; ch < 512 * 80; ch += NTHR) { const int n = ch / 80, k0 = (ch % 80) * 8, tp = n >> 4, hp = n & 15; float v[8];
        if (k0 < 512) { const int sp = k0 >> 4, h0 = k0 & 15;
#pragma unroll
            for (int j = 0; j < 8; ++j) v[j] = (sp <= tp) ? KJ[((tp - sp) * 16 + hp) * 16 + h0 + j] : 0.f; }
        else { const bool im = k0 >= 576; const int p0 = k0 - (im ? 576 : 512);
#pragma unroll
            for (int j = 0; j < 8; ++j) { const int p = p0 + j; const float cr = CC[(hp * 64 + p) * 2], ci = CC[(hp * 64 + p) * 2 + 1], ar = AP[((tp + 1) * 64 + p) * 2], ai = AP[((tp + 1) * 64 + p) * 2 + 1];
                v[j] = im ? -(cr * ai + ci * ar) : (cr * ar - ci * ai); } }
        v4u o; o.x = pk2(v[0], v[1]); o.y = pk2(v[2], v[3]); o.z = pk2(v[4], v[5]); o.w = pk2(v[6], v[7]);
        *(GAS v4u*)(MT + (size_t)n * 640 + k0) = o; }
    bf16* WS = (bf16*)(F.ws + WS_WS) + (size_t)g * 256 * 512;
    for (int ch = F.tid; ch < 256 * 64; ch += NTHR) { const int n = ch >> 6, k0 = (ch & 63) * 8, sp = k0 >> 4, h0 = k0 & 15; float v[8];
#pragma unroll
        for (int j = 0; j < 8; ++j) { if (n < 128) { const int p = n & 63; const float ar = AP[((31 - sp) * 64 + p) * 2], ai = AP[((31 - sp) * 64 + p) * 2 + 1], br = BB[(p * 16 + h0 + j) * 2], bi = BB[(p * 16 + h0 + j) * 2 + 1];
                v[j] = (n < 64) ? (ar * br - ai * bi) : (ar * bi + ai * br); } else v[j] = 0.f; }
        v4u o; o.x = pk2(v[0], v[1]); o.y = pk2(v[2], v[3]); o.z = pk2(v[4], v[5]); o.w = pk2(v[6], v[7]);
        *(GAS v4u*)(WS + (size_t)n * 512 + k0) = o; }
    float* A32 = (float*)(F.ws + WS_A32) + g * 128;
    if (F.tid < 128) A32[F.tid] = AP[32 * 128 + F.tid];
    __syncthreads();
}
__device__ __forceinline__ void p0_prologue(Frame& F) {
    const int NW = F.G - NGRP;
    const bool s5wg = (int)blockIdx.x >= NW;
    TPROBE_BEGIN(120);
    if (s5wg) p0_s5_group(F, (int)blockIdx.x - NW);
    TPROBE_END(120);
    TPROBE_BEGIN(121);
    if (!s5wg) {
    LAS float* scr = (LAS float*)(F.lds + F.wave * 16384);
    const int gw = blockIdx.x * NWAVES + F.wave, NGW = NW * NWAVES;
    { float* cosT = (float*)(F.ws + WS_ROPE); float* sinT = cosT + SEQ * 32;
      for (int i = blockIdx.x * NTHR + F.tid; i < SEQ * 32; i += NW * NTHR) { const int pos = i >> 5, k = i & 31;
          const double inv = pow(10000.0, -(double)k / 32.0); const double ang = (double)pos * (double)(float)inv;
          cosT[i] = (float)cos(ang); sinT[i] = (float)sin(ang); } }
    for (int m = gw; m < NTOK; m += NGW) rms_row_to_bf16(F.lane, F.in[I_X] + (size_t)m * DM, F.in[I_N1G], (bf16*)(F.ws + WS_XN) + (size_t)m * DM);
    constexpr int I_IN = 16 * (NIN_PAD / 32), I_GLU = 8 * 16, I_PS = 8 * 32, I_PA = 8 * 32, I_OUT = 16 * 32;
    constexpr int NITEMS = I_IN + I_GLU + I_PS + I_PA + I_OUT;
    auto decode = [&](int it) -> TItem {
        int r = it; const float* W; bf16* WT; int K, N, ndb, map = 0;
        if (r < I_IN) { W = F.in[I_WIN]; K = DM; N = 4432; WT = (bf16*)(F.ws + WS_WIN); ndb = NIN_PAD / 32; map = 1; }
        else if ((r -= I_IN) < I_GLU) { W = F.in[I_WGLU]; K = 512; N = 512; WT = (bf16*)(F.ws + WS_WGLU); ndb = 16; }
        else if ((r -= I_GLU) < I_PS) { W = F.in[I_WPS]; K = 512; N = 1024; WT = (bf16*)(F.ws + WS_WPS); ndb = 32; }
        else if ((r -= I_PS) < I_PA) { W = F.in[I_WPA]; K = 512; N = 1024; WT = (bf16*)(F.ws + WS_WPA); ndb = 32; }
        else { r -= I_PA; W = F.in[I_WOUT]; K = 1024; N = 1024; WT = (bf16*)(F.ws + WS_WOUT); ndb = 32; }
        const int kb = r / ndb, nb = r % ndb, k0 = 64 * kb, n0 = 32 * nb; int sc = n0 + (F.lane & 31); if (map) sc = win_src(sc);
        TItem T; T.src = (sc >= 0) ? W + (size_t)k0 * N + sc : nullptr; T.dst = WT + (size_t)n0 * K + k0; T.N = N; T.K = K; return T; };
    { float tvA[32], tvB[32]; int it = gw;
      if (it < NITEMS) { TItem TA = decode(it); titem_load(TA, tvA, F.lane);
        for (;;) {
            const int it1 = it + NGW; const bool h1 = it1 < NITEMS; TItem TB = TA; if (h1) { TB = decode(it1); titem_load(TB, tvB, F.lane); }
            titem_store(TA, tvA, scr, F.lane); if (!h1) break;
            const int it2 = it1 + NGW; const bool h2 = it2 < NITEMS; if (h2) { TA = decode(it2); titem_load(TA, tvA, F.lane); }
            titem_store(TB, tvB, scr, F.lane); if (!h2) break;
            it = it2; } } }
    }
    TPROBE_END(121);
    TPROBE_BEGIN(122);
    { const size_t n8_in = (size_t)NEXP * 1024 * 2048 / 8, n8 = n8_in + (size_t)NEXP * 1024 * 1024 / 8;
      const int nvw = s5wg ? 2 : 4, vw0 = s5wg ? 4 * NW + 2 * ((int)blockIdx.x - NW) : 4 * (int)blockIdx.x;
      const size_t vstride = (size_t)(4 * NW + 2 * NGRP) * NTHR;
      for (int vw = 0; vw < nvw; ++vw)
      for (size_t i0 = (size_t)(vw0 + vw) * NTHR + F.tid; i0 < n8; i0 += 4 * vstride) {
          f32x4 a[4], b[4];
#pragma unroll
          for (int u = 0; u < 4; ++u) { const size_t i = i0 + (size_t)u * vstride; if (i < n8) { const float* s = (i < n8_in) ? F.in[I_WMI] + i * 8 : F.in[I_WMO] + (i - n8_in) * 8;
              a[u] = __builtin_nontemporal_load((const f32x4*)s); b[u] = __builtin_nontemporal_load((const f32x4*)s + 1); } }
#pragma unroll
          for (int u = 0; u < 4; ++u) { const size_t i = i0 + (size_t)u * vstride; if (i < n8) { bf16* d = (i < n8_in) ? (bf16*)(F.ws + WS_WMI) + i * 8 : (bf16*)(F.ws + WS_WMO) + (i - n8_in) * 8;
              *(GAS v4u*)d = pg8::pack8(a[u], b[u]); } } } }
    TPROBE_END(122);
}

struct StaticOrder {
    int nM, nN, nwg, G, c;
    __device__ void init(int nM_, int nN_, int G_, int c_) { nM = nM_; nN = nN_; nwg = nM * nN; G = G_; c = c_; }
    __device__ bool tile(int i, int& pm, int& pn) const {
        const long L = (long)i * G + c; if (L >= nwg) return false;
        int wgid = (int)L; { const int q = nwg / pg8::NXCD, r = nwg % pg8::NXCD, xcd = wgid % pg8::NXCD, off = wgid / pg8::NXCD; wgid = (xcd < r ? xcd * (q + 1) : r * (q + 1) + (xcd - r) * q) + off; }
        const int nig = pg8::WGM * nN, gid = wgid / nig, fm = gid * pg8::WGM, gsz = (nM - fm) < pg8::WGM ? (nM - fm) : pg8::WGM;
        pm = fm + ((wgid % nig) % gsz); pn = (wgid % nig) / gsz; return true;
    }
    __device__ bool next(int i, pg8::Unit& u) const { int pm, pn; if (!tile(i, pm, pn)) return false; u.pm = pm; u.pn = pn; u.pa = pm; u.pb = pn; u.e = 0; return true; }
    __device__ __forceinline__ int arow(const pg8::Unit& u, int h, int R) const { return u.pa * 256 + h * 128 + R; }
};
struct S5StateOrder {
    int c;
    __device__ bool next(int i, pg8::Unit& u) const { if (i > 0 || c >= 64) return false; const int g = c >> 1, pm = c & 1; u.pm = pm; u.pn = 0; u.pa = g * 2 + pm; u.pb = g; u.e = g; return true; }
    __device__ __forceinline__ int arow(const pg8::Unit& u, int h, int R) const { return u.pa * 256 + h * 128 + R; }
};
struct S5YOrder {
    int c;
    __device__ bool next(int i, pg8::Unit& u) const { if (i > 0 || c >= 128) return false; const int g = c >> 2, pm = (c >> 1) & 1, pn = c & 1; u.pm = pm; u.pn = pn; u.pa = g * 2 + pm; u.pb = g * 2 + pn; u.e = g; return true; }
    __device__ __forceinline__ int arow(const pg8::Unit& u, int h, int R) const { return u.pa * 256 + h * 128 + R; }
};
struct MixOrder {
    StaticOrder so;
    __device__ bool next(int i, pg8::Unit& u) const { int pm, pn; if (!so.tile(i >> 1, pm, pn)) return false; const int h = i & 1; u.pm = pm; u.pn = pn; u.pa = pm + 64 * h; u.pb = pn + 4 * h; u.e = h; return true; }
    __device__ __forceinline__ int arow(const pg8::Unit& u, int h, int R) const { return u.pa * 256 + h * 128 + R; }
};
struct MoeOrder {
    const volatile LAS int* te; const volatile LAS int* off; const volatile LAS int* cnt; const int* rowmap; int TT, NTN, c;
    __device__ bool next(int i, pg8::Unit& u) const {
        const int xcd = c & 7, j = c >> 3, mpx = 32 / NTN; const int mt = i * (8 * mpx) + xcd * mpx + j / NTN, pn = j % NTN;
        if (mt >= TT) return false; const int e = te[mt]; u.pm = mt; u.pn = pn; u.pa = mt; u.pb = e * NTN + pn; u.e = e; return true; }
    __device__ __forceinline__ int arow(const pg8::Unit& u, int h, int R) const {
        if (!rowmap) return u.pa * 256 + h * 128 + R;
        const int lr = u.pm * 256 - off[u.e] + h * 128 + R;
        return lr < cnt[u.e] ? rowmap[(size_t)u.e * NTOK + lr] : 0; }
};

using pg8::f32x2; using pg8::u32x2; using pg8::pack8; using pg8::cvt_pk_bf16;
#define EPI_ROWS_BEGIN _Pragma("unroll") for (int ai = 0; ai < 2; ++ai) _Pragma("unroll") for (int m = 0; m < 4; ++m) { asm volatile("" ::: "memory"); const int row = u.pm * 256 + ai * 128 + wr * 64 + m * 16 + fr; (void)row;
#define EPI_COLS_BEGIN _Pragma("unroll") for (int bj = 0; bj < 2; ++bj) { const int ct = bj * 128 + wc * 32 + fq * 8; (void)ct; f32x4 v0 = acc[ai][bj][m][0], v1 = acc[ai][bj][m][1];
#define EPI_END } }
struct EpiInProj {
    static constexpr bool PERM = true;
    unsigned char* ws; const float* bgate;
    __device__ __forceinline__ void rope(f32x4& v0, f32x4& v1, int pos, int a, float sc) const {
        const unsigned o = (unsigned)WS_ROPE + (unsigned)(pos * 32 + 4 * a) * 4u;
        const f32x4 c = *(const GAS f32x4*)(ws + o), s = *(const GAS f32x4*)(ws + o + (unsigned)(SEQ * 32 * 4));
        const f32x4 o1 = (v0 * c - v1 * s) * sc, o2 = (v1 * c + v0 * s) * sc; v0 = o1; v1 = o2;
    }
    __device__ __forceinline__ void store_rope(unsigned off, const f32x4& o1, const f32x4& o2) const {
        u32x2 a, b; a.x = cvt_pk_bf16(o1[0], o1[1]); a.y = cvt_pk_bf16(o1[2], o1[3]); b.x = cvt_pk_bf16(o2[0], o2[1]); b.y = cvt_pk_bf16(o2[2], o2[3]);
        *(GAS u32x2*)(ws + off) = a; *(GAS u32x2*)(ws + off + 64u) = b;
    }
    __device__ __forceinline__ void operator()(const f32x4 (&acc)[2][2][4][2], const pg8::Unit& u, int wr, int wc, int fr, int fq) const {
        const int pn = u.pn;
        if (pn < 2) {
            EPI_ROWS_BEGIN const int bb = row >> 12, cc = (row >> 5) & 127, sp = row & 31;
            EPI_COLS_BEGIN const int col = pn * 256 + ct, g = col >> 4, h0 = col & 15;
                *(GAS v4u*)(ws + ((unsigned)WS_UGX + (unsigned)((g * 512 + bb * 128 + cc) * UGX_LD + sp * 16 + h0) * 2u)) = pack8(v0, v1);
            EPI_END
        } else if (pn < 4) {
            EPI_ROWS_BEGIN const int pos = row & 4095;
            EPI_COLS_BEGIN const int j = (pn - 2) * 256 + ct, head = j >> 6, a = (j & 63) >> 3;
                rope(v0, v1, pos, a, 0.125f); store_rope((unsigned)WS_Q + (unsigned)(row * 512 + head * 64 + 4 * a) * 2u, v0, v1);
            EPI_END
        } else if (pn == 4) {
            EPI_ROWS_BEGIN const int pos = row & 4095;
            EPI_COLS_BEGIN
                if (bj == 0) { const int head = ct >> 6, a = (ct & 63) >> 3; rope(v0, v1, pos, a, 1.0f); store_rope((unsigned)WS_K + (unsigned)(row * 128 + head * 64 + 4 * a) * 2u, v0, v1); }
                else *(GAS v4u*)(ws + ((unsigned)WS_V + (unsigned)(row * 128 + (ct - 128)) * 2u)) = pack8(v0, v1);
            EPI_END
        } else if (pn < 9) {
            EPI_ROWS_BEGIN const int pos = row & 4095;
            EPI_COLS_BEGIN const int j = (pn - 5) * 256 + ct, head = j >> 6, a = (j & 63) >> 3;
                rope(v0, v1, pos, a, 1.0f); store_rope((unsigned)WS_QI + (unsigned)(row * 1024 + head * 64 + 4 * a) * 2u, v0, v1);
            EPI_END
        } else if (pn == 9) {
            EPI_ROWS_BEGIN const int pos = row & 4095;
            EPI_COLS_BEGIN
                if (bj == 0) { if (ct < 64) { const int a = ct >> 3; rope(v0, v1, pos, a, 1.0f); store_rope((unsigned)WS_KI + (unsigned)(row * 64 + 4 * a) * 2u, v0, v1); }
                    else if (ct < 80) { const unsigned o = (unsigned)WS_WI + (unsigned)(row * 16 + (ct - 64)) * 4u; *(GAS f32x4*)(ws + o) = v0 * 0.03125f; *(GAS f32x4*)(ws + o + 16u) = v1 * 0.03125f; } }
            EPI_END
        } else {
            const int br = pn >= 14; const unsigned gbase = br ? (unsigned)WS_GA : (unsigned)WS_GS; const float* bgp = bgate + br * 1024;
            EPI_ROWS_BEGIN
            EPI_COLS_BEGIN const int col = (pn - (br ? 14 : 10)) * 256 + ct;
                const f32x4 b0 = *(const GAS f32x4*)(bgp + col), b1 = *(const GAS f32x4*)(bgp + col + 4);
#pragma unroll
                for (int j = 0; j < 4; ++j) { v0[j] = sigmoidf_(v0[j] + b0[j]); v1[j] = sigmoidf_(v1[j] + b1[j]); }
                *(GAS v4u*)(ws + (gbase + (unsigned)(row * 1024 + col) * 2u)) = pack8(v0, v1);
            EPI_END
        }
    }
};
struct EpiS5State {
    static constexpr bool PERM = true;
    float* SB;
    __device__ __forceinline__ void operator()(const f32x4 (&acc)[2][2][4][2], const pg8::Unit& u, int wr, int wc, int fr, int fq) const {
        EPI_ROWS_BEGIN
        EPI_COLS_BEGIN
            if (bj == 0) { float* d = SB + ((size_t)u.e * 512 + row) * 128 + ct; *(GAS f32x4*)d = v0; *(GAS f32x4*)(d + 4) = v1; }
        EPI_END
    }
};
struct EpiS5Y {
    static constexpr bool PERM = true;
    const bf16* UGX; const float* Dsk; bf16* YG;
    __device__ __forceinline__ void operator()(const f32x4 (&acc)[2][2][4][2], const pg8::Unit& u, int wr, int wc, int fr, int fq) const {
        const int g = u.e;
        EPI_ROWS_BEGIN const int bb = row >> 7, cc = row & 127;
        EPI_COLS_BEGIN const int n = u.pn * 256 + ct, tp = n >> 4, h0 = n & 15;
            const v4u uu = *(const GAS v4u*)(UGX + ((size_t)g * 512 + row) * UGX_LD + n);
            const f32x4 d0 = *(const GAS f32x4*)(Dsk + g * 16 + h0), d1 = *(const GAS f32x4*)(Dsk + g * 16 + h0 + 4);
            v0[0] += d0[0] * bflo(uu.x); v0[1] += d0[1] * bfhi(uu.x); v0[2] += d0[2] * bflo(uu.y); v0[3] += d0[3] * bfhi(uu.y);
            v1[0] += d1[0] * bflo(uu.z); v1[1] += d1[1] * bfhi(uu.z); v1[2] += d1[2] * bflo(uu.w); v1[3] += d1[3] * bfhi(uu.w);
#pragma unroll
            for (int j = 0; j < 4; ++j) { v0[j] = gelu_tanh(v0[j]); v1[j] = gelu_tanh(v1[j]); }
            const int tok = bb * 4096 + cc * 32 + tp;
            *(GAS v4u*)(YG + (size_t)tok * 512 + g * 16 + h0) = pack8(v0, v1);
        EPI_END
    }
};
struct EpiGlu {
    static constexpr bool PERM = true;
    const bf16* YG; const float* bglu; bf16* YS;
    __device__ __forceinline__ void operator()(const f32x4 (&acc)[2][2][4][2], const pg8::Unit& u, int wr, int wc, int fr, int fq) const {
        EPI_ROWS_BEGIN
        EPI_COLS_BEGIN const int col = u.pn * 256 + ct;
            const v4u yy = *(const GAS v4u*)(YG + (size_t)row * 512 + col);
            const f32x4 b0 = *(const GAS f32x4*)(bglu + col), b1 = *(const GAS f32x4*)(bglu + col + 4);
            v0[0] = bflo(yy.x) * sigmoidf_(v0[0] + b0[0]); v0[1] = bfhi(yy.x) * sigmoidf_(v0[1] + b0[1]); v0[2] = bflo(yy.y) * sigmoidf_(v0[2] + b0[2]); v0[3] = bfhi(yy.y) * sigmoidf_(v0[3] + b0[3]);
            v1[0] = bflo(yy.z) * sigmoidf_(v1[0] + b1[0]); v1[1] = bfhi(yy.z) * sigmoidf_(v1[1] + b1[1]); v1[2] = bflo(yy.w) * sigmoidf_(v1[2] + b1[2]); v1[3] = bfhi(yy.w) * sigmoidf_(v1[3] + b1[3]);
            *(GAS v4u*)(YS + (size_t)row * 512 + col) = pack8(v0, v1);
        EPI_END
    }
};
struct EpiMix {
    static constexpr bool PERM = true;
    const bf16* GS; const bf16* GA; bf16* MX;
    __device__ __forceinline__ void operator()(const f32x4 (&acc)[2][2][4][2], const pg8::Unit& u, int wr, int wc, int fr, int fq) const {
        const bf16* Gp = u.e ? GA : GS;
        EPI_ROWS_BEGIN
        EPI_COLS_BEGIN const size_t off = (size_t)row * 1024 + u.pn * 256 + ct;
            const v4u gg = *(const GAS v4u*)(Gp + off);
            v0[0] *= bflo(gg.x); v0[1] *= bfhi(gg.x); v0[2] *= bflo(gg.y); v0[3] *= bfhi(gg.y); v1[0] *= bflo(gg.z); v1[1] *= bfhi(gg.z); v1[2] *= bflo(gg.w); v1[3] *= bfhi(gg.w);
            if (u.e) { const v4u pp = *(const GAS v4u*)(MX + off);
                v0[0] += bflo(pp.x); v0[1] += bfhi(pp.x); v0[2] += bflo(pp.y); v0[3] += bfhi(pp.y); v1[0] += bflo(pp.z); v1[1] += bfhi(pp.z); v1[2] += bflo(pp.w); v1[3] += bfhi(pp.w); }
            *(GAS v4u*)(MX + off) = pack8(v0, v1);
        EPI_END
    }
};
struct EpiOut {
    static constexpr bool PERM = true;
    const float* X; float* X1;
    __device__ __forceinline__ void operator()(const f32x4 (&acc)[2][2][4][2], const pg8::Unit& u, int wr, int wc, int fr, int fq) const {
        EPI_ROWS_BEGIN
        EPI_COLS_BEGIN const size_t off = (size_t)row * 1024 + u.pn * 256 + ct;
            const f32x4 x0 = *(const GAS f32x4*)(X + off), x1 = *(const GAS f32x4*)(X + off + 4);
            *(GAS f32x4*)(X1 + off) = v0 + x0; *(GAS f32x4*)(X1 + off + 4) = v1 + x1;
        EPI_END
    }
};
struct EpiMoe1 {
    static constexpr bool PERM = true;
    const float* bmi; bf16* ACT;
    __device__ __forceinline__ void operator()(const f32x4 (&acc)[2][2][4][2], const pg8::Unit& u, int wr, int wc, int fr, int fq) const {
        const float* bp = bmi + (size_t)u.e * 2048;
        EPI_ROWS_BEGIN
        EPI_COLS_BEGIN const int col = u.pn * 256 + ct;
            const f32x4 b0 = *(const GAS f32x4*)(bp + col), b1 = *(const GAS f32x4*)(bp + col + 4);
            v0 += b0; v1 += b1; float o[4];
#pragma unroll
            for (int j = 0; j < 4; ++j) { const float zg0 = (j < 2) ? v0[2 * j] : v1[2 * j - 4], zl0 = (j < 2) ? v0[2 * j + 1] : v1[2 * j - 3];
                const float zg = fminf(zg0, 7.0f), zl = fminf(fmaxf(zl0, -7.0f), 7.0f); o[j] = zg * sigmoidf_(1.702f * zg) * (zl + 1.0f); }
            u32x2 w; w.x = cvt_pk_bf16(o[0], o[1]); w.y = cvt_pk_bf16(o[2], o[3]);
            *(GAS u32x2*)(ACT + (size_t)row * 1024 + (col >> 1)) = w;
        EPI_END
    }
};
struct EpiMoe2 {
    static constexpr bool PERM = true;
    const float* bmo; bf16* Y2;
    __device__ __forceinline__ void operator()(const f32x4 (&acc)[2][2][4][2], const pg8::Unit& u, int wr, int wc, int fr, int fq) const {
        const float* bp = bmo + (size_t)u.e * 1024;
        EPI_ROWS_BEGIN
        EPI_COLS_BEGIN const int col = u.pn * 256 + ct;
            const f32x4 b0 = *(const GAS f32x4*)(bp + col), b1 = *(const GAS f32x4*)(bp + col + 4);
            v0 += b0; v1 += b1;
            *(GAS v4u*)(Y2 + (size_t)row * 1024 + col) = pack8(v0, v1);
        EPI_END
    }
};

__device__ __forceinline__ unsigned f16key(unsigned bits) { return (bits & 0x8000u) ? (bits ^ 0xffffu) : (bits | 0x8000u); }
__device__ __forceinline__ void idx_phase(Frame& F) {
    LAS unsigned char* lds = F.lds;
    LAS u16* SC = (LAS u16*)lds;
    LAS unsigned char* KT = lds + 65536;
    LAS unsigned* HP = (LAS unsigned*)(lds + 147456);
    LAS unsigned char* OLB = lds + 147456 + 4096;
    const bf16* QI = (const bf16*)(F.ws + WS_QI); const bf16* KI = (const bf16*)(F.ws + WS_KI); const float* WI = (const float*)(F.ws + WS_WI);
    u16* SEL = (u16*)(F.ws + WS_SEL);
    const int tid = F.tid, lane = F.lane, wave = F.wave, qg = wave & 1, kq = wave >> 1, kgrp = lane >> 4, l15 = lane & 15;
    const int kx = l15 >> 1, cpos = lane & 7;
    const int dsw = ((wave & 1) * 4 + (lane >> 4)) & 7;
    bf16x8 qa[4][2]; float w[16];
#define IDX_UNIT(r_, b_, t0_) const int b_ = (r_) >> 1, t0_ = (((r_) & 1) ? 511 - (int)blockIdx.x : (int)blockIdx.x) * 8
#define IDX_DMA(kb_, st, bufi) do { _Pragma("unroll") for (int j_ = 0; j_ < 2; ++j_) { const int row_ = (j_ * 8 + wave) * 8 + (lane >> 3); \
        __builtin_amdgcn_global_load_lds((const unsigned*)((kb_) + ((size_t)(st) * 128 + row_) * 64 + ((cpos ^ dsw) << 3)), (LAS unsigned*)(KT + (bufi) * 16384 + (j_ * 8 + wave) * 1024), 16, 0, 0); } } while (0)
#define IDX_PREFETCH(r_) do { IDX_UNIT(r_, pb_, pt0_); if (pt0_ >= 256) { \
        const bf16* qp_ = QI + ((size_t)pb_ * SEQ + pt0_ + 4 * qg + (l15 >> 2)) * 1024 + (l15 & 3) * 64 + kgrp * 8; \
        _Pragma("unroll") for (int i = 0; i < 4; ++i) _Pragma("unroll") for (int ks = 0; ks < 2; ++ks) qa[i][ks] = *(const GAS bf16x8*)(qp_ + i * 256 + ks * 32); \
        const float* wp_ = WI + ((size_t)pb_ * SEQ + pt0_ + 4 * qg + kgrp) * 16; \
        _Pragma("unroll") for (int i = 0; i < 4; ++i) { const f32x4 x = *(const GAS f32x4*)(wp_ + 4 * i); w[4 * i] = x[0]; w[4 * i + 1] = x[1]; w[4 * i + 2] = x[2]; w[4 * i + 3] = x[3]; } \
        const bf16* pk_ = KI + (size_t)pb_ * SEQ * 64; const int pn_ = (pt0_ + 7) / 128 + 1; \
        IDX_DMA(pk_, 0, 0); if (1 < pn_) IDX_DMA(pk_, 1, 1); if (2 < pn_) IDX_DMA(pk_, 2, 2); if (3 < pn_) IDX_DMA(pk_, 3, 3); } } while (0)
    IDX_PREFETCH(0);
    for (int r = 0; r < 8; ++r) {
        IDX_UNIT(r, b, t0);
        __syncthreads();
        const int t = t0 + wave; const size_t tok = (size_t)b * SEQ + t;
        if (t0 < 256) {
            v2u x; const int k0 = lane * 4;
            x.x = (unsigned)(k0 <= t ? k0 : 0) | ((unsigned)(k0 + 1 <= t ? k0 + 1 : 0) << 16); x.y = (unsigned)(k0 + 2 <= t ? k0 + 2 : 0) | ((unsigned)(k0 + 3 <= t ? k0 + 3 : 0) << 16);
            *(GAS v2u*)(SEL + tok * NSEL + k0) = x;
            if (r + 1 < 8) IDX_PREFETCH(r + 1);
            continue;
        }
        HP[tid * 2] = 0u; HP[tid * 2 + 1] = 0u;
        const int nst = (t0 + 7) / 128 + 1;
        const int tq = t0 + 4 * qg + kgrp, qrow = 4 * qg + kgrp;
        const bf16* kbat = KI + (size_t)b * SEQ * 64;
        const unsigned hpq = (unsigned)(unsigned long)(HP + qrow * 128);
#define IDX_EPI1(kgl_, AC) do { float s0 = 0.f; \
            _Pragma("unroll") for (int i = 0; i < 4; ++i) _Pragma("unroll") for (int r_ = 0; r_ < 4; ++r_) { const float a0_ = AC[i][r_]; const int i0 = __builtin_bit_cast(int, a0_); const float m0 = __builtin_bit_cast(float, i0 > 0 ? i0 : 0); s0 += w[4 * i + r_] * m0; } \
            const _Float16 h0_ = (_Float16)s0; const unsigned key0_ = f16key(__builtin_bit_cast(unsigned short, h0_)); const int kg0 = (kgl_); \
            SC[qrow * 4096 + kg0] = (u16)key0_; \
            if (kg0 <= tq) { const unsigned bin = key0_ >> 8; const unsigned ha_ = hpq + ((bin >> 1) << 2), hv_ = (bin & 1u) ? 0x10000u : 1u; \
                asm volatile("ds_add_u32 %0, %1" :: "v"(ha_), "v"(hv_) : "memory"); } } while (0)
#define IDX_READ(BQ, kt2) do { _Pragma("unroll") for (int ks = 0; ks < 2; ++ks) BQ[ks] = *(const LAS bf16x8*)(kb + (kq * 32 + (kt2) * 16 + l15) * 128 + (((ks * 4 + kgrp) ^ kx) << 4)); } while (0)
#define IDX_MMA(AC, BQ) do { _Pragma("unroll") for (int i = 0; i < 4; ++i) { AC[i] = (f32x4){0.f, 0.f, 0.f, 0.f}; _Pragma("unroll") for (int ks = 0; ks < 2; ++ks) AC[i] = __builtin_amdgcn_mfma_f32_16x16x32_bf16(qa[i][ks], BQ[ks], AC[i], 0, 0, 0); } } while (0)
        bf16x8 bq0[2], bq1[2];
        f32x4 aA[4], aB[4];
#pragma unroll
        for (int i = 0; i < 4; ++i) { aA[i] = (f32x4){0.f, 0.f, 0.f, 0.f}; aB[i] = aA[i]; }
        int bcur = 0, bnew = 4;
        TPROBE_BEGIN(100);
        for (int st = 0; st < nst; ++st) {
            if (st + 3 < nst) asm volatile("s_waitcnt vmcnt(6)" ::: "memory"); else asm volatile("s_waitcnt vmcnt(0)" ::: "memory");
            __syncthreads();
            if (st + 4 < nst) IDX_DMA(kbat, st + 4, bnew);
            const LAS unsigned char* kb = KT + bcur * 16384;
            const int kbase_ = st * 128 + kq * 32 + l15;
            IDX_READ(bq0, 0);
            IDX_READ(bq1, 1); IDX_MMA(aA, bq0); if (st >= 1) IDX_EPI1(kbase_ - 128 + 16, aB);
            IDX_MMA(aB, bq1); IDX_EPI1(kbase_, aA);
            bcur = (bcur == 4) ? 0 : bcur + 1; bnew = (bnew == 4) ? 0 : bnew + 1;
        }
        IDX_EPI1((nst - 1) * 128 + kq * 32 + l15 + 16, aB);
#undef IDX_EPI1
#undef IDX_MMA
#undef IDX_READ
        __syncthreads();
        TPROBE_END(100);
        TPROBE_BEGIN(101);
        TPROBE_BEGIN(110);
        if (r + 1 < 8) IDX_PREFETCH(r + 1);
        const int n = t + 1, jj = lane, ql = wave;
        const LAS u16* sc = SC + ql * 4096;
        LAS unsigned* hp = HP + ql * 128;
        unsigned b1, need1;
        { const v2u wv = *(const LAS v2u*)(hp + 126 - 2 * jj); unsigned hb[4];
          hb[3] = wv.x & 0xffffu; hb[2] = wv.x >> 16; hb[1] = wv.y & 0xffffu; hb[0] = wv.y >> 16;
          const unsigned s4 = hb[0] + hb[1] + hb[2] + hb[3];
          unsigned pre = s4;
#pragma unroll
          for (int o = 1; o < 64; o <<= 1) { const unsigned x = __shfl_up(pre, o, 64); if (jj >= o) pre += x; }
          const unsigned long long bal = __ballot(pre >= 256u); const int js = __builtin_ctzll(bal);
          unsigned above = pre - s4, bb1 = 0, nd1 = 0; bool found = false;
#pragma unroll
          for (int i = 0; i < 4; ++i) { if (!found) { if (above + hb[i] >= 256u) { bb1 = 255 - (jj * 4 + i); nd1 = 256u - above; found = true; } else above += hb[i]; } }
          b1 = __shfl(bb1, js); need1 = __shfl(nd1, js); }
        TPROBE_END(110);
        TPROBE_BEGIN(111);
        LDS_WAIT(); __builtin_amdgcn_wave_barrier();
#define LDS_ST32(addr_, val_) asm volatile("ds_write_b32 %0, %1" :: "v"((unsigned)(addr_)), "v"((unsigned)(val_)) : "memory")
#define LDS_ST16(addr_, val_) asm volatile("ds_write_b16 %0, %1" :: "v"((unsigned)(addr_)), "v"((unsigned)(val_)) : "memory")
#define LDS_ADD32(addr_, val_) asm volatile("ds_add_u32 %0, %1" :: "v"((unsigned)(addr_)), "v"((unsigned)(val_)) : "memory")
        const unsigned hpw = (unsigned)(unsigned long)hp, scw = (unsigned)(unsigned long)sc;
        LDS_ST32(hpw + jj * 8, 0u); LDS_ST32(hpw + jj * 8 + 4, 0u);
        const int nit = (n + 511) >> 9;
        { const int base = (nit - 1) * 512 + jj * 8;
#pragma unroll
          for (int e = 0; e < 8; ++e) if (base + e >= n) LDS_ST16(scw + (base + e) * 2, 0u); }
        LDS_WAIT(); __builtin_amdgcn_wave_barrier();
        const unsigned B1 = b1 | (b1 << 16);
#pragma unroll 4
        for (int it = 0; it < nit; ++it) { const int base = it * 512 + jj * 8; const v4u x = *(const LAS v4u*)(sc + base);
#pragma unroll
            for (int i = 0; i < 4; ++i) { const unsigned d = (i == 0) ? x.x : (i == 1) ? x.y : (i == 2) ? x.z : x.w; const unsigned m = ((d >> 8) & 0x00ff00ffu) ^ B1;
                const unsigned l0 = d & 255u, l1 = (d >> 16) & 255u;
                LDS_ADD32(hpw + ((l0 >> 1) << 2), ((m & 0xffffu) == 0u) ? ((l0 & 1u) ? 0x10000u : 1u) : 0u);
                LDS_ADD32(hpw + ((l1 >> 1) << 2), ((m >> 16) == 0u) ? ((l1 & 1u) ? 0x10000u : 1u) : 0u); } }
        LDS_WAIT(); __builtin_amdgcn_wave_barrier();
        TPROBE_END(111);
        TPROBE_BEGIN(112);
        unsigned T, need2;
        { const v2u wv = *(const LAS v2u*)(hp + 126 - 2 * jj); unsigned hb[4];
          hb[3] = wv.x & 0xffffu; hb[2] = wv.x >> 16; hb[1] = wv.y & 0xffffu; hb[0] = wv.y >> 16;
          const unsigned s4 = hb[0] + hb[1] + hb[2] + hb[3];
          unsigned pre = s4;
#pragma unroll
          for (int o = 1; o < 64; o <<= 1) { const unsigned x = __shfl_up(pre, o, 64); if (jj >= o) pre += x; }
          const unsigned long long bal = __ballot(pre >= need1); const int js = __builtin_ctzll(bal);
          unsigned above = pre - s4, bb2 = 0, nd2 = 0; bool found = false;
#pragma unroll
          for (int i = 0; i < 4; ++i) { if (!found) { if (above + hb[i] >= need1) { bb2 = 255 - (jj * 4 + i); nd2 = need1 - above; found = true; } else above += hb[i]; } }
          const unsigned b2 = __shfl(bb2, js); need2 = __shfl(nd2, js); T = (b1 << 8) | b2; }
        TPROBE_END(112);
        TPROBE_BEGIN(113);
        const unsigned olw = (unsigned)(unsigned long)(OLB + ql * 512);
        const unsigned G = 256u - need2, Tp = T | (T << 16); unsigned cg = 0, tc = 0;
#pragma unroll 2
        for (int it = 0; it < nit; ++it) { const int base = it * 512 + jj * 8; const v4u x = *(const LAS v4u*)(sc + base);
            unsigned g[8], c = 0, anyeq = 0;
#pragma unroll
            for (int i = 0; i < 4; ++i) { const unsigned d = (i == 0) ? x.x : (i == 1) ? x.y : (i == 2) ? x.z : x.w;
                g[2 * i] = ((d & 0xffffu) > T) ? 1u : 0u; g[2 * i + 1] = ((d >> 16) > T) ? 1u : 0u; c += g[2 * i] + g[2 * i + 1];
                const unsigned q = d ^ Tp; anyeq |= (((q & 0xffffu) == 0u) || ((q >> 16) == 0u)) ? 1u : 0u; }
            const unsigned long long m0 = __ballot(c & 1u), m1 = __ballot(c & 2u), m2 = __ballot(c & 4u), m3 = __ballot(c & 8u);
            unsigned pos = cg + __builtin_amdgcn_mbcnt_hi((unsigned)(m0 >> 32), __builtin_amdgcn_mbcnt_lo((unsigned)m0, 0u)) + 2u * __builtin_amdgcn_mbcnt_hi((unsigned)(m1 >> 32), __builtin_amdgcn_mbcnt_lo((unsigned)m1, 0u))
                         + 4u * __builtin_amdgcn_mbcnt_hi((unsigned)(m2 >> 32), __builtin_amdgcn_mbcnt_lo((unsigned)m2, 0u)) + 8u * __builtin_amdgcn_mbcnt_hi((unsigned)(m3 >> 32), __builtin_amdgcn_mbcnt_lo((unsigned)m3, 0u));
            cg += (unsigned)__builtin_popcountll(m0) + 2u * (unsigned)__builtin_popcountll(m1) + 4u * (unsigned)__builtin_popcountll(m2) + 8u * (unsigned)__builtin_popcountll(m3);
#pragma unroll
            for (int e = 0; e < 8; ++e) { const unsigned a_ = olw + ((pos < 256u ? pos : 255u) << 1); if (g[e]) LDS_ST16(a_, base + e); pos += g[e]; }
            if (__ballot(anyeq) != 0ull) {
#pragma unroll
                for (int e = 0; e < 8; ++e) { const unsigned wd = (e < 2) ? x.x : (e < 4) ? x.y : (e < 6) ? x.z : x.w; const unsigned k = (e & 1) ? (wd >> 16) : (wd & 0xffffu);
                    const bool eq = k == T; const unsigned long long me = __ballot(eq);
                    const unsigned pe = tc + __builtin_amdgcn_mbcnt_hi((unsigned)(me >> 32), __builtin_amdgcn_mbcnt_lo((unsigned)me, 0u));
                    if (eq && pe < need2) LDS_ST16(olw + ((G + pe) << 1), base + e);
                    tc += (unsigned)__builtin_popcountll(me); } } }
#undef LDS_ST32
#undef LDS_ST16
#undef LDS_ADD32
        LDS_WAIT(); __builtin_amdgcn_wave_barrier();
        { const v2u x = *(const LAS v2u*)((LAS u16*)(OLB + ql * 512) + jj * 4); *(GAS v2u*)(SEL + tok * NSEL + jj * 4) = x; }
        TPROBE_END(113);
        TPROBE_END(101);
    }
#undef IDX_DMA
#undef IDX_PREFETCH
#undef IDX_UNIT
}

__device__ __forceinline__ void carry_phase(Frame& F) {
    const int gid = blockIdx.x * NTHR + F.tid; if (gid >= NGRP * NB * 64) return;
    const int p = gid & 63, b = (gid >> 6) & 3, g = gid >> 8;
    const float* A32 = (const float*)(F.ws + WS_A32) + g * 128; const float ar = A32[p * 2], ai = A32[p * 2 + 1];
    const float* SB = (const float*)(F.ws + WS_SBUF) + ((size_t)g * 512 + b * 128) * 128; bf16* UX = (bf16*)(F.ws + WS_UGX) + ((size_t)g * 512 + b * 128) * UGX_LD;
    float xr = 0.f, xi = 0.f;
    for (int c = 0; c < NCH; ++c) {
        UX[(size_t)c * UGX_LD + 512 + p] = (bf16)f2bf(xr); UX[(size_t)c * UGX_LD + 576 + p] = (bf16)f2bf(xi);
        const float sr = SB[c * 128 + p], si = SB[c * 128 + 64 + p];
        const float nr = ar * xr - ai * xi + sr, ni = ar * xi + ai * xr + si; xr = nr; xi = ni;
    }
}

template <int N> __device__ __forceinline__ void wait_vm() { asm volatile("s_waitcnt vmcnt(%0)" :: "n"(N) : "memory"); }
typedef short s16x4 __attribute__((ext_vector_type(4)));
__device__ __forceinline__ void attn_phase(Frame& F) {
    constexpr int WSTR = 20224;
    LAS unsigned char* RING = F.lds + F.wave * WSTR;
    LAS u16* SL = (LAS u16*)(RING + 16384);
    const bf16* Q = (const bf16*)(F.ws + WS_Q); const bf16* Kg = (const bf16*)(F.ws + WS_K); const bf16* Vg = (const bf16*)(F.ws + WS_V);
    const u16* SEL = (const u16*)(F.ws + WS_SEL); bf16* YA = (bf16*)(F.ws + WS_YATT);
    const int lane = F.lane, gw = blockIdx.x * NWAVES + F.wave, NGW = F.G * NWAVES;
    const int hd = lane & 15, kg = lane >> 4;
    const int l8 = lane >> 3, cpos = lane & 7;
    unsigned tra[8];
    { const int q4 = hd >> 2, p4 = hd & 3; const unsigned rb = (unsigned)(unsigned long)RING;
#pragma unroll
      for (int mt = 0; mt < 4; ++mt)
#pragma unroll
          for (int tl = 0; tl < 2; ++tl) { const int row = tl * 16 + kg * 4 + q4, cc = 2 * mt + (p4 >> 1), pos = cc ^ (2 * ((row >> 1) & 3)); tra[2 * mt + tl] = rb + row * 128 + pos * 16 + (p4 & 1) * 8; } }
    for (int it = gw; it < NTOK * 2; it += NGW) {
        const int tok = it >> 1, kvh = it & 1, t = tok & 4095; const size_t bbase = (size_t)(tok >> 12) * SEQ;
        const int nsel = (t + 1 < NSEL) ? t + 1 : NSEL;
        { const v2u x = *(const GAS v2u*)(SEL + (size_t)tok * NSEL + lane * 4); *(LAS v2u*)(SL + lane * 4) = x; }
        bf16x8 qf[2];
#pragma unroll
        for (int ks = 0; ks < 2; ++ks) { if (hd < 4) qf[ks] = *(const GAS bf16x8*)(Q + (size_t)tok * 512 + (kvh * 4 + hd) * 64 + ks * 32 + kg * 8); else qf[ks] = (bf16x8){0, 0, 0, 0, 0, 0, 0, 0}; }
        asm volatile("s_waitcnt vmcnt(0)" : "+v"(qf[0]), "+v"(qf[1]) :: "memory");
        LDS_WAIT(); __builtin_amdgcn_wave_barrier();
        const bf16* kbp = Kg + bbase * 128 + kvh * 64; const bf16* vbp = Vg + bbase * 128 + kvh * 64;
        f32x4 sc[8][2]; f32x4 oacc[4];
#pragma unroll
        for (int c = 0; c < 8; ++c) { sc[c][0] = (f32x4){0.f, 0.f, 0.f, 0.f}; sc[c][1] = (f32x4){0.f, 0.f, 0.f, 0.f}; }
#pragma unroll
        for (int m = 0; m < 4; ++m) oacc[m] = (f32x4){0.f, 0.f, 0.f, 0.f};
        float inv = 1.0f;
#define ATT_ISSUE(s) do { const int c_ = (s) & 7; const bool isk_ = (s) < 8; const bf16* gb_ = isk_ ? kbp : vbp; int sel_[4]; \
            _Pragma("unroll") for (int j_ = 0; j_ < 4; ++j_) { const int ki_ = c_ * 32 + j_ * 8 + l8; sel_[j_] = (int)SL[ki_ < nsel ? ki_ : 0]; } \
            _Pragma("unroll") for (int j_ = 0; j_ < 4; ++j_) { const int f_ = isk_ ? ((j_ & 1) * 4 + (lane >> 4)) : (2 * (lane >> 4)); \
                __builtin_amdgcn_global_load_lds((const unsigned*)(gb_ + (size_t)sel_[j_] * 128 + ((cpos ^ f_) << 3)), (LAS unsigned*)(RING + ((s) & 3) * 4096 + j_ * 1024), 16, 0, 0); } } while (0)
        ATT_ISSUE(0); ATT_ISSUE(1); ATT_ISSUE(2);
#pragma unroll
        for (int s = 0; s < 16; ++s) {
            if (s + 3 < 16) ATT_ISSUE(s + 3);
            if (s <= 12) wait_vm<12>(); else if (s == 13) wait_vm<8>(); else if (s == 14) wait_vm<4>(); else wait_vm<0>();
            const LAS unsigned char* buf = RING + (s & 3) * 4096;
            if (s < 8) {
#pragma unroll
                for (int tl = 0; tl < 2; ++tl)
#pragma unroll
                    for (int ks = 0; ks < 2; ++ks) { const bf16x8 af = *(const LAS bf16x8*)(buf + (tl * 16 + hd) * 128 + (((ks * 4 + kg) ^ (hd >> 1)) << 4));
                        sc[s][tl] = __builtin_amdgcn_mfma_f32_16x16x32_bf16(af, qf[ks], sc[s][tl], 0, 0, 0); }
                if (s == 7) {
                    float mx = -3.0e38f;
#pragma unroll
                    for (int c = 0; c < 8; ++c)
#pragma unroll
                        for (int tl = 0; tl < 2; ++tl)
#pragma unroll
                            for (int r = 0; r < 4; ++r) { const int key = c * 32 + tl * 16 + kg * 4 + r; const float v = (key < nsel) ? sc[c][tl][r] : -3.0e38f; sc[c][tl][r] = v; mx = fmaxf(mx, v); }
                    mx = fmaxf(mx, __shfl_xor(mx, 16)); mx = fmaxf(mx, __shfl_xor(mx, 32));
                    float sum = 0.f;
#pragma unroll
                    for (int c = 0; c < 8; ++c)
#pragma unroll
                        for (int tl = 0; tl < 2; ++tl)
#pragma unroll
                            for (int r = 0; r < 4; ++r) { const float e = __expf(sc[c][tl][r] - mx); sc[c][tl][r] = e; sum += e; }
                    sum += __shfl_xor(sum, 16); sum += __shfl_xor(sum, 32);
                    inv = 1.0f / sum;
                }
            } else {
                const int c = s - 8;
                v4u pw; pw.x = pg8::cvt_pk_bf16(sc[c][0][0], sc[c][0][1]); pw.y = pg8::cvt_pk_bf16(sc[c][0][2], sc[c][0][3]); pw.z = pg8::cvt_pk_bf16(sc[c][1][0], sc[c][1][1]); pw.w = pg8::cvt_pk_bf16(sc[c][1][2], sc[c][1][3]);
                const bf16x8 pf = __builtin_bit_cast(bf16x8, pw);
                v2u a[8];
                asm volatile("ds_read_b64_tr_b16 %0, %8 offset:%16\n\tds_read_b64_tr_b16 %1, %9 offset:%16\n\tds_read_b64_tr_b16 %2, %10 offset:%16\n\tds_read_b64_tr_b16 %3, %11 offset:%16\n\t"
                             "ds_read_b64_tr_b16 %4, %12 offset:%16\n\tds_read_b64_tr_b16 %5, %13 offset:%16\n\tds_read_b64_tr_b16 %6, %14 offset:%16\n\tds_read_b64_tr_b16 %7, %15 offset:%16\n\ts_waitcnt lgkmcnt(0)"
                             : "=&v"(a[0]), "=&v"(a[1]), "=&v"(a[2]), "=&v"(a[3]), "=&v"(a[4]), "=&v"(a[5]), "=&v"(a[6]), "=&v"(a[7])
                             : "v"(tra[0]), "v"(tra[1]), "v"(tra[2]), "v"(tra[3]), "v"(tra[4]), "v"(tra[5]), "v"(tra[6]), "v"(tra[7]), "n"((s & 3) * 4096) : "memory");
#pragma unroll
                for (int mt = 0; mt < 4; ++mt) {
                    v4u aw; aw.x = a[2 * mt].x; aw.y = a[2 * mt].y; aw.z = a[2 * mt + 1].x; aw.w = a[2 * mt + 1].y;
                    oacc[mt] = __builtin_amdgcn_mfma_f32_16x16x32_bf16(__builtin_bit_cast(bf16x8, aw), pf, oacc[mt], 0, 0, 0);
                }
            }
        }
#undef ATT_ISSUE
        if (hd < 4) {
            bf16* yo = YA + (size_t)tok * 512 + (kvh * 4 + hd) * 64 + kg * 4;
#pragma unroll
            for (int mt = 0; mt < 4; ++mt) { pg8::u32x2 w; w.x = pg8::cvt_pk_bf16(oacc[mt][0] * inv, oacc[mt][1] * inv); w.y = pg8::cvt_pk_bf16(oacc[mt][2] * inv, oacc[mt][3] * inv); *(GAS pg8::u32x2*)(yo + 16 * mt) = w; }
        }
        LDS_WAIT(); __builtin_amdgcn_wave_barrier();
    }
}

__device__ __forceinline__ void router_phase(Frame& F) {
    LAS float* HR = (LAS float*)(F.lds);
    LAS float* PT = (LAS float*)(F.lds + 65536);
    LAS int* LE = (LAS int*)(F.lds + 81920);
    LAS int* LP = (LAS int*)(F.lds + 82944);
    LAS unsigned* LC = (LAS unsigned*)(F.lds + 83968);
    const float* X1 = (const float*)(F.ws + WS_X1); bf16* H2 = (bf16*)(F.ws + WS_H2);
    const float* WR = F.in[I_WR]; const float* BR = F.in[I_BR]; const float* G2 = F.in[I_N2G];
    int* TOPE = (int*)(F.ws + WS_TOPE); float* TOPW = (float*)(F.ws + WS_TOPW); int* TOPPOS = (int*)(F.ws + WS_TOPPOS); int* ROWMAP = (int*)(F.ws + WS_ROWMAP);
    const int tid = F.tid, lane = F.lane, wave = F.wave, e = lane & 31, dh = lane >> 5;
    float wr[64];
#pragma unroll
    for (int i = 0; i < 64; ++i) wr[i] = WR[(size_t)(128 * wave + dh * 64 + i) * 32 + e];
    if (tid < 64) LC[tid] = 0u;
    const int tok0 = blockIdx.x * 64;
    f32x4 nv[2][4];
#pragma unroll
    for (int rr = 0; rr < 2; ++rr)
#pragma unroll
        for (int j = 0; j < 4; ++j) nv[rr][j] = ((const GAS f32x4*)(X1 + (size_t)(tok0 + 2 * wave + rr) * DM) + lane)[64 * j];
    for (int bt = 0; bt < 4; ++bt) {
        __syncthreads();
#pragma unroll
        for (int rr = 0; rr < 2; ++rr) { const int lr = 2 * wave + rr, tok = tok0 + bt * 16 + lr;
            const GAS f32x4* gr = (const GAS f32x4*)G2 + lane;
            f32x4 v[4]; float s2 = 0.f;
#pragma unroll
            for (int j = 0; j < 4; ++j) { v[j] = nv[rr][j]; s2 += (v[j].x * v[j].x + v[j].y * v[j].y) + (v[j].z * v[j].z + v[j].w * v[j].w); }
            const float rstd = 1.0f / sqrtf(wave_sum(s2) * (1.f / DM) + RMS_EPS);
            GAS unsigned long long* o8 = (GAS unsigned long long*)(H2 + (size_t)tok * DM) + lane;
#pragma unroll
            for (int j = 0; j < 4; ++j) { const f32x4 gg = gr[64 * j]; const f32x4 h = v[j] * rstd * gg;
                *(LAS f32x4*)(HR + lr * 1024 + 256 * j + 4 * lane) = h;
                o8[64 * j] = (unsigned long long)pk2(h.x, h.y) | ((unsigned long long)pk2(h.z, h.w) << 32); } }
        if (bt + 1 < 4) {
#pragma unroll
            for (int rr = 0; rr < 2; ++rr)
#pragma unroll
                for (int j = 0; j < 4; ++j) nv[rr][j] = ((const GAS f32x4*)(X1 + (size_t)(tok0 + (bt + 1) * 16 + 2 * wave + rr) * DM) + lane)[64 * j];
        }
        __syncthreads();
#pragma unroll 2
        for (int lr = 0; lr < 16; ++lr) { const LAS float* hp = HR + lr * 1024 + 128 * wave + dh * 64; float s = 0.f;
#pragma unroll
            for (int i = 0; i < 16; ++i) { const f32x4 h = *(const LAS f32x4*)(hp + 4 * i); s += h[0] * wr[4 * i] + h[1] * wr[4 * i + 1] + h[2] * wr[4 * i + 2] + h[3] * wr[4 * i + 3]; }
            s += __shfl_xor(s, 32);
            if (dh == 0) PT[(lr * 8 + wave) * 32 + e] = s; }
        __syncthreads();
        { const int lr = 2 * wave + dh, tl = bt * 16 + lr, tok = tok0 + tl; float lg = BR[e];
#pragma unroll
          for (int w8 = 0; w8 < 8; ++w8) lg += PT[(lr * 8 + w8) * 32 + e];
          float cur = lg; float tv[4]; int te[4];
#pragma unroll
          for (int k = 0; k < 4; ++k) { float mv = cur; int mi = e;
#pragma unroll
              for (int o = 1; o < 32; o <<= 1) { const float ov = __shfl_xor(mv, o); const int oi = __shfl_xor(mi, o); if (ov > mv || (ov == mv && oi < mi)) { mv = ov; mi = oi; } }
              tv[k] = mv; te[k] = mi; if (e == mi) cur = -3.0e38f; }
          const float e1 = __expf(tv[1] - tv[0]), e2 = __expf(tv[2] - tv[0]), e3 = __expf(tv[3] - tv[0]); const float inv = 1.0f / (1.0f + e1 + e2 + e3);
          if (e < 4) { const int ex = (e == 0) ? te[0] : (e == 1) ? te[1] : (e == 2) ? te[2] : te[3]; const float wv = ((e == 0) ? 1.0f : (e == 1) ? e1 : (e == 2) ? e2 : e3) * inv;
              TOPE[(size_t)tok * 4 + e] = ex; TOPW[(size_t)tok * 4 + e] = wv; LE[tl * 4 + e] = ex; LP[tl * 4 + e] = (int)atomicAdd((unsigned*)&LC[ex], 1u); } }
    }
    __syncthreads();
    if (tid < 32) LC[32 + tid] = __hip_atomic_fetch_add((unsigned*)(F.ctl + CW_ECNT) + tid, LC[tid], RLX_AGENT);
    __syncthreads();
    if (tid < 256) { const int ex = LE[tid], pos = (int)LC[32 + ex] + LP[tid], tok = tok0 + (tid >> 2); TOPPOS[(size_t)tok * 4 + (tid & 3)] = pos; ROWMAP[(size_t)ex * NTOK + pos] = tok; }
}

__device__ __forceinline__ int moe_tables(Frame& F, LAS int* OFF, LAS int* TE) {
    __syncthreads();
    if (F.tid == 0) { int acc = 0; for (int e = 0; e < NEXP; ++e) { const int c = (int)__hip_atomic_load((unsigned*)(F.ctl + CW_ECNT) + e, RLX_AGENT); const int nt = (c + 255) >> 8; OFF[e] = acc * 256; OFF[33 + e] = c; for (int i = 0; i < nt; ++i) TE[acc + i] = e; acc += nt; } OFF[NEXP] = acc; }
    __syncthreads();
    return OFF[NEXP];
}
__device__ __forceinline__ void combine_phase(Frame& F) {
    LAS int* OFF = (LAS int*)(F.lds + MISC_OFF + 512); LAS int* TE = OFF + 72;
    (void)moe_tables(F, OFF, TE);
    const int* TOPE = (const int*)(F.ws + WS_TOPE); const int* TOPPOS = (const int*)(F.ws + WS_TOPPOS); const float* TOPW = (const float*)(F.ws + WS_TOPW);
    const float* X1 = (const float*)(F.ws + WS_X1); const bf16* Y2 = (const bf16*)(F.ws + WS_Y2); const float* GF = F.in[I_NFG];
    const int gw = blockIdx.x * NWAVES + F.wave, NGW = F.G * NWAVES, lane = F.lane;
    for (int tok = gw; tok < NTOK; tok += NGW) {
        f32x4 v[4];
#pragma unroll
        for (int j = 0; j < 4; ++j) v[j] = ((const GAS f32x4*)(X1 + (size_t)tok * DM) + lane)[64 * j];
#pragma unroll
        for (int k = 0; k < 4; ++k) { const int slot = OFF[TOPE[tok * 4 + k]] + TOPPOS[tok * 4 + k]; const float wk = TOPW[tok * 4 + k];
            const GAS v2u* yr = (const GAS v2u*)(Y2 + (size_t)slot * DM) + lane;
#pragma unroll
            for (int j = 0; j < 4; ++j) { const v2u y = yr[64 * j]; v[j].x += wk * bflo(y.x); v[j].y += wk * bfhi(y.x); v[j].z += wk * bflo(y.y); v[j].w += wk * bfhi(y.y); } }
        float s2 = 0.f;
#pragma unroll
        for (int j = 0; j < 4; ++j) s2 += (v[j].x * v[j].x + v[j].y * v[j].y) + (v[j].z * v[j].z + v[j].w * v[j].w);
        const float rstd = 1.0f / sqrtf(wave_sum(s2) * (1.f / DM) + RMS_EPS);
#pragma unroll
        for (int j = 0; j < 4; ++j) { const f32x4 gg = ((const GAS f32x4*)GF + lane)[64 * j]; ((GAS f32x4*)(F.out + (size_t)tok * DM) + lane)[64 * j] = v[j] * rstd * gg; }
    }
}

__device__ __forceinline__ void ubench(Frame& F) {
    bf16x8 a = (bf16x8){1, 2, 3, 4, 5, 6, 7, 8}, b = (bf16x8){8, 7, 6, 5, 4, 3, 2, 1}; a[0] = (short)F.lane;
    float sink = 0.f;
    if (PROBE_DUP == 900) { f32x16 c0 = {0.f, 0.f, 0.f, 0.f, 0.f, 0.f, 0.f, 0.f, 0.f, 0.f, 0.f, 0.f, 0.f, 0.f, 0.f, 0.f}, c1 = c0;
        for (int i = 0; i < 2000; ++i) { c0 = __builtin_amdgcn_mfma_f32_32x32x16_bf16(a, b, c0, 0, 0, 0); c1 = __builtin_amdgcn_mfma_f32_32x32x16_bf16(a, b, c1, 0, 0, 0); }
        sink = c0[0] + c1[5]; }
    if (PROBE_DUP == 901) { f32x4 c0 = {0.f, 0.f, 0.f, 0.f}, c1 = c0, c2 = c0, c3 = c0;
        for (int i = 0; i < 2000; ++i) { c0 = __builtin_amdgcn_mfma_f32_16x16x32_bf16(a, b, c0, 0, 0, 0); c1 = __builtin_amdgcn_mfma_f32_16x16x32_bf16(a, b, c1, 0, 0, 0); c2 = __builtin_amdgcn_mfma_f32_16x16x32_bf16(a, b, c2, 0, 0, 0); c3 = __builtin_amdgcn_mfma_f32_16x16x32_bf16(a, b, c3, 0, 0, 0); }
        sink = c0[0] + c1[1] + c2[2] + c3[3]; }
    if (PROBE_DUP == 902) { float x0 = F.lane, x1 = 1.f, x2 = 2.f, x3 = 3.f, x4 = 4.f, x5 = 5.f, x6 = 6.f, x7 = 7.f; const float m = 1.0001f, d = 0.5f;
        for (int i = 0; i < 4000; ++i) { x0 = x0 * m + d; x1 = x1 * m + d; x2 = x2 * m + d; x3 = x3 * m + d; x4 = x4 * m + d; x5 = x5 * m + d; x6 = x6 * m + d; x7 = x7 * m + d; }
        sink = x0 + x1 + x2 + x3 + x4 + x5 + x6 + x7; }
    if (PROBE_DUP == 903) {
        f32x4 c[4]; float s = 0.f; float wv[16];
#pragma unroll
        for (int i = 0; i < 4; ++i) c[i] = (f32x4){0.f, 0.f, 0.f, 0.f};
#pragma unroll
        for (int i = 0; i < 16; ++i) wv[i] = 0.001f * (i + F.lane);
        for (int it = 0; it < 275; ++it) { f32x4 d[4];
#pragma unroll
            for (int i = 0; i < 4; ++i) { d[i] = (f32x4){0.f, 0.f, 0.f, 0.f}; d[i] = __builtin_amdgcn_mfma_f32_16x16x32_bf16(a, b, d[i], 0, 0, 0); d[i] = __builtin_amdgcn_mfma_f32_16x16x32_bf16(b, a, d[i], 0, 0, 0); }
            float t = 0.f;
#pragma unroll
            for (int i = 0; i < 4; ++i)
#pragma unroll
                for (int r = 0; r < 4; ++r) { const float x = c[i][r]; const int xi = __builtin_bit_cast(int, x); const float m = __builtin_bit_cast(float, xi > 0 ? xi : 0); t += wv[4 * i + r] * m; }
            float u = t;
#pragma unroll
            for (int k = 0; k < 12; ++k) u = u * 1.0001f + 0.5f;
            s += u; a[1] = (short)(it + (int)s);
#pragma unroll
            for (int i = 0; i < 4; ++i) c[i] = d[i]; }
        sink = s; }
    if (sink == 123.456f) ((float*)(F.ws + WS_SBUF))[F.tid] = sink;
}

constexpr int NPHASE = 12;
struct Args { const float* in[25]; float* out; unsigned char* ws; int ph_lo, ph_hi; };
__global__ void __launch_bounds__(NTHR, 2) fwd_kernel(Args args) {
    extern __shared__ __attribute__((aligned(16))) unsigned char lds[];
    Frame F;
    F.lds = (LAS unsigned char*)lds;
    F.MISC = (volatile LAS unsigned*)(F.lds + MISC_OFF);
    F.tid = threadIdx.x; F.lane = F.tid & 63; F.wave = __builtin_amdgcn_readfirstlane(F.tid >> 6); F.G = gridDim.x;
    F.ws = args.ws; F.ctl = (gu32*)(args.ws + WS_CTL); F.out = args.out;
#pragma unroll
    for (int i = 0; i < 25; ++i) F.in[i] = args.in[i];
    for (int u = F.tid; u < 2048 / 4; u += NTHR) ((LAS unsigned*)(F.lds + MISC_OFF))[u] = 0u;
    __syncthreads();
    XcdBarrier bar; bar.bar = (unsigned*)(F.ctl + CW_BAR); bar.x = 0; bar.st = nullptr;
    if (MK_N_LAUNCHES == 1) bar = xcd_barrier_post((unsigned*)(F.ctl + CW_BAR), F.MISC + 8);
    const int lo = args.ph_lo, hi = args.ph_hi;
#define IN(k) (lo <= (k) && (k) < hi)
#define SEAM(k) do { if (IN(k) && IN((k) + 1)) xcd_barrier(bar); } while (0)
    unsigned char* ws = F.ws; const int c = (int)blockIdx.x;

#define BODY_P0 { p0_prologue(F); if (PROBE_DUP >= 900) ubench(F); }
#define BODY_P1 { pg8::Gemm g{(const bf16*)(ws + WS_XN), (const bf16*)(ws + WS_WIN), 1024, 1024, 1024, 0}; StaticOrder S; S.init(NTOK / 256, NIN_PAD / 256, F.G, c); \
        EpiInProj E{ws, F.in[I_BGATE]}; pg8::gemm_phase<EpiInProj, StaticOrder>(F.lds, g, S, E); }
#define BODY_P2 { { pg8::Gemm g{(const bf16*)(ws + WS_UGX), (const bf16*)(ws + WS_WS), UGX_LD, 512, 512, 0}; S5StateOrder S{c}; EpiS5State E{(float*)(ws + WS_SBUF)}; \
          pg8::gemm_phase<EpiS5State, S5StateOrder>(F.lds, g, S, E); if (PROBE_DUP == 202) { xcd_barrier(bar); pg8::gemm_phase<EpiS5State, S5StateOrder>(F.lds, g, S, E); } } idx_phase(F); if (PROBE_DUP == 102) { xcd_barrier(bar); idx_phase(F); } }
#define BODY_P3 { carry_phase(F); attn_phase(F); }
#define BODY_P4 { pg8::Gemm g{(const bf16*)(ws + WS_UGX), (const bf16*)(ws + WS_MT), UGX_LD, UGX_LD, 640, 0}; S5YOrder S{c}; EpiS5Y E{(const bf16*)(ws + WS_UGX), F.in[I_SD], (bf16*)(ws + WS_YG)}; \
        pg8::gemm_phase<EpiS5Y, S5YOrder>(F.lds, g, S, E); }
#define BODY_P5 { pg8::Gemm g{(const bf16*)(ws + WS_YG), (const bf16*)(ws + WS_WGLU), 512, 512, 512, 0}; StaticOrder S; S.init(NTOK / 256, 2, F.G, c); EpiGlu E{(const bf16*)(ws + WS_YG), F.in[I_BGLU], (bf16*)(ws + WS_YSSM)}; \
        pg8::gemm_phase<EpiGlu, StaticOrder>(F.lds, g, S, E); }
#define BODY_P6 { pg8::Gemm g{(const bf16*)(ws + WS_YSSM), (const bf16*)(ws + WS_WPS), 512, 512, 512, 0}; MixOrder S; S.so.init(NTOK / 256, 4, F.G, c); \
        EpiMix E{(const bf16*)(ws + WS_GS), (const bf16*)(ws + WS_GA), (bf16*)(ws + WS_MIXED)}; pg8::gemm_phase<EpiMix, MixOrder>(F.lds, g, S, E); }
#define BODY_P7 { pg8::Gemm g{(const bf16*)(ws + WS_MIXED), (const bf16*)(ws + WS_WOUT), 1024, 1024, 1024, 0}; StaticOrder S; S.init(NTOK / 256, 4, F.G, c); EpiOut E{F.in[I_X], (float*)(ws + WS_X1)}; \
        pg8::gemm_phase<EpiOut, StaticOrder>(F.lds, g, S, E); }
#define BODY_P8 { router_phase(F); }
#define BODY_P9 { LAS int* OFF = (LAS int*)(F.lds + MISC_OFF + 512); LAS int* TE = OFF + 72; const int TT = moe_tables(F, OFF, TE); \
        pg8::Gemm g{(const bf16*)(ws + WS_H2), (const bf16*)(ws + WS_WMI), 1024, 2048, 1024, (size_t)1024 * 2048 * 2}; MoeOrder S{TE, OFF, OFF + 33, (const int*)(ws + WS_ROWMAP), TT, 8, c}; EpiMoe1 E{F.in[I_BMI], (bf16*)(ws + WS_ACT)}; \
        pg8::gemm_phase<EpiMoe1, MoeOrder, true, true>(F.lds, g, S, E); }
#define BODY_P10 { LAS int* OFF = (LAS int*)(F.lds + MISC_OFF + 512); LAS int* TE = OFF + 72; const int TT = moe_tables(F, OFF, TE); \
        pg8::Gemm g{(const bf16*)(ws + WS_ACT), (const bf16*)(ws + WS_WMO), 1024, 1024, 1024, (size_t)1024 * 1024 * 2}; MoeOrder S{TE, OFF, OFF + 33, nullptr, TT, 4, c}; EpiMoe2 E{F.in[I_BMO], (bf16*)(ws + WS_Y2)}; \
        pg8::gemm_phase<EpiMoe2, MoeOrder, true, true>(F.lds, g, S, E); }
#define BODY_P11 { combine_phase(F); }
#define PHASE(k, BODY) if (IN(k)) { TPROBE_BEGIN(k); BODY TPROBE_END(k); if (PROBE_DUP == (k)) { xcd_barrier(bar); BODY } } SEAM(k);
    PHASE(0, BODY_P0) PHASE(1, BODY_P1) PHASE(2, BODY_P2) PHASE(3, BODY_P3) PHASE(4, BODY_P4) PHASE(5, BODY_P5) PHASE(6, BODY_P6)
    PHASE(7, BODY_P7) PHASE(8, BODY_P8) PHASE(9, BODY_P9) PHASE(10, BODY_P10) PHASE(11, BODY_P11)
#undef IN
#undef SEAM
}

extern "C" void kernel_launch(void* const* d_in, const int* in_sizes, int n_in, void* d_out, int out_size, void* d_ws, size_t ws_size, hipStream_t stream) {
    static int grid = 0;
    if (grid == 0) {
        if (n_in != 25 || out_size != NTOK * DM || ws_size < WS_END) { fprintf(stderr, "kernel_launch: unexpected problem (n_in %d out %d ws %zu)\n", n_in, out_size, ws_size); grid = -1; return; }
        if (hipFuncSetAttribute((const void*)fwd_kernel, hipFuncAttributeMaxDynamicSharedMemorySize, LDS_BYTES) != hipSuccess) { fprintf(stderr, "kernel_launch: hipFuncSetAttribute failed\n"); grid = -1; return; }
        int per_cu = 0; (void)hipOccupancyMaxActiveBlocksPerMultiprocessor(&per_cu, (const void*)fwd_kernel, NTHR, LDS_BYTES); (void)hipGetLastError();
        grid = 256;
    }
    if (grid < 0) return;
    (void)hipMemsetAsync((char*)d_ws + WS_CTL, 0, CTL_ZERO_BYTES, stream);
    Args a{};
    for (int i = 0; i < 25; ++i) a.in[i] = (const float*)d_in[i];
    a.out = (float*)d_out; a.ws = (unsigned char*)d_ws;
    if (MK_N_LAUNCHES == 1) { a.ph_lo = 0; a.ph_hi = NPHASE; hipLaunchKernelGGL(fwd_kernel, dim3(grid), dim3(NTHR), LDS_BYTES, stream, a); }
    else for (int p = 0; p < NPHASE; ++p) { a.ph_lo = p; a.ph_hi = p + 1; hipLaunchKernelGGL(fwd_kernel, dim3(grid), dim3(NTHR), LDS_BYTES, stream, a); }
}
```

```cpp
#include <hip/hip_runtime.h>
#include <cstdio>
#include <cstdint>

#ifndef MK_N_LAUNCHES
#define MK_N_LAUNCHES 1
#endif
#ifndef PROBE_DUP
#define PROBE_DUP -1
#endif
#ifndef PROBE_T
#define PROBE_T -1
#endif
#define TPROBE_BEGIN(id) unsigned long long tpb_##id = (PROBE_T == (id)) ? __builtin_amdgcn_s_memrealtime() : 0ull
#define TPROBE_END(id) do { if (PROBE_T == (id)) { const unsigned long long d_ = __builtin_amdgcn_s_memrealtime() - tpb_##id, t1_ = __builtin_amdgcn_s_memrealtime(); while (__builtin_amdgcn_s_memrealtime() - t1_ < 4ull * d_) __builtin_amdgcn_s_sleep(8); } } while (0)

namespace pg8 {
#define PG8_LAS __attribute__((address_space(3)))
typedef unsigned short bf16_t;
typedef short bf16x8 __attribute__((ext_vector_type(8)));
typedef float f32x4 __attribute__((ext_vector_type(4)));
typedef float f32x2 __attribute__((ext_vector_type(2)));
typedef unsigned u32x4 __attribute__((ext_vector_type(4)));
typedef unsigned u32x2 __attribute__((ext_vector_type(2)));
constexpr int BM = 256, BK = 64, HALF = 128, HTB = HALF * BK * 2, STAGE_BYTES = 8 * HTB, NXCD = 8, WGM = 8;

__host__ __device__ __forceinline__ int lds_byte(int r, int c) { const int st = (r >> 4) * 2 + (c >> 5), rr = r & 15, cc = c & 31, ob = rr * 64 + cc * 2; return st * 1024 + (ob ^ (((ob >> 9) & 1) << 5)); }
__host__ __device__ __forceinline__ void stage_rc(int b, int& R, int& C) { const int st = b / 1024, sb = b % 1024, swz = sb ^ (((sb >> 9) & 1) << 5); R = (st >> 1) * 16 + swz / 64; C = (st & 1) * 32 + (swz % 64) / 2; }
__host__ __device__ __forceinline__ int perm32(int rho) { const int n = rho >> 4, i = rho & 15; return 8 * (i >> 2) + 4 * n + (i & 3); }

struct Unit { int pm, pn, pa, pb, e; };
struct Gemm { const bf16_t* A; const bf16_t* Bt; int lda, ldb, K; size_t bexp; };

__device__ __forceinline__ unsigned cvt_pk_bf16(float lo, float hi) { unsigned r; asm volatile("v_cvt_pk_bf16_f32 %0, %1, %2" : "=v"(r) : "v"(lo), "v"(hi)); return r; }
__device__ __forceinline__ u32x4 pack8(const f32x4& v0, const f32x4& v1) { u32x4 w; w.x = cvt_pk_bf16(v0[0], v0[1]); w.y = cvt_pk_bf16(v0[2], v0[3]); w.z = cvt_pk_bf16(v1[0], v1[1]); w.w = cvt_pk_bf16(v1[2], v1[3]); return w; }

template <class Epi, class Sched, bool ALIGN_EPI = true, bool BKN = false>
__device__ __forceinline__ void gemm_phase(PG8_LAS unsigned char* lds, const Gemm g, const Sched& S, const Epi& E) {
    const int tid = threadIdx.x, wid = __builtin_amdgcn_readfirstlane(tid >> 6), lane = tid & 63, wr = wid >> 2, wc = wid & 3, fr = lane & 15, fq = lane >> 4;
    const int K = g.K, nt = K / BK;
    unsigned voffB[2];
#pragma unroll
    for (int i = 0; i < 2; ++i) {
        if constexpr (BKN) { const int krow = (tid >> 4) + 32 * i, cp = tid & 15, fk = ((krow & 3) << 1) | (((krow >> 3) & 1) << 3); voffB[i] = (unsigned)(krow * g.ldb) * 2u + (unsigned)((cp ^ fk) << 4); }
        else { int R, C; stage_rc(tid * 16 + i * 8192, R, C); const int Rb = (R & ~31) + perm32(R & 31); voffB[i] = (unsigned)(Rb * g.ldb + C) * 2u; } }
    const size_t kstep = (size_t)(BK * 2);
    const size_t kstepB = BKN ? (size_t)BK * g.ldb * 2 : kstep;
    const size_t hstepB = BKN ? (size_t)256 : (size_t)HALF * g.ldb * 2;
    const size_t tstepB = BKN ? (size_t)512 : 2 * hstepB;
    const unsigned tbase = (unsigned)(unsigned long)lds + (unsigned)((8 * fq + (fr >> 2)) * 256 + (((4 * wc + (fr & 3)) ^ (((fr >> 2) << 1) | ((fq & 1) << 3))) << 4));
#define PG8_AROWS(VV, U) do { _Pragma("unroll") for (int i_ = 0; i_ < 2; ++i_) { int R_, C_; stage_rc((threadIdx.x & 511) * 16 + i_ * 8192, R_, C_); \
        _Pragma("unroll") for (int h_ = 0; h_ < 2; ++h_) VV[h_][i_] = (unsigned)(S.arow(U, h_, R_) * g.lda + C_) * 2u; } } while (0)
    unsigned vA[2][2], vAn[2][2];
    const unsigned ldsw = (unsigned)wid * 1024u;
    const int aoff = lds_byte(wr * 64 + fr, fq * 8), boff = lds_byte(wc * 32 + fr, fq * 8);
#define PG8_SA(b, h) (((b) * 2 + (h)) * HTB)
#define PG8_SB(b, h) ((4 + (b) * 2 + (h)) * HTB)
#define PG8_STAGE(bufoff, gbase, voff) do { _Pragma("unroll") for (int _i = 0; _i < 2; ++_i) \
        __builtin_amdgcn_global_load_lds((const unsigned*)((const char*)(gbase) + (voff)[_i]), (PG8_LAS unsigned*)(lds + (bufoff) + ldsw + _i * 8192), 16, 0, 0); } while (0)
#define PG8_LDA(dst, b, h) do { _Pragma("unroll") for (int m = 0; m < 4; ++m) _Pragma("unroll") for (int k = 0; k < 2; ++k) dst[m][k] = *(const PG8_LAS bf16x8*)(lds + PG8_SA(b, h) + aoff + m * 2048 + k * 1024); } while (0)
#define PG8_LDB(dst, b, h) do { if constexpr (BKN) { const unsigned ab_ = tbase + PG8_SB(b, h); _Pragma("unroll") for (int n = 0; n < 2; ++n) _Pragma("unroll") for (int k = 0; k < 2; ++k) { u32x2 lo_, hi_; \
            asm volatile("ds_read_b64_tr_b16 %0, %2 offset:%3\n\tds_read_b64_tr_b16 %1, %2 offset:%4" : "=&v"(lo_), "=&v"(hi_) : "v"(ab_), "n"(k * 8192 + n * 8), "n"(k * 8192 + n * 8 + 1024) : "memory"); \
            u32x4 w_; w_.x = lo_.x; w_.y = lo_.y; w_.z = hi_.x; w_.w = hi_.y; dst[n][k] = __builtin_bit_cast(bf16x8, w_); } } \
        else { _Pragma("unroll") for (int n = 0; n < 2; ++n) _Pragma("unroll") for (int k = 0; k < 2; ++k) dst[n][k] = *(const PG8_LAS bf16x8*)(lds + PG8_SB(b, h) + boff + n * 2048 + k * 1024); } } while (0)
#define PG8_WAIT_LB() do { if constexpr (BKN) asm volatile("s_waitcnt lgkmcnt(0)" : "+v"(B0[0][0]), "+v"(B0[0][1]), "+v"(B0[1][0]), "+v"(B0[1][1]), "+v"(B1[0][0]), "+v"(B1[0][1]), "+v"(B1[1][0]), "+v"(B1[1][1]) :: "memory"); \
        else asm volatile("s_waitcnt lgkmcnt(0)" ::: "memory"); } while (0)
#define PG8_MMA(ai, bj, At, Bt) do { __builtin_amdgcn_s_setprio(1); _Pragma("unroll") for (int m = 0; m < 4; ++m) _Pragma("unroll") for (int n = 0; n < 2; ++n) _Pragma("unroll") for (int k = 0; k < 2; ++k) \
        acc[ai][bj][m][n] = __builtin_amdgcn_mfma_f32_16x16x32_bf16(Bt[n][k], At[m][k], acc[ai][bj][m][n], 0, 0, 0); __builtin_amdgcn_s_setprio(0); } while (0)
#define PG8_WAIT_V(n) asm volatile("s_waitcnt vmcnt(" #n ")" ::: "memory")
#define PG8_WAIT_L(n) asm volatile("s_waitcnt lgkmcnt(" #n ")" ::: "memory")
#define PG8_BAR __builtin_amdgcn_s_barrier()
#define PG8_SCHED __builtin_amdgcn_sched_barrier(0)
    Unit cur, nxt; int ui = 0;
    if (!S.next(0, cur)) return;
    f32x4 acc[2][2][4][2];
#pragma unroll
    for (int a = 0; a < 2; ++a)
#pragma unroll
        for (int b = 0; b < 2; ++b)
#pragma unroll
            for (int m = 0; m < 4; ++m)
#pragma unroll
                for (int n = 0; n < 2; ++n) acc[a][b][m][n] = (f32x4){0.f, 0.f, 0.f, 0.f};
    bf16x8 At[4][2], B0[2][2], B1[2][2];
    const char* const bA = (const char*)g.A; const char* cB = BKN ? (const char*)g.Bt + (size_t)cur.e * g.bexp + (size_t)cur.pn * tstepB : (const char*)g.Bt + (size_t)cur.pb * tstepB;
    PG8_AROWS(vA, cur);
    PG8_STAGE(PG8_SB(0, 0), cB, voffB); PG8_STAGE(PG8_SB(0, 1), cB + hstepB, voffB); PG8_STAGE(PG8_SA(0, 0), bA, vA[0]); PG8_STAGE(PG8_SA(0, 1), bA, vA[1]);
    if (wr == 1) PG8_BAR;
    PG8_WAIT_V(2); PG8_BAR;
    PG8_STAGE(PG8_SB(1, 0), cB + kstepB, voffB); PG8_STAGE(PG8_SA(1, 0), bA + kstep, vA[0]); PG8_STAGE(PG8_SB(1, 1), cB + hstepB + kstepB, voffB);
    PG8_WAIT_V(6); PG8_BAR;
    for (;;) {
        const bool has_next = S.next(ui + 1, nxt);
        const char* nB = has_next ? (BKN ? (const char*)g.Bt + (size_t)nxt.e * g.bexp + (size_t)nxt.pn * tstepB : (const char*)g.Bt + (size_t)nxt.pb * tstepB) : cB;
        if (has_next) PG8_AROWS(vAn, nxt); else { vAn[0][0] = vA[0][0]; vAn[0][1] = vA[0][1]; vAn[1][0] = vA[1][0]; vAn[1][1] = vA[1][1]; }
        for (int t = 0; t < nt; t += 2) {
            const bool last = (t == nt - 2);
            const char* a1 = bA + (size_t)(t + 1) * kstep;
            const char* a2 = last ? bA : bA + (size_t)(t + 2) * kstep; const char* b2 = last ? nB : cB + (size_t)(t + 2) * kstepB;
            const char* a3 = a2 + kstep; const char* b3 = b2 + kstepB;
            unsigned w0[2], w1[2];
            w0[0] = last ? vAn[0][0] : vA[0][0]; w0[1] = last ? vAn[0][1] : vA[0][1]; w1[0] = last ? vAn[1][0] : vA[1][0]; w1[1] = last ? vAn[1][1] : vA[1][1];
            PG8_LDB(B0, 0, 0); PG8_LDB(B1, 0, 1); PG8_SCHED; PG8_LDA(At, 0, 0); PG8_STAGE(PG8_SA(1, 1), a1, vA[1]);
            PG8_WAIT_V(8); PG8_WAIT_LB(); PG8_BAR; PG8_MMA(0, 0, At, B0); PG8_MMA(0, 1, At, B1); PG8_BAR; PG8_SCHED;
            PG8_LDA(At, 0, 1); PG8_STAGE(PG8_SB(0, 0), b2, voffB); PG8_STAGE(PG8_SB(0, 1), b2 + hstepB, voffB); PG8_STAGE(PG8_SA(0, 0), a2, w0);
            PG8_WAIT_V(8); PG8_WAIT_L(0); PG8_BAR; PG8_MMA(1, 0, At, B0); PG8_MMA(1, 1, At, B1); PG8_BAR; PG8_SCHED;
            PG8_LDB(B0, 1, 0); PG8_LDB(B1, 1, 1); PG8_SCHED; PG8_LDA(At, 1, 0); PG8_STAGE(PG8_SA(0, 1), a2, w1);
            PG8_WAIT_V(8); PG8_WAIT_LB(); PG8_BAR; PG8_MMA(0, 0, At, B0); PG8_MMA(0, 1, At, B1); PG8_BAR; PG8_SCHED;
            PG8_LDA(At, 1, 1); PG8_STAGE(PG8_SB(1, 0), b3, voffB); PG8_STAGE(PG8_SB(1, 1), b3 + hstepB, voffB); PG8_STAGE(PG8_SA(1, 0), a3, w0);
            PG8_WAIT_V(8); PG8_WAIT_L(0); PG8_BAR; PG8_MMA(1, 0, At, B0); PG8_MMA(1, 1, At, B1); PG8_BAR; PG8_SCHED;
        }
        if constexpr (ALIGN_EPI) { if (wr == 0) PG8_BAR; }
        E(acc, cur, wr, wc, fr, fq); S.done(cur);
        if (!has_next) break;
#pragma unroll
        for (int a = 0; a < 2; ++a)
#pragma unroll
            for (int b = 0; b < 2; ++b)
#pragma unroll
                for (int m = 0; m < 4; ++m)
#pragma unroll
                    for (int n = 0; n < 2; ++n) acc[a][b][m][n] = (f32x4){0.f, 0.f, 0.f, 0.f};
        cur = nxt; cB = nB; ++ui; vA[0][0] = vAn[0][0]; vA[0][1] = vAn[0][1]; vA[1][0] = vAn[1][0]; vA[1][1] = vAn[1][1];
        if constexpr (ALIGN_EPI) { if (wr == 1) PG8_BAR; }
    }
    PG8_WAIT_V(0);
    if constexpr (!ALIGN_EPI) { if (wr == 0) PG8_BAR; }
    PG8_BAR;
#undef PG8_AROWS
#undef PG8_SA
#undef PG8_SB
#undef PG8_STAGE
#undef PG8_LDA
#undef PG8_LDB
#undef PG8_WAIT_LB
#undef PG8_MMA
#undef PG8_WAIT_V
#undef PG8_WAIT_L
#undef PG8_BAR
#undef PG8_SCHED
}
}

constexpr int NB = 4, SEQ = 4096, NTOK = NB * SEQ, DM = 1024;
constexpr int NWAVES = 8, NTHR = 512;
constexpr int D_SSM = 512, NGRP = 32, NSTATE = 64, CH = 32  , NCH = SEQ / CH  , UGX_LD = 640, S5_ROWS = NB * NCH  ;
constexpr int NIN_PAD = 4608;
constexpr int NEXP = 32, TOPK_E = 4, DFF = 1024;
constexpr int NSEL = 256;
constexpr int MAX_MT = 288;
constexpr float RMS_EPS = 1e-5f;

constexpr size_t MiB = 1u << 20;
constexpr size_t WS_CTL = 0, CTL_ZERO_BYTES = 1 * MiB;
constexpr size_t WS_ROPE = 1 * MiB;
constexpr size_t WS_WIN = 2 * MiB;
constexpr size_t WS_WGLU = 11 * MiB;
constexpr size_t WS_WPS = 12 * MiB;
constexpr size_t WS_WPA = 13 * MiB;
constexpr size_t WS_WOUT = 14 * MiB;
constexpr size_t WS_MT = 16 * MiB;
constexpr size_t WS_WS = 36 * MiB;
constexpr size_t WS_A32 = 44 * MiB;
constexpr size_t WS_SBUF = 45 * MiB;
constexpr size_t WS_WI = 53 * MiB;
constexpr size_t WS_KI = 54 * MiB;
constexpr size_t WS_K = 56 * MiB;
constexpr size_t WS_V = 60 * MiB;
constexpr size_t WS_UGX = 64 * MiB;
constexpr size_t WS_Q = 84 * MiB;
constexpr size_t WS_QI = 100 * MiB;
constexpr size_t WS_GS = 132 * MiB;
constexpr size_t WS_GA = 164 * MiB;
constexpr size_t WS_XN = 196 * MiB;
constexpr size_t WS_YG = 228 * MiB;
constexpr size_t WS_YSSM = 244 * MiB;
constexpr size_t WS_YATT = 260 * MiB;
constexpr size_t WS_SEL = 276 * MiB;
constexpr size_t WS_MIXED = 284 * MiB;
constexpr size_t WS_X1 = 316 * MiB;
constexpr size_t WS_H2 = 380 * MiB;
constexpr size_t WS_TOPE = 412 * MiB;
constexpr size_t WS_TOPW = WS_TOPE + 256 * 1024;
constexpr size_t WS_TOPPOS = WS_TOPW + 256 * 1024;
constexpr size_t WS_ROWMAP = 413 * MiB;
constexpr size_t WS_WMI = 416 * MiB;
constexpr size_t WS_WMO = 544 * MiB;
constexpr size_t WS_ACT = 608 * MiB;
constexpr size_t WS_XP = 64 * MiB;
constexpr size_t WS_Y2 = 64 * MiB;
constexpr size_t WS_END = 752 * MiB;
static_assert(WS_XP + (size_t)MAX_MT * 256 * 1024 * 2 <= WS_YG, "XP overlay");
constexpr int CW_TMO = 0, CW_CODE = 1;
constexpr int CW_BAR = 4096;
constexpr int CW_ECNT = 16384;
constexpr int CW_UDONE = 16384 + 64;
constexpr int CW_YDONE = 16384 + 128;

constexpr int LDS_BYTES = 163840;
constexpr int MISC_OFF = 163840 - 2048;

#define GAS __attribute__((address_space(1)))
#define LAS __attribute__((address_space(3)))
typedef unsigned short bf16;
typedef unsigned short u16;
typedef unsigned v4u __attribute__((ext_vector_type(4)));
typedef unsigned v2u __attribute__((ext_vector_type(2)));
typedef float f32x4 __attribute__((ext_vector_type(4)));
typedef float f32x16 __attribute__((ext_vector_type(16)));
typedef short bf16x8 __attribute__((ext_vector_type(8)));
typedef GAS unsigned gu32;
#define RLX_AGENT __ATOMIC_RELAXED, __HIP_MEMORY_SCOPE_AGENT
#define LDS_WAIT() asm volatile("s_waitcnt lgkmcnt(0)" ::: "memory")
#define VM_WAIT() asm volatile("s_waitcnt vmcnt(0)" ::: "memory")
__device__ __forceinline__ unsigned f2bf(float f) { unsigned u = __builtin_bit_cast(unsigned, f); return (u + 0x7fffu + ((u >> 16) & 1u)) >> 16; }
__device__ __forceinline__ unsigned pk2(float lo, float hi) { return f2bf(lo) | (f2bf(hi) << 16); }
__device__ __forceinline__ float bf2f(unsigned b) { return __builtin_bit_cast(float, b << 16); }
__device__ __forceinline__ float bflo(unsigned w) { return __builtin_bit_cast(float, w << 16); }
__device__ __forceinline__ float bfhi(unsigned w) { return __builtin_bit_cast(float, w & 0xffff0000u); }
__device__ __forceinline__ float sigmoidf_(float x) { return 1.0f / (1.0f + __expf(-x)); }
__device__ __forceinline__ float gelu_tanh(float x) { const float u = 0.7978845608028654f * (x + 0.044715f * x * x * x); const float e = __expf(2.0f * u); const float t = 1.0f - 2.0f / (e + 1.0f); return 0.5f * x * (1.0f + t); }

#define XB_TMO      128
#define XB_XCNT(j)  (256  + 64 * (j))
#define XB_XSUB(j)  (1280 + 64 * (j))
#define XB_XGEN(j)  (2304 + 64 * (j))
#define XB_TOP      3328
#define XB_TOPGEN   3392
#define XCD_BAR_WORDS 3456
#define XB_SPIN_CAP (1u << 18)
__device__ __forceinline__ unsigned xb_ld(unsigned* p)              { return __hip_atomic_load(p, __ATOMIC_RELAXED, __HIP_MEMORY_SCOPE_AGENT); }
__device__ __forceinline__ unsigned xb_add(unsigned* p, unsigned v) { return __hip_atomic_fetch_add(p, v, __ATOMIC_RELAXED, __HIP_MEMORY_SCOPE_AGENT); }
__device__ __forceinline__ unsigned xb_xcc_id() { return (unsigned)__builtin_amdgcn_s_getreg((3 << 11) | 20) & 0xFu; }
#define XB_SPIN(cond, bar) do { unsigned _sp = 0; while (cond) { __builtin_amdgcn_s_sleep(1); \
    if ((++_sp & 255u) == 0u) { if (xb_ld(&(bar)[XB_TMO])) break; if (_sp > XB_SPIN_CAP) { atomicAdd(&(bar)[XB_TMO], 1u); break; } } } } while (0)
struct XcdBarrier { unsigned* bar; unsigned x; volatile LAS unsigned* st; };
__device__ __forceinline__ XcdBarrier xcd_barrier_post(unsigned* bar, volatile LAS unsigned* st) {
    XcdBarrier b; b.bar = bar; b.x = xb_xcc_id(); b.st = st;
    if (threadIdx.x == 0) (void)xb_add(&bar[XB_XCNT(b.x)], 1u);
    return b;
}
__device__ __forceinline__ void xcd_barrier_complete(unsigned* bar, unsigned x, unsigned& nloc, unsigned& nx) {
    const unsigned G = gridDim.x * gridDim.y * gridDim.z;
    unsigned sum, cnt, mine, sp = 0u;
    for (;;) {
        sum = 0u; cnt = 0u; mine = 0u;
#pragma unroll
        for (unsigned j = 0; j < 16; ++j) { const unsigned c = xb_ld(&bar[XB_XCNT(j)]); sum += c; cnt += (c > 0u) ? 1u : 0u; mine = (j == x) ? c : mine; }
        if (sum == G) break;
        __builtin_amdgcn_s_sleep(1);
        if ((++sp & 255u) == 0u) { if (xb_ld(&bar[XB_TMO])) break; if (sp > XB_SPIN_CAP) { atomicAdd(&bar[XB_TMO], 1u); break; } }
    }
    nloc = mine > 0u ? mine : 1u; nx = cnt > 0u ? cnt : 1u;
}
__device__ __forceinline__ void xcd_barrier(const XcdBarrier& b) {
    asm volatile("s_waitcnt vmcnt(0)" ::: "memory");
    __syncthreads();
    if (threadIdx.x == 0) {
        unsigned* bar = b.bar;
        __builtin_amdgcn_s_waitcnt(0);
        unsigned nloc = b.st[0], nx = b.st[1];
        if (nloc == 0u) { xcd_barrier_complete(bar, b.x, nloc, nx); b.st[0] = nloc; b.st[1] = nx; }
        const unsigned old = xb_add(&bar[XB_XSUB(b.x)], 1u);
        const unsigned gen = old / nloc;
        if (old + 1u == (gen + 1u) * nloc) {
            __builtin_amdgcn_fence(__ATOMIC_RELEASE, "agent");
            asm volatile("s_waitcnt vmcnt(0)" ::: "memory");
            const unsigned og = xb_add(&bar[XB_TOP], 1u);
            const unsigned tg = og / nx;
            if (og + 1u == (tg + 1u) * nx) xb_add(&bar[XB_TOPGEN], 1u);
            else XB_SPIN(xb_ld(&bar[XB_TOPGEN]) == tg, bar);
            __builtin_amdgcn_fence(__ATOMIC_ACQUIRE, "agent");
            xb_add(&bar[XB_XGEN(b.x)], 1u);
            asm volatile("s_waitcnt vmcnt(0)" ::: "memory");
        } else {
            XB_SPIN(xb_ld(&bar[XB_XGEN(b.x)]) == gen, bar);
            __builtin_amdgcn_fence(__ATOMIC_ACQUIRE, "agent");
            asm volatile("s_waitcnt vmcnt(0)" ::: "memory");
        }
    }
    __syncthreads();
}

struct Frame {
    LAS unsigned char* lds;
    volatile LAS unsigned* MISC;
    gu32* ctl;
    int tid, lane, wave, G;
    unsigned char* ws;
    const float* in[25];
    float* out;
};
enum { I_X = 0, I_N1G, I_WIN, I_BGATE, I_LRE, I_LIM, I_LOGDT, I_BRE, I_BIM, I_CRE, I_CIM, I_SD, I_WGLU, I_BGLU, I_WPS, I_WPA, I_WOUT, I_N2G, I_WR, I_BR, I_WMI, I_BMI, I_WMO, I_BMO, I_NFG };

__device__ __forceinline__ float wave_sum(float v) {
#pragma unroll
    for (int o = 1; o < 64; o <<= 1) v += __shfl_xor(v, o);
    return v;
}

__device__ __forceinline__ int ropeperm(int p) { const int a = p >> 3, bb = p & 7; return bb < 4 ? 4 * a + bb : 32 + 4 * a + (bb - 4); }
__device__ __forceinline__ int win_src(int nd) {
    const int pn = nd >> 8, j = nd & 255;
    if (pn < 2) return nd;
    if (pn < 4) { const int i = nd - 512; return 512 + (i & ~63) + ropeperm(i & 63); }
    if (pn == 4) { if (j < 128) return 1024 + (j & ~63) + ropeperm(j & 63); return 1152 + (j - 128); }
    if (pn < 9) { const int i = nd - 1280; return 1280 + (i & ~63) + ropeperm(i & 63); }
    if (pn == 9) { if (j < 64) return 2304 + ropeperm(j); if (j < 80) return 2368 + (j - 64); return -1; }
    if (pn < 14) return 2384 + (nd - 2560);
    return 3408 + (nd - 3584);
}
struct TItem { const float* src; bf16* dst; int N, K; };
__device__ __forceinline__ void titem_load(const TItem& T, float (&tv)[32], int lane) {
#pragma unroll
    for (int i = 0; i < 32; ++i) { const int kk = 2 * i + (lane >> 5); tv[i] = T.src ? __builtin_nontemporal_load(T.src + (size_t)kk * T.N) : 0.f; }
}
__device__ __forceinline__ void titem_store(const TItem& T, const float (&tv)[32], LAS float* scr, int lane) {
#pragma unroll
    for (int i = 0; i < 32; ++i) { const int kk = 2 * i + (lane >> 5); scr[kk * 33 + (lane & 31)] = tv[i]; }
    LDS_WAIT(); asm volatile("" ::: "memory");
    const int c = lane & 7;
#pragma unroll
    for (int j = 0; j < 4; ++j) { const int n = (lane >> 3) + 8 * j; const LAS float* s = scr + (8 * c) * 33 + n;
        v4u o; o.x = pk2(s[0 * 33], s[1 * 33]); o.y = pk2(s[2 * 33], s[3 * 33]); o.z = pk2(s[4 * 33], s[5 * 33]); o.w = pk2(s[6 * 33], s[7 * 33]);
        *(GAS v4u*)(T.dst + (size_t)n * T.K + 8 * c) = o; }
    LDS_WAIT(); asm volatile("" ::: "memory");
}
__device__ __forceinline__ void rms_row_to_bf16(int lane, const float* xrow, const float* g, bf16* orow) {
    const GAS f32x4* xr = (const GAS f32x4*)xrow + lane; const GAS f32x4* gr = (const GAS f32x4*)g + lane;
    f32x4 v[4]; float s2 = 0.f;
#pragma unroll
    for (int j = 0; j < 4; ++j) { v[j] = xr[64 * j]; s2 += (v[j].x * v[j].x + v[j].y * v[j].y) + (v[j].z * v[j].z + v[j].w * v[j].w); }
    const float rstd = 1.0f / sqrtf(wave_sum(s2) * (1.f / DM) + RMS_EPS);
    GAS unsigned long long* o8 = (GAS unsigned long long*)orow + lane;
#pragma unroll
    for (int j = 0; j < 4; ++j) { const f32x4 gg = gr[64 * j];
        o8[64 * j] = (unsigned long long)pk2(v[j].x * rstd * gg.x, v[j].y * rstd * gg.y) | ((unsigned long long)pk2(v[j].z * rstd * gg.z, v[j].w * rstd * gg.w) << 32); }
}
__device__ __forceinline__ void p0_s5_group(Frame& F, int g) {
    LAS float* AP = (LAS float*)(F.lds);
    LAS float* BB = (LAS float*)(F.lds + 16896);
    LAS float* CC = (LAS float*)(F.lds + 25088);
    LAS float* KJ = (LAS float*)(F.lds + 33280);
    const float* lre = F.in[I_LRE] + g * 64; const float* lim = F.in[I_LIM] + g * 64;
    const double dt = exp((double)F.in[I_LOGDT][g]);
    __syncthreads();
    for (int idx = F.tid; idx < 33 * 64; idx += NTHR) { const int p = idx & 63, j = idx >> 6;
        const double lr = lre[p], li = lim[p]; const double mag = exp(j * lr * dt), ang = j * li * dt;
        AP[idx * 2] = (float)(mag * cos(ang)); AP[idx * 2 + 1] = (float)(mag * sin(ang)); }
    for (int idx = F.tid; idx < 1024; idx += NTHR) { const int p = idx >> 4;
        const double lr = lre[p], li = lim[p]; const double mag = exp(lr * dt), ang = li * dt; const double ar = mag * cos(ang), ai = mag * sin(ang);
        const double nr = ar - 1.0, ni = ai, den = lr * lr + li * li; const double zr = (nr * lr + ni * li) / den, zi = (ni * lr - nr * li) / den;
        const double br = F.in[I_BRE][g * 1024 + idx], bi = F.in[I_BIM][g * 1024 + idx];
        BB[idx * 2] = (float)(zr * br - zi * bi); BB[idx * 2 + 1] = (float)(zr * bi + zi * br); }
    for (int idx = F.tid; idx < 1024; idx += NTHR) { CC[idx * 2] = F.in[I_CRE][g * 1024 + idx]; CC[idx * 2 + 1] = F.in[I_CIM][g * 1024 + idx]; }
    __syncthreads();
    { const int j = F.tid >> 4, hp = F.tid & 15; float s[16];
#pragma unroll
      for (int h = 0; h < 16; ++h) s[h] = 0.f;
      for (int p = 0; p < 64; ++p) { const float cr = CC[(hp * 64 + p) * 2], ci = CC[(hp * 64 + p) * 2 + 1], ar = AP[(j * 64 + p) * 2], ai = AP[(j * 64 + p) * 2 + 1];
          const float er = cr * ar - ci * ai, ei = cr * ai + ci * ar;
#pragma unroll
          for (int h4 = 0; h4 < 8; ++h4) { const f32x4 bb = *(const LAS f32x4*)(BB + (p * 16 + 2 * h4) * 2); s[2 * h4] += er * bb[0] - ei * bb[1]; s[2 * h4 + 1] += er * bb[2] - ei * bb[3]; } }
#pragma unroll
      for (int h = 0; h < 16; ++h) KJ[(j * 16 + hp) * 16 + h] = s[h]; }
    __syncthreads();
    bf16* MT = (bf16*)(F.ws + WS_MT) + (size_t)g * 512 * 640;
    for (int ch = F.tid; ch < 512 * 80; ch += NTHR) { const int n = ch / 80, k0 = (ch % 80) * 8, tp = n >> 4, hp = n & 15; float v[8];
        if (k0 < 512) { const int sp = k0 >> 4, h0 = k0 & 15;
#pragma unroll
            for (int j = 0; j < 8; ++j) v[j] = (sp <= tp) ? KJ[((tp - sp) * 16 + hp) * 16 + h0 + j] : 0.f; }
        else { const bool im = k0 >= 576; const int p0 = k0 - (im ? 576 : 512);
#pragma unroll
            for (int j = 0; j < 8; ++j) { const int p = p0 + j; const float cr = CC[(hp * 64 + p) * 2], ci = CC[(hp * 64 + p) * 2 + 1], ar = AP[((tp + 1) * 64 + p) * 2], ai = AP[((tp + 1) * 64 + p) * 2 + 1];
                v[j] = im ? -(cr * ai + ci * ar) : (cr * ar - ci * ai); } }
        v4u o; o.x = pk2(v[0], v[1]); o.y = pk2(v[2], v[3]); o.z = pk2(v[4], v[5]); o.w = pk2(v[6], v[7]);
        *(GAS v4u*)(MT + (size_t)n * 640 + k0) = o; }
    bf16* WS = (bf16*)(F.ws + WS_WS) + (size_t)g * 256 * 512;
    for (int ch = F.tid; ch < 256 * 64; ch += NTHR) { const int n = ch >> 6, k0 = (ch & 63) * 8, sp = k0 >> 4, h0 = k0 & 15; float v[8];
#pragma unroll
        for (int j = 0; j < 8; ++j) { if (n < 128) { const int p = n & 63; const float ar = AP[((31 - sp) * 64 + p) * 2], ai = AP[((31 - sp) * 64 + p) * 2 + 1], br = BB[(p * 16 + h0 + j) * 2], bi = BB[(p * 16 + h0 + j) * 2 + 1];
                v[j] = (n < 64) ? (ar * br - ai * bi) : (ar * bi + ai * br); } else v[j] = 0.f; }
        v4u o; o.x = pk2(v[0], v[1]); o.y = pk2(v[2], v[3]); o.z = pk2(v[4], v[5]); o.w = pk2(v[6], v[7]);
        *(GAS v4u*)(WS + (size_t)n * 512 + k0) = o; }
    float* A32 = (float*)(F.ws + WS_A32) + g * 128;
    if (F.tid < 128) A32[F.tid] = AP[32 * 128 + F.tid];
    __syncthreads();
}
__device__ __forceinline__ void p0_prologue(Frame& F) {
    const int NW = F.G - NGRP;
    const bool s5wg = (int)blockIdx.x >= NW;
    TPROBE_BEGIN(120);
    if (s5wg) p0_s5_group(F, (int)blockIdx.x - NW);
    TPROBE_END(120);
    TPROBE_BEGIN(121);
    if (!s5wg) {
    LAS float* scr = (LAS float*)(F.lds + F.wave * 16384);
    const int gw = blockIdx.x * NWAVES + F.wave, NGW = NW * NWAVES;
    { float* cosT = (float*)(F.ws + WS_ROPE); float* sinT = cosT + SEQ * 32;
      for (int i = blockIdx.x * NTHR + F.tid; i < SEQ * 32; i += NW * NTHR) { const int pos = i >> 5, k = i & 31;
          const double inv = pow(10000.0, -(double)k / 32.0); const double ang = (double)pos * (double)(float)inv;
          cosT[i] = (float)cos(ang); sinT[i] = (float)sin(ang); } }
    for (int m = gw; m < NTOK; m += NGW) rms_row_to_bf16(F.lane, F.in[I_X] + (size_t)m * DM, F.in[I_N1G], (bf16*)(F.ws + WS_XN) + (size_t)m * DM);
    constexpr int I_IN = 16 * (NIN_PAD / 32), I_GLU = 8 * 16, I_PS = 8 * 32, I_PA = 8 * 32, I_OUT = 16 * 32;
    constexpr int NITEMS = I_IN + I_GLU + I_PS + I_PA + I_OUT;
    auto decode = [&](int it) -> TItem {
        int r = it; const float* W; bf16* WT; int K, N, ndb, map = 0;
        if (r < I_IN) { W = F.in[I_WIN]; K = DM; N = 4432; WT = (bf16*)(F.ws + WS_WIN); ndb = NIN_PAD / 32; map = 1; }
        else if ((r -= I_IN) < I_GLU) { W = F.in[I_WGLU]; K = 512; N = 512; WT = (bf16*)(F.ws + WS_WGLU); ndb = 16; }
        else if ((r -= I_GLU) < I_PS) { W = F.in[I_WPS]; K = 512; N = 1024; WT = (bf16*)(F.ws + WS_WPS); ndb = 32; }
        else if ((r -= I_PS) < I_PA) { W = F.in[I_WPA]; K = 512; N = 1024; WT = (bf16*)(F.ws + WS_WPA); ndb = 32; }
        else { r -= I_PA; W = F.in[I_WOUT]; K = 1024; N = 1024; WT = (bf16*)(F.ws + WS_WOUT); ndb = 32; }
        const int kb = r / ndb, nb = r % ndb, k0 = 64 * kb, n0 = 32 * nb; int sc = n0 + (F.lane & 31); if (map) sc = win_src(sc);
        TItem T; T.src = (sc >= 0) ? W + (size_t)k0 * N + sc : nullptr; T.dst = WT + (size_t)n0 * K + k0; T.N = N; T.K = K; return T; };
    { float tvA[32], tvB[32]; int it = gw;
      if (it < NITEMS) { TItem TA = decode(it); titem_load(TA, tvA, F.lane);
        for (;;) {
            const int it1 = it + NGW; const bool h1 = it1 < NITEMS; TItem TB = TA; if (h1) { TB = decode(it1); titem_load(TB, tvB, F.lane); }
            titem_store(TA, tvA, scr, F.lane); if (!h1) break;
            const int it2 = it1 + NGW; const bool h2 = it2 < NITEMS; if (h2) { TA = decode(it2); titem_load(TA, tvA, F.lane); }
            titem_store(TB, tvB, scr, F.lane); if (!h2) break;
            it = it2; } } }
    }
    TPROBE_END(121);
    TPROBE_BEGIN(122);
    { const size_t n8_in = (size_t)NEXP * 1024 * 2048 / 8, n8 = n8_in + (size_t)NEXP * 1024 * 1024 / 8;
      const int nvw = s5wg ? 2 : 4, vw0 = s5wg ? 4 * NW + 2 * ((int)blockIdx.x - NW) : 4 * (int)blockIdx.x;
      const size_t vstride = (size_t)(4 * NW + 2 * NGRP) * NTHR;
      for (int vw = 0; vw < nvw; ++vw)
      for (size_t i0 = (size_t)(vw0 + vw) * NTHR + F.tid; i0 < n8; i0 += 4 * vstride) {
          f32x4 a[4], b[4];
#pragma unroll
          for (int u = 0; u < 4; ++u) { const size_t i = i0 + (size_t)u * vstride; if (i < n8) { const float* s = (i < n8_in) ? F.in[I_WMI] + i * 8 : F.in[I_WMO] + (i - n8_in) * 8;
              a[u] = __builtin_nontemporal_load((const f32x4*)s); b[u] = __builtin_nontemporal_load((const f32x4*)s + 1); } }
#pragma unroll
          for (int u = 0; u < 4; ++u) { const size_t i = i0 + (size_t)u * vstride; if (i < n8) { bf16* d = (i < n8_in) ? (bf16*)(F.ws + WS_WMI) + i * 8 : (bf16*)(F.ws + WS_WMO) + (i - n8_in) * 8;
              *(GAS v4u*)d = pg8::pack8(a[u], b[u]); } } } }
    TPROBE_END(122);
}

struct StaticOrder {
    int nM, nN, nwg, G, c;
    __device__ void init(int nM_, int nN_, int G_, int c_) { nM = nM_; nN = nN_; nwg = nM * nN; G = G_; c = c_; }
    __device__ bool tile(int i, int& pm, int& pn) const {
        const long L = (long)i * G + c; if (L >= nwg) return false;
        int wgid = (int)L; { const int q = nwg / pg8::NXCD, r = nwg % pg8::NXCD, xcd = wgid % pg8::NXCD, off = wgid / pg8::NXCD; wgid = (xcd < r ? xcd * (q + 1) : r * (q + 1) + (xcd - r) * q) + off; }
        const int nig = pg8::WGM * nN, gid = wgid / nig, fm = gid * pg8::WGM, gsz = (nM - fm) < pg8::WGM ? (nM - fm) : pg8::WGM;
        pm = fm + ((wgid % nig) % gsz); pn = (wgid % nig) / gsz; return true;
    }
    __device__ bool next(int i, pg8::Unit& u) const { int pm, pn; if (!tile(i, pm, pn)) return false; u.pm = pm; u.pn = pn; u.pa = pm; u.pb = pn; u.e = 0; return true; }
    __device__ __forceinline__ int arow(const pg8::Unit& u, int h, int R) const { return u.pa * 256 + h * 128 + R; }
    __device__ __forceinline__ void done(const pg8::Unit&) const {}
};
__device__ __forceinline__ void wg_wait_ge(Frame& F, int word, unsigned target) {
    if (F.tid == 0) { unsigned sp = 0;
        while (__hip_atomic_load((unsigned*)(F.ctl + word), RLX_AGENT) < target) { __builtin_amdgcn_s_sleep(2); if (++sp > (1u << 22)) { __hip_atomic_store((unsigned*)(F.ctl + CW_TMO), 1u, RLX_AGENT); break; } }
        __builtin_amdgcn_fence(__ATOMIC_ACQUIRE, "agent"); asm volatile("s_waitcnt vmcnt(0)" ::: "memory"); }
    __syncthreads();
}
__device__ __forceinline__ void wg_signal(Frame& F, int word) {
    asm volatile("s_waitcnt vmcnt(0)" ::: "memory"); __syncthreads();
    if (F.tid == 0) { __builtin_amdgcn_fence(__ATOMIC_RELEASE, "agent"); asm volatile("s_waitcnt vmcnt(0)" ::: "memory"); (void)__hip_atomic_fetch_add((unsigned*)(F.ctl + word), 1u, RLX_AGENT); }
}
struct InProjOrder {
    int G, c; unsigned* udone;
    __device__ bool next(int i, pg8::Unit& u) const { const int L = i * G + c; if (L >= 64 * (NIN_PAD / 256)) return false; u.pm = L & 63; u.pn = L >> 6; u.pa = u.pm; u.pb = u.pn; u.e = 0; return true; }
    __device__ __forceinline__ int arow(const pg8::Unit& u, int h, int R) const { return u.pa * 256 + h * 128 + R; }
    __device__ __forceinline__ void done(const pg8::Unit& u) const {
        if (u.pn < 2) { asm volatile("s_waitcnt vmcnt(0)" ::: "memory");
            if ((threadIdx.x & 63) == 0) (void)__hip_atomic_fetch_add(udone, 1u, RLX_AGENT); } }
};
struct S5StateOrder {
    int c;
    __device__ bool next(int i, pg8::Unit& u) const { if (i > 0 || c >= 64) return false; const int g = c >> 1, pm = c & 1; u.pm = pm; u.pn = 0; u.pa = g * 2 + pm; u.pb = g; u.e = g; return true; }
    __device__ __forceinline__ int arow(const pg8::Unit& u, int h, int R) const { return u.pa * 256 + h * 128 + R; }
    __device__ __forceinline__ void done(const pg8::Unit&) const {}
};
struct S5YOrder {
    int c;
    __device__ bool next(int i, pg8::Unit& u) const { if (i > 0 || c >= 128) return false; const int g = c >> 2, pm = (c >> 1) & 1, pn = c & 1; u.pm = pm; u.pn = pn; u.pa = g * 2 + pm; u.pb = g * 2 + pn; u.e = g; return true; }
    __device__ __forceinline__ int arow(const pg8::Unit& u, int h, int R) const { return u.pa * 256 + h * 128 + R; }
    __device__ __forceinline__ void done(const pg8::Unit&) const {}
};
struct MixOrder {
    StaticOrder so;
    __device__ bool next(int i, pg8::Unit& u) const { int pm, pn; if (!so.tile(i >> 1, pm, pn)) return false; const int h = i & 1; u.pm = pm; u.pn = pn; u.pa = pm + 64 * h; u.pb = pn + 4 * h; u.e = h; return true; }
    __device__ __forceinline__ int arow(const pg8::Unit& u, int h, int R) const { return u.pa * 256 + h * 128 + R; }
    __device__ __forceinline__ void done(const pg8::Unit&) const {}
};
struct MoeOrder {
    const volatile LAS int* te; const volatile LAS int* off; const volatile LAS int* cnt; const int* rowmap; int TT, NTN, c;
    __device__ bool next(int i, pg8::Unit& u) const {
        const int xcd = c & 7, j = c >> 3, mpx = 32 / NTN; const int mt = i * (8 * mpx) + xcd * mpx + j / NTN, pn = j % NTN;
        if (mt >= TT) return false; const int e = te[mt]; u.pm = mt; u.pn = pn; u.pa = mt; u.pb = e * NTN + pn; u.e = e; return true; }
    __device__ __forceinline__ int arow(const pg8::Unit& u, int h, int R) const {
        if (!rowmap) return u.pa * 256 + h * 128 + R;
        const int lr = u.pm * 256 - off[u.e] + h * 128 + R;
        return lr < cnt[u.e] ? rowmap[(size_t)u.e * NTOK + lr] : 0; }
    __device__ __forceinline__ void done(const pg8::Unit&) const {}
};

using pg8::f32x2; using pg8::u32x2; using pg8::pack8; using pg8::cvt_pk_bf16;
#define EPI_ROWS_BEGIN _Pragma("unroll") for (int ai = 0; ai < 2; ++ai) _Pragma("unroll") for (int m = 0; m < 4; ++m) { asm volatile("" ::: "memory"); const int row = u.pm * 256 + ai * 128 + wr * 64 + m * 16 + fr; (void)row;
#define EPI_COLS_BEGIN _Pragma("unroll") for (int bj = 0; bj < 2; ++bj) { const int ct = bj * 128 + wc * 32 + fq * 8; (void)ct; f32x4 v0 = acc[ai][bj][m][0], v1 = acc[ai][bj][m][1];
#define EPI_END } }
struct EpiInProj {
    static constexpr bool PERM = true;
    unsigned char* ws; const float* bgate;
    __device__ __forceinline__ void rope(f32x4& v0, f32x4& v1, int pos, int a, float sc) const {
        const unsigned o = (unsigned)WS_ROPE + (unsigned)(pos * 32 + 4 * a) * 4u;
        const f32x4 c = *(const GAS f32x4*)(ws + o), s = *(const GAS f32x4*)(ws + o + (unsigned)(SEQ * 32 * 4));
        const f32x4 o1 = (v0 * c - v1 * s) * sc, o2 = (v1 * c + v0 * s) * sc; v0 = o1; v1 = o2;
    }
    __device__ __forceinline__ void store_rope(unsigned off, const f32x4& o1, const f32x4& o2) const {
        u32x2 a, b; a.x = cvt_pk_bf16(o1[0], o1[1]); a.y = cvt_pk_bf16(o1[2], o1[3]); b.x = cvt_pk_bf16(o2[0], o2[1]); b.y = cvt_pk_bf16(o2[2], o2[3]);
        *(GAS u32x2*)(ws + off) = a; *(GAS u32x2*)(ws + off + 64u) = b;
    }
    __device__ __forceinline__ void operator()(const f32x4 (&acc)[2][2][4][2], const pg8::Unit& u, int wr, int wc, int fr, int fq) const {
        const int pn = u.pn;
        if (pn < 2) {
            EPI_ROWS_BEGIN const int bb = row >> 12, cc = (row >> 5) & 127, sp = row & 31;
            EPI_COLS_BEGIN const int col = pn * 256 + ct, g = col >> 4, h0 = col & 15;
                { const unsigned uo_ = (unsigned)WS_UGX + (unsigned)((g * 512 + bb * 128 + cc) * UGX_LD + sp * 16 + h0) * 2u; const pg8::u32x4 ud_ = pack8(v0, v1);
                  asm volatile("global_store_dwordx4 %0, %1, %2 sc0 sc1\n\ts_nop 1" :: "v"(uo_), "v"(ud_), "s"(ws) : "memory"); }
            EPI_END
        } else if (pn < 4) {
            EPI_ROWS_BEGIN const int pos = row & 4095;
            EPI_COLS_BEGIN const int j = (pn - 2) * 256 + ct, head = j >> 6, a = (j & 63) >> 3;
                rope(v0, v1, pos, a, 0.125f); store_rope((unsigned)WS_Q + (unsigned)(row * 512 + head * 64 + 4 * a) * 2u, v0, v1);
            EPI_END
        } else if (pn == 4) {
            EPI_ROWS_BEGIN const int pos = row & 4095;
            EPI_COLS_BEGIN
                if (bj == 0) { const int head = ct >> 6, a = (ct & 63) >> 3; rope(v0, v1, pos, a, 1.0f); store_rope((unsigned)WS_K + (unsigned)(row * 128 + head * 64 + 4 * a) * 2u, v0, v1); }
                else *(GAS v4u*)(ws + ((unsigned)WS_V + (unsigned)(row * 128 + (ct - 128)) * 2u)) = pack8(v0, v1);
            EPI_END
        } else if (pn < 9) {
            EPI_ROWS_BEGIN const int pos = row & 4095;
            EPI_COLS_BEGIN const int j = (pn - 5) * 256 + ct, head = j >> 6, a = (j & 63) >> 3;
                rope(v0, v1, pos, a, 1.0f); store_rope((unsigned)WS_QI + (unsigned)(row * 1024 + head * 64 + 4 * a) * 2u, v0, v1);
            EPI_END
        } else if (pn == 9) {
            EPI_ROWS_BEGIN const int pos = row & 4095;
            EPI_COLS_BEGIN
                if (bj == 0) { if (ct < 64) { const int a = ct >> 3; rope(v0, v1, pos, a, 1.0f); store_rope((unsigned)WS_KI + (unsigned)(row * 64 + 4 * a) * 2u, v0, v1); }
                    else if (ct < 80) { const unsigned o = (unsigned)WS_WI + (unsigned)(row * 16 + (ct - 64)) * 4u; *(GAS f32x4*)(ws + o) = v0 * 0.03125f; *(GAS f32x4*)(ws + o + 16u) = v1 * 0.03125f; } }
            EPI_END
        } else {
            const int br = pn >= 14; const unsigned gbase = br ? (unsigned)WS_GA : (unsigned)WS_GS; const float* bgp = bgate + br * 1024;
            EPI_ROWS_BEGIN
            EPI_COLS_BEGIN const int col = (pn - (br ? 14 : 10)) * 256 + ct;
                const f32x4 b0 = *(const GAS f32x4*)(bgp + col), b1 = *(const GAS f32x4*)(bgp + col + 4);
#pragma unroll
                for (int j = 0; j < 4; ++j) { v0[j] = sigmoidf_(v0[j] + b0[j]); v1[j] = sigmoidf_(v1[j] + b1[j]); }
                *(GAS v4u*)(ws + (gbase + (unsigned)(row * 1024 + col) * 2u)) = pack8(v0, v1);
            EPI_END
        }
    }
};
struct EpiS5State {
    static constexpr bool PERM = true;
    float* SB;
    __device__ __forceinline__ void operator()(const f32x4 (&acc)[2][2][4][2], const pg8::Unit& u, int wr, int wc, int fr, int fq) const {
        EPI_ROWS_BEGIN
        EPI_COLS_BEGIN
            if (bj == 0) { float* d = SB + ((size_t)u.e * 512 + row) * 128 + ct; *(GAS f32x4*)d = v0; *(GAS f32x4*)(d + 4) = v1; }
        EPI_END
    }
};
struct EpiS5Y {
    static constexpr bool PERM = true;
    const bf16* UGX; const float* Dsk; bf16* YG;
    __device__ __forceinline__ void operator()(const f32x4 (&acc)[2][2][4][2], const pg8::Unit& u, int wr, int wc, int fr, int fq) const {
        const int g = u.e;
        EPI_ROWS_BEGIN const int bb = row >> 7, cc = row & 127;
        EPI_COLS_BEGIN const int n = u.pn * 256 + ct, tp = n >> 4, h0 = n & 15;
            const v4u uu = *(const GAS v4u*)(UGX + ((size_t)g * 512 + row) * UGX_LD + n);
            const f32x4 d0 = *(const GAS f32x4*)(Dsk + g * 16 + h0), d1 = *(const GAS f32x4*)(Dsk + g * 16 + h0 + 4);
            v0[0] += d0[0] * bflo(uu.x); v0[1] += d0[1] * bfhi(uu.x); v0[2] += d0[2] * bflo(uu.y); v0[3] += d0[3] * bfhi(uu.y);
            v1[0] += d1[0] * bflo(uu.z); v1[1] += d1[1] * bfhi(uu.z); v1[2] += d1[2] * bflo(uu.w); v1[3] += d1[3] * bfhi(uu.w);
#pragma unroll
            for (int j = 0; j < 4; ++j) { v0[j] = gelu_tanh(v0[j]); v1[j] = gelu_tanh(v1[j]); }
            const int tok = bb * 4096 + cc * 32 + tp;
            *(GAS v4u*)(YG + (size_t)tok * 512 + g * 16 + h0) = pack8(v0, v1);
        EPI_END
    }
};
struct EpiGlu {
    static constexpr bool PERM = true;
    const bf16* YG; const float* bglu; bf16* YS;
    __device__ __forceinline__ void operator()(const f32x4 (&acc)[2][2][4][2], const pg8::Unit& u, int wr, int wc, int fr, int fq) const {
        EPI_ROWS_BEGIN
        EPI_COLS_BEGIN const int col = u.pn * 256 + ct;
            const v4u yy = *(const GAS v4u*)(YG + (size_t)row * 512 + col);
            const f32x4 b0 = *(const GAS f32x4*)(bglu + col), b1 = *(const GAS f32x4*)(bglu + col + 4);
            v0[0] = bflo(yy.x) * sigmoidf_(v0[0] + b0[0]); v0[1] = bfhi(yy.x) * sigmoidf_(v0[1] + b0[1]); v0[2] = bflo(yy.y) * sigmoidf_(v0[2] + b0[2]); v0[3] = bfhi(yy.y) * sigmoidf_(v0[3] + b0[3]);
            v1[0] = bflo(yy.z) * sigmoidf_(v1[0] + b1[0]); v1[1] = bfhi(yy.z) * sigmoidf_(v1[1] + b1[1]); v1[2] = bflo(yy.w) * sigmoidf_(v1[2] + b1[2]); v1[3] = bfhi(yy.w) * sigmoidf_(v1[3] + b1[3]);
            *(GAS v4u*)(YS + (size_t)row * 512 + col) = pack8(v0, v1);
        EPI_END
    }
};
struct EpiMix {
    static constexpr bool PERM = true;
    const bf16* GS; const bf16* GA; bf16* MX;
    __device__ __forceinline__ void operator()(const f32x4 (&acc)[2][2][4][2], const pg8::Unit& u, int wr, int wc, int fr, int fq) const {
        const bf16* Gp = u.e ? GA : GS;
        EPI_ROWS_BEGIN
        EPI_COLS_BEGIN const size_t off = (size_t)row * 1024 + u.pn * 256 + ct;
            const v4u gg = *(const GAS v4u*)(Gp + off);
            v0[0] *= bflo(gg.x); v0[1] *= bfhi(gg.x); v0[2] *= bflo(gg.y); v0[3] *= bfhi(gg.y); v1[0] *= bflo(gg.z); v1[1] *= bfhi(gg.z); v1[2] *= bflo(gg.w); v1[3] *= bfhi(gg.w);
            if (u.e) { const v4u pp = *(const GAS v4u*)(MX + off);
                v0[0] += bflo(pp.x); v0[1] += bfhi(pp.x); v0[2] += bflo(pp.y); v0[3] += bfhi(pp.y); v1[0] += bflo(pp.z); v1[1] += bfhi(pp.z); v1[2] += bflo(pp.w); v1[3] += bfhi(pp.w); }
            *(GAS v4u*)(MX + off) = pack8(v0, v1);
        EPI_END
    }
};
struct EpiOut {
    static constexpr bool PERM = true;
    const float* X; float* X1;
    __device__ __forceinline__ void operator()(const f32x4 (&acc)[2][2][4][2], const pg8::Unit& u, int wr, int wc, int fr, int fq) const {
        EPI_ROWS_BEGIN
        EPI_COLS_BEGIN const size_t off = (size_t)row * 1024 + u.pn * 256 + ct;
            const f32x4 x0 = *(const GAS f32x4*)(X + off), x1 = *(const GAS f32x4*)(X + off + 4);
            *(GAS f32x4*)(X1 + off) = v0 + x0; *(GAS f32x4*)(X1 + off + 4) = v1 + x1;
        EPI_END
    }
};
struct EpiMoe1 {
    static constexpr bool PERM = true;
    const float* bmi; bf16* ACT;
    __device__ __forceinline__ void operator()(const f32x4 (&acc)[2][2][4][2], const pg8::Unit& u, int wr, int wc, int fr, int fq) const {
        const float* bp = bmi + (size_t)u.e * 2048;
        EPI_ROWS_BEGIN
        EPI_COLS_BEGIN const int col = u.pn * 256 + ct;
            const f32x4 b0 = *(const GAS f32x4*)(bp + col), b1 = *(const GAS f32x4*)(bp + col + 4);
            v0 += b0; v1 += b1; float o[4];
#pragma unroll
            for (int j = 0; j < 4; ++j) { const float zg0 = (j < 2) ? v0[2 * j] : v1[2 * j - 4], zl0 = (j < 2) ? v0[2 * j + 1] : v1[2 * j - 3];
                const float zg = fminf(zg0, 7.0f), zl = fminf(fmaxf(zl0, -7.0f), 7.0f); o[j] = zg * sigmoidf_(1.702f * zg) * (zl + 1.0f); }
            u32x2 w; w.x = cvt_pk_bf16(o[0], o[1]); w.y = cvt_pk_bf16(o[2], o[3]);
            *(GAS u32x2*)(ACT + (size_t)row * 1024 + (col >> 1)) = w;
        EPI_END
    }
};
struct EpiMoe2 {
    static constexpr bool PERM = true;
    const float* bmo; bf16* Y2;
    __device__ __forceinline__ void operator()(const f32x4 (&acc)[2][2][4][2], const pg8::Unit& u, int wr, int wc, int fr, int fq) const {
        const float* bp = bmo + (size_t)u.e * 1024;
        EPI_ROWS_BEGIN
        EPI_COLS_BEGIN const int col = u.pn * 256 + ct;
            const f32x4 b0 = *(const GAS f32x4*)(bp + col), b1 = *(const GAS f32x4*)(bp + col + 4);
            v0 += b0; v1 += b1;
            *(GAS v4u*)(Y2 + (size_t)row * 1024 + col) = pack8(v0, v1);
        EPI_END
    }
};

__device__ __forceinline__ unsigned f16key(unsigned bits) { return (bits & 0x8000u) ? (bits ^ 0xffffu) : (bits | 0x8000u); }
__device__ __forceinline__ void idx_phase(Frame& F) {
    LAS unsigned char* lds = F.lds;
    LAS u16* SC = (LAS u16*)lds;
    LAS unsigned char* KT = lds + 65536;
    LAS unsigned* HP = (LAS unsigned*)(lds + 147456);
    LAS unsigned char* OLB = lds + 147456 + 4096;
    const bf16* QI = (const bf16*)(F.ws + WS_QI); const bf16* KI = (const bf16*)(F.ws + WS_KI); const float* WI = (const float*)(F.ws + WS_WI);
    u16* SEL = (u16*)(F.ws + WS_SEL);
    const int tid = F.tid, lane = F.lane, wave = F.wave, qg = wave & 1, kq = wave >> 1, kgrp = lane >> 4, l15 = lane & 15;
    const int kx = l15 >> 1, cpos = lane & 7;
    const int dsw = ((wave & 1) * 4 + (lane >> 4)) & 7;
    bf16x8 qa[4][2]; float w[16];
#define IDX_UNIT(r_, b_, t0_) const int b_ = (r_) >> 1, t0_ = (((r_) & 1) ? 511 - (int)blockIdx.x : (int)blockIdx.x) * 8
#define IDX_DMA(kb_, st, bufi) do { _Pragma("unroll") for (int j_ = 0; j_ < 2; ++j_) { const int row_ = (j_ * 8 + wave) * 8 + (lane >> 3); \
        __builtin_amdgcn_global_load_lds((const unsigned*)((kb_) + ((size_t)(st) * 128 + row_) * 64 + ((cpos ^ dsw) << 3)), (LAS unsigned*)(KT + (bufi) * 16384 + (j_ * 8 + wave) * 1024), 16, 0, 0); } } while (0)
#define IDX_PREFETCH(r_) do { IDX_UNIT(r_, pb_, pt0_); if (pt0_ >= 256) { \
        const bf16* qp_ = QI + ((size_t)pb_ * SEQ + pt0_ + 4 * qg + (l15 >> 2)) * 1024 + (l15 & 3) * 64 + kgrp * 8; \
        _Pragma("unroll") for (int i = 0; i < 4; ++i) _Pragma("unroll") for (int ks = 0; ks < 2; ++ks) qa[i][ks] = *(const GAS bf16x8*)(qp_ + i * 256 + ks * 32); \
        const float* wp_ = WI + ((size_t)pb_ * SEQ + pt0_ + 4 * qg + kgrp) * 16; \
        _Pragma("unroll") for (int i = 0; i < 4; ++i) { const f32x4 x = *(const GAS f32x4*)(wp_ + 4 * i); w[4 * i] = x[0]; w[4 * i + 1] = x[1]; w[4 * i + 2] = x[2]; w[4 * i + 3] = x[3]; } \
        const bf16* pk_ = KI + (size_t)pb_ * SEQ * 64; const int pn_ = (pt0_ + 7) / 128 + 1; \
        IDX_DMA(pk_, 0, 0); if (1 < pn_) IDX_DMA(pk_, 1, 1); if (2 < pn_) IDX_DMA(pk_, 2, 2); if (3 < pn_) IDX_DMA(pk_, 3, 3); } } while (0)
    IDX_PREFETCH(0);
    for (int r = 0; r < 8; ++r) {
        IDX_UNIT(r, b, t0);
        __syncthreads();
        const int t = t0 + wave; const size_t tok = (size_t)b * SEQ + t;
        if (t0 < 256) {
            v2u x; const int k0 = lane * 4;
            x.x = (unsigned)(k0 <= t ? k0 : 0) | ((unsigned)(k0 + 1 <= t ? k0 + 1 : 0) << 16); x.y = (unsigned)(k0 + 2 <= t ? k0 + 2 : 0) | ((unsigned)(k0 + 3 <= t ? k0 + 3 : 0) << 16);
            *(GAS v2u*)(SEL + tok * NSEL + k0) = x;
            if (r + 1 < 8) IDX_PREFETCH(r + 1);
            continue;
        }
        HP[tid * 2] = 0u; HP[tid * 2 + 1] = 0u;
        const int nst = (t0 + 7) / 128 + 1;
        const int tq = t0 + 4 * qg + kgrp, qrow = 4 * qg + kgrp;
        const bf16* kbat = KI + (size_t)b * SEQ * 64;
        const unsigned hpq = (unsigned)(unsigned long)(HP + qrow * 128);
#define IDX_EPI1(kgl_, AC) do { float s0 = 0.f; \
            _Pragma("unroll") for (int i = 0; i < 4; ++i) _Pragma("unroll") for (int r_ = 0; r_ < 4; ++r_) { const float a0_ = AC[i][r_]; const int i0 = __builtin_bit_cast(int, a0_); const float m0 = __builtin_bit_cast(float, i0 > 0 ? i0 : 0); s0 += w[4 * i + r_] * m0; } \
            const _Float16 h0_ = (_Float16)s0; const unsigned key0_ = f16key(__builtin_bit_cast(unsigned short, h0_)); const int kg0 = (kgl_); \
            SC[qrow * 4096 + kg0] = (u16)key0_; \
            if (kg0 <= tq) { const unsigned bin = key0_ >> 8; const unsigned ha_ = hpq + ((bin >> 1) << 2), hv_ = (bin & 1u) ? 0x10000u : 1u; \
                asm volatile("ds_add_u32 %0, %1" :: "v"(ha_), "v"(hv_) : "memory"); } } while (0)
#define IDX_READ(BQ, kt2) do { _Pragma("unroll") for (int ks = 0; ks < 2; ++ks) BQ[ks] = *(const LAS bf16x8*)(kb + (kq * 32 + (kt2) * 16 + l15) * 128 + (((ks * 4 + kgrp) ^ kx) << 4)); } while (0)
#define IDX_MMA(AC, BQ) do { _Pragma("unroll") for (int i = 0; i < 4; ++i) { AC[i] = (f32x4){0.f, 0.f, 0.f, 0.f}; _Pragma("unroll") for (int ks = 0; ks < 2; ++ks) AC[i] = __builtin_amdgcn_mfma_f32_16x16x32_bf16(qa[i][ks], BQ[ks], AC[i], 0, 0, 0); } } while (0)
        bf16x8 bq0[2], bq1[2];
        f32x4 aA[4], aB[4];
#pragma unroll
        for (int i = 0; i < 4; ++i) { aA[i] = (f32x4){0.f, 0.f, 0.f, 0.f}; aB[i] = aA[i]; }
        int bcur = 0, bnew = 4;
        TPROBE_BEGIN(100);
        for (int st = 0; st < nst; ++st) {
            if (st + 3 < nst) asm volatile("s_waitcnt vmcnt(6)" ::: "memory"); else asm volatile("s_waitcnt vmcnt(0)" ::: "memory");
            __syncthreads();
            if (st + 4 < nst) IDX_DMA(kbat, st + 4, bnew);
            const LAS unsigned char* kb = KT + bcur * 16384;
            const int kbase_ = st * 128 + kq * 32 + l15;
            IDX_READ(bq0, 0);
            IDX_READ(bq1, 1); IDX_MMA(aA, bq0); if (st >= 1) IDX_EPI1(kbase_ - 128 + 16, aB);
            IDX_MMA(aB, bq1); IDX_EPI1(kbase_, aA);
            bcur = (bcur == 4) ? 0 : bcur + 1; bnew = (bnew == 4) ? 0 : bnew + 1;
        }
        IDX_EPI1((nst - 1) * 128 + kq * 32 + l15 + 16, aB);
#undef IDX_EPI1
#undef IDX_MMA
#undef IDX_READ
        __syncthreads();
        TPROBE_END(100);
        TPROBE_BEGIN(101);
        TPROBE_BEGIN(110);
        if (r + 1 < 8) IDX_PREFETCH(r + 1);
        const int n = t + 1, jj = lane, ql = wave;
        const LAS u16* sc = SC + ql * 4096;
        LAS unsigned* hp = HP + ql * 128;
        unsigned b1, need1;
        { const v2u wv = *(const LAS v2u*)(hp + 126 - 2 * jj); unsigned hb[4];
          hb[3] = wv.x & 0xffffu; hb[2] = wv.x >> 16; hb[1] = wv.y & 0xffffu; hb[0] = wv.y >> 16;
          const unsigned s4 = hb[0] + hb[1] + hb[2] + hb[3];
          unsigned pre = s4;
#pragma unroll
          for (int o = 1; o < 64; o <<= 1) { const unsigned x = __shfl_up(pre, o, 64); if (jj >= o) pre += x; }
          const unsigned long long bal = __ballot(pre >= 256u); const int js = __builtin_ctzll(bal);
          unsigned above = pre - s4, bb1 = 0, nd1 = 0; bool found = false;
#pragma unroll
          for (int i = 0; i < 4; ++i) { if (!found) { if (above + hb[i] >= 256u) { bb1 = 255 - (jj * 4 + i); nd1 = 256u - above; found = true; } else above += hb[i]; } }
          b1 = __shfl(bb1, js); need1 = __shfl(nd1, js); }
        TPROBE_END(110);
        TPROBE_BEGIN(111);
        LDS_WAIT(); __builtin_amdgcn_wave_barrier();
#define LDS_ST32(addr_, val_) asm volatile("ds_write_b32 %0, %1" :: "v"((unsigned)(addr_)), "v"((unsigned)(val_)) : "memory")
#define LDS_ST16(addr_, val_) asm volatile("ds_write_b16 %0, %1" :: "v"((unsigned)(addr_)), "v"((unsigned)(val_)) : "memory")
#define LDS_ADD32(addr_, val_) asm volatile("ds_add_u32 %0, %1" :: "v"((unsigned)(addr_)), "v"((unsigned)(val_)) : "memory")
        const unsigned hpw = (unsigned)(unsigned long)hp, scw = (unsigned)(unsigned long)sc;
        LDS_ST32(hpw + jj * 8, 0u); LDS_ST32(hpw + jj * 8 + 4, 0u);
        const int nit = (n + 511) >> 9;
        { const int base = (nit - 1) * 512 + jj * 8;
#pragma unroll
          for (int e = 0; e < 8; ++e) if (base + e >= n) LDS_ST16(scw + (base + e) * 2, 0u); }
        LDS_WAIT(); __builtin_amdgcn_wave_barrier();
        const unsigned B1 = b1 | (b1 << 16);
#pragma unroll 4
        for (int it = 0; it < nit; ++it) { const int base = it * 512 + jj * 8; const v4u x = *(const LAS v4u*)(sc + base);
#pragma unroll
            for (int i = 0; i < 4; ++i) { const unsigned d = (i == 0) ? x.x : (i == 1) ? x.y : (i == 2) ? x.z : x.w; const unsigned m = ((d >> 8) & 0x00ff00ffu) ^ B1;
                const unsigned l0 = d & 255u, l1 = (d >> 16) & 255u;
                LDS_ADD32(hpw + ((l0 >> 1) << 2), ((m & 0xffffu) == 0u) ? ((l0 & 1u) ? 0x10000u : 1u) : 0u);
                LDS_ADD32(hpw + ((l1 >> 1) << 2), ((m >> 16) == 0u) ? ((l1 & 1u) ? 0x10000u : 1u) : 0u); } }
        LDS_WAIT(); __builtin_amdgcn_wave_barrier();
        TPROBE_END(111);
        TPROBE_BEGIN(112);
        unsigned T, need2;
        { const v2u wv = *(const LAS v2u*)(hp + 126 - 2 * jj); unsigned hb[4];
          hb[3] = wv.x & 0xffffu; hb[2] = wv.x >> 16; hb[1] = wv.y & 0xffffu; hb[0] = wv.y >> 16;
          const unsigned s4 = hb[0] + hb[1] + hb[2] + hb[3];
          unsigned pre = s4;
#pragma unroll
          for (int o = 1; o < 64; o <<= 1) { const unsigned x = __shfl_up(pre, o, 64); if (jj >= o) pre += x; }
          const unsigned long long bal = __ballot(pre >= need1); const int js = __builtin_ctzll(bal);
          unsigned above = pre - s4, bb2 = 0, nd2 = 0; bool found = false;
#pragma unroll
          for (int i = 0; i < 4; ++i) { if (!found) { if (above + hb[i] >= need1) { bb2 = 255 - (jj * 4 + i); nd2 = need1 - above; found = true; } else above += hb[i]; } }
          const unsigned b2 = __shfl(bb2, js); need2 = __shfl(nd2, js); T = (b1 << 8) | b2; }
        TPROBE_END(112);
        TPROBE_BEGIN(113);
        const unsigned olw = (unsigned)(unsigned long)(OLB + ql * 512);
        const unsigned G = 256u - need2, Tp = T | (T << 16); unsigned cg = 0, tc = 0;
#pragma unroll 2
        for (int it = 0; it < nit; ++it) { const int base = it * 512 + jj * 8; const v4u x = *(const LAS v4u*)(sc + base);
            unsigned g[8], c = 0, anyeq = 0;
#pragma unroll
            for (int i = 0; i < 4; ++i) { const unsigned d = (i == 0) ? x.x : (i == 1) ? x.y : (i == 2) ? x.z : x.w;
                g[2 * i] = ((d & 0xffffu) > T) ? 1u : 0u; g[2 * i + 1] = ((d >> 16) > T) ? 1u : 0u; c += g[2 * i] + g[2 * i + 1];
                const unsigned q = d ^ Tp; anyeq |= (((q & 0xffffu) == 0u) || ((q >> 16) == 0u)) ? 1u : 0u; }
            const unsigned long long m0 = __ballot(c & 1u), m1 = __ballot(c & 2u), m2 = __ballot(c & 4u), m3 = __ballot(c & 8u);
            unsigned pos = cg + __builtin_amdgcn_mbcnt_hi((unsigned)(m0 >> 32), __builtin_amdgcn_mbcnt_lo((unsigned)m0, 0u)) + 2u * __builtin_amdgcn_mbcnt_hi((unsigned)(m1 >> 32), __builtin_amdgcn_mbcnt_lo((unsigned)m1, 0u))
                         + 4u * __builtin_amdgcn_mbcnt_hi((unsigned)(m2 >> 32), __builtin_amdgcn_mbcnt_lo((unsigned)m2, 0u)) + 8u * __builtin_amdgcn_mbcnt_hi((unsigned)(m3 >> 32), __builtin_amdgcn_mbcnt_lo((unsigned)m3, 0u));
            cg += (unsigned)__builtin_popcountll(m0) + 2u * (unsigned)__builtin_popcountll(m1) + 4u * (unsigned)__builtin_popcountll(m2) + 8u * (unsigned)__builtin_popcountll(m3);
#pragma unroll
            for (int e = 0; e < 8; ++e) { const unsigned a_ = olw + ((pos < 256u ? pos : 255u) << 1); if (g[e]) LDS_ST16(a_, base + e); pos += g[e]; }
            if (__ballot(anyeq) != 0ull) {
#pragma unroll
                for (int e = 0; e < 8; ++e) { const unsigned wd = (e < 2) ? x.x : (e < 4) ? x.y : (e < 6) ? x.z : x.w; const unsigned k = (e & 1) ? (wd >> 16) : (wd & 0xffffu);
                    const bool eq = k == T; const unsigned long long me = __ballot(eq);
                    const unsigned pe = tc + __builtin_amdgcn_mbcnt_hi((unsigned)(me >> 32), __builtin_amdgcn_mbcnt_lo((unsigned)me, 0u));
                    if (eq && pe < need2) LDS_ST16(olw + ((G + pe) << 1), base + e);
                    tc += (unsigned)__builtin_popcountll(me); } } }
#undef LDS_ST32
#undef LDS_ST16
#undef LDS_ADD32
        LDS_WAIT(); __builtin_amdgcn_wave_barrier();
        { const v2u x = *(const LAS v2u*)((LAS u16*)(OLB + ql * 512) + jj * 4); *(GAS v2u*)(SEL + tok * NSEL + jj * 4) = x; }
        TPROBE_END(113);
        TPROBE_END(101);
    }
#undef IDX_DMA
#undef IDX_PREFETCH
#undef IDX_UNIT
}

__device__ __forceinline__ void carry_phase(Frame& F) {
    const int gid = blockIdx.x * NTHR + F.tid; if (gid >= NGRP * NB * 64) return;
    const int p = gid & 63, b = (gid >> 6) & 3, g = gid >> 8;
    const float* A32 = (const float*)(F.ws + WS_A32) + g * 128; const float ar = A32[p * 2], ai = A32[p * 2 + 1];
    const float* SB = (const float*)(F.ws + WS_SBUF) + ((size_t)g * 512 + b * 128) * 128; bf16* UX = (bf16*)(F.ws + WS_UGX) + ((size_t)g * 512 + b * 128) * UGX_LD;
    float xr = 0.f, xi = 0.f;
    for (int c = 0; c < NCH; ++c) {
        UX[(size_t)c * UGX_LD + 512 + p] = (bf16)f2bf(xr); UX[(size_t)c * UGX_LD + 576 + p] = (bf16)f2bf(xi);
        const float sr = SB[c * 128 + p], si = SB[c * 128 + 64 + p];
        const float nr = ar * xr - ai * xi + sr, ni = ar * xi + ai * xr + si; xr = nr; xi = ni;
    }
}

template <int N> __device__ __forceinline__ void wait_vm() { asm volatile("s_waitcnt vmcnt(%0)" :: "n"(N) : "memory"); }
typedef short s16x4 __attribute__((ext_vector_type(4)));
__device__ __forceinline__ void attn_phase(Frame& F) {
    constexpr int WSTR = 20224;
    LAS unsigned char* RING = F.lds + F.wave * WSTR;
    LAS u16* SL = (LAS u16*)(RING + 16384);
    const bf16* Q = (const bf16*)(F.ws + WS_Q); const bf16* Kg = (const bf16*)(F.ws + WS_K); const bf16* Vg = (const bf16*)(F.ws + WS_V);
    const u16* SEL = (const u16*)(F.ws + WS_SEL); bf16* YA = (bf16*)(F.ws + WS_YATT);
    const int lane = F.lane, gw = blockIdx.x * NWAVES + F.wave, NGW = F.G * NWAVES;
    const int hd = lane & 15, kg = lane >> 4;
    const int l8 = lane >> 3, cpos = lane & 7;
    unsigned tra[8];
    { const int q4 = hd >> 2, p4 = hd & 3; const unsigned rb = (unsigned)(unsigned long)RING;
#pragma unroll
      for (int mt = 0; mt < 4; ++mt)
#pragma unroll
          for (int tl = 0; tl < 2; ++tl) { const int row = tl * 16 + kg * 4 + q4, cc = 2 * mt + (p4 >> 1), pos = cc ^ (2 * ((row >> 1) & 3)); tra[2 * mt + tl] = rb + row * 128 + pos * 16 + (p4 & 1) * 8; } }
    const bool early = (int)blockIdx.x < 128; const int ew = blockIdx.x * NWAVES + F.wave, nitems = early ? 21 : 11; (void)NGW;
    for (int k_ = 0; k_ < nitems; ++k_) { const int it = (k_ < 11) ? gw + 2048 * k_ : 22528 + ew + 1024 * (k_ - 11);
        const int tok = it >> 1, kvh = it & 1, t = tok & 4095; const size_t bbase = (size_t)(tok >> 12) * SEQ;
        const int nsel = (t + 1 < NSEL) ? t + 1 : NSEL;
        { const v2u x = *(const GAS v2u*)(SEL + (size_t)tok * NSEL + lane * 4); *(LAS v2u*)(SL + lane * 4) = x; }
        bf16x8 qf[2];
#pragma unroll
        for (int ks = 0; ks < 2; ++ks) { if (hd < 4) qf[ks] = *(const GAS bf16x8*)(Q + (size_t)tok * 512 + (kvh * 4 + hd) * 64 + ks * 32 + kg * 8); else qf[ks] = (bf16x8){0, 0, 0, 0, 0, 0, 0, 0}; }
        asm volatile("s_waitcnt vmcnt(0)" : "+v"(qf[0]), "+v"(qf[1]) :: "memory");
        LDS_WAIT(); __builtin_amdgcn_wave_barrier();
        const bf16* kbp = Kg + bbase * 128 + kvh * 64; const bf16* vbp = Vg + bbase * 128 + kvh * 64;
        f32x4 sc[8][2]; f32x4 oacc[4];
#pragma unroll
        for (int c = 0; c < 8; ++c) { sc[c][0] = (f32x4){0.f, 0.f, 0.f, 0.f}; sc[c][1] = (f32x4){0.f, 0.f, 0.f, 0.f}; }
#pragma unroll
        for (int m = 0; m < 4; ++m) oacc[m] = (f32x4){0.f, 0.f, 0.f, 0.f};
        float inv = 1.0f;
#define ATT_ISSUE(s) do { const int c_ = (s) & 7; const bool isk_ = (s) < 8; const bf16* gb_ = isk_ ? kbp : vbp; int sel_[4]; \
            _Pragma("unroll") for (int j_ = 0; j_ < 4; ++j_) { const int ki_ = c_ * 32 + j_ * 8 + l8; sel_[j_] = (int)SL[ki_ < nsel ? ki_ : 0]; } \
            _Pragma("unroll") for (int j_ = 0; j_ < 4; ++j_) { const int f_ = isk_ ? ((j_ & 1) * 4 + (lane >> 4)) : (2 * (lane >> 4)); \
                __builtin_amdgcn_global_load_lds((const unsigned*)(gb_ + (size_t)sel_[j_] * 128 + ((cpos ^ f_) << 3)), (LAS unsigned*)(RING + ((s) & 3) * 4096 + j_ * 1024), 16, 0, 0); } } while (0)
        ATT_ISSUE(0); ATT_ISSUE(1); ATT_ISSUE(2);
#pragma unroll
        for (int s = 0; s < 16; ++s) {
            if (s + 3 < 16) ATT_ISSUE(s + 3);
            if (s <= 12) wait_vm<12>(); else if (s == 13) wait_vm<8>(); else if (s == 14) wait_vm<4>(); else wait_vm<0>();
            const LAS unsigned char* buf = RING + (s & 3) * 4096;
            if (s < 8) {
#pragma unroll
                for (int tl = 0; tl < 2; ++tl)
#pragma unroll
                    for (int ks = 0; ks < 2; ++ks) { const bf16x8 af = *(const LAS bf16x8*)(buf + (tl * 16 + hd) * 128 + (((ks * 4 + kg) ^ (hd >> 1)) << 4));
                        sc[s][tl] = __builtin_amdgcn_mfma_f32_16x16x32_bf16(af, qf[ks], sc[s][tl], 0, 0, 0); }
                if (s == 7) {
                    float mx = -3.0e38f;
#pragma unroll
                    for (int c = 0; c < 8; ++c)
#pragma unroll
                        for (int tl = 0; tl < 2; ++tl)
#pragma unroll
                            for (int r = 0; r < 4; ++r) { const int key = c * 32 + tl * 16 + kg * 4 + r; const float v = (key < nsel) ? sc[c][tl][r] : -3.0e38f; sc[c][tl][r] = v; mx = fmaxf(mx, v); }
                    mx = fmaxf(mx, __shfl_xor(mx, 16)); mx = fmaxf(mx, __shfl_xor(mx, 32));
                    float sum = 0.f;
#pragma unroll
                    for (int c = 0; c < 8; ++c)
#pragma unroll
                        for (int tl = 0; tl < 2; ++tl)
#pragma unroll
                            for (int r = 0; r < 4; ++r) { const float e = __expf(sc[c][tl][r] - mx); sc[c][tl][r] = e; sum += e; }
                    sum += __shfl_xor(sum, 16); sum += __shfl_xor(sum, 32);
                    inv = 1.0f / sum;
                }
            } else {
                const int c = s - 8;
                v4u pw; pw.x = pg8::cvt_pk_bf16(sc[c][0][0], sc[c][0][1]); pw.y = pg8::cvt_pk_bf16(sc[c][0][2], sc[c][0][3]); pw.z = pg8::cvt_pk_bf16(sc[c][1][0], sc[c][1][1]); pw.w = pg8::cvt_pk_bf16(sc[c][1][2], sc[c][1][3]);
                const bf16x8 pf = __builtin_bit_cast(bf16x8, pw);
                v2u a[8];
                asm volatile("ds_read_b64_tr_b16 %0, %8 offset:%16\n\tds_read_b64_tr_b16 %1, %9 offset:%16\n\tds_read_b64_tr_b16 %2, %10 offset:%16\n\tds_read_b64_tr_b16 %3, %11 offset:%16\n\t"
                             "ds_read_b64_tr_b16 %4, %12 offset:%16\n\tds_read_b64_tr_b16 %5, %13 offset:%16\n\tds_read_b64_tr_b16 %6, %14 offset:%16\n\tds_read_b64_tr_b16 %7, %15 offset:%16\n\ts_waitcnt lgkmcnt(0)"
                             : "=&v"(a[0]), "=&v"(a[1]), "=&v"(a[2]), "=&v"(a[3]), "=&v"(a[4]), "=&v"(a[5]), "=&v"(a[6]), "=&v"(a[7])
                             : "v"(tra[0]), "v"(tra[1]), "v"(tra[2]), "v"(tra[3]), "v"(tra[4]), "v"(tra[5]), "v"(tra[6]), "v"(tra[7]), "n"((s & 3) * 4096) : "memory");
#pragma unroll
                for (int mt = 0; mt < 4; ++mt) {
                    v4u aw; aw.x = a[2 * mt].x; aw.y = a[2 * mt].y; aw.z = a[2 * mt + 1].x; aw.w = a[2 * mt + 1].y;
                    oacc[mt] = __builtin_amdgcn_mfma_f32_16x16x32_bf16(__builtin_bit_cast(bf16x8, aw), pf, oacc[mt], 0, 0, 0);
                }
            }
        }
#undef ATT_ISSUE
        if (hd < 4) {
            bf16* yo = YA + (size_t)tok * 512 + (kvh * 4 + hd) * 64 + kg * 4;
#pragma unroll
            for (int mt = 0; mt < 4; ++mt) { pg8::u32x2 w; w.x = pg8::cvt_pk_bf16(oacc[mt][0] * inv, oacc[mt][1] * inv); w.y = pg8::cvt_pk_bf16(oacc[mt][2] * inv, oacc[mt][3] * inv); *(GAS pg8::u32x2*)(yo + 16 * mt) = w; }
        }
        LDS_WAIT(); __builtin_amdgcn_wave_barrier();
    }
}

__device__ __forceinline__ void router_phase(Frame& F) {
    LAS float* HR = (LAS float*)(F.lds);
    LAS float* PT = (LAS float*)(F.lds + 65536);
    LAS int* LE = (LAS int*)(F.lds + 81920);
    LAS int* LP = (LAS int*)(F.lds + 82944);
    LAS unsigned* LC = (LAS unsigned*)(F.lds + 83968);
    const float* X1 = (const float*)(F.ws + WS_X1); bf16* H2 = (bf16*)(F.ws + WS_H2);
    const float* WR = F.in[I_WR]; const float* BR = F.in[I_BR]; const float* G2 = F.in[I_N2G];
    int* TOPE = (int*)(F.ws + WS_TOPE); float* TOPW = (float*)(F.ws + WS_TOPW); int* TOPPOS = (int*)(F.ws + WS_TOPPOS); int* ROWMAP = (int*)(F.ws + WS_ROWMAP);
    const int tid = F.tid, lane = F.lane, wave = F.wave, e = lane & 31, dh = lane >> 5;
    float wr[64];
#pragma unroll
    for (int i = 0; i < 64; ++i) wr[i] = WR[(size_t)(128 * wave + dh * 64 + i) * 32 + e];
    if (tid < 64) LC[tid] = 0u;
    const int tok0 = blockIdx.x * 64;
    f32x4 nv[2][4];
#pragma unroll
    for (int rr = 0; rr < 2; ++rr)
#pragma unroll
        for (int j = 0; j < 4; ++j) nv[rr][j] = ((const GAS f32x4*)(X1 + (size_t)(tok0 + 2 * wave + rr) * DM) + lane)[64 * j];
    for (int bt = 0; bt < 4; ++bt) {
        __syncthreads();
#pragma unroll
        for (int rr = 0; rr < 2; ++rr) { const int lr = 2 * wave + rr, tok = tok0 + bt * 16 + lr;
            const GAS f32x4* gr = (const GAS f32x4*)G2 + lane;
            f32x4 v[4]; float s2 = 0.f;
#pragma unroll
            for (int j = 0; j < 4; ++j) { v[j] = nv[rr][j]; s2 += (v[j].x * v[j].x + v[j].y * v[j].y) + (v[j].z * v[j].z + v[j].w * v[j].w); }
            const float rstd = 1.0f / sqrtf(wave_sum(s2) * (1.f / DM) + RMS_EPS);
            GAS unsigned long long* o8 = (GAS unsigned long long*)(H2 + (size_t)tok * DM) + lane;
#pragma unroll
            for (int j = 0; j < 4; ++j) { const f32x4 gg = gr[64 * j]; const f32x4 h = v[j] * rstd * gg;
                *(LAS f32x4*)(HR + lr * 1024 + 256 * j + 4 * lane) = h;
                o8[64 * j] = (unsigned long long)pk2(h.x, h.y) | ((unsigned long long)pk2(h.z, h.w) << 32); } }
        if (bt + 1 < 4) {
#pragma unroll
            for (int rr = 0; rr < 2; ++rr)
#pragma unroll
                for (int j = 0; j < 4; ++j) nv[rr][j] = ((const GAS f32x4*)(X1 + (size_t)(tok0 + (bt + 1) * 16 + 2 * wave + rr) * DM) + lane)[64 * j];
        }
        __syncthreads();
#pragma unroll 2
        for (int lr = 0; lr < 16; ++lr) { const LAS float* hp = HR + lr * 1024 + 128 * wave + dh * 64; float s = 0.f;
#pragma unroll
            for (int i = 0; i < 16; ++i) { const f32x4 h = *(const LAS f32x4*)(hp + 4 * i); s += h[0] * wr[4 * i] + h[1] * wr[4 * i + 1] + h[2] * wr[4 * i + 2] + h[3] * wr[4 * i + 3]; }
            s += __shfl_xor(s, 32);
            if (dh == 0) PT[(lr * 8 + wave) * 32 + e] = s; }
        __syncthreads();
        { const int lr = 2 * wave + dh, tl = bt * 16 + lr, tok = tok0 + tl; float lg = BR[e];
#pragma unroll
          for (int w8 = 0; w8 < 8; ++w8) lg += PT[(lr * 8 + w8) * 32 + e];
          float cur = lg; float tv[4]; int te[4];
#pragma unroll
          for (int k = 0; k < 4; ++k) { float mv = cur; int mi = e;
#pragma unroll
              for (int o = 1; o < 32; o <<= 1) { const float ov = __shfl_xor(mv, o); const int oi = __shfl_xor(mi, o); if (ov > mv || (ov == mv && oi < mi)) { mv = ov; mi = oi; } }
              tv[k] = mv; te[k] = mi; if (e == mi) cur = -3.0e38f; }
          const float e1 = __expf(tv[1] - tv[0]), e2 = __expf(tv[2] - tv[0]), e3 = __expf(tv[3] - tv[0]); const float inv = 1.0f / (1.0f + e1 + e2 + e3);
          if (e < 4) { const int ex = (e == 0) ? te[0] : (e == 1) ? te[1] : (e == 2) ? te[2] : te[3]; const float wv = ((e == 0) ? 1.0f : (e == 1) ? e1 : (e == 2) ? e2 : e3) * inv;
              TOPE[(size_t)tok * 4 + e] = ex; TOPW[(size_t)tok * 4 + e] = wv; LE[tl * 4 + e] = ex; LP[tl * 4 + e] = (int)atomicAdd((unsigned*)&LC[ex], 1u); } }
    }
    __syncthreads();
    if (tid < 32) LC[32 + tid] = __hip_atomic_fetch_add((unsigned*)(F.ctl + CW_ECNT) + tid, LC[tid], RLX_AGENT);
    __syncthreads();
    if (tid < 256) { const int ex = LE[tid], pos = (int)LC[32 + ex] + LP[tid], tok = tok0 + (tid >> 2); TOPPOS[(size_t)tok * 4 + (tid & 3)] = pos; ROWMAP[(size_t)ex * NTOK + pos] = tok; }
}

__device__ __forceinline__ int moe_tables(Frame& F, LAS int* OFF, LAS int* TE) {
    __syncthreads();
    if (F.tid == 0) { int acc = 0; for (int e = 0; e < NEXP; ++e) { const int c = (int)__hip_atomic_load((unsigned*)(F.ctl + CW_ECNT) + e, RLX_AGENT); const int nt = (c + 255) >> 8; OFF[e] = acc * 256; OFF[33 + e] = c; for (int i = 0; i < nt; ++i) TE[acc + i] = e; acc += nt; } OFF[NEXP] = acc; }
    __syncthreads();
    return OFF[NEXP];
}
__device__ __forceinline__ void combine_phase(Frame& F) {
    LAS int* OFF = (LAS int*)(F.lds + MISC_OFF + 512); LAS int* TE = OFF + 72;
    (void)moe_tables(F, OFF, TE);
    const int* TOPE = (const int*)(F.ws + WS_TOPE); const int* TOPPOS = (const int*)(F.ws + WS_TOPPOS); const float* TOPW = (const float*)(F.ws + WS_TOPW);
    const float* X1 = (const float*)(F.ws + WS_X1); const bf16* Y2 = (const bf16*)(F.ws + WS_Y2); const float* GF = F.in[I_NFG];
    const int gw = blockIdx.x * NWAVES + F.wave, NGW = F.G * NWAVES, lane = F.lane;
    for (int tok = gw; tok < NTOK; tok += NGW) {
        f32x4 v[4];
#pragma unroll
        for (int j = 0; j < 4; ++j) v[j] = ((const GAS f32x4*)(X1 + (size_t)tok * DM) + lane)[64 * j];
#pragma unroll
        for (int k = 0; k < 4; ++k) { const int slot = OFF[TOPE[tok * 4 + k]] + TOPPOS[tok * 4 + k]; const float wk = TOPW[tok * 4 + k];
            const GAS v2u* yr = (const GAS v2u*)(Y2 + (size_t)slot * DM) + lane;
#pragma unroll
            for (int j = 0; j < 4; ++j) { const v2u y = yr[64 * j]; v[j].x += wk * bflo(y.x); v[j].y += wk * bfhi(y.x); v[j].z += wk * bflo(y.y); v[j].w += wk * bfhi(y.y); } }
        float s2 = 0.f;
#pragma unroll
        for (int j = 0; j < 4; ++j) s2 += (v[j].x * v[j].x + v[j].y * v[j].y) + (v[j].z * v[j].z + v[j].w * v[j].w);
        const float rstd = 1.0f / sqrtf(wave_sum(s2) * (1.f / DM) + RMS_EPS);
#pragma unroll
        for (int j = 0; j < 4; ++j) { const f32x4 gg = ((const GAS f32x4*)GF + lane)[64 * j]; ((GAS f32x4*)(F.out + (size_t)tok * DM) + lane)[64 * j] = v[j] * rstd * gg; }
    }
}

__device__ __forceinline__ void ubench(Frame& F) {
    bf16x8 a = (bf16x8){1, 2, 3, 4, 5, 6, 7, 8}, b = (bf16x8){8, 7, 6, 5, 4, 3, 2, 1}; a[0] = (short)F.lane;
    float sink = 0.f;
    if (PROBE_DUP == 900) { f32x16 c0 = {0.f, 0.f, 0.f, 0.f, 0.f, 0.f, 0.f, 0.f, 0.f, 0.f, 0.f, 0.f, 0.f, 0.f, 0.f, 0.f}, c1 = c0;
        for (int i = 0; i < 2000; ++i) { c0 = __builtin_amdgcn_mfma_f32_32x32x16_bf16(a, b, c0, 0, 0, 0); c1 = __builtin_amdgcn_mfma_f32_32x32x16_bf16(a, b, c1, 0, 0, 0); }
        sink = c0[0] + c1[5]; }
    if (PROBE_DUP == 901) { f32x4 c0 = {0.f, 0.f, 0.f, 0.f}, c1 = c0, c2 = c0, c3 = c0;
        for (int i = 0; i < 2000; ++i) { c0 = __builtin_amdgcn_mfma_f32_16x16x32_bf16(a, b, c0, 0, 0, 0); c1 = __builtin_amdgcn_mfma_f32_16x16x32_bf16(a, b, c1, 0, 0, 0); c2 = __builtin_amdgcn_mfma_f32_16x16x32_bf16(a, b, c2, 0, 0, 0); c3 = __builtin_amdgcn_mfma_f32_16x16x32_bf16(a, b, c3, 0, 0, 0); }
        sink = c0[0] + c1[1] + c2[2] + c3[3]; }
    if (PROBE_DUP == 902) { float x0 = F.lane, x1 = 1.f, x2 = 2.f, x3 = 3.f, x4 = 4.f, x5 = 5.f, x6 = 6.f, x7 = 7.f; const float m = 1.0001f, d = 0.5f;
        for (int i = 0; i < 4000; ++i) { x0 = x0 * m + d; x1 = x1 * m + d; x2 = x2 * m + d; x3 = x3 * m + d; x4 = x4 * m + d; x5 = x5 * m + d; x6 = x6 * m + d; x7 = x7 * m + d; }
        sink = x0 + x1 + x2 + x3 + x4 + x5 + x6 + x7; }
    if (PROBE_DUP == 903) {
        f32x4 c[4]; float s = 0.f; float wv[16];
#pragma unroll
        for (int i = 0; i < 4; ++i) c[i] = (f32x4){0.f, 0.f, 0.f, 0.f};
#pragma unroll
        for (int i = 0; i < 16; ++i) wv[i] = 0.001f * (i + F.lane);
        for (int it = 0; it < 275; ++it) { f32x4 d[4];
#pragma unroll
            for (int i = 0; i < 4; ++i) { d[i] = (f32x4){0.f, 0.f, 0.f, 0.f}; d[i] = __builtin_amdgcn_mfma_f32_16x16x32_bf16(a, b, d[i], 0, 0, 0); d[i] = __builtin_amdgcn_mfma_f32_16x16x32_bf16(b, a, d[i], 0, 0, 0); }
            float t = 0.f;
#pragma unroll
            for (int i = 0; i < 4; ++i)
#pragma unroll
                for (int r = 0; r < 4; ++r) { const float x = c[i][r]; const int xi = __builtin_bit_cast(int, x); const float m = __builtin_bit_cast(float, xi > 0 ? xi : 0); t += wv[4 * i + r] * m; }
            float u = t;
#pragma unroll
            for (int k = 0; k < 12; ++k) u = u * 1.0001f + 0.5f;
            s += u; a[1] = (short)(it + (int)s);
#pragma unroll
            for (int i = 0; i < 4; ++i) c[i] = d[i]; }
        sink = s; }
    if (sink == 123.456f) ((float*)(F.ws + WS_SBUF))[F.tid] = sink;
}

constexpr int NPHASE = 10;
struct Args { const float* in[25]; float* out; unsigned char* ws; int ph_lo, ph_hi; };
__global__ void __launch_bounds__(NTHR, 2) fwd_kernel(Args args) {
    extern __shared__ __attribute__((aligned(16))) unsigned char lds[];
    Frame F;
    F.lds = (LAS unsigned char*)lds;
    F.MISC = (volatile LAS unsigned*)(F.lds + MISC_OFF);
    F.tid = threadIdx.x; F.lane = F.tid & 63; F.wave = __builtin_amdgcn_readfirstlane(F.tid >> 6); F.G = gridDim.x;
    F.ws = args.ws; F.ctl = (gu32*)(args.ws + WS_CTL); F.out = args.out;
#pragma unroll
    for (int i = 0; i < 25; ++i) F.in[i] = args.in[i];
    for (int u = F.tid; u < 2048 / 4; u += NTHR) ((LAS unsigned*)(F.lds + MISC_OFF))[u] = 0u;
    __syncthreads();
    XcdBarrier bar; bar.bar = (unsigned*)(F.ctl + CW_BAR); bar.x = 0; bar.st = nullptr;
    if (MK_N_LAUNCHES == 1) bar = xcd_barrier_post((unsigned*)(F.ctl + CW_BAR), F.MISC + 8);
    const int lo = args.ph_lo, hi = args.ph_hi;
#define IN(k) (lo <= (k) && (k) < hi)
#define SEAM(k) do { if (IN(k) && IN((k) + 1)) xcd_barrier(bar); } while (0)
    unsigned char* ws = F.ws; const int c = (int)blockIdx.x;

#define BODY_P0 { p0_prologue(F); if (PROBE_DUP >= 900) ubench(F); }
#define BODY_P1 { { pg8::Gemm g{(const bf16*)(ws + WS_XN), (const bf16*)(ws + WS_WIN), 1024, 1024, 1024, 0}; InProjOrder S{F.G, c, (unsigned*)(F.ctl + CW_UDONE)}; \
        EpiInProj E{ws, F.in[I_BGATE]}; pg8::gemm_phase<EpiInProj, InProjOrder>(F.lds, g, S, E); } \
        if (c >= 128 && c < 192) { wg_wait_ge(F, CW_UDONE, 128u * 8u); pg8::Gemm g{(const bf16*)(ws + WS_UGX), (const bf16*)(ws + WS_WS), UGX_LD, 512, 512, 0}; S5StateOrder S{c - 128}; EpiS5State E{(float*)(ws + WS_SBUF)}; \
          pg8::gemm_phase<EpiS5State, S5StateOrder>(F.lds, g, S, E); } }
#define BODY_P2 { carry_phase(F); idx_phase(F); if (PROBE_DUP == 102) { xcd_barrier(bar); idx_phase(F); } }
#define BODY_P3 { if (c >= 128) { { pg8::Gemm g{(const bf16*)(ws + WS_UGX), (const bf16*)(ws + WS_MT), UGX_LD, UGX_LD, 640, 0}; S5YOrder S{c - 128}; EpiS5Y E{(const bf16*)(ws + WS_UGX), F.in[I_SD], (bf16*)(ws + WS_YG)}; \
            pg8::gemm_phase<EpiS5Y, S5YOrder>(F.lds, g, S, E); } \
          wg_signal(F, CW_YDONE); wg_wait_ge(F, CW_YDONE, 128u); \
          { pg8::Gemm g{(const bf16*)(ws + WS_YG), (const bf16*)(ws + WS_WGLU), 512, 512, 512, 0}; StaticOrder S; S.init(NTOK / 256, 2, 128, c - 128); EpiGlu E{(const bf16*)(ws + WS_YG), F.in[I_BGLU], (bf16*)(ws + WS_YSSM)}; \
            pg8::gemm_phase<EpiGlu, StaticOrder>(F.lds, g, S, E); } } \
        attn_phase(F); }
#define BODY_P4 { pg8::Gemm g{(const bf16*)(ws + WS_YSSM), (const bf16*)(ws + WS_WPS), 512, 512, 512, 0}; MixOrder S; S.so.init(NTOK / 256, 4, F.G, c); \
        EpiMix E{(const bf16*)(ws + WS_GS), (const bf16*)(ws + WS_GA), (bf16*)(ws + WS_MIXED)}; pg8::gemm_phase<EpiMix, MixOrder>(F.lds, g, S, E); }
#define BODY_P5 { pg8::Gemm g{(const bf16*)(ws + WS_MIXED), (const bf16*)(ws + WS_WOUT), 1024, 1024, 1024, 0}; StaticOrder S; S.init(NTOK / 256, 4, F.G, c); EpiOut E{F.in[I_X], (float*)(ws + WS_X1)}; \
        pg8::gemm_phase<EpiOut, StaticOrder>(F.lds, g, S, E); }
#define BODY_P6 { router_phase(F); }
#define BODY_P7 { LAS int* OFF = (LAS int*)(F.lds + MISC_OFF + 512); LAS int* TE = OFF + 72; const int TT = moe_tables(F, OFF, TE); \
        pg8::Gemm g{(const bf16*)(ws + WS_H2), (const bf16*)(ws + WS_WMI), 1024, 2048, 1024, (size_t)1024 * 2048 * 2}; MoeOrder S{TE, OFF, OFF + 33, (const int*)(ws + WS_ROWMAP), TT, 8, c}; EpiMoe1 E{F.in[I_BMI], (bf16*)(ws + WS_ACT)}; \
        pg8::gemm_phase<EpiMoe1, MoeOrder, true, true>(F.lds, g, S, E); }
#define BODY_P8 { LAS int* OFF = (LAS int*)(F.lds + MISC_OFF + 512); LAS int* TE = OFF + 72; const int TT = moe_tables(F, OFF, TE); \
        pg8::Gemm g{(const bf16*)(ws + WS_ACT), (const bf16*)(ws + WS_WMO), 1024, 1024, 1024, (size_t)1024 * 1024 * 2}; MoeOrder S{TE, OFF, OFF + 33, nullptr, TT, 4, c}; EpiMoe2 E{F.in[I_BMO], (bf16*)(ws + WS_Y2)}; \
        pg8::gemm_phase<EpiMoe2, MoeOrder, true, true>(F.lds, g, S, E); }
#define BODY_P9 { combine_phase(F); }
#define PHASE(k, BODY) if (IN(k)) { TPROBE_BEGIN(k); BODY TPROBE_END(k); if (PROBE_DUP == (k)) { xcd_barrier(bar); BODY } } SEAM(k);
    PHASE(0, BODY_P0) PHASE(1, BODY_P1) PHASE(2, BODY_P2) PHASE(3, BODY_P3) PHASE(4, BODY_P4) PHASE(5, BODY_P5) PHASE(6, BODY_P6)
    PHASE(7, BODY_P7) PHASE(8, BODY_P8) PHASE(9, BODY_P9)
#undef IN
#undef SEAM
}

extern "C" void kernel_launch(void* const* d_in, const int* in_sizes, int n_in, void* d_out, int out_size, void* d_ws, size_t ws_size, hipStream_t stream) {
    static int grid = 0;
    if (grid == 0) {
        if (n_in != 25 || out_size != NTOK * DM || ws_size < WS_END) { fprintf(stderr, "kernel_launch: unexpected problem (n_in %d out %d ws %zu)\n", n_in, out_size, ws_size); grid = -1; return; }
        if (hipFuncSetAttribute((const void*)fwd_kernel, hipFuncAttributeMaxDynamicSharedMemorySize, LDS_BYTES) != hipSuccess) { fprintf(stderr, "kernel_launch: hipFuncSetAttribute failed\n"); grid = -1; return; }
        int per_cu = 0; (void)hipOccupancyMaxActiveBlocksPerMultiprocessor(&per_cu, (const void*)fwd_kernel, NTHR, LDS_BYTES); (void)hipGetLastError();
        grid = 256;
    }
    if (grid < 0) return;
    (void)hipMemsetAsync((char*)d_ws + WS_CTL, 0, CTL_ZERO_BYTES, stream);
    Args a{};
    for (int i = 0; i < 25; ++i) a.in[i] = (const float*)d_in[i];
    a.out = (float*)d_out; a.ws = (unsigned char*)d_ws;
    if (MK_N_LAUNCHES == 1) { a.ph_lo = 0; a.ph_hi = NPHASE; hipLaunchKernelGGL(fwd_kernel, dim3(grid), dim3(NTHR), LDS_BYTES, stream, a); }
    else for (int p = 0; p < NPHASE; ++p) { a.ph_lo = p; a.ph_hi = p + 1; hipLaunchKernelGGL(fwd_kernel, dim3(grid), dim3(NTHR), LDS_BYTES, stream, a); }
}
```

```cpp
#include <hip/hip_runtime.h>
#include <cstdio>
#include <cstdint>

#ifndef MK_N_LAUNCHES
#define MK_N_LAUNCHES 1
#endif
#ifndef PROBE_DUP
#define PROBE_DUP -1
#endif
#ifndef PROBE_T
#define PROBE_T -1
#endif
#define TPROBE_BEGIN(id) unsigned long long tpb_##id = (PROBE_T == (id)) ? __builtin_amdgcn_s_memrealtime() : 0ull
#define TPROBE_END(id) do { if (PROBE_T == (id)) { const unsigned long long d_ = __builtin_amdgcn_s_memrealtime() - tpb_##id, t1_ = __builtin_amdgcn_s_memrealtime(); while (__builtin_amdgcn_s_memrealtime() - t1_ < 4ull * d_) __builtin_amdgcn_s_sleep(8); } } while (0)

namespace pg8 {
#define PG8_LAS __attribute__((address_space(3)))
typedef unsigned short bf16_t;
typedef short bf16x8 __attribute__((ext_vector_type(8)));
typedef float f32x4 __attribute__((ext_vector_type(4)));
typedef float f32x2 __attribute__((ext_vector_type(2)));
typedef unsigned u32x4 __attribute__((ext_vector_type(4)));
typedef unsigned u32x2 __attribute__((ext_vector_type(2)));
constexpr int BM = 256, BK = 64, HALF = 128, HTB = HALF * BK * 2, STAGE_BYTES = 8 * HTB, NXCD = 8, WGM = 8;

__host__ __device__ __forceinline__ int lds_byte(int r, int c) { const int st = (r >> 4) * 2 + (c >> 5), rr = r & 15, cc = c & 31, ob = rr * 64 + cc * 2; return st * 1024 + (ob ^ (((ob >> 9) & 1) << 5)); }
__host__ __device__ __forceinline__ void stage_rc(int b, int& R, int& C) { const int st = b / 1024, sb = b % 1024, swz = sb ^ (((sb >> 9) & 1) << 5); R = (st >> 1) * 16 + swz / 64; C = (st & 1) * 32 + (swz % 64) / 2; }
__host__ __device__ __forceinline__ int perm32(int rho) { const int n = rho >> 4, i = rho & 15; return 8 * (i >> 2) + 4 * n + (i & 3); }

struct Unit { int pm, pn, pa, pb, e; };
struct Gemm { const bf16_t* A; const bf16_t* Bt; int lda, ldb, K; size_t bexp; };

__device__ __forceinline__ unsigned cvt_pk_bf16(float lo, float hi) { unsigned r; asm volatile("v_cvt_pk_bf16_f32 %0, %1, %2" : "=v"(r) : "v"(lo), "v"(hi)); return r; }
__device__ __forceinline__ u32x4 pack8(const f32x4& v0, const f32x4& v1) { u32x4 w; w.x = cvt_pk_bf16(v0[0], v0[1]); w.y = cvt_pk_bf16(v0[2], v0[3]); w.z = cvt_pk_bf16(v1[0], v1[1]); w.w = cvt_pk_bf16(v1[2], v1[3]); return w; }

template <class Epi, class Sched, bool ALIGN_EPI = true, bool BKN = false>
__device__ __forceinline__ void gemm_phase(PG8_LAS unsigned char* lds, const Gemm g, const Sched& S, const Epi& E) {
    const int tid = threadIdx.x, wid = __builtin_amdgcn_readfirstlane(tid >> 6), lane = tid & 63, wr = wid >> 2, wc = wid & 3, fr = lane & 15, fq = lane >> 4;
    const int K = g.K, nt = K / BK;
    unsigned voffB[2];
#pragma unroll
    for (int i = 0; i < 2; ++i) {
        if constexpr (BKN) { const int krow = (tid >> 4) + 32 * i, cp = tid & 15, fk = ((krow & 3) << 1) | (((krow >> 3) & 1) << 3); voffB[i] = (unsigned)(krow * g.ldb) * 2u + (unsigned)((cp ^ fk) << 4); }
        else { int R, C; stage_rc(tid * 16 + i * 8192, R, C); const int Rb = (R & ~31) + perm32(R & 31); voffB[i] = (unsigned)(Rb * g.ldb + C) * 2u; } }
    const size_t kstep = (size_t)(BK * 2);
    const size_t kstepB = BKN ? (size_t)BK * g.ldb * 2 : kstep;
    const size_t hstepB = BKN ? (size_t)256 : (size_t)HALF * g.ldb * 2;
    const size_t tstepB = BKN ? (size_t)512 : 2 * hstepB;
    const unsigned tbase = (unsigned)(unsigned long)lds + (unsigned)((8 * fq + (fr >> 2)) * 256 + (((4 * wc + (fr & 3)) ^ (((fr >> 2) << 1) | ((fq & 1) << 3))) << 4));
#define PG8_AROWS(VV, U) do { _Pragma("unroll") for (int i_ = 0; i_ < 2; ++i_) { int R_, C_; stage_rc((threadIdx.x & 511) * 16 + i_ * 8192, R_, C_); \
        _Pragma("unroll") for (int h_ = 0; h_ < 2; ++h_) VV[h_][i_] = (unsigned)(S.arow(U, h_, R_) * g.lda + C_) * 2u; } } while (0)
    unsigned vA[2][2], vAn[2][2];
    const unsigned ldsw = (unsigned)wid * 1024u;
    const int aoff = lds_byte(wr * 64 + fr, fq * 8), boff = lds_byte(wc * 32 + fr, fq * 8);
#define PG8_SA(b, h) (((b) * 2 + (h)) * HTB)
#define PG8_SB(b, h) ((4 + (b) * 2 + (h)) * HTB)
#define PG8_STAGE(bufoff, gbase, voff) do { _Pragma("unroll") for (int _i = 0; _i < 2; ++_i) \
        __builtin_amdgcn_global_load_lds((const unsigned*)((const char*)(gbase) + (voff)[_i]), (PG8_LAS unsigned*)(lds + (bufoff) + ldsw + _i * 8192), 16, 0, 0); } while (0)
#define PG8_LDA(dst, b, h) do { _Pragma("unroll") for (int m = 0; m < 4; ++m) _Pragma("unroll") for (int k = 0; k < 2; ++k) dst[m][k] = *(const PG8_LAS bf16x8*)(lds + PG8_SA(b, h) + aoff + m * 2048 + k * 1024); } while (0)
#define PG8_LDB(dst, b, h) do { if constexpr (BKN) { const unsigned ab_ = tbase + PG8_SB(b, h); _Pragma("unroll") for (int n = 0; n < 2; ++n) _Pragma("unroll") for (int k = 0; k < 2; ++k) { u32x2 lo_, hi_; \
            asm volatile("ds_read_b64_tr_b16 %0, %2 offset:%3\n\tds_read_b64_tr_b16 %1, %2 offset:%4" : "=&v"(lo_), "=&v"(hi_) : "v"(ab_), "n"(k * 8192 + n * 8), "n"(k * 8192 + n * 8 + 1024) : "memory"); \
            u32x4 w_; w_.x = lo_.x; w_.y = lo_.y; w_.z = hi_.x; w_.w = hi_.y; dst[n][k] = __builtin_bit_cast(bf16x8, w_); } } \
        else { _Pragma("unroll") for (int n = 0; n < 2; ++n) _Pragma("unroll") for (int k = 0; k < 2; ++k) dst[n][k] = *(const PG8_LAS bf16x8*)(lds + PG8_SB(b, h) + boff + n * 2048 + k * 1024); } } while (0)
#define PG8_WAIT_LB() do { if constexpr (BKN) asm volatile("s_waitcnt lgkmcnt(0)" : "+v"(B0[0][0]), "+v"(B0[0][1]), "+v"(B0[1][0]), "+v"(B0[1][1]), "+v"(B1[0][0]), "+v"(B1[0][1]), "+v"(B1[1][0]), "+v"(B1[1][1]) :: "memory"); \
        else asm volatile("s_waitcnt lgkmcnt(0)" ::: "memory"); } while (0)
#define PG8_MMA(ai, bj, At, Bt) do { __builtin_amdgcn_s_setprio(1); _Pragma("unroll") for (int m = 0; m < 4; ++m) _Pragma("unroll") for (int n = 0; n < 2; ++n) _Pragma("unroll") for (int k = 0; k < 2; ++k) \
        acc[ai][bj][m][n] = __builtin_amdgcn_mfma_f32_16x16x32_bf16(Bt[n][k], At[m][k], acc[ai][bj][m][n], 0, 0, 0); __builtin_amdgcn_s_setprio(0); } while (0)
#define PG8_WAIT_V(n) asm volatile("s_waitcnt vmcnt(" #n ")" ::: "memory")
#define PG8_WAIT_L(n) asm volatile("s_waitcnt lgkmcnt(" #n ")" ::: "memory")
#define PG8_BAR __builtin_amdgcn_s_barrier()
#define PG8_SCHED __builtin_amdgcn_sched_barrier(0)
    Unit cur, nxt; int ui = 0;
    if (!S.next(0, cur)) return;
    f32x4 acc[2][2][4][2];
#pragma unroll
    for (int a = 0; a < 2; ++a)
#pragma unroll
        for (int b = 0; b < 2; ++b)
#pragma unroll
            for (int m = 0; m < 4; ++m)
#pragma unroll
                for (int n = 0; n < 2; ++n) acc[a][b][m][n] = (f32x4){0.f, 0.f, 0.f, 0.f};
    bf16x8 At[4][2], B0[2][2], B1[2][2];
    const char* const bA = (const char*)g.A; const char* cB = BKN ? (const char*)g.Bt + (size_t)cur.e * g.bexp + (size_t)cur.pn * tstepB : (const char*)g.Bt + (size_t)cur.pb * tstepB;
    PG8_AROWS(vA, cur);
    PG8_STAGE(PG8_SB(0, 0), cB, voffB); PG8_STAGE(PG8_SB(0, 1), cB + hstepB, voffB); PG8_STAGE(PG8_SA(0, 0), bA, vA[0]); PG8_STAGE(PG8_SA(0, 1), bA, vA[1]);
    if (wr == 1) PG8_BAR;
    PG8_WAIT_V(2); PG8_BAR;
    PG8_STAGE(PG8_SB(1, 0), cB + kstepB, voffB); PG8_STAGE(PG8_SA(1, 0), bA + kstep, vA[0]); PG8_STAGE(PG8_SB(1, 1), cB + hstepB + kstepB, voffB);
    PG8_WAIT_V(6); PG8_BAR;
    for (;;) {
        const bool has_next = S.next(ui + 1, nxt);
        const char* nB = has_next ? (BKN ? (const char*)g.Bt + (size_t)nxt.e * g.bexp + (size_t)nxt.pn * tstepB : (const char*)g.Bt + (size_t)nxt.pb * tstepB) : cB;
        if (has_next) PG8_AROWS(vAn, nxt); else { vAn[0][0] = vA[0][0]; vAn[0][1] = vA[0][1]; vAn[1][0] = vA[1][0]; vAn[1][1] = vA[1][1]; }
        for (int t = 0; t < nt; t += 2) {
            const bool last = (t == nt - 2);
            const char* a1 = bA + (size_t)(t + 1) * kstep;
            const char* a2 = last ? bA : bA + (size_t)(t + 2) * kstep; const char* b2 = last ? nB : cB + (size_t)(t + 2) * kstepB;
            const char* a3 = a2 + kstep; const char* b3 = b2 + kstepB;
            unsigned w0[2], w1[2];
            w0[0] = last ? vAn[0][0] : vA[0][0]; w0[1] = last ? vAn[0][1] : vA[0][1]; w1[0] = last ? vAn[1][0] : vA[1][0]; w1[1] = last ? vAn[1][1] : vA[1][1];
            PG8_LDB(B0, 0, 0); PG8_LDB(B1, 0, 1); PG8_SCHED; PG8_LDA(At, 0, 0); PG8_STAGE(PG8_SA(1, 1), a1, vA[1]);
            PG8_WAIT_V(8); PG8_WAIT_LB(); PG8_BAR; PG8_MMA(0, 0, At, B0); PG8_MMA(0, 1, At, B1); PG8_BAR; PG8_SCHED;
            PG8_LDA(At, 0, 1); PG8_STAGE(PG8_SB(0, 0), b2, voffB); PG8_STAGE(PG8_SB(0, 1), b2 + hstepB, voffB); PG8_STAGE(PG8_SA(0, 0), a2, w0);
            PG8_WAIT_V(8); PG8_WAIT_L(0); PG8_BAR; PG8_MMA(1, 0, At, B0); PG8_MMA(1, 1, At, B1); PG8_BAR; PG8_SCHED;
            PG8_LDB(B0, 1, 0); PG8_LDB(B1, 1, 1); PG8_SCHED; PG8_LDA(At, 1, 0); PG8_STAGE(PG8_SA(0, 1), a2, w1);
            PG8_WAIT_V(8); PG8_WAIT_LB(); PG8_BAR; PG8_MMA(0, 0, At, B0); PG8_MMA(0, 1, At, B1); PG8_BAR; PG8_SCHED;
            PG8_LDA(At, 1, 1); PG8_STAGE(PG8_SB(1, 0), b3, voffB); PG8_STAGE(PG8_SB(1, 1), b3 + hstepB, voffB); PG8_STAGE(PG8_SA(1, 0), a3, w0);
            PG8_WAIT_V(8); PG8_WAIT_L(0); PG8_BAR; PG8_MMA(1, 0, At, B0); PG8_MMA(1, 1, At, B1); PG8_BAR; PG8_SCHED;
        }
        if constexpr (ALIGN_EPI) { if (wr == 0) PG8_BAR; }
        E(acc, cur, wr, wc, fr, fq); S.done(cur);
        if (!has_next) break;
#pragma unroll
        for (int a = 0; a < 2; ++a)
#pragma unroll
            for (int b = 0; b < 2; ++b)
#pragma unroll
                for (int m = 0; m < 4; ++m)
#pragma unroll
                    for (int n = 0; n < 2; ++n) acc[a][b][m][n] = (f32x4){0.f, 0.f, 0.f, 0.f};
        cur = nxt; cB = nB; ++ui; vA[0][0] = vAn[0][0]; vA[0][1] = vAn[0][1]; vA[1][0] = vAn[1][0]; vA[1][1] = vAn[1][1];
        if constexpr (ALIGN_EPI) { if (wr == 1) PG8_BAR; }
    }
    PG8_WAIT_V(0);
    if constexpr (!ALIGN_EPI) { if (wr == 0) PG8_BAR; }
    PG8_BAR;
#undef PG8_AROWS
#undef PG8_SA
#undef PG8_SB
#undef PG8_STAGE
#undef PG8_LDA
#undef PG8_LDB
#undef PG8_WAIT_LB
#undef PG8_MMA
#undef PG8_WAIT_V
#undef PG8_WAIT_L
#undef PG8_BAR
#undef PG8_SCHED
}
}

constexpr int NB = 4, SEQ = 4096, NTOK = NB * SEQ, DM = 1024;
constexpr int NWAVES = 8, NTHR = 512;
constexpr int D_SSM = 512, NGRP = 32, NSTATE = 64, CH = 32  , NCH = SEQ / CH  , UGX_LD = 640, S5_ROWS = NB * NCH  ;
constexpr int NIN_PAD = 4608;
constexpr int NEXP = 32, TOPK_E = 4, DFF = 1024;
constexpr int NSEL = 256;
constexpr int MAX_MT = 288;
constexpr float RMS_EPS = 1e-5f;

constexpr size_t MiB = 1u << 20;
constexpr size_t WS_CTL = 0, CTL_ZERO_BYTES = 1 * MiB;
constexpr size_t WS_ROPE = 1 * MiB;
constexpr size_t WS_WIN = 2 * MiB;
constexpr size_t WS_WGLU = 11 * MiB;
constexpr size_t WS_WPS = 12 * MiB;
constexpr size_t WS_WPA = 13 * MiB;
constexpr size_t WS_WOUT = 14 * MiB;
constexpr size_t WS_MT = 16 * MiB;
constexpr size_t WS_WS = 36 * MiB;
constexpr size_t WS_A32 = 44 * MiB;
constexpr size_t WS_SBUF = 45 * MiB;
constexpr size_t WS_WI = 53 * MiB;
constexpr size_t WS_KI = 54 * MiB;
constexpr size_t WS_K = 56 * MiB;
constexpr size_t WS_V = 60 * MiB;
constexpr size_t WS_UGX = 64 * MiB;
constexpr size_t WS_Q = 84 * MiB;
constexpr size_t WS_QI = 100 * MiB;
constexpr size_t WS_GS = 132 * MiB;
constexpr size_t WS_GA = 164 * MiB;
constexpr size_t WS_XN = 196 * MiB;
constexpr size_t WS_YG = 228 * MiB;
constexpr size_t WS_YSSM = 244 * MiB;
constexpr size_t WS_YATT = 260 * MiB;
constexpr size_t WS_SEL = 276 * MiB;
constexpr size_t WS_MIXED = 284 * MiB;
constexpr size_t WS_X1 = 316 * MiB;
constexpr size_t WS_H2 = 380 * MiB;
constexpr size_t WS_TOPE = 412 * MiB;
constexpr size_t WS_TOPW = WS_TOPE + 256 * 1024;
constexpr size_t WS_TOPPOS = WS_TOPW + 256 * 1024;
constexpr size_t WS_ROWMAP = 413 * MiB;
constexpr size_t WS_WMI = 416 * MiB;
constexpr size_t WS_WMO = 544 * MiB;
constexpr size_t WS_ACT = 608 * MiB;
constexpr size_t WS_XP = 64 * MiB;
constexpr size_t WS_Y2 = 64 * MiB;
constexpr size_t WS_END = 752 * MiB;
static_assert(WS_XP + (size_t)MAX_MT * 256 * 1024 * 2 <= WS_YG, "XP overlay");
constexpr int CW_TMO = 0, CW_CODE = 1;
constexpr int CW_BAR = 4096;
constexpr int CW_ECNT = 16384;
constexpr int CW_UDONE = 16384 + 64;
constexpr int CW_YDONE = 16384 + 128;

constexpr int LDS_BYTES = 163840;
constexpr int MISC_OFF = 163840 - 2048;

#define GAS __attribute__((address_space(1)))
#define LAS __attribute__((address_space(3)))
typedef unsigned short bf16;
typedef unsigned short u16;
typedef unsigned v4u __attribute__((ext_vector_type(4)));
typedef unsigned v2u __attribute__((ext_vector_type(2)));
typedef float f32x4 __attribute__((ext_vector_type(4)));
typedef float f32x16 __attribute__((ext_vector_type(16)));
typedef short bf16x8 __attribute__((ext_vector_type(8)));
typedef GAS unsigned gu32;
#define RLX_AGENT __ATOMIC_RELAXED, __HIP_MEMORY_SCOPE_AGENT
#define LDS_WAIT() asm volatile("s_waitcnt lgkmcnt(0)" ::: "memory")
#define VM_WAIT() asm volatile("s_waitcnt vmcnt(0)" ::: "memory")
__device__ __forceinline__ unsigned f2bf(float f) { unsigned u = __builtin_bit_cast(unsigned, f); return (u + 0x7fffu + ((u >> 16) & 1u)) >> 16; }
__device__ __forceinline__ unsigned pk2(float lo, float hi) { return f2bf(lo) | (f2bf(hi) << 16); }
__device__ __forceinline__ float bf2f(unsigned b) { return __builtin_bit_cast(float, b << 16); }
__device__ __forceinline__ float bflo(unsigned w) { return __builtin_bit_cast(float, w << 16); }
__device__ __forceinline__ float bfhi(unsigned w) { return __builtin_bit_cast(float, w & 0xffff0000u); }
__device__ __forceinline__ float sigmoidf_(float x) { return 1.0f / (1.0f + __expf(-x)); }
__device__ __forceinline__ float gelu_tanh(float x) { const float u = 0.7978845608028654f * (x + 0.044715f * x * x * x); const float e = __expf(2.0f * u); const float t = 1.0f - 2.0f / (e + 1.0f); return 0.5f * x * (1.0f + t); }

#define XB_TMO      128
#define XB_XCNT(j)  (256  + 64 * (j))
#define XB_XSUB(j)  (1280 + 64 * (j))
#define XB_XGEN(j)  (2304 + 64 * (j))
#define XB_TOP      3328
#define XB_TOPGEN   3392
#define XCD_BAR_WORDS 3456
#define XB_SPIN_CAP (1u << 18)
__device__ __forceinline__ unsigned xb_ld(unsigned* p)              { return __hip_atomic_load(p, __ATOMIC_RELAXED, __HIP_MEMORY_SCOPE_AGENT); }
__device__ __forceinline__ unsigned xb_add(unsigned* p, unsigned v) { return __hip_atomic_fetch_add(p, v, __ATOMIC_RELAXED, __HIP_MEMORY_SCOPE_AGENT); }
__device__ __forceinline__ unsigned xb_xcc_id() { return (unsigned)__builtin_amdgcn_s_getreg((3 << 11) | 20) & 0xFu; }
#define XB_SPIN(cond, bar) do { unsigned _sp = 0; while (cond) { __builtin_amdgcn_s_sleep(1); \
    if ((++_sp & 255u) == 0u) { if (xb_ld(&(bar)[XB_TMO])) break; if (_sp > XB_SPIN_CAP) { atomicAdd(&(bar)[XB_TMO], 1u); break; } } } } while (0)
struct XcdBarrier { unsigned* bar; unsigned x; volatile LAS unsigned* st; };
__device__ __forceinline__ XcdBarrier xcd_barrier_post(unsigned* bar, volatile LAS unsigned* st) {
    XcdBarrier b; b.bar = bar; b.x = xb_xcc_id(); b.st = st;
    if (threadIdx.x == 0) (void)xb_add(&bar[XB_XCNT(b.x)], 1u);
    return b;
}
__device__ __forceinline__ void xcd_barrier_complete(unsigned* bar, unsigned x, unsigned& nloc, unsigned& nx) {
    const unsigned G = gridDim.x * gridDim.y * gridDim.z;
    unsigned sum, cnt, mine, sp = 0u;
    for (;;) {
        sum = 0u; cnt = 0u; mine = 0u;
#pragma unroll
        for (unsigned j = 0; j < 16; ++j) { const unsigned c = xb_ld(&bar[XB_XCNT(j)]); sum += c; cnt += (c > 0u) ? 1u : 0u; mine = (j == x) ? c : mine; }
        if (sum == G) break;
        __builtin_amdgcn_s_sleep(1);
        if ((++sp & 255u) == 0u) { if (xb_ld(&bar[XB_TMO])) break; if (sp > XB_SPIN_CAP) { atomicAdd(&bar[XB_TMO], 1u); break; } }
    }
    nloc = mine > 0u ? mine : 1u; nx = cnt > 0u ? cnt : 1u;
}
__device__ __forceinline__ void xcd_barrier(const XcdBarrier& b) {
    asm volatile("s_waitcnt vmcnt(0)" ::: "memory");
    __syncthreads();
    if (threadIdx.x == 0) {
        unsigned* bar = b.bar;
        __builtin_amdgcn_s_waitcnt(0);
        unsigned nloc = b.st[0], nx = b.st[1];
        if (nloc == 0u) { xcd_barrier_complete(bar, b.x, nloc, nx); b.st[0] = nloc; b.st[1] = nx; }
        const unsigned old = xb_add(&bar[XB_XSUB(b.x)], 1u);
        const unsigned gen = old / nloc;
        if (old + 1u == (gen + 1u) * nloc) {
            __builtin_amdgcn_fence(__ATOMIC_RELEASE, "agent");
            asm volatile("s_waitcnt vmcnt(0)" ::: "memory");
            const unsigned og = xb_add(&bar[XB_TOP], 1u);
            const unsigned tg = og / nx;
            if (og + 1u == (tg + 1u) * nx) xb_add(&bar[XB_TOPGEN], 1u);
            else XB_SPIN(xb_ld(&bar[XB_TOPGEN]) == tg, bar);
            __builtin_amdgcn_fence(__ATOMIC_ACQUIRE, "agent");
            xb_add(&bar[XB_XGEN(b.x)], 1u);
            asm volatile("s_waitcnt vmcnt(0)" ::: "memory");
        } else {
            XB_SPIN(xb_ld(&bar[XB_XGEN(b.x)]) == gen, bar);
            __builtin_amdgcn_fence(__ATOMIC_ACQUIRE, "agent");
            asm volatile("s_waitcnt vmcnt(0)" ::: "memory");
        }
    }
    __syncthreads();
}

struct Frame {
    LAS unsigned char* lds;
    volatile LAS unsigned* MISC;
    gu32* ctl;
    int tid, lane, wave, G;
    unsigned char* ws;
    const float* in[25];
    float* out;
};
enum { I_X = 0, I_N1G, I_WIN, I_BGATE, I_LRE, I_LIM, I_LOGDT, I_BRE, I_BIM, I_CRE, I_CIM, I_SD, I_WGLU, I_BGLU, I_WPS, I_WPA, I_WOUT, I_N2G, I_WR, I_BR, I_WMI, I_BMI, I_WMO, I_BMO, I_NFG };

__device__ __forceinline__ float wave_sum(float v) {
#pragma unroll
    for (int o = 1; o < 64; o <<= 1) v += __shfl_xor(v, o);
    return v;
}

__device__ __forceinline__ int ropeperm(int p) { const int a = p >> 3, bb = p & 7; return bb < 4 ? 4 * a + bb : 32 + 4 * a + (bb - 4); }
__device__ __forceinline__ int win_src(int nd) {
    const int pn = nd >> 8, j = nd & 255;
    if (pn < 2) return nd;
    if (pn < 4) { const int i = nd - 512; return 512 + (i & ~63) + ropeperm(i & 63); }
    if (pn == 4) { if (j < 128) return 1024 + (j & ~63) + ropeperm(j & 63); return 1152 + (j - 128); }
    if (pn < 9) { const int i = nd - 1280; return 1280 + (i & ~63) + ropeperm(i & 63); }
    if (pn == 9) { if (j < 64) return 2304 + ropeperm(j); if (j < 80) return 2368 + (j - 64); return -1; }
    if (pn < 14) return 2384 + (nd - 2560);
    return 3408 + (nd - 3584);
}
struct TItem { const float* src; bf16* dst; int N, K; };
__device__ __forceinline__ void titem_load(const TItem& T, float (&tv)[32], int lane) {
#pragma unroll
    for (int i = 0; i < 32; ++i) { const int kk = 2 * i + (lane >> 5); tv[i] = T.src ? __builtin_nontemporal_load(T.src + (size_t)kk * T.N) : 0.f; }
}
__device__ __forceinline__ void titem_store(const TItem& T, const float (&tv)[32], LAS float* scr, int lane) {
#pragma unroll
    for (int i = 0; i < 32; ++i) { const int kk = 2 * i + (lane >> 5); scr[kk * 33 + (lane & 31)] = tv[i]; }
    LDS_WAIT(); asm volatile("" ::: "memory");
    const int c = lane & 7;
#pragma unroll
    for (int j = 0; j < 4; ++j) { const int n = (lane >> 3) + 8 * j; const LAS float* s = scr + (8 * c) * 33 + n;
        v4u o; o.x = pk2(s[0 * 33], s[1 * 33]); o.y = pk2(s[2 * 33], s[3 * 33]); o.z = pk2(s[4 * 33], s[5 * 33]); o.w = pk2(s[6 * 33], s[7 * 33]);
        *(GAS v4u*)(T.dst + (size_t)n * T.K + 8 * c) = o; }
    LDS_WAIT(); asm volatile("" ::: "memory");
}
__device__ __forceinline__ void rms_row_to_bf16(int lane, const float* xrow, const float* g, bf16* orow) {
    const GAS f32x4* xr = (const GAS f32x4*)xrow + lane; const GAS f32x4* gr = (const GAS f32x4*)g + lane;
    f32x4 v[4]; float s2 = 0.f;
#pragma unroll
    for (int j = 0; j < 4; ++j) { v[j] = xr[64 * j]; s2 += (v[j].x * v[j].x + v[j].y * v[j].y) + (v[j].z * v[j].z + v[j].w * v[j].w); }
    const float rstd = 1.0f / sqrtf(wave_sum(s2) * (1.f / DM) + RMS_EPS);
    GAS unsigned long long* o8 = (GAS unsigned long long*)orow + lane;
#pragma unroll
    for (int j = 0; j < 4; ++j) { const f32x4 gg = gr[64 * j];
        o8[64 * j] = (unsigned long long)pk2(v[j].x * rstd * gg.x, v[j].y * rstd * gg.y) | ((unsigned long long)pk2(v[j].z * rstd * gg.z, v[j].w * rstd * gg.w) << 32); }
}
__device__ __forceinline__ void p0_s5_group(Frame& F, int g) {
    LAS float* AP = (LAS float*)(F.lds);
    LAS float* BB = (LAS float*)(F.lds + 16896);
    LAS float* CC = (LAS float*)(F.lds + 25088);
    LAS float* KJ = (LAS float*)(F.lds + 33280);
    const float* lre = F.in[I_LRE] + g * 64; const float* lim = F.in[I_LIM] + g * 64;
    const double dt = exp((double)F.in[I_LOGDT][g]);
    __syncthreads();
    for (int idx = F.tid; idx < 33 * 64; idx += NTHR) { const int p = idx & 63, j = idx >> 6;
        const double lr = lre[p], li = lim[p]; const double mag = exp(j * lr * dt), ang = j * li * dt;
        AP[idx * 2] = (float)(mag * cos(ang)); AP[idx * 2 + 1] = (float)(mag * sin(ang)); }
    for (int idx = F.tid; idx < 1024; idx += NTHR) { const int p = idx >> 4;
        const double lr = lre[p], li = lim[p]; const double mag = exp(lr * dt), ang = li * dt; const double ar = mag * cos(ang), ai = mag * sin(ang);
        const double nr = ar - 1.0, ni = ai, den = lr * lr + li * li; const double zr = (nr * lr + ni * li) / den, zi = (ni * lr - nr * li) / den;
        const double br = F.in[I_BRE][g * 1024 + idx], bi = F.in[I_BIM][g * 1024 + idx];
        BB[idx * 2] = (float)(zr * br - zi * bi); BB[idx * 2 + 1] = (float)(zr * bi + zi * br); }
    for (int idx = F.tid; idx < 1024; idx += NTHR) { CC[idx * 2] = F.in[I_CRE][g * 1024 + idx]; CC[idx * 2 + 1] = F.in[I_CIM][g * 1024 + idx]; }
    __syncthreads();
    { const int j = F.tid >> 4, hp = F.tid & 15; float s[16];
#pragma unroll
      for (int h = 0; h < 16; ++h) s[h] = 0.f;
      for (int p = 0; p < 64; ++p) { const float cr = CC[(hp * 64 + p) * 2], ci = CC[(hp * 64 + p) * 2 + 1], ar = AP[(j * 64 + p) * 2], ai = AP[(j * 64 + p) * 2 + 1];
          const float er = cr * ar - ci * ai, ei = cr * ai + ci * ar;
#pragma unroll
          for (int h4 = 0; h4 < 8; ++h4) { const f32x4 bb = *(const LAS f32x4*)(BB + (p * 16 + 2 * h4) * 2); s[2 * h4] += er * bb[0] - ei * bb[1]; s[2 * h4 + 1] += er * bb[2] - ei * bb[3]; } }
#pragma unroll
      for (int h = 0; h < 16; ++h) KJ[(j * 16 + hp) * 16 + h] = s[h]; }
    __syncthreads();
    bf16* MT = (bf16*)(F.ws + WS_MT) + (size_t)g * 512 * 640;
    for (int ch = F.tid; ch < 512 * 80; ch += NTHR) { const int n = ch / 80, k0 = (ch % 80) * 8, tp = n >> 4, hp = n & 15; float v[8];
        if (k0 < 512) { const int sp = k0 >> 4, h0 = k0 & 15;
#pragma unroll
            for (int j = 0; j < 8; ++j) v[j] = (sp <= tp) ? KJ[((tp - sp) * 16 + hp) * 16 + h0 + j] : 0.f; }
        else { const bool im = k0 >= 576; const int p0 = k0 - (im ? 576 : 512);
#pragma unroll
            for (int j = 0; j < 8; ++j) { const int p = p0 + j; const float cr = CC[(hp * 64 + p) * 2], ci = CC[(hp * 64 + p) * 2 + 1], ar = AP[((tp + 1) * 64 + p) * 2], ai = AP[((tp + 1) * 64 + p) * 2 + 1];
                v[j] = im ? -(cr * ai + ci * ar) : (cr * ar - ci * ai); } }
        v4u o; o.x = pk2(v[0], v[1]); o.y = pk2(v[2], v[3]); o.z = pk2(v[4], v[5]); o.w = pk2(v[6], v[7]);
        *(GAS v4u*)(MT + (size_t)n * 640 + k0) = o; }
    bf16* WS = (bf16*)(F.ws + WS_WS) + (size_t)g * 256 * 512;
    for (int ch = F.tid; ch < 256 * 64; ch += NTHR) { const int n = ch >> 6, k0 = (ch & 63) * 8, sp = k0 >> 4, h0 = k0 & 15; float v[8];
#pragma unroll
        for (int j = 0; j < 8; ++j) { if (n < 128) { const int p = n & 63; const float ar = AP[((31 - sp) * 64 + p) * 2], ai = AP[((31 - sp) * 64 + p) * 2 + 1], br = BB[(p * 16 + h0 + j) * 2], bi = BB[(p * 16 + h0 + j) * 2 + 1];
                v[j] = (n < 64) ? (ar * br - ai * bi) : (ar * bi + ai * br); } else v[j] = 0.f; }
        v4u o; o.x = pk2(v[0], v[1]); o.y = pk2(v[2], v[3]); o.z = pk2(v[4], v[5]); o.w = pk2(v[6], v[7]);
        *(GAS v4u*)(WS + (size_t)n * 512 + k0) = o; }
    float* A32 = (float*)(F.ws + WS_A32) + g * 128;
    if (F.tid < 128) A32[F.tid] = AP[32 * 128 + F.tid];
    __syncthreads();
}
constexpr size_t MOE_N8_IN = (size_t)NEXP * 1024 * 2048 / 8, MOE_N8 = MOE_N8_IN + (size_t)NEXP * 1024 * 1024 / 8, MOE_N8A = (MOE_N8 / 10) * 9;
__device__ __forceinline__ void moe_convert(Frame& F, size_t lo8, size_t hi8, int vw0, int nvw, int vtotal) {
    const size_t vstride = (size_t)vtotal * NTHR;
    for (int vw = 0; vw < nvw; ++vw)
    for (size_t i0 = lo8 + (size_t)(vw0 + vw) * NTHR + F.tid; i0 < hi8; i0 += 4 * vstride) {
        f32x4 a[4], b[4];
#pragma unroll
        for (int u = 0; u < 4; ++u) { const size_t i = i0 + (size_t)u * vstride; if (i < hi8) { const float* s = (i < MOE_N8_IN) ? F.in[I_WMI] + i * 8 : F.in[I_WMO] + (i - MOE_N8_IN) * 8;
            a[u] = __builtin_nontemporal_load((const f32x4*)s); b[u] = __builtin_nontemporal_load((const f32x4*)s + 1); } }
#pragma unroll
        for (int u = 0; u < 4; ++u) { const size_t i = i0 + (size_t)u * vstride; if (i < hi8) { bf16* d = (i < MOE_N8_IN) ? (bf16*)(F.ws + WS_WMI) + i * 8 : (bf16*)(F.ws + WS_WMO) + (i - MOE_N8_IN) * 8;
            *(GAS v4u*)d = pg8::pack8(a[u], b[u]); } } }
}
__device__ __forceinline__ void p0_prologue(Frame& F) {
    const int NW = F.G - NGRP;
    const bool s5wg = (int)blockIdx.x >= NW;
    TPROBE_BEGIN(120);
    if (s5wg) p0_s5_group(F, (int)blockIdx.x - NW);
    TPROBE_END(120);
    TPROBE_BEGIN(121);
    if (!s5wg) {
    LAS float* scr = (LAS float*)(F.lds + F.wave * 16384);
    const int gw = blockIdx.x * NWAVES + F.wave, NGW = NW * NWAVES;
    { float* cosT = (float*)(F.ws + WS_ROPE); float* sinT = cosT + SEQ * 32;
      for (int i = blockIdx.x * NTHR + F.tid; i < SEQ * 32; i += NW * NTHR) { const int pos = i >> 5, k = i & 31;
          const double inv = pow(10000.0, -(double)k / 32.0); const double ang = (double)pos * (double)(float)inv;
          cosT[i] = (float)cos(ang); sinT[i] = (float)sin(ang); } }
    for (int m = gw; m < NTOK; m += NGW) rms_row_to_bf16(F.lane, F.in[I_X] + (size_t)m * DM, F.in[I_N1G], (bf16*)(F.ws + WS_XN) + (size_t)m * DM);
    constexpr int I_IN = 16 * (NIN_PAD / 32), I_GLU = 8 * 16, I_PS = 8 * 32, I_PA = 8 * 32, I_OUT = 16 * 32;
    constexpr int NITEMS = I_IN + I_GLU + I_PS + I_PA + I_OUT;
    auto decode = [&](int it) -> TItem {
        int r = it; const float* W; bf16* WT; int K, N, ndb, map = 0;
        if (r < I_IN) { W = F.in[I_WIN]; K = DM; N = 4432; WT = (bf16*)(F.ws + WS_WIN); ndb = NIN_PAD / 32; map = 1; }
        else if ((r -= I_IN) < I_GLU) { W = F.in[I_WGLU]; K = 512; N = 512; WT = (bf16*)(F.ws + WS_WGLU); ndb = 16; }
        else if ((r -= I_GLU) < I_PS) { W = F.in[I_WPS]; K = 512; N = 1024; WT = (bf16*)(F.ws + WS_WPS); ndb = 32; }
        else if ((r -= I_PS) < I_PA) { W = F.in[I_WPA]; K = 512; N = 1024; WT = (bf16*)(F.ws + WS_WPA); ndb = 32; }
        else { r -= I_PA; W = F.in[I_WOUT]; K = 1024; N = 1024; WT = (bf16*)(F.ws + WS_WOUT); ndb = 32; }
        const int kb = r / ndb, nb = r % ndb, k0 = 64 * kb, n0 = 32 * nb; int sc = n0 + (F.lane & 31); if (map) sc = win_src(sc);
        TItem T; T.src = (sc >= 0) ? W + (size_t)k0 * N + sc : nullptr; T.dst = WT + (size_t)n0 * K + k0; T.N = N; T.K = K; return T; };
    { float tvA[32], tvB[32]; int it = gw;
      if (it < NITEMS) { TItem TA = decode(it); titem_load(TA, tvA, F.lane);
        for (;;) {
            const int it1 = it + NGW; const bool h1 = it1 < NITEMS; TItem TB = TA; if (h1) { TB = decode(it1); titem_load(TB, tvB, F.lane); }
            titem_store(TA, tvA, scr, F.lane); if (!h1) break;
            const int it2 = it1 + NGW; const bool h2 = it2 < NITEMS; if (h2) { TA = decode(it2); titem_load(TA, tvA, F.lane); }
            titem_store(TB, tvB, scr, F.lane); if (!h2) break;
            it = it2; } } }
    }
    TPROBE_END(121);
    TPROBE_BEGIN(122);
    moe_convert(F, 0, MOE_N8A, s5wg ? 4 * NW + 2 * ((int)blockIdx.x - NW) : 4 * (int)blockIdx.x, s5wg ? 2 : 4, 4 * NW + 2 * NGRP);
    TPROBE_END(122);
}

struct StaticOrder {
    int nM, nN, nwg, G, c;
    __device__ void init(int nM_, int nN_, int G_, int c_) { nM = nM_; nN = nN_; nwg = nM * nN; G = G_; c = c_; }
    __device__ bool tile(int i, int& pm, int& pn) const {
        const long L = (long)i * G + c; if (L >= nwg) return false;
        int wgid = (int)L; { const int q = nwg / pg8::NXCD, r = nwg % pg8::NXCD, xcd = wgid % pg8::NXCD, off = wgid / pg8::NXCD; wgid = (xcd < r ? xcd * (q + 1) : r * (q + 1) + (xcd - r) * q) + off; }
        const int nig = pg8::WGM * nN, gid = wgid / nig, fm = gid * pg8::WGM, gsz = (nM - fm) < pg8::WGM ? (nM - fm) : pg8::WGM;
        pm = fm + ((wgid % nig) % gsz); pn = (wgid % nig) / gsz; return true;
    }
    __device__ bool next(int i, pg8::Unit& u) const { int pm, pn; if (!tile(i, pm, pn)) return false; u.pm = pm; u.pn = pn; u.pa = pm; u.pb = pn; u.e = 0; return true; }
    __device__ __forceinline__ int arow(const pg8::Unit& u, int h, int R) const { return u.pa * 256 + h * 128 + R; }
    __device__ __forceinline__ void done(const pg8::Unit&) const {}
};
__device__ __forceinline__ void wg_wait_ge(Frame& F, int word, unsigned target) {
    if (F.tid == 0) { unsigned sp = 0;
        while (__hip_atomic_load((unsigned*)(F.ctl + word), RLX_AGENT) < target) { __builtin_amdgcn_s_sleep(2); if (++sp > (1u << 22)) { __hip_atomic_store((unsigned*)(F.ctl + CW_TMO), 1u, RLX_AGENT); break; } }
        __builtin_amdgcn_fence(__ATOMIC_ACQUIRE, "agent"); asm volatile("s_waitcnt vmcnt(0)" ::: "memory"); }
    __syncthreads();
}
__device__ __forceinline__ void wg_signal(Frame& F, int word) {
    asm volatile("s_waitcnt vmcnt(0)" ::: "memory"); __syncthreads();
    if (F.tid == 0) { __builtin_amdgcn_fence(__ATOMIC_RELEASE, "agent"); asm volatile("s_waitcnt vmcnt(0)" ::: "memory"); (void)__hip_atomic_fetch_add((unsigned*)(F.ctl + word), 1u, RLX_AGENT); }
}
struct InProjOrder {
    int G, c; unsigned* udone;
    __device__ bool next(int i, pg8::Unit& u) const { const int L = i * G + c; if (L >= 64 * (NIN_PAD / 256)) return false; u.pm = L & 63; u.pn = L >> 6; u.pa = u.pm; u.pb = u.pn; u.e = 0; return true; }
    __device__ __forceinline__ int arow(const pg8::Unit& u, int h, int R) const { return u.pa * 256 + h * 128 + R; }
    __device__ __forceinline__ void done(const pg8::Unit& u) const {
        if (u.pn < 2) { asm volatile("s_waitcnt vmcnt(0)" ::: "memory");
            if ((threadIdx.x & 63) == 0) (void)__hip_atomic_fetch_add(udone, 1u, RLX_AGENT); } }
};
struct S5StateOrder {
    int c;
    __device__ bool next(int i, pg8::Unit& u) const { if (i > 0 || c >= 64) return false; const int g = c >> 1, pm = c & 1; u.pm = pm; u.pn = 0; u.pa = g * 2 + pm; u.pb = g; u.e = g; return true; }
    __device__ __forceinline__ int arow(const pg8::Unit& u, int h, int R) const { return u.pa * 256 + h * 128 + R; }
    __device__ __forceinline__ void done(const pg8::Unit&) const {}
};
struct S5YOrder {
    int c;
    __device__ bool next(int i, pg8::Unit& u) const { if (i > 0 || c >= 128) return false; const int g = c >> 2, pm = (c >> 1) & 1, pn = c & 1; u.pm = pm; u.pn = pn; u.pa = g * 2 + pm; u.pb = g * 2 + pn; u.e = g; return true; }
    __device__ __forceinline__ int arow(const pg8::Unit& u, int h, int R) const { return u.pa * 256 + h * 128 + R; }
    __device__ __forceinline__ void done(const pg8::Unit&) const {}
};
struct MixOrder {
    StaticOrder so;
    __device__ bool next(int i, pg8::Unit& u) const { int pm, pn; if (!so.tile(i >> 1, pm, pn)) return false; const int h = i & 1; u.pm = pm; u.pn = pn; u.pa = pm + 64 * h; u.pb = pn + 4 * h; u.e = h; return true; }
    __device__ __forceinline__ int arow(const pg8::Unit& u, int h, int R) const { return u.pa * 256 + h * 128 + R; }
    __device__ __forceinline__ void done(const pg8::Unit&) const {}
};
struct MoeOrder {
    const volatile LAS int* te; const volatile LAS int* off; const volatile LAS int* cnt; const int* rowmap; int TT, NTN, c;
    __device__ bool next(int i, pg8::Unit& u) const {
        const int xcd = c & 7, j = c >> 3, mpx = 32 / NTN; const int mt = i * (8 * mpx) + xcd * mpx + j / NTN, pn = j % NTN;
        if (mt >= TT) return false; const int e = te[mt]; u.pm = mt; u.pn = pn; u.pa = mt; u.pb = e * NTN + pn; u.e = e; return true; }
    __device__ __forceinline__ int arow(const pg8::Unit& u, int h, int R) const {
        if (!rowmap) return u.pa * 256 + h * 128 + R;
        const int lr = u.pm * 256 - off[u.e] + h * 128 + R;
        return lr < cnt[u.e] ? rowmap[(size_t)u.e * NTOK + lr] : 0; }
    __device__ __forceinline__ void done(const pg8::Unit&) const {}
};

using pg8::f32x2; using pg8::u32x2; using pg8::pack8; using pg8::cvt_pk_bf16;
#define EPI_ROWS_BEGIN _Pragma("unroll") for (int ai = 0; ai < 2; ++ai) _Pragma("unroll") for (int m = 0; m < 4; ++m) { asm volatile("" ::: "memory"); const int row = u.pm * 256 + ai * 128 + wr * 64 + m * 16 + fr; (void)row;
#define EPI_COLS_BEGIN _Pragma("unroll") for (int bj = 0; bj < 2; ++bj) { const int ct = bj * 128 + wc * 32 + fq * 8; (void)ct; f32x4 v0 = acc[ai][bj][m][0], v1 = acc[ai][bj][m][1];
#define EPI_END } }
struct EpiInProj {
    static constexpr bool PERM = true;
    unsigned char* ws; const float* bgate;
    __device__ __forceinline__ void rope(f32x4& v0, f32x4& v1, int pos, int a, float sc) const {
        const unsigned o = (unsigned)WS_ROPE + (unsigned)(pos * 32 + 4 * a) * 4u;
        const f32x4 c = *(const GAS f32x4*)(ws + o), s = *(const GAS f32x4*)(ws + o + (unsigned)(SEQ * 32 * 4));
        const f32x4 o1 = (v0 * c - v1 * s) * sc, o2 = (v1 * c + v0 * s) * sc; v0 = o1; v1 = o2;
    }
    __device__ __forceinline__ unsigned pk8(const f32x4& v) const { unsigned w = 0; w = __builtin_amdgcn_cvt_pk_fp8_f32(v[0], v[1], w, false); w = __builtin_amdgcn_cvt_pk_fp8_f32(v[2], v[3], w, true); return w; }
    __device__ __forceinline__ void store_rope8(unsigned off, const f32x4& o1, const f32x4& o2) const { *(GAS unsigned*)(ws + off) = pk8(o1); *(GAS unsigned*)(ws + off + 32u) = pk8(o2); }
    __device__ __forceinline__ void store_rope(unsigned off, const f32x4& o1, const f32x4& o2) const {
        u32x2 a, b; a.x = cvt_pk_bf16(o1[0], o1[1]); a.y = cvt_pk_bf16(o1[2], o1[3]); b.x = cvt_pk_bf16(o2[0], o2[1]); b.y = cvt_pk_bf16(o2[2], o2[3]);
        *(GAS u32x2*)(ws + off) = a; *(GAS u32x2*)(ws + off + 64u) = b;
    }
    __device__ __forceinline__ void operator()(const f32x4 (&acc)[2][2][4][2], const pg8::Unit& u, int wr, int wc, int fr, int fq) const {
        asm volatile("" : "+v"(fr), "+v"(fq));
        const int pn = u.pn;
        if (pn < 2) {
            EPI_ROWS_BEGIN const int bb = row >> 12, cc = (row >> 5) & 127, sp = row & 31;
            EPI_COLS_BEGIN const int col = pn * 256 + ct, g = col >> 4, h0 = col & 15;
                { const unsigned uo_ = (unsigned)WS_UGX + (unsigned)((g * 512 + bb * 128 + cc) * UGX_LD + sp * 16 + h0) * 2u; const pg8::u32x4 ud_ = pack8(v0, v1);
                  asm volatile("global_store_dwordx4 %0, %1, %2 sc0 sc1\n\ts_nop 1" :: "v"(uo_), "v"(ud_), "s"(ws) : "memory"); }
            EPI_END
        } else if (pn < 4) {
            EPI_ROWS_BEGIN const int pos = row & 4095;
            EPI_COLS_BEGIN const int j = (pn - 2) * 256 + ct, head = j >> 6, a = (j & 63) >> 3;
                rope(v0, v1, pos, a, 1.0f); store_rope8((unsigned)WS_Q + (unsigned)(row * 512 + head * 64 + 4 * a), v0, v1);
            EPI_END
        } else if (pn == 4) {
            EPI_ROWS_BEGIN const int pos = row & 4095;
            EPI_COLS_BEGIN
                if (bj == 0) { const int head = ct >> 6, a = (ct & 63) >> 3; rope(v0, v1, pos, a, 1.0f); store_rope8((unsigned)WS_K + (unsigned)(row * 128 + head * 64 + 4 * a), v0, v1); }
                else { u32x2 w8; w8.x = pk8(v0); w8.y = pk8(v1); *(GAS u32x2*)(ws + ((unsigned)WS_V + (unsigned)(row * 128 + (ct - 128)))) = w8; }
            EPI_END
        } else if (pn < 9) {
            EPI_ROWS_BEGIN const int pos = row & 4095;
            EPI_COLS_BEGIN const int j = (pn - 5) * 256 + ct, head = j >> 6, a = (j & 63) >> 3;
                rope(v0, v1, pos, a, 1.0f); store_rope((unsigned)WS_QI + (unsigned)(row * 1024 + head * 64 + 4 * a) * 2u, v0, v1);
            EPI_END
        } else if (pn == 9) {
            EPI_ROWS_BEGIN const int pos = row & 4095;
            EPI_COLS_BEGIN
                if (bj == 0) { if (ct < 64) { const int a = ct >> 3; rope(v0, v1, pos, a, 1.0f); store_rope((unsigned)WS_KI + (unsigned)(row * 64 + 4 * a) * 2u, v0, v1); }
                    else if (ct < 80) { const unsigned o = (unsigned)WS_WI + (unsigned)(row * 16 + (ct - 64)) * 4u; *(GAS f32x4*)(ws + o) = v0 * 0.03125f; *(GAS f32x4*)(ws + o + 16u) = v1 * 0.03125f; } }
            EPI_END
        } else {
            const int br = pn >= 14; const unsigned gbase = br ? (unsigned)WS_GA : (unsigned)WS_GS; const float* bgp = bgate + br * 1024;
            EPI_ROWS_BEGIN
            EPI_COLS_BEGIN const int col = (pn - (br ? 14 : 10)) * 256 + ct;
                const f32x4 b0 = *(const GAS f32x4*)(bgp + col), b1 = *(const GAS f32x4*)(bgp + col + 4);
#pragma unroll
                for (int j = 0; j < 4; ++j) { v0[j] = sigmoidf_(v0[j] + b0[j]); v1[j] = sigmoidf_(v1[j] + b1[j]); }
                *(GAS v4u*)(ws + (gbase + (unsigned)(row * 1024 + col) * 2u)) = pack8(v0, v1);
            EPI_END
        }
    }
};
struct EpiS5State {
    static constexpr bool PERM = true;
    float* SB;
    __device__ __forceinline__ void operator()(const f32x4 (&acc)[2][2][4][2], const pg8::Unit& u, int wr, int wc, int fr, int fq) const {
        EPI_ROWS_BEGIN
        EPI_COLS_BEGIN
            if (bj == 0) { float* d = SB + ((size_t)u.e * 512 + row) * 128 + ct; *(GAS f32x4*)d = v0; *(GAS f32x4*)(d + 4) = v1; }
        EPI_END
    }
};
struct EpiS5Y {
    static constexpr bool PERM = true;
    const bf16* UGX; const float* Dsk; bf16* YG;
    __device__ __forceinline__ void operator()(const f32x4 (&acc)[2][2][4][2], const pg8::Unit& u, int wr, int wc, int fr, int fq) const {
        const int g = u.e;
        EPI_ROWS_BEGIN const int bb = row >> 7, cc = row & 127;
        EPI_COLS_BEGIN const int n = u.pn * 256 + ct, tp = n >> 4, h0 = n & 15;
            const v4u uu = *(const GAS v4u*)(UGX + ((size_t)g * 512 + row) * UGX_LD + n);
            const f32x4 d0 = *(const GAS f32x4*)(Dsk + g * 16 + h0), d1 = *(const GAS f32x4*)(Dsk + g * 16 + h0 + 4);
            v0[0] += d0[0] * bflo(uu.x); v0[1] += d0[1] * bfhi(uu.x); v0[2] += d0[2] * bflo(uu.y); v0[3] += d0[3] * bfhi(uu.y);
            v1[0] += d1[0] * bflo(uu.z); v1[1] += d1[1] * bfhi(uu.z); v1[2] += d1[2] * bflo(uu.w); v1[3] += d1[3] * bfhi(uu.w);
#pragma unroll
            for (int j = 0; j < 4; ++j) { v0[j] = gelu_tanh(v0[j]); v1[j] = gelu_tanh(v1[j]); }
            const int tok = bb * 4096 + cc * 32 + tp;
            *(GAS v4u*)(YG + (size_t)tok * 512 + g * 16 + h0) = pack8(v0, v1);
        EPI_END
    }
};
struct EpiGlu {
    static constexpr bool PERM = true;
    const bf16* YG; const float* bglu; bf16* YS;
    __device__ __forceinline__ void operator()(const f32x4 (&acc)[2][2][4][2], const pg8::Unit& u, int wr, int wc, int fr, int fq) const {
        EPI_ROWS_BEGIN
        EPI_COLS_BEGIN const int col = u.pn * 256 + ct;
            const v4u yy = *(const GAS v4u*)(YG + (size_t)row * 512 + col);
            const f32x4 b0 = *(const GAS f32x4*)(bglu + col), b1 = *(const GAS f32x4*)(bglu + col + 4);
            v0[0] = bflo(yy.x) * sigmoidf_(v0[0] + b0[0]); v0[1] = bfhi(yy.x) * sigmoidf_(v0[1] + b0[1]); v0[2] = bflo(yy.y) * sigmoidf_(v0[2] + b0[2]); v0[3] = bfhi(yy.y) * sigmoidf_(v0[3] + b0[3]);
            v1[0] = bflo(yy.z) * sigmoidf_(v1[0] + b1[0]); v1[1] = bfhi(yy.z) * sigmoidf_(v1[1] + b1[1]); v1[2] = bflo(yy.w) * sigmoidf_(v1[2] + b1[2]); v1[3] = bfhi(yy.w) * sigmoidf_(v1[3] + b1[3]);
            *(GAS v4u*)(YS + (size_t)row * 512 + col) = pack8(v0, v1);
        EPI_END
    }
};
struct EpiMix {
    static constexpr bool PERM = true;
    const bf16* GS; const bf16* GA; bf16* MX;
    __device__ __forceinline__ void operator()(const f32x4 (&acc)[2][2][4][2], const pg8::Unit& u, int wr, int wc, int fr, int fq) const {
        const bf16* Gp = u.e ? GA : GS;
        EPI_ROWS_BEGIN
        EPI_COLS_BEGIN const size_t off = (size_t)row * 1024 + u.pn * 256 + ct;
            const v4u gg = *(const GAS v4u*)(Gp + off);
            v0[0] *= bflo(gg.x); v0[1] *= bfhi(gg.x); v0[2] *= bflo(gg.y); v0[3] *= bfhi(gg.y); v1[0] *= bflo(gg.z); v1[1] *= bfhi(gg.z); v1[2] *= bflo(gg.w); v1[3] *= bfhi(gg.w);
            if (u.e) { const v4u pp = *(const GAS v4u*)(MX + off);
                v0[0] += bflo(pp.x); v0[1] += bfhi(pp.x); v0[2] += bflo(pp.y); v0[3] += bfhi(pp.y); v1[0] += bflo(pp.z); v1[1] += bfhi(pp.z); v1[2] += bflo(pp.w); v1[3] += bfhi(pp.w); }
            *(GAS v4u*)(MX + off) = pack8(v0, v1);
        EPI_END
    }
};
struct EpiOut {
    static constexpr bool PERM = true;
    const float* X; float* X1;
    __device__ __forceinline__ void operator()(const f32x4 (&acc)[2][2][4][2], const pg8::Unit& u, int wr, int wc, int fr, int fq) const {
        EPI_ROWS_BEGIN
        EPI_COLS_BEGIN const size_t off = (size_t)row * 1024 + u.pn * 256 + ct;
            const f32x4 x0 = *(const GAS f32x4*)(X + off), x1 = *(const GAS f32x4*)(X + off + 4);
            *(GAS f32x4*)(X1 + off) = v0 + x0; *(GAS f32x4*)(X1 + off + 4) = v1 + x1;
        EPI_END
    }
};
struct EpiMoe1 {
    static constexpr bool PERM = true;
    const float* bmi; bf16* ACT;
    __device__ __forceinline__ void operator()(const f32x4 (&acc)[2][2][4][2], const pg8::Unit& u, int wr, int wc, int fr, int fq) const {
        const float* bp = bmi + (size_t)u.e * 2048;
        EPI_ROWS_BEGIN
        EPI_COLS_BEGIN const int col = u.pn * 256 + ct;
            const f32x4 b0 = *(const GAS f32x4*)(bp + col), b1 = *(const GAS f32x4*)(bp + col + 4);
            v0 += b0; v1 += b1; float o[4];
#pragma unroll
            for (int j = 0; j < 4; ++j) { const float zg0 = (j < 2) ? v0[2 * j] : v1[2 * j - 4], zl0 = (j < 2) ? v0[2 * j + 1] : v1[2 * j - 3];
                const float zg = fminf(zg0, 7.0f), zl = fminf(fmaxf(zl0, -7.0f), 7.0f); o[j] = zg * sigmoidf_(1.702f * zg) * (zl + 1.0f); }
            u32x2 w; w.x = cvt_pk_bf16(o[0], o[1]); w.y = cvt_pk_bf16(o[2], o[3]);
            *(GAS u32x2*)(ACT + (size_t)row * 1024 + (col >> 1)) = w;
        EPI_END
    }
};
struct EpiMoe2 {
    static constexpr bool PERM = true;
    const float* bmo; bf16* Y2;
    __device__ __forceinline__ void operator()(const f32x4 (&acc)[2][2][4][2], const pg8::Unit& u, int wr, int wc, int fr, int fq) const {
        const float* bp = bmo + (size_t)u.e * 1024;
        EPI_ROWS_BEGIN
        EPI_COLS_BEGIN const int col = u.pn * 256 + ct;
            const f32x4 b0 = *(const GAS f32x4*)(bp + col), b1 = *(const GAS f32x4*)(bp + col + 4);
            v0 += b0; v1 += b1;
            *(GAS v4u*)(Y2 + (size_t)row * 1024 + col) = pack8(v0, v1);
        EPI_END
    }
};

__device__ __forceinline__ unsigned f16key(unsigned bits) { return (bits & 0x8000u) ? (bits ^ 0xffffu) : (bits | 0x8000u); }
__device__ __forceinline__ void idx_phase(Frame& F) {
    LAS unsigned char* lds = F.lds;
    LAS u16* SC = (LAS u16*)lds;
    LAS unsigned char* KT = lds + 65536;
    LAS unsigned* HP = (LAS unsigned*)(lds + 147456);
    LAS unsigned char* OLB = lds + 147456 + 4096;
    const bf16* QI = (const bf16*)(F.ws + WS_QI); const bf16* KI = (const bf16*)(F.ws + WS_KI); const float* WI = (const float*)(F.ws + WS_WI);
    u16* SEL = (u16*)(F.ws + WS_SEL);
    const int tid = F.tid, lane = F.lane, wave = F.wave, qg = wave & 1, kq = wave >> 1, kgrp = lane >> 4, l15 = lane & 15;
    const int kx = l15 >> 1, cpos = lane & 7;
    const int dsw = ((wave & 1) * 4 + (lane >> 4)) & 7;
    bf16x8 qa[4][2]; float w[16];
#define IDX_UNIT(r_, b_, t0_) const int b_ = (r_) >> 1, t0_ = (((r_) & 1) ? 511 - (int)blockIdx.x : (int)blockIdx.x) * 8
#define IDX_DMA(kb_, st, bufi) do { _Pragma("unroll") for (int j_ = 0; j_ < 2; ++j_) { const int row_ = (j_ * 8 + wave) * 8 + (lane >> 3); \
        __builtin_amdgcn_global_load_lds((const unsigned*)((kb_) + ((size_t)(st) * 128 + row_) * 64 + ((cpos ^ dsw) << 3)), (LAS unsigned*)(KT + (bufi) * 16384 + (j_ * 8 + wave) * 1024), 16, 0, 0); } } while (0)
#define IDX_PREFETCH(r_) do { IDX_UNIT(r_, pb_, pt0_); if (pt0_ >= 256) { \
        const bf16* qp_ = QI + ((size_t)pb_ * SEQ + pt0_ + 4 * qg + (l15 >> 2)) * 1024 + (l15 & 3) * 64 + kgrp * 8; \
        _Pragma("unroll") for (int i = 0; i < 4; ++i) _Pragma("unroll") for (int ks = 0; ks < 2; ++ks) qa[i][ks] = *(const GAS bf16x8*)(qp_ + i * 256 + ks * 32); \
        const float* wp_ = WI + ((size_t)pb_ * SEQ + pt0_ + 4 * qg + kgrp) * 16; \
        _Pragma("unroll") for (int i = 0; i < 4; ++i) { const f32x4 x = *(const GAS f32x4*)(wp_ + 4 * i); w[4 * i] = x[0]; w[4 * i + 1] = x[1]; w[4 * i + 2] = x[2]; w[4 * i + 3] = x[3]; } \
        const bf16* pk_ = KI + (size_t)pb_ * SEQ * 64; const int pn_ = (pt0_ + 7) / 128 + 1; \
        IDX_DMA(pk_, 0, 0); if (1 < pn_) IDX_DMA(pk_, 1, 1); if (2 < pn_) IDX_DMA(pk_, 2, 2); if (3 < pn_) IDX_DMA(pk_, 3, 3); } } while (0)
    IDX_PREFETCH(0);
    for (int r = 0; r < 8; ++r) {
        IDX_UNIT(r, b, t0);
        __syncthreads();
        const int t = t0 + wave; const size_t tok = (size_t)b * SEQ + t;
        if (t0 < 256) {
            v2u x; const int k0 = lane * 4;
            x.x = (unsigned)(k0 <= t ? k0 : 0) | ((unsigned)(k0 + 1 <= t ? k0 + 1 : 0) << 16); x.y = (unsigned)(k0 + 2 <= t ? k0 + 2 : 0) | ((unsigned)(k0 + 3 <= t ? k0 + 3 : 0) << 16);
            *(GAS v2u*)(SEL + tok * NSEL + k0) = x;
            if (r + 1 < 8) IDX_PREFETCH(r + 1);
            continue;
        }
        HP[tid * 2] = 0u; HP[tid * 2 + 1] = 0u;
        const int nst = (t0 + 7) / 128 + 1;
        const int tq = t0 + 4 * qg + kgrp, qrow = 4 * qg + kgrp;
        const bf16* kbat = KI + (size_t)b * SEQ * 64;
        const unsigned hpq = (unsigned)(unsigned long)(HP + qrow * 128);
#define IDX_EPI1(kgl_, AC) do { float s0 = 0.f; \
            _Pragma("unroll") for (int i = 0; i < 4; ++i) _Pragma("unroll") for (int r_ = 0; r_ < 4; ++r_) { const float a0_ = AC[i][r_]; const int i0 = __builtin_bit_cast(int, a0_); const float m0 = __builtin_bit_cast(float, i0 > 0 ? i0 : 0); s0 += w[4 * i + r_] * m0; } \
            const _Float16 h0_ = (_Float16)s0; const unsigned key0_ = f16key(__builtin_bit_cast(unsigned short, h0_)); const int kg0 = (kgl_); \
            SC[qrow * 4096 + kg0] = (u16)key0_; \
            if (kg0 <= tq) { const unsigned bin = key0_ >> 8; const unsigned ha_ = hpq + ((bin >> 1) << 2), hv_ = (bin & 1u) ? 0x10000u : 1u; \
                asm volatile("ds_add_u32 %0, %1" :: "v"(ha_), "v"(hv_) : "memory"); } } while (0)
#define IDX_READ(BQ, kt2) do { _Pragma("unroll") for (int ks = 0; ks < 2; ++ks) BQ[ks] = *(const LAS bf16x8*)(kb + (kq * 32 + (kt2) * 16 + l15) * 128 + (((ks * 4 + kgrp) ^ kx) << 4)); } while (0)
#define IDX_MMA(AC, BQ) do { _Pragma("unroll") for (int i = 0; i < 4; ++i) { AC[i] = (f32x4){0.f, 0.f, 0.f, 0.f}; _Pragma("unroll") for (int ks = 0; ks < 2; ++ks) AC[i] = __builtin_amdgcn_mfma_f32_16x16x32_bf16(qa[i][ks], BQ[ks], AC[i], 0, 0, 0); } } while (0)
        bf16x8 bq0[2], bq1[2];
        f32x4 aA[4], aB[4];
#pragma unroll
        for (int i = 0; i < 4; ++i) { aA[i] = (f32x4){0.f, 0.f, 0.f, 0.f}; aB[i] = aA[i]; }
        int bcur = 0, bnew = 4;
        TPROBE_BEGIN(100);
        for (int st = 0; st < nst; ++st) {
            if (st + 3 < nst) asm volatile("s_waitcnt vmcnt(6)" ::: "memory"); else asm volatile("s_waitcnt vmcnt(0)" ::: "memory");
            __syncthreads();
            if (st + 4 < nst) IDX_DMA(kbat, st + 4, bnew);
            const LAS unsigned char* kb = KT + bcur * 16384;
            const int kbase_ = st * 128 + kq * 32 + l15;
            IDX_READ(bq0, 0);
            IDX_READ(bq1, 1); IDX_MMA(aA, bq0); if (st >= 1) IDX_EPI1(kbase_ - 128 + 16, aB);
            IDX_MMA(aB, bq1); IDX_EPI1(kbase_, aA);
            bcur = (bcur == 4) ? 0 : bcur + 1; bnew = (bnew == 4) ? 0 : bnew + 1;
        }
        IDX_EPI1((nst - 1) * 128 + kq * 32 + l15 + 16, aB);
#undef IDX_EPI1
#undef IDX_MMA
#undef IDX_READ
        __syncthreads();
        TPROBE_END(100);
        TPROBE_BEGIN(101);
        TPROBE_BEGIN(110);
        if (r + 1 < 8) IDX_PREFETCH(r + 1);
        const int n = t + 1, jj = lane, ql = wave;
        const LAS u16* sc = SC + ql * 4096;
        LAS unsigned* hp = HP + ql * 128;
        unsigned b1, need1;
        { const v2u wv = *(const LAS v2u*)(hp + 126 - 2 * jj); unsigned hb[4];
          hb[3] = wv.x & 0xffffu; hb[2] = wv.x >> 16; hb[1] = wv.y & 0xffffu; hb[0] = wv.y >> 16;
          const unsigned s4 = hb[0] + hb[1] + hb[2] + hb[3];
          unsigned pre = s4;
#pragma unroll
          for (int o = 1; o < 64; o <<= 1) { const unsigned x = __shfl_up(pre, o, 64); if (jj >= o) pre += x; }
          const unsigned long long bal = __ballot(pre >= 256u); const int js = __builtin_ctzll(bal);
          unsigned above = pre - s4, bb1 = 0, nd1 = 0; bool found = false;
#pragma unroll
          for (int i = 0; i < 4; ++i) { if (!found) { if (above + hb[i] >= 256u) { bb1 = 255 - (jj * 4 + i); nd1 = 256u - above; found = true; } else above += hb[i]; } }
          b1 = __shfl(bb1, js); need1 = __shfl(nd1, js); }
        TPROBE_END(110);
        TPROBE_BEGIN(111);
        LDS_WAIT(); __builtin_amdgcn_wave_barrier();
#define LDS_ST32(addr_, val_) asm volatile("ds_write_b32 %0, %1" :: "v"((unsigned)(addr_)), "v"((unsigned)(val_)) : "memory")
#define LDS_ST16(addr_, val_) asm volatile("ds_write_b16 %0, %1" :: "v"((unsigned)(addr_)), "v"((unsigned)(val_)) : "memory")
#define LDS_ADD32(addr_, val_) asm volatile("ds_add_u32 %0, %1" :: "v"((unsigned)(addr_)), "v"((unsigned)(val_)) : "memory")
        const unsigned hpw = (unsigned)(unsigned long)hp, scw = (unsigned)(unsigned long)sc;
        LDS_ST32(hpw + jj * 8, 0u); LDS_ST32(hpw + jj * 8 + 4, 0u);
        const int nit = (n + 511) >> 9;
        { const int base = (nit - 1) * 512 + jj * 8;
#pragma unroll
          for (int e = 0; e < 8; ++e) if (base + e >= n) LDS_ST16(scw + (base + e) * 2, 0u); }
        LDS_WAIT(); __builtin_amdgcn_wave_barrier();
        const unsigned B1 = b1 | (b1 << 16);
#pragma unroll 4
        for (int it = 0; it < nit; ++it) { const int base = it * 512 + jj * 8; const v4u x = *(const LAS v4u*)(sc + base);
#pragma unroll
            for (int i = 0; i < 4; ++i) { const unsigned d = (i == 0) ? x.x : (i == 1) ? x.y : (i == 2) ? x.z : x.w; const unsigned m = ((d >> 8) & 0x00ff00ffu) ^ B1;
                const unsigned l0 = d & 255u, l1 = (d >> 16) & 255u;
                LDS_ADD32(hpw + ((l0 >> 1) << 2), ((m & 0xffffu) == 0u) ? ((l0 & 1u) ? 0x10000u : 1u) : 0u);
                LDS_ADD32(hpw + ((l1 >> 1) << 2), ((m >> 16) == 0u) ? ((l1 & 1u) ? 0x10000u : 1u) : 0u); } }
        LDS_WAIT(); __builtin_amdgcn_wave_barrier();
        TPROBE_END(111);
        TPROBE_BEGIN(112);
        unsigned T, need2;
        { const v2u wv = *(const LAS v2u*)(hp + 126 - 2 * jj); unsigned hb[4];
          hb[3] = wv.x & 0xffffu; hb[2] = wv.x >> 16; hb[1] = wv.y & 0xffffu; hb[0] = wv.y >> 16;
          const unsigned s4 = hb[0] + hb[1] + hb[2] + hb[3];
          unsigned pre = s4;
#pragma unroll
          for (int o = 1; o < 64; o <<= 1) { const unsigned x = __shfl_up(pre, o, 64); if (jj >= o) pre += x; }
          const unsigned long long bal = __ballot(pre >= need1); const int js = __builtin_ctzll(bal);
          unsigned above = pre - s4, bb2 = 0, nd2 = 0; bool found = false;
#pragma unroll
          for (int i = 0; i < 4; ++i) { if (!found) { if (above + hb[i] >= need1) { bb2 = 255 - (jj * 4 + i); nd2 = need1 - above; found = true; } else above += hb[i]; } }
          const unsigned b2 = __shfl(bb2, js); need2 = __shfl(nd2, js); T = (b1 << 8) | b2; }
        TPROBE_END(112);
        TPROBE_BEGIN(113);
        const unsigned olw = (unsigned)(unsigned long)(OLB + ql * 512);
        const unsigned G = 256u - need2, Tp = T | (T << 16); unsigned cg = 0, tc = 0;
#pragma unroll 2
        for (int it = 0; it < nit; ++it) { const int base = it * 512 + jj * 8; const v4u x = *(const LAS v4u*)(sc + base);
            unsigned g[8], c = 0, anyeq = 0;
#pragma unroll
            for (int i = 0; i < 4; ++i) { const unsigned d = (i == 0) ? x.x : (i == 1) ? x.y : (i == 2) ? x.z : x.w;
                g[2 * i] = ((d & 0xffffu) > T) ? 1u : 0u; g[2 * i + 1] = ((d >> 16) > T) ? 1u : 0u; c += g[2 * i] + g[2 * i + 1];
                const unsigned q = d ^ Tp; anyeq |= (((q & 0xffffu) == 0u) || ((q >> 16) == 0u)) ? 1u : 0u; }
            const unsigned long long m0 = __ballot(c & 1u), m1 = __ballot(c & 2u), m2 = __ballot(c & 4u), m3 = __ballot(c & 8u);
            unsigned pos = cg + __builtin_amdgcn_mbcnt_hi((unsigned)(m0 >> 32), __builtin_amdgcn_mbcnt_lo((unsigned)m0, 0u)) + 2u * __builtin_amdgcn_mbcnt_hi((unsigned)(m1 >> 32), __builtin_amdgcn_mbcnt_lo((unsigned)m1, 0u))
                         + 4u * __builtin_amdgcn_mbcnt_hi((unsigned)(m2 >> 32), __builtin_amdgcn_mbcnt_lo((unsigned)m2, 0u)) + 8u * __builtin_amdgcn_mbcnt_hi((unsigned)(m3 >> 32), __builtin_amdgcn_mbcnt_lo((unsigned)m3, 0u));
            cg += (unsigned)__builtin_popcountll(m0) + 2u * (unsigned)__builtin_popcountll(m1) + 4u * (unsigned)__builtin_popcountll(m2) + 8u * (unsigned)__builtin_popcountll(m3);
#pragma unroll
            for (int e = 0; e < 8; ++e) { const unsigned a_ = olw + ((pos < 256u ? pos : 255u) << 1); if (g[e]) LDS_ST16(a_, base + e); pos += g[e]; }
            if (__ballot(anyeq) != 0ull) {
#pragma unroll
                for (int e = 0; e < 8; ++e) { const unsigned wd = (e < 2) ? x.x : (e < 4) ? x.y : (e < 6) ? x.z : x.w; const unsigned k = (e & 1) ? (wd >> 16) : (wd & 0xffffu);
                    const bool eq = k == T; const unsigned long long me = __ballot(eq);
                    const unsigned pe = tc + __builtin_amdgcn_mbcnt_hi((unsigned)(me >> 32), __builtin_amdgcn_mbcnt_lo((unsigned)me, 0u));
                    if (eq && pe < need2) LDS_ST16(olw + ((G + pe) << 1), base + e);
                    tc += (unsigned)__builtin_popcountll(me); } } }
#undef LDS_ST32
#undef LDS_ST16
#undef LDS_ADD32
        LDS_WAIT(); __builtin_amdgcn_wave_barrier();
        { const v2u x = *(const LAS v2u*)((LAS u16*)(OLB + ql * 512) + jj * 4); *(GAS v2u*)(SEL + tok * NSEL + jj * 4) = x; }
        TPROBE_END(113);
        TPROBE_END(101);
    }
#undef IDX_DMA
#undef IDX_PREFETCH
#undef IDX_UNIT
}

__device__ __forceinline__ void carry_phase(Frame& F) {
    const int gid = blockIdx.x * NTHR + F.tid; if (gid >= NGRP * NB * 64) return;
    const int p = gid & 63, b = (gid >> 6) & 3, g = gid >> 8;
    const float* A32 = (const float*)(F.ws + WS_A32) + g * 128; const float ar = A32[p * 2], ai = A32[p * 2 + 1];
    const float* SB = (const float*)(F.ws + WS_SBUF) + ((size_t)g * 512 + b * 128) * 128; bf16* UX = (bf16*)(F.ws + WS_UGX) + ((size_t)g * 512 + b * 128) * UGX_LD;
    float xr = 0.f, xi = 0.f;
    for (int c = 0; c < NCH; ++c) {
        UX[(size_t)c * UGX_LD + 512 + p] = (bf16)f2bf(xr); UX[(size_t)c * UGX_LD + 576 + p] = (bf16)f2bf(xi);
        const float sr = SB[c * 128 + p], si = SB[c * 128 + 64 + p];
        const float nr = ar * xr - ai * xi + sr, ni = ar * xi + ai * xr + si; xr = nr; xi = ni;
    }
}

template <int N> __device__ __forceinline__ void wait_vm() { asm volatile("s_waitcnt vmcnt(%0)" :: "n"(N) : "memory"); }
__device__ __forceinline__ unsigned pk_fp8x4(float a, float b, float c, float d) { unsigned w = 0; w = __builtin_amdgcn_cvt_pk_fp8_f32(a, b, w, false); w = __builtin_amdgcn_cvt_pk_fp8_f32(c, d, w, true); return w; }
__device__ __forceinline__ void attn_phase(Frame& F) {
    constexpr int WSTR = 20224;
    LAS unsigned char* RING = F.lds + F.wave * WSTR;
    LAS u16* SL = (LAS u16*)(RING + 16384);
    const unsigned char* Q8 = F.ws + WS_Q; const unsigned char* K8 = F.ws + WS_K; const unsigned char* V8 = F.ws + WS_V;
    const u16* SEL = (const u16*)(F.ws + WS_SEL); bf16* YA = (bf16*)(F.ws + WS_YATT);
    const int lane = F.lane, gw = blockIdx.x * NWAVES + F.wave;
    const int hd = lane & 15, kg = lane >> 4;
    const int l4 = lane >> 2, cpos = lane & 3;
    int kra[2];
#pragma unroll
    for (int ks = 0; ks < 2; ++ks) kra[ks] = hd * 64 + (((ks * 2 + (kg >> 1)) ^ ((hd >> 2) & 3)) << 4) + (kg & 1) * 8;
    unsigned tra[4];
    { const int r = hd >> 1, c = hd & 1, row = (r >> 2) * 16 + kg * 4 + (r & 3), f = (kg & 1) | ((r >> 2) << 1); const unsigned rb = (unsigned)(unsigned long)RING;
#pragma unroll
      for (int mt = 0; mt < 4; ++mt) tra[mt] = rb + row * 64 + ((mt ^ f) << 4) + c * 8; }
    const bool early = (int)blockIdx.x < 128; const int ew = blockIdx.x * NWAVES + F.wave, nitems = early ? 23 : 9;
    for (int k_ = 0; k_ < nitems; ++k_) { const int it = (k_ < 9) ? gw + 2048 * k_ : 18432 + ew + 1024 * (k_ - 9);
        const int tok = it >> 1, kvh = it & 1, t = tok & 4095; const size_t bbase = (size_t)(tok >> 12) * SEQ;
        const int nsel = (t + 1 < NSEL) ? t + 1 : NSEL;
        { const v2u x = *(const GAS v2u*)(SEL + (size_t)tok * NSEL + lane * 4); *(LAS v2u*)(SL + lane * 4) = x; }
        long qf[2];
#pragma unroll
        for (int ks = 0; ks < 2; ++ks) { if (hd < 4) qf[ks] = *(const GAS long*)(Q8 + (size_t)tok * 512 + (kvh * 4 + hd) * 64 + ks * 32 + kg * 8); else qf[ks] = 0; }
        asm volatile("s_waitcnt vmcnt(0)" : "+v"(qf[0]), "+v"(qf[1]) :: "memory");
        LDS_WAIT(); __builtin_amdgcn_wave_barrier();
        const unsigned char* kbp = K8 + bbase * 128 + kvh * 64; const unsigned char* vbp = V8 + bbase * 128 + kvh * 64;
        f32x4 sc[4][4]; f32x4 oacc[4];
#pragma unroll
        for (int c = 0; c < 4; ++c)
#pragma unroll
            for (int tl = 0; tl < 4; ++tl) sc[c][tl] = (f32x4){0.f, 0.f, 0.f, 0.f};
#pragma unroll
        for (int m = 0; m < 4; ++m) oacc[m] = (f32x4){0.f, 0.f, 0.f, 0.f};
        float inv = 1.0f;
#define ATT_ISSUE(s) do { const int c_ = (s) & 3; const bool isk_ = (s) < 4; const unsigned char* gb_ = isk_ ? kbp : vbp; int sel_[4]; \
            _Pragma("unroll") for (int j_ = 0; j_ < 4; ++j_) { const int ki_ = c_ * 64 + j_ * 16 + l4; sel_[j_] = (int)SL[ki_ < nsel ? ki_ : 0]; } \
            _Pragma("unroll") for (int j_ = 0; j_ < 4; ++j_) { const int f_ = isk_ ? ((l4 >> 2) & 3) : (((l4 >> 2) & 1) | ((j_ & 1) << 1)); \
                __builtin_amdgcn_global_load_lds((const unsigned*)(gb_ + (size_t)sel_[j_] * 128 + ((cpos ^ f_) << 4)), (LAS unsigned*)(RING + ((s) & 3) * 4096 + j_ * 1024), 16, 0, 0); } } while (0)
        ATT_ISSUE(0); ATT_ISSUE(1); ATT_ISSUE(2);
#pragma unroll
        for (int s = 0; s < 8; ++s) {
            if (s + 3 < 8) ATT_ISSUE(s + 3);
            if (s <= 4) wait_vm<12>(); else if (s == 5) wait_vm<8>(); else if (s == 6) wait_vm<4>(); else wait_vm<0>();
            const LAS unsigned char* buf = RING + (s & 3) * 4096;
            if (s < 4) {
#pragma unroll
                for (int tl = 0; tl < 4; ++tl)
#pragma unroll
                    for (int ks = 0; ks < 2; ++ks) { const long af = *(const LAS long*)(buf + tl * 1024 + kra[ks]);
                        sc[s][tl] = __builtin_amdgcn_mfma_f32_16x16x32_fp8_fp8(af, qf[ks], sc[s][tl], 0, 0, 0); }
                if (s == 3) {
                    float mx = -3.0e38f;
#pragma unroll
                    for (int c = 0; c < 4; ++c)
#pragma unroll
                        for (int tl = 0; tl < 4; ++tl)
#pragma unroll
                            for (int r = 0; r < 4; ++r) { const int key = c * 64 + tl * 16 + kg * 4 + r; const float v = (key < nsel) ? sc[c][tl][r] * 0.125f : -3.0e38f; sc[c][tl][r] = v; mx = fmaxf(mx, v); }
                    mx = fmaxf(mx, __shfl_xor(mx, 16)); mx = fmaxf(mx, __shfl_xor(mx, 32));
                    float sum = 0.f;
#pragma unroll
                    for (int c = 0; c < 4; ++c)
#pragma unroll
                        for (int tl = 0; tl < 4; ++tl)
#pragma unroll
                            for (int r = 0; r < 4; ++r) { const float e = __expf(sc[c][tl][r] - mx); sc[c][tl][r] = e; sum += e; }
                    sum += __shfl_xor(sum, 16); sum += __shfl_xor(sum, 32);
                    inv = 1.0f / sum;
                }
            } else {
                const int c = s - 4;
                v2u pw[2];
#pragma unroll
                for (int h2 = 0; h2 < 2; ++h2) { pw[h2].x = pk_fp8x4(sc[c][2 * h2][0], sc[c][2 * h2][1], sc[c][2 * h2][2], sc[c][2 * h2][3]); pw[h2].y = pk_fp8x4(sc[c][2 * h2 + 1][0], sc[c][2 * h2 + 1][1], sc[c][2 * h2 + 1][2], sc[c][2 * h2 + 1][3]); }
                v2u a[8];
                asm volatile("ds_read_b64_tr_b8 %0, %8 offset:%12\n\tds_read_b64_tr_b8 %1, %9 offset:%12\n\tds_read_b64_tr_b8 %2, %10 offset:%12\n\tds_read_b64_tr_b8 %3, %11 offset:%12\n\t"
                             "ds_read_b64_tr_b8 %4, %8 offset:%13\n\tds_read_b64_tr_b8 %5, %9 offset:%13\n\tds_read_b64_tr_b8 %6, %10 offset:%13\n\tds_read_b64_tr_b8 %7, %11 offset:%13\n\ts_waitcnt lgkmcnt(0)"
                             : "=&v"(a[0]), "=&v"(a[1]), "=&v"(a[2]), "=&v"(a[3]), "=&v"(a[4]), "=&v"(a[5]), "=&v"(a[6]), "=&v"(a[7])
                             : "v"(tra[0]), "v"(tra[1]), "v"(tra[2]), "v"(tra[3]), "n"((s & 3) * 4096), "n"((s & 3) * 4096 + 2048) : "memory");
#pragma unroll
                for (int h2 = 0; h2 < 2; ++h2)
#pragma unroll
                    for (int mt = 0; mt < 4; ++mt)
                        oacc[mt] = __builtin_amdgcn_mfma_f32_16x16x32_fp8_fp8(__builtin_bit_cast(long, a[4 * h2 + mt]), __builtin_bit_cast(long, pw[h2]), oacc[mt], 0, 0, 0);
            }
        }
#undef ATT_ISSUE
        if (hd < 4) {
            bf16* yo = YA + (size_t)tok * 512 + (kvh * 4 + hd) * 64 + kg * 4;
#pragma unroll
            for (int mt = 0; mt < 4; ++mt) { pg8::u32x2 w; w.x = pg8::cvt_pk_bf16(oacc[mt][0] * inv, oacc[mt][1] * inv); w.y = pg8::cvt_pk_bf16(oacc[mt][2] * inv, oacc[mt][3] * inv); *(GAS pg8::u32x2*)(yo + 16 * mt) = w; }
        }
        LDS_WAIT(); __builtin_amdgcn_wave_barrier();
    }
}

__device__ __forceinline__ void router_phase(Frame& F) {
    LAS float* HR = (LAS float*)(F.lds);
    LAS float* PT = (LAS float*)(F.lds + 65536);
    LAS int* LE = (LAS int*)(F.lds + 81920);
    LAS int* LP = (LAS int*)(F.lds + 82944);
    LAS unsigned* LC = (LAS unsigned*)(F.lds + 83968);
    const float* X1 = (const float*)(F.ws + WS_X1); bf16* H2 = (bf16*)(F.ws + WS_H2);
    const float* WR = F.in[I_WR]; const float* BR = F.in[I_BR]; const float* G2 = F.in[I_N2G];
    int* TOPE = (int*)(F.ws + WS_TOPE); float* TOPW = (float*)(F.ws + WS_TOPW); int* TOPPOS = (int*)(F.ws + WS_TOPPOS); int* ROWMAP = (int*)(F.ws + WS_ROWMAP);
    const int tid = F.tid, lane = F.lane, wave = F.wave, e = lane & 31, dh = lane >> 5;
    float wr[64];
#pragma unroll
    for (int i = 0; i < 64; ++i) wr[i] = WR[(size_t)(128 * wave + dh * 64 + i) * 32 + e];
    if (tid < 64) LC[tid] = 0u;
    const int tok0 = blockIdx.x * 64;
    f32x4 nv[2][4];
#pragma unroll
    for (int rr = 0; rr < 2; ++rr)
#pragma unroll
        for (int j = 0; j < 4; ++j) nv[rr][j] = ((const GAS f32x4*)(X1 + (size_t)(tok0 + 2 * wave + rr) * DM) + lane)[64 * j];
    for (int bt = 0; bt < 4; ++bt) {
        __syncthreads();
#pragma unroll
        for (int rr = 0; rr < 2; ++rr) { const int lr = 2 * wave + rr, tok = tok0 + bt * 16 + lr;
            const GAS f32x4* gr = (const GAS f32x4*)G2 + lane;
            f32x4 v[4]; float s2 = 0.f;
#pragma unroll
            for (int j = 0; j < 4; ++j) { v[j] = nv[rr][j]; s2 += (v[j].x * v[j].x + v[j].y * v[j].y) + (v[j].z * v[j].z + v[j].w * v[j].w); }
            const float rstd = 1.0f / sqrtf(wave_sum(s2) * (1.f / DM) + RMS_EPS);
            GAS unsigned long long* o8 = (GAS unsigned long long*)(H2 + (size_t)tok * DM) + lane;
#pragma unroll
            for (int j = 0; j < 4; ++j) { const f32x4 gg = gr[64 * j]; const f32x4 h = v[j] * rstd * gg;
                *(LAS f32x4*)(HR + lr * 1024 + 256 * j + 4 * lane) = h;
                o8[64 * j] = (unsigned long long)pk2(h.x, h.y) | ((unsigned long long)pk2(h.z, h.w) << 32); } }
        if (bt + 1 < 4) {
#pragma unroll
            for (int rr = 0; rr < 2; ++rr)
#pragma unroll
                for (int j = 0; j < 4; ++j) nv[rr][j] = ((const GAS f32x4*)(X1 + (size_t)(tok0 + (bt + 1) * 16 + 2 * wave + rr) * DM) + lane)[64 * j];
        }
        __syncthreads();
#pragma unroll 2
        for (int lr = 0; lr < 16; ++lr) { const LAS float* hp = HR + lr * 1024 + 128 * wave + dh * 64; float s = 0.f;
#pragma unroll
            for (int i = 0; i < 16; ++i) { const f32x4 h = *(const LAS f32x4*)(hp + 4 * i); s += h[0] * wr[4 * i] + h[1] * wr[4 * i + 1] + h[2] * wr[4 * i + 2] + h[3] * wr[4 * i + 3]; }
            s += __shfl_xor(s, 32);
            if (dh == 0) PT[(lr * 8 + wave) * 32 + e] = s; }
        __syncthreads();
        { const int lr = 2 * wave + dh, tl = bt * 16 + lr, tok = tok0 + tl; float lg = BR[e];
#pragma unroll
          for (int w8 = 0; w8 < 8; ++w8) lg += PT[(lr * 8 + w8) * 32 + e];
          float cur = lg; float tv[4]; int te[4];
#pragma unroll
          for (int k = 0; k < 4; ++k) { float mv = cur; int mi = e;
#pragma unroll
              for (int o = 1; o < 32; o <<= 1) { const float ov = __shfl_xor(mv, o); const int oi = __shfl_xor(mi, o); if (ov > mv || (ov == mv && oi < mi)) { mv = ov; mi = oi; } }
              tv[k] = mv; te[k] = mi; if (e == mi) cur = -3.0e38f; }
          const float e1 = __expf(tv[1] - tv[0]), e2 = __expf(tv[2] - tv[0]), e3 = __expf(tv[3] - tv[0]); const float inv = 1.0f / (1.0f + e1 + e2 + e3);
          if (e < 4) { const int ex = (e == 0) ? te[0] : (e == 1) ? te[1] : (e == 2) ? te[2] : te[3]; const float wv = ((e == 0) ? 1.0f : (e == 1) ? e1 : (e == 2) ? e2 : e3) * inv;
              TOPE[(size_t)tok * 4 + e] = ex; TOPW[(size_t)tok * 4 + e] = wv; LE[tl * 4 + e] = ex; LP[tl * 4 + e] = (int)atomicAdd((unsigned*)&LC[ex], 1u); } }
    }
    __syncthreads();
    if (tid < 32) LC[32 + tid] = __hip_atomic_fetch_add((unsigned*)(F.ctl + CW_ECNT) + tid, LC[tid], RLX_AGENT);
    __syncthreads();
    if (tid < 256) { const int ex = LE[tid], pos = (int)LC[32 + ex] + LP[tid], tok = tok0 + (tid >> 2); TOPPOS[(size_t)tok * 4 + (tid & 3)] = pos; ROWMAP[(size_t)ex * NTOK + pos] = tok; }
}

__device__ __forceinline__ int moe_tables(Frame& F, LAS int* OFF, LAS int* TE) {
    __syncthreads();
    if (F.tid == 0) { int acc = 0; for (int e = 0; e < NEXP; ++e) { const int c = (int)__hip_atomic_load((unsigned*)(F.ctl + CW_ECNT) + e, RLX_AGENT); const int nt = (c + 255) >> 8; OFF[e] = acc * 256; OFF[33 + e] = c; for (int i = 0; i < nt; ++i) TE[acc + i] = e; acc += nt; } OFF[NEXP] = acc; }
    __syncthreads();
    return OFF[NEXP];
}
__device__ __forceinline__ void combine_phase(Frame& F) {
    LAS int* OFF = (LAS int*)(F.lds + MISC_OFF + 512); LAS int* TE = OFF + 72;
    (void)moe_tables(F, OFF, TE);
    const int* TOPE = (const int*)(F.ws + WS_TOPE); const int* TOPPOS = (const int*)(F.ws + WS_TOPPOS); const float* TOPW = (const float*)(F.ws + WS_TOPW);
    const float* X1 = (const float*)(F.ws + WS_X1); const bf16* Y2 = (const bf16*)(F.ws + WS_Y2); const float* GF = F.in[I_NFG];
    const int gw = blockIdx.x * NWAVES + F.wave, NGW = F.G * NWAVES, lane = F.lane;
    for (int tok = gw; tok < NTOK; tok += NGW) {
        f32x4 v[4];
#pragma unroll
        for (int j = 0; j < 4; ++j) v[j] = ((const GAS f32x4*)(X1 + (size_t)tok * DM) + lane)[64 * j];
#pragma unroll
        for (int k = 0; k < 4; ++k) { const int slot = OFF[TOPE[tok * 4 + k]] + TOPPOS[tok * 4 + k]; const float wk = TOPW[tok * 4 + k];
            const GAS v2u* yr = (const GAS v2u*)(Y2 + (size_t)slot * DM) + lane;
#pragma unroll
            for (int j = 0; j < 4; ++j) { const v2u y = yr[64 * j]; v[j].x += wk * bflo(y.x); v[j].y += wk * bfhi(y.x); v[j].z += wk * bflo(y.y); v[j].w += wk * bfhi(y.y); } }
        float s2 = 0.f;
#pragma unroll
        for (int j = 0; j < 4; ++j) s2 += (v[j].x * v[j].x + v[j].y * v[j].y) + (v[j].z * v[j].z + v[j].w * v[j].w);
        const float rstd = 1.0f / sqrtf(wave_sum(s2) * (1.f / DM) + RMS_EPS);
#pragma unroll
        for (int j = 0; j < 4; ++j) { const f32x4 gg = ((const GAS f32x4*)GF + lane)[64 * j]; ((GAS f32x4*)(F.out + (size_t)tok * DM) + lane)[64 * j] = v[j] * rstd * gg; }
    }
}

__device__ __forceinline__ void ubench(Frame& F) {
    bf16x8 a = (bf16x8){1, 2, 3, 4, 5, 6, 7, 8}, b = (bf16x8){8, 7, 6, 5, 4, 3, 2, 1}; a[0] = (short)F.lane;
    float sink = 0.f;
    if (PROBE_DUP == 900) { f32x16 c0 = {0.f, 0.f, 0.f, 0.f, 0.f, 0.f, 0.f, 0.f, 0.f, 0.f, 0.f, 0.f, 0.f, 0.f, 0.f, 0.f}, c1 = c0;
        for (int i = 0; i < 2000; ++i) { c0 = __builtin_amdgcn_mfma_f32_32x32x16_bf16(a, b, c0, 0, 0, 0); c1 = __builtin_amdgcn_mfma_f32_32x32x16_bf16(a, b, c1, 0, 0, 0); }
        sink = c0[0] + c1[5]; }
    if (PROBE_DUP == 901) { f32x4 c0 = {0.f, 0.f, 0.f, 0.f}, c1 = c0, c2 = c0, c3 = c0;
        for (int i = 0; i < 2000; ++i) { c0 = __builtin_amdgcn_mfma_f32_16x16x32_bf16(a, b, c0, 0, 0, 0); c1 = __builtin_amdgcn_mfma_f32_16x16x32_bf16(a, b, c1, 0, 0, 0); c2 = __builtin_amdgcn_mfma_f32_16x16x32_bf16(a, b, c2, 0, 0, 0); c3 = __builtin_amdgcn_mfma_f32_16x16x32_bf16(a, b, c3, 0, 0, 0); }
        sink = c0[0] + c1[1] + c2[2] + c3[3]; }
    if (PROBE_DUP == 902) { float x0 = F.lane, x1 = 1.f, x2 = 2.f, x3 = 3.f, x4 = 4.f, x5 = 5.f, x6 = 6.f, x7 = 7.f; const float m = 1.0001f, d = 0.5f;
        for (int i = 0; i < 4000; ++i) { x0 = x0 * m + d; x1 = x1 * m + d; x2 = x2 * m + d; x3 = x3 * m + d; x4 = x4 * m + d; x5 = x5 * m + d; x6 = x6 * m + d; x7 = x7 * m + d; }
        sink = x0 + x1 + x2 + x3 + x4 + x5 + x6 + x7; }
    if (PROBE_DUP == 903) {
        f32x4 c[4]; float s = 0.f; float wv[16];
#pragma unroll
        for (int i = 0; i < 4; ++i) c[i] = (f32x4){0.f, 0.f, 0.f, 0.f};
#pragma unroll
        for (int i = 0; i < 16; ++i) wv[i] = 0.001f * (i + F.lane);
        for (int it = 0; it < 275; ++it) { f32x4 d[4];
#pragma unroll
            for (int i = 0; i < 4; ++i) { d[i] = (f32x4){0.f, 0.f, 0.f, 0.f}; d[i] = __builtin_amdgcn_mfma_f32_16x16x32_bf16(a, b, d[i], 0, 0, 0); d[i] = __builtin_amdgcn_mfma_f32_16x16x32_bf16(b, a, d[i], 0, 0, 0); }
            float t = 0.f;
#pragma unroll
            for (int i = 0; i < 4; ++i)
#pragma unroll
                for (int r = 0; r < 4; ++r) { const float x = c[i][r]; const int xi = __builtin_bit_cast(int, x); const float m = __builtin_bit_cast(float, xi > 0 ? xi : 0); t += wv[4 * i + r] * m; }
            float u = t;
#pragma unroll
            for (int k = 0; k < 12; ++k) u = u * 1.0001f + 0.5f;
            s += u; a[1] = (short)(it + (int)s);
#pragma unroll
            for (int i = 0; i < 4; ++i) c[i] = d[i]; }
        sink = s; }
    if (sink == 123.456f) ((float*)(F.ws + WS_SBUF))[F.tid] = sink;
}

constexpr int NPHASE = 10;
struct Args { const float* in[25]; float* out; unsigned char* ws; int ph_lo, ph_hi; };
__global__ void __launch_bounds__(NTHR, 2) fwd_kernel(Args args) {
    extern __shared__ __attribute__((aligned(16))) unsigned char lds[];
    Frame F;
    F.lds = (LAS unsigned char*)lds;
    F.MISC = (volatile LAS unsigned*)(F.lds + MISC_OFF);
    F.tid = threadIdx.x; F.lane = F.tid & 63; F.wave = __builtin_amdgcn_readfirstlane(F.tid >> 6); F.G = gridDim.x;
    F.ws = args.ws; F.ctl = (gu32*)(args.ws + WS_CTL); F.out = args.out;
#pragma unroll
    for (int i = 0; i < 25; ++i) F.in[i] = args.in[i];
    for (int u = F.tid; u < 2048 / 4; u += NTHR) ((LAS unsigned*)(F.lds + MISC_OFF))[u] = 0u;
    __syncthreads();
    XcdBarrier bar; bar.bar = (unsigned*)(F.ctl + CW_BAR); bar.x = 0; bar.st = nullptr;
    if (MK_N_LAUNCHES == 1) bar = xcd_barrier_post((unsigned*)(F.ctl + CW_BAR), F.MISC + 8);
    const int lo = args.ph_lo, hi = args.ph_hi;
#define IN(k) (lo <= (k) && (k) < hi)
#define SEAM(k) do { if (IN(k) && IN((k) + 1)) xcd_barrier(bar); } while (0)
    unsigned char* ws = F.ws; const int c = (int)blockIdx.x;

#define BODY_P0 { p0_prologue(F); if (PROBE_DUP >= 900) ubench(F); }
#define BODY_P1 { { pg8::Gemm g{(const bf16*)(ws + WS_XN), (const bf16*)(ws + WS_WIN), 1024, 1024, 1024, 0}; InProjOrder S{F.G, c, (unsigned*)(F.ctl + CW_UDONE)}; \
        EpiInProj E{ws, F.in[I_BGATE]}; pg8::gemm_phase<EpiInProj, InProjOrder>(F.lds, g, S, E); } \
        if (c >= 128 && c < 192) { wg_wait_ge(F, CW_UDONE, 128u * 8u); pg8::Gemm g{(const bf16*)(ws + WS_UGX), (const bf16*)(ws + WS_WS), UGX_LD, 512, 512, 0}; S5StateOrder S{c - 128}; EpiS5State E{(float*)(ws + WS_SBUF)}; \
          pg8::gemm_phase<EpiS5State, S5StateOrder>(F.lds, g, S, E); } \
        if (c >= 128) moe_convert(F, MOE_N8A, MOE_N8, (c < 192) ? c - 128 : 64 + 2 * (c - 192), (c < 192) ? 1 : 2, 192); }
#define BODY_P2 { carry_phase(F); idx_phase(F); if (PROBE_DUP == 102) { xcd_barrier(bar); idx_phase(F); } }
#define BODY_P3 { if (c >= 128) { { pg8::Gemm g{(const bf16*)(ws + WS_UGX), (const bf16*)(ws + WS_MT), UGX_LD, UGX_LD, 640, 0}; S5YOrder S{c - 128}; EpiS5Y E{(const bf16*)(ws + WS_UGX), F.in[I_SD], (bf16*)(ws + WS_YG)}; \
            pg8::gemm_phase<EpiS5Y, S5YOrder>(F.lds, g, S, E); } \
          wg_signal(F, CW_YDONE); wg_wait_ge(F, CW_YDONE, 128u); \
          { pg8::Gemm g{(const bf16*)(ws + WS_YG), (const bf16*)(ws + WS_WGLU), 512, 512, 512, 0}; StaticOrder S; S.init(NTOK / 256, 2, 128, c - 128); EpiGlu E{(const bf16*)(ws + WS_YG), F.in[I_BGLU], (bf16*)(ws + WS_YSSM)}; \
            pg8::gemm_phase<EpiGlu, StaticOrder>(F.lds, g, S, E); } } \
        attn_phase(F); }
#define BODY_P4 { pg8::Gemm g{(const bf16*)(ws + WS_YSSM), (const bf16*)(ws + WS_WPS), 512, 512, 512, 0}; MixOrder S; S.so.init(NTOK / 256, 4, F.G, c); \
        EpiMix E{(const bf16*)(ws + WS_GS), (const bf16*)(ws + WS_GA), (bf16*)(ws + WS_MIXED)}; pg8::gemm_phase<EpiMix, MixOrder>(F.lds, g, S, E); }
#define BODY_P5 { pg8::Gemm g{(const bf16*)(ws + WS_MIXED), (const bf16*)(ws + WS_WOUT), 1024, 1024, 1024, 0}; StaticOrder S; S.init(NTOK / 256, 4, F.G, c); EpiOut E{F.in[I_X], (float*)(ws + WS_X1)}; \
        pg8::gemm_phase<EpiOut, StaticOrder>(F.lds, g, S, E); }
#define BODY_P6 { router_phase(F); }
#define BODY_P7 { LAS int* OFF = (LAS int*)(F.lds + MISC_OFF + 512); LAS int* TE = OFF + 72; const int TT = moe_tables(F, OFF, TE); \
        pg8::Gemm g{(const bf16*)(ws + WS_H2), (const bf16*)(ws + WS_WMI), 1024, 2048, 1024, (size_t)1024 * 2048 * 2}; MoeOrder S{TE, OFF, OFF + 33, (const int*)(ws + WS_ROWMAP), TT, 8, c}; EpiMoe1 E{F.in[I_BMI], (bf16*)(ws + WS_ACT)}; \
        pg8::gemm_phase<EpiMoe1, MoeOrder, true, true>(F.lds, g, S, E); }
#define BODY_P8 { LAS int* OFF = (LAS int*)(F.lds + MISC_OFF + 512); LAS int* TE = OFF + 72; const int TT = moe_tables(F, OFF, TE); \
        pg8::Gemm g{(const bf16*)(ws + WS_ACT), (const bf16*)(ws + WS_WMO), 1024, 1024, 1024, (size_t)1024 * 1024 * 2}; MoeOrder S{TE, OFF, OFF + 33, nullptr, TT, 4, c}; EpiMoe2 E{F.in[I_BMO], (bf16*)(ws + WS_Y2)}; \
        pg8::gemm_phase<EpiMoe2, MoeOrder, true, true>(F.lds, g, S, E); }
#define BODY_P9 { combine_phase(F); }
#define PHASE(k, BODY) if (IN(k)) { TPROBE_BEGIN(k); BODY TPROBE_END(k); if (PROBE_DUP == (k)) { xcd_barrier(bar); BODY } } SEAM(k);
    PHASE(0, BODY_P0) PHASE(1, BODY_P1) PHASE(2, BODY_P2) PHASE(3, BODY_P3) PHASE(4, BODY_P4) PHASE(5, BODY_P5) PHASE(6, BODY_P6)
    PHASE(7, BODY_P7) PHASE(8, BODY_P8) PHASE(9, BODY_P9)
#undef IN
#undef SEAM
}

extern "C" void kernel_launch(void* const* d_in, const int* in_sizes, int n_in, void* d_out, int out_size, void* d_ws, size_t ws_size, hipStream_t stream) {
    static int grid = 0;
    if (grid == 0) {
        if (n_in != 25 || out_size != NTOK * DM || ws_size < WS_END) { fprintf(stderr, "kernel_launch: unexpected problem (n_in %d out %d ws %zu)\n", n_in, out_size, ws_size); grid = -1; return; }
        if (hipFuncSetAttribute((const void*)fwd_kernel, hipFuncAttributeMaxDynamicSharedMemorySize, LDS_BYTES) != hipSuccess) { fprintf(stderr, "kernel_launch: hipFuncSetAttribute failed\n"); grid = -1; return; }
        int per_cu = 0; (void)hipOccupancyMaxActiveBlocksPerMultiprocessor(&per_cu, (const void*)fwd_kernel, NTHR, LDS_BYTES); (void)hipGetLastError();
        grid = 256;
    }
    if (grid < 0) return;
    (void)hipMemsetAsync((char*)d_ws + WS_CTL, 0, CTL_ZERO_BYTES, stream);
    Args a{};
    for (int i = 0; i < 25; ++i) a.in[i] = (const float*)d_in[i];
    a.out = (float*)d_out; a.ws = (unsigned char*)d_ws;
    if (MK_N_LAUNCHES == 1) { a.ph_lo = 0; a.ph_hi = NPHASE; hipLaunchKernelGGL(fwd_kernel, dim3(grid), dim3(NTHR), LDS_BYTES, stream, a); }
    else for (int p = 0; p < NPHASE; ++p) { a.ph_lo = p; a.ph_hi = p + 1; hipLaunchKernelGGL(fwd_kernel, dim3(grid), dim3(NTHR), LDS_BYTES, stream, a); }
}
```

```cpp
#include <hip/hip_runtime.h>
#include <cstdio>
#include <cstdint>

#ifndef MK_N_LAUNCHES
#define MK_N_LAUNCHES 1
#endif
#ifndef PROBE_DUP
#define PROBE_DUP -1
#endif
#ifndef PROBE_MULT
#define PROBE_MULT 4
#endif
#ifndef PROBE_T
#define PROBE_T -1
#endif
#define TPROBE_BEGIN(id) unsigned long long tpb_##id = (PROBE_T == (id)) ? __builtin_amdgcn_s_memrealtime() : 0ull
#define TPROBE_END(id) do { if (PROBE_T == (id)) { const unsigned long long d_ = __builtin_amdgcn_s_memrealtime() - tpb_##id, t1_ = __builtin_amdgcn_s_memrealtime(); while (__builtin_amdgcn_s_memrealtime() - t1_ < 4ull * d_) __builtin_amdgcn_s_sleep(8); } } while (0)

namespace pg8 {
#define PG8_LAS __attribute__((address_space(3)))
typedef unsigned short bf16_t;
typedef short bf16x8 __attribute__((ext_vector_type(8)));
typedef float f32x4 __attribute__((ext_vector_type(4)));
typedef float f32x2 __attribute__((ext_vector_type(2)));
typedef unsigned u32x4 __attribute__((ext_vector_type(4)));
typedef unsigned u32x2 __attribute__((ext_vector_type(2)));
constexpr int BM = 256, BK = 64, HALF = 128, HTB = HALF * BK * 2, STAGE_BYTES = 8 * HTB, NXCD = 8, WGM = 8;

__host__ __device__ __forceinline__ int lds_byte(int r, int c) { const int st = (r >> 4) * 2 + (c >> 5), rr = r & 15, cc = c & 31, ob = rr * 64 + cc * 2; return st * 1024 + (ob ^ (((ob >> 9) & 1) << 5)); }
__host__ __device__ __forceinline__ void stage_rc(int b, int& R, int& C) { const int st = b / 1024, sb = b % 1024, swz = sb ^ (((sb >> 9) & 1) << 5); R = (st >> 1) * 16 + swz / 64; C = (st & 1) * 32 + (swz % 64) / 2; }
__host__ __device__ __forceinline__ int perm32(int rho) { const int n = rho >> 4, i = rho & 15; return 8 * (i >> 2) + 4 * n + (i & 3); }

struct Unit { int pm, pn, pa, pb, e; };
struct Gemm { const bf16_t* A; const bf16_t* Bt; int lda, ldb, K; size_t bexp; };

__device__ __forceinline__ unsigned cvt_pk_bf16(float lo, float hi) { unsigned r; asm volatile("v_cvt_pk_bf16_f32 %0, %1, %2" : "=v"(r) : "v"(lo), "v"(hi)); return r; }
__device__ __forceinline__ u32x4 pack8(const f32x4& v0, const f32x4& v1) { u32x4 w; w.x = cvt_pk_bf16(v0[0], v0[1]); w.y = cvt_pk_bf16(v0[2], v0[3]); w.z = cvt_pk_bf16(v1[0], v1[1]); w.w = cvt_pk_bf16(v1[2], v1[3]); return w; }

template <class Epi, class Sched, bool ALIGN_EPI = true, bool BKN = false>
__device__ __forceinline__ void gemm_phase(PG8_LAS unsigned char* lds, const Gemm g, const Sched& S, const Epi& E) {
    const int tid = threadIdx.x, wid = __builtin_amdgcn_readfirstlane(tid >> 6), lane = tid & 63, wr = wid >> 2, wc = wid & 3, fr = lane & 15, fq = lane >> 4;
    const int K = g.K, nt = K / BK;
    unsigned voffB[2];
#pragma unroll
    for (int i = 0; i < 2; ++i) {
        if constexpr (BKN) { const int krow = (tid >> 4) + 32 * i, cp = tid & 15, fk = ((krow & 3) << 1) | (((krow >> 3) & 1) << 3); voffB[i] = (unsigned)(krow * g.ldb) * 2u + (unsigned)((cp ^ fk) << 4); }
        else { int R, C; stage_rc(tid * 16 + i * 8192, R, C); const int Rb = (R & ~31) + perm32(R & 31); voffB[i] = (unsigned)(Rb * g.ldb + C) * 2u; } }
    const size_t kstep = (size_t)(BK * 2);
    const size_t kstepB = BKN ? (size_t)BK * g.ldb * 2 : kstep;
    const size_t hstepB = BKN ? (size_t)256 : (size_t)HALF * g.ldb * 2;
    const size_t tstepB = BKN ? (size_t)512 : 2 * hstepB;
    const unsigned tbase = (unsigned)(unsigned long)lds + (unsigned)((8 * fq + (fr >> 2)) * 256 + (((4 * wc + (fr & 3)) ^ (((fr >> 2) << 1) | ((fq & 1) << 3))) << 4));
#define PG8_AROWS(VV, U) do { _Pragma("unroll") for (int i_ = 0; i_ < 2; ++i_) { int R_, C_; stage_rc((threadIdx.x & 511) * 16 + i_ * 8192, R_, C_); \
        _Pragma("unroll") for (int h_ = 0; h_ < 2; ++h_) VV[h_][i_] = (unsigned)(S.arow(U, h_, R_) * g.lda + C_) * 2u; } } while (0)
    unsigned vA[2][2], vAn[2][2];
    const unsigned ldsw = (unsigned)wid * 1024u;
    const int aoff = lds_byte(wr * 64 + fr, fq * 8), boff = lds_byte(wc * 32 + fr, fq * 8);
#define PG8_SA(b, h) (((b) * 2 + (h)) * HTB)
#define PG8_SB(b, h) ((4 + (b) * 2 + (h)) * HTB)
#define PG8_STAGE(bufoff, gbase, voff) do { _Pragma("unroll") for (int _i = 0; _i < 2; ++_i) \
        __builtin_amdgcn_global_load_lds((const unsigned*)((const char*)(gbase) + (voff)[_i]), (PG8_LAS unsigned*)(lds + (bufoff) + ldsw + _i * 8192), 16, 0, 0); } while (0)
#define PG8_LDA(dst, b, h) do { _Pragma("unroll") for (int m = 0; m < 4; ++m) _Pragma("unroll") for (int k = 0; k < 2; ++k) dst[m][k] = *(const PG8_LAS bf16x8*)(lds + PG8_SA(b, h) + aoff + m * 2048 + k * 1024); } while (0)
#define PG8_LDB(dst, b, h) do { if constexpr (BKN) { const unsigned ab_ = tbase + PG8_SB(b, h); _Pragma("unroll") for (int n = 0; n < 2; ++n) _Pragma("unroll") for (int k = 0; k < 2; ++k) { u32x2 lo_, hi_; \
            asm volatile("ds_read_b64_tr_b16 %0, %2 offset:%3\n\tds_read_b64_tr_b16 %1, %2 offset:%4" : "=&v"(lo_), "=&v"(hi_) : "v"(ab_), "n"(k * 8192 + n * 8), "n"(k * 8192 + n * 8 + 1024) : "memory"); \
            u32x4 w_; w_.x = lo_.x; w_.y = lo_.y; w_.z = hi_.x; w_.w = hi_.y; dst[n][k] = __builtin_bit_cast(bf16x8, w_); } } \
        else { _Pragma("unroll") for (int n = 0; n < 2; ++n) _Pragma("unroll") for (int k = 0; k < 2; ++k) dst[n][k] = *(const PG8_LAS bf16x8*)(lds + PG8_SB(b, h) + boff + n * 2048 + k * 1024); } } while (0)
#define PG8_WAIT_LB() do { if constexpr (BKN) asm volatile("s_waitcnt lgkmcnt(0)" : "+v"(B0[0][0]), "+v"(B0[0][1]), "+v"(B0[1][0]), "+v"(B0[1][1]), "+v"(B1[0][0]), "+v"(B1[0][1]), "+v"(B1[1][0]), "+v"(B1[1][1]) :: "memory"); \
        else asm volatile("s_waitcnt lgkmcnt(0)" ::: "memory"); } while (0)
#define PG8_MMA(ai, bj, At, Bt) do { __builtin_amdgcn_s_setprio(1); _Pragma("unroll") for (int m = 0; m < 4; ++m) _Pragma("unroll") for (int n = 0; n < 2; ++n) _Pragma("unroll") for (int k = 0; k < 2; ++k) \
        acc[ai][bj][m][n] = __builtin_amdgcn_mfma_f32_16x16x32_bf16(Bt[n][k], At[m][k], acc[ai][bj][m][n], 0, 0, 0); __builtin_amdgcn_s_setprio(0); } while (0)
#define PG8_WAIT_V(n) asm volatile("s_waitcnt vmcnt(" #n ")" ::: "memory")
#define PG8_WAIT_L(n) asm volatile("s_waitcnt lgkmcnt(" #n ")" ::: "memory")
#define PG8_BAR __builtin_amdgcn_s_barrier()
#define PG8_SCHED __builtin_amdgcn_sched_barrier(0)
    Unit cur, nxt; int ui = 0;
    if (!S.next(0, cur)) return;
    f32x4 acc[2][2][4][2];
#pragma unroll
    for (int a = 0; a < 2; ++a)
#pragma unroll
        for (int b = 0; b < 2; ++b)
#pragma unroll
            for (int m = 0; m < 4; ++m)
#pragma unroll
                for (int n = 0; n < 2; ++n) acc[a][b][m][n] = (f32x4){0.f, 0.f, 0.f, 0.f};
    bf16x8 At[4][2], B0[2][2], B1[2][2];
    const char* const bA = (const char*)g.A; const char* cB = BKN ? (const char*)g.Bt + (size_t)cur.e * g.bexp + (size_t)cur.pn * tstepB : (const char*)g.Bt + (size_t)cur.pb * tstepB;
    PG8_AROWS(vA, cur);
    PG8_STAGE(PG8_SB(0, 0), cB, voffB); PG8_STAGE(PG8_SB(0, 1), cB + hstepB, voffB); PG8_STAGE(PG8_SA(0, 0), bA, vA[0]); PG8_STAGE(PG8_SA(0, 1), bA, vA[1]);
    if (wr == 1) PG8_BAR;
    PG8_WAIT_V(2); PG8_BAR;
    PG8_STAGE(PG8_SB(1, 0), cB + kstepB, voffB); PG8_STAGE(PG8_SA(1, 0), bA + kstep, vA[0]); PG8_STAGE(PG8_SB(1, 1), cB + hstepB + kstepB, voffB);
    PG8_WAIT_V(6); PG8_BAR;
    for (;;) {
        const bool has_next = S.next(ui + 1, nxt);
        const char* nB = has_next ? (BKN ? (const char*)g.Bt + (size_t)nxt.e * g.bexp + (size_t)nxt.pn * tstepB : (const char*)g.Bt + (size_t)nxt.pb * tstepB) : cB;
        if (has_next) PG8_AROWS(vAn, nxt); else { vAn[0][0] = vA[0][0]; vAn[0][1] = vA[0][1]; vAn[1][0] = vA[1][0]; vAn[1][1] = vA[1][1]; }
        for (int t = 0; t < nt; t += 2) {
            const bool last = (t == nt - 2);
            const char* a1 = bA + (size_t)(t + 1) * kstep;
            const char* a2 = last ? bA : bA + (size_t)(t + 2) * kstep; const char* b2 = last ? nB : cB + (size_t)(t + 2) * kstepB;
            const char* a3 = a2 + kstep; const char* b3 = b2 + kstepB;
            unsigned w0[2], w1[2];
            w0[0] = last ? vAn[0][0] : vA[0][0]; w0[1] = last ? vAn[0][1] : vA[0][1]; w1[0] = last ? vAn[1][0] : vA[1][0]; w1[1] = last ? vAn[1][1] : vA[1][1];
            PG8_LDB(B0, 0, 0); PG8_LDB(B1, 0, 1); PG8_SCHED; PG8_LDA(At, 0, 0); PG8_STAGE(PG8_SA(1, 1), a1, vA[1]);
            PG8_WAIT_V(8); PG8_WAIT_LB(); PG8_BAR; PG8_MMA(0, 0, At, B0); PG8_MMA(0, 1, At, B1); PG8_BAR; PG8_SCHED;
            PG8_LDA(At, 0, 1); PG8_STAGE(PG8_SB(0, 0), b2, voffB); PG8_STAGE(PG8_SB(0, 1), b2 + hstepB, voffB); PG8_STAGE(PG8_SA(0, 0), a2, w0);
            PG8_WAIT_V(8); PG8_WAIT_L(0); PG8_BAR; PG8_MMA(1, 0, At, B0); PG8_MMA(1, 1, At, B1); PG8_BAR; PG8_SCHED;
            PG8_LDB(B0, 1, 0); PG8_LDB(B1, 1, 1); PG8_SCHED; PG8_LDA(At, 1, 0); PG8_STAGE(PG8_SA(0, 1), a2, w1);
            PG8_WAIT_V(8); PG8_WAIT_LB(); PG8_BAR; PG8_MMA(0, 0, At, B0); PG8_MMA(0, 1, At, B1); PG8_BAR; PG8_SCHED;
            PG8_LDA(At, 1, 1); PG8_STAGE(PG8_SB(1, 0), b3, voffB); PG8_STAGE(PG8_SB(1, 1), b3 + hstepB, voffB); PG8_STAGE(PG8_SA(1, 0), a3, w0);
            PG8_WAIT_V(8); PG8_WAIT_L(0); PG8_BAR; PG8_MMA(1, 0, At, B0); PG8_MMA(1, 1, At, B1); PG8_BAR; PG8_SCHED;
        }
        if constexpr (ALIGN_EPI) { if (wr == 0) PG8_BAR; }
        { const bool pe_ = (PROBE_T == 200 && !BKN) || (PROBE_T == 201 && BKN) || (PROBE_T == 203 && BKN && g.ldb == 2048) || (PROBE_T == 204 && BKN && g.ldb == 1024) || (PROBE_T >= 210 && PROBE_T < 216 && !BKN && S.probe_id() == PROBE_T) || (PROBE_T == 216 && !BKN && S.probe_id() == 211 && cur.pn < 2) || (PROBE_T == 217 && !BKN && S.probe_id() == 211 && cur.pn >= 2) || (PROBE_T == 218 && !BKN && S.probe_id() == 211 && blockIdx.x >= 192) || (PROBE_T == 219 && !BKN && S.probe_id() == 211 && blockIdx.x < 128 && cur.pn >= 2);
          unsigned long long tpe_ = 0; if (pe_) tpe_ = __builtin_amdgcn_s_memrealtime();
          E(acc, cur, wr, wc, fr, fq);
          if ((PROBE_T == 220 || (PROBE_T == 221 && wid == 0)) && !BKN && S.probe_id() == 211 && blockIdx.x >= 192) { const unsigned long long t1_ = __builtin_amdgcn_s_memrealtime(); while (__builtin_amdgcn_s_memrealtime() - t1_ < 2000ull) __builtin_amdgcn_s_sleep(8); }
          if (pe_) { const unsigned long long d_ = __builtin_amdgcn_s_memrealtime() - tpe_, t1_ = __builtin_amdgcn_s_memrealtime(); while (__builtin_amdgcn_s_memrealtime() - t1_ < (unsigned long long)PROBE_MULT * d_) __builtin_amdgcn_s_sleep(8); } } S.done(cur);
        if (!has_next) break;
#pragma unroll
        for (int a = 0; a < 2; ++a)
#pragma unroll
            for (int b = 0; b < 2; ++b)
#pragma unroll
                for (int m = 0; m < 4; ++m)
#pragma unroll
                    for (int n = 0; n < 2; ++n) acc[a][b][m][n] = (f32x4){0.f, 0.f, 0.f, 0.f};
        cur = nxt; cB = nB; ++ui; vA[0][0] = vAn[0][0]; vA[0][1] = vAn[0][1]; vA[1][0] = vAn[1][0]; vA[1][1] = vAn[1][1];
        if constexpr (ALIGN_EPI) { if (wr == 1) PG8_BAR; }
    }
    PG8_WAIT_V(0);
    if constexpr (!ALIGN_EPI) { if (wr == 0) PG8_BAR; }
    PG8_BAR;
#undef PG8_AROWS
#undef PG8_SA
#undef PG8_SB
#undef PG8_STAGE
#undef PG8_LDA
#undef PG8_LDB
#undef PG8_WAIT_LB
#undef PG8_MMA
#undef PG8_WAIT_V
#undef PG8_WAIT_L
#undef PG8_BAR
#undef PG8_SCHED
}
}

constexpr int NB = 4, SEQ = 4096, NTOK = NB * SEQ, DM = 1024;
constexpr int NWAVES = 8, NTHR = 512;
constexpr int D_SSM = 512, NGRP = 32, NSTATE = 64, CH = 32  , NCH = SEQ / CH  , UGX_LD = 640, S5_ROWS = NB * NCH  ;
constexpr int NIN_PAD = 4608;
constexpr int NEXP = 32, TOPK_E = 4, DFF = 1024;
constexpr int NSEL = 256;
constexpr int MAX_MT = 288;
constexpr float RMS_EPS = 1e-5f;

constexpr size_t MiB = 1u << 20;
constexpr size_t WS_CTL = 0, CTL_ZERO_BYTES = 1 * MiB;
constexpr size_t WS_ROPE = 1 * MiB;
constexpr size_t WS_WIN = 2 * MiB;
constexpr size_t WS_WGLU = 11 * MiB;
constexpr size_t WS_WPS = 12 * MiB;
constexpr size_t WS_WPA = 13 * MiB;
constexpr size_t WS_WOUT = 14 * MiB;
constexpr size_t WS_MT = 16 * MiB;
constexpr size_t WS_WS = 36 * MiB;
constexpr size_t WS_A32 = 44 * MiB;
constexpr size_t WS_SBUF = 45 * MiB;
constexpr size_t WS_WI = 53 * MiB;
constexpr size_t WS_KI = 54 * MiB;
constexpr size_t WS_K = 56 * MiB;
constexpr size_t WS_V = 60 * MiB;
constexpr size_t WS_UGX = 64 * MiB;
constexpr size_t WS_Q = 84 * MiB;
constexpr size_t WS_QI = 100 * MiB;
constexpr size_t WS_GS = 132 * MiB;
constexpr size_t WS_GA = 164 * MiB;
constexpr size_t WS_XN = 196 * MiB;
constexpr size_t WS_YG = 228 * MiB;
constexpr size_t WS_YSSM = 244 * MiB;
constexpr size_t WS_YATT = 260 * MiB;
constexpr size_t WS_SEL = 276 * MiB;
constexpr size_t WS_MIXED = 284 * MiB;
constexpr size_t WS_X1 = 316 * MiB;
constexpr size_t WS_H2 = 380 * MiB;
constexpr size_t WS_TOPE = 412 * MiB;
constexpr size_t WS_TOPW = WS_TOPE + 256 * 1024;
constexpr size_t WS_TOPPOS = WS_TOPW + 256 * 1024;
constexpr size_t WS_ROWMAP = 413 * MiB;
constexpr size_t WS_WMI = 416 * MiB;
constexpr size_t WS_WMO = 544 * MiB;
constexpr size_t WS_ACT = 608 * MiB;
constexpr size_t WS_XP = 64 * MiB;
constexpr size_t WS_Y2 = 64 * MiB;
constexpr size_t WS_END = 752 * MiB;
static_assert(WS_XP + (size_t)MAX_MT * 256 * 1024 * 2 <= WS_YG, "XP overlay");
constexpr int CW_TMO = 0, CW_CODE = 1;
constexpr int CW_BAR = 4096;
constexpr int CW_ECNT = 16384;
constexpr int CW_UDONE = 16384 + 64;
constexpr int CW_YDONE = 16384 + 128;

constexpr int LDS_BYTES = 163840;
constexpr int MISC_OFF = 163840 - 2048;

#define GAS __attribute__((address_space(1)))
#define LAS __attribute__((address_space(3)))
typedef unsigned short bf16;
typedef unsigned short u16;
typedef unsigned v4u __attribute__((ext_vector_type(4)));
typedef unsigned v2u __attribute__((ext_vector_type(2)));
typedef float f32x4 __attribute__((ext_vector_type(4)));
typedef float f32x16 __attribute__((ext_vector_type(16)));
typedef short bf16x8 __attribute__((ext_vector_type(8)));
typedef GAS unsigned gu32;
#define RLX_AGENT __ATOMIC_RELAXED, __HIP_MEMORY_SCOPE_AGENT
#define LDS_WAIT() asm volatile("s_waitcnt lgkmcnt(0)" ::: "memory")
#define VM_WAIT() asm volatile("s_waitcnt vmcnt(0)" ::: "memory")
__device__ __forceinline__ unsigned f2bf(float f) { unsigned u = __builtin_bit_cast(unsigned, f); return (u + 0x7fffu + ((u >> 16) & 1u)) >> 16; }
__device__ __forceinline__ unsigned pk2(float lo, float hi) { return f2bf(lo) | (f2bf(hi) << 16); }
__device__ __forceinline__ float bf2f(unsigned b) { return __builtin_bit_cast(float, b << 16); }
__device__ __forceinline__ float bflo(unsigned w) { return __builtin_bit_cast(float, w << 16); }
__device__ __forceinline__ float bfhi(unsigned w) { return __builtin_bit_cast(float, w & 0xffff0000u); }
__device__ __forceinline__ float sigmoidf_(float x) { return __builtin_amdgcn_rcpf(1.0f + __builtin_amdgcn_exp2f(-1.4426950408889634f * x)); }
__device__ __forceinline__ float gelu_tanh(float x) { const float u = 0.7978845608028654f * (x + 0.044715f * x * x * x); const float e = __builtin_amdgcn_exp2f(2.8853900817779268f * u); const float t = 1.0f - 2.0f * __builtin_amdgcn_rcpf(e + 1.0f); return 0.5f * x * (1.0f + t); }

#define XB_TMO      128
#define XB_XCNT(j)  (256  + 64 * (j))
#define XB_XSUB(j)  (1280 + 64 * (j))
#define XB_XGEN(j)  (2304 + 64 * (j))
#define XB_TOP      3328
#define XB_TOPGEN   3392
#define XCD_BAR_WORDS 3456
#define XB_SPIN_CAP (1u << 18)
__device__ __forceinline__ unsigned xb_ld(unsigned* p)              { return __hip_atomic_load(p, __ATOMIC_RELAXED, __HIP_MEMORY_SCOPE_AGENT); }
__device__ __forceinline__ unsigned xb_add(unsigned* p, unsigned v) { return __hip_atomic_fetch_add(p, v, __ATOMIC_RELAXED, __HIP_MEMORY_SCOPE_AGENT); }
__device__ __forceinline__ unsigned xb_xcc_id() { return (unsigned)__builtin_amdgcn_s_getreg((3 << 11) | 20) & 0xFu; }
#define XB_SPIN(cond, bar) do { unsigned _sp = 0; while (cond) { __builtin_amdgcn_s_sleep(1); \
    if ((++_sp & 255u) == 0u) { if (xb_ld(&(bar)[XB_TMO])) break; if (_sp > XB_SPIN_CAP) { atomicAdd(&(bar)[XB_TMO], 1u); break; } } } } while (0)
struct XcdBarrier { unsigned* bar; unsigned x; volatile LAS unsigned* st; };
__device__ __forceinline__ XcdBarrier xcd_barrier_post(unsigned* bar, volatile LAS unsigned* st) {
    XcdBarrier b; b.bar = bar; b.x = xb_xcc_id(); b.st = st;
    if (threadIdx.x == 0) (void)xb_add(&bar[XB_XCNT(b.x)], 1u);
    return b;
}
__device__ __forceinline__ void xcd_barrier_complete(unsigned* bar, unsigned x, unsigned& nloc, unsigned& nx) {
    const unsigned G = gridDim.x * gridDim.y * gridDim.z;
    unsigned sum, cnt, mine, sp = 0u;
    for (;;) {
        sum = 0u; cnt = 0u; mine = 0u;
#pragma unroll
        for (unsigned j = 0; j < 16; ++j) { const unsigned c = xb_ld(&bar[XB_XCNT(j)]); sum += c; cnt += (c > 0u) ? 1u : 0u; mine = (j == x) ? c : mine; }
        if (sum == G) break;
        __builtin_amdgcn_s_sleep(1);
        if ((++sp & 255u) == 0u) { if (xb_ld(&bar[XB_TMO])) break; if (sp > XB_SPIN_CAP) { atomicAdd(&bar[XB_TMO], 1u); break; } }
    }
    nloc = mine > 0u ? mine : 1u; nx = cnt > 0u ? cnt : 1u;
}
__device__ __forceinline__ void xcd_barrier(const XcdBarrier& b) {
    asm volatile("s_waitcnt vmcnt(0)" ::: "memory");
    __syncthreads();
    if (threadIdx.x == 0) {
        unsigned* bar = b.bar;
        __builtin_amdgcn_s_waitcnt(0);
        unsigned nloc = b.st[0], nx = b.st[1];
        if (nloc == 0u) { xcd_barrier_complete(bar, b.x, nloc, nx); b.st[0] = nloc; b.st[1] = nx; }
        const unsigned old = xb_add(&bar[XB_XSUB(b.x)], 1u);
        const unsigned gen = old / nloc;
        if (old + 1u == (gen + 1u) * nloc) {
            __builtin_amdgcn_fence(__ATOMIC_RELEASE, "agent");
            asm volatile("s_waitcnt vmcnt(0)" ::: "memory");
            const unsigned og = xb_add(&bar[XB_TOP], 1u);
            const unsigned tg = og / nx;
            if (og + 1u == (tg + 1u) * nx) xb_add(&bar[XB_TOPGEN], 1u);
            else XB_SPIN(xb_ld(&bar[XB_TOPGEN]) == tg, bar);
            __builtin_amdgcn_fence(__ATOMIC_ACQUIRE, "agent");
            xb_add(&bar[XB_XGEN(b.x)], 1u);
            asm volatile("s_waitcnt vmcnt(0)" ::: "memory");
        } else {
            XB_SPIN(xb_ld(&bar[XB_XGEN(b.x)]) == gen, bar);
            __builtin_amdgcn_fence(__ATOMIC_ACQUIRE, "agent");
            asm volatile("s_waitcnt vmcnt(0)" ::: "memory");
        }
    }
    __syncthreads();
}

struct Frame {
    LAS unsigned char* lds;
    volatile LAS unsigned* MISC;
    gu32* ctl;
    int tid, lane, wave, G;
    unsigned char* ws;
    const float* in[25];
    float* out;
};
enum { I_X = 0, I_N1G, I_WIN, I_BGATE, I_LRE, I_LIM, I_LOGDT, I_BRE, I_BIM, I_CRE, I_CIM, I_SD, I_WGLU, I_BGLU, I_WPS, I_WPA, I_WOUT, I_N2G, I_WR, I_BR, I_WMI, I_BMI, I_WMO, I_BMO, I_NFG };

__device__ __forceinline__ float wave_sum(float v) {
#pragma unroll
    for (int o = 1; o < 64; o <<= 1) v += __shfl_xor(v, o);
    return v;
}

__device__ __forceinline__ int ropeperm(int p) { const int a = p >> 3, bb = p & 7; return bb < 4 ? 4 * a + bb : 32 + 4 * a + (bb - 4); }
__device__ __forceinline__ int win_src(int nd) {
    const int pn = nd >> 8, j = nd & 255;
    if (pn < 2) return nd;
    if (pn < 4) { const int i = nd - 512; return 512 + (i & ~63) + ropeperm(i & 63); }
    if (pn == 4) { if (j < 128) return 1024 + (j & ~63) + ropeperm(j & 63); return 1152 + (j - 128); }
    if (pn < 9) { const int i = nd - 1280; return 1280 + (i & ~63) + ropeperm(i & 63); }
    if (pn == 9) { if (j < 64) return 2304 + ropeperm(j); if (j < 80) return 2368 + (j - 64); return -1; }
    if (pn < 14) return 2384 + (nd - 2560);
    return 3408 + (nd - 3584);
}
struct TItem { const float* src; bf16* dst; int N, K; };
__device__ __forceinline__ void titem_load(const TItem& T, float (&tv)[32], int lane) {
#pragma unroll
    for (int i = 0; i < 32; ++i) { const int kk = 2 * i + (lane >> 5); tv[i] = T.src ? __builtin_nontemporal_load(T.src + (size_t)kk * T.N) : 0.f; }
}
__device__ __forceinline__ void titem_store(const TItem& T, const float (&tv)[32], LAS float* scr, int lane) {
#pragma unroll
    for (int i = 0; i < 32; ++i) { const int kk = 2 * i + (lane >> 5); scr[kk * 33 + (lane & 31)] = tv[i]; }
    LDS_WAIT(); asm volatile("" ::: "memory");
    const int c = lane & 7;
#pragma unroll
    for (int j = 0; j < 4; ++j) { const int n = (lane >> 3) + 8 * j; const LAS float* s = scr + (8 * c) * 33 + n;
        v4u o; o.x = pk2(s[0 * 33], s[1 * 33]); o.y = pk2(s[2 * 33], s[3 * 33]); o.z = pk2(s[4 * 33], s[5 * 33]); o.w = pk2(s[6 * 33], s[7 * 33]);
        *(GAS v4u*)(T.dst + (size_t)n * T.K + 8 * c) = o; }
    LDS_WAIT(); asm volatile("" ::: "memory");
}
__device__ __forceinline__ void rms_row_to_bf16(int lane, const float* xrow, const float* g, bf16* orow) {
    const GAS f32x4* xr = (const GAS f32x4*)xrow + lane; const GAS f32x4* gr = (const GAS f32x4*)g + lane;
    f32x4 v[4]; float s2 = 0.f;
#pragma unroll
    for (int j = 0; j < 4; ++j) { v[j] = xr[64 * j]; s2 += (v[j].x * v[j].x + v[j].y * v[j].y) + (v[j].z * v[j].z + v[j].w * v[j].w); }
    const float rstd = 1.0f / sqrtf(wave_sum(s2) * (1.f / DM) + RMS_EPS);
    GAS unsigned long long* o8 = (GAS unsigned long long*)orow + lane;
#pragma unroll
    for (int j = 0; j < 4; ++j) { const f32x4 gg = gr[64 * j];
        o8[64 * j] = (unsigned long long)pk2(v[j].x * rstd * gg.x, v[j].y * rstd * gg.y) | ((unsigned long long)pk2(v[j].z * rstd * gg.z, v[j].w * rstd * gg.w) << 32); }
}
__device__ __forceinline__ void p0_s5_group(Frame& F, int g) {
    LAS float* AP = (LAS float*)(F.lds);
    LAS float* BB = (LAS float*)(F.lds + 16896);
    LAS float* CC = (LAS float*)(F.lds + 25088);
    LAS float* KJ = (LAS float*)(F.lds + 33280);
    const float* lre = F.in[I_LRE] + g * 64; const float* lim = F.in[I_LIM] + g * 64;
    const double dt = exp((double)F.in[I_LOGDT][g]);
    __syncthreads();
    for (int idx = F.tid; idx < 33 * 64; idx += NTHR) { const int p = idx & 63, j = idx >> 6;
        const double lr = lre[p], li = lim[p]; const double mag = exp(j * lr * dt), ang = j * li * dt;
        AP[idx * 2] = (float)(mag * cos(ang)); AP[idx * 2 + 1] = (float)(mag * sin(ang)); }
    for (int idx = F.tid; idx < 1024; idx += NTHR) { const int p = idx >> 4;
        const double lr = lre[p], li = lim[p]; const double mag = exp(lr * dt), ang = li * dt; const double ar = mag * cos(ang), ai = mag * sin(ang);
        const double nr = ar - 1.0, ni = ai, den = lr * lr + li * li; const double zr = (nr * lr + ni * li) / den, zi = (ni * lr - nr * li) / den;
        const double br = F.in[I_BRE][g * 1024 + idx], bi = F.in[I_BIM][g * 1024 + idx];
        BB[idx * 2] = (float)(zr * br - zi * bi); BB[idx * 2 + 1] = (float)(zr * bi + zi * br); }
    for (int idx = F.tid; idx < 1024; idx += NTHR) { CC[idx * 2] = F.in[I_CRE][g * 1024 + idx]; CC[idx * 2 + 1] = F.in[I_CIM][g * 1024 + idx]; }
    __syncthreads();
    { const int j = F.tid >> 4, hp = F.tid & 15; float s[16];
#pragma unroll
      for (int h = 0; h < 16; ++h) s[h] = 0.f;
      for (int p = 0; p < 64; ++p) { const float cr = CC[(hp * 64 + p) * 2], ci = CC[(hp * 64 + p) * 2 + 1], ar = AP[(j * 64 + p) * 2], ai = AP[(j * 64 + p) * 2 + 1];
          const float er = cr * ar - ci * ai, ei = cr * ai + ci * ar;
#pragma unroll
          for (int h4 = 0; h4 < 8; ++h4) { const f32x4 bb = *(const LAS f32x4*)(BB + (p * 16 + 2 * h4) * 2); s[2 * h4] += er * bb[0] - ei * bb[1]; s[2 * h4 + 1] += er * bb[2] - ei * bb[3]; } }
#pragma unroll
      for (int h = 0; h < 16; ++h) KJ[(j * 16 + hp) * 16 + h] = s[h]; }
    __syncthreads();
    bf16* MT = (bf16*)(F.ws + WS_MT) + (size_t)g * 512 * 640;
    for (int ch = F.tid; ch < 512 * 80; ch += NTHR) { const int n = ch / 80, k0 = (ch % 80) * 8, tp = n >> 4, hp = n & 15; float v[8];
        if (k0 < 512) { const int sp = k0 >> 4, h0 = k0 & 15;
#pragma unroll
            for (int j = 0; j < 8; ++j) v[j] = (sp <= tp) ? KJ[((tp - sp) * 16 + hp) * 16 + h0 + j] : 0.f; }
        else { const bool im = k0 >= 576; const int p0 = k0 - (im ? 576 : 512);
#pragma unroll
            for (int j = 0; j < 8; ++j) { const int p = p0 + j; const float cr = CC[(hp * 64 + p) * 2], ci = CC[(hp * 64 + p) * 2 + 1], ar = AP[((tp + 1) * 64 + p) * 2], ai = AP[((tp + 1) * 64 + p) * 2 + 1];
                v[j] = im ? -(cr * ai + ci * ar) : (cr * ar - ci * ai); } }
        v4u o; o.x = pk2(v[0], v[1]); o.y = pk2(v[2], v[3]); o.z = pk2(v[4], v[5]); o.w = pk2(v[6], v[7]);
        *(GAS v4u*)(MT + (size_t)n * 640 + k0) = o; }
    bf16* WS = (bf16*)(F.ws + WS_WS) + (size_t)g * 256 * 512;
    for (int ch = F.tid; ch < 256 * 64; ch += NTHR) { const int n = ch >> 6, k0 = (ch & 63) * 8, sp = k0 >> 4, h0 = k0 & 15; float v[8];
#pragma unroll
        for (int j = 0; j < 8; ++j) { if (n < 128) { const int p = n & 63; const float ar = AP[((31 - sp) * 64 + p) * 2], ai = AP[((31 - sp) * 64 + p) * 2 + 1], br = BB[(p * 16 + h0 + j) * 2], bi = BB[(p * 16 + h0 + j) * 2 + 1];
                v[j] = (n < 64) ? (ar * br - ai * bi) : (ar * bi + ai * br); } else v[j] = 0.f; }
        v4u o; o.x = pk2(v[0], v[1]); o.y = pk2(v[2], v[3]); o.z = pk2(v[4], v[5]); o.w = pk2(v[6], v[7]);
        *(GAS v4u*)(WS + (size_t)n * 512 + k0) = o; }
    float* A32 = (float*)(F.ws + WS_A32) + g * 128;
    if (F.tid < 128) A32[F.tid] = AP[32 * 128 + F.tid];
    __syncthreads();
}
constexpr size_t MOE_N8_IN = (size_t)NEXP * 1024 * 2048 / 8, MOE_N8 = MOE_N8_IN + (size_t)NEXP * 1024 * 1024 / 8, MOE_N8A = (MOE_N8 / 10) * 9;
__device__ __forceinline__ void moe_convert(Frame& F, size_t lo8, size_t hi8, int vw0, int nvw, int vtotal) {
    const size_t vstride = (size_t)vtotal * NTHR;
    for (int vw = 0; vw < nvw; ++vw)
    for (size_t i0 = lo8 + (size_t)(vw0 + vw) * NTHR + F.tid; i0 < hi8; i0 += 4 * vstride) {
        f32x4 a[4], b[4];
#pragma unroll
        for (int u = 0; u < 4; ++u) { const size_t i = i0 + (size_t)u * vstride; if (i < hi8) { const float* s = (i < MOE_N8_IN) ? F.in[I_WMI] + i * 8 : F.in[I_WMO] + (i - MOE_N8_IN) * 8;
            a[u] = __builtin_nontemporal_load((const f32x4*)s); b[u] = __builtin_nontemporal_load((const f32x4*)s + 1); } }
#pragma unroll
        for (int u = 0; u < 4; ++u) { const size_t i = i0 + (size_t)u * vstride; if (i < hi8) { bf16* d = (i < MOE_N8_IN) ? (bf16*)(F.ws + WS_WMI) + i * 8 : (bf16*)(F.ws + WS_WMO) + (i - MOE_N8_IN) * 8;
            *(GAS v4u*)d = pg8::pack8(a[u], b[u]); } } }
}
__device__ __forceinline__ void p0_prologue(Frame& F) {
    const int NW = F.G - NGRP;
    const bool s5wg = (int)blockIdx.x >= NW;
    TPROBE_BEGIN(120);
    if (s5wg) p0_s5_group(F, (int)blockIdx.x - NW);
    TPROBE_END(120);
    TPROBE_BEGIN(121);
    if (!s5wg) {
    LAS float* scr = (LAS float*)(F.lds + F.wave * 16384);
    const int gw = blockIdx.x * NWAVES + F.wave, NGW = NW * NWAVES;
    { float* cosT = (float*)(F.ws + WS_ROPE); float* sinT = cosT + SEQ * 32;
      for (int i = blockIdx.x * NTHR + F.tid; i < SEQ * 32; i += NW * NTHR) { const int pos = i >> 5, k = i & 31;
          const double inv = pow(10000.0, -(double)k / 32.0); const double ang = (double)pos * (double)(float)inv;
          cosT[i] = (float)cos(ang); sinT[i] = (float)sin(ang); } }
    for (int m = gw; m < NTOK; m += NGW) rms_row_to_bf16(F.lane, F.in[I_X] + (size_t)m * DM, F.in[I_N1G], (bf16*)(F.ws + WS_XN) + (size_t)m * DM);
    constexpr int I_IN = 16 * (NIN_PAD / 32), I_GLU = 8 * 16, I_PS = 8 * 32, I_PA = 8 * 32, I_OUT = 16 * 32;
    constexpr int NITEMS = I_IN + I_GLU + I_PS + I_PA + I_OUT;
    auto decode = [&](int it) -> TItem {
        int r = it; const float* W; bf16* WT; int K, N, ndb, map = 0;
        if (r < I_IN) { W = F.in[I_WIN]; K = DM; N = 4432; WT = (bf16*)(F.ws + WS_WIN); ndb = NIN_PAD / 32; map = 1; }
        else if ((r -= I_IN) < I_GLU) { W = F.in[I_WGLU]; K = 512; N = 512; WT = (bf16*)(F.ws + WS_WGLU); ndb = 16; }
        else if ((r -= I_GLU) < I_PS) { W = F.in[I_WPS]; K = 512; N = 1024; WT = (bf16*)(F.ws + WS_WPS); ndb = 32; }
        else if ((r -= I_PS) < I_PA) { W = F.in[I_WPA]; K = 512; N = 1024; WT = (bf16*)(F.ws + WS_WPA); ndb = 32; }
        else { r -= I_PA; W = F.in[I_WOUT]; K = 1024; N = 1024; WT = (bf16*)(F.ws + WS_WOUT); ndb = 32; }
        const int kb = r / ndb, nb = r % ndb, k0 = 64 * kb, n0 = 32 * nb; int sc = n0 + (F.lane & 31); if (map) sc = win_src(sc);
        TItem T; T.src = (sc >= 0) ? W + (size_t)k0 * N + sc : nullptr; T.dst = WT + (size_t)n0 * K + k0; T.N = N; T.K = K; return T; };
    { float tvA[32], tvB[32]; int it = gw;
      if (it < NITEMS) { TItem TA = decode(it); titem_load(TA, tvA, F.lane);
        for (;;) {
            const int it1 = it + NGW; const bool h1 = it1 < NITEMS; TItem TB = TA; if (h1) { TB = decode(it1); titem_load(TB, tvB, F.lane); }
            titem_store(TA, tvA, scr, F.lane); if (!h1) break;
            const int it2 = it1 + NGW; const bool h2 = it2 < NITEMS; if (h2) { TA = decode(it2); titem_load(TA, tvA, F.lane); }
            titem_store(TB, tvB, scr, F.lane); if (!h2) break;
            it = it2; } } }
    }
    TPROBE_END(121);
    TPROBE_BEGIN(122);
    moe_convert(F, 0, MOE_N8A, s5wg ? 4 * NW + 2 * ((int)blockIdx.x - NW) : 4 * (int)blockIdx.x, s5wg ? 2 : 4, 4 * NW + 2 * NGRP);
    TPROBE_END(122);
}

struct StaticOrder {
    int nM, nN, nwg, G, c;
    __device__ void init(int nM_, int nN_, int G_, int c_) { nM = nM_; nN = nN_; nwg = nM * nN; G = G_; c = c_; }
    __device__ bool tile(int i, int& pm, int& pn) const {
        const long L = (long)i * G + c; if (L >= nwg) return false;
        int wgid = (int)L; { const int q = nwg / pg8::NXCD, r = nwg % pg8::NXCD, xcd = wgid % pg8::NXCD, off = wgid / pg8::NXCD; wgid = (xcd < r ? xcd * (q + 1) : r * (q + 1) + (xcd - r) * q) + off; }
        const int nig = pg8::WGM * nN, gid = wgid / nig, fm = gid * pg8::WGM, gsz = (nM - fm) < pg8::WGM ? (nM - fm) : pg8::WGM;
        pm = fm + ((wgid % nig) % gsz); pn = (wgid % nig) / gsz; return true;
    }
    __device__ bool next(int i, pg8::Unit& u) const { int pm, pn; if (!tile(i, pm, pn)) return false; u.pm = pm; u.pn = pn; u.pa = pm; u.pb = pn; u.e = 0; return true; }
    __device__ __forceinline__ int arow(const pg8::Unit& u, int h, int R) const { return u.pa * 256 + h * 128 + R; }
    __device__ __forceinline__ void done(const pg8::Unit&) const {}
    __device__ __forceinline__ int probe_id() const { return 210; }
};
__device__ __forceinline__ void wg_wait_ge(Frame& F, int word, unsigned target) {
    if (F.tid == 0) { unsigned sp = 0;
        while (__hip_atomic_load((unsigned*)(F.ctl + word), RLX_AGENT) < target) { __builtin_amdgcn_s_sleep(2); if (++sp > (1u << 22)) { __hip_atomic_store((unsigned*)(F.ctl + CW_TMO), 1u, RLX_AGENT); break; } }
        __builtin_amdgcn_fence(__ATOMIC_ACQUIRE, "agent"); asm volatile("s_waitcnt vmcnt(0)" ::: "memory"); }
    __syncthreads();
}
__device__ __forceinline__ void wg_signal(Frame& F, int word) {
    asm volatile("s_waitcnt vmcnt(0)" ::: "memory"); __syncthreads();
    if (F.tid == 0) { __builtin_amdgcn_fence(__ATOMIC_RELEASE, "agent"); asm volatile("s_waitcnt vmcnt(0)" ::: "memory"); (void)__hip_atomic_fetch_add((unsigned*)(F.ctl + word), 1u, RLX_AGENT); }
}
struct InProjOrder {
    int G, c; unsigned* udone;
    __device__ bool next(int i, pg8::Unit& u) const { const int L = i * G + c; if (L >= 64 * (NIN_PAD / 256)) return false; u.pm = L & 63; u.pn = L >> 6; u.pa = u.pm; u.pb = u.pn; u.e = 0; return true; }
    __device__ __forceinline__ int arow(const pg8::Unit& u, int h, int R) const { return u.pa * 256 + h * 128 + R; }
    __device__ __forceinline__ void done(const pg8::Unit& u) const {
        if (u.pn < 2) { asm volatile("s_waitcnt vmcnt(0)" ::: "memory");
            if ((threadIdx.x & 63) == 0) (void)__hip_atomic_fetch_add(udone, 1u, RLX_AGENT); } }
    __device__ __forceinline__ int probe_id() const { return 211; }
};
struct S5StateOrder {
    int c;
    __device__ bool next(int i, pg8::Unit& u) const { if (i > 0 || c >= 64) return false; const int g = c >> 1, pm = c & 1; u.pm = pm; u.pn = 0; u.pa = g * 2 + pm; u.pb = g; u.e = g; return true; }
    __device__ __forceinline__ int arow(const pg8::Unit& u, int h, int R) const { return u.pa * 256 + h * 128 + R; }
    __device__ __forceinline__ void done(const pg8::Unit&) const {}
    __device__ __forceinline__ int probe_id() const { return 212; }
};
struct S5YOrder {
    int c;
    __device__ bool next(int i, pg8::Unit& u) const { if (i > 0 || c >= 128) return false; const int g = c >> 2, pm = (c >> 1) & 1, pn = c & 1; u.pm = pm; u.pn = pn; u.pa = g * 2 + pm; u.pb = g * 2 + pn; u.e = g; return true; }
    __device__ __forceinline__ int arow(const pg8::Unit& u, int h, int R) const { return u.pa * 256 + h * 128 + R; }
    __device__ __forceinline__ void done(const pg8::Unit&) const {}
    __device__ __forceinline__ int probe_id() const { return 213; }
};
struct MixOrder {
    StaticOrder so;
    __device__ bool next(int i, pg8::Unit& u) const { int pm, pn; if (!so.tile(i >> 1, pm, pn)) return false; const int h = i & 1; u.pm = pm; u.pn = pn; u.pa = pm + 64 * h; u.pb = pn + 4 * h; u.e = h; return true; }
    __device__ __forceinline__ int arow(const pg8::Unit& u, int h, int R) const { return u.pa * 256 + h * 128 + R; }
    __device__ __forceinline__ void done(const pg8::Unit&) const {}
    __device__ __forceinline__ int probe_id() const { return 214; }
};
struct MoeOrder {
    const volatile LAS int* te; const volatile LAS int* off; const volatile LAS int* cnt; const int* rowmap; int TT, NTN, c;
    __device__ bool next(int i, pg8::Unit& u) const {
        const int xcd = c & 7, j = c >> 3, mpx = 32 / NTN; const int mt = i * (8 * mpx) + xcd * mpx + j / NTN, pn = j % NTN;
        if (mt >= TT) return false; const int e = te[mt]; u.pm = mt; u.pn = pn; u.pa = mt; u.pb = e * NTN + pn; u.e = e; return true; }
    __device__ __forceinline__ int arow(const pg8::Unit& u, int h, int R) const {
        if (!rowmap) return u.pa * 256 + h * 128 + R;
        const int lr = u.pm * 256 - off[u.e] + h * 128 + R;
        return lr < cnt[u.e] ? rowmap[(size_t)u.e * NTOK + lr] : 0; }
    __device__ __forceinline__ void done(const pg8::Unit&) const {}
    __device__ __forceinline__ int probe_id() const { return 215; }
};

using pg8::f32x2; using pg8::u32x2; using pg8::pack8; using pg8::cvt_pk_bf16;
#define EPI_ROWS_BEGIN _Pragma("unroll") for (int ai = 0; ai < 2; ++ai) _Pragma("unroll") for (int m = 0; m < 4; ++m) { asm volatile("" ::: "memory"); const int row = u.pm * 256 + ai * 128 + wr * 64 + m * 16 + fr; (void)row;
#define EPI_COLS_BEGIN _Pragma("unroll") for (int bj = 0; bj < 2; ++bj) { const int ct = bj * 128 + wc * 32 + fq * 8; (void)ct; f32x4 v0 = acc[ai][bj][m][0], v1 = acc[ai][bj][m][1];
#define EPI_END } }
#define EPI_FENCE asm volatile("" ::: "memory")
#define EPI_ALLROWS _Pragma("unroll") for (int ai = 0; ai < 2; ++ai) _Pragma("unroll") for (int m = 0; m < 4; ++m)
#define EPI_ROW(ai, m) (u.pm * 256 + (ai) * 128 + wr * 64 + (m) * 16 + fr)
struct EpiInProj {
    static constexpr bool PERM = true;
    unsigned char* ws; const float* bgate;
    __device__ __forceinline__ void rope(f32x4& v0, f32x4& v1, const f32x4& c, const f32x4& s) const { const f32x4 o1 = v0 * c - v1 * s, o2 = v1 * c + v0 * s; v0 = o1; v1 = o2; }
    __device__ __forceinline__ unsigned pk8(const f32x4& v) const { unsigned w = 0; w = __builtin_amdgcn_cvt_pk_fp8_f32(v[0], v[1], w, false); w = __builtin_amdgcn_cvt_pk_fp8_f32(v[2], v[3], w, true); return w; }
    __device__ __forceinline__ void store_rope8(unsigned off, const f32x4& o1, const f32x4& o2) const { *(GAS unsigned*)(ws + off) = pk8(o1); *(GAS unsigned*)(ws + off + 32u) = pk8(o2); }
    __device__ __forceinline__ void store_rope(unsigned off, const f32x4& o1, const f32x4& o2) const {
        u32x2 a, b; a.x = cvt_pk_bf16(o1[0], o1[1]); a.y = cvt_pk_bf16(o1[2], o1[3]); b.x = cvt_pk_bf16(o2[0], o2[1]); b.y = cvt_pk_bf16(o2[2], o2[3]);
        *(GAS u32x2*)(ws + off) = a; *(GAS u32x2*)(ws + off + 64u) = b;
    }
    __device__ __forceinline__ void operator()(const f32x4 (&acc)[2][2][4][2], const pg8::Unit& u, int wr, int wc, int fr, int fq) const {
        asm volatile("" : "+v"(fr), "+v"(fq));
        const int pn = u.pn;
        f32x4 rc[2][4], rs[2][4];
        if (pn >= 2 && pn <= 9) { const int a = (wc & 1) * 4 + fq;
            EPI_ALLROWS { const unsigned o = (unsigned)WS_ROPE + (unsigned)((EPI_ROW(ai, m) & 4095) * 32 + 4 * a) * 4u; rc[ai][m] = *(const GAS f32x4*)(ws + o); rs[ai][m] = *(const GAS f32x4*)(ws + o + (unsigned)(SEQ * 32 * 4)); }
            EPI_FENCE; }
        if (pn < 2) {
            EPI_ROWS_BEGIN const int bb = row >> 12, cc = (row >> 5) & 127, sp = row & 31;
            EPI_COLS_BEGIN const int col = pn * 256 + ct, g = col >> 4, h0 = col & 15;
                { const unsigned uo_ = (unsigned)WS_UGX + (unsigned)((g * 512 + bb * 128 + cc) * UGX_LD + sp * 16 + h0) * 2u; const pg8::u32x4 ud_ = pack8(v0, v1);
                  asm volatile("global_store_dwordx4 %0, %1, %2 sc0 sc1\n\ts_nop 1" :: "v"(uo_), "v"(ud_), "s"(ws) : "memory"); }
            EPI_END
        } else if (pn < 4) {
            EPI_ROWS_BEGIN
            EPI_COLS_BEGIN const int j = (pn - 2) * 256 + ct, head = j >> 6, a = (j & 63) >> 3;
                rope(v0, v1, rc[ai][m], rs[ai][m]); store_rope8((unsigned)WS_Q + (unsigned)(row * 512 + head * 64 + 4 * a), v0, v1);
            EPI_END
        } else if (pn == 4) {
            EPI_ROWS_BEGIN
            EPI_COLS_BEGIN
                if (bj == 0) { const int head = ct >> 6, a = (ct & 63) >> 3; rope(v0, v1, rc[ai][m], rs[ai][m]); store_rope8((unsigned)WS_K + (unsigned)(row * 128 + head * 64 + 4 * a), v0, v1); }
                else { u32x2 w8; w8.x = pk8(v0); w8.y = pk8(v1); *(GAS u32x2*)(ws + ((unsigned)WS_V + (unsigned)(row * 128 + (ct - 128)))) = w8; }
            EPI_END
        } else if (pn < 9) {
            EPI_ROWS_BEGIN
            EPI_COLS_BEGIN const int j = (pn - 5) * 256 + ct, head = j >> 6, a = (j & 63) >> 3;
                rope(v0, v1, rc[ai][m], rs[ai][m]); store_rope((unsigned)WS_QI + (unsigned)(row * 1024 + head * 64 + 4 * a) * 2u, v0, v1);
            EPI_END
        } else if (pn == 9) {
            EPI_ROWS_BEGIN
            EPI_COLS_BEGIN
                if (bj == 0) { if (ct < 64) { const int a = ct >> 3; rope(v0, v1, rc[ai][m], rs[ai][m]); store_rope((unsigned)WS_KI + (unsigned)(row * 64 + 4 * a) * 2u, v0, v1); }
                    else if (ct < 80) { const unsigned o = (unsigned)WS_WI + (unsigned)(row * 16 + (ct - 64)) * 4u; *(GAS f32x4*)(ws + o) = v0 * 0.03125f; *(GAS f32x4*)(ws + o + 16u) = v1 * 0.03125f; } }
            EPI_END
        } else {
            const int br = pn >= 14; const unsigned gbase = br ? (unsigned)WS_GA : (unsigned)WS_GS; const float* bgp = bgate + br * 1024 + (pn - (br ? 14 : 10)) * 256 + wc * 32 + fq * 8;
            f32x4 bb[2][2];
#pragma unroll
            for (int bj = 0; bj < 2; ++bj) { bb[bj][0] = *(const GAS f32x4*)(bgp + bj * 128); bb[bj][1] = *(const GAS f32x4*)(bgp + bj * 128 + 4); }
            EPI_ROWS_BEGIN
            EPI_COLS_BEGIN const int col = (pn - (br ? 14 : 10)) * 256 + ct;
#pragma unroll
                for (int j = 0; j < 4; ++j) { v0[j] = sigmoidf_(v0[j] + bb[bj][0][j]); v1[j] = sigmoidf_(v1[j] + bb[bj][1][j]); }
                *(GAS v4u*)(ws + (gbase + (unsigned)(row * 1024 + col) * 2u)) = pack8(v0, v1);
            EPI_END
        }
    }
};
struct EpiS5State {
    static constexpr bool PERM = true;
    float* SB;
    __device__ __forceinline__ void operator()(const f32x4 (&acc)[2][2][4][2], const pg8::Unit& u, int wr, int wc, int fr, int fq) const {
        EPI_ROWS_BEGIN
        EPI_COLS_BEGIN
            if (bj == 0) { float* d = SB + ((size_t)u.e * 512 + row) * 128 + ct; *(GAS f32x4*)d = v0; *(GAS f32x4*)(d + 4) = v1; }
        EPI_END
    }
};
struct EpiS5Y {
    static constexpr bool PERM = true;
    const bf16* UGX; const float* Dsk; bf16* YG;
    __device__ __forceinline__ void operator()(const f32x4 (&acc)[2][2][4][2], const pg8::Unit& u, int wr, int wc, int fr, int fq) const {
        const int g = u.e;
        const f32x4 d0 = *(const GAS f32x4*)(Dsk + g * 16 + ((fq * 8) & 15)), d1 = *(const GAS f32x4*)(Dsk + g * 16 + ((fq * 8) & 15) + 4);
        v4u ux[2][4][2];
        EPI_ALLROWS {
#pragma unroll
            for (int bj = 0; bj < 2; ++bj) ux[ai][m][bj] = *(const GAS v4u*)(UGX + ((size_t)g * 512 + EPI_ROW(ai, m)) * UGX_LD + u.pn * 256 + bj * 128 + wc * 32 + fq * 8); }
        EPI_FENCE;
        EPI_ROWS_BEGIN const int bb = row >> 7, cc = row & 127;
        EPI_COLS_BEGIN const int n = u.pn * 256 + ct, tp = n >> 4, h0 = n & 15;
            const v4u uu = ux[ai][m][bj];
            v0[0] += d0[0] * bflo(uu.x); v0[1] += d0[1] * bfhi(uu.x); v0[2] += d0[2] * bflo(uu.y); v0[3] += d0[3] * bfhi(uu.y);
            v1[0] += d1[0] * bflo(uu.z); v1[1] += d1[1] * bfhi(uu.z); v1[2] += d1[2] * bflo(uu.w); v1[3] += d1[3] * bfhi(uu.w);
#pragma unroll
            for (int j = 0; j < 4; ++j) { v0[j] = gelu_tanh(v0[j]); v1[j] = gelu_tanh(v1[j]); }
            const int tok = bb * 4096 + cc * 32 + tp;
            *(GAS v4u*)(YG + (size_t)tok * 512 + g * 16 + h0) = pack8(v0, v1);
        EPI_END
    }
};
struct EpiGlu {
    static constexpr bool PERM = true;
    const bf16* YG; const float* bglu; bf16* YS;
    __device__ __forceinline__ void operator()(const f32x4 (&acc)[2][2][4][2], const pg8::Unit& u, int wr, int wc, int fr, int fq) const {
        f32x4 bb[2][2]; v4u yx[2][4][2];
#pragma unroll
        for (int bj = 0; bj < 2; ++bj) { const float* bp = bglu + u.pn * 256 + bj * 128 + wc * 32 + fq * 8; bb[bj][0] = *(const GAS f32x4*)bp; bb[bj][1] = *(const GAS f32x4*)(bp + 4); }
        EPI_ALLROWS {
#pragma unroll
            for (int bj = 0; bj < 2; ++bj) yx[ai][m][bj] = *(const GAS v4u*)(YG + (size_t)EPI_ROW(ai, m) * 512 + u.pn * 256 + bj * 128 + wc * 32 + fq * 8); }
        EPI_FENCE;
        EPI_ROWS_BEGIN
        EPI_COLS_BEGIN const int col = u.pn * 256 + ct;
            const v4u yy = yx[ai][m][bj];
            const f32x4 b0 = bb[bj][0], b1 = bb[bj][1];
            v0[0] = bflo(yy.x) * sigmoidf_(v0[0] + b0[0]); v0[1] = bfhi(yy.x) * sigmoidf_(v0[1] + b0[1]); v0[2] = bflo(yy.y) * sigmoidf_(v0[2] + b0[2]); v0[3] = bfhi(yy.y) * sigmoidf_(v0[3] + b0[3]);
            v1[0] = bflo(yy.z) * sigmoidf_(v1[0] + b1[0]); v1[1] = bfhi(yy.z) * sigmoidf_(v1[1] + b1[1]); v1[2] = bflo(yy.w) * sigmoidf_(v1[2] + b1[2]); v1[3] = bfhi(yy.w) * sigmoidf_(v1[3] + b1[3]);
            *(GAS v4u*)(YS + (size_t)row * 512 + col) = pack8(v0, v1);
        EPI_END
    }
};
struct EpiMix {
    static constexpr bool PERM = true;
    const bf16* GS; const bf16* GA; bf16* MX;
    __device__ __forceinline__ void operator()(const f32x4 (&acc)[2][2][4][2], const pg8::Unit& u, int wr, int wc, int fr, int fq) const {
        const bf16* Gp = u.e ? GA : GS;
        EPI_ROWS_BEGIN
        EPI_COLS_BEGIN const size_t off = (size_t)row * 1024 + u.pn * 256 + ct;
            const v4u gg = *(const GAS v4u*)(Gp + off);
            v0[0] *= bflo(gg.x); v0[1] *= bfhi(gg.x); v0[2] *= bflo(gg.y); v0[3] *= bfhi(gg.y); v1[0] *= bflo(gg.z); v1[1] *= bfhi(gg.z); v1[2] *= bflo(gg.w); v1[3] *= bfhi(gg.w);
            if (u.e) { const v4u pp = *(const GAS v4u*)(MX + off);
                v0[0] += bflo(pp.x); v0[1] += bfhi(pp.x); v0[2] += bflo(pp.y); v0[3] += bfhi(pp.y); v1[0] += bflo(pp.z); v1[1] += bfhi(pp.z); v1[2] += bflo(pp.w); v1[3] += bfhi(pp.w); }
            *(GAS v4u*)(MX + off) = pack8(v0, v1);
        EPI_END
    }
};
struct EpiOut {
    static constexpr bool PERM = true;
    const float* X; float* X1;
    __device__ __forceinline__ void operator()(const f32x4 (&acc)[2][2][4][2], const pg8::Unit& u, int wr, int wc, int fr, int fq) const {
        f32x4 xr[4][2][2];
#pragma unroll
        for (int m = 0; m < 4; ++m)
#pragma unroll
            for (int bj = 0; bj < 2; ++bj) { const float* xp = X + (size_t)EPI_ROW(0, m) * 1024 + u.pn * 256 + bj * 128 + wc * 32 + fq * 8; xr[m][bj][0] = *(const GAS f32x4*)xp; xr[m][bj][1] = *(const GAS f32x4*)(xp + 4); }
        EPI_FENCE;
        EPI_ROWS_BEGIN
        EPI_COLS_BEGIN const size_t off = (size_t)row * 1024 + u.pn * 256 + ct;
            *(GAS f32x4*)(X1 + off) = v0 + xr[m][bj][0]; *(GAS f32x4*)(X1 + off + 4) = v1 + xr[m][bj][1];
            if (ai == 0) { const float* xp = X + off + (size_t)128 * 1024; xr[m][bj][0] = *(const GAS f32x4*)xp; xr[m][bj][1] = *(const GAS f32x4*)(xp + 4); }
        EPI_END
    }
};
struct EpiMoe1 {
    static constexpr bool PERM = true;
    const float* bmi; bf16* ACT;
    __device__ __forceinline__ void operator()(const f32x4 (&acc)[2][2][4][2], const pg8::Unit& u, int wr, int wc, int fr, int fq) const {
        const float* bp = bmi + (size_t)u.e * 2048 + u.pn * 256 + wc * 32 + fq * 8;
        f32x4 bb[2][2];
#pragma unroll
        for (int bj = 0; bj < 2; ++bj) { bb[bj][0] = *(const GAS f32x4*)(bp + bj * 128); bb[bj][1] = *(const GAS f32x4*)(bp + bj * 128 + 4); }
        EPI_ROWS_BEGIN
        EPI_COLS_BEGIN const int col = u.pn * 256 + ct;
            v0 += bb[bj][0]; v1 += bb[bj][1]; float o[4];
#pragma unroll
            for (int j = 0; j < 4; ++j) { const float zg0 = (j < 2) ? v0[2 * j] : v1[2 * j - 4], zl0 = (j < 2) ? v0[2 * j + 1] : v1[2 * j - 3];
                const float zg = fminf(zg0, 7.0f), zl = fminf(fmaxf(zl0, -7.0f), 7.0f); o[j] = zg * __builtin_amdgcn_rcpf(1.0f + __builtin_amdgcn_exp2f(-2.4554669595930157f * zg)) * (zl + 1.0f); }
            u32x2 w; w.x = cvt_pk_bf16(o[0], o[1]); w.y = cvt_pk_bf16(o[2], o[3]);
            *(GAS u32x2*)(ACT + (size_t)row * 1024 + (col >> 1)) = w;
        EPI_END
    }
};
struct EpiMoe2 {
    static constexpr bool PERM = true;
    const float* bmo; bf16* Y2;
    __device__ __forceinline__ void operator()(const f32x4 (&acc)[2][2][4][2], const pg8::Unit& u, int wr, int wc, int fr, int fq) const {
        const float* bp = bmo + (size_t)u.e * 1024 + u.pn * 256 + wc * 32 + fq * 8;
        f32x4 bb[2][2];
#pragma unroll
        for (int bj = 0; bj < 2; ++bj) { bb[bj][0] = *(const GAS f32x4*)(bp + bj * 128); bb[bj][1] = *(const GAS f32x4*)(bp + bj * 128 + 4); }
        EPI_ROWS_BEGIN
        EPI_COLS_BEGIN const int col = u.pn * 256 + ct;
            v0 += bb[bj][0]; v1 += bb[bj][1];
            *(GAS v4u*)(Y2 + (size_t)row * 1024 + col) = pack8(v0, v1);
        EPI_END
    }
};

__device__ __forceinline__ unsigned f16key(unsigned bits) { return (bits & 0x8000u) ? (bits ^ 0xffffu) : (bits | 0x8000u); }
__device__ __forceinline__ void idx_phase(Frame& F) {
    LAS unsigned char* lds = F.lds;
    LAS u16* SC = (LAS u16*)lds;
    LAS unsigned char* KT = lds + 65536;
    LAS unsigned* HP = (LAS unsigned*)(lds + 147456);
    LAS unsigned char* OLB = lds + 147456 + 4096;
    const bf16* QI = (const bf16*)(F.ws + WS_QI); const bf16* KI = (const bf16*)(F.ws + WS_KI); const float* WI = (const float*)(F.ws + WS_WI);
    u16* SEL = (u16*)(F.ws + WS_SEL);
    const int tid = F.tid, lane = F.lane, wave = F.wave, qg = wave & 1, kq = wave >> 1, kgrp = lane >> 4, l15 = lane & 15;
    const int kx = l15 >> 1, cpos = lane & 7;
    const int dsw = ((wave & 1) * 4 + (lane >> 4)) & 7;
    bf16x8 qa[4][2]; float w[16];
#define IDX_UNIT(r_, b_, t0_) const int b_ = (r_) >> 1, t0_ = (((r_) & 1) ? 511 - (int)blockIdx.x : (int)blockIdx.x) * 8
#define IDX_DMA(kb_, st, bufi) do { _Pragma("unroll") for (int j_ = 0; j_ < 2; ++j_) { const int row_ = (j_ * 8 + wave) * 8 + (lane >> 3); \
        __builtin_amdgcn_global_load_lds((const unsigned*)((kb_) + ((size_t)(st) * 128 + row_) * 64 + ((cpos ^ dsw) << 3)), (LAS unsigned*)(KT + (bufi) * 16384 + (j_ * 8 + wave) * 1024), 16, 0, 0); } } while (0)
#define IDX_PREFETCH(r_) do { IDX_UNIT(r_, pb_, pt0_); if (pt0_ >= 256) { \
        const bf16* qp_ = QI + ((size_t)pb_ * SEQ + pt0_ + 4 * qg + (l15 >> 2)) * 1024 + (l15 & 3) * 64 + kgrp * 8; \
        _Pragma("unroll") for (int i = 0; i < 4; ++i) _Pragma("unroll") for (int ks = 0; ks < 2; ++ks) qa[i][ks] = *(const GAS bf16x8*)(qp_ + i * 256 + ks * 32); \
        const float* wp_ = WI + ((size_t)pb_ * SEQ + pt0_ + 4 * qg + kgrp) * 16; \
        _Pragma("unroll") for (int i = 0; i < 4; ++i) { const f32x4 x = *(const GAS f32x4*)(wp_ + 4 * i); w[4 * i] = x[0]; w[4 * i + 1] = x[1]; w[4 * i + 2] = x[2]; w[4 * i + 3] = x[3]; } \
        const bf16* pk_ = KI + (size_t)pb_ * SEQ * 64; const int pn_ = (pt0_ + 7) / 128 + 1; \
        IDX_DMA(pk_, 0, 0); if (1 < pn_) IDX_DMA(pk_, 1, 1); if (2 < pn_) IDX_DMA(pk_, 2, 2); if (3 < pn_) IDX_DMA(pk_, 3, 3); } } while (0)
    IDX_PREFETCH(0);
    for (int r = 0; r < 8; ++r) {
        IDX_UNIT(r, b, t0);
        __syncthreads();
        const int t = t0 + wave; const size_t tok = (size_t)b * SEQ + t;
        if (t0 < 256) {
            v2u x; const int k0 = lane * 4;
            x.x = (unsigned)(k0 <= t ? k0 : 0) | ((unsigned)(k0 + 1 <= t ? k0 + 1 : 0) << 16); x.y = (unsigned)(k0 + 2 <= t ? k0 + 2 : 0) | ((unsigned)(k0 + 3 <= t ? k0 + 3 : 0) << 16);
            *(GAS v2u*)(SEL + tok * NSEL + k0) = x;
            if (r + 1 < 8) IDX_PREFETCH(r + 1);
            continue;
        }
        HP[tid * 2] = 0u; HP[tid * 2 + 1] = 0u;
        const int nst = (t0 + 7) / 128 + 1;
        const int tq = t0 + 4 * qg + kgrp, qrow = 4 * qg + kgrp;
        const bf16* kbat = KI + (size_t)b * SEQ * 64;
        const unsigned hpq = (unsigned)(unsigned long)(HP + qrow * 128);
#define IDX_EPI1(kgl_, AC) do { float s0 = 0.f; \
            _Pragma("unroll") for (int i = 0; i < 4; ++i) _Pragma("unroll") for (int r_ = 0; r_ < 4; ++r_) { const float a0_ = AC[i][r_]; const int i0 = __builtin_bit_cast(int, a0_); const float m0 = __builtin_bit_cast(float, i0 > 0 ? i0 : 0); s0 += w[4 * i + r_] * m0; } \
            const _Float16 h0_ = (_Float16)s0; const unsigned key0_ = f16key(__builtin_bit_cast(unsigned short, h0_)); const int kg0 = (kgl_); \
            SC[qrow * 4096 + kg0] = (u16)key0_; \
            if (kg0 <= tq) { const unsigned bin = key0_ >> 8; const unsigned ha_ = hpq + ((bin >> 1) << 2), hv_ = (bin & 1u) ? 0x10000u : 1u; \
                asm volatile("ds_add_u32 %0, %1" :: "v"(ha_), "v"(hv_) : "memory"); } } while (0)
#define IDX_READ(BQ, kt2) do { _Pragma("unroll") for (int ks = 0; ks < 2; ++ks) BQ[ks] = *(const LAS bf16x8*)(kb + (kq * 32 + (kt2) * 16 + l15) * 128 + (((ks * 4 + kgrp) ^ kx) << 4)); } while (0)
#define IDX_MMA(AC, BQ) do { _Pragma("unroll") for (int i = 0; i < 4; ++i) { AC[i] = (f32x4){0.f, 0.f, 0.f, 0.f}; _Pragma("unroll") for (int ks = 0; ks < 2; ++ks) AC[i] = __builtin_amdgcn_mfma_f32_16x16x32_bf16(qa[i][ks], BQ[ks], AC[i], 0, 0, 0); } } while (0)
        bf16x8 bq0[2], bq1[2];
        f32x4 aA[4], aB[4];
#pragma unroll
        for (int i = 0; i < 4; ++i) { aA[i] = (f32x4){0.f, 0.f, 0.f, 0.f}; aB[i] = aA[i]; }
        int bcur = 0, bnew = 4;
        TPROBE_BEGIN(100);
        for (int st = 0; st < nst; ++st) {
            if (st + 3 < nst) asm volatile("s_waitcnt vmcnt(6)" ::: "memory"); else asm volatile("s_waitcnt vmcnt(0)" ::: "memory");
            __syncthreads();
            if (st + 4 < nst) IDX_DMA(kbat, st + 4, bnew);
            const LAS unsigned char* kb = KT + bcur * 16384;
            const int kbase_ = st * 128 + kq * 32 + l15;
            IDX_READ(bq0, 0);
            IDX_READ(bq1, 1); IDX_MMA(aA, bq0); if (st >= 1) IDX_EPI1(kbase_ - 128 + 16, aB);
            IDX_MMA(aB, bq1); IDX_EPI1(kbase_, aA);
            bcur = (bcur == 4) ? 0 : bcur + 1; bnew = (bnew == 4) ? 0 : bnew + 1;
        }
        IDX_EPI1((nst - 1) * 128 + kq * 32 + l15 + 16, aB);
#undef IDX_EPI1
#undef IDX_MMA
#undef IDX_READ
        __syncthreads();
        TPROBE_END(100);
        TPROBE_BEGIN(101);
        TPROBE_BEGIN(110);
        if (r + 1 < 8) IDX_PREFETCH(r + 1);
        const int n = t + 1, jj = lane, ql = wave;
        const LAS u16* sc = SC + ql * 4096;
        LAS unsigned* hp = HP + ql * 128;
        unsigned b1, need1;
        { const v2u wv = *(const LAS v2u*)(hp + 126 - 2 * jj); unsigned hb[4];
          hb[3] = wv.x & 0xffffu; hb[2] = wv.x >> 16; hb[1] = wv.y & 0xffffu; hb[0] = wv.y >> 16;
          const unsigned s4 = hb[0] + hb[1] + hb[2] + hb[3];
          unsigned pre = s4;
#pragma unroll
          for (int o = 1; o < 64; o <<= 1) { const unsigned x = __shfl_up(pre, o, 64); if (jj >= o) pre += x; }
          const unsigned long long bal = __ballot(pre >= 256u); const int js = __builtin_ctzll(bal);
          unsigned above = pre - s4, bb1 = 0, nd1 = 0; bool found = false;
#pragma unroll
          for (int i = 0; i < 4; ++i) { if (!found) { if (above + hb[i] >= 256u) { bb1 = 255 - (jj * 4 + i); nd1 = 256u - above; found = true; } else above += hb[i]; } }
          b1 = __shfl(bb1, js); need1 = __shfl(nd1, js); }
        TPROBE_END(110);
        TPROBE_BEGIN(111);
        LDS_WAIT(); __builtin_amdgcn_wave_barrier();
#define LDS_ST32(addr_, val_) asm volatile("ds_write_b32 %0, %1" :: "v"((unsigned)(addr_)), "v"((unsigned)(val_)) : "memory")
#define LDS_ST16(addr_, val_) asm volatile("ds_write_b16 %0, %1" :: "v"((unsigned)(addr_)), "v"((unsigned)(val_)) : "memory")
#define LDS_ADD32(addr_, val_) asm volatile("ds_add_u32 %0, %1" :: "v"((unsigned)(addr_)), "v"((unsigned)(val_)) : "memory")
        const unsigned hpw = (unsigned)(unsigned long)hp, scw = (unsigned)(unsigned long)sc;
        LDS_ST32(hpw + jj * 8, 0u); LDS_ST32(hpw + jj * 8 + 4, 0u);
        const int nit = (n + 511) >> 9;
        { const int base = (nit - 1) * 512 + jj * 8;
#pragma unroll
          for (int e = 0; e < 8; ++e) if (base + e >= n) LDS_ST16(scw + (base + e) * 2, 0u); }
        LDS_WAIT(); __builtin_amdgcn_wave_barrier();
        const unsigned B1 = b1 | (b1 << 16);
#pragma unroll 4
        for (int it = 0; it < nit; ++it) { const int base = it * 512 + jj * 8; const v4u x = *(const LAS v4u*)(sc + base);
#pragma unroll
            for (int i = 0; i < 4; ++i) { const unsigned d = (i == 0) ? x.x : (i == 1) ? x.y : (i == 2) ? x.z : x.w; const unsigned m = ((d >> 8) & 0x00ff00ffu) ^ B1;
                const unsigned l0 = d & 255u, l1 = (d >> 16) & 255u;
                LDS_ADD32(hpw + ((l0 >> 1) << 2), ((m & 0xffffu) == 0u) ? ((l0 & 1u) ? 0x10000u : 1u) : 0u);
                LDS_ADD32(hpw + ((l1 >> 1) << 2), ((m >> 16) == 0u) ? ((l1 & 1u) ? 0x10000u : 1u) : 0u); } }
        LDS_WAIT(); __builtin_amdgcn_wave_barrier();
        TPROBE_END(111);
        TPROBE_BEGIN(112);
        unsigned T, need2;
        { const v2u wv = *(const LAS v2u*)(hp + 126 - 2 * jj); unsigned hb[4];
          hb[3] = wv.x & 0xffffu; hb[2] = wv.x >> 16; hb[1] = wv.y & 0xffffu; hb[0] = wv.y >> 16;
          const unsigned s4 = hb[0] + hb[1] + hb[2] + hb[3];
          unsigned pre = s4;
#pragma unroll
          for (int o = 1; o < 64; o <<= 1) { const unsigned x = __shfl_up(pre, o, 64); if (jj >= o) pre += x; }
          const unsigned long long bal = __ballot(pre >= need1); const int js = __builtin_ctzll(bal);
          unsigned above = pre - s4, bb2 = 0, nd2 = 0; bool found = false;
#pragma unroll
          for (int i = 0; i < 4; ++i) { if (!found) { if (above + hb[i] >= need1) { bb2 = 255 - (jj * 4 + i); nd2 = need1 - above; found = true; } else above += hb[i]; } }
          const unsigned b2 = __shfl(bb2, js); need2 = __shfl(nd2, js); T = (b1 << 8) | b2; }
        TPROBE_END(112);
        TPROBE_BEGIN(113);
        const unsigned olw = (unsigned)(unsigned long)(OLB + ql * 512);
        const unsigned G = 256u - need2, Tp = T | (T << 16); unsigned cg = 0, tc = 0;
#pragma unroll 2
        for (int it = 0; it < nit; ++it) { const int base = it * 512 + jj * 8; const v4u x = *(const LAS v4u*)(sc + base);
            unsigned g[8], c = 0, anyeq = 0;
#pragma unroll
            for (int i = 0; i < 4; ++i) { const unsigned d = (i == 0) ? x.x : (i == 1) ? x.y : (i == 2) ? x.z : x.w;
                g[2 * i] = ((d & 0xffffu) > T) ? 1u : 0u; g[2 * i + 1] = ((d >> 16) > T) ? 1u : 0u; c += g[2 * i] + g[2 * i + 1];
                const unsigned q = d ^ Tp; anyeq |= (((q & 0xffffu) == 0u) || ((q >> 16) == 0u)) ? 1u : 0u; }
            const unsigned long long m0 = __ballot(c & 1u), m1 = __ballot(c & 2u), m2 = __ballot(c & 4u), m3 = __ballot(c & 8u);
            unsigned pos = cg + __builtin_amdgcn_mbcnt_hi((unsigned)(m0 >> 32), __builtin_amdgcn_mbcnt_lo((unsigned)m0, 0u)) + 2u * __builtin_amdgcn_mbcnt_hi((unsigned)(m1 >> 32), __builtin_amdgcn_mbcnt_lo((unsigned)m1, 0u))
                         + 4u * __builtin_amdgcn_mbcnt_hi((unsigned)(m2 >> 32), __builtin_amdgcn_mbcnt_lo((unsigned)m2, 0u)) + 8u * __builtin_amdgcn_mbcnt_hi((unsigned)(m3 >> 32), __builtin_amdgcn_mbcnt_lo((unsigned)m3, 0u));
            cg += (unsigned)__builtin_popcountll(m0) + 2u * (unsigned)__builtin_popcountll(m1) + 4u * (unsigned)__builtin_popcountll(m2) + 8u * (unsigned)__builtin_popcountll(m3);
#pragma unroll
            for (int e = 0; e < 8; ++e) { const unsigned a_ = olw + ((pos < 256u ? pos : 255u) << 1); if (g[e]) LDS_ST16(a_, base + e); pos += g[e]; }
            if (__ballot(anyeq) != 0ull) {
#pragma unroll
                for (int e = 0; e < 8; ++e) { const unsigned wd = (e < 2) ? x.x : (e < 4) ? x.y : (e < 6) ? x.z : x.w; const unsigned k = (e & 1) ? (wd >> 16) : (wd & 0xffffu);
                    const bool eq = k == T; const unsigned long long me = __ballot(eq);
                    const unsigned pe = tc + __builtin_amdgcn_mbcnt_hi((unsigned)(me >> 32), __builtin_amdgcn_mbcnt_lo((unsigned)me, 0u));
                    if (eq && pe < need2) LDS_ST16(olw + ((G + pe) << 1), base + e);
                    tc += (unsigned)__builtin_popcountll(me); } } }
#undef LDS_ST32
#undef LDS_ST16
#undef LDS_ADD32
        LDS_WAIT(); __builtin_amdgcn_wave_barrier();
        { const v2u x = *(const LAS v2u*)((LAS u16*)(OLB + ql * 512) + jj * 4); *(GAS v2u*)(SEL + tok * NSEL + jj * 4) = x; }
        TPROBE_END(113);
        TPROBE_END(101);
    }
#undef IDX_DMA
#undef IDX_PREFETCH
#undef IDX_UNIT
}

__device__ __forceinline__ void carry_phase(Frame& F) {
    const int gid = blockIdx.x * NTHR + F.tid; if (gid >= NGRP * NB * 64) return;
    const int p = gid & 63, b = (gid >> 6) & 3, g = gid >> 8;
    const float* A32 = (const float*)(F.ws + WS_A32) + g * 128; const float ar = A32[p * 2], ai = A32[p * 2 + 1];
    const float* SB = (const float*)(F.ws + WS_SBUF) + ((size_t)g * 512 + b * 128) * 128; bf16* UX = (bf16*)(F.ws + WS_UGX) + ((size_t)g * 512 + b * 128) * UGX_LD;
    float xr = 0.f, xi = 0.f;
    for (int c = 0; c < NCH; ++c) {
        UX[(size_t)c * UGX_LD + 512 + p] = (bf16)f2bf(xr); UX[(size_t)c * UGX_LD + 576 + p] = (bf16)f2bf(xi);
        const float sr = SB[c * 128 + p], si = SB[c * 128 + 64 + p];
        const float nr = ar * xr - ai * xi + sr, ni = ar * xi + ai * xr + si; xr = nr; xi = ni;
    }
}

template <int N> __device__ __forceinline__ void wait_vm() { asm volatile("s_waitcnt vmcnt(%0)" :: "n"(N) : "memory"); }
__device__ __forceinline__ unsigned pk_fp8x4(float a, float b, float c, float d) { unsigned w = 0; w = __builtin_amdgcn_cvt_pk_fp8_f32(a, b, w, false); w = __builtin_amdgcn_cvt_pk_fp8_f32(c, d, w, true); return w; }
__device__ __forceinline__ void attn_phase(Frame& F) {
    constexpr int WSTR = 20224;
    LAS unsigned char* RING = F.lds + F.wave * WSTR;
    LAS u16* SL = (LAS u16*)(RING + 16384);
    const unsigned char* Q8 = F.ws + WS_Q; const unsigned char* K8 = F.ws + WS_K; const unsigned char* V8 = F.ws + WS_V;
    const u16* SEL = (const u16*)(F.ws + WS_SEL); bf16* YA = (bf16*)(F.ws + WS_YATT);
    const int lane = F.lane, gw = blockIdx.x * NWAVES + F.wave;
    const int hd = lane & 15, kg = lane >> 4;
    const int l4 = lane >> 2, cpos = lane & 3;
    int kra[2];
#pragma unroll
    for (int ks = 0; ks < 2; ++ks) kra[ks] = hd * 64 + (((ks * 2 + (kg >> 1)) ^ ((hd >> 2) & 3)) << 4) + (kg & 1) * 8;
    unsigned tra[4];
    { const int r = hd >> 1, c = hd & 1, row = (r >> 2) * 16 + kg * 4 + (r & 3), f = (kg & 1) | ((r >> 2) << 1); const unsigned rb = (unsigned)(unsigned long)RING;
#pragma unroll
      for (int mt = 0; mt < 4; ++mt) tra[mt] = rb + row * 64 + ((mt ^ f) << 4) + c * 8; }
    const bool early = (int)blockIdx.x < 128; const int ew = blockIdx.x * NWAVES + F.wave, nitems = early ? 23 : 9;
    for (int k_ = 0; k_ < nitems; ++k_) { const int it = (k_ < 9) ? gw + 2048 * k_ : 18432 + ew + 1024 * (k_ - 9);
        const int tok = it >> 1, kvh = it & 1, t = tok & 4095; const size_t bbase = (size_t)(tok >> 12) * SEQ;
        const int nsel = (t + 1 < NSEL) ? t + 1 : NSEL;
        { const v2u x = *(const GAS v2u*)(SEL + (size_t)tok * NSEL + lane * 4); *(LAS v2u*)(SL + lane * 4) = x; }
        long qf[2];
#pragma unroll
        for (int ks = 0; ks < 2; ++ks) { if (hd < 4) qf[ks] = *(const GAS long*)(Q8 + (size_t)tok * 512 + (kvh * 4 + hd) * 64 + ks * 32 + kg * 8); else qf[ks] = 0; }
        asm volatile("s_waitcnt vmcnt(0)" : "+v"(qf[0]), "+v"(qf[1]) :: "memory");
        LDS_WAIT(); __builtin_amdgcn_wave_barrier();
        const unsigned char* kbp = K8 + bbase * 128 + kvh * 64; const unsigned char* vbp = V8 + bbase * 128 + kvh * 64;
        f32x4 sc[4][4]; f32x4 oacc[4];
#pragma unroll
        for (int c = 0; c < 4; ++c)
#pragma unroll
            for (int tl = 0; tl < 4; ++tl) sc[c][tl] = (f32x4){0.f, 0.f, 0.f, 0.f};
#pragma unroll
        for (int m = 0; m < 4; ++m) oacc[m] = (f32x4){0.f, 0.f, 0.f, 0.f};
        float inv = 1.0f;
#define ATT_ISSUE(s) do { const int c_ = (s) & 3; const bool isk_ = (s) < 4; const unsigned char* gb_ = isk_ ? kbp : vbp; int sel_[4]; \
            _Pragma("unroll") for (int j_ = 0; j_ < 4; ++j_) { const int ki_ = c_ * 64 + j_ * 16 + l4; sel_[j_] = (int)SL[ki_ < nsel ? ki_ : 0]; } \
            _Pragma("unroll") for (int j_ = 0; j_ < 4; ++j_) { const int f_ = isk_ ? ((l4 >> 2) & 3) : (((l4 >> 2) & 1) | ((j_ & 1) << 1)); \
                __builtin_amdgcn_global_load_lds((const unsigned*)(gb_ + (size_t)sel_[j_] * 128 + ((cpos ^ f_) << 4)), (LAS unsigned*)(RING + ((s) & 3) * 4096 + j_ * 1024), 16, 0, 0); } } while (0)
        ATT_ISSUE(0); ATT_ISSUE(1); ATT_ISSUE(2);
#pragma unroll
        for (int s = 0; s < 8; ++s) {
            if (s + 3 < 8) ATT_ISSUE(s + 3);
            if (s <= 4) wait_vm<12>(); else if (s == 5) wait_vm<8>(); else if (s == 6) wait_vm<4>(); else wait_vm<0>();
            const LAS unsigned char* buf = RING + (s & 3) * 4096;
            if (s < 4) {
#pragma unroll
                for (int tl = 0; tl < 4; ++tl)
#pragma unroll
                    for (int ks = 0; ks < 2; ++ks) { const long af = *(const LAS long*)(buf + tl * 1024 + kra[ks]);
                        sc[s][tl] = __builtin_amdgcn_mfma_f32_16x16x32_fp8_fp8(af, qf[ks], sc[s][tl], 0, 0, 0); }
                if (s == 3) {
                    float mx = -3.0e38f;
#pragma unroll
                    for (int c = 0; c < 4; ++c)
#pragma unroll
                        for (int tl = 0; tl < 4; ++tl)
#pragma unroll
                            for (int r = 0; r < 4; ++r) { const int key = c * 64 + tl * 16 + kg * 4 + r; const float v = (key < nsel) ? sc[c][tl][r] * 0.125f : -3.0e38f; sc[c][tl][r] = v; mx = fmaxf(mx, v); }
                    mx = fmaxf(mx, __shfl_xor(mx, 16)); mx = fmaxf(mx, __shfl_xor(mx, 32));
                    float sum = 0.f;
#pragma unroll
                    for (int c = 0; c < 4; ++c)
#pragma unroll
                        for (int tl = 0; tl < 4; ++tl)
#pragma unroll
                            for (int r = 0; r < 4; ++r) { const float e = __expf(sc[c][tl][r] - mx); sc[c][tl][r] = e; sum += e; }
                    sum += __shfl_xor(sum, 16); sum += __shfl_xor(sum, 32);
                    inv = 1.0f / sum;
                }
            } else {
                const int c = s - 4;
                v2u pw[2];
#pragma unroll
                for (int h2 = 0; h2 < 2; ++h2) { pw[h2].x = pk_fp8x4(sc[c][2 * h2][0], sc[c][2 * h2][1], sc[c][2 * h2][2], sc[c][2 * h2][3]); pw[h2].y = pk_fp8x4(sc[c][2 * h2 + 1][0], sc[c][2 * h2 + 1][1], sc[c][2 * h2 + 1][2], sc[c][2 * h2 + 1][3]); }
                v2u a[8];
                asm volatile("ds_read_b64_tr_b8 %0, %8 offset:%12\n\tds_read_b64_tr_b8 %1, %9 offset:%12\n\tds_read_b64_tr_b8 %2, %10 offset:%12\n\tds_read_b64_tr_b8 %3, %11 offset:%12\n\t"
                             "ds_read_b64_tr_b8 %4, %8 offset:%13\n\tds_read_b64_tr_b8 %5, %9 offset:%13\n\tds_read_b64_tr_b8 %6, %10 offset:%13\n\tds_read_b64_tr_b8 %7, %11 offset:%13\n\ts_waitcnt lgkmcnt(0)"
                             : "=&v"(a[0]), "=&v"(a[1]), "=&v"(a[2]), "=&v"(a[3]), "=&v"(a[4]), "=&v"(a[5]), "=&v"(a[6]), "=&v"(a[7])
                             : "v"(tra[0]), "v"(tra[1]), "v"(tra[2]), "v"(tra[3]), "n"((s & 3) * 4096), "n"((s & 3) * 4096 + 2048) : "memory");
#pragma unroll
                for (int h2 = 0; h2 < 2; ++h2)
#pragma unroll
                    for (int mt = 0; mt < 4; ++mt)
                        oacc[mt] = __builtin_amdgcn_mfma_f32_16x16x32_fp8_fp8(__builtin_bit_cast(long, a[4 * h2 + mt]), __builtin_bit_cast(long, pw[h2]), oacc[mt], 0, 0, 0);
            }
        }
#undef ATT_ISSUE
        if (hd < 4) {
            bf16* yo = YA + (size_t)tok * 512 + (kvh * 4 + hd) * 64 + kg * 4;
#pragma unroll
            for (int mt = 0; mt < 4; ++mt) { pg8::u32x2 w; w.x = pg8::cvt_pk_bf16(oacc[mt][0] * inv, oacc[mt][1] * inv); w.y = pg8::cvt_pk_bf16(oacc[mt][2] * inv, oacc[mt][3] * inv); *(GAS pg8::u32x2*)(yo + 16 * mt) = w; }
        }
        LDS_WAIT(); __builtin_amdgcn_wave_barrier();
    }
}

__device__ __forceinline__ void router_phase(Frame& F) {
    LAS float* HR = (LAS float*)(F.lds);
    LAS float* PT = (LAS float*)(F.lds + 65536);
    LAS int* LE = (LAS int*)(F.lds + 81920);
    LAS int* LP = (LAS int*)(F.lds + 82944);
    LAS unsigned* LC = (LAS unsigned*)(F.lds + 83968);
    const float* X1 = (const float*)(F.ws + WS_X1); bf16* H2 = (bf16*)(F.ws + WS_H2);
    const float* WR = F.in[I_WR]; const float* BR = F.in[I_BR]; const float* G2 = F.in[I_N2G];
    int* TOPE = (int*)(F.ws + WS_TOPE); float* TOPW = (float*)(F.ws + WS_TOPW); int* TOPPOS = (int*)(F.ws + WS_TOPPOS); int* ROWMAP = (int*)(F.ws + WS_ROWMAP);
    const int tid = F.tid, lane = F.lane, wave = F.wave, e = lane & 31, dh = lane >> 5;
    float wr[64];
#pragma unroll
    for (int i = 0; i < 64; ++i) wr[i] = WR[(size_t)(128 * wave + dh * 64 + i) * 32 + e];
    if (tid < 64) LC[tid] = 0u;
    const int tok0 = blockIdx.x * 64;
    f32x4 nv[2][4];
#pragma unroll
    for (int rr = 0; rr < 2; ++rr)
#pragma unroll
        for (int j = 0; j < 4; ++j) nv[rr][j] = ((const GAS f32x4*)(X1 + (size_t)(tok0 + 2 * wave + rr) * DM) + lane)[64 * j];
    for (int bt = 0; bt < 4; ++bt) {
        __syncthreads();
#pragma unroll
        for (int rr = 0; rr < 2; ++rr) { const int lr = 2 * wave + rr, tok = tok0 + bt * 16 + lr;
            const GAS f32x4* gr = (const GAS f32x4*)G2 + lane;
            f32x4 v[4]; float s2 = 0.f;
#pragma unroll
            for (int j = 0; j < 4; ++j) { v[j] = nv[rr][j]; s2 += (v[j].x * v[j].x + v[j].y * v[j].y) + (v[j].z * v[j].z + v[j].w * v[j].w); }
            const float rstd = 1.0f / sqrtf(wave_sum(s2) * (1.f / DM) + RMS_EPS);
            GAS unsigned long long* o8 = (GAS unsigned long long*)(H2 + (size_t)tok * DM) + lane;
#pragma unroll
            for (int j = 0; j < 4; ++j) { const f32x4 gg = gr[64 * j]; const f32x4 h = v[j] * rstd * gg;
                *(LAS f32x4*)(HR + lr * 1024 + 256 * j + 4 * lane) = h;
                o8[64 * j] = (unsigned long long)pk2(h.x, h.y) | ((unsigned long long)pk2(h.z, h.w) << 32); } }
        if (bt + 1 < 4) {
#pragma unroll
            for (int rr = 0; rr < 2; ++rr)
#pragma unroll
                for (int j = 0; j < 4; ++j) nv[rr][j] = ((const GAS f32x4*)(X1 + (size_t)(tok0 + (bt + 1) * 16 + 2 * wave + rr) * DM) + lane)[64 * j];
        }
        __syncthreads();
#pragma unroll 2
        for (int lr = 0; lr < 16; ++lr) { const LAS float* hp = HR + lr * 1024 + 128 * wave + dh * 64; float s = 0.f;
#pragma unroll
            for (int i = 0; i < 16; ++i) { const f32x4 h = *(const LAS f32x4*)(hp + 4 * i); s += h[0] * wr[4 * i] + h[1] * wr[4 * i + 1] + h[2] * wr[4 * i + 2] + h[3] * wr[4 * i + 3]; }
            s += __shfl_xor(s, 32);
            if (dh == 0) PT[(lr * 8 + wave) * 32 + e] = s; }
        __syncthreads();
        { const int lr = 2 * wave + dh, tl = bt * 16 + lr, tok = tok0 + tl; float lg = BR[e];
#pragma unroll
          for (int w8 = 0; w8 < 8; ++w8) lg += PT[(lr * 8 + w8) * 32 + e];
          float cur = lg; float tv[4]; int te[4];
#pragma unroll
          for (int k = 0; k < 4; ++k) { float mv = cur; int mi = e;
#pragma unroll
              for (int o = 1; o < 32; o <<= 1) { const float ov = __shfl_xor(mv, o); const int oi = __shfl_xor(mi, o); if (ov > mv || (ov == mv && oi < mi)) { mv = ov; mi = oi; } }
              tv[k] = mv; te[k] = mi; if (e == mi) cur = -3.0e38f; }
          const float e1 = __expf(tv[1] - tv[0]), e2 = __expf(tv[2] - tv[0]), e3 = __expf(tv[3] - tv[0]); const float inv = 1.0f / (1.0f + e1 + e2 + e3);
          if (e < 4) { const int ex = (e == 0) ? te[0] : (e == 1) ? te[1] : (e == 2) ? te[2] : te[3]; const float wv = ((e == 0) ? 1.0f : (e == 1) ? e1 : (e == 2) ? e2 : e3) * inv;
              TOPE[(size_t)tok * 4 + e] = ex; TOPW[(size_t)tok * 4 + e] = wv; LE[tl * 4 + e] = ex; LP[tl * 4 + e] = (int)atomicAdd((unsigned*)&LC[ex], 1u); } }
    }
    __syncthreads();
    if (tid < 32) LC[32 + tid] = __hip_atomic_fetch_add((unsigned*)(F.ctl + CW_ECNT) + tid, LC[tid], RLX_AGENT);
    __syncthreads();
    if (tid < 256) { const int ex = LE[tid], pos = (int)LC[32 + ex] + LP[tid], tok = tok0 + (tid >> 2); TOPPOS[(size_t)tok * 4 + (tid & 3)] = pos; ROWMAP[(size_t)ex * NTOK + pos] = tok; }
}

__device__ __forceinline__ int moe_tables(Frame& F, LAS int* OFF, LAS int* TE, bool build) {
    __syncthreads();
    if (build && F.tid == 0) { int cn[NEXP];
#pragma unroll
        for (int e = 0; e < NEXP; ++e) cn[e] = (int)__hip_atomic_load((unsigned*)(F.ctl + CW_ECNT) + e, RLX_AGENT);
        int acc = 0;
#pragma unroll
        for (int e = 0; e < NEXP; ++e) { const int c = cn[e], nt = (c + 255) >> 8; OFF[e] = acc * 256; OFF[33 + e] = c; for (int i = 0; i < nt; ++i) TE[acc + i] = e; acc += nt; }
        OFF[NEXP] = acc; }
    __syncthreads();
    return OFF[NEXP];
}
__device__ __forceinline__ void combine_phase(Frame& F, bool build) {
    LAS int* OFF = (LAS int*)(F.lds + MISC_OFF + 512); LAS int* TE = OFF + 72;
    (void)moe_tables(F, OFF, TE, build);
    const int* TOPE = (const int*)(F.ws + WS_TOPE); const int* TOPPOS = (const int*)(F.ws + WS_TOPPOS); const float* TOPW = (const float*)(F.ws + WS_TOPW);
    const float* X1 = (const float*)(F.ws + WS_X1); const bf16* Y2 = (const bf16*)(F.ws + WS_Y2); const float* GF = F.in[I_NFG];
    const int gw = blockIdx.x * NWAVES + F.wave, NGW = F.G * NWAVES, lane = F.lane;
    for (int tok = gw; tok < NTOK; tok += NGW) {
        f32x4 v[4];
#pragma unroll
        for (int j = 0; j < 4; ++j) v[j] = ((const GAS f32x4*)(X1 + (size_t)tok * DM) + lane)[64 * j];
#pragma unroll
        for (int k = 0; k < 4; ++k) { const int slot = OFF[TOPE[tok * 4 + k]] + TOPPOS[tok * 4 + k]; const float wk = TOPW[tok * 4 + k];
            const GAS v2u* yr = (const GAS v2u*)(Y2 + (size_t)slot * DM) + lane;
#pragma unroll
            for (int j = 0; j < 4; ++j) { const v2u y = yr[64 * j]; v[j].x += wk * bflo(y.x); v[j].y += wk * bfhi(y.x); v[j].z += wk * bflo(y.y); v[j].w += wk * bfhi(y.y); } }
        float s2 = 0.f;
#pragma unroll
        for (int j = 0; j < 4; ++j) s2 += (v[j].x * v[j].x + v[j].y * v[j].y) + (v[j].z * v[j].z + v[j].w * v[j].w);
        const float rstd = 1.0f / sqrtf(wave_sum(s2) * (1.f / DM) + RMS_EPS);
#pragma unroll
        for (int j = 0; j < 4; ++j) { const f32x4 gg = ((const GAS f32x4*)GF + lane)[64 * j]; ((GAS f32x4*)(F.out + (size_t)tok * DM) + lane)[64 * j] = v[j] * rstd * gg; }
    }
}

__device__ __forceinline__ void ubench(Frame& F) {
    bf16x8 a = (bf16x8){1, 2, 3, 4, 5, 6, 7, 8}, b = (bf16x8){8, 7, 6, 5, 4, 3, 2, 1}; a[0] = (short)F.lane;
    float sink = 0.f;
    if (PROBE_DUP == 900) { f32x16 c0 = {0.f, 0.f, 0.f, 0.f, 0.f, 0.f, 0.f, 0.f, 0.f, 0.f, 0.f, 0.f, 0.f, 0.f, 0.f, 0.f}, c1 = c0;
        for (int i = 0; i < 2000; ++i) { c0 = __builtin_amdgcn_mfma_f32_32x32x16_bf16(a, b, c0, 0, 0, 0); c1 = __builtin_amdgcn_mfma_f32_32x32x16_bf16(a, b, c1, 0, 0, 0); }
        sink = c0[0] + c1[5]; }
    if (PROBE_DUP == 901) { f32x4 c0 = {0.f, 0.f, 0.f, 0.f}, c1 = c0, c2 = c0, c3 = c0;
        for (int i = 0; i < 2000; ++i) { c0 = __builtin_amdgcn_mfma_f32_16x16x32_bf16(a, b, c0, 0, 0, 0); c1 = __builtin_amdgcn_mfma_f32_16x16x32_bf16(a, b, c1, 0, 0, 0); c2 = __builtin_amdgcn_mfma_f32_16x16x32_bf16(a, b, c2, 0, 0, 0); c3 = __builtin_amdgcn_mfma_f32_16x16x32_bf16(a, b, c3, 0, 0, 0); }
        sink = c0[0] + c1[1] + c2[2] + c3[3]; }
    if (PROBE_DUP == 902) { float x0 = F.lane, x1 = 1.f, x2 = 2.f, x3 = 3.f, x4 = 4.f, x5 = 5.f, x6 = 6.f, x7 = 7.f; const float m = 1.0001f, d = 0.5f;
        for (int i = 0; i < 4000; ++i) { x0 = x0 * m + d; x1 = x1 * m + d; x2 = x2 * m + d; x3 = x3 * m + d; x4 = x4 * m + d; x5 = x5 * m + d; x6 = x6 * m + d; x7 = x7 * m + d; }
        sink = x0 + x1 + x2 + x3 + x4 + x5 + x6 + x7; }
    if (PROBE_DUP == 903) {
        f32x4 c[4]; float s = 0.f; float wv[16];
#pragma unroll
        for (int i = 0; i < 4; ++i) c[i] = (f32x4){0.f, 0.f, 0.f, 0.f};
#pragma unroll
        for (int i = 0; i < 16; ++i) wv[i] = 0.001f * (i + F.lane);
        for (int it = 0; it < 275; ++it) { f32x4 d[4];
#pragma unroll
            for (int i = 0; i < 4; ++i) { d[i] = (f32x4){0.f, 0.f, 0.f, 0.f}; d[i] = __builtin_amdgcn_mfma_f32_16x16x32_bf16(a, b, d[i], 0, 0, 0); d[i] = __builtin_amdgcn_mfma_f32_16x16x32_bf16(b, a, d[i], 0, 0, 0); }
            float t = 0.f;
#pragma unroll
            for (int i = 0; i < 4; ++i)
#pragma unroll
                for (int r = 0; r < 4; ++r) { const float x = c[i][r]; const int xi = __builtin_bit_cast(int, x); const float m = __builtin_bit_cast(float, xi > 0 ? xi : 0); t += wv[4 * i + r] * m; }
            float u = t;
#pragma unroll
            for (int k = 0; k < 12; ++k) u = u * 1.0001f + 0.5f;
            s += u; a[1] = (short)(it + (int)s);
#pragma unroll
            for (int i = 0; i < 4; ++i) c[i] = d[i]; }
        sink = s; }
    if (sink == 123.456f) ((float*)(F.ws + WS_SBUF))[F.tid] = sink;
}

constexpr int NPHASE = 10;
struct Args { const float* in[25]; float* out; unsigned char* ws; int ph_lo, ph_hi; };
__global__ void __launch_bounds__(NTHR, 2) fwd_kernel(Args args) {
    extern __shared__ __attribute__((aligned(16))) unsigned char lds[];
    Frame F;
    F.lds = (LAS unsigned char*)lds;
    F.MISC = (volatile LAS unsigned*)(F.lds + MISC_OFF);
    F.tid = threadIdx.x; F.lane = F.tid & 63; F.wave = __builtin_amdgcn_readfirstlane(F.tid >> 6); F.G = gridDim.x;
    F.ws = args.ws; F.ctl = (gu32*)(args.ws + WS_CTL); F.out = args.out;
#pragma unroll
    for (int i = 0; i < 25; ++i) F.in[i] = args.in[i];
    for (int u = F.tid; u < 2048 / 4; u += NTHR) ((LAS unsigned*)(F.lds + MISC_OFF))[u] = 0u;
    __syncthreads();
    XcdBarrier bar; bar.bar = (unsigned*)(F.ctl + CW_BAR); bar.x = 0; bar.st = nullptr;
    if (MK_N_LAUNCHES == 1) bar = xcd_barrier_post((unsigned*)(F.ctl + CW_BAR), F.MISC + 8);
    const int lo = args.ph_lo, hi = args.ph_hi;
#define IN(k) (lo <= (k) && (k) < hi)
#define SEAM(k) do { if (IN(k) && IN((k) + 1)) xcd_barrier(bar); } while (0)
    unsigned char* ws = F.ws; const int c = (int)blockIdx.x;

#define BODY_P0 { p0_prologue(F); if (PROBE_DUP >= 900) ubench(F); }
#define BODY_P1 { { pg8::Gemm g{(const bf16*)(ws + WS_XN), (const bf16*)(ws + WS_WIN), 1024, 1024, 1024, 0}; InProjOrder S{F.G, c, (unsigned*)(F.ctl + CW_UDONE)}; \
        EpiInProj E{ws, F.in[I_BGATE]}; pg8::gemm_phase<EpiInProj, InProjOrder>(F.lds, g, S, E); } \
        if (c >= 128 && c < 192) { wg_wait_ge(F, CW_UDONE, 128u * 8u); pg8::Gemm g{(const bf16*)(ws + WS_UGX), (const bf16*)(ws + WS_WS), UGX_LD, 512, 512, 0}; S5StateOrder S{c - 128}; EpiS5State E{(float*)(ws + WS_SBUF)}; \
          pg8::gemm_phase<EpiS5State, S5StateOrder>(F.lds, g, S, E); } \
        if (c >= 128) moe_convert(F, MOE_N8A, MOE_N8, (c < 192) ? c - 128 : 64 + 2 * (c - 192), (c < 192) ? 1 : 2, 192); }
#define BODY_P2 { carry_phase(F); idx_phase(F); if (PROBE_DUP == 102) { xcd_barrier(bar); idx_phase(F); } }
#define BODY_P3 { if (c >= 128) { { pg8::Gemm g{(const bf16*)(ws + WS_UGX), (const bf16*)(ws + WS_MT), UGX_LD, UGX_LD, 640, 0}; S5YOrder S{c - 128}; EpiS5Y E{(const bf16*)(ws + WS_UGX), F.in[I_SD], (bf16*)(ws + WS_YG)}; \
            pg8::gemm_phase<EpiS5Y, S5YOrder>(F.lds, g, S, E); } \
          wg_signal(F, CW_YDONE); wg_wait_ge(F, CW_YDONE, 128u); \
          { pg8::Gemm g{(const bf16*)(ws + WS_YG), (const bf16*)(ws + WS_WGLU), 512, 512, 512, 0}; StaticOrder S; S.init(NTOK / 256, 2, 128, c - 128); EpiGlu E{(const bf16*)(ws + WS_YG), F.in[I_BGLU], (bf16*)(ws + WS_YSSM)}; \
            pg8::gemm_phase<EpiGlu, StaticOrder>(F.lds, g, S, E); } } \
        attn_phase(F); }
#define BODY_P4 { pg8::Gemm g{(const bf16*)(ws + WS_YSSM), (const bf16*)(ws + WS_WPS), 512, 512, 512, 0}; MixOrder S; S.so.init(NTOK / 256, 4, F.G, c); \
        EpiMix E{(const bf16*)(ws + WS_GS), (const bf16*)(ws + WS_GA), (bf16*)(ws + WS_MIXED)}; pg8::gemm_phase<EpiMix, MixOrder>(F.lds, g, S, E); }
#define BODY_P5 { pg8::Gemm g{(const bf16*)(ws + WS_MIXED), (const bf16*)(ws + WS_WOUT), 1024, 1024, 1024, 0}; StaticOrder S; S.init(NTOK / 256, 4, F.G, c); EpiOut E{F.in[I_X], (float*)(ws + WS_X1)}; \
        pg8::gemm_phase<EpiOut, StaticOrder>(F.lds, g, S, E); }
#define BODY_P6 { router_phase(F); }
#define BODY_P7 { LAS int* OFF = (LAS int*)(F.lds + MISC_OFF + 512); LAS int* TE = OFF + 72; const int TT = moe_tables(F, OFF, TE, true); \
        pg8::Gemm g{(const bf16*)(ws + WS_H2), (const bf16*)(ws + WS_WMI), 1024, 2048, 1024, (size_t)1024 * 2048 * 2}; MoeOrder S{TE, OFF, OFF + 33, (const int*)(ws + WS_ROWMAP), TT, 8, c}; EpiMoe1 E{F.in[I_BMI], (bf16*)(ws + WS_ACT)}; \
        pg8::gemm_phase<EpiMoe1, MoeOrder, true, true>(F.lds, g, S, E); }
#define BODY_P8 { LAS int* OFF = (LAS int*)(F.lds + MISC_OFF + 512); LAS int* TE = OFF + 72; const int TT = moe_tables(F, OFF, TE, lo == 8); \
        pg8::Gemm g{(const bf16*)(ws + WS_ACT), (const bf16*)(ws + WS_WMO), 1024, 1024, 1024, (size_t)1024 * 1024 * 2}; MoeOrder S{TE, OFF, OFF + 33, nullptr, TT, 4, c}; EpiMoe2 E{F.in[I_BMO], (bf16*)(ws + WS_Y2)}; \
        pg8::gemm_phase<EpiMoe2, MoeOrder, true, true>(F.lds, g, S, E); }
#define BODY_P9 { combine_phase(F, lo == 9); }
#define PHASE(k, BODY) if (IN(k)) { TPROBE_BEGIN(k); BODY TPROBE_END(k); if (PROBE_DUP == (k)) { xcd_barrier(bar); BODY } } SEAM(k);
    PHASE(0, BODY_P0) PHASE(1, BODY_P1) PHASE(2, BODY_P2) PHASE(3, BODY_P3) PHASE(4, BODY_P4) PHASE(5, BODY_P5) PHASE(6, BODY_P6)
    PHASE(7, BODY_P7) PHASE(8, BODY_P8) PHASE(9, BODY_P9)
#undef IN
#undef SEAM
}

extern "C" void kernel_launch(void* const* d_in, const int* in_sizes, int n_in, void* d_out, int out_size, void* d_ws, size_t ws_size, hipStream_t stream) {
    static int grid = 0;
    if (grid == 0) {
        if (n_in != 25 || out_size != NTOK * DM || ws_size < WS_END) { fprintf(stderr, "kernel_launch: unexpected problem (n_in %d out %d ws %zu)\n", n_in, out_size, ws_size); grid = -1; return; }
        if (hipFuncSetAttribute((const void*)fwd_kernel, hipFuncAttributeMaxDynamicSharedMemorySize, LDS_BYTES) != hipSuccess) { fprintf(stderr, "kernel_launch: hipFuncSetAttribute failed\n"); grid = -1; return; }
        int per_cu = 0; (void)hipOccupancyMaxActiveBlocksPerMultiprocessor(&per_cu, (const void*)fwd_kernel, NTHR, LDS_BYTES); (void)hipGetLastError();
        grid = 256;
    }
    if (grid < 0) return;
    (void)hipMemsetAsync((char*)d_ws + WS_CTL, 0, CTL_ZERO_BYTES, stream);
    Args a{};
    for (int i = 0; i < 25; ++i) a.in[i] = (const float*)d_in[i];
    a.out = (float*)d_out; a.ws = (unsigned char*)d_ws;
    if (MK_N_LAUNCHES == 1) { a.ph_lo = 0; a.ph_hi = NPHASE; hipLaunchKernelGGL(fwd_kernel, dim3(grid), dim3(NTHR), LDS_BYTES, stream, a); }
    else for (int p = 0; p < NPHASE; ++p) { a.ph_lo = p; a.ph_hi = p + 1; hipLaunchKernelGGL(fwd_kernel, dim3(grid), dim3(NTHR), LDS_BYTES, stream, a); }
}
```

```cpp
#include <hip/hip_runtime.h>
#include <cstdio>
#include <cstdint>

#ifndef MK_N_LAUNCHES
#define MK_N_LAUNCHES 1
#endif
#ifndef PROBE_DUP
#define PROBE_DUP -1
#endif
#ifndef PROBE_MULT
#define PROBE_MULT 4
#endif
#ifndef PROBE_T
#define PROBE_T -1
#endif
#define TPROBE_BEGIN(id) unsigned long long tpb_##id = (PROBE_T == (id)) ? __builtin_amdgcn_s_memrealtime() : 0ull
#define TPROBE_END(id) do { if (PROBE_T == (id)) { const unsigned long long d_ = __builtin_amdgcn_s_memrealtime() - tpb_##id, t1_ = __builtin_amdgcn_s_memrealtime(); while (__builtin_amdgcn_s_memrealtime() - t1_ < 4ull * d_) __builtin_amdgcn_s_sleep(8); } } while (0)

namespace pg8 {
#define PG8_LAS __attribute__((address_space(3)))
typedef unsigned short bf16_t;
typedef short bf16x8 __attribute__((ext_vector_type(8)));
typedef float f32x4 __attribute__((ext_vector_type(4)));
typedef float f32x2 __attribute__((ext_vector_type(2)));
typedef unsigned u32x4 __attribute__((ext_vector_type(4)));
typedef unsigned u32x2 __attribute__((ext_vector_type(2)));
constexpr int BM = 256, BK = 64, HALF = 128, HTB = HALF * BK * 2, STAGE_BYTES = 8 * HTB, NXCD = 8, WGM = 8;

__host__ __device__ __forceinline__ int lds_byte(int r, int c) { const int st = (r >> 4) * 2 + (c >> 5), rr = r & 15, cc = c & 31, ob = rr * 64 + cc * 2; return st * 1024 + (ob ^ (((ob >> 9) & 1) << 5)); }
__host__ __device__ __forceinline__ void stage_rc(int b, int& R, int& C) { const int st = b / 1024, sb = b % 1024, swz = sb ^ (((sb >> 9) & 1) << 5); R = (st >> 1) * 16 + swz / 64; C = (st & 1) * 32 + (swz % 64) / 2; }
__host__ __device__ __forceinline__ int perm32(int rho) { const int n = rho >> 4, i = rho & 15; return 8 * (i >> 2) + 4 * n + (i & 3); }

struct Unit { int pm, pn, pa, pb, e; };
struct Gemm { const bf16_t* A; const bf16_t* Bt; int lda, ldb, K; size_t bexp; };

__device__ __forceinline__ unsigned cvt_pk_bf16(float lo, float hi) { unsigned r; asm volatile("v_cvt_pk_bf16_f32 %0, %1, %2" : "=v"(r) : "v"(lo), "v"(hi)); return r; }
__device__ __forceinline__ u32x4 pack8(const f32x4& v0, const f32x4& v1) { u32x4 w; w.x = cvt_pk_bf16(v0[0], v0[1]); w.y = cvt_pk_bf16(v0[2], v0[3]); w.z = cvt_pk_bf16(v1[0], v1[1]); w.w = cvt_pk_bf16(v1[2], v1[3]); return w; }

template <class Epi, class Sched, bool ALIGN_EPI = true, bool BKN = false>
__device__ __forceinline__ void gemm_phase(PG8_LAS unsigned char* lds, const Gemm g, const Sched& S, const Epi& E) {
    const int tid = threadIdx.x, wid = __builtin_amdgcn_readfirstlane(tid >> 6), lane = tid & 63, wr = wid >> 2, wc = wid & 3, fr = lane & 15, fq = lane >> 4;
    const int K = g.K, nt = K / BK;
    unsigned voffB[2];
#pragma unroll
    for (int i = 0; i < 2; ++i) {
        if constexpr (BKN) { const int krow = (tid >> 4) + 32 * i, cp = tid & 15, fk = ((krow & 3) << 1) | (((krow >> 3) & 1) << 3); voffB[i] = (unsigned)(krow * g.ldb) * 2u + (unsigned)((cp ^ fk) << 4); }
        else { int R, C; stage_rc(tid * 16 + i * 8192, R, C); const int Rb = (R & ~31) + perm32(R & 31); voffB[i] = (unsigned)(Rb * g.ldb + C) * 2u; } }
    const size_t kstep = (size_t)(BK * 2);
    const size_t kstepB = BKN ? (size_t)BK * g.ldb * 2 : kstep;
    const size_t hstepB = BKN ? (size_t)256 : (size_t)HALF * g.ldb * 2;
    const size_t tstepB = BKN ? (size_t)512 : 2 * hstepB;
    const unsigned tbase = (unsigned)(unsigned long)lds + (unsigned)((8 * fq + (fr >> 2)) * 256 + (((4 * wc + (fr & 3)) ^ (((fr >> 2) << 1) | ((fq & 1) << 3))) << 4));
#define PG8_AROWS(VV, U) do { _Pragma("unroll") for (int i_ = 0; i_ < 2; ++i_) { int R_, C_; stage_rc((threadIdx.x & 511) * 16 + i_ * 8192, R_, C_); \
        _Pragma("unroll") for (int h_ = 0; h_ < 2; ++h_) VV[h_][i_] = (unsigned)(S.arow(U, h_, R_) * g.lda + C_) * 2u; } } while (0)
    unsigned vA[2][2], vAn[2][2];
    const unsigned ldsw = (unsigned)wid * 1024u;
    const int aoff = lds_byte(wr * 64 + fr, fq * 8), boff = lds_byte(wc * 32 + fr, fq * 8);
#define PG8_SA(b, h) (((b) * 2 + (h)) * HTB)
#define PG8_SB(b, h) ((4 + (b) * 2 + (h)) * HTB)
#define PG8_STAGE(bufoff, gbase, voff) do { _Pragma("unroll") for (int _i = 0; _i < 2; ++_i) \
        __builtin_amdgcn_global_load_lds((const unsigned*)((const char*)(gbase) + (voff)[_i]), (PG8_LAS unsigned*)(lds + (bufoff) + ldsw + _i * 8192), 16, 0, 0); } while (0)
#define PG8_LDA(dst, b, h) do { _Pragma("unroll") for (int m = 0; m < 4; ++m) _Pragma("unroll") for (int k = 0; k < 2; ++k) dst[m][k] = *(const PG8_LAS bf16x8*)(lds + PG8_SA(b, h) + aoff + m * 2048 + k * 1024); } while (0)
#define PG8_LDB(dst, b, h) do { if constexpr (BKN) { const unsigned ab_ = tbase + PG8_SB(b, h); _Pragma("unroll") for (int n = 0; n < 2; ++n) _Pragma("unroll") for (int k = 0; k < 2; ++k) { u32x2 lo_, hi_; \
            asm volatile("ds_read_b64_tr_b16 %0, %2 offset:%3\n\tds_read_b64_tr_b16 %1, %2 offset:%4" : "=&v"(lo_), "=&v"(hi_) : "v"(ab_), "n"(k * 8192 + n * 8), "n"(k * 8192 + n * 8 + 1024) : "memory"); \
            u32x4 w_; w_.x = lo_.x; w_.y = lo_.y; w_.z = hi_.x; w_.w = hi_.y; dst[n][k] = __builtin_bit_cast(bf16x8, w_); } } \
        else { _Pragma("unroll") for (int n = 0; n < 2; ++n) _Pragma("unroll") for (int k = 0; k < 2; ++k) dst[n][k] = *(const PG8_LAS bf16x8*)(lds + PG8_SB(b, h) + boff + n * 2048 + k * 1024); } } while (0)
#define PG8_WAIT_LB() do { if constexpr (BKN) asm volatile("s_waitcnt lgkmcnt(0)" : "+v"(B0[0][0]), "+v"(B0[0][1]), "+v"(B0[1][0]), "+v"(B0[1][1]), "+v"(B1[0][0]), "+v"(B1[0][1]), "+v"(B1[1][0]), "+v"(B1[1][1]) :: "memory"); \
        else asm volatile("s_waitcnt lgkmcnt(0)" ::: "memory"); } while (0)
#define PG8_MMA(ai, bj, At, Bt) do { __builtin_amdgcn_s_setprio(1); _Pragma("unroll") for (int m = 0; m < 4; ++m) _Pragma("unroll") for (int n = 0; n < 2; ++n) _Pragma("unroll") for (int k = 0; k < 2; ++k) \
        acc[ai][bj][m][n] = __builtin_amdgcn_mfma_f32_16x16x32_bf16(Bt[n][k], At[m][k], acc[ai][bj][m][n], 0, 0, 0); __builtin_amdgcn_s_setprio(0); } while (0)
#define PG8_WAIT_V(n) asm volatile("s_waitcnt vmcnt(" #n ")" ::: "memory")
#define PG8_WAIT_L(n) asm volatile("s_waitcnt lgkmcnt(" #n ")" ::: "memory")
#define PG8_BAR __builtin_amdgcn_s_barrier()
#define PG8_SCHED __builtin_amdgcn_sched_barrier(0)
    Unit cur, nxt; int ui = 0;
    if (!S.next(0, cur)) return;
    f32x4 acc[2][2][4][2];
#pragma unroll
    for (int a = 0; a < 2; ++a)
#pragma unroll
        for (int b = 0; b < 2; ++b)
#pragma unroll
            for (int m = 0; m < 4; ++m)
#pragma unroll
                for (int n = 0; n < 2; ++n) acc[a][b][m][n] = (f32x4){0.f, 0.f, 0.f, 0.f};
    bf16x8 At[4][2], B0[2][2], B1[2][2];
    const char* const bA = (const char*)g.A; const char* cB = BKN ? (const char*)g.Bt + (size_t)cur.e * g.bexp + (size_t)cur.pn * tstepB : (const char*)g.Bt + (size_t)cur.pb * tstepB;
    PG8_AROWS(vA, cur);
    PG8_STAGE(PG8_SB(0, 0), cB, voffB); PG8_STAGE(PG8_SB(0, 1), cB + hstepB, voffB); PG8_STAGE(PG8_SA(0, 0), bA, vA[0]); PG8_STAGE(PG8_SA(0, 1), bA, vA[1]);
    if (wr == 1) PG8_BAR;
    PG8_WAIT_V(2); PG8_BAR;
    PG8_STAGE(PG8_SB(1, 0), cB + kstepB, voffB); PG8_STAGE(PG8_SA(1, 0), bA + kstep, vA[0]); PG8_STAGE(PG8_SB(1, 1), cB + hstepB + kstepB, voffB);
    PG8_WAIT_V(6); PG8_BAR;
    for (;;) {
        const bool has_next = S.next(ui + 1, nxt);
        const char* nB = has_next ? (BKN ? (const char*)g.Bt + (size_t)nxt.e * g.bexp + (size_t)nxt.pn * tstepB : (const char*)g.Bt + (size_t)nxt.pb * tstepB) : cB;
        if (has_next) PG8_AROWS(vAn, nxt); else { vAn[0][0] = vA[0][0]; vAn[0][1] = vA[0][1]; vAn[1][0] = vA[1][0]; vAn[1][1] = vA[1][1]; }
        for (int t = 0; t < nt; t += 2) {
            const bool last = (t == nt - 2);
            const char* a1 = bA + (size_t)(t + 1) * kstep;
            const char* a2 = last ? bA : bA + (size_t)(t + 2) * kstep; const char* b2 = last ? nB : cB + (size_t)(t + 2) * kstepB;
            const char* a3 = a2 + kstep; const char* b3 = b2 + kstepB;
            unsigned w0[2], w1[2];
            w0[0] = last ? vAn[0][0] : vA[0][0]; w0[1] = last ? vAn[0][1] : vA[0][1]; w1[0] = last ? vAn[1][0] : vA[1][0]; w1[1] = last ? vAn[1][1] : vA[1][1];
            PG8_LDB(B0, 0, 0); PG8_LDB(B1, 0, 1); PG8_SCHED; PG8_LDA(At, 0, 0); PG8_STAGE(PG8_SA(1, 1), a1, vA[1]);
            PG8_WAIT_V(8); PG8_WAIT_LB(); PG8_BAR; PG8_MMA(0, 0, At, B0); PG8_MMA(0, 1, At, B1); PG8_BAR; PG8_SCHED;
            PG8_LDA(At, 0, 1); PG8_STAGE(PG8_SB(0, 0), b2, voffB); PG8_STAGE(PG8_SB(0, 1), b2 + hstepB, voffB); PG8_STAGE(PG8_SA(0, 0), a2, w0);
            PG8_WAIT_V(8); PG8_WAIT_L(0); PG8_BAR; PG8_MMA(1, 0, At, B0); PG8_MMA(1, 1, At, B1); PG8_BAR; PG8_SCHED;
            PG8_LDB(B0, 1, 0); PG8_LDB(B1, 1, 1); PG8_SCHED; PG8_LDA(At, 1, 0); PG8_STAGE(PG8_SA(0, 1), a2, w1);
            PG8_WAIT_V(8); PG8_WAIT_LB(); PG8_BAR; PG8_MMA(0, 0, At, B0); PG8_MMA(0, 1, At, B1); PG8_BAR; PG8_SCHED;
            PG8_LDA(At, 1, 1); PG8_STAGE(PG8_SB(1, 0), b3, voffB); PG8_STAGE(PG8_SB(1, 1), b3 + hstepB, voffB); PG8_STAGE(PG8_SA(1, 0), a3, w0);
            PG8_WAIT_V(8); PG8_WAIT_L(0); PG8_BAR; PG8_MMA(1, 0, At, B0); PG8_MMA(1, 1, At, B1); PG8_BAR; PG8_SCHED;
        }
        if constexpr (ALIGN_EPI) { if (wr == 0) PG8_BAR; }
        { const bool pe_ = (PROBE_T == 200 && !BKN) || (PROBE_T == 201 && BKN) || (PROBE_T == 203 && BKN && g.ldb == 2048) || (PROBE_T == 204 && BKN && g.ldb == 1024) || (PROBE_T >= 210 && PROBE_T < 216 && !BKN && S.probe_id() == PROBE_T) || (PROBE_T == 216 && !BKN && S.probe_id() == 211 && cur.pn < 2) || (PROBE_T == 217 && !BKN && S.probe_id() == 211 && cur.pn >= 2) || (PROBE_T == 218 && !BKN && S.probe_id() == 211 && blockIdx.x >= 192) || (PROBE_T == 219 && !BKN && S.probe_id() == 211 && blockIdx.x < 128 && cur.pn >= 2);
          unsigned long long tpe_ = 0; if (pe_) tpe_ = __builtin_amdgcn_s_memrealtime();
          E(acc, cur, wr, wc, fr, fq);
          if ((PROBE_T == 220 || (PROBE_T == 221 && wid == 0)) && !BKN && S.probe_id() == 211 && blockIdx.x >= 192) { const unsigned long long t1_ = __builtin_amdgcn_s_memrealtime(); while (__builtin_amdgcn_s_memrealtime() - t1_ < 2000ull) __builtin_amdgcn_s_sleep(8); }
          if (pe_) { const unsigned long long d_ = __builtin_amdgcn_s_memrealtime() - tpe_, t1_ = __builtin_amdgcn_s_memrealtime(); while (__builtin_amdgcn_s_memrealtime() - t1_ < (unsigned long long)PROBE_MULT * d_) __builtin_amdgcn_s_sleep(8); } } S.done(cur);
        if (!has_next) break;
#pragma unroll
        for (int a = 0; a < 2; ++a)
#pragma unroll
            for (int b = 0; b < 2; ++b)
#pragma unroll
                for (int m = 0; m < 4; ++m)
#pragma unroll
                    for (int n = 0; n < 2; ++n) acc[a][b][m][n] = (f32x4){0.f, 0.f, 0.f, 0.f};
        cur = nxt; cB = nB; ++ui; vA[0][0] = vAn[0][0]; vA[0][1] = vAn[0][1]; vA[1][0] = vAn[1][0]; vA[1][1] = vAn[1][1];
        if constexpr (ALIGN_EPI) { if (wr == 1) PG8_BAR; }
    }
    PG8_WAIT_V(0);
    if constexpr (!ALIGN_EPI) { if (wr == 0) PG8_BAR; }
    PG8_BAR;
#undef PG8_AROWS
#undef PG8_SA
#undef PG8_SB
#undef PG8_STAGE
#undef PG8_LDA
#undef PG8_LDB
#undef PG8_WAIT_LB
#undef PG8_MMA
#undef PG8_WAIT_V
#undef PG8_WAIT_L
#undef PG8_BAR
#undef PG8_SCHED
}
}

constexpr int NB = 4, SEQ = 4096, NTOK = NB * SEQ, DM = 1024;
constexpr int NWAVES = 8, NTHR = 512;
constexpr int D_SSM = 512, NGRP = 32, NSTATE = 64, CH = 32  , NCH = SEQ / CH  , UGX_LD = 640, S5_ROWS = NB * NCH  ;
constexpr int NIN_PAD = 4608;
constexpr int NEXP = 32, TOPK_E = 4, DFF = 1024;
constexpr int NSEL = 256;
constexpr int MAX_MT = 288;
constexpr float RMS_EPS = 1e-5f;

constexpr size_t MiB = 1u << 20;
constexpr size_t WS_CTL = 0, CTL_ZERO_BYTES = 1 * MiB;
constexpr size_t WS_ROPE = 1 * MiB;
constexpr size_t WS_WIN = 2 * MiB;
constexpr size_t WS_WGLU = 11 * MiB;
constexpr size_t WS_WPS = 12 * MiB;
constexpr size_t WS_WPA = 13 * MiB;
constexpr size_t WS_WOUT = 14 * MiB;
constexpr size_t WS_MT = 16 * MiB;
constexpr size_t WS_WS = 36 * MiB;
constexpr size_t WS_A32 = 44 * MiB;
constexpr size_t WS_SBUF = 45 * MiB;
constexpr size_t WS_WI = 53 * MiB;
constexpr size_t WS_KI = 54 * MiB;
constexpr size_t WS_K = 56 * MiB;
constexpr size_t WS_V = 60 * MiB;
constexpr size_t WS_UGX = 64 * MiB;
constexpr size_t WS_Q = 84 * MiB;
constexpr size_t WS_QI = 100 * MiB;
constexpr size_t WS_GS = 132 * MiB;
constexpr size_t WS_GA = 164 * MiB;
constexpr size_t WS_XN = 196 * MiB;
constexpr size_t WS_YG = 228 * MiB;
constexpr size_t WS_YSSM = 244 * MiB;
constexpr size_t WS_YATT = 260 * MiB;
constexpr size_t WS_SEL = 276 * MiB;
constexpr size_t WS_MIXED = 284 * MiB;
constexpr size_t WS_X1 = 316 * MiB;
constexpr size_t WS_H2 = 380 * MiB;
constexpr size_t WS_TOPE = 412 * MiB;
constexpr size_t WS_TOPW = WS_TOPE + 256 * 1024;
constexpr size_t WS_TOPPOS = WS_TOPW + 256 * 1024;
constexpr size_t WS_ROWMAP = 413 * MiB;
constexpr size_t WS_WMI = 416 * MiB;
constexpr size_t WS_WMO = 544 * MiB;
constexpr size_t WS_ACT = 608 * MiB;
constexpr size_t WS_XP = 64 * MiB;
constexpr size_t WS_Y2 = 64 * MiB;
constexpr size_t WS_END = 752 * MiB;
static_assert(WS_XP + (size_t)MAX_MT * 256 * 1024 * 2 <= WS_YG, "XP overlay");
constexpr int CW_TMO = 0, CW_CODE = 1;
constexpr int CW_BAR = 4096;
constexpr int CW_ECNT = 16384;
constexpr int CW_UDONE = 16384 + 64;
constexpr int CW_YDONE = 16384 + 128;

constexpr int LDS_BYTES = 163840;
constexpr int MISC_OFF = 163840 - 2048;

#define GAS __attribute__((address_space(1)))
#define LAS __attribute__((address_space(3)))
typedef unsigned short bf16;
typedef unsigned short u16;
typedef unsigned v4u __attribute__((ext_vector_type(4)));
typedef unsigned v2u __attribute__((ext_vector_type(2)));
typedef float f32x4 __attribute__((ext_vector_type(4)));
typedef float f32x16 __attribute__((ext_vector_type(16)));
typedef short bf16x8 __attribute__((ext_vector_type(8)));
typedef GAS unsigned gu32;
#define RLX_AGENT __ATOMIC_RELAXED, __HIP_MEMORY_SCOPE_AGENT
#define LDS_WAIT() asm volatile("s_waitcnt lgkmcnt(0)" ::: "memory")
#define VM_WAIT() asm volatile("s_waitcnt vmcnt(0)" ::: "memory")
__device__ __forceinline__ unsigned f2bf(float f) { unsigned u = __builtin_bit_cast(unsigned, f); return (u + 0x7fffu + ((u >> 16) & 1u)) >> 16; }
__device__ __forceinline__ unsigned pk2(float lo, float hi) { return f2bf(lo) | (f2bf(hi) << 16); }
__device__ __forceinline__ float bf2f(unsigned b) { return __builtin_bit_cast(float, b << 16); }
__device__ __forceinline__ float bflo(unsigned w) { return __builtin_bit_cast(float, w << 16); }
__device__ __forceinline__ float bfhi(unsigned w) { return __builtin_bit_cast(float, w & 0xffff0000u); }
__device__ __forceinline__ float sigmoidf_(float x) { return __builtin_amdgcn_rcpf(1.0f + __builtin_amdgcn_exp2f(-1.4426950408889634f * x)); }
__device__ __forceinline__ float gelu_tanh(float x) { const float u = 0.7978845608028654f * (x + 0.044715f * x * x * x); const float e = __builtin_amdgcn_exp2f(2.8853900817779268f * u); const float t = 1.0f - 2.0f * __builtin_amdgcn_rcpf(e + 1.0f); return 0.5f * x * (1.0f + t); }

#define XB_TMO      128
#define XB_XCNT(j)  (256  + 64 * (j))
#define XB_XSUB(j)  (1280 + 64 * (j))
#define XB_XGEN(j)  (2304 + 64 * (j))
#define XB_TOP      3328
#define XB_TOPGEN   3392
#define XCD_BAR_WORDS 3456
#define XB_SPIN_CAP (1u << 18)
__device__ __forceinline__ unsigned xb_ld(unsigned* p)              { return __hip_atomic_load(p, __ATOMIC_RELAXED, __HIP_MEMORY_SCOPE_AGENT); }
__device__ __forceinline__ unsigned xb_add(unsigned* p, unsigned v) { return __hip_atomic_fetch_add(p, v, __ATOMIC_RELAXED, __HIP_MEMORY_SCOPE_AGENT); }
__device__ __forceinline__ unsigned xb_xcc_id() { return (unsigned)__builtin_amdgcn_s_getreg((3 << 11) | 20) & 0xFu; }
#define XB_SPIN(cond, bar) do { unsigned _sp = 0; while (cond) { __builtin_amdgcn_s_sleep(1); \
    if ((++_sp & 255u) == 0u) { if (xb_ld(&(bar)[XB_TMO])) break; if (_sp > XB_SPIN_CAP) { atomicAdd(&(bar)[XB_TMO], 1u); break; } } } } while (0)
struct XcdBarrier { unsigned* bar; unsigned x; volatile LAS unsigned* st; };
__device__ __forceinline__ XcdBarrier xcd_barrier_post(unsigned* bar, volatile LAS unsigned* st) {
    XcdBarrier b; b.bar = bar; b.x = xb_xcc_id(); b.st = st;
    if (threadIdx.x == 0) (void)xb_add(&bar[XB_XCNT(b.x)], 1u);
    return b;
}
__device__ __forceinline__ void xcd_barrier_complete(unsigned* bar, unsigned x, unsigned& nloc, unsigned& nx) {
    const unsigned G = gridDim.x * gridDim.y * gridDim.z;
    unsigned sum, cnt, mine, sp = 0u;
    for (;;) {
        sum = 0u; cnt = 0u; mine = 0u;
#pragma unroll
        for (unsigned j = 0; j < 16; ++j) { const unsigned c = xb_ld(&bar[XB_XCNT(j)]); sum += c; cnt += (c > 0u) ? 1u : 0u; mine = (j == x) ? c : mine; }
        if (sum == G) break;
        __builtin_amdgcn_s_sleep(1);
        if ((++sp & 255u) == 0u) { if (xb_ld(&bar[XB_TMO])) break; if (sp > XB_SPIN_CAP) { atomicAdd(&bar[XB_TMO], 1u); break; } }
    }
    nloc = mine > 0u ? mine : 1u; nx = cnt > 0u ? cnt : 1u;
}
__device__ __forceinline__ void xcd_barrier(const XcdBarrier& b) {
    asm volatile("s_waitcnt vmcnt(0)" ::: "memory");
    __syncthreads();
    if (threadIdx.x == 0) {
        unsigned* bar = b.bar;
        __builtin_amdgcn_s_waitcnt(0);
        unsigned nloc = b.st[0], nx = b.st[1];
        if (nloc == 0u) { xcd_barrier_complete(bar, b.x, nloc, nx); b.st[0] = nloc; b.st[1] = nx; }
        const unsigned old = xb_add(&bar[XB_XSUB(b.x)], 1u);
        const unsigned gen = old / nloc;
        if (old + 1u == (gen + 1u) * nloc) {
            __builtin_amdgcn_fence(__ATOMIC_RELEASE, "agent");
            asm volatile("s_waitcnt vmcnt(0)" ::: "memory");
            const unsigned og = xb_add(&bar[XB_TOP], 1u);
            const unsigned tg = og / nx;
            if (og + 1u == (tg + 1u) * nx) xb_add(&bar[XB_TOPGEN], 1u);
            else XB_SPIN(xb_ld(&bar[XB_TOPGEN]) == tg, bar);
            __builtin_amdgcn_fence(__ATOMIC_ACQUIRE, "agent");
            xb_add(&bar[XB_XGEN(b.x)], 1u);
            asm volatile("s_waitcnt vmcnt(0)" ::: "memory");
        } else {
            XB_SPIN(xb_ld(&bar[XB_XGEN(b.x)]) == gen, bar);
            __builtin_amdgcn_fence(__ATOMIC_ACQUIRE, "agent");
            asm volatile("s_waitcnt vmcnt(0)" ::: "memory");
        }
    }
    __syncthreads();
}

struct Frame {
    LAS unsigned char* lds;
    volatile LAS unsigned* MISC;
    gu32* ctl;
    int tid, lane, wave, G;
    unsigned char* ws;
    const float* in[25];
    float* out;
};
enum { I_X = 0, I_N1G, I_WIN, I_BGATE, I_LRE, I_LIM, I_LOGDT, I_BRE, I_BIM, I_CRE, I_CIM, I_SD, I_WGLU, I_BGLU, I_WPS, I_WPA, I_WOUT, I_N2G, I_WR, I_BR, I_WMI, I_BMI, I_WMO, I_BMO, I_NFG };

__device__ __forceinline__ float wave_sum(float v) {
#pragma unroll
    for (int o = 1; o < 64; o <<= 1) v += __shfl_xor(v, o);
    return v;
}

__device__ __forceinline__ int ropeperm(int p) { const int a = p >> 3, bb = p & 7; return bb < 4 ? 4 * a + bb : 32 + 4 * a + (bb - 4); }
__device__ __forceinline__ int win_src(int nd) {
    const int pn = nd >> 8, j = nd & 255;
    if (pn < 2) return nd;
    if (pn < 4) { const int i = nd - 512; return 512 + (i & ~63) + ropeperm(i & 63); }
    if (pn == 4) { if (j < 128) return 1024 + (j & ~63) + ropeperm(j & 63); return 1152 + (j - 128); }
    if (pn < 9) { const int i = nd - 1280; return 1280 + (i & ~63) + ropeperm(i & 63); }
    if (pn == 9) { if (j < 64) return 2304 + ropeperm(j); if (j < 80) return 2368 + (j - 64); return -1; }
    if (pn < 14) return 2384 + (nd - 2560);
    return 3408 + (nd - 3584);
}
struct TItem { const float* src; bf16* dst; int N, K; };
__device__ __forceinline__ void titem_load(const TItem& T, float (&tv)[32], int lane) {
#pragma unroll
    for (int i = 0; i < 32; ++i) { const int kk = 2 * i + (lane >> 5); tv[i] = T.src ? __builtin_nontemporal_load(T.src + (size_t)kk * T.N) : 0.f; }
}
__device__ __forceinline__ void titem_store(const TItem& T, const float (&tv)[32], LAS float* scr, int lane) {
#pragma unroll
    for (int i = 0; i < 32; ++i) { const int kk = 2 * i + (lane >> 5); scr[kk * 33 + (lane & 31)] = tv[i]; }
    LDS_WAIT(); asm volatile("" ::: "memory");
    const int c = lane & 7;
#pragma unroll
    for (int j = 0; j < 4; ++j) { const int n = (lane >> 3) + 8 * j; const LAS float* s = scr + (8 * c) * 33 + n;
        v4u o; o.x = pk2(s[0 * 33], s[1 * 33]); o.y = pk2(s[2 * 33], s[3 * 33]); o.z = pk2(s[4 * 33], s[5 * 33]); o.w = pk2(s[6 * 33], s[7 * 33]);
        *(GAS v4u*)(T.dst + (size_t)n * T.K + 8 * c) = o; }
    LDS_WAIT(); asm volatile("" ::: "memory");
}
__device__ __forceinline__ void rms_row_to_bf16(int lane, const float* xrow, const float* g, bf16* orow) {
    const GAS f32x4* xr = (const GAS f32x4*)xrow + lane; const GAS f32x4* gr = (const GAS f32x4*)g + lane;
    f32x4 v[4]; float s2 = 0.f;
#pragma unroll
    for (int j = 0; j < 4; ++j) { v[j] = xr[64 * j]; s2 += (v[j].x * v[j].x + v[j].y * v[j].y) + (v[j].z * v[j].z + v[j].w * v[j].w); }
    const float rstd = 1.0f / sqrtf(wave_sum(s2) * (1.f / DM) + RMS_EPS);
    GAS unsigned long long* o8 = (GAS unsigned long long*)orow + lane;
#pragma unroll
    for (int j = 0; j < 4; ++j) { const f32x4 gg = gr[64 * j];
        o8[64 * j] = (unsigned long long)pk2(v[j].x * rstd * gg.x, v[j].y * rstd * gg.y) | ((unsigned long long)pk2(v[j].z * rstd * gg.z, v[j].w * rstd * gg.w) << 32); }
}
__device__ __forceinline__ void p0_s5_group(Frame& F, int g) {
    LAS float* AP = (LAS float*)(F.lds);
    LAS float* BB = (LAS float*)(F.lds + 16896);
    LAS float* CC = (LAS float*)(F.lds + 25088);
    LAS float* KJ = (LAS float*)(F.lds + 33280);
    const float* lre = F.in[I_LRE] + g * 64; const float* lim = F.in[I_LIM] + g * 64;
    const double dt = exp((double)F.in[I_LOGDT][g]);
    __syncthreads();
    for (int idx = F.tid; idx < 33 * 64; idx += NTHR) { const int p = idx & 63, j = idx >> 6;
        const double lr = lre[p], li = lim[p]; const double mag = exp(j * lr * dt), ang = j * li * dt;
        AP[idx * 2] = (float)(mag * cos(ang)); AP[idx * 2 + 1] = (float)(mag * sin(ang)); }
    for (int idx = F.tid; idx < 1024; idx += NTHR) { const int p = idx >> 4;
        const double lr = lre[p], li = lim[p]; const double mag = exp(lr * dt), ang = li * dt; const double ar = mag * cos(ang), ai = mag * sin(ang);
        const double nr = ar - 1.0, ni = ai, den = lr * lr + li * li; const double zr = (nr * lr + ni * li) / den, zi = (ni * lr - nr * li) / den;
        const double br = F.in[I_BRE][g * 1024 + idx], bi = F.in[I_BIM][g * 1024 + idx];
        BB[idx * 2] = (float)(zr * br - zi * bi); BB[idx * 2 + 1] = (float)(zr * bi + zi * br); }
    for (int idx = F.tid; idx < 1024; idx += NTHR) { CC[idx * 2] = F.in[I_CRE][g * 1024 + idx]; CC[idx * 2 + 1] = F.in[I_CIM][g * 1024 + idx]; }
    __syncthreads();
    { const int j = F.tid >> 4, hp = F.tid & 15; float s[16];
#pragma unroll
      for (int h = 0; h < 16; ++h) s[h] = 0.f;
      for (int p = 0; p < 64; ++p) { const float cr = CC[(hp * 64 + p) * 2], ci = CC[(hp * 64 + p) * 2 + 1], ar = AP[(j * 64 + p) * 2], ai = AP[(j * 64 + p) * 2 + 1];
          const float er = cr * ar - ci * ai, ei = cr * ai + ci * ar;
#pragma unroll
          for (int h4 = 0; h4 < 8; ++h4) { const f32x4 bb = *(const LAS f32x4*)(BB + (p * 16 + 2 * h4) * 2); s[2 * h4] += er * bb[0] - ei * bb[1]; s[2 * h4 + 1] += er * bb[2] - ei * bb[3]; } }
#pragma unroll
      for (int h = 0; h < 16; ++h) KJ[(j * 16 + hp) * 16 + h] = s[h]; }
    __syncthreads();
    bf16* MT = (bf16*)(F.ws + WS_MT) + (size_t)g * 512 * 640;
    for (int ch = F.tid; ch < 512 * 80; ch += NTHR) { const int n = ch / 80, k0 = (ch % 80) * 8, tp = n >> 4, hp = n & 15; float v[8];
        if (k0 < 512) { const int sp = k0 >> 4, h0 = k0 & 15;
#pragma unroll
            for (int j = 0; j < 8; ++j) v[j] = (sp <= tp) ? KJ[((tp - sp) * 16 + hp) * 16 + h0 + j] : 0.f; }
        else { const bool im = k0 >= 576; const int p0 = k0 - (im ? 576 : 512);
#pragma unroll
            for (int j = 0; j < 8; ++j) { const int p = p0 + j; const float cr = CC[(hp * 64 + p) * 2], ci = CC[(hp * 64 + p) * 2 + 1], ar = AP[((tp + 1) * 64 + p) * 2], ai = AP[((tp + 1) * 64 + p) * 2 + 1];
                v[j] = im ? -(cr * ai + ci * ar) : (cr * ar - ci * ai); } }
        v4u o; o.x = pk2(v[0], v[1]); o.y = pk2(v[2], v[3]); o.z = pk2(v[4], v[5]); o.w = pk2(v[6], v[7]);
        *(GAS v4u*)(MT + (size_t)n * 640 + k0) = o; }
    bf16* WS = (bf16*)(F.ws + WS_WS) + (size_t)g * 256 * 512;
    for (int ch = F.tid; ch < 256 * 64; ch += NTHR) { const int n = ch >> 6, k0 = (ch & 63) * 8, sp = k0 >> 4, h0 = k0 & 15; float v[8];
#pragma unroll
        for (int j = 0; j < 8; ++j) { if (n < 128) { const int p = n & 63; const float ar = AP[((31 - sp) * 64 + p) * 2], ai = AP[((31 - sp) * 64 + p) * 2 + 1], br = BB[(p * 16 + h0 + j) * 2], bi = BB[(p * 16 + h0 + j) * 2 + 1];
                v[j] = (n < 64) ? (ar * br - ai * bi) : (ar * bi + ai * br); } else v[j] = 0.f; }
        v4u o; o.x = pk2(v[0], v[1]); o.y = pk2(v[2], v[3]); o.z = pk2(v[4], v[5]); o.w = pk2(v[6], v[7]);
        *(GAS v4u*)(WS + (size_t)n * 512 + k0) = o; }
    float* A32 = (float*)(F.ws + WS_A32) + g * 128;
    if (F.tid < 128) A32[F.tid] = AP[32 * 128 + F.tid];
    __syncthreads();
}
constexpr size_t MOE_N8_IN = (size_t)NEXP * 1024 * 2048 / 8, MOE_N8 = MOE_N8_IN + (size_t)NEXP * 1024 * 1024 / 8, MOE_N8A = (MOE_N8 / 10) * 9;
__device__ __forceinline__ void moe_convert(Frame& F, size_t lo8, size_t hi8, int vw0, int nvw, int vtotal) {
    const size_t vstride = (size_t)vtotal * NTHR;
    for (int vw = 0; vw < nvw; ++vw)
    for (size_t i0 = lo8 + (size_t)(vw0 + vw) * NTHR + F.tid; i0 < hi8; i0 += 4 * vstride) {
        f32x4 a[4], b[4];
#pragma unroll
        for (int u = 0; u < 4; ++u) { const size_t i = i0 + (size_t)u * vstride; if (i < hi8) { const float* s = (i < MOE_N8_IN) ? F.in[I_WMI] + i * 8 : F.in[I_WMO] + (i - MOE_N8_IN) * 8;
            a[u] = __builtin_nontemporal_load((const f32x4*)s); b[u] = __builtin_nontemporal_load((const f32x4*)s + 1); } }
#pragma unroll
        for (int u = 0; u < 4; ++u) { const size_t i = i0 + (size_t)u * vstride; if (i < hi8) { bf16* d = (i < MOE_N8_IN) ? (bf16*)(F.ws + WS_WMI) + i * 8 : (bf16*)(F.ws + WS_WMO) + (i - MOE_N8_IN) * 8;
            *(GAS v4u*)d = pg8::pack8(a[u], b[u]); } } }
}
__device__ __forceinline__ void p0_prologue(Frame& F) {
    const int NW = F.G - NGRP;
    const bool s5wg = (int)blockIdx.x >= NW;
    TPROBE_BEGIN(120);
    if (s5wg) p0_s5_group(F, (int)blockIdx.x - NW);
    TPROBE_END(120);
    TPROBE_BEGIN(121);
    if (!s5wg) {
    LAS float* scr = (LAS float*)(F.lds + F.wave * 16384);
    const int gw = blockIdx.x * NWAVES + F.wave, NGW = NW * NWAVES;
    { float* cosT = (float*)(F.ws + WS_ROPE); float* sinT = cosT + SEQ * 32;
      for (int i = blockIdx.x * NTHR + F.tid; i < SEQ * 32; i += NW * NTHR) { const int pos = i >> 5, k = i & 31;
          const double inv = pow(10000.0, -(double)k / 32.0); const double ang = (double)pos * (double)(float)inv;
          cosT[i] = (float)cos(ang); sinT[i] = (float)sin(ang); } }
    for (int m = gw; m < NTOK; m += NGW) rms_row_to_bf16(F.lane, F.in[I_X] + (size_t)m * DM, F.in[I_N1G], (bf16*)(F.ws + WS_XN) + (size_t)m * DM);
    constexpr int I_IN = 16 * (NIN_PAD / 32), I_GLU = 8 * 16, I_PS = 8 * 32, I_PA = 8 * 32, I_OUT = 16 * 32;
    constexpr int NITEMS = I_IN + I_GLU + I_PS + I_PA + I_OUT;
    auto decode = [&](int it) -> TItem {
        int r = it; const float* W; bf16* WT; int K, N, ndb, map = 0;
        if (r < I_IN) { W = F.in[I_WIN]; K = DM; N = 4432; WT = (bf16*)(F.ws + WS_WIN); ndb = NIN_PAD / 32; map = 1; }
        else if ((r -= I_IN) < I_GLU) { W = F.in[I_WGLU]; K = 512; N = 512; WT = (bf16*)(F.ws + WS_WGLU); ndb = 16; }
        else if ((r -= I_GLU) < I_PS) { W = F.in[I_WPS]; K = 512; N = 1024; WT = (bf16*)(F.ws + WS_WPS); ndb = 32; }
        else if ((r -= I_PS) < I_PA) { W = F.in[I_WPA]; K = 512; N = 1024; WT = (bf16*)(F.ws + WS_WPA); ndb = 32; }
        else { r -= I_PA; W = F.in[I_WOUT]; K = 1024; N = 1024; WT = (bf16*)(F.ws + WS_WOUT); ndb = 32; }
        const int kb = r / ndb, nb = r % ndb, k0 = 64 * kb, n0 = 32 * nb; int sc = n0 + (F.lane & 31); if (map) sc = win_src(sc);
        TItem T; T.src = (sc >= 0) ? W + (size_t)k0 * N + sc : nullptr; T.dst = WT + (size_t)n0 * K + k0; T.N = N; T.K = K; return T; };
    { float tvA[32], tvB[32]; int it = gw;
      if (it < NITEMS) { TItem TA = decode(it); titem_load(TA, tvA, F.lane);
        for (;;) {
            const int it1 = it + NGW; const bool h1 = it1 < NITEMS; TItem TB = TA; if (h1) { TB = decode(it1); titem_load(TB, tvB, F.lane); }
            titem_store(TA, tvA, scr, F.lane); if (!h1) break;
            const int it2 = it1 + NGW; const bool h2 = it2 < NITEMS; if (h2) { TA = decode(it2); titem_load(TA, tvA, F.lane); }
            titem_store(TB, tvB, scr, F.lane); if (!h2) break;
            it = it2; } } }
    }
    TPROBE_END(121);
    TPROBE_BEGIN(122);
    moe_convert(F, 0, MOE_N8A, s5wg ? 4 * NW + 2 * ((int)blockIdx.x - NW) : 4 * (int)blockIdx.x, s5wg ? 2 : 4, 4 * NW + 2 * NGRP);
    TPROBE_END(122);
}

struct StaticOrder {
    int nM, nN, nwg, G, c;
    __device__ void init(int nM_, int nN_, int G_, int c_) { nM = nM_; nN = nN_; nwg = nM * nN; G = G_; c = c_; }
    __device__ bool tile(int i, int& pm, int& pn) const {
        const long L = (long)i * G + c; if (L >= nwg) return false;
        int wgid = (int)L; { const int q = nwg / pg8::NXCD, r = nwg % pg8::NXCD, xcd = wgid % pg8::NXCD, off = wgid / pg8::NXCD; wgid = (xcd < r ? xcd * (q + 1) : r * (q + 1) + (xcd - r) * q) + off; }
        const int nig = pg8::WGM * nN, gid = wgid / nig, fm = gid * pg8::WGM, gsz = (nM - fm) < pg8::WGM ? (nM - fm) : pg8::WGM;
        pm = fm + ((wgid % nig) % gsz); pn = (wgid % nig) / gsz; return true;
    }
    __device__ bool next(int i, pg8::Unit& u) const { int pm, pn; if (!tile(i, pm, pn)) return false; u.pm = pm; u.pn = pn; u.pa = pm; u.pb = pn; u.e = 0; return true; }
    __device__ __forceinline__ int arow(const pg8::Unit& u, int h, int R) const { return u.pa * 256 + h * 128 + R; }
    __device__ __forceinline__ void done(const pg8::Unit&) const {}
    __device__ __forceinline__ int probe_id() const { return 210; }
};
__device__ __forceinline__ void wg_wait_ge(Frame& F, int word, unsigned target) {
    if (F.tid == 0) { unsigned sp = 0;
        while (__hip_atomic_load((unsigned*)(F.ctl + word), RLX_AGENT) < target) { __builtin_amdgcn_s_sleep(2); if (++sp > (1u << 22)) { __hip_atomic_store((unsigned*)(F.ctl + CW_TMO), 1u, RLX_AGENT); break; } }
        __builtin_amdgcn_fence(__ATOMIC_ACQUIRE, "agent"); asm volatile("s_waitcnt vmcnt(0)" ::: "memory"); }
    __syncthreads();
}
__device__ __forceinline__ void wg_signal(Frame& F, int word) {
    asm volatile("s_waitcnt vmcnt(0)" ::: "memory"); __syncthreads();
    if (F.tid == 0) { __builtin_amdgcn_fence(__ATOMIC_RELEASE, "agent"); asm volatile("s_waitcnt vmcnt(0)" ::: "memory"); (void)__hip_atomic_fetch_add((unsigned*)(F.ctl + word), 1u, RLX_AGENT); }
}
struct InProjOrder {
    int G, c; unsigned* udone;
    __device__ bool next(int i, pg8::Unit& u) const { const int L = i * G + c; if (L >= 64 * (NIN_PAD / 256)) return false; u.pm = L & 63; u.pn = L >> 6; u.pa = u.pm; u.pb = u.pn; u.e = 0; return true; }
    __device__ __forceinline__ int arow(const pg8::Unit& u, int h, int R) const { return u.pa * 256 + h * 128 + R; }
    __device__ __forceinline__ void done(const pg8::Unit& u) const {
        if (u.pn < 2) { asm volatile("s_waitcnt vmcnt(0)" ::: "memory");
            if ((threadIdx.x & 63) == 0) (void)__hip_atomic_fetch_add(udone, 1u, RLX_AGENT); } }
    __device__ __forceinline__ int probe_id() const { return 211; }
};
struct S5StateOrder {
    int c;
    __device__ bool next(int i, pg8::Unit& u) const { if (i > 0 || c >= 64) return false; const int g = c >> 1, pm = c & 1; u.pm = pm; u.pn = 0; u.pa = g * 2 + pm; u.pb = g; u.e = g; return true; }
    __device__ __forceinline__ int arow(const pg8::Unit& u, int h, int R) const { return u.pa * 256 + h * 128 + R; }
    __device__ __forceinline__ void done(const pg8::Unit&) const {}
    __device__ __forceinline__ int probe_id() const { return 212; }
};
struct S5YOrder {
    int c;
    __device__ bool next(int i, pg8::Unit& u) const { if (i > 0 || c >= 128) return false; const int g = c >> 2, pm = (c >> 1) & 1, pn = c & 1; u.pm = pm; u.pn = pn; u.pa = g * 2 + pm; u.pb = g * 2 + pn; u.e = g; return true; }
    __device__ __forceinline__ int arow(const pg8::Unit& u, int h, int R) const { return u.pa * 256 + h * 128 + R; }
    __device__ __forceinline__ void done(const pg8::Unit&) const {}
    __device__ __forceinline__ int probe_id() const { return 213; }
};
struct MixOrder {
    StaticOrder so;
    __device__ bool next(int i, pg8::Unit& u) const { int pm, pn; if (!so.tile(i >> 1, pm, pn)) return false; const int h = i & 1; u.pm = pm; u.pn = pn; u.pa = pm + 64 * h; u.pb = pn + 4 * h; u.e = h; return true; }
    __device__ __forceinline__ int arow(const pg8::Unit& u, int h, int R) const { return u.pa * 256 + h * 128 + R; }
    __device__ __forceinline__ void done(const pg8::Unit&) const {}
    __device__ __forceinline__ int probe_id() const { return 214; }
};
struct MoeOrder {
    const volatile LAS int* te; const volatile LAS int* off; const volatile LAS int* cnt; const int* rowmap; int TT, NTN, c;
    __device__ bool next(int i, pg8::Unit& u) const {
        const int xcd = c & 7, j = c >> 3, mpx = 32 / NTN; const int mt = i * (8 * mpx) + xcd * mpx + j / NTN, pn = j % NTN;
        if (mt >= TT) return false; const int e = te[mt]; u.pm = mt; u.pn = pn; u.pa = mt; u.pb = e * NTN + pn; u.e = e; return true; }
    __device__ __forceinline__ int arow(const pg8::Unit& u, int h, int R) const {
        if (!rowmap) return u.pa * 256 + h * 128 + R;
        const int lr = u.pm * 256 - off[u.e] + h * 128 + R;
        return lr < cnt[u.e] ? rowmap[(size_t)u.e * NTOK + lr] : 0; }
    __device__ __forceinline__ void done(const pg8::Unit&) const {}
    __device__ __forceinline__ int probe_id() const { return 215; }
};

using pg8::f32x2; using pg8::u32x2; using pg8::pack8; using pg8::cvt_pk_bf16;
#define EPI_ROWS_BEGIN _Pragma("unroll") for (int ai = 0; ai < 2; ++ai) _Pragma("unroll") for (int m = 0; m < 4; ++m) { asm volatile("" ::: "memory"); const int row = u.pm * 256 + ai * 128 + wr * 64 + m * 16 + fr; (void)row;
#define EPI_COLS_BEGIN _Pragma("unroll") for (int bj = 0; bj < 2; ++bj) { const int ct = bj * 128 + wc * 32 + fq * 8; (void)ct; f32x4 v0 = acc[ai][bj][m][0], v1 = acc[ai][bj][m][1];
#define EPI_END } }
#define EPI_FENCE asm volatile("" ::: "memory")
#define EPI_ALLROWS _Pragma("unroll") for (int ai = 0; ai < 2; ++ai) _Pragma("unroll") for (int m = 0; m < 4; ++m)
#define EPI_ROW(ai, m) (u.pm * 256 + (ai) * 128 + wr * 64 + (m) * 16 + fr)
struct EpiInProj {
    static constexpr bool PERM = true;
    unsigned char* ws; const float* bgate;
    __device__ __forceinline__ void rope(f32x4& v0, f32x4& v1, const f32x4& c, const f32x4& s) const { const f32x4 o1 = v0 * c - v1 * s, o2 = v1 * c + v0 * s; v0 = o1; v1 = o2; }
    __device__ __forceinline__ unsigned pk8(const f32x4& v) const { unsigned w = 0; w = __builtin_amdgcn_cvt_pk_fp8_f32(v[0], v[1], w, false); w = __builtin_amdgcn_cvt_pk_fp8_f32(v[2], v[3], w, true); return w; }
    __device__ __forceinline__ void store_rope8(unsigned off, const f32x4& o1, const f32x4& o2) const { *(GAS unsigned*)(ws + off) = pk8(o1); *(GAS unsigned*)(ws + off + 32u) = pk8(o2); }
    __device__ __forceinline__ void store_rope(unsigned off, const f32x4& o1, const f32x4& o2) const {
        u32x2 a, b; a.x = cvt_pk_bf16(o1[0], o1[1]); a.y = cvt_pk_bf16(o1[2], o1[3]); b.x = cvt_pk_bf16(o2[0], o2[1]); b.y = cvt_pk_bf16(o2[2], o2[3]);
        *(GAS u32x2*)(ws + off) = a; *(GAS u32x2*)(ws + off + 64u) = b;
    }
    __device__ __forceinline__ void operator()(const f32x4 (&acc)[2][2][4][2], const pg8::Unit& u, int wr, int wc, int fr, int fq) const {
        asm volatile("" : "+v"(fr), "+v"(fq));
        const int pn = u.pn;
        f32x4 rc[2][4], rs[2][4];
        if (pn >= 2 && pn <= 9) { const int a = (wc & 1) * 4 + fq;
            EPI_ALLROWS { const unsigned o = (unsigned)WS_ROPE + (unsigned)((EPI_ROW(ai, m) & 4095) * 32 + 4 * a) * 4u; rc[ai][m] = *(const GAS f32x4*)(ws + o); rs[ai][m] = *(const GAS f32x4*)(ws + o + (unsigned)(SEQ * 32 * 4)); }
            EPI_FENCE; }
        if (pn < 2) {
            EPI_ROWS_BEGIN const int bb = row >> 12, cc = (row >> 5) & 127, sp = row & 31;
            EPI_COLS_BEGIN const int col = pn * 256 + ct, g = col >> 4, h0 = col & 15;
                { const unsigned uo_ = (unsigned)WS_UGX + (unsigned)((g * 512 + bb * 128 + cc) * UGX_LD + sp * 16 + h0) * 2u; const pg8::u32x4 ud_ = pack8(v0, v1);
                  asm volatile("global_store_dwordx4 %0, %1, %2 sc0 sc1\n\ts_nop 1" :: "v"(uo_), "v"(ud_), "s"(ws) : "memory"); }
            EPI_END
        } else if (pn < 4) {
            EPI_ROWS_BEGIN
            EPI_COLS_BEGIN const int j = (pn - 2) * 256 + ct, head = j >> 6, a = (j & 63) >> 3;
                rope(v0, v1, rc[ai][m], rs[ai][m]); store_rope8((unsigned)WS_Q + (unsigned)(row * 512 + head * 64 + 4 * a), v0, v1);
            EPI_END
        } else if (pn == 4) {
            EPI_ROWS_BEGIN
            EPI_COLS_BEGIN
                if (bj == 0) { const int head = ct >> 6, a = (ct & 63) >> 3; rope(v0, v1, rc[ai][m], rs[ai][m]); store_rope8((unsigned)WS_K + (unsigned)(row * 128 + head * 64 + 4 * a), v0, v1); }
                else { u32x2 w8; w8.x = pk8(v0); w8.y = pk8(v1); *(GAS u32x2*)(ws + ((unsigned)WS_V + (unsigned)(row * 128 + (ct - 128)))) = w8; }
            EPI_END
        } else if (pn < 9) {
            EPI_ROWS_BEGIN
            EPI_COLS_BEGIN const int j = (pn - 5) * 256 + ct, head = j >> 6, a = (j & 63) >> 3;
                rope(v0, v1, rc[ai][m], rs[ai][m]); store_rope((unsigned)WS_QI + (unsigned)(row * 1024 + head * 64 + 4 * a) * 2u, v0, v1);
            EPI_END
        } else if (pn == 9) {
            EPI_ROWS_BEGIN
            EPI_COLS_BEGIN
                if (bj == 0) { if (ct < 64) { const int a = ct >> 3; rope(v0, v1, rc[ai][m], rs[ai][m]); store_rope((unsigned)WS_KI + (unsigned)(row * 64 + 4 * a) * 2u, v0, v1); }
                    else if (ct < 80) { const unsigned o = (unsigned)WS_WI + (unsigned)(row * 16 + (ct - 64)) * 4u; *(GAS f32x4*)(ws + o) = v0 * 0.03125f; *(GAS f32x4*)(ws + o + 16u) = v1 * 0.03125f; } }
            EPI_END
        } else {
            const int br = pn >= 14; const unsigned gbase = br ? (unsigned)WS_GA : (unsigned)WS_GS; const float* bgp = bgate + br * 1024 + (pn - (br ? 14 : 10)) * 256 + wc * 32 + fq * 8;
            f32x4 bb[2][2];
#pragma unroll
            for (int bj = 0; bj < 2; ++bj) { bb[bj][0] = *(const GAS f32x4*)(bgp + bj * 128); bb[bj][1] = *(const GAS f32x4*)(bgp + bj * 128 + 4); }
            EPI_ROWS_BEGIN
            EPI_COLS_BEGIN const int col = (pn - (br ? 14 : 10)) * 256 + ct;
#pragma unroll
                for (int j = 0; j < 4; ++j) { v0[j] = sigmoidf_(v0[j] + bb[bj][0][j]); v1[j] = sigmoidf_(v1[j] + bb[bj][1][j]); }
                *(GAS v4u*)(ws + (gbase + (unsigned)(row * 1024 + col) * 2u)) = pack8(v0, v1);
            EPI_END
        }
    }
};
struct EpiS5State {
    static constexpr bool PERM = true;
    float* SB;
    __device__ __forceinline__ void operator()(const f32x4 (&acc)[2][2][4][2], const pg8::Unit& u, int wr, int wc, int fr, int fq) const {
        EPI_ROWS_BEGIN
        EPI_COLS_BEGIN
            if (bj == 0) { float* d = SB + ((size_t)u.e * 512 + row) * 128 + ct; *(GAS f32x4*)d = v0; *(GAS f32x4*)(d + 4) = v1; }
        EPI_END
    }
};
struct EpiS5Y {
    static constexpr bool PERM = true;
    const bf16* UGX; const float* Dsk; bf16* YG;
    __device__ __forceinline__ void operator()(const f32x4 (&acc)[2][2][4][2], const pg8::Unit& u, int wr, int wc, int fr, int fq) const {
        const int g = u.e;
        const f32x4 d0 = *(const GAS f32x4*)(Dsk + g * 16 + ((fq * 8) & 15)), d1 = *(const GAS f32x4*)(Dsk + g * 16 + ((fq * 8) & 15) + 4);
        v4u ux[2][4][2];
        EPI_ALLROWS {
#pragma unroll
            for (int bj = 0; bj < 2; ++bj) ux[ai][m][bj] = *(const GAS v4u*)(UGX + ((size_t)g * 512 + EPI_ROW(ai, m)) * UGX_LD + u.pn * 256 + bj * 128 + wc * 32 + fq * 8); }
        EPI_FENCE;
        EPI_ROWS_BEGIN const int bb = row >> 7, cc = row & 127;
        EPI_COLS_BEGIN const int n = u.pn * 256 + ct, tp = n >> 4, h0 = n & 15;
            const v4u uu = ux[ai][m][bj];
            v0[0] += d0[0] * bflo(uu.x); v0[1] += d0[1] * bfhi(uu.x); v0[2] += d0[2] * bflo(uu.y); v0[3] += d0[3] * bfhi(uu.y);
            v1[0] += d1[0] * bflo(uu.z); v1[1] += d1[1] * bfhi(uu.z); v1[2] += d1[2] * bflo(uu.w); v1[3] += d1[3] * bfhi(uu.w);
#pragma unroll
            for (int j = 0; j < 4; ++j) { v0[j] = gelu_tanh(v0[j]); v1[j] = gelu_tanh(v1[j]); }
            const int tok = bb * 4096 + cc * 32 + tp;
            *(GAS v4u*)(YG + (size_t)tok * 512 + g * 16 + h0) = pack8(v0, v1);
        EPI_END
    }
};
struct EpiGlu {
    static constexpr bool PERM = true;
    const bf16* YG; const float* bglu; bf16* YS;
    __device__ __forceinline__ void operator()(const f32x4 (&acc)[2][2][4][2], const pg8::Unit& u, int wr, int wc, int fr, int fq) const {
        f32x4 bb[2][2]; v4u yx[2][4][2];
#pragma unroll
        for (int bj = 0; bj < 2; ++bj) { const float* bp = bglu + u.pn * 256 + bj * 128 + wc * 32 + fq * 8; bb[bj][0] = *(const GAS f32x4*)bp; bb[bj][1] = *(const GAS f32x4*)(bp + 4); }
        EPI_ALLROWS {
#pragma unroll
            for (int bj = 0; bj < 2; ++bj) yx[ai][m][bj] = *(const GAS v4u*)(YG + (size_t)EPI_ROW(ai, m) * 512 + u.pn * 256 + bj * 128 + wc * 32 + fq * 8); }
        EPI_FENCE;
        EPI_ROWS_BEGIN
        EPI_COLS_BEGIN const int col = u.pn * 256 + ct;
            const v4u yy = yx[ai][m][bj];
            const f32x4 b0 = bb[bj][0], b1 = bb[bj][1];
            v0[0] = bflo(yy.x) * sigmoidf_(v0[0] + b0[0]); v0[1] = bfhi(yy.x) * sigmoidf_(v0[1] + b0[1]); v0[2] = bflo(yy.y) * sigmoidf_(v0[2] + b0[2]); v0[3] = bfhi(yy.y) * sigmoidf_(v0[3] + b0[3]);
            v1[0] = bflo(yy.z) * sigmoidf_(v1[0] + b1[0]); v1[1] = bfhi(yy.z) * sigmoidf_(v1[1] + b1[1]); v1[2] = bflo(yy.w) * sigmoidf_(v1[2] + b1[2]); v1[3] = bfhi(yy.w) * sigmoidf_(v1[3] + b1[3]);
            *(GAS v4u*)(YS + (size_t)row * 512 + col) = pack8(v0, v1);
        EPI_END
    }
};
struct EpiMix {
    static constexpr bool PERM = true;
    const bf16* GS; const bf16* GA; bf16* MX;
    __device__ __forceinline__ void operator()(const f32x4 (&acc)[2][2][4][2], const pg8::Unit& u, int wr, int wc, int fr, int fq) const {
        const bf16* Gp = u.e ? GA : GS;
        EPI_ROWS_BEGIN
        EPI_COLS_BEGIN const size_t off = (size_t)row * 1024 + u.pn * 256 + ct;
            const v4u gg = *(const GAS v4u*)(Gp + off);
            v0[0] *= bflo(gg.x); v0[1] *= bfhi(gg.x); v0[2] *= bflo(gg.y); v0[3] *= bfhi(gg.y); v1[0] *= bflo(gg.z); v1[1] *= bfhi(gg.z); v1[2] *= bflo(gg.w); v1[3] *= bfhi(gg.w);
            if (u.e) { const v4u pp = *(const GAS v4u*)(MX + off);
                v0[0] += bflo(pp.x); v0[1] += bfhi(pp.x); v0[2] += bflo(pp.y); v0[3] += bfhi(pp.y); v1[0] += bflo(pp.z); v1[1] += bfhi(pp.z); v1[2] += bflo(pp.w); v1[3] += bfhi(pp.w); }
            *(GAS v4u*)(MX + off) = pack8(v0, v1);
        EPI_END
    }
};
struct EpiOut {
    static constexpr bool PERM = true;
    const float* X; bf16* X1;
    __device__ __forceinline__ void operator()(const f32x4 (&acc)[2][2][4][2], const pg8::Unit& u, int wr, int wc, int fr, int fq) const {
        f32x4 xr[4][2][2];
#pragma unroll
        for (int m = 0; m < 4; ++m)
#pragma unroll
            for (int bj = 0; bj < 2; ++bj) { const float* xp = X + (size_t)EPI_ROW(0, m) * 1024 + u.pn * 256 + bj * 128 + wc * 32 + fq * 8; xr[m][bj][0] = *(const GAS f32x4*)xp; xr[m][bj][1] = *(const GAS f32x4*)(xp + 4); }
        EPI_FENCE;
        EPI_ROWS_BEGIN
        EPI_COLS_BEGIN const size_t off = (size_t)row * 1024 + u.pn * 256 + ct;
            *(GAS v4u*)(X1 + off) = pack8(v0 + xr[m][bj][0], v1 + xr[m][bj][1]);
            if (ai == 0) { const float* xp = X + off + (size_t)128 * 1024; xr[m][bj][0] = *(const GAS f32x4*)xp; xr[m][bj][1] = *(const GAS f32x4*)(xp + 4); }
        EPI_END
    }
};
struct EpiMoe1 {
    static constexpr bool PERM = true;
    const float* bmi; bf16* ACT;
    __device__ __forceinline__ void operator()(const f32x4 (&acc)[2][2][4][2], const pg8::Unit& u, int wr, int wc, int fr, int fq) const {
        const float* bp = bmi + (size_t)u.e * 2048 + u.pn * 256 + wc * 32 + fq * 8;
        f32x4 bb[2][2];
#pragma unroll
        for (int bj = 0; bj < 2; ++bj) { bb[bj][0] = *(const GAS f32x4*)(bp + bj * 128); bb[bj][1] = *(const GAS f32x4*)(bp + bj * 128 + 4); }
        EPI_ROWS_BEGIN
        EPI_COLS_BEGIN const int col = u.pn * 256 + ct;
            v0 += bb[bj][0]; v1 += bb[bj][1]; float o[4];
#pragma unroll
            for (int j = 0; j < 4; ++j) { const float zg0 = (j < 2) ? v0[2 * j] : v1[2 * j - 4], zl0 = (j < 2) ? v0[2 * j + 1] : v1[2 * j - 3];
                const float zg = fminf(zg0, 7.0f), zl = fminf(fmaxf(zl0, -7.0f), 7.0f); o[j] = zg * __builtin_amdgcn_rcpf(1.0f + __builtin_amdgcn_exp2f(-2.4554669595930157f * zg)) * (zl + 1.0f); }
            u32x2 w; w.x = cvt_pk_bf16(o[0], o[1]); w.y = cvt_pk_bf16(o[2], o[3]);
            *(GAS u32x2*)(ACT + (size_t)row * 1024 + (col >> 1)) = w;
        EPI_END
    }
};
struct EpiMoe2 {
    static constexpr bool PERM = true;
    const float* bmo; bf16* Y2;
    __device__ __forceinline__ void operator()(const f32x4 (&acc)[2][2][4][2], const pg8::Unit& u, int wr, int wc, int fr, int fq) const {
        const float* bp = bmo + (size_t)u.e * 1024 + u.pn * 256 + wc * 32 + fq * 8;
        f32x4 bb[2][2];
#pragma unroll
        for (int bj = 0; bj < 2; ++bj) { bb[bj][0] = *(const GAS f32x4*)(bp + bj * 128); bb[bj][1] = *(const GAS f32x4*)(bp + bj * 128 + 4); }
        EPI_ROWS_BEGIN
        EPI_COLS_BEGIN const int col = u.pn * 256 + ct;
            v0 += bb[bj][0]; v1 += bb[bj][1];
            *(GAS v4u*)(Y2 + (size_t)row * 1024 + col) = pack8(v0, v1);
        EPI_END
    }
};

__device__ __forceinline__ unsigned f16key(unsigned bits) { return (bits & 0x8000u) ? (bits ^ 0xffffu) : (bits | 0x8000u); }
__device__ __forceinline__ void idx_phase(Frame& F) {
    LAS unsigned char* lds = F.lds;
    LAS u16* SC = (LAS u16*)lds;
    LAS unsigned char* KT = lds + 65536;
    LAS unsigned* HP = (LAS unsigned*)(lds + 147456);
    LAS unsigned char* OLB = lds + 147456 + 4096;
    const bf16* QI = (const bf16*)(F.ws + WS_QI); const bf16* KI = (const bf16*)(F.ws + WS_KI); const float* WI = (const float*)(F.ws + WS_WI);
    u16* SEL = (u16*)(F.ws + WS_SEL);
    const int tid = F.tid, lane = F.lane, wave = F.wave, qg = wave & 1, kq = wave >> 1, kgrp = lane >> 4, l15 = lane & 15;
    const int kx = l15 >> 1, cpos = lane & 7;
    const int dsw = ((wave & 1) * 4 + (lane >> 4)) & 7;
    bf16x8 qa[4][2]; float w[16];
#define IDX_UNIT(r_, b_, t0_) const int b_ = (r_) >> 1, t0_ = (((r_) & 1) ? 511 - (int)blockIdx.x : (int)blockIdx.x) * 8
#define IDX_DMA(kb_, st, bufi) do { _Pragma("unroll") for (int j_ = 0; j_ < 2; ++j_) { const int row_ = (j_ * 8 + wave) * 8 + (lane >> 3); \
        __builtin_amdgcn_global_load_lds((const unsigned*)((kb_) + ((size_t)(st) * 128 + row_) * 64 + ((cpos ^ dsw) << 3)), (LAS unsigned*)(KT + (bufi) * 16384 + (j_ * 8 + wave) * 1024), 16, 0, 0); } } while (0)
#define IDX_PREFETCH(r_) do { IDX_UNIT(r_, pb_, pt0_); if (pt0_ >= 256) { \
        const bf16* qp_ = QI + ((size_t)pb_ * SEQ + pt0_ + 4 * qg + (l15 >> 2)) * 1024 + (l15 & 3) * 64 + kgrp * 8; \
        _Pragma("unroll") for (int i = 0; i < 4; ++i) _Pragma("unroll") for (int ks = 0; ks < 2; ++ks) qa[i][ks] = *(const GAS bf16x8*)(qp_ + i * 256 + ks * 32); \
        const float* wp_ = WI + ((size_t)pb_ * SEQ + pt0_ + 4 * qg + kgrp) * 16; \
        _Pragma("unroll") for (int i = 0; i < 4; ++i) { const f32x4 x = *(const GAS f32x4*)(wp_ + 4 * i); w[4 * i] = x[0]; w[4 * i + 1] = x[1]; w[4 * i + 2] = x[2]; w[4 * i + 3] = x[3]; } \
        const bf16* pk_ = KI + (size_t)pb_ * SEQ * 64; const int pn_ = (pt0_ + 7) / 128 + 1; \
        IDX_DMA(pk_, 0, 0); if (1 < pn_) IDX_DMA(pk_, 1, 1); if (2 < pn_) IDX_DMA(pk_, 2, 2); if (3 < pn_) IDX_DMA(pk_, 3, 3); } } while (0)
    IDX_PREFETCH(0);
    for (int r = 0; r < 8; ++r) {
        IDX_UNIT(r, b, t0);
        __syncthreads();
        const int t = t0 + wave; const size_t tok = (size_t)b * SEQ + t;
        if (t0 < 256) {
            v2u x; const int k0 = lane * 4;
            x.x = (unsigned)(k0 <= t ? k0 : 0) | ((unsigned)(k0 + 1 <= t ? k0 + 1 : 0) << 16); x.y = (unsigned)(k0 + 2 <= t ? k0 + 2 : 0) | ((unsigned)(k0 + 3 <= t ? k0 + 3 : 0) << 16);
            *(GAS v2u*)(SEL + tok * NSEL + k0) = x;
            if (r + 1 < 8) IDX_PREFETCH(r + 1);
            continue;
        }
        HP[tid * 2] = 0u; HP[tid * 2 + 1] = 0u;
        const int nst = (t0 + 7) / 128 + 1;
        const int tq = t0 + 4 * qg + kgrp, qrow = 4 * qg + kgrp;
        const bf16* kbat = KI + (size_t)b * SEQ * 64;
        const unsigned hpq = (unsigned)(unsigned long)(HP + qrow * 128);
#define IDX_EPI1(kgl_, AC) do { float s0 = 0.f; \
            _Pragma("unroll") for (int i = 0; i < 4; ++i) _Pragma("unroll") for (int r_ = 0; r_ < 4; ++r_) { const float a0_ = AC[i][r_]; const int i0 = __builtin_bit_cast(int, a0_); const float m0 = __builtin_bit_cast(float, i0 > 0 ? i0 : 0); s0 += w[4 * i + r_] * m0; } \
            const _Float16 h0_ = (_Float16)s0; const unsigned key0_ = f16key(__builtin_bit_cast(unsigned short, h0_)); const int kg0 = (kgl_); \
            SC[qrow * 4096 + kg0] = (u16)key0_; \
            if (kg0 <= tq) { const unsigned bin = key0_ >> 8; const unsigned ha_ = hpq + ((bin >> 1) << 2), hv_ = (bin & 1u) ? 0x10000u : 1u; \
                asm volatile("ds_add_u32 %0, %1" :: "v"(ha_), "v"(hv_) : "memory"); } } while (0)
#define IDX_READ(BQ, kt2) do { _Pragma("unroll") for (int ks = 0; ks < 2; ++ks) BQ[ks] = *(const LAS bf16x8*)(kb + (kq * 32 + (kt2) * 16 + l15) * 128 + (((ks * 4 + kgrp) ^ kx) << 4)); } while (0)
#define IDX_MMA(AC, BQ) do { _Pragma("unroll") for (int i = 0; i < 4; ++i) { AC[i] = (f32x4){0.f, 0.f, 0.f, 0.f}; _Pragma("unroll") for (int ks = 0; ks < 2; ++ks) AC[i] = __builtin_amdgcn_mfma_f32_16x16x32_bf16(qa[i][ks], BQ[ks], AC[i], 0, 0, 0); } } while (0)
        bf16x8 bq0[2], bq1[2];
        f32x4 aA[4], aB[4];
#pragma unroll
        for (int i = 0; i < 4; ++i) { aA[i] = (f32x4){0.f, 0.f, 0.f, 0.f}; aB[i] = aA[i]; }
        int bcur = 0, bnew = 4;
        TPROBE_BEGIN(100);
        for (int st = 0; st < nst; ++st) {
            if (st + 3 < nst) asm volatile("s_waitcnt vmcnt(6)" ::: "memory"); else asm volatile("s_waitcnt vmcnt(0)" ::: "memory");
            __syncthreads();
            if (st + 4 < nst) IDX_DMA(kbat, st + 4, bnew);
            const LAS unsigned char* kb = KT + bcur * 16384;
            const int kbase_ = st * 128 + kq * 32 + l15;
            IDX_READ(bq0, 0);
            IDX_READ(bq1, 1); IDX_MMA(aA, bq0); if (st >= 1) IDX_EPI1(kbase_ - 128 + 16, aB);
            IDX_MMA(aB, bq1); IDX_EPI1(kbase_, aA);
            bcur = (bcur == 4) ? 0 : bcur + 1; bnew = (bnew == 4) ? 0 : bnew + 1;
        }
        IDX_EPI1((nst - 1) * 128 + kq * 32 + l15 + 16, aB);
#undef IDX_EPI1
#undef IDX_MMA
#undef IDX_READ
        __syncthreads();
        TPROBE_END(100);
        TPROBE_BEGIN(101);
        TPROBE_BEGIN(110);
        if (r + 1 < 8) IDX_PREFETCH(r + 1);
        const int n = t + 1, jj = lane, ql = wave;
        const LAS u16* sc = SC + ql * 4096;
        LAS unsigned* hp = HP + ql * 128;
        unsigned b1, need1;
        { const v2u wv = *(const LAS v2u*)(hp + 126 - 2 * jj); unsigned hb[4];
          hb[3] = wv.x & 0xffffu; hb[2] = wv.x >> 16; hb[1] = wv.y & 0xffffu; hb[0] = wv.y >> 16;
          const unsigned s4 = hb[0] + hb[1] + hb[2] + hb[3];
          unsigned pre = s4;
#pragma unroll
          for (int o = 1; o < 64; o <<= 1) { const unsigned x = __shfl_up(pre, o, 64); if (jj >= o) pre += x; }
          const unsigned long long bal = __ballot(pre >= 256u); const int js = __builtin_ctzll(bal);
          unsigned above = pre - s4, bb1 = 0, nd1 = 0; bool found = false;
#pragma unroll
          for (int i = 0; i < 4; ++i) { if (!found) { if (above + hb[i] >= 256u) { bb1 = 255 - (jj * 4 + i); nd1 = 256u - above; found = true; } else above += hb[i]; } }
          b1 = __shfl(bb1, js); need1 = __shfl(nd1, js); }
        TPROBE_END(110);
        TPROBE_BEGIN(111);
        LDS_WAIT(); __builtin_amdgcn_wave_barrier();
#define LDS_ST32(addr_, val_) asm volatile("ds_write_b32 %0, %1" :: "v"((unsigned)(addr_)), "v"((unsigned)(val_)) : "memory")
#define LDS_ST16(addr_, val_) asm volatile("ds_write_b16 %0, %1" :: "v"((unsigned)(addr_)), "v"((unsigned)(val_)) : "memory")
#define LDS_ADD32(addr_, val_) asm volatile("ds_add_u32 %0, %1" :: "v"((unsigned)(addr_)), "v"((unsigned)(val_)) : "memory")
        const unsigned hpw = (unsigned)(unsigned long)hp, scw = (unsigned)(unsigned long)sc;
        LDS_ST32(hpw + jj * 8, 0u); LDS_ST32(hpw + jj * 8 + 4, 0u);
        const int nit = (n + 511) >> 9;
        { const int base = (nit - 1) * 512 + jj * 8;
#pragma unroll
          for (int e = 0; e < 8; ++e) if (base + e >= n) LDS_ST16(scw + (base + e) * 2, 0u); }
        LDS_WAIT(); __builtin_amdgcn_wave_barrier();
        const unsigned B1 = b1 | (b1 << 16);
#pragma unroll 4
        for (int it = 0; it < nit; ++it) { const int base = it * 512 + jj * 8; const v4u x = *(const LAS v4u*)(sc + base);
#pragma unroll
            for (int i = 0; i < 4; ++i) { const unsigned d = (i == 0) ? x.x : (i == 1) ? x.y : (i == 2) ? x.z : x.w; const unsigned m = ((d >> 8) & 0x00ff00ffu) ^ B1;
                const unsigned l0 = d & 255u, l1 = (d >> 16) & 255u;
                LDS_ADD32(hpw + ((l0 >> 1) << 2), ((m & 0xffffu) == 0u) ? ((l0 & 1u) ? 0x10000u : 1u) : 0u);
                LDS_ADD32(hpw + ((l1 >> 1) << 2), ((m >> 16) == 0u) ? ((l1 & 1u) ? 0x10000u : 1u) : 0u); } }
        LDS_WAIT(); __builtin_amdgcn_wave_barrier();
        TPROBE_END(111);
        TPROBE_BEGIN(112);
        unsigned T, need2;
        { const v2u wv = *(const LAS v2u*)(hp + 126 - 2 * jj); unsigned hb[4];
          hb[3] = wv.x & 0xffffu; hb[2] = wv.x >> 16; hb[1] = wv.y & 0xffffu; hb[0] = wv.y >> 16;
          const unsigned s4 = hb[0] + hb[1] + hb[2] + hb[3];
          unsigned pre = s4;
#pragma unroll
          for (int o = 1; o < 64; o <<= 1) { const unsigned x = __shfl_up(pre, o, 64); if (jj >= o) pre += x; }
          const unsigned long long bal = __ballot(pre >= need1); const int js = __builtin_ctzll(bal);
          unsigned above = pre - s4, bb2 = 0, nd2 = 0; bool found = false;
#pragma unroll
          for (int i = 0; i < 4; ++i) { if (!found) { if (above + hb[i] >= need1) { bb2 = 255 - (jj * 4 + i); nd2 = need1 - above; found = true; } else above += hb[i]; } }
          const unsigned b2 = __shfl(bb2, js); need2 = __shfl(nd2, js); T = (b1 << 8) | b2; }
        TPROBE_END(112);
        TPROBE_BEGIN(113);
        const unsigned olw = (unsigned)(unsigned long)(OLB + ql * 512);
        const unsigned G = 256u - need2, Tp = T | (T << 16); unsigned cg = 0, tc = 0;
#pragma unroll 2
        for (int it = 0; it < nit; ++it) { const int base = it * 512 + jj * 8; const v4u x = *(const LAS v4u*)(sc + base);
            unsigned g[8], c = 0, anyeq = 0;
#pragma unroll
            for (int i = 0; i < 4; ++i) { const unsigned d = (i == 0) ? x.x : (i == 1) ? x.y : (i == 2) ? x.z : x.w;
                g[2 * i] = ((d & 0xffffu) > T) ? 1u : 0u; g[2 * i + 1] = ((d >> 16) > T) ? 1u : 0u; c += g[2 * i] + g[2 * i + 1];
                const unsigned q = d ^ Tp; anyeq |= (((q & 0xffffu) == 0u) || ((q >> 16) == 0u)) ? 1u : 0u; }
            const unsigned long long m0 = __ballot(c & 1u), m1 = __ballot(c & 2u), m2 = __ballot(c & 4u), m3 = __ballot(c & 8u);
            unsigned pos = cg + __builtin_amdgcn_mbcnt_hi((unsigned)(m0 >> 32), __builtin_amdgcn_mbcnt_lo((unsigned)m0, 0u)) + 2u * __builtin_amdgcn_mbcnt_hi((unsigned)(m1 >> 32), __builtin_amdgcn_mbcnt_lo((unsigned)m1, 0u))
                         + 4u * __builtin_amdgcn_mbcnt_hi((unsigned)(m2 >> 32), __builtin_amdgcn_mbcnt_lo((unsigned)m2, 0u)) + 8u * __builtin_amdgcn_mbcnt_hi((unsigned)(m3 >> 32), __builtin_amdgcn_mbcnt_lo((unsigned)m3, 0u));
            cg += (unsigned)__builtin_popcountll(m0) + 2u * (unsigned)__builtin_popcountll(m1) + 4u * (unsigned)__builtin_popcountll(m2) + 8u * (unsigned)__builtin_popcountll(m3);
#pragma unroll
            for (int e = 0; e < 8; ++e) { const unsigned a_ = olw + ((pos < 256u ? pos : 255u) << 1); if (g[e]) LDS_ST16(a_, base + e); pos += g[e]; }
            if (__ballot(anyeq) != 0ull) {
#pragma unroll
                for (int e = 0; e < 8; ++e) { const unsigned wd = (e < 2) ? x.x : (e < 4) ? x.y : (e < 6) ? x.z : x.w; const unsigned k = (e & 1) ? (wd >> 16) : (wd & 0xffffu);
                    const bool eq = k == T; const unsigned long long me = __ballot(eq);
                    const unsigned pe = tc + __builtin_amdgcn_mbcnt_hi((unsigned)(me >> 32), __builtin_amdgcn_mbcnt_lo((unsigned)me, 0u));
                    if (eq && pe < need2) LDS_ST16(olw + ((G + pe) << 1), base + e);
                    tc += (unsigned)__builtin_popcountll(me); } } }
#undef LDS_ST32
#undef LDS_ST16
#undef LDS_ADD32
        LDS_WAIT(); __builtin_amdgcn_wave_barrier();
        { const v2u x = *(const LAS v2u*)((LAS u16*)(OLB + ql * 512) + jj * 4); *(GAS v2u*)(SEL + tok * NSEL + jj * 4) = x; }
        TPROBE_END(113);
        TPROBE_END(101);
    }
#undef IDX_DMA
#undef IDX_PREFETCH
#undef IDX_UNIT
}

__device__ __forceinline__ void carry_phase(Frame& F) {
    const int gid = blockIdx.x * NTHR + F.tid; if (gid >= NGRP * NB * 64) return;
    const int p = gid & 63, b = (gid >> 6) & 3, g = gid >> 8;
    const float* A32 = (const float*)(F.ws + WS_A32) + g * 128; const float ar = A32[p * 2], ai = A32[p * 2 + 1];
    const float* SB = (const float*)(F.ws + WS_SBUF) + ((size_t)g * 512 + b * 128) * 128; bf16* UX = (bf16*)(F.ws + WS_UGX) + ((size_t)g * 512 + b * 128) * UGX_LD;
    float xr = 0.f, xi = 0.f;
    for (int c = 0; c < NCH; ++c) {
        UX[(size_t)c * UGX_LD + 512 + p] = (bf16)f2bf(xr); UX[(size_t)c * UGX_LD + 576 + p] = (bf16)f2bf(xi);
        const float sr = SB[c * 128 + p], si = SB[c * 128 + 64 + p];
        const float nr = ar * xr - ai * xi + sr, ni = ar * xi + ai * xr + si; xr = nr; xi = ni;
    }
}

template <int N> __device__ __forceinline__ void wait_vm() { asm volatile("s_waitcnt vmcnt(%0)" :: "n"(N) : "memory"); }
__device__ __forceinline__ unsigned pk_fp8x4(float a, float b, float c, float d) { unsigned w = 0; w = __builtin_amdgcn_cvt_pk_fp8_f32(a, b, w, false); w = __builtin_amdgcn_cvt_pk_fp8_f32(c, d, w, true); return w; }
__device__ __forceinline__ void attn_phase(Frame& F) {
    constexpr int WSTR = 20224;
    LAS unsigned char* RING = F.lds + F.wave * WSTR;
    LAS u16* SL = (LAS u16*)(RING + 16384);
    const unsigned char* Q8 = F.ws + WS_Q; const unsigned char* K8 = F.ws + WS_K; const unsigned char* V8 = F.ws + WS_V;
    const u16* SEL = (const u16*)(F.ws + WS_SEL); bf16* YA = (bf16*)(F.ws + WS_YATT);
    const int lane = F.lane, gw = blockIdx.x * NWAVES + F.wave;
    const int hd = lane & 15, kg = lane >> 4;
    const int l4 = lane >> 2, cpos = lane & 3;
    int kra[2];
#pragma unroll
    for (int ks = 0; ks < 2; ++ks) kra[ks] = hd * 64 + (((ks * 2 + (kg >> 1)) ^ ((hd >> 2) & 3)) << 4) + (kg & 1) * 8;
    unsigned tra[4];
    { const int r = hd >> 1, c = hd & 1, row = (r >> 2) * 16 + kg * 4 + (r & 3), f = (kg & 1) | ((r >> 2) << 1); const unsigned rb = (unsigned)(unsigned long)RING;
#pragma unroll
      for (int mt = 0; mt < 4; ++mt) tra[mt] = rb + row * 64 + ((mt ^ f) << 4) + c * 8; }
    const bool early = (int)blockIdx.x < 128; const int ew = blockIdx.x * NWAVES + F.wave, nitems = early ? 23 : 9;
    for (int k_ = 0; k_ < nitems; ++k_) { const int it = (k_ < 9) ? gw + 2048 * k_ : 18432 + ew + 1024 * (k_ - 9);
        const int tok = it >> 1, kvh = it & 1, t = tok & 4095; const size_t bbase = (size_t)(tok >> 12) * SEQ;
        const int nsel = (t + 1 < NSEL) ? t + 1 : NSEL;
        { const v2u x = *(const GAS v2u*)(SEL + (size_t)tok * NSEL + lane * 4); *(LAS v2u*)(SL + lane * 4) = x; }
        long qf[2];
#pragma unroll
        for (int ks = 0; ks < 2; ++ks) { if (hd < 4) qf[ks] = *(const GAS long*)(Q8 + (size_t)tok * 512 + (kvh * 4 + hd) * 64 + ks * 32 + kg * 8); else qf[ks] = 0; }
        asm volatile("s_waitcnt vmcnt(0)" : "+v"(qf[0]), "+v"(qf[1]) :: "memory");
        LDS_WAIT(); __builtin_amdgcn_wave_barrier();
        const unsigned char* kbp = K8 + bbase * 128 + kvh * 64; const unsigned char* vbp = V8 + bbase * 128 + kvh * 64;
        f32x4 sc[4][4]; f32x4 oacc[4];
#pragma unroll
        for (int c = 0; c < 4; ++c)
#pragma unroll
            for (int tl = 0; tl < 4; ++tl) sc[c][tl] = (f32x4){0.f, 0.f, 0.f, 0.f};
#pragma unroll
        for (int m = 0; m < 4; ++m) oacc[m] = (f32x4){0.f, 0.f, 0.f, 0.f};
        float inv = 1.0f;
#define ATT_ISSUE(s) do { const int c_ = (s) & 3; const bool isk_ = (s) < 4; const unsigned char* gb_ = isk_ ? kbp : vbp; int sel_[4]; \
            _Pragma("unroll") for (int j_ = 0; j_ < 4; ++j_) { const int ki_ = c_ * 64 + j_ * 16 + l4; sel_[j_] = (int)SL[ki_ < nsel ? ki_ : 0]; } \
            _Pragma("unroll") for (int j_ = 0; j_ < 4; ++j_) { const int f_ = isk_ ? ((l4 >> 2) & 3) : (((l4 >> 2) & 1) | ((j_ & 1) << 1)); \
                __builtin_amdgcn_global_load_lds((const unsigned*)(gb_ + (size_t)sel_[j_] * 128 + ((cpos ^ f_) << 4)), (LAS unsigned*)(RING + ((s) & 3) * 4096 + j_ * 1024), 16, 0, 0); } } while (0)
        ATT_ISSUE(0); ATT_ISSUE(1); ATT_ISSUE(2);
#pragma unroll
        for (int s = 0; s < 8; ++s) {
            if (s + 3 < 8) ATT_ISSUE(s + 3);
            if (s <= 4) wait_vm<12>(); else if (s == 5) wait_vm<8>(); else if (s == 6) wait_vm<4>(); else wait_vm<0>();
            const LAS unsigned char* buf = RING + (s & 3) * 4096;
            if (s < 4) {
#pragma unroll
                for (int tl = 0; tl < 4; ++tl)
#pragma unroll
                    for (int ks = 0; ks < 2; ++ks) { const long af = *(const LAS long*)(buf + tl * 1024 + kra[ks]);
                        sc[s][tl] = __builtin_amdgcn_mfma_f32_16x16x32_fp8_fp8(af, qf[ks], sc[s][tl], 0, 0, 0); }
                if (s == 3) {
                    float mx = -3.0e38f;
#pragma unroll
                    for (int c = 0; c < 4; ++c)
#pragma unroll
                        for (int tl = 0; tl < 4; ++tl)
#pragma unroll
                            for (int r = 0; r < 4; ++r) { const int key = c * 64 + tl * 16 + kg * 4 + r; const float v = (key < nsel) ? sc[c][tl][r] * 0.125f : -3.0e38f; sc[c][tl][r] = v; mx = fmaxf(mx, v); }
                    mx = fmaxf(mx, __shfl_xor(mx, 16)); mx = fmaxf(mx, __shfl_xor(mx, 32));
                    float sum = 0.f;
#pragma unroll
                    for (int c = 0; c < 4; ++c)
#pragma unroll
                        for (int tl = 0; tl < 4; ++tl)
#pragma unroll
                            for (int r = 0; r < 4; ++r) { const float e = __expf(sc[c][tl][r] - mx); sc[c][tl][r] = e; sum += e; }
                    sum += __shfl_xor(sum, 16); sum += __shfl_xor(sum, 32);
                    inv = 1.0f / sum;
                }
            } else {
                const int c = s - 4;
                v2u pw[2];
#pragma unroll
                for (int h2 = 0; h2 < 2; ++h2) { pw[h2].x = pk_fp8x4(sc[c][2 * h2][0], sc[c][2 * h2][1], sc[c][2 * h2][2], sc[c][2 * h2][3]); pw[h2].y = pk_fp8x4(sc[c][2 * h2 + 1][0], sc[c][2 * h2 + 1][1], sc[c][2 * h2 + 1][2], sc[c][2 * h2 + 1][3]); }
                v2u a[8];
                asm volatile("ds_read_b64_tr_b8 %0, %8 offset:%12\n\tds_read_b64_tr_b8 %1, %9 offset:%12\n\tds_read_b64_tr_b8 %2, %10 offset:%12\n\tds_read_b64_tr_b8 %3, %11 offset:%12\n\t"
                             "ds_read_b64_tr_b8 %4, %8 offset:%13\n\tds_read_b64_tr_b8 %5, %9 offset:%13\n\tds_read_b64_tr_b8 %6, %10 offset:%13\n\tds_read_b64_tr_b8 %7, %11 offset:%13\n\ts_waitcnt lgkmcnt(0)"
                             : "=&v"(a[0]), "=&v"(a[1]), "=&v"(a[2]), "=&v"(a[3]), "=&v"(a[4]), "=&v"(a[5]), "=&v"(a[6]), "=&v"(a[7])
                             : "v"(tra[0]), "v"(tra[1]), "v"(tra[2]), "v"(tra[3]), "n"((s & 3) * 4096), "n"((s & 3) * 4096 + 2048) : "memory");
#pragma unroll
                for (int h2 = 0; h2 < 2; ++h2)
#pragma unroll
                    for (int mt = 0; mt < 4; ++mt)
                        oacc[mt] = __builtin_amdgcn_mfma_f32_16x16x32_fp8_fp8(__builtin_bit_cast(long, a[4 * h2 + mt]), __builtin_bit_cast(long, pw[h2]), oacc[mt], 0, 0, 0);
            }
        }
#undef ATT_ISSUE
        if (hd < 4) {
            bf16* yo = YA + (size_t)tok * 512 + (kvh * 4 + hd) * 64 + kg * 4;
#pragma unroll
            for (int mt = 0; mt < 4; ++mt) { pg8::u32x2 w; w.x = pg8::cvt_pk_bf16(oacc[mt][0] * inv, oacc[mt][1] * inv); w.y = pg8::cvt_pk_bf16(oacc[mt][2] * inv, oacc[mt][3] * inv); *(GAS pg8::u32x2*)(yo + 16 * mt) = w; }
        }
        LDS_WAIT(); __builtin_amdgcn_wave_barrier();
    }
}

__device__ __forceinline__ void router_phase(Frame& F) {
    constexpr int HRS = 1028;
    LAS float* HR = (LAS float*)(F.lds);
    LAS float* PT = (LAS float*)(F.lds + 65792);
    LAS int* LE = (LAS int*)(F.lds + 82176);
    LAS int* LP = (LAS int*)(F.lds + 83200);
    LAS unsigned* LC = (LAS unsigned*)(F.lds + 84224);
    const bf16* X1 = (const bf16*)(F.ws + WS_X1); bf16* H2 = (bf16*)(F.ws + WS_H2);
    const float* WR = F.in[I_WR]; const float* BR = F.in[I_BR]; const float* G2 = F.in[I_N2G];
    int* TOPE = (int*)(F.ws + WS_TOPE); float* TOPW = (float*)(F.ws + WS_TOPW); int* TOPPOS = (int*)(F.ws + WS_TOPPOS); int* ROWMAP = (int*)(F.ws + WS_ROWMAP);
    const int tid = F.tid, lane = F.lane, wave = F.wave, e = lane & 31, dh = lane >> 5;
    float wb[32][2];
#pragma unroll
    for (int i = 0; i < 32; ++i)
#pragma unroll
        for (int t = 0; t < 2; ++t) wb[i][t] = WR[(size_t)(128 * wave + 4 * i + (lane >> 4)) * 32 + (lane & 15) + 16 * t];
    if (tid < 64) LC[tid] = 0u;
    const int tok0 = blockIdx.x * 64;
    v2u nv[2][4];
#pragma unroll
    for (int rr = 0; rr < 2; ++rr)
#pragma unroll
        for (int j = 0; j < 4; ++j) nv[rr][j] = ((const GAS v2u*)(X1 + (size_t)(tok0 + 2 * wave + rr) * DM) + lane)[64 * j];
    for (int bt = 0; bt < 4; ++bt) {
        __syncthreads();
#pragma unroll
        for (int rr = 0; rr < 2; ++rr) { const int lr = 2 * wave + rr, tok = tok0 + bt * 16 + lr;
            const GAS f32x4* gr = (const GAS f32x4*)G2 + lane;
            f32x4 v[4]; float s2 = 0.f;
#pragma unroll
            for (int j = 0; j < 4; ++j) { v[j] = (f32x4){bflo(nv[rr][j].x), bfhi(nv[rr][j].x), bflo(nv[rr][j].y), bfhi(nv[rr][j].y)}; s2 += (v[j].x * v[j].x + v[j].y * v[j].y) + (v[j].z * v[j].z + v[j].w * v[j].w); }
            const float rstd = 1.0f / sqrtf(wave_sum(s2) * (1.f / DM) + RMS_EPS);
            GAS unsigned long long* o8 = (GAS unsigned long long*)(H2 + (size_t)tok * DM) + lane;
#pragma unroll
            for (int j = 0; j < 4; ++j) { const f32x4 gg = gr[64 * j]; const f32x4 h = v[j] * rstd * gg;
                *(LAS f32x4*)(HR + lr * HRS + 256 * j + 4 * lane) = h;
                o8[64 * j] = (unsigned long long)pk2(h.x, h.y) | ((unsigned long long)pk2(h.z, h.w) << 32); } }
        if (bt + 1 < 4) {
#pragma unroll
            for (int rr = 0; rr < 2; ++rr)
#pragma unroll
                for (int j = 0; j < 4; ++j) nv[rr][j] = ((const GAS v2u*)(X1 + (size_t)(tok0 + (bt + 1) * 16 + 2 * wave + rr) * DM) + lane)[64 * j];
        }
        __syncthreads();
        { f32x4 d0 = {0.f, 0.f, 0.f, 0.f}, d1 = d0; const LAS float* hp = HR + (lane & 15) * HRS + 128 * wave + (lane >> 4);
#pragma unroll
          for (int i = 0; i < 32; ++i) { const float a = hp[4 * i]; d0 = __builtin_amdgcn_mfma_f32_16x16x4f32(a, wb[i][0], d0, 0, 0, 0); d1 = __builtin_amdgcn_mfma_f32_16x16x4f32(a, wb[i][1], d1, 0, 0, 0); }
#pragma unroll
          for (int r = 0; r < 4; ++r) { const int row = 4 * (lane >> 4) + r; PT[(row * 8 + wave) * 32 + (lane & 15)] = d0[r]; PT[(row * 8 + wave) * 32 + 16 + (lane & 15)] = d1[r]; } }
        __syncthreads();
        { const int lr = 2 * wave + dh, tl = bt * 16 + lr, tok = tok0 + tl; float lg = BR[e];
#pragma unroll
          for (int w8 = 0; w8 < 8; ++w8) lg += PT[(lr * 8 + w8) * 32 + e];
          float cur = lg; float tv[4]; int te[4];
#pragma unroll
          for (int k = 0; k < 4; ++k) { float mv = cur; int mi = e;
#pragma unroll
              for (int o = 1; o < 32; o <<= 1) { const float ov = __shfl_xor(mv, o); const int oi = __shfl_xor(mi, o); if (ov > mv || (ov == mv && oi < mi)) { mv = ov; mi = oi; } }
              tv[k] = mv; te[k] = mi; if (e == mi) cur = -3.0e38f; }
          const float e1 = __expf(tv[1] - tv[0]), e2 = __expf(tv[2] - tv[0]), e3 = __expf(tv[3] - tv[0]); const float inv = 1.0f / (1.0f + e1 + e2 + e3);
          if (e < 4) { const int ex = (e == 0) ? te[0] : (e == 1) ? te[1] : (e == 2) ? te[2] : te[3]; const float wv = ((e == 0) ? 1.0f : (e == 1) ? e1 : (e == 2) ? e2 : e3) * inv;
              TOPE[(size_t)tok * 4 + e] = ex; TOPW[(size_t)tok * 4 + e] = wv; LE[tl * 4 + e] = ex; LP[tl * 4 + e] = (int)atomicAdd((unsigned*)&LC[ex], 1u); } }
    }
    __syncthreads();
    if (tid < 32) LC[32 + tid] = __hip_atomic_fetch_add((unsigned*)(F.ctl + CW_ECNT) + tid, LC[tid], RLX_AGENT);
    __syncthreads();
    if (tid < 256) { const int ex = LE[tid], pos = (int)LC[32 + ex] + LP[tid], tok = tok0 + (tid >> 2); TOPPOS[(size_t)tok * 4 + (tid & 3)] = pos; ROWMAP[(size_t)ex * NTOK + pos] = tok; }
}

__device__ __forceinline__ int moe_tables(Frame& F, LAS int* OFF, LAS int* TE, bool build) {
    __syncthreads();
    if (build && F.tid == 0) { int cn[NEXP];
#pragma unroll
        for (int e = 0; e < NEXP; ++e) cn[e] = (int)__hip_atomic_load((unsigned*)(F.ctl + CW_ECNT) + e, RLX_AGENT);
        int acc = 0;
#pragma unroll
        for (int e = 0; e < NEXP; ++e) { const int c = cn[e], nt = (c + 255) >> 8; OFF[e] = acc * 256; OFF[33 + e] = c; for (int i = 0; i < nt; ++i) TE[acc + i] = e; acc += nt; }
        OFF[NEXP] = acc; }
    __syncthreads();
    return OFF[NEXP];
}
__device__ __forceinline__ void combine_phase(Frame& F, bool build) {
    LAS int* OFF = (LAS int*)(F.lds + MISC_OFF + 512); LAS int* TE = OFF + 72;
    (void)moe_tables(F, OFF, TE, build);
    const int* TOPE = (const int*)(F.ws + WS_TOPE); const int* TOPPOS = (const int*)(F.ws + WS_TOPPOS); const float* TOPW = (const float*)(F.ws + WS_TOPW);
    const bf16* X1 = (const bf16*)(F.ws + WS_X1); const bf16* Y2 = (const bf16*)(F.ws + WS_Y2); const float* GF = F.in[I_NFG];
    const int gw = blockIdx.x * NWAVES + F.wave, NGW = F.G * NWAVES, lane = F.lane;
    typedef int v4i __attribute__((ext_vector_type(4)));
    constexpr int NT = NTOK / (256 * NWAVES);
    f32x4 gg[4];
#pragma unroll
    for (int j = 0; j < 4; ++j) gg[j] = ((const GAS f32x4*)GF + lane)[64 * j];
    v4i re, rp; f32x4 rw;
    v2u xr[2][4], yr[2][4][4]; f32x4 wr[2];
#define CMB_REC(i_) do { const int t_ = gw + (i_) * NGW; re = *(const GAS v4i*)(TOPE + (size_t)t_ * 4); rp = *(const GAS v4i*)(TOPPOS + (size_t)t_ * 4); rw = *(const GAS f32x4*)(TOPW + (size_t)t_ * 4); } while (0)
#define CMB_ROWS(i_, b_) do { const int t_ = gw + (i_) * NGW; wr[b_] = rw; \
        _Pragma("unroll") for (int j = 0; j < 4; ++j) xr[b_][j] = ((const GAS v2u*)(X1 + (size_t)t_ * DM) + lane)[64 * j]; \
        _Pragma("unroll") for (int k = 0; k < 4; ++k) { const int slot = OFF[re[k]] + rp[k]; const GAS v2u* yp = (const GAS v2u*)(Y2 + (size_t)slot * DM) + lane; \
            _Pragma("unroll") for (int j = 0; j < 4; ++j) yr[b_][k][j] = yp[64 * j]; } } while (0)
    CMB_REC(0); CMB_ROWS(0, 0); if (NT > 1) CMB_REC(1);
#pragma unroll
    for (int i = 0; i < NT; ++i) { const int b = i & 1, tok = gw + i * NGW;
        asm volatile("" ::: "memory");
        if (i + 1 < NT) CMB_ROWS(i + 1, b ^ 1);
        if (i + 2 < NT) CMB_REC(i + 2);
        asm volatile("" ::: "memory");
        f32x4 v[4];
#pragma unroll
        for (int j = 0; j < 4; ++j) { const v2u x = xr[b][j]; v[j] = (f32x4){bflo(x.x), bfhi(x.x), bflo(x.y), bfhi(x.y)}; }
#pragma unroll
        for (int k = 0; k < 4; ++k) { const float wk = wr[b][k];
#pragma unroll
            for (int j = 0; j < 4; ++j) { const v2u y = yr[b][k][j]; v[j].x += wk * bflo(y.x); v[j].y += wk * bfhi(y.x); v[j].z += wk * bflo(y.y); v[j].w += wk * bfhi(y.y); } }
        float s2 = 0.f;
#pragma unroll
        for (int j = 0; j < 4; ++j) s2 += (v[j].x * v[j].x + v[j].y * v[j].y) + (v[j].z * v[j].z + v[j].w * v[j].w);
        const float rstd = 1.0f / sqrtf(wave_sum(s2) * (1.f / DM) + RMS_EPS);
#pragma unroll
        for (int j = 0; j < 4; ++j) ((GAS f32x4*)(F.out + (size_t)tok * DM) + lane)[64 * j] = v[j] * rstd * gg[j];
    }
#undef CMB_REC
#undef CMB_ROWS
}

__device__ __forceinline__ void ubench(Frame& F) {
    bf16x8 a = (bf16x8){1, 2, 3, 4, 5, 6, 7, 8}, b = (bf16x8){8, 7, 6, 5, 4, 3, 2, 1}; a[0] = (short)F.lane;
    float sink = 0.f;
    if (PROBE_DUP == 900) { f32x16 c0 = {0.f, 0.f, 0.f, 0.f, 0.f, 0.f, 0.f, 0.f, 0.f, 0.f, 0.f, 0.f, 0.f, 0.f, 0.f, 0.f}, c1 = c0;
        for (int i = 0; i < 2000; ++i) { c0 = __builtin_amdgcn_mfma_f32_32x32x16_bf16(a, b, c0, 0, 0, 0); c1 = __builtin_amdgcn_mfma_f32_32x32x16_bf16(a, b, c1, 0, 0, 0); }
        sink = c0[0] + c1[5]; }
    if (PROBE_DUP == 901) { f32x4 c0 = {0.f, 0.f, 0.f, 0.f}, c1 = c0, c2 = c0, c3 = c0;
        for (int i = 0; i < 2000; ++i) { c0 = __builtin_amdgcn_mfma_f32_16x16x32_bf16(a, b, c0, 0, 0, 0); c1 = __builtin_amdgcn_mfma_f32_16x16x32_bf16(a, b, c1, 0, 0, 0); c2 = __builtin_amdgcn_mfma_f32_16x16x32_bf16(a, b, c2, 0, 0, 0); c3 = __builtin_amdgcn_mfma_f32_16x16x32_bf16(a, b, c3, 0, 0, 0); }
        sink = c0[0] + c1[1] + c2[2] + c3[3]; }
    if (PROBE_DUP == 902) { float x0 = F.lane, x1 = 1.f, x2 = 2.f, x3 = 3.f, x4 = 4.f, x5 = 5.f, x6 = 6.f, x7 = 7.f; const float m = 1.0001f, d = 0.5f;
        for (int i = 0; i < 4000; ++i) { x0 = x0 * m + d; x1 = x1 * m + d; x2 = x2 * m + d; x3 = x3 * m + d; x4 = x4 * m + d; x5 = x5 * m + d; x6 = x6 * m + d; x7 = x7 * m + d; }
        sink = x0 + x1 + x2 + x3 + x4 + x5 + x6 + x7; }
    if (PROBE_DUP == 903) {
        f32x4 c[4]; float s = 0.f; float wv[16];
#pragma unroll
        for (int i = 0; i < 4; ++i) c[i] = (f32x4){0.f, 0.f, 0.f, 0.f};
#pragma unroll
        for (int i = 0; i < 16; ++i) wv[i] = 0.001f * (i + F.lane);
        for (int it = 0; it < 275; ++it) { f32x4 d[4];
#pragma unroll
            for (int i = 0; i < 4; ++i) { d[i] = (f32x4){0.f, 0.f, 0.f, 0.f}; d[i] = __builtin_amdgcn_mfma_f32_16x16x32_bf16(a, b, d[i], 0, 0, 0); d[i] = __builtin_amdgcn_mfma_f32_16x16x32_bf16(b, a, d[i], 0, 0, 0); }
            float t = 0.f;
#pragma unroll
            for (int i = 0; i < 4; ++i)
#pragma unroll
                for (int r = 0; r < 4; ++r) { const float x = c[i][r]; const int xi = __builtin_bit_cast(int, x); const float m = __builtin_bit_cast(float, xi > 0 ? xi : 0); t += wv[4 * i + r] * m; }
            float u = t;
#pragma unroll
            for (int k = 0; k < 12; ++k) u = u * 1.0001f + 0.5f;
            s += u; a[1] = (short)(it + (int)s);
#pragma unroll
            for (int i = 0; i < 4; ++i) c[i] = d[i]; }
        sink = s; }
    if (sink == 123.456f) ((float*)(F.ws + WS_SBUF))[F.tid] = sink;
}

constexpr int NPHASE = 10;
struct Args { const float* in[25]; float* out; unsigned char* ws; int ph_lo, ph_hi; };
__global__ void __launch_bounds__(NTHR, 2) fwd_kernel(Args args) {
    extern __shared__ __attribute__((aligned(16))) unsigned char lds[];
    Frame F;
    F.lds = (LAS unsigned char*)lds;
    F.MISC = (volatile LAS unsigned*)(F.lds + MISC_OFF);
    F.tid = threadIdx.x; F.lane = F.tid & 63; F.wave = __builtin_amdgcn_readfirstlane(F.tid >> 6); F.G = gridDim.x;
    F.ws = args.ws; F.ctl = (gu32*)(args.ws + WS_CTL); F.out = args.out;
#pragma unroll
    for (int i = 0; i < 25; ++i) F.in[i] = args.in[i];
    for (int u = F.tid; u < 2048 / 4; u += NTHR) ((LAS unsigned*)(F.lds + MISC_OFF))[u] = 0u;
    __syncthreads();
    XcdBarrier bar; bar.bar = (unsigned*)(F.ctl + CW_BAR); bar.x = 0; bar.st = nullptr;
    if (MK_N_LAUNCHES == 1) bar = xcd_barrier_post((unsigned*)(F.ctl + CW_BAR), F.MISC + 8);
    const int lo = args.ph_lo, hi = args.ph_hi;
#define IN(k) (lo <= (k) && (k) < hi)
#define SEAM(k) do { if (IN(k) && IN((k) + 1)) xcd_barrier(bar); } while (0)
    unsigned char* ws = F.ws; const int c = (int)blockIdx.x;

#define BODY_P0 { p0_prologue(F); if (PROBE_DUP >= 900) ubench(F); }
#define BODY_P1 { { pg8::Gemm g{(const bf16*)(ws + WS_XN), (const bf16*)(ws + WS_WIN), 1024, 1024, 1024, 0}; InProjOrder S{F.G, c, (unsigned*)(F.ctl + CW_UDONE)}; \
        EpiInProj E{ws, F.in[I_BGATE]}; pg8::gemm_phase<EpiInProj, InProjOrder>(F.lds, g, S, E); } \
        if (c >= 128 && c < 192) { wg_wait_ge(F, CW_UDONE, 128u * 8u); pg8::Gemm g{(const bf16*)(ws + WS_UGX), (const bf16*)(ws + WS_WS), UGX_LD, 512, 512, 0}; S5StateOrder S{c - 128}; EpiS5State E{(float*)(ws + WS_SBUF)}; \
          pg8::gemm_phase<EpiS5State, S5StateOrder>(F.lds, g, S, E); } \
        if (c >= 128) moe_convert(F, MOE_N8A, MOE_N8, (c < 192) ? c - 128 : 64 + 2 * (c - 192), (c < 192) ? 1 : 2, 192); }
#define BODY_P2 { carry_phase(F); idx_phase(F); if (PROBE_DUP == 102) { xcd_barrier(bar); idx_phase(F); } }
#define BODY_P3 { if (c >= 128) { { pg8::Gemm g{(const bf16*)(ws + WS_UGX), (const bf16*)(ws + WS_MT), UGX_LD, UGX_LD, 640, 0}; S5YOrder S{c - 128}; EpiS5Y E{(const bf16*)(ws + WS_UGX), F.in[I_SD], (bf16*)(ws + WS_YG)}; \
            pg8::gemm_phase<EpiS5Y, S5YOrder>(F.lds, g, S, E); } \
          wg_signal(F, CW_YDONE); wg_wait_ge(F, CW_YDONE, 128u); \
          { pg8::Gemm g{(const bf16*)(ws + WS_YG), (const bf16*)(ws + WS_WGLU), 512, 512, 512, 0}; StaticOrder S; S.init(NTOK / 256, 2, 128, c - 128); EpiGlu E{(const bf16*)(ws + WS_YG), F.in[I_BGLU], (bf16*)(ws + WS_YSSM)}; \
            pg8::gemm_phase<EpiGlu, StaticOrder>(F.lds, g, S, E); } } \
        attn_phase(F); }
#define BODY_P4 { pg8::Gemm g{(const bf16*)(ws + WS_YSSM), (const bf16*)(ws + WS_WPS), 512, 512, 512, 0}; MixOrder S; S.so.init(NTOK / 256, 4, F.G, c); \
        EpiMix E{(const bf16*)(ws + WS_GS), (const bf16*)(ws + WS_GA), (bf16*)(ws + WS_MIXED)}; pg8::gemm_phase<EpiMix, MixOrder>(F.lds, g, S, E); }
#define BODY_P5 { pg8::Gemm g{(const bf16*)(ws + WS_MIXED), (const bf16*)(ws + WS_WOUT), 1024, 1024, 1024, 0}; StaticOrder S; S.init(NTOK / 256, 4, F.G, c); EpiOut E{F.in[I_X], (bf16*)(ws + WS_X1)}; \
        pg8::gemm_phase<EpiOut, StaticOrder>(F.lds, g, S, E); }
#define BODY_P6 { router_phase(F); }
#define BODY_P7 { LAS int* OFF = (LAS int*)(F.lds + MISC_OFF + 512); LAS int* TE = OFF + 72; const int TT = moe_tables(F, OFF, TE, true); \
        pg8::Gemm g{(const bf16*)(ws + WS_H2), (const bf16*)(ws + WS_WMI), 1024, 2048, 1024, (size_t)1024 * 2048 * 2}; MoeOrder S{TE, OFF, OFF + 33, (const int*)(ws + WS_ROWMAP), TT, 8, c}; EpiMoe1 E{F.in[I_BMI], (bf16*)(ws + WS_ACT)}; \
        pg8::gemm_phase<EpiMoe1, MoeOrder, true, true>(F.lds, g, S, E); }
#define BODY_P8 { LAS int* OFF = (LAS int*)(F.lds + MISC_OFF + 512); LAS int* TE = OFF + 72; const int TT = moe_tables(F, OFF, TE, lo == 8); \
        pg8::Gemm g{(const bf16*)(ws + WS_ACT), (const bf16*)(ws + WS_WMO), 1024, 1024, 1024, (size_t)1024 * 1024 * 2}; MoeOrder S{TE, OFF, OFF + 33, nullptr, TT, 4, c}; EpiMoe2 E{F.in[I_BMO], (bf16*)(ws + WS_Y2)}; \
        pg8::gemm_phase<EpiMoe2, MoeOrder, true, true>(F.lds, g, S, E); }
#define BODY_P9 { combine_phase(F, lo == 9); }
#define PHASE(k, BODY) if (IN(k)) { TPROBE_BEGIN(k); BODY TPROBE_END(k); if (PROBE_DUP == (k)) { xcd_barrier(bar); BODY } } SEAM(k);
    PHASE(0, BODY_P0) PHASE(1, BODY_P1) PHASE(2, BODY_P2) PHASE(3, BODY_P3) PHASE(4, BODY_P4) PHASE(5, BODY_P5) PHASE(6, BODY_P6)
    PHASE(7, BODY_P7) PHASE(8, BODY_P8) PHASE(9, BODY_P9)
#undef IN
#undef SEAM
}

extern "C" void kernel_launch(void* const* d_in, const int* in_sizes, int n_in, void* d_out, int out_size, void* d_ws, size_t ws_size, hipStream_t stream) {
    static int grid = 0;
    if (grid == 0) {
        if (n_in != 25 || out_size != NTOK * DM || ws_size < WS_END) { fprintf(stderr, "kernel_launch: unexpected problem (n_in %d out %d ws %zu)\n", n_in, out_size, ws_size); grid = -1; return; }
        if (hipFuncSetAttribute((const void*)fwd_kernel, hipFuncAttributeMaxDynamicSharedMemorySize, LDS_BYTES) != hipSuccess) { fprintf(stderr, "kernel_launch: hipFuncSetAttribute failed\n"); grid = -1; return; }
        int per_cu = 0; (void)hipOccupancyMaxActiveBlocksPerMultiprocessor(&per_cu, (const void*)fwd_kernel, NTHR, LDS_BYTES); (void)hipGetLastError();
        grid = 256;
    }
    if (grid < 0) return;
    (void)hipMemsetAsync((char*)d_ws + WS_CTL, 0, CTL_ZERO_BYTES, stream);
    Args a{};
    for (int i = 0; i < 25; ++i) a.in[i] = (const float*)d_in[i];
    a.out = (float*)d_out; a.ws = (unsigned char*)d_ws;
    if (MK_N_LAUNCHES == 1) { a.ph_lo = 0; a.ph_hi = NPHASE; hipLaunchKernelGGL(fwd_kernel, dim3(grid), dim3(NTHR), LDS_BYTES, stream, a); }
    else for (int p = 0; p < NPHASE; ++p) { a.ph_lo = p; a.ph_hi = p + 1; hipLaunchKernelGGL(fwd_kernel, dim3(grid), dim3(NTHR), LDS_BYTES, stream, a); }
}
```

```cpp
#include <hip/hip_runtime.h>
#include <cstdio>
#include <cstdint>

#ifndef MK_N_LAUNCHES
#define MK_N_LAUNCHES 1
#endif
#ifndef PROBE_DUP
#define PROBE_DUP -1
#endif
#ifndef PROBE_MULT
#define PROBE_MULT 4
#endif
#ifndef PROBE_T
#define PROBE_T -1
#endif
#define TPROBE_BEGIN(id) unsigned long long tpb_##id = (PROBE_T == (id)) ? __builtin_amdgcn_s_memrealtime() : 0ull
#define TPROBE_END(id) do { if (PROBE_T == (id)) { const unsigned long long d_ = __builtin_amdgcn_s_memrealtime() - tpb_##id, t1_ = __builtin_amdgcn_s_memrealtime(); while (__builtin_amdgcn_s_memrealtime() - t1_ < 4ull * d_) __builtin_amdgcn_s_sleep(8); } } while (0)

namespace pg8 {
#define PG8_LAS __attribute__((address_space(3)))
typedef unsigned short bf16_t;
typedef short bf16x8 __attribute__((ext_vector_type(8)));
typedef float f32x4 __attribute__((ext_vector_type(4)));
typedef float f32x2 __attribute__((ext_vector_type(2)));
typedef unsigned u32x4 __attribute__((ext_vector_type(4)));
typedef unsigned u32x2 __attribute__((ext_vector_type(2)));
constexpr int BM = 256, BK = 64, HALF = 128, HTB = HALF * BK * 2, STAGE_BYTES = 8 * HTB, NXCD = 8, WGM = 8;

__host__ __device__ __forceinline__ int lds_byte(int r, int c) { const int st = (r >> 4) * 2 + (c >> 5), rr = r & 15, cc = c & 31, ob = rr * 64 + cc * 2; return st * 1024 + (ob ^ (((ob >> 9) & 1) << 5)); }
__host__ __device__ __forceinline__ void stage_rc(int b, int& R, int& C) { const int st = b / 1024, sb = b % 1024, swz = sb ^ (((sb >> 9) & 1) << 5); R = (st >> 1) * 16 + swz / 64; C = (st & 1) * 32 + (swz % 64) / 2; }
__host__ __device__ __forceinline__ int perm32(int rho) { const int n = rho >> 4, i = rho & 15; return 8 * (i >> 2) + 4 * n + (i & 3); }

struct Unit { int pm, pn, pa, pb, e; };
struct Gemm { const bf16_t* A; const bf16_t* Bt; int lda, ldb, K; size_t bexp; };

__device__ __forceinline__ unsigned cvt_pk_bf16(float lo, float hi) { unsigned r; asm volatile("v_cvt_pk_bf16_f32 %0, %1, %2" : "=v"(r) : "v"(lo), "v"(hi)); return r; }
__device__ __forceinline__ u32x4 pack8(const f32x4& v0, const f32x4& v1) { u32x4 w; w.x = cvt_pk_bf16(v0[0], v0[1]); w.y = cvt_pk_bf16(v0[2], v0[3]); w.z = cvt_pk_bf16(v1[0], v1[1]); w.w = cvt_pk_bf16(v1[2], v1[3]); return w; }

template <class Epi, class Sched, bool ALIGN_EPI = true, bool BKN = false>
__device__ __forceinline__ void gemm_phase(PG8_LAS unsigned char* lds, const Gemm g, const Sched& S, const Epi& E) {
    const int tid = threadIdx.x, wid = __builtin_amdgcn_readfirstlane(tid >> 6), lane = tid & 63, wr = wid >> 2, wc = wid & 3, fr = lane & 15, fq = lane >> 4;
    const int K = g.K, nt = K / BK;
    unsigned voffB[2];
#pragma unroll
    for (int i = 0; i < 2; ++i) {
        if constexpr (BKN) { const int krow = (tid >> 4) + 32 * i, cp = tid & 15, fk = ((krow & 3) << 1) | (((krow >> 3) & 1) << 3); voffB[i] = (unsigned)(krow * g.ldb) * 2u + (unsigned)((cp ^ fk) << 4); }
        else { int R, C; stage_rc(tid * 16 + i * 8192, R, C); const int Rb = (R & ~31) + perm32(R & 31); voffB[i] = (unsigned)(Rb * g.ldb + C) * 2u; } }
    const size_t kstep = (size_t)(BK * 2);
    const size_t kstepB = BKN ? (size_t)BK * g.ldb * 2 : kstep;
    const size_t hstepB = BKN ? (size_t)256 : (size_t)HALF * g.ldb * 2;
    const size_t tstepB = BKN ? (size_t)512 : 2 * hstepB;
    const unsigned tbase = (unsigned)(unsigned long)lds + (unsigned)((8 * fq + (fr >> 2)) * 256 + (((4 * wc + (fr & 3)) ^ (((fr >> 2) << 1) | ((fq & 1) << 3))) << 4));
#define PG8_AROWS(VV, U) do { _Pragma("unroll") for (int i_ = 0; i_ < 2; ++i_) { int R_, C_; stage_rc((threadIdx.x & 511) * 16 + i_ * 8192, R_, C_); \
        _Pragma("unroll") for (int h_ = 0; h_ < 2; ++h_) VV[h_][i_] = (unsigned)(S.arow(U, h_, R_) * g.lda + C_) * 2u; } } while (0)
    unsigned vA[2][2], vAn[2][2];
    const unsigned ldsw = (unsigned)wid * 1024u;
    const int aoff = lds_byte(wr * 64 + fr, fq * 8), boff = lds_byte(wc * 32 + fr, fq * 8);
#define PG8_SA(b, h) (((b) * 2 + (h)) * HTB)
#define PG8_SB(b, h) ((4 + (b) * 2 + (h)) * HTB)
#define PG8_STAGE(bufoff, gbase, voff) do { _Pragma("unroll") for (int _i = 0; _i < 2; ++_i) \
        __builtin_amdgcn_global_load_lds((const unsigned*)((const char*)(gbase) + (voff)[_i]), (PG8_LAS unsigned*)(lds + (bufoff) + ldsw + _i * 8192), 16, 0, 0); } while (0)
#define PG8_LDA(dst, b, h) do { _Pragma("unroll") for (int m = 0; m < 4; ++m) _Pragma("unroll") for (int k = 0; k < 2; ++k) dst[m][k] = *(const PG8_LAS bf16x8*)(lds + PG8_SA(b, h) + aoff + m * 2048 + k * 1024); } while (0)
#define PG8_LDB(dst, b, h) do { if constexpr (BKN) { const unsigned ab_ = tbase + PG8_SB(b, h); _Pragma("unroll") for (int n = 0; n < 2; ++n) _Pragma("unroll") for (int k = 0; k < 2; ++k) { u32x2 lo_, hi_; \
            asm volatile("ds_read_b64_tr_b16 %0, %2 offset:%3\n\tds_read_b64_tr_b16 %1, %2 offset:%4" : "=&v"(lo_), "=&v"(hi_) : "v"(ab_), "n"(k * 8192 + n * 8), "n"(k * 8192 + n * 8 + 1024) : "memory"); \
            u32x4 w_; w_.x = lo_.x; w_.y = lo_.y; w_.z = hi_.x; w_.w = hi_.y; dst[n][k] = __builtin_bit_cast(bf16x8, w_); } } \
        else { _Pragma("unroll") for (int n = 0; n < 2; ++n) _Pragma("unroll") for (int k = 0; k < 2; ++k) dst[n][k] = *(const PG8_LAS bf16x8*)(lds + PG8_SB(b, h) + boff + n * 2048 + k * 1024); } } while (0)
#define PG8_WAIT_LB() do { if constexpr (BKN) asm volatile("s_waitcnt lgkmcnt(0)" : "+v"(B0[0][0]), "+v"(B0[0][1]), "+v"(B0[1][0]), "+v"(B0[1][1]), "+v"(B1[0][0]), "+v"(B1[0][1]), "+v"(B1[1][0]), "+v"(B1[1][1]) :: "memory"); \
        else asm volatile("s_waitcnt lgkmcnt(0)" ::: "memory"); } while (0)
#define PG8_MMA(ai, bj, At, Bt) do { __builtin_amdgcn_s_setprio(1); _Pragma("unroll") for (int m = 0; m < 4; ++m) _Pragma("unroll") for (int n = 0; n < 2; ++n) _Pragma("unroll") for (int k = 0; k < 2; ++k) \
        acc[ai][bj][m][n] = __builtin_amdgcn_mfma_f32_16x16x32_bf16(Bt[n][k], At[m][k], acc[ai][bj][m][n], 0, 0, 0); __builtin_amdgcn_s_setprio(0); } while (0)
#define PG8_WAIT_V(n) asm volatile("s_waitcnt vmcnt(" #n ")" ::: "memory")
#define PG8_WAIT_L(n) asm volatile("s_waitcnt lgkmcnt(" #n ")" ::: "memory")
#define PG8_BAR __builtin_amdgcn_s_barrier()
#define PG8_SCHED __builtin_amdgcn_sched_barrier(0)
    Unit cur, nxt; int ui = 0;
    if (!S.next(0, cur)) return;
    f32x4 acc[2][2][4][2];
#pragma unroll
    for (int a = 0; a < 2; ++a)
#pragma unroll
        for (int b = 0; b < 2; ++b)
#pragma unroll
            for (int m = 0; m < 4; ++m)
#pragma unroll
                for (int n = 0; n < 2; ++n) acc[a][b][m][n] = (f32x4){0.f, 0.f, 0.f, 0.f};
    bf16x8 At[4][2], B0[2][2], B1[2][2];
    const char* const bA = (const char*)g.A; const char* cB = BKN ? (const char*)g.Bt + (size_t)cur.e * g.bexp + (size_t)cur.pn * tstepB : (const char*)g.Bt + (size_t)cur.pb * tstepB;
    PG8_AROWS(vA, cur);
    PG8_STAGE(PG8_SB(0, 0), cB, voffB); PG8_STAGE(PG8_SB(0, 1), cB + hstepB, voffB); PG8_STAGE(PG8_SA(0, 0), bA, vA[0]); PG8_STAGE(PG8_SA(0, 1), bA, vA[1]);
    if (wr == 1) PG8_BAR;
    PG8_WAIT_V(2); PG8_BAR;
    PG8_STAGE(PG8_SB(1, 0), cB + kstepB, voffB); PG8_STAGE(PG8_SA(1, 0), bA + kstep, vA[0]); PG8_STAGE(PG8_SB(1, 1), cB + hstepB + kstepB, voffB);
    PG8_WAIT_V(6); PG8_BAR;
    for (;;) {
        const bool has_next = S.next(ui + 1, nxt);
        const char* nB = has_next ? (BKN ? (const char*)g.Bt + (size_t)nxt.e * g.bexp + (size_t)nxt.pn * tstepB : (const char*)g.Bt + (size_t)nxt.pb * tstepB) : cB;
        if (has_next) PG8_AROWS(vAn, nxt); else { vAn[0][0] = vA[0][0]; vAn[0][1] = vA[0][1]; vAn[1][0] = vA[1][0]; vAn[1][1] = vA[1][1]; }
        for (int t = 0; t < nt; t += 2) {
            const bool last = (t == nt - 2);
            const char* a1 = bA + (size_t)(t + 1) * kstep;
            const char* a2 = last ? bA : bA + (size_t)(t + 2) * kstep; const char* b2 = last ? nB : cB + (size_t)(t + 2) * kstepB;
            const char* a3 = a2 + kstep; const char* b3 = b2 + kstepB;
            unsigned w0[2], w1[2];
            w0[0] = last ? vAn[0][0] : vA[0][0]; w0[1] = last ? vAn[0][1] : vA[0][1]; w1[0] = last ? vAn[1][0] : vA[1][0]; w1[1] = last ? vAn[1][1] : vA[1][1];
            PG8_LDB(B0, 0, 0); PG8_LDB(B1, 0, 1); PG8_SCHED; PG8_LDA(At, 0, 0); PG8_STAGE(PG8_SA(1, 1), a1, vA[1]);
            PG8_WAIT_V(8); PG8_WAIT_LB(); PG8_BAR; PG8_MMA(0, 0, At, B0); PG8_MMA(0, 1, At, B1); PG8_BAR; PG8_SCHED;
            PG8_LDA(At, 0, 1); PG8_STAGE(PG8_SB(0, 0), b2, voffB); PG8_STAGE(PG8_SB(0, 1), b2 + hstepB, voffB); PG8_STAGE(PG8_SA(0, 0), a2, w0);
            PG8_WAIT_V(8); PG8_WAIT_L(0); PG8_BAR; PG8_MMA(1, 0, At, B0); PG8_MMA(1, 1, At, B1); PG8_BAR; PG8_SCHED;
            PG8_LDB(B0, 1, 0); PG8_LDB(B1, 1, 1); PG8_SCHED; PG8_LDA(At, 1, 0); PG8_STAGE(PG8_SA(0, 1), a2, w1);
            PG8_WAIT_V(8); PG8_WAIT_LB(); PG8_BAR; PG8_MMA(0, 0, At, B0); PG8_MMA(0, 1, At, B1); PG8_BAR; PG8_SCHED;
            PG8_LDA(At, 1, 1); PG8_STAGE(PG8_SB(1, 0), b3, voffB); PG8_STAGE(PG8_SB(1, 1), b3 + hstepB, voffB); PG8_STAGE(PG8_SA(1, 0), a3, w0);
            PG8_WAIT_V(8); PG8_WAIT_L(0); PG8_BAR; PG8_MMA(1, 0, At, B0); PG8_MMA(1, 1, At, B1); PG8_BAR; PG8_SCHED;
        }
        if constexpr (ALIGN_EPI) { if (wr == 0) PG8_BAR; }
        { const bool pe_ = (PROBE_T == 200 && !BKN) || (PROBE_T == 201 && BKN) || (PROBE_T == 203 && BKN && g.ldb == 2048) || (PROBE_T == 204 && BKN && g.ldb == 1024) || (PROBE_T >= 210 && PROBE_T < 216 && !BKN && S.probe_id() == PROBE_T) || (PROBE_T == 216 && !BKN && S.probe_id() == 211 && cur.pn < 2) || (PROBE_T == 217 && !BKN && S.probe_id() == 211 && cur.pn >= 2) || (PROBE_T == 218 && !BKN && S.probe_id() == 211 && blockIdx.x >= 192) || (PROBE_T == 219 && !BKN && S.probe_id() == 211 && blockIdx.x < 128 && cur.pn >= 2);
          unsigned long long tpe_ = 0; if (pe_) tpe_ = __builtin_amdgcn_s_memrealtime();
          E(acc, cur, wr, wc, fr, fq);
          if ((PROBE_T == 220 || (PROBE_T == 221 && wid == 0)) && !BKN && S.probe_id() == 211 && blockIdx.x >= 192) { const unsigned long long t1_ = __builtin_amdgcn_s_memrealtime(); while (__builtin_amdgcn_s_memrealtime() - t1_ < 2000ull) __builtin_amdgcn_s_sleep(8); }
          if (pe_) { const unsigned long long d_ = __builtin_amdgcn_s_memrealtime() - tpe_, t1_ = __builtin_amdgcn_s_memrealtime(); while (__builtin_amdgcn_s_memrealtime() - t1_ < (unsigned long long)PROBE_MULT * d_) __builtin_amdgcn_s_sleep(8); } } S.done(cur);
        if (!has_next) break;
#pragma unroll
        for (int a = 0; a < 2; ++a)
#pragma unroll
            for (int b = 0; b < 2; ++b)
#pragma unroll
                for (int m = 0; m < 4; ++m)
#pragma unroll
                    for (int n = 0; n < 2; ++n) acc[a][b][m][n] = (f32x4){0.f, 0.f, 0.f, 0.f};
        cur = nxt; cB = nB; ++ui; vA[0][0] = vAn[0][0]; vA[0][1] = vAn[0][1]; vA[1][0] = vAn[1][0]; vA[1][1] = vAn[1][1];
        if constexpr (ALIGN_EPI) { if (wr == 1) PG8_BAR; }
    }
    PG8_WAIT_V(0);
    if constexpr (!ALIGN_EPI) { if (wr == 0) PG8_BAR; }
    PG8_BAR;
#undef PG8_AROWS
#undef PG8_SA
#undef PG8_SB
#undef PG8_STAGE
#undef PG8_LDA
#undef PG8_LDB
#undef PG8_WAIT_LB
#undef PG8_MMA
#undef PG8_WAIT_V
#undef PG8_WAIT_L
#undef PG8_BAR
#undef PG8_SCHED
}
}

constexpr int NB = 4, SEQ = 4096, NTOK = NB * SEQ, DM = 1024;
constexpr int NWAVES = 8, NTHR = 512;
constexpr int D_SSM = 512, NGRP = 32, NSTATE = 64, CH = 32  , NCH = SEQ / CH  , UGX_LD = 640, S5_ROWS = NB * NCH  ;
constexpr int NIN_PAD = 4608;
constexpr int NEXP = 32, TOPK_E = 4, DFF = 1024;
constexpr int NSEL = 256;
constexpr int MAX_MT = 288;
constexpr float RMS_EPS = 1e-5f;

constexpr size_t MiB = 1u << 20;
constexpr size_t WS_CTL = 0, CTL_ZERO_BYTES = 1 * MiB;
constexpr size_t WS_ROPE = 1 * MiB;
constexpr size_t WS_WIN = 2 * MiB;
constexpr size_t WS_WGLU = 11 * MiB;
constexpr size_t WS_WPS = 12 * MiB;
constexpr size_t WS_WPA = 13 * MiB;
constexpr size_t WS_WOUT = 14 * MiB;
constexpr size_t WS_MT = 16 * MiB;
constexpr size_t WS_WS = 36 * MiB;
constexpr size_t WS_A32 = 44 * MiB;
constexpr size_t WS_SBUF = 45 * MiB;
constexpr size_t WS_WI = 53 * MiB;
constexpr size_t WS_KI = 54 * MiB;
constexpr size_t WS_K = 56 * MiB;
constexpr size_t WS_V = 60 * MiB;
constexpr size_t WS_UGX = 64 * MiB;
constexpr size_t WS_Q = 84 * MiB;
constexpr size_t WS_QI = 100 * MiB;
constexpr size_t WS_GS = 132 * MiB;
constexpr size_t WS_GA = 164 * MiB;
constexpr size_t WS_XN = 196 * MiB;
constexpr size_t WS_YG = 228 * MiB;
constexpr size_t WS_YSSM = 244 * MiB;
constexpr size_t WS_YATT = 260 * MiB;
constexpr size_t WS_SEL = 276 * MiB;
constexpr size_t WS_MIXED = 284 * MiB;
constexpr size_t WS_X1 = 316 * MiB;
constexpr size_t WS_H2 = 380 * MiB;
constexpr size_t WS_TOPE = 412 * MiB;
constexpr size_t WS_TOPW = WS_TOPE + 256 * 1024;
constexpr size_t WS_TOPPOS = WS_TOPW + 256 * 1024;
constexpr size_t WS_ROWMAP = 413 * MiB;
constexpr size_t WS_WMI = 416 * MiB;
constexpr size_t WS_WMO = 544 * MiB;
constexpr size_t WS_ACT = 608 * MiB;
constexpr size_t WS_XP = 64 * MiB;
constexpr size_t WS_Y2 = 64 * MiB;
constexpr size_t WS_END = 752 * MiB;
static_assert(WS_XP + (size_t)MAX_MT * 256 * 1024 * 2 <= WS_YG, "XP overlay");
constexpr int CW_TMO = 0, CW_CODE = 1;
constexpr int CW_BAR = 4096;
constexpr int CW_ECNT = 16384;
constexpr int CW_UDONE = 16384 + 64;
constexpr int CW_YDONE = 16384 + 128;

constexpr int LDS_BYTES = 163840;
constexpr int MISC_OFF = 163840 - 2048;

#define GAS __attribute__((address_space(1)))
#define LAS __attribute__((address_space(3)))
typedef unsigned short bf16;
typedef unsigned short u16;
typedef unsigned v4u __attribute__((ext_vector_type(4)));
typedef unsigned v2u __attribute__((ext_vector_type(2)));
typedef float f32x4 __attribute__((ext_vector_type(4)));
typedef float f32x16 __attribute__((ext_vector_type(16)));
typedef short bf16x8 __attribute__((ext_vector_type(8)));
typedef GAS unsigned gu32;
#define RLX_AGENT __ATOMIC_RELAXED, __HIP_MEMORY_SCOPE_AGENT
#define LDS_WAIT() asm volatile("s_waitcnt lgkmcnt(0)" ::: "memory")
#define VM_WAIT() asm volatile("s_waitcnt vmcnt(0)" ::: "memory")
__device__ __forceinline__ unsigned f2bf(float f) { unsigned u = __builtin_bit_cast(unsigned, f); return (u + 0x7fffu + ((u >> 16) & 1u)) >> 16; }
__device__ __forceinline__ unsigned pk2(float lo, float hi) { return f2bf(lo) | (f2bf(hi) << 16); }
__device__ __forceinline__ float bf2f(unsigned b) { return __builtin_bit_cast(float, b << 16); }
__device__ __forceinline__ float bflo(unsigned w) { return __builtin_bit_cast(float, w << 16); }
__device__ __forceinline__ float bfhi(unsigned w) { return __builtin_bit_cast(float, w & 0xffff0000u); }
__device__ __forceinline__ float sigmoidf_(float x) { return __builtin_amdgcn_rcpf(1.0f + __builtin_amdgcn_exp2f(-1.4426950408889634f * x)); }
__device__ __forceinline__ float gelu_tanh(float x) { const float u = 0.7978845608028654f * (x + 0.044715f * x * x * x); const float e = __builtin_amdgcn_exp2f(2.8853900817779268f * u); const float t = 1.0f - 2.0f * __builtin_amdgcn_rcpf(e + 1.0f); return 0.5f * x * (1.0f + t); }

#define XB_TMO      128
#define XB_XCNT(j)  (256  + 64 * (j))
#define XB_XSUB(j)  (1280 + 64 * (j))
#define XB_XGEN(j)  (2304 + 64 * (j))
#define XB_TOP      3328
#define XB_TOPGEN   3392
#define XCD_BAR_WORDS 3456
#define XB_SPIN_CAP (1u << 18)
__device__ __forceinline__ unsigned xb_ld(unsigned* p)              { return __hip_atomic_load(p, __ATOMIC_RELAXED, __HIP_MEMORY_SCOPE_AGENT); }
__device__ __forceinline__ unsigned xb_add(unsigned* p, unsigned v) { return __hip_atomic_fetch_add(p, v, __ATOMIC_RELAXED, __HIP_MEMORY_SCOPE_AGENT); }
__device__ __forceinline__ unsigned xb_xcc_id() { return (unsigned)__builtin_amdgcn_s_getreg((3 << 11) | 20) & 0xFu; }
#define XB_SPIN(cond, bar) do { unsigned _sp = 0; while (cond) { __builtin_amdgcn_s_sleep(1); \
    if ((++_sp & 255u) == 0u) { if (xb_ld(&(bar)[XB_TMO])) break; if (_sp > XB_SPIN_CAP) { atomicAdd(&(bar)[XB_TMO], 1u); break; } } } } while (0)
struct XcdBarrier { unsigned* bar; unsigned x; volatile LAS unsigned* st; };
__device__ __forceinline__ XcdBarrier xcd_barrier_post(unsigned* bar, volatile LAS unsigned* st) {
    XcdBarrier b; b.bar = bar; b.x = xb_xcc_id(); b.st = st;
    if (threadIdx.x == 0) (void)xb_add(&bar[XB_XCNT(b.x)], 1u);
    return b;
}
__device__ __forceinline__ void xcd_barrier_complete(unsigned* bar, unsigned x, unsigned& nloc, unsigned& nx) {
    const unsigned G = gridDim.x * gridDim.y * gridDim.z;
    unsigned sum, cnt, mine, sp = 0u;
    for (;;) {
        sum = 0u; cnt = 0u; mine = 0u;
#pragma unroll
        for (unsigned j = 0; j < 16; ++j) { const unsigned c = xb_ld(&bar[XB_XCNT(j)]); sum += c; cnt += (c > 0u) ? 1u : 0u; mine = (j == x) ? c : mine; }
        if (sum == G) break;
        __builtin_amdgcn_s_sleep(1);
        if ((++sp & 255u) == 0u) { if (xb_ld(&bar[XB_TMO])) break; if (sp > XB_SPIN_CAP) { atomicAdd(&bar[XB_TMO], 1u); break; } }
    }
    nloc = mine > 0u ? mine : 1u; nx = cnt > 0u ? cnt : 1u;
}
__device__ __forceinline__ void xcd_barrier(const XcdBarrier& b) {
    asm volatile("s_waitcnt vmcnt(0)" ::: "memory");
    __syncthreads();
    if (threadIdx.x == 0) {
        unsigned* bar = b.bar;
        __builtin_amdgcn_s_waitcnt(0);
        unsigned nloc = b.st[0], nx = b.st[1];
        if (nloc == 0u) { xcd_barrier_complete(bar, b.x, nloc, nx); b.st[0] = nloc; b.st[1] = nx; }
        const unsigned old = xb_add(&bar[XB_XSUB(b.x)], 1u);
        const unsigned gen = old / nloc;
        if (old + 1u == (gen + 1u) * nloc) {
            __builtin_amdgcn_fence(__ATOMIC_RELEASE, "agent");
            asm volatile("s_waitcnt vmcnt(0)" ::: "memory");
            const unsigned og = xb_add(&bar[XB_TOP], 1u);
            const unsigned tg = og / nx;
            if (og + 1u == (tg + 1u) * nx) xb_add(&bar[XB_TOPGEN], 1u);
            else XB_SPIN(xb_ld(&bar[XB_TOPGEN]) == tg, bar);
            __builtin_amdgcn_fence(__ATOMIC_ACQUIRE, "agent");
            xb_add(&bar[XB_XGEN(b.x)], 1u);
            asm volatile("s_waitcnt vmcnt(0)" ::: "memory");
        } else {
            XB_SPIN(xb_ld(&bar[XB_XGEN(b.x)]) == gen, bar);
            __builtin_amdgcn_fence(__ATOMIC_ACQUIRE, "agent");
            asm volatile("s_waitcnt vmcnt(0)" ::: "memory");
        }
    }
    __syncthreads();
}

struct Frame {
    LAS unsigned char* lds;
    volatile LAS unsigned* MISC;
    gu32* ctl;
    int tid, lane, wave, G;
    unsigned char* ws;
    const float* in[25];
    float* out;
};
enum { I_X = 0, I_N1G, I_WIN, I_BGATE, I_LRE, I_LIM, I_LOGDT, I_BRE, I_BIM, I_CRE, I_CIM, I_SD, I_WGLU, I_BGLU, I_WPS, I_WPA, I_WOUT, I_N2G, I_WR, I_BR, I_WMI, I_BMI, I_WMO, I_BMO, I_NFG };

__device__ __forceinline__ float wave_sum(float v) {
#pragma unroll
    for (int o = 1; o < 64; o <<= 1) v += __shfl_xor(v, o);
    return v;
}

__device__ __forceinline__ int ropeperm(int p) { const int a = p >> 3, bb = p & 7; return bb < 4 ? 4 * a + bb : 32 + 4 * a + (bb - 4); }
__device__ __forceinline__ int win_src(int nd) {
    const int pn = nd >> 8, j = nd & 255;
    if (pn < 2) return nd;
    if (pn < 4) { const int i = nd - 512; return 512 + (i & ~63) + ropeperm(i & 63); }
    if (pn == 4) { if (j < 128) return 1024 + (j & ~63) + ropeperm(j & 63); return 1152 + (j - 128); }
    if (pn < 9) { const int i = nd - 1280; return 1280 + (i & ~63) + ropeperm(i & 63); }
    if (pn == 9) { if (j < 64) return 2304 + ropeperm(j); if (j < 80) return 2368 + (j - 64); return -1; }
    if (pn < 14) return 2384 + (nd - 2560);
    return 3408 + (nd - 3584);
}
struct TItem { const float* src; bf16* dst; int N, K; };
__device__ __forceinline__ void titem_load(const TItem& T, float (&tv)[32], int lane) {
#pragma unroll
    for (int i = 0; i < 32; ++i) { const int kk = 2 * i + (lane >> 5); tv[i] = T.src ? __builtin_nontemporal_load(T.src + (size_t)kk * T.N) : 0.f; }
}
__device__ __forceinline__ void titem_store(const TItem& T, const float (&tv)[32], LAS float* scr, int lane) {
#pragma unroll
    for (int i = 0; i < 32; ++i) { const int kk = 2 * i + (lane >> 5); scr[kk * 33 + (lane & 31)] = tv[i]; }
    LDS_WAIT(); asm volatile("" ::: "memory");
    const int c = lane & 7;
#pragma unroll
    for (int j = 0; j < 4; ++j) { const int n = (lane >> 3) + 8 * j; const LAS float* s = scr + (8 * c) * 33 + n;
        v4u o; o.x = pk2(s[0 * 33], s[1 * 33]); o.y = pk2(s[2 * 33], s[3 * 33]); o.z = pk2(s[4 * 33], s[5 * 33]); o.w = pk2(s[6 * 33], s[7 * 33]);
        *(GAS v4u*)(T.dst + (size_t)n * T.K + 8 * c) = o; }
    LDS_WAIT(); asm volatile("" ::: "memory");
}
__device__ __forceinline__ void rms_row_to_bf16(int lane, const float* xrow, const float* g, bf16* orow) {
    const GAS f32x4* xr = (const GAS f32x4*)xrow + lane; const GAS f32x4* gr = (const GAS f32x4*)g + lane;
    f32x4 v[4]; float s2 = 0.f;
#pragma unroll
    for (int j = 0; j < 4; ++j) { v[j] = xr[64 * j]; s2 += (v[j].x * v[j].x + v[j].y * v[j].y) + (v[j].z * v[j].z + v[j].w * v[j].w); }
    const float rstd = 1.0f / sqrtf(wave_sum(s2) * (1.f / DM) + RMS_EPS);
    GAS unsigned long long* o8 = (GAS unsigned long long*)orow + lane;
#pragma unroll
    for (int j = 0; j < 4; ++j) { const f32x4 gg = gr[64 * j];
        o8[64 * j] = (unsigned long long)pk2(v[j].x * rstd * gg.x, v[j].y * rstd * gg.y) | ((unsigned long long)pk2(v[j].z * rstd * gg.z, v[j].w * rstd * gg.w) << 32); }
}
__device__ __forceinline__ void p0_s5_group(Frame& F, int g) {
    LAS float* AP = (LAS float*)(F.lds);
    LAS float* BB = (LAS float*)(F.lds + 16896);
    LAS float* CC = (LAS float*)(F.lds + 25088);
    LAS float* KJ = (LAS float*)(F.lds + 33280);
    const float* lre = F.in[I_LRE] + g * 64; const float* lim = F.in[I_LIM] + g * 64;
    const double dt = exp((double)F.in[I_LOGDT][g]);
    __syncthreads();
    for (int idx = F.tid; idx < 33 * 64; idx += NTHR) { const int p = idx & 63, j = idx >> 6;
        const double lr = lre[p], li = lim[p]; const double mag = exp(j * lr * dt), ang = j * li * dt;
        AP[idx * 2] = (float)(mag * cos(ang)); AP[idx * 2 + 1] = (float)(mag * sin(ang)); }
    for (int idx = F.tid; idx < 1024; idx += NTHR) { const int p = idx >> 4;
        const double lr = lre[p], li = lim[p]; const double mag = exp(lr * dt), ang = li * dt; const double ar = mag * cos(ang), ai = mag * sin(ang);
        const double nr = ar - 1.0, ni = ai, den = lr * lr + li * li; const double zr = (nr * lr + ni * li) / den, zi = (ni * lr - nr * li) / den;
        const double br = F.in[I_BRE][g * 1024 + idx], bi = F.in[I_BIM][g * 1024 + idx];
        BB[idx * 2] = (float)(zr * br - zi * bi); BB[idx * 2 + 1] = (float)(zr * bi + zi * br); }
    for (int idx = F.tid; idx < 1024; idx += NTHR) { CC[idx * 2] = F.in[I_CRE][g * 1024 + idx]; CC[idx * 2 + 1] = F.in[I_CIM][g * 1024 + idx]; }
    __syncthreads();
    { const int j = F.tid >> 4, hp = F.tid & 15; float s[16];
#pragma unroll
      for (int h = 0; h < 16; ++h) s[h] = 0.f;
      for (int p = 0; p < 64; ++p) { const float cr = CC[(hp * 64 + p) * 2], ci = CC[(hp * 64 + p) * 2 + 1], ar = AP[(j * 64 + p) * 2], ai = AP[(j * 64 + p) * 2 + 1];
          const float er = cr * ar - ci * ai, ei = cr * ai + ci * ar;
#pragma unroll
          for (int h4 = 0; h4 < 8; ++h4) { const f32x4 bb = *(const LAS f32x4*)(BB + (p * 16 + 2 * h4) * 2); s[2 * h4] += er * bb[0] - ei * bb[1]; s[2 * h4 + 1] += er * bb[2] - ei * bb[3]; } }
#pragma unroll
      for (int h = 0; h < 16; ++h) KJ[(j * 16 + hp) * 16 + h] = s[h]; }
    __syncthreads();
    bf16* MT = (bf16*)(F.ws + WS_MT) + (size_t)g * 512 * 640;
    for (int ch = F.tid; ch < 512 * 80; ch += NTHR) { const int n = ch / 80, k0 = (ch % 80) * 8, tp = n >> 4, hp = n & 15; float v[8];
        if (k0 < 512) { const int sp = k0 >> 4, h0 = k0 & 15;
#pragma unroll
            for (int j = 0; j < 8; ++j) v[j] = (sp <= tp) ? KJ[((tp - sp) * 16 + hp) * 16 + h0 + j] : 0.f; }
        else { const bool im = k0 >= 576; const int p0 = k0 - (im ? 576 : 512);
#pragma unroll
            for (int j = 0; j < 8; ++j) { const int p = p0 + j; const float cr = CC[(hp * 64 + p) * 2], ci = CC[(hp * 64 + p) * 2 + 1], ar = AP[((tp + 1) * 64 + p) * 2], ai = AP[((tp + 1) * 64 + p) * 2 + 1];
                v[j] = im ? -(cr * ai + ci * ar) : (cr * ar - ci * ai); } }
        v4u o; o.x = pk2(v[0], v[1]); o.y = pk2(v[2], v[3]); o.z = pk2(v[4], v[5]); o.w = pk2(v[6], v[7]);
        *(GAS v4u*)(MT + (size_t)n * 640 + k0) = o; }
    bf16* WS = (bf16*)(F.ws + WS_WS) + (size_t)g * 256 * 512;
    for (int ch = F.tid; ch < 256 * 64; ch += NTHR) { const int n = ch >> 6, k0 = (ch & 63) * 8, sp = k0 >> 4, h0 = k0 & 15; float v[8];
#pragma unroll
        for (int j = 0; j < 8; ++j) { if (n < 128) { const int p = n & 63; const float ar = AP[((31 - sp) * 64 + p) * 2], ai = AP[((31 - sp) * 64 + p) * 2 + 1], br = BB[(p * 16 + h0 + j) * 2], bi = BB[(p * 16 + h0 + j) * 2 + 1];
                v[j] = (n < 64) ? (ar * br - ai * bi) : (ar * bi + ai * br); } else v[j] = 0.f; }
        v4u o; o.x = pk2(v[0], v[1]); o.y = pk2(v[2], v[3]); o.z = pk2(v[4], v[5]); o.w = pk2(v[6], v[7]);
        *(GAS v4u*)(WS + (size_t)n * 512 + k0) = o; }
    float* A32 = (float*)(F.ws + WS_A32) + g * 128;
    if (F.tid < 128) A32[F.tid] = AP[32 * 128 + F.tid];
    __syncthreads();
}
constexpr size_t MOE_N8_IN = (size_t)NEXP * 1024 * 2048 / 8, MOE_N8 = MOE_N8_IN + (size_t)NEXP * 1024 * 1024 / 8, MOE_N8A = (MOE_N8 / 10) * 9;
__device__ __forceinline__ void moe_convert(Frame& F, size_t lo8, size_t hi8, int vw0, int nvw, int vtotal) {
    const size_t vstride = (size_t)vtotal * NTHR;
    for (int vw = 0; vw < nvw; ++vw)
    for (size_t i0 = lo8 + (size_t)(vw0 + vw) * NTHR + F.tid; i0 < hi8; i0 += 4 * vstride) {
        f32x4 a[4], b[4];
#pragma unroll
        for (int u = 0; u < 4; ++u) { const size_t i = i0 + (size_t)u * vstride; if (i < hi8) { const float* s = (i < MOE_N8_IN) ? F.in[I_WMI] + i * 8 : F.in[I_WMO] + (i - MOE_N8_IN) * 8;
            a[u] = __builtin_nontemporal_load((const f32x4*)s); b[u] = __builtin_nontemporal_load((const f32x4*)s + 1); } }
#pragma unroll
        for (int u = 0; u < 4; ++u) { const size_t i = i0 + (size_t)u * vstride; if (i < hi8) { bf16* d = (i < MOE_N8_IN) ? (bf16*)(F.ws + WS_WMI) + i * 8 : (bf16*)(F.ws + WS_WMO) + (i - MOE_N8_IN) * 8;
            *(GAS v4u*)d = pg8::pack8(a[u], b[u]); } } }
}
__device__ __forceinline__ void p0_prologue(Frame& F) {
    const int NW = F.G - NGRP;
    const bool s5wg = (int)blockIdx.x >= NW;
    TPROBE_BEGIN(120);
    if (s5wg) p0_s5_group(F, (int)blockIdx.x - NW);
    TPROBE_END(120);
    TPROBE_BEGIN(121);
    if (!s5wg) {
    LAS float* scr = (LAS float*)(F.lds + F.wave * 16384);
    const int gw = blockIdx.x * NWAVES + F.wave, NGW = NW * NWAVES;
    { float* cosT = (float*)(F.ws + WS_ROPE); float* sinT = cosT + SEQ * 32;
      for (int i = blockIdx.x * NTHR + F.tid; i < SEQ * 32; i += NW * NTHR) { const int pos = i >> 5, k = i & 31;
          const double inv = pow(10000.0, -(double)k / 32.0); const double ang = (double)pos * (double)(float)inv;
          cosT[i] = (float)cos(ang); sinT[i] = (float)sin(ang); } }
    { const int lane = F.lane; f32x4 gg[4], va[4], vb[4];
#pragma unroll
      for (int j = 0; j < 4; ++j) gg[j] = ((const GAS f32x4*)F.in[I_N1G] + lane)[64 * j];
#define XN_LOAD(V, m_) do { _Pragma("unroll") for (int j = 0; j < 4; ++j) V[j] = ((const GAS f32x4*)(F.in[I_X] + (size_t)(m_) * DM) + lane)[64 * j]; } while (0)
#define XN_DO(V, m_) do { float s2 = 0.f; _Pragma("unroll") for (int j = 0; j < 4; ++j) s2 += (V[j].x * V[j].x + V[j].y * V[j].y) + (V[j].z * V[j].z + V[j].w * V[j].w); \
        const float rstd = 1.0f / sqrtf(wave_sum(s2) * (1.f / DM) + RMS_EPS); GAS unsigned long long* o8 = (GAS unsigned long long*)((bf16*)(F.ws + WS_XN) + (size_t)(m_) * DM) + lane; \
        _Pragma("unroll") for (int j = 0; j < 4; ++j) o8[64 * j] = (unsigned long long)pk2(V[j].x * rstd * gg[j].x, V[j].y * rstd * gg[j].y) | ((unsigned long long)pk2(V[j].z * rstd * gg[j].z, V[j].w * rstd * gg[j].w) << 32); } while (0)
      int m = gw; if (m < NTOK) XN_LOAD(va, m);
      for (; m < NTOK; m += 2 * NGW) { const int m1 = m + NGW, m2 = m1 + NGW;
          asm volatile("" ::: "memory"); if (m1 < NTOK) XN_LOAD(vb, m1); asm volatile("" ::: "memory");
          XN_DO(va, m);
          asm volatile("" ::: "memory"); if (m2 < NTOK) XN_LOAD(va, m2); asm volatile("" ::: "memory");
          if (m1 < NTOK) XN_DO(vb, m1); }
#undef XN_LOAD
#undef XN_DO
    }
    constexpr int I_IN = 16 * (NIN_PAD / 32), I_GLU = 8 * 16, I_PS = 8 * 32, I_PA = 8 * 32, I_OUT = 16 * 32;
    constexpr int NITEMS = I_IN + I_GLU + I_PS + I_PA + I_OUT;
    auto decode = [&](int it) -> TItem {
        int r = it; const float* W; bf16* WT; int K, N, ndb, map = 0;
        if (r < I_IN) { W = F.in[I_WIN]; K = DM; N = 4432; WT = (bf16*)(F.ws + WS_WIN); ndb = NIN_PAD / 32; map = 1; }
        else if ((r -= I_IN) < I_GLU) { W = F.in[I_WGLU]; K = 512; N = 512; WT = (bf16*)(F.ws + WS_WGLU); ndb = 16; }
        else if ((r -= I_GLU) < I_PS) { W = F.in[I_WPS]; K = 512; N = 1024; WT = (bf16*)(F.ws + WS_WPS); ndb = 32; }
        else if ((r -= I_PS) < I_PA) { W = F.in[I_WPA]; K = 512; N = 1024; WT = (bf16*)(F.ws + WS_WPA); ndb = 32; }
        else { r -= I_PA; W = F.in[I_WOUT]; K = 1024; N = 1024; WT = (bf16*)(F.ws + WS_WOUT); ndb = 32; }
        const int kb = r / ndb, nb = r % ndb, k0 = 64 * kb, n0 = 32 * nb; int sc = n0 + (F.lane & 31); if (map) sc = win_src(sc);
        TItem T; T.src = (sc >= 0) ? W + (size_t)k0 * N + sc : nullptr; T.dst = WT + (size_t)n0 * K + k0; T.N = N; T.K = K; return T; };
    { float tvA[32], tvB[32]; int it = gw;
      if (it < NITEMS) { TItem TA = decode(it); titem_load(TA, tvA, F.lane);
        for (;;) {
            const int it1 = it + NGW; const bool h1 = it1 < NITEMS; TItem TB = TA; if (h1) { TB = decode(it1); titem_load(TB, tvB, F.lane); }
            titem_store(TA, tvA, scr, F.lane); if (!h1) break;
            const int it2 = it1 + NGW; const bool h2 = it2 < NITEMS; if (h2) { TA = decode(it2); titem_load(TA, tvA, F.lane); }
            titem_store(TB, tvB, scr, F.lane); if (!h2) break;
            it = it2; } } }
    }
    TPROBE_END(121);
    TPROBE_BEGIN(122);
    moe_convert(F, 0, MOE_N8A, s5wg ? 4 * NW + 2 * ((int)blockIdx.x - NW) : 4 * (int)blockIdx.x, s5wg ? 2 : 4, 4 * NW + 2 * NGRP);
    TPROBE_END(122);
}

struct StaticOrder {
    int nM, nN, nwg, G, c;
    __device__ void init(int nM_, int nN_, int G_, int c_) { nM = nM_; nN = nN_; nwg = nM * nN; G = G_; c = c_; }
    __device__ bool tile(int i, int& pm, int& pn) const {
        const long L = (long)i * G + c; if (L >= nwg) return false;
        int wgid = (int)L; { const int q = nwg / pg8::NXCD, r = nwg % pg8::NXCD, xcd = wgid % pg8::NXCD, off = wgid / pg8::NXCD; wgid = (xcd < r ? xcd * (q + 1) : r * (q + 1) + (xcd - r) * q) + off; }
        const int nig = pg8::WGM * nN, gid = wgid / nig, fm = gid * pg8::WGM, gsz = (nM - fm) < pg8::WGM ? (nM - fm) : pg8::WGM;
        pm = fm + ((wgid % nig) % gsz); pn = (wgid % nig) / gsz; return true;
    }
    __device__ bool next(int i, pg8::Unit& u) const { int pm, pn; if (!tile(i, pm, pn)) return false; u.pm = pm; u.pn = pn; u.pa = pm; u.pb = pn; u.e = 0; return true; }
    __device__ __forceinline__ int arow(const pg8::Unit& u, int h, int R) const { return u.pa * 256 + h * 128 + R; }
    __device__ __forceinline__ void done(const pg8::Unit&) const {}
    __device__ __forceinline__ int probe_id() const { return 210; }
};
__device__ __forceinline__ void wg_wait_ge(Frame& F, int word, unsigned target) {
    if (F.tid == 0) { unsigned sp = 0;
        while (__hip_atomic_load((unsigned*)(F.ctl + word), RLX_AGENT) < target) { __builtin_amdgcn_s_sleep(2); if (++sp > (1u << 22)) { __hip_atomic_store((unsigned*)(F.ctl + CW_TMO), 1u, RLX_AGENT); break; } }
        __builtin_amdgcn_fence(__ATOMIC_ACQUIRE, "agent"); asm volatile("s_waitcnt vmcnt(0)" ::: "memory"); }
    __syncthreads();
}
__device__ __forceinline__ void wg_signal(Frame& F, int word) {
    asm volatile("s_waitcnt vmcnt(0)" ::: "memory"); __syncthreads();
    if (F.tid == 0) { __builtin_amdgcn_fence(__ATOMIC_RELEASE, "agent"); asm volatile("s_waitcnt vmcnt(0)" ::: "memory"); (void)__hip_atomic_fetch_add((unsigned*)(F.ctl + word), 1u, RLX_AGENT); }
}
struct InProjOrder {
    int G, c; unsigned* udone;
    __device__ bool next(int i, pg8::Unit& u) const { const int L = i * G + c; if (L >= 64 * (NIN_PAD / 256)) return false; u.pm = L & 63; u.pn = L >> 6; u.pa = u.pm; u.pb = u.pn; u.e = 0; return true; }
    __device__ __forceinline__ int arow(const pg8::Unit& u, int h, int R) const { return u.pa * 256 + h * 128 + R; }
    __device__ __forceinline__ void done(const pg8::Unit& u) const {
        if (u.pn < 2) { asm volatile("s_waitcnt vmcnt(0)" ::: "memory");
            if ((threadIdx.x & 63) == 0) (void)__hip_atomic_fetch_add(udone, 1u, RLX_AGENT); } }
    __device__ __forceinline__ int probe_id() const { return 211; }
};
struct S5StateOrder {
    int c;
    __device__ bool next(int i, pg8::Unit& u) const { if (i > 0 || c >= 64) return false; const int g = c >> 1, pm = c & 1; u.pm = pm; u.pn = 0; u.pa = g * 2 + pm; u.pb = g; u.e = g; return true; }
    __device__ __forceinline__ int arow(const pg8::Unit& u, int h, int R) const { return u.pa * 256 + h * 128 + R; }
    __device__ __forceinline__ void done(const pg8::Unit&) const {}
    __device__ __forceinline__ int probe_id() const { return 212; }
};
struct S5YOrder {
    int c;
    __device__ bool next(int i, pg8::Unit& u) const { if (i > 0 || c >= 128) return false; const int g = c >> 2, pm = (c >> 1) & 1, pn = c & 1; u.pm = pm; u.pn = pn; u.pa = g * 2 + pm; u.pb = g * 2 + pn; u.e = g; return true; }
    __device__ __forceinline__ int arow(const pg8::Unit& u, int h, int R) const { return u.pa * 256 + h * 128 + R; }
    __device__ __forceinline__ void done(const pg8::Unit&) const {}
    __device__ __forceinline__ int probe_id() const { return 213; }
};
struct MixOrder {
    StaticOrder so;
    __device__ bool next(int i, pg8::Unit& u) const { int pm, pn; if (!so.tile(i >> 1, pm, pn)) return false; const int h = i & 1; u.pm = pm; u.pn = pn; u.pa = pm + 64 * h; u.pb = pn + 4 * h; u.e = h; return true; }
    __device__ __forceinline__ int arow(const pg8::Unit& u, int h, int R) const { return u.pa * 256 + h * 128 + R; }
    __device__ __forceinline__ void done(const pg8::Unit&) const {}
    __device__ __forceinline__ int probe_id() const { return 214; }
};
struct MoeOrder {
    const volatile LAS int* te; const volatile LAS int* off; const volatile LAS int* cnt; const int* rowmap; int TT, NTN, c;
    __device__ bool next(int i, pg8::Unit& u) const {
        const int xcd = c & 7, j = c >> 3, mpx = 32 / NTN; const int mt = i * (8 * mpx) + xcd * mpx + j / NTN, pn = j % NTN;
        if (mt >= TT) return false; const int e = te[mt]; u.pm = mt; u.pn = pn; u.pa = mt; u.pb = e * NTN + pn; u.e = e; return true; }
    __device__ __forceinline__ int arow(const pg8::Unit& u, int h, int R) const {
        if (!rowmap) return u.pa * 256 + h * 128 + R;
        const int lr = u.pm * 256 - off[u.e] + h * 128 + R;
        return lr < cnt[u.e] ? rowmap[(size_t)u.e * NTOK + lr] : 0; }
    __device__ __forceinline__ void done(const pg8::Unit&) const {}
    __device__ __forceinline__ int probe_id() const { return 215; }
};

using pg8::f32x2; using pg8::u32x2; using pg8::pack8; using pg8::cvt_pk_bf16;
#define EPI_ROWS_BEGIN _Pragma("unroll") for (int ai = 0; ai < 2; ++ai) _Pragma("unroll") for (int m = 0; m < 4; ++m) { asm volatile("" ::: "memory"); const int row = u.pm * 256 + ai * 128 + wr * 64 + m * 16 + fr; (void)row;
#define EPI_COLS_BEGIN _Pragma("unroll") for (int bj = 0; bj < 2; ++bj) { const int ct = bj * 128 + wc * 32 + fq * 8; (void)ct; f32x4 v0 = acc[ai][bj][m][0], v1 = acc[ai][bj][m][1];
#define EPI_END } }
#define EPI_FENCE asm volatile("" ::: "memory")
#define EPI_ALLROWS _Pragma("unroll") for (int ai = 0; ai < 2; ++ai) _Pragma("unroll") for (int m = 0; m < 4; ++m)
#define EPI_ROW(ai, m) (u.pm * 256 + (ai) * 128 + wr * 64 + (m) * 16 + fr)
struct EpiInProj {
    static constexpr bool PERM = true;
    unsigned char* ws; const float* bgate;
    __device__ __forceinline__ void rope(f32x4& v0, f32x4& v1, const f32x4& c, const f32x4& s) const { const f32x4 o1 = v0 * c - v1 * s, o2 = v1 * c + v0 * s; v0 = o1; v1 = o2; }
    __device__ __forceinline__ unsigned pk8(const f32x4& v) const { unsigned w = 0; w = __builtin_amdgcn_cvt_pk_fp8_f32(v[0], v[1], w, false); w = __builtin_amdgcn_cvt_pk_fp8_f32(v[2], v[3], w, true); return w; }
    __device__ __forceinline__ void store_rope8(unsigned off, const f32x4& o1, const f32x4& o2) const { *(GAS unsigned*)(ws + off) = pk8(o1); *(GAS unsigned*)(ws + off + 32u) = pk8(o2); }
    __device__ __forceinline__ void store_rope(unsigned off, const f32x4& o1, const f32x4& o2) const {
        u32x2 a, b; a.x = cvt_pk_bf16(o1[0], o1[1]); a.y = cvt_pk_bf16(o1[2], o1[3]); b.x = cvt_pk_bf16(o2[0], o2[1]); b.y = cvt_pk_bf16(o2[2], o2[3]);
        *(GAS u32x2*)(ws + off) = a; *(GAS u32x2*)(ws + off + 64u) = b;
    }
    __device__ __forceinline__ void operator()(const f32x4 (&acc)[2][2][4][2], const pg8::Unit& u, int wr, int wc, int fr, int fq) const {
        asm volatile("" : "+v"(fr), "+v"(fq));
        const int pn = u.pn;
        f32x4 rc[2][4], rs[2][4];
        if (pn >= 2 && pn <= 9) { const int a = (wc & 1) * 4 + fq;
            EPI_ALLROWS { const unsigned o = (unsigned)WS_ROPE + (unsigned)((EPI_ROW(ai, m) & 4095) * 32 + 4 * a) * 4u; rc[ai][m] = *(const GAS f32x4*)(ws + o); rs[ai][m] = *(const GAS f32x4*)(ws + o + (unsigned)(SEQ * 32 * 4)); }
            EPI_FENCE; }
        if (pn < 2) {
            EPI_ROWS_BEGIN const int bb = row >> 12, cc = (row >> 5) & 127, sp = row & 31;
            EPI_COLS_BEGIN const int col = pn * 256 + ct, g = col >> 4, h0 = col & 15;
                { const unsigned uo_ = (unsigned)WS_UGX + (unsigned)((g * 512 + bb * 128 + cc) * UGX_LD + sp * 16 + h0) * 2u; const pg8::u32x4 ud_ = pack8(v0, v1);
                  asm volatile("global_store_dwordx4 %0, %1, %2 sc0 sc1\n\ts_nop 1" :: "v"(uo_), "v"(ud_), "s"(ws) : "memory"); }
            EPI_END
        } else if (pn < 4) {
            EPI_ROWS_BEGIN
            EPI_COLS_BEGIN const int j = (pn - 2) * 256 + ct, head = j >> 6, a = (j & 63) >> 3;
                rope(v0, v1, rc[ai][m], rs[ai][m]); store_rope8((unsigned)WS_Q + (unsigned)(row * 512 + head * 64 + 4 * a), v0, v1);
            EPI_END
        } else if (pn == 4) {
            EPI_ROWS_BEGIN
            EPI_COLS_BEGIN
                if (bj == 0) { const int head = ct >> 6, a = (ct & 63) >> 3; rope(v0, v1, rc[ai][m], rs[ai][m]); store_rope8((unsigned)WS_K + (unsigned)(row * 128 + head * 64 + 4 * a), v0, v1); }
                else { u32x2 w8; w8.x = pk8(v0); w8.y = pk8(v1); *(GAS u32x2*)(ws + ((unsigned)WS_V + (unsigned)(row * 128 + (ct - 128)))) = w8; }
            EPI_END
        } else if (pn < 9) {
            EPI_ROWS_BEGIN
            EPI_COLS_BEGIN const int j = (pn - 5) * 256 + ct, head = j >> 6, a = (j & 63) >> 3;
                rope(v0, v1, rc[ai][m], rs[ai][m]); store_rope((unsigned)WS_QI + (unsigned)(row * 1024 + head * 64 + 4 * a) * 2u, v0, v1);
            EPI_END
        } else if (pn == 9) {
            EPI_ROWS_BEGIN
            EPI_COLS_BEGIN
                if (bj == 0) { if (ct < 64) { const int a = ct >> 3; rope(v0, v1, rc[ai][m], rs[ai][m]); store_rope((unsigned)WS_KI + (unsigned)(row * 64 + 4 * a) * 2u, v0, v1); }
                    else if (ct < 80) { const unsigned o = (unsigned)WS_WI + (unsigned)(row * 16 + (ct - 64)) * 4u; *(GAS f32x4*)(ws + o) = v0 * 0.03125f; *(GAS f32x4*)(ws + o + 16u) = v1 * 0.03125f; } }
            EPI_END
        } else {
            const int br = pn >= 14; const unsigned gbase = br ? (unsigned)WS_GA : (unsigned)WS_GS; const float* bgp = bgate + br * 1024 + (pn - (br ? 14 : 10)) * 256 + wc * 32 + fq * 8;
            f32x4 bb[2][2];
#pragma unroll
            for (int bj = 0; bj < 2; ++bj) { bb[bj][0] = *(const GAS f32x4*)(bgp + bj * 128); bb[bj][1] = *(const GAS f32x4*)(bgp + bj * 128 + 4); }
            EPI_ROWS_BEGIN
            EPI_COLS_BEGIN const int col = (pn - (br ? 14 : 10)) * 256 + ct;
#pragma unroll
                for (int j = 0; j < 4; ++j) { v0[j] = sigmoidf_(v0[j] + bb[bj][0][j]); v1[j] = sigmoidf_(v1[j] + bb[bj][1][j]); }
                *(GAS v4u*)(ws + (gbase + (unsigned)(row * 1024 + col) * 2u)) = pack8(v0, v1);
            EPI_END
        }
    }
};
struct EpiS5State {
    static constexpr bool PERM = true;
    float* SB;
    __device__ __forceinline__ void operator()(const f32x4 (&acc)[2][2][4][2], const pg8::Unit& u, int wr, int wc, int fr, int fq) const {
        EPI_ROWS_BEGIN
        EPI_COLS_BEGIN
            if (bj == 0) { float* d = SB + ((size_t)u.e * 512 + row) * 128 + ct; *(GAS f32x4*)d = v0; *(GAS f32x4*)(d + 4) = v1; }
        EPI_END
    }
};
struct EpiS5Y {
    static constexpr bool PERM = true;
    const bf16* UGX; const float* Dsk; bf16* YG;
    __device__ __forceinline__ void operator()(const f32x4 (&acc)[2][2][4][2], const pg8::Unit& u, int wr, int wc, int fr, int fq) const {
        const int g = u.e;
        const f32x4 d0 = *(const GAS f32x4*)(Dsk + g * 16 + ((fq * 8) & 15)), d1 = *(const GAS f32x4*)(Dsk + g * 16 + ((fq * 8) & 15) + 4);
        v4u ux[2][4][2];
        EPI_ALLROWS {
#pragma unroll
            for (int bj = 0; bj < 2; ++bj) ux[ai][m][bj] = *(const GAS v4u*)(UGX + ((size_t)g * 512 + EPI_ROW(ai, m)) * UGX_LD + u.pn * 256 + bj * 128 + wc * 32 + fq * 8); }
        EPI_FENCE;
        EPI_ROWS_BEGIN const int bb = row >> 7, cc = row & 127;
        EPI_COLS_BEGIN const int n = u.pn * 256 + ct, tp = n >> 4, h0 = n & 15;
            const v4u uu = ux[ai][m][bj];
            v0[0] += d0[0] * bflo(uu.x); v0[1] += d0[1] * bfhi(uu.x); v0[2] += d0[2] * bflo(uu.y); v0[3] += d0[3] * bfhi(uu.y);
            v1[0] += d1[0] * bflo(uu.z); v1[1] += d1[1] * bfhi(uu.z); v1[2] += d1[2] * bflo(uu.w); v1[3] += d1[3] * bfhi(uu.w);
#pragma unroll
            for (int j = 0; j < 4; ++j) { v0[j] = gelu_tanh(v0[j]); v1[j] = gelu_tanh(v1[j]); }
            const int tok = bb * 4096 + cc * 32 + tp;
            *(GAS v4u*)(YG + (size_t)tok * 512 + g * 16 + h0) = pack8(v0, v1);
        EPI_END
    }
};
struct EpiGlu {
    static constexpr bool PERM = true;
    const bf16* YG; const float* bglu; bf16* YS;
    __device__ __forceinline__ void operator()(const f32x4 (&acc)[2][2][4][2], const pg8::Unit& u, int wr, int wc, int fr, int fq) const {
        f32x4 bb[2][2]; v4u yx[2][4][2];
#pragma unroll
        for (int bj = 0; bj < 2; ++bj) { const float* bp = bglu + u.pn * 256 + bj * 128 + wc * 32 + fq * 8; bb[bj][0] = *(const GAS f32x4*)bp; bb[bj][1] = *(const GAS f32x4*)(bp + 4); }
        EPI_ALLROWS {
#pragma unroll
            for (int bj = 0; bj < 2; ++bj) yx[ai][m][bj] = *(const GAS v4u*)(YG + (size_t)EPI_ROW(ai, m) * 512 + u.pn * 256 + bj * 128 + wc * 32 + fq * 8); }
        EPI_FENCE;
        EPI_ROWS_BEGIN
        EPI_COLS_BEGIN const int col = u.pn * 256 + ct;
            const v4u yy = yx[ai][m][bj];
            const f32x4 b0 = bb[bj][0], b1 = bb[bj][1];
            v0[0] = bflo(yy.x) * sigmoidf_(v0[0] + b0[0]); v0[1] = bfhi(yy.x) * sigmoidf_(v0[1] + b0[1]); v0[2] = bflo(yy.y) * sigmoidf_(v0[2] + b0[2]); v0[3] = bfhi(yy.y) * sigmoidf_(v0[3] + b0[3]);
            v1[0] = bflo(yy.z) * sigmoidf_(v1[0] + b1[0]); v1[1] = bfhi(yy.z) * sigmoidf_(v1[1] + b1[1]); v1[2] = bflo(yy.w) * sigmoidf_(v1[2] + b1[2]); v1[3] = bfhi(yy.w) * sigmoidf_(v1[3] + b1[3]);
            *(GAS v4u*)(YS + (size_t)row * 512 + col) = pack8(v0, v1);
        EPI_END
    }
};
struct EpiMix {
    static constexpr bool PERM = true;
    const bf16* GS; const bf16* GA; bf16* MX;
    __device__ __forceinline__ void operator()(const f32x4 (&acc)[2][2][4][2], const pg8::Unit& u, int wr, int wc, int fr, int fq) const {
        const bf16* Gp = u.e ? GA : GS;
        EPI_ROWS_BEGIN
        EPI_COLS_BEGIN const size_t off = (size_t)row * 1024 + u.pn * 256 + ct;
            const v4u gg = *(const GAS v4u*)(Gp + off);
            v0[0] *= bflo(gg.x); v0[1] *= bfhi(gg.x); v0[2] *= bflo(gg.y); v0[3] *= bfhi(gg.y); v1[0] *= bflo(gg.z); v1[1] *= bfhi(gg.z); v1[2] *= bflo(gg.w); v1[3] *= bfhi(gg.w);
            if (u.e) { const v4u pp = *(const GAS v4u*)(MX + off);
                v0[0] += bflo(pp.x); v0[1] += bfhi(pp.x); v0[2] += bflo(pp.y); v0[3] += bfhi(pp.y); v1[0] += bflo(pp.z); v1[1] += bfhi(pp.z); v1[2] += bflo(pp.w); v1[3] += bfhi(pp.w); }
            *(GAS v4u*)(MX + off) = pack8(v0, v1);
        EPI_END
    }
};
struct EpiOut {
    static constexpr bool PERM = true;
    const float* X; bf16* X1;
    __device__ __forceinline__ void operator()(const f32x4 (&acc)[2][2][4][2], const pg8::Unit& u, int wr, int wc, int fr, int fq) const {
        f32x4 xr[4][2][2];
#pragma unroll
        for (int m = 0; m < 4; ++m)
#pragma unroll
            for (int bj = 0; bj < 2; ++bj) { const float* xp = X + (size_t)EPI_ROW(0, m) * 1024 + u.pn * 256 + bj * 128 + wc * 32 + fq * 8; xr[m][bj][0] = *(const GAS f32x4*)xp; xr[m][bj][1] = *(const GAS f32x4*)(xp + 4); }
        EPI_FENCE;
        EPI_ROWS_BEGIN
        EPI_COLS_BEGIN const size_t off = (size_t)row * 1024 + u.pn * 256 + ct;
            *(GAS v4u*)(X1 + off) = pack8(v0 + xr[m][bj][0], v1 + xr[m][bj][1]);
            if (ai == 0) { const float* xp = X + off + (size_t)128 * 1024; xr[m][bj][0] = *(const GAS f32x4*)xp; xr[m][bj][1] = *(const GAS f32x4*)(xp + 4); }
        EPI_END
    }
};
struct EpiMoe1 {
    static constexpr bool PERM = true;
    const float* bmi; bf16* ACT;
    __device__ __forceinline__ void operator()(const f32x4 (&acc)[2][2][4][2], const pg8::Unit& u, int wr, int wc, int fr, int fq) const {
        const float* bp = bmi + (size_t)u.e * 2048 + u.pn * 256 + wc * 32 + fq * 8;
        f32x4 bb[2][2];
#pragma unroll
        for (int bj = 0; bj < 2; ++bj) { bb[bj][0] = *(const GAS f32x4*)(bp + bj * 128); bb[bj][1] = *(const GAS f32x4*)(bp + bj * 128 + 4); }
        EPI_ROWS_BEGIN
        EPI_COLS_BEGIN const int col = u.pn * 256 + ct;
            v0 += bb[bj][0]; v1 += bb[bj][1]; float o[4];
#pragma unroll
            for (int j = 0; j < 4; ++j) { const float zg0 = (j < 2) ? v0[2 * j] : v1[2 * j - 4], zl0 = (j < 2) ? v0[2 * j + 1] : v1[2 * j - 3];
                const float zg = fminf(zg0, 7.0f), zl = fminf(fmaxf(zl0, -7.0f), 7.0f); o[j] = zg * __builtin_amdgcn_rcpf(1.0f + __builtin_amdgcn_exp2f(-2.4554669595930157f * zg)) * (zl + 1.0f); }
            u32x2 w; w.x = cvt_pk_bf16(o[0], o[1]); w.y = cvt_pk_bf16(o[2], o[3]);
            *(GAS u32x2*)(ACT + (size_t)row * 1024 + (col >> 1)) = w;
        EPI_END
    }
};
struct EpiMoe2 {
    static constexpr bool PERM = true;
    const float* bmo; bf16* Y2;
    __device__ __forceinline__ void operator()(const f32x4 (&acc)[2][2][4][2], const pg8::Unit& u, int wr, int wc, int fr, int fq) const {
        const float* bp = bmo + (size_t)u.e * 1024 + u.pn * 256 + wc * 32 + fq * 8;
        f32x4 bb[2][2];
#pragma unroll
        for (int bj = 0; bj < 2; ++bj) { bb[bj][0] = *(const GAS f32x4*)(bp + bj * 128); bb[bj][1] = *(const GAS f32x4*)(bp + bj * 128 + 4); }
        EPI_ROWS_BEGIN
        EPI_COLS_BEGIN const int col = u.pn * 256 + ct;
            v0 += bb[bj][0]; v1 += bb[bj][1];
            *(GAS v4u*)(Y2 + (size_t)row * 1024 + col) = pack8(v0, v1);
        EPI_END
    }
};

__device__ __forceinline__ unsigned f16key(unsigned bits) { return (bits & 0x8000u) ? (bits ^ 0xffffu) : (bits | 0x8000u); }
__device__ __forceinline__ void idx_phase(Frame& F) {
    LAS unsigned char* lds = F.lds;
    LAS u16* SC = (LAS u16*)lds;
    LAS unsigned char* KT = lds + 65536;
    LAS unsigned* HP = (LAS unsigned*)(lds + 147456);
    LAS unsigned char* OLB = lds + 147456 + 4096;
    const bf16* QI = (const bf16*)(F.ws + WS_QI); const bf16* KI = (const bf16*)(F.ws + WS_KI); const float* WI = (const float*)(F.ws + WS_WI);
    u16* SEL = (u16*)(F.ws + WS_SEL);
    const int tid = F.tid, lane = F.lane, wave = F.wave, qg = wave & 1, kq = wave >> 1, kgrp = lane >> 4, l15 = lane & 15;
    const int kx = l15 >> 1, cpos = lane & 7;
    const int dsw = ((wave & 1) * 4 + (lane >> 4)) & 7;
    bf16x8 qa[4][2]; float w[16];
#define IDX_UNIT(r_, b_, t0_) const int b_ = (r_) >> 1, t0_ = (((r_) & 1) ? 511 - (int)blockIdx.x : (int)blockIdx.x) * 8
#define IDX_DMA(kb_, st, bufi) do { _Pragma("unroll") for (int j_ = 0; j_ < 2; ++j_) { const int row_ = (j_ * 8 + wave) * 8 + (lane >> 3); \
        __builtin_amdgcn_global_load_lds((const unsigned*)((kb_) + ((size_t)(st) * 128 + row_) * 64 + ((cpos ^ dsw) << 3)), (LAS unsigned*)(KT + (bufi) * 16384 + (j_ * 8 + wave) * 1024), 16, 0, 0); } } while (0)
#define IDX_PREFETCH(r_) do { IDX_UNIT(r_, pb_, pt0_); if (pt0_ >= 256) { \
        const bf16* qp_ = QI + ((size_t)pb_ * SEQ + pt0_ + 4 * qg + (l15 >> 2)) * 1024 + (l15 & 3) * 64 + kgrp * 8; \
        _Pragma("unroll") for (int i = 0; i < 4; ++i) _Pragma("unroll") for (int ks = 0; ks < 2; ++ks) qa[i][ks] = *(const GAS bf16x8*)(qp_ + i * 256 + ks * 32); \
        const float* wp_ = WI + ((size_t)pb_ * SEQ + pt0_ + 4 * qg + kgrp) * 16; \
        _Pragma("unroll") for (int i = 0; i < 4; ++i) { const f32x4 x = *(const GAS f32x4*)(wp_ + 4 * i); w[4 * i] = x[0]; w[4 * i + 1] = x[1]; w[4 * i + 2] = x[2]; w[4 * i + 3] = x[3]; } \
        const bf16* pk_ = KI + (size_t)pb_ * SEQ * 64; const int pn_ = (pt0_ + 7) / 128 + 1; \
        IDX_DMA(pk_, 0, 0); if (1 < pn_) IDX_DMA(pk_, 1, 1); if (2 < pn_) IDX_DMA(pk_, 2, 2); if (3 < pn_) IDX_DMA(pk_, 3, 3); } } while (0)
    IDX_PREFETCH(0);
    for (int r = 0; r < 8; ++r) {
        IDX_UNIT(r, b, t0);
        __syncthreads();
        const int t = t0 + wave; const size_t tok = (size_t)b * SEQ + t;
        if (t0 < 256) {
            v2u x; const int k0 = lane * 4;
            x.x = (unsigned)(k0 <= t ? k0 : 0) | ((unsigned)(k0 + 1 <= t ? k0 + 1 : 0) << 16); x.y = (unsigned)(k0 + 2 <= t ? k0 + 2 : 0) | ((unsigned)(k0 + 3 <= t ? k0 + 3 : 0) << 16);
            *(GAS v2u*)(SEL + tok * NSEL + k0) = x;
            if (r + 1 < 8) IDX_PREFETCH(r + 1);
            continue;
        }
        HP[tid * 2] = 0u; HP[tid * 2 + 1] = 0u;
        const int nst = (t0 + 7) / 128 + 1;
        const int tq = t0 + 4 * qg + kgrp, qrow = 4 * qg + kgrp;
        const bf16* kbat = KI + (size_t)b * SEQ * 64;
        const unsigned hpq = (unsigned)(unsigned long)(HP + qrow * 128);
#define IDX_EPI1(kgl_, AC) do { float s0 = 0.f; \
            _Pragma("unroll") for (int i = 0; i < 4; ++i) _Pragma("unroll") for (int r_ = 0; r_ < 4; ++r_) { const float a0_ = AC[i][r_]; const int i0 = __builtin_bit_cast(int, a0_); const float m0 = __builtin_bit_cast(float, i0 > 0 ? i0 : 0); s0 += w[4 * i + r_] * m0; } \
            const _Float16 h0_ = (_Float16)s0; const unsigned key0_ = f16key(__builtin_bit_cast(unsigned short, h0_)); const int kg0 = (kgl_); \
            SC[qrow * 4096 + kg0] = (u16)key0_; \
            if (kg0 <= tq) { const unsigned bin = key0_ >> 8; const unsigned ha_ = hpq + ((bin >> 1) << 2), hv_ = (bin & 1u) ? 0x10000u : 1u; \
                asm volatile("ds_add_u32 %0, %1" :: "v"(ha_), "v"(hv_) : "memory"); } } while (0)
#define IDX_READ(BQ, kt2) do { _Pragma("unroll") for (int ks = 0; ks < 2; ++ks) BQ[ks] = *(const LAS bf16x8*)(kb + (kq * 32 + (kt2) * 16 + l15) * 128 + (((ks * 4 + kgrp) ^ kx) << 4)); } while (0)
#define IDX_MMA(AC, BQ) do { _Pragma("unroll") for (int i = 0; i < 4; ++i) { AC[i] = (f32x4){0.f, 0.f, 0.f, 0.f}; _Pragma("unroll") for (int ks = 0; ks < 2; ++ks) AC[i] = __builtin_amdgcn_mfma_f32_16x16x32_bf16(qa[i][ks], BQ[ks], AC[i], 0, 0, 0); } } while (0)
        bf16x8 bq0[2], bq1[2];
        f32x4 aA[4], aB[4];
#pragma unroll
        for (int i = 0; i < 4; ++i) { aA[i] = (f32x4){0.f, 0.f, 0.f, 0.f}; aB[i] = aA[i]; }
        int bcur = 0, bnew = 4;
        TPROBE_BEGIN(100);
        for (int st = 0; st < nst; ++st) {
            if (st + 3 < nst) asm volatile("s_waitcnt vmcnt(6)" ::: "memory"); else asm volatile("s_waitcnt vmcnt(0)" ::: "memory");
            __syncthreads();
            if (st + 4 < nst) IDX_DMA(kbat, st + 4, bnew);
            const LAS unsigned char* kb = KT + bcur * 16384;
            const int kbase_ = st * 128 + kq * 32 + l15;
            IDX_READ(bq0, 0);
            IDX_READ(bq1, 1); IDX_MMA(aA, bq0); if (st >= 1) IDX_EPI1(kbase_ - 128 + 16, aB);
            IDX_MMA(aB, bq1); IDX_EPI1(kbase_, aA);
            bcur = (bcur == 4) ? 0 : bcur + 1; bnew = (bnew == 4) ? 0 : bnew + 1;
        }
        IDX_EPI1((nst - 1) * 128 + kq * 32 + l15 + 16, aB);
#undef IDX_EPI1
#undef IDX_MMA
#undef IDX_READ
        __syncthreads();
        TPROBE_END(100);
        TPROBE_BEGIN(101);
        TPROBE_BEGIN(110);
        if (r + 1 < 8) IDX_PREFETCH(r + 1);
        const int n = t + 1, jj = lane, ql = wave;
        const LAS u16* sc = SC + ql * 4096;
        LAS unsigned* hp = HP + ql * 128;
        unsigned b1, need1;
        { const v2u wv = *(const LAS v2u*)(hp + 126 - 2 * jj); unsigned hb[4];
          hb[3] = wv.x & 0xffffu; hb[2] = wv.x >> 16; hb[1] = wv.y & 0xffffu; hb[0] = wv.y >> 16;
          const unsigned s4 = hb[0] + hb[1] + hb[2] + hb[3];
          unsigned pre = s4;
#pragma unroll
          for (int o = 1; o < 64; o <<= 1) { const unsigned x = __shfl_up(pre, o, 64); if (jj >= o) pre += x; }
          const unsigned long long bal = __ballot(pre >= 256u); const int js = __builtin_ctzll(bal);
          unsigned above = pre - s4, bb1 = 0, nd1 = 0; bool found = false;
#pragma unroll
          for (int i = 0; i < 4; ++i) { if (!found) { if (above + hb[i] >= 256u) { bb1 = 255 - (jj * 4 + i); nd1 = 256u - above; found = true; } else above += hb[i]; } }
          b1 = __shfl(bb1, js); need1 = __shfl(nd1, js); }
        TPROBE_END(110);
        TPROBE_BEGIN(111);
        LDS_WAIT(); __builtin_amdgcn_wave_barrier();
#define LDS_ST32(addr_, val_) asm volatile("ds_write_b32 %0, %1" :: "v"((unsigned)(addr_)), "v"((unsigned)(val_)) : "memory")
#define LDS_ST16(addr_, val_) asm volatile("ds_write_b16 %0, %1" :: "v"((unsigned)(addr_)), "v"((unsigned)(val_)) : "memory")
#define LDS_ADD32(addr_, val_) asm volatile("ds_add_u32 %0, %1" :: "v"((unsigned)(addr_)), "v"((unsigned)(val_)) : "memory")
        const unsigned hpw = (unsigned)(unsigned long)hp, scw = (unsigned)(unsigned long)sc;
        LDS_ST32(hpw + jj * 8, 0u); LDS_ST32(hpw + jj * 8 + 4, 0u);
        const int nit = (n + 511) >> 9;
        { const int base = (nit - 1) * 512 + jj * 8;
#pragma unroll
          for (int e = 0; e < 8; ++e) if (base + e >= n) LDS_ST16(scw + (base + e) * 2, 0u); }
        LDS_WAIT(); __builtin_amdgcn_wave_barrier();
        const unsigned B1 = b1 | (b1 << 16);
#pragma unroll 4
        for (int it = 0; it < nit; ++it) { const int base = it * 512 + jj * 8; const v4u x = *(const LAS v4u*)(sc + base);
#pragma unroll
            for (int i = 0; i < 4; ++i) { const unsigned d = (i == 0) ? x.x : (i == 1) ? x.y : (i == 2) ? x.z : x.w; const unsigned m = ((d >> 8) & 0x00ff00ffu) ^ B1;
                const unsigned l0 = d & 255u, l1 = (d >> 16) & 255u;
                LDS_ADD32(hpw + ((l0 >> 1) << 2), ((m & 0xffffu) == 0u) ? ((l0 & 1u) ? 0x10000u : 1u) : 0u);
                LDS_ADD32(hpw + ((l1 >> 1) << 2), ((m >> 16) == 0u) ? ((l1 & 1u) ? 0x10000u : 1u) : 0u); } }
        LDS_WAIT(); __builtin_amdgcn_wave_barrier();
        TPROBE_END(111);
        TPROBE_BEGIN(112);
        unsigned T, need2;
        { const v2u wv = *(const LAS v2u*)(hp + 126 - 2 * jj); unsigned hb[4];
          hb[3] = wv.x & 0xffffu; hb[2] = wv.x >> 16; hb[1] = wv.y & 0xffffu; hb[0] = wv.y >> 16;
          const unsigned s4 = hb[0] + hb[1] + hb[2] + hb[3];
          unsigned pre = s4;
#pragma unroll
          for (int o = 1; o < 64; o <<= 1) { const unsigned x = __shfl_up(pre, o, 64); if (jj >= o) pre += x; }
          const unsigned long long bal = __ballot(pre >= need1); const int js = __builtin_ctzll(bal);
          unsigned above = pre - s4, bb2 = 0, nd2 = 0; bool found = false;
#pragma unroll
          for (int i = 0; i < 4; ++i) { if (!found) { if (above + hb[i] >= need1) { bb2 = 255 - (jj * 4 + i); nd2 = need1 - above; found = true; } else above += hb[i]; } }
          const unsigned b2 = __shfl(bb2, js); need2 = __shfl(nd2, js); T = (b1 << 8) | b2; }
        TPROBE_END(112);
        TPROBE_BEGIN(113);
        const unsigned olw = (unsigned)(unsigned long)(OLB + ql * 512);
        const unsigned G = 256u - need2, Tp = T | (T << 16); unsigned cg = 0, tc = 0;
#pragma unroll 2
        for (int it = 0; it < nit; ++it) { const int base = it * 512 + jj * 8; const v4u x = *(const LAS v4u*)(sc + base);
            unsigned g[8], c = 0, anyeq = 0;
#pragma unroll
            for (int i = 0; i < 4; ++i) { const unsigned d = (i == 0) ? x.x : (i == 1) ? x.y : (i == 2) ? x.z : x.w;
                g[2 * i] = ((d & 0xffffu) > T) ? 1u : 0u; g[2 * i + 1] = ((d >> 16) > T) ? 1u : 0u; c += g[2 * i] + g[2 * i + 1];
                const unsigned q = d ^ Tp; anyeq |= (((q & 0xffffu) == 0u) || ((q >> 16) == 0u)) ? 1u : 0u; }
            const unsigned long long m0 = __ballot(c & 1u), m1 = __ballot(c & 2u), m2 = __ballot(c & 4u), m3 = __ballot(c & 8u);
            unsigned pos = cg + __builtin_amdgcn_mbcnt_hi((unsigned)(m0 >> 32), __builtin_amdgcn_mbcnt_lo((unsigned)m0, 0u)) + 2u * __builtin_amdgcn_mbcnt_hi((unsigned)(m1 >> 32), __builtin_amdgcn_mbcnt_lo((unsigned)m1, 0u))
                         + 4u * __builtin_amdgcn_mbcnt_hi((unsigned)(m2 >> 32), __builtin_amdgcn_mbcnt_lo((unsigned)m2, 0u)) + 8u * __builtin_amdgcn_mbcnt_hi((unsigned)(m3 >> 32), __builtin_amdgcn_mbcnt_lo((unsigned)m3, 0u));
            cg += (unsigned)__builtin_popcountll(m0) + 2u * (unsigned)__builtin_popcountll(m1) + 4u * (unsigned)__builtin_popcountll(m2) + 8u * (unsigned)__builtin_popcountll(m3);
#pragma unroll
            for (int e = 0; e < 8; ++e) { const unsigned a_ = olw + ((pos < 256u ? pos : 255u) << 1); if (g[e]) LDS_ST16(a_, base + e); pos += g[e]; }
            if (__ballot(anyeq) != 0ull) {
#pragma unroll
                for (int e = 0; e < 8; ++e) { const unsigned wd = (e < 2) ? x.x : (e < 4) ? x.y : (e < 6) ? x.z : x.w; const unsigned k = (e & 1) ? (wd >> 16) : (wd & 0xffffu);
                    const bool eq = k == T; const unsigned long long me = __ballot(eq);
                    const unsigned pe = tc + __builtin_amdgcn_mbcnt_hi((unsigned)(me >> 32), __builtin_amdgcn_mbcnt_lo((unsigned)me, 0u));
                    if (eq && pe < need2) LDS_ST16(olw + ((G + pe) << 1), base + e);
                    tc += (unsigned)__builtin_popcountll(me); } } }
#undef LDS_ST32
#undef LDS_ST16
#undef LDS_ADD32
        LDS_WAIT(); __builtin_amdgcn_wave_barrier();
        { const v2u x = *(const LAS v2u*)((LAS u16*)(OLB + ql * 512) + jj * 4); *(GAS v2u*)(SEL + tok * NSEL + jj * 4) = x; }
        TPROBE_END(113);
        TPROBE_END(101);
    }
#undef IDX_DMA
#undef IDX_PREFETCH
#undef IDX_UNIT
}

__device__ __forceinline__ void carry_phase(Frame& F) {
    const int gid = blockIdx.x * NTHR + F.tid; if (gid >= NGRP * NB * 64) return;
    const int p = gid & 63, b = (gid >> 6) & 3, g = gid >> 8;
    const float* A32 = (const float*)(F.ws + WS_A32) + g * 128; const float ar = A32[p * 2], ai = A32[p * 2 + 1];
    const float* SB = (const float*)(F.ws + WS_SBUF) + ((size_t)g * 512 + b * 128) * 128; bf16* UX = (bf16*)(F.ws + WS_UGX) + ((size_t)g * 512 + b * 128) * UGX_LD;
    float xr = 0.f, xi = 0.f;
    for (int c = 0; c < NCH; ++c) {
        UX[(size_t)c * UGX_LD + 512 + p] = (bf16)f2bf(xr); UX[(size_t)c * UGX_LD + 576 + p] = (bf16)f2bf(xi);
        const float sr = SB[c * 128 + p], si = SB[c * 128 + 64 + p];
        const float nr = ar * xr - ai * xi + sr, ni = ar * xi + ai * xr + si; xr = nr; xi = ni;
    }
}

template <int N> __device__ __forceinline__ void wait_vm() { asm volatile("s_waitcnt vmcnt(%0)" :: "n"(N) : "memory"); }
__device__ __forceinline__ unsigned pk_fp8x4(float a, float b, float c, float d) { unsigned w = 0; w = __builtin_amdgcn_cvt_pk_fp8_f32(a, b, w, false); w = __builtin_amdgcn_cvt_pk_fp8_f32(c, d, w, true); return w; }
__device__ __forceinline__ void attn_phase(Frame& F) {
    constexpr int WSTR = 20224;
    LAS unsigned char* RING = F.lds + F.wave * WSTR;
    LAS u16* SL = (LAS u16*)(RING + 16384);
    const unsigned char* Q8 = F.ws + WS_Q; const unsigned char* K8 = F.ws + WS_K; const unsigned char* V8 = F.ws + WS_V;
    const u16* SEL = (const u16*)(F.ws + WS_SEL); bf16* YA = (bf16*)(F.ws + WS_YATT);
    const int lane = F.lane, gw = blockIdx.x * NWAVES + F.wave;
    const int hd = lane & 15, kg = lane >> 4;
    const int l4 = lane >> 2, cpos = lane & 3;
    int kra[2];
#pragma unroll
    for (int ks = 0; ks < 2; ++ks) kra[ks] = hd * 64 + (((ks * 2 + (kg >> 1)) ^ ((hd >> 2) & 3)) << 4) + (kg & 1) * 8;
    unsigned tra[4];
    { const int r = hd >> 1, c = hd & 1, row = (r >> 2) * 16 + kg * 4 + (r & 3), f = (kg & 1) | ((r >> 2) << 1); const unsigned rb = (unsigned)(unsigned long)RING;
#pragma unroll
      for (int mt = 0; mt < 4; ++mt) tra[mt] = rb + row * 64 + ((mt ^ f) << 4) + c * 8; }
    const bool early = (int)blockIdx.x < 128; const int ew = blockIdx.x * NWAVES + F.wave, nitems = early ? 23 : 9;
    for (int k_ = 0; k_ < nitems; ++k_) { const int it = (k_ < 9) ? gw + 2048 * k_ : 18432 + ew + 1024 * (k_ - 9);
        const int tok = it >> 1, kvh = it & 1, t = tok & 4095; const size_t bbase = (size_t)(tok >> 12) * SEQ;
        const int nsel = (t + 1 < NSEL) ? t + 1 : NSEL;
        { const v2u x = *(const GAS v2u*)(SEL + (size_t)tok * NSEL + lane * 4); *(LAS v2u*)(SL + lane * 4) = x; }
        long qf[2];
#pragma unroll
        for (int ks = 0; ks < 2; ++ks) { if (hd < 4) qf[ks] = *(const GAS long*)(Q8 + (size_t)tok * 512 + (kvh * 4 + hd) * 64 + ks * 32 + kg * 8); else qf[ks] = 0; }
        asm volatile("s_waitcnt vmcnt(0)" : "+v"(qf[0]), "+v"(qf[1]) :: "memory");
        LDS_WAIT(); __builtin_amdgcn_wave_barrier();
        const unsigned char* kbp = K8 + bbase * 128 + kvh * 64; const unsigned char* vbp = V8 + bbase * 128 + kvh * 64;
        f32x4 sc[4][4]; f32x4 oacc[4];
#pragma unroll
        for (int c = 0; c < 4; ++c)
#pragma unroll
            for (int tl = 0; tl < 4; ++tl) sc[c][tl] = (f32x4){0.f, 0.f, 0.f, 0.f};
#pragma unroll
        for (int m = 0; m < 4; ++m) oacc[m] = (f32x4){0.f, 0.f, 0.f, 0.f};
        float inv = 1.0f;
#define ATT_ISSUE(s) do { const int c_ = (s) & 3; const bool isk_ = (s) < 4; const unsigned char* gb_ = isk_ ? kbp : vbp; int sel_[4]; \
            _Pragma("unroll") for (int j_ = 0; j_ < 4; ++j_) { const int ki_ = c_ * 64 + j_ * 16 + l4; sel_[j_] = (int)SL[ki_ < nsel ? ki_ : 0]; } \
            _Pragma("unroll") for (int j_ = 0; j_ < 4; ++j_) { const int f_ = isk_ ? ((l4 >> 2) & 3) : (((l4 >> 2) & 1) | ((j_ & 1) << 1)); \
                __builtin_amdgcn_global_load_lds((const unsigned*)(gb_ + (size_t)sel_[j_] * 128 + ((cpos ^ f_) << 4)), (LAS unsigned*)(RING + ((s) & 3) * 4096 + j_ * 1024), 16, 0, 0); } } while (0)
        ATT_ISSUE(0); ATT_ISSUE(1); ATT_ISSUE(2);
#pragma unroll
        for (int s = 0; s < 8; ++s) {
            if (s + 3 < 8) ATT_ISSUE(s + 3);
            if (s <= 4) wait_vm<12>(); else if (s == 5) wait_vm<8>(); else if (s == 6) wait_vm<4>(); else wait_vm<0>();
            const LAS unsigned char* buf = RING + (s & 3) * 4096;
            if (s < 4) {
#pragma unroll
                for (int tl = 0; tl < 4; ++tl)
#pragma unroll
                    for (int ks = 0; ks < 2; ++ks) { const long af = *(const LAS long*)(buf + tl * 1024 + kra[ks]);
                        sc[s][tl] = __builtin_amdgcn_mfma_f32_16x16x32_fp8_fp8(af, qf[ks], sc[s][tl], 0, 0, 0); }
                if (s == 3) {
                    float mx = -3.0e38f;
#pragma unroll
                    for (int c = 0; c < 4; ++c)
#pragma unroll
                        for (int tl = 0; tl < 4; ++tl)
#pragma unroll
                            for (int r = 0; r < 4; ++r) { const int key = c * 64 + tl * 16 + kg * 4 + r; const float v = (key < nsel) ? sc[c][tl][r] * 0.125f : -3.0e38f; sc[c][tl][r] = v; mx = fmaxf(mx, v); }
                    mx = fmaxf(mx, __shfl_xor(mx, 16)); mx = fmaxf(mx, __shfl_xor(mx, 32));
                    float sum = 0.f;
#pragma unroll
                    for (int c = 0; c < 4; ++c)
#pragma unroll
                        for (int tl = 0; tl < 4; ++tl)
#pragma unroll
                            for (int r = 0; r < 4; ++r) { const float e = __expf(sc[c][tl][r] - mx); sc[c][tl][r] = e; sum += e; }
                    sum += __shfl_xor(sum, 16); sum += __shfl_xor(sum, 32);
                    inv = 1.0f / sum;
                }
            } else {
                const int c = s - 4;
                v2u pw[2];
#pragma unroll
                for (int h2 = 0; h2 < 2; ++h2) { pw[h2].x = pk_fp8x4(sc[c][2 * h2][0], sc[c][2 * h2][1], sc[c][2 * h2][2], sc[c][2 * h2][3]); pw[h2].y = pk_fp8x4(sc[c][2 * h2 + 1][0], sc[c][2 * h2 + 1][1], sc[c][2 * h2 + 1][2], sc[c][2 * h2 + 1][3]); }
                v2u a[8];
                asm volatile("ds_read_b64_tr_b8 %0, %8 offset:%12\n\tds_read_b64_tr_b8 %1, %9 offset:%12\n\tds_read_b64_tr_b8 %2, %10 offset:%12\n\tds_read_b64_tr_b8 %3, %11 offset:%12\n\t"
                             "ds_read_b64_tr_b8 %4, %8 offset:%13\n\tds_read_b64_tr_b8 %5, %9 offset:%13\n\tds_read_b64_tr_b8 %6, %10 offset:%13\n\tds_read_b64_tr_b8 %7, %11 offset:%13\n\ts_waitcnt lgkmcnt(0)"
                             : "=&v"(a[0]), "=&v"(a[1]), "=&v"(a[2]), "=&v"(a[3]), "=&v"(a[4]), "=&v"(a[5]), "=&v"(a[6]), "=&v"(a[7])
                             : "v"(tra[0]), "v"(tra[1]), "v"(tra[2]), "v"(tra[3]), "n"((s & 3) * 4096), "n"((s & 3) * 4096 + 2048) : "memory");
#pragma unroll
                for (int h2 = 0; h2 < 2; ++h2)
#pragma unroll
                    for (int mt = 0; mt < 4; ++mt)
                        oacc[mt] = __builtin_amdgcn_mfma_f32_16x16x32_fp8_fp8(__builtin_bit_cast(long, a[4 * h2 + mt]), __builtin_bit_cast(long, pw[h2]), oacc[mt], 0, 0, 0);
            }
        }
#undef ATT_ISSUE
        if (hd < 4) {
            bf16* yo = YA + (size_t)tok * 512 + (kvh * 4 + hd) * 64 + kg * 4;
#pragma unroll
            for (int mt = 0; mt < 4; ++mt) { pg8::u32x2 w; w.x = pg8::cvt_pk_bf16(oacc[mt][0] * inv, oacc[mt][1] * inv); w.y = pg8::cvt_pk_bf16(oacc[mt][2] * inv, oacc[mt][3] * inv); *(GAS pg8::u32x2*)(yo + 16 * mt) = w; }
        }
        LDS_WAIT(); __builtin_amdgcn_wave_barrier();
    }
}

__device__ __forceinline__ void router_phase(Frame& F) {
    constexpr int HRS = 1028;
    LAS float* HR = (LAS float*)(F.lds);
    LAS float* PT = (LAS float*)(F.lds + 65792);
    LAS int* LE = (LAS int*)(F.lds + 82176);
    LAS int* LP = (LAS int*)(F.lds + 83200);
    LAS unsigned* LC = (LAS unsigned*)(F.lds + 84224);
    const bf16* X1 = (const bf16*)(F.ws + WS_X1); bf16* H2 = (bf16*)(F.ws + WS_H2);
    const float* WR = F.in[I_WR]; const float* BR = F.in[I_BR]; const float* G2 = F.in[I_N2G];
    int* TOPE = (int*)(F.ws + WS_TOPE); float* TOPW = (float*)(F.ws + WS_TOPW); int* TOPPOS = (int*)(F.ws + WS_TOPPOS); int* ROWMAP = (int*)(F.ws + WS_ROWMAP);
    const int tid = F.tid, lane = F.lane, wave = F.wave, e = lane & 31, dh = lane >> 5;
    float wb[32][2];
#pragma unroll
    for (int i = 0; i < 32; ++i)
#pragma unroll
        for (int t = 0; t < 2; ++t) wb[i][t] = WR[(size_t)(128 * wave + 4 * i + (lane >> 4)) * 32 + (lane & 15) + 16 * t];
    if (tid < 64) LC[tid] = 0u;
    const int tok0 = blockIdx.x * 64;
    v2u nv[2][4];
#pragma unroll
    for (int rr = 0; rr < 2; ++rr)
#pragma unroll
        for (int j = 0; j < 4; ++j) nv[rr][j] = ((const GAS v2u*)(X1 + (size_t)(tok0 + 2 * wave + rr) * DM) + lane)[64 * j];
    for (int bt = 0; bt < 4; ++bt) {
        __syncthreads();
#pragma unroll
        for (int rr = 0; rr < 2; ++rr) { const int lr = 2 * wave + rr, tok = tok0 + bt * 16 + lr;
            const GAS f32x4* gr = (const GAS f32x4*)G2 + lane;
            f32x4 v[4]; float s2 = 0.f;
#pragma unroll
            for (int j = 0; j < 4; ++j) { v[j] = (f32x4){bflo(nv[rr][j].x), bfhi(nv[rr][j].x), bflo(nv[rr][j].y), bfhi(nv[rr][j].y)}; s2 += (v[j].x * v[j].x + v[j].y * v[j].y) + (v[j].z * v[j].z + v[j].w * v[j].w); }
            const float rstd = 1.0f / sqrtf(wave_sum(s2) * (1.f / DM) + RMS_EPS);
            GAS unsigned long long* o8 = (GAS unsigned long long*)(H2 + (size_t)tok * DM) + lane;
#pragma unroll
            for (int j = 0; j < 4; ++j) { const f32x4 gg = gr[64 * j]; const f32x4 h = v[j] * rstd * gg;
                *(LAS f32x4*)(HR + lr * HRS + 256 * j + 4 * lane) = h;
                o8[64 * j] = (unsigned long long)pk2(h.x, h.y) | ((unsigned long long)pk2(h.z, h.w) << 32); } }
        if (bt + 1 < 4) {
#pragma unroll
            for (int rr = 0; rr < 2; ++rr)
#pragma unroll
                for (int j = 0; j < 4; ++j) nv[rr][j] = ((const GAS v2u*)(X1 + (size_t)(tok0 + (bt + 1) * 16 + 2 * wave + rr) * DM) + lane)[64 * j];
        }
        __syncthreads();
        { f32x4 d0 = {0.f, 0.f, 0.f, 0.f}, d1 = d0; const LAS float* hp = HR + (lane & 15) * HRS + 128 * wave + (lane >> 4);
#pragma unroll
          for (int i = 0; i < 32; ++i) { const float a = hp[4 * i]; d0 = __builtin_amdgcn_mfma_f32_16x16x4f32(a, wb[i][0], d0, 0, 0, 0); d1 = __builtin_amdgcn_mfma_f32_16x16x4f32(a, wb[i][1], d1, 0, 0, 0); }
#pragma unroll
          for (int r = 0; r < 4; ++r) { const int row = 4 * (lane >> 4) + r; PT[(row * 8 + wave) * 32 + (lane & 15)] = d0[r]; PT[(row * 8 + wave) * 32 + 16 + (lane & 15)] = d1[r]; } }
        __syncthreads();
        { const int lr = 2 * wave + dh, tl = bt * 16 + lr, tok = tok0 + tl; float lg = BR[e];
#pragma unroll
          for (int w8 = 0; w8 < 8; ++w8) lg += PT[(lr * 8 + w8) * 32 + e];
          float cur = lg; float tv[4]; int te[4];
#pragma unroll
          for (int k = 0; k < 4; ++k) { float mv = cur; int mi = e;
#pragma unroll
              for (int o = 1; o < 32; o <<= 1) { const float ov = __shfl_xor(mv, o); const int oi = __shfl_xor(mi, o); if (ov > mv || (ov == mv && oi < mi)) { mv = ov; mi = oi; } }
              tv[k] = mv; te[k] = mi; if (e == mi) cur = -3.0e38f; }
          const float e1 = __expf(tv[1] - tv[0]), e2 = __expf(tv[2] - tv[0]), e3 = __expf(tv[3] - tv[0]); const float inv = 1.0f / (1.0f + e1 + e2 + e3);
          if (e < 4) { const int ex = (e == 0) ? te[0] : (e == 1) ? te[1] : (e == 2) ? te[2] : te[3]; const float wv = ((e == 0) ? 1.0f : (e == 1) ? e1 : (e == 2) ? e2 : e3) * inv;
              TOPE[(size_t)tok * 4 + e] = ex; TOPW[(size_t)tok * 4 + e] = wv; LE[tl * 4 + e] = ex; LP[tl * 4 + e] = (int)atomicAdd((unsigned*)&LC[ex], 1u); } }
    }
    __syncthreads();
    if (tid < 32) LC[32 + tid] = __hip_atomic_fetch_add((unsigned*)(F.ctl + CW_ECNT) + tid, LC[tid], RLX_AGENT);
    __syncthreads();
    if (tid < 256) { const int ex = LE[tid], pos = (int)LC[32 + ex] + LP[tid], tok = tok0 + (tid >> 2); TOPPOS[(size_t)tok * 4 + (tid & 3)] = pos; ROWMAP[(size_t)ex * NTOK + pos] = tok; }
}

__device__ __forceinline__ int moe_tables(Frame& F, LAS int* OFF, LAS int* TE, bool build) {
    __syncthreads();
    if (build && F.tid == 0) { int cn[NEXP];
#pragma unroll
        for (int e = 0; e < NEXP; ++e) cn[e] = (int)__hip_atomic_load((unsigned*)(F.ctl + CW_ECNT) + e, RLX_AGENT);
        int acc = 0;
#pragma unroll
        for (int e = 0; e < NEXP; ++e) { const int c = cn[e], nt = (c + 255) >> 8; OFF[e] = acc * 256; OFF[33 + e] = c; for (int i = 0; i < nt; ++i) TE[acc + i] = e; acc += nt; }
        OFF[NEXP] = acc; }
    __syncthreads();
    return OFF[NEXP];
}
__device__ __forceinline__ void combine_phase(Frame& F, bool build) {
    LAS int* OFF = (LAS int*)(F.lds + MISC_OFF + 512); LAS int* TE = OFF + 72;
    (void)moe_tables(F, OFF, TE, build);
    const int* TOPE = (const int*)(F.ws + WS_TOPE); const int* TOPPOS = (const int*)(F.ws + WS_TOPPOS); const float* TOPW = (const float*)(F.ws + WS_TOPW);
    const bf16* X1 = (const bf16*)(F.ws + WS_X1); const bf16* Y2 = (const bf16*)(F.ws + WS_Y2); const float* GF = F.in[I_NFG];
    const int gw = blockIdx.x * NWAVES + F.wave, NGW = F.G * NWAVES, lane = F.lane;
    typedef int v4i __attribute__((ext_vector_type(4)));
    constexpr int NT = NTOK / (256 * NWAVES);
    f32x4 gg[4];
#pragma unroll
    for (int j = 0; j < 4; ++j) gg[j] = ((const GAS f32x4*)GF + lane)[64 * j];
    v4i re, rp; f32x4 rw;
    v2u xr[2][4], yr[2][4][4]; f32x4 wr[2];
#define CMB_REC(i_) do { const int t_ = gw + (i_) * NGW; re = *(const GAS v4i*)(TOPE + (size_t)t_ * 4); rp = *(const GAS v4i*)(TOPPOS + (size_t)t_ * 4); rw = *(const GAS f32x4*)(TOPW + (size_t)t_ * 4); } while (0)
#define CMB_ROWS(i_, b_) do { const int t_ = gw + (i_) * NGW; wr[b_] = rw; \
        _Pragma("unroll") for (int j = 0; j < 4; ++j) xr[b_][j] = ((const GAS v2u*)(X1 + (size_t)t_ * DM) + lane)[64 * j]; \
        _Pragma("unroll") for (int k = 0; k < 4; ++k) { const int slot = OFF[re[k]] + rp[k]; const GAS v2u* yp = (const GAS v2u*)(Y2 + (size_t)slot * DM) + lane; \
            _Pragma("unroll") for (int j = 0; j < 4; ++j) yr[b_][k][j] = yp[64 * j]; } } while (0)
    CMB_REC(0); CMB_ROWS(0, 0); if (NT > 1) CMB_REC(1);
#pragma unroll
    for (int i = 0; i < NT; ++i) { const int b = i & 1, tok = gw + i * NGW;
        asm volatile("" ::: "memory");
        if (i + 1 < NT) CMB_ROWS(i + 1, b ^ 1);
        if (i + 2 < NT) CMB_REC(i + 2);
        asm volatile("" ::: "memory");
        f32x4 v[4];
#pragma unroll
        for (int j = 0; j < 4; ++j) { const v2u x = xr[b][j]; v[j] = (f32x4){bflo(x.x), bfhi(x.x), bflo(x.y), bfhi(x.y)}; }
#pragma unroll
        for (int k = 0; k < 4; ++k) { const float wk = wr[b][k];
#pragma unroll
            for (int j = 0; j < 4; ++j) { const v2u y = yr[b][k][j]; v[j].x += wk * bflo(y.x); v[j].y += wk * bfhi(y.x); v[j].z += wk * bflo(y.y); v[j].w += wk * bfhi(y.y); } }
        float s2 = 0.f;
#pragma unroll
        for (int j = 0; j < 4; ++j) s2 += (v[j].x * v[j].x + v[j].y * v[j].y) + (v[j].z * v[j].z + v[j].w * v[j].w);
        const float rstd = 1.0f / sqrtf(wave_sum(s2) * (1.f / DM) + RMS_EPS);
#pragma unroll
        for (int j = 0; j < 4; ++j) ((GAS f32x4*)(F.out + (size_t)tok * DM) + lane)[64 * j] = v[j] * rstd * gg[j];
    }
#undef CMB_REC
#undef CMB_ROWS
}

__device__ __forceinline__ void ubench(Frame& F) {
    bf16x8 a = (bf16x8){1, 2, 3, 4, 5, 6, 7, 8}, b = (bf16x8){8, 7, 6, 5, 4, 3, 2, 1}; a[0] = (short)F.lane;
    float sink = 0.f;
    if (PROBE_DUP == 900) { f32x16 c0 = {0.f, 0.f, 0.f, 0.f, 0.f, 0.f, 0.f, 0.f, 0.f, 0.f, 0.f, 0.f, 0.f, 0.f, 0.f, 0.f}, c1 = c0;
        for (int i = 0; i < 2000; ++i) { c0 = __builtin_amdgcn_mfma_f32_32x32x16_bf16(a, b, c0, 0, 0, 0); c1 = __builtin_amdgcn_mfma_f32_32x32x16_bf16(a, b, c1, 0, 0, 0); }
        sink = c0[0] + c1[5]; }
    if (PROBE_DUP == 901) { f32x4 c0 = {0.f, 0.f, 0.f, 0.f}, c1 = c0, c2 = c0, c3 = c0;
        for (int i = 0; i < 2000; ++i) { c0 = __builtin_amdgcn_mfma_f32_16x16x32_bf16(a, b, c0, 0, 0, 0); c1 = __builtin_amdgcn_mfma_f32_16x16x32_bf16(a, b, c1, 0, 0, 0); c2 = __builtin_amdgcn_mfma_f32_16x16x32_bf16(a, b, c2, 0, 0, 0); c3 = __builtin_amdgcn_mfma_f32_16x16x32_bf16(a, b, c3, 0, 0, 0); }
        sink = c0[0] + c1[1] + c2[2] + c3[3]; }
    if (PROBE_DUP == 902) { float x0 = F.lane, x1 = 1.f, x2 = 2.f, x3 = 3.f, x4 = 4.f, x5 = 5.f, x6 = 6.f, x7 = 7.f; const float m = 1.0001f, d = 0.5f;
        for (int i = 0; i < 4000; ++i) { x0 = x0 * m + d; x1 = x1 * m + d; x2 = x2 * m + d; x3 = x3 * m + d; x4 = x4 * m + d; x5 = x5 * m + d; x6 = x6 * m + d; x7 = x7 * m + d; }
        sink = x0 + x1 + x2 + x3 + x4 + x5 + x6 + x7; }
    if (PROBE_DUP == 903) {
        f32x4 c[4]; float s = 0.f; float wv[16];
#pragma unroll
        for (int i = 0; i < 4; ++i) c[i] = (f32x4){0.f, 0.f, 0.f, 0.f};
#pragma unroll
        for (int i = 0; i < 16; ++i) wv[i] = 0.001f * (i + F.lane);
        for (int it = 0; it < 275; ++it) { f32x4 d[4];
#pragma unroll
            for (int i = 0; i < 4; ++i) { d[i] = (f32x4){0.f, 0.f, 0.f, 0.f}; d[i] = __builtin_amdgcn_mfma_f32_16x16x32_bf16(a, b, d[i], 0, 0, 0); d[i] = __builtin_amdgcn_mfma_f32_16x16x32_bf16(b, a, d[i], 0, 0, 0); }
            float t = 0.f;
#pragma unroll
            for (int i = 0; i < 4; ++i)
#pragma unroll
                for (int r = 0; r < 4; ++r) { const float x = c[i][r]; const int xi = __builtin_bit_cast(int, x); const float m = __builtin_bit_cast(float, xi > 0 ? xi : 0); t += wv[4 * i + r] * m; }
            float u = t;
#pragma unroll
            for (int k = 0; k < 12; ++k) u = u * 1.0001f + 0.5f;
            s += u; a[1] = (short)(it + (int)s);
#pragma unroll
            for (int i = 0; i < 4; ++i) c[i] = d[i]; }
        sink = s; }
    if (sink == 123.456f) ((float*)(F.ws + WS_SBUF))[F.tid] = sink;
}

constexpr int NPHASE = 10;
struct Args { const float* in[25]; float* out; unsigned char* ws; int ph_lo, ph_hi; };
__global__ void __launch_bounds__(NTHR, 2) fwd_kernel(Args args) {
    extern __shared__ __attribute__((aligned(16))) unsigned char lds[];
    Frame F;
    F.lds = (LAS unsigned char*)lds;
    F.MISC = (volatile LAS unsigned*)(F.lds + MISC_OFF);
    F.tid = threadIdx.x; F.lane = F.tid & 63; F.wave = __builtin_amdgcn_readfirstlane(F.tid >> 6); F.G = gridDim.x;
    F.ws = args.ws; F.ctl = (gu32*)(args.ws + WS_CTL); F.out = args.out;
#pragma unroll
    for (int i = 0; i < 25; ++i) F.in[i] = args.in[i];
    for (int u = F.tid; u < 2048 / 4; u += NTHR) ((LAS unsigned*)(F.lds + MISC_OFF))[u] = 0u;
    __syncthreads();
    XcdBarrier bar; bar.bar = (unsigned*)(F.ctl + CW_BAR); bar.x = 0; bar.st = nullptr;
    if (MK_N_LAUNCHES == 1) bar = xcd_barrier_post((unsigned*)(F.ctl + CW_BAR), F.MISC + 8);
    const int lo = args.ph_lo, hi = args.ph_hi;
#define IN(k) (lo <= (k) && (k) < hi)
#define SEAM(k) do { if (IN(k) && IN((k) + 1)) xcd_barrier(bar); } while (0)
    unsigned char* ws = F.ws; const int c = (int)blockIdx.x;

#define BODY_P0 { p0_prologue(F); if (PROBE_DUP >= 900) ubench(F); }
#define BODY_P1 { { pg8::Gemm g{(const bf16*)(ws + WS_XN), (const bf16*)(ws + WS_WIN), 1024, 1024, 1024, 0}; InProjOrder S{F.G, c, (unsigned*)(F.ctl + CW_UDONE)}; \
        EpiInProj E{ws, F.in[I_BGATE]}; pg8::gemm_phase<EpiInProj, InProjOrder>(F.lds, g, S, E); } \
        if (c >= 128 && c < 192) { wg_wait_ge(F, CW_UDONE, 128u * 8u); pg8::Gemm g{(const bf16*)(ws + WS_UGX), (const bf16*)(ws + WS_WS), UGX_LD, 512, 512, 0}; S5StateOrder S{c - 128}; EpiS5State E{(float*)(ws + WS_SBUF)}; \
          pg8::gemm_phase<EpiS5State, S5StateOrder>(F.lds, g, S, E); } \
        if (c >= 128) moe_convert(F, MOE_N8A, MOE_N8, (c < 192) ? c - 128 : 64 + 2 * (c - 192), (c < 192) ? 1 : 2, 192); }
#define BODY_P2 { carry_phase(F); idx_phase(F); if (PROBE_DUP == 102) { xcd_barrier(bar); idx_phase(F); } }
#define BODY_P3 { if (c >= 128) { { pg8::Gemm g{(const bf16*)(ws + WS_UGX), (const bf16*)(ws + WS_MT), UGX_LD, UGX_LD, 640, 0}; S5YOrder S{c - 128}; EpiS5Y E{(const bf16*)(ws + WS_UGX), F.in[I_SD], (bf16*)(ws + WS_YG)}; \
            pg8::gemm_phase<EpiS5Y, S5YOrder>(F.lds, g, S, E); } \
          wg_signal(F, CW_YDONE); wg_wait_ge(F, CW_YDONE, 128u); \
          { pg8::Gemm g{(const bf16*)(ws + WS_YG), (const bf16*)(ws + WS_WGLU), 512, 512, 512, 0}; StaticOrder S; S.init(NTOK / 256, 2, 128, c - 128); EpiGlu E{(const bf16*)(ws + WS_YG), F.in[I_BGLU], (bf16*)(ws + WS_YSSM)}; \
            pg8::gemm_phase<EpiGlu, StaticOrder>(F.lds, g, S, E); } } \
        attn_phase(F); }
#define BODY_P4 { pg8::Gemm g{(const bf16*)(ws + WS_YSSM), (const bf16*)(ws + WS_WPS), 512, 512, 512, 0}; MixOrder S; S.so.init(NTOK / 256, 4, F.G, c); \
        EpiMix E{(const bf16*)(ws + WS_GS), (const bf16*)(ws + WS_GA), (bf16*)(ws + WS_MIXED)}; pg8::gemm_phase<EpiMix, MixOrder>(F.lds, g, S, E); }
#define BODY_P5 { pg8::Gemm g{(const bf16*)(ws + WS_MIXED), (const bf16*)(ws + WS_WOUT), 1024, 1024, 1024, 0}; StaticOrder S; S.init(NTOK / 256, 4, F.G, c); EpiOut E{F.in[I_X], (bf16*)(ws + WS_X1)}; \
        pg8::gemm_phase<EpiOut, StaticOrder>(F.lds, g, S, E); }
#define BODY_P6 { router_phase(F); }
#define BODY_P7 { LAS int* OFF = (LAS int*)(F.lds + MISC_OFF + 512); LAS int* TE = OFF + 72; const int TT = moe_tables(F, OFF, TE, true); \
        pg8::Gemm g{(const bf16*)(ws + WS_H2), (const bf16*)(ws + WS_WMI), 1024, 2048, 1024, (size_t)1024 * 2048 * 2}; MoeOrder S{TE, OFF, OFF + 33, (const int*)(ws + WS_ROWMAP), TT, 8, c}; EpiMoe1 E{F.in[I_BMI], (bf16*)(ws + WS_ACT)}; \
        pg8::gemm_phase<EpiMoe1, MoeOrder, true, true>(F.lds, g, S, E); }
#define BODY_P8 { LAS int* OFF = (LAS int*)(F.lds + MISC_OFF + 512); LAS int* TE = OFF + 72; const int TT = moe_tables(F, OFF, TE, lo == 8); \
        pg8::Gemm g{(const bf16*)(ws + WS_ACT), (const bf16*)(ws + WS_WMO), 1024, 1024, 1024, (size_t)1024 * 1024 * 2}; MoeOrder S{TE, OFF, OFF + 33, nullptr, TT, 4, c}; EpiMoe2 E{F.in[I_BMO], (bf16*)(ws + WS_Y2)}; \
        pg8::gemm_phase<EpiMoe2, MoeOrder, true, true>(F.lds, g, S, E); }
#define BODY_P9 { combine_phase(F, lo == 9); }
#define PHASE(k, BODY) if (IN(k)) { TPROBE_BEGIN(k); BODY TPROBE_END(k); if (PROBE_DUP == (k)) { xcd_barrier(bar); BODY } } SEAM(k);
    PHASE(0, BODY_P0) PHASE(1, BODY_P1) PHASE(2, BODY_P2) PHASE(3, BODY_P3) PHASE(4, BODY_P4) PHASE(5, BODY_P5) PHASE(6, BODY_P6)
    PHASE(7, BODY_P7) PHASE(8, BODY_P8) PHASE(9, BODY_P9)
#undef IN
#undef SEAM
}

extern "C" void kernel_launch(void* const* d_in, const int* in_sizes, int n_in, void* d_out, int out_size, void* d_ws, size_t ws_size, hipStream_t stream) {
    static int grid = 0;
    if (grid == 0) {
        if (n_in != 25 || out_size != NTOK * DM || ws_size < WS_END) { fprintf(stderr, "kernel_launch: unexpected problem (n_in %d out %d ws %zu)\n", n_in, out_size, ws_size); grid = -1; return; }
        if (hipFuncSetAttribute((const void*)fwd_kernel, hipFuncAttributeMaxDynamicSharedMemorySize, LDS_BYTES) != hipSuccess) { fprintf(stderr, "kernel_launch: hipFuncSetAttribute failed\n"); grid = -1; return; }
        int per_cu = 0; (void)hipOccupancyMaxActiveBlocksPerMultiprocessor(&per_cu, (const void*)fwd_kernel, NTHR, LDS_BYTES); (void)hipGetLastError();
        grid = 256;
    }
    if (grid < 0) return;
    (void)hipMemsetAsync((char*)d_ws + WS_CTL, 0, CTL_ZERO_BYTES, stream);
    Args a{};
    for (int i = 0; i < 25; ++i) a.in[i] = (const float*)d_in[i];
    a.out = (float*)d_out; a.ws = (unsigned char*)d_ws;
    if (MK_N_LAUNCHES == 1) { a.ph_lo = 0; a.ph_hi = NPHASE; hipLaunchKernelGGL(fwd_kernel, dim3(grid), dim3(NTHR), LDS_BYTES, stream, a); }
    else for (int p = 0; p < NPHASE; ++p) { a.ph_lo = p; a.ph_hi = p + 1; hipLaunchKernelGGL(fwd_kernel, dim3(grid), dim3(NTHR), LDS_BYTES, stream, a); }
}
```

```cpp
#include <hip/hip_runtime.h>
#include <cstdio>
#include <cstdint>

#ifndef MK_N_LAUNCHES
#define MK_N_LAUNCHES 1
#endif
#ifndef PROBE_DUP
#define PROBE_DUP -1
#endif
#ifndef PROBE_MULT
#define PROBE_MULT 4
#endif
#ifndef PROBE_T
#define PROBE_T -1
#endif
#define TPROBE_BEGIN(id) unsigned long long tpb_##id = (PROBE_T == (id)) ? __builtin_amdgcn_s_memrealtime() : 0ull
#define TPROBE_END(id) do { if (PROBE_T == (id)) { const unsigned long long d_ = __builtin_amdgcn_s_memrealtime() - tpb_##id, t1_ = __builtin_amdgcn_s_memrealtime(); while (__builtin_amdgcn_s_memrealtime() - t1_ < 4ull * d_) __builtin_amdgcn_s_sleep(8); } } while (0)

namespace pg8 {
#define PG8_LAS __attribute__((address_space(3)))
typedef unsigned short bf16_t;
typedef short bf16x8 __attribute__((ext_vector_type(8)));
typedef float f32x4 __attribute__((ext_vector_type(4)));
typedef float f32x2 __attribute__((ext_vector_type(2)));
typedef unsigned u32x4 __attribute__((ext_vector_type(4)));
typedef unsigned u32x2 __attribute__((ext_vector_type(2)));
constexpr int BM = 256, BK = 64, HALF = 128, HTB = HALF * BK * 2, STAGE_BYTES = 8 * HTB, NXCD = 8, WGM = 8;

__host__ __device__ __forceinline__ int lds_byte(int r, int c) { const int st = (r >> 4) * 2 + (c >> 5), rr = r & 15, cc = c & 31, ob = rr * 64 + cc * 2; return st * 1024 + (ob ^ (((ob >> 9) & 1) << 5)); }
__host__ __device__ __forceinline__ void stage_rc(int b, int& R, int& C) { const int st = b / 1024, sb = b % 1024, swz = sb ^ (((sb >> 9) & 1) << 5); R = (st >> 1) * 16 + swz / 64; C = (st & 1) * 32 + (swz % 64) / 2; }
__host__ __device__ __forceinline__ int perm32(int rho) { const int n = rho >> 4, i = rho & 15; return 8 * (i >> 2) + 4 * n + (i & 3); }

struct Unit { int pm, pn, pa, pb, e; };
struct Gemm { const bf16_t* A; const bf16_t* Bt; int lda, ldb, K; size_t bexp; };

__device__ __forceinline__ unsigned cvt_pk_bf16(float lo, float hi) { unsigned r; asm volatile("v_cvt_pk_bf16_f32 %0, %1, %2" : "=v"(r) : "v"(lo), "v"(hi)); return r; }
__device__ __forceinline__ u32x4 pack8(const f32x4& v0, const f32x4& v1) { u32x4 w; w.x = cvt_pk_bf16(v0[0], v0[1]); w.y = cvt_pk_bf16(v0[2], v0[3]); w.z = cvt_pk_bf16(v1[0], v1[1]); w.w = cvt_pk_bf16(v1[2], v1[3]); return w; }

template <class Epi, class Sched, bool ALIGN_EPI = true, bool BKN = false>
__device__ __forceinline__ void gemm_phase(PG8_LAS unsigned char* lds, const Gemm g, const Sched& S, const Epi& E) {
    const int tid = threadIdx.x, wid = __builtin_amdgcn_readfirstlane(tid >> 6), lane = tid & 63, wr = wid >> 2, wc = wid & 3, fr = lane & 15, fq = lane >> 4;
    const int K = g.K, nt = K / BK;
    unsigned voffB[2];
#pragma unroll
    for (int i = 0; i < 2; ++i) {
        if constexpr (BKN) { const int krow = (tid >> 4) + 32 * i, cp = tid & 15, fk = ((krow & 3) << 1) | (((krow >> 3) & 1) << 3); voffB[i] = (unsigned)(krow * g.ldb) * 2u + (unsigned)((cp ^ fk) << 4); }
        else { int R, C; stage_rc(tid * 16 + i * 8192, R, C); const int Rb = (R & ~31) + perm32(R & 31); voffB[i] = (unsigned)(Rb * g.ldb + C) * 2u; } }
    const size_t kstep = (size_t)(BK * 2);
    const size_t kstepB = BKN ? (size_t)BK * g.ldb * 2 : kstep;
    const size_t hstepB = BKN ? (size_t)256 : (size_t)HALF * g.ldb * 2;
    const size_t tstepB = BKN ? (size_t)512 : 2 * hstepB;
    const unsigned tbase = (unsigned)(unsigned long)lds + (unsigned)((8 * fq + (fr >> 2)) * 256 + (((4 * wc + (fr & 3)) ^ (((fr >> 2) << 1) | ((fq & 1) << 3))) << 4));
#define PG8_AROWS(VV, U) do { _Pragma("unroll") for (int i_ = 0; i_ < 2; ++i_) { int R_, C_; stage_rc((threadIdx.x & 511) * 16 + i_ * 8192, R_, C_); \
        _Pragma("unroll") for (int h_ = 0; h_ < 2; ++h_) VV[h_][i_] = (unsigned)(S.arow(U, h_, R_) * g.lda + C_) * 2u; } } while (0)
    unsigned vA[2][2], vAn[2][2];
    const unsigned ldsw = (unsigned)wid * 1024u;
    const int aoff = lds_byte(wr * 64 + fr, fq * 8), boff = lds_byte(wc * 32 + fr, fq * 8);
#define PG8_SA(b, h) (((b) * 2 + (h)) * HTB)
#define PG8_SB(b, h) ((4 + (b) * 2 + (h)) * HTB)
#define PG8_STAGE(bufoff, gbase, voff) do { _Pragma("unroll") for (int _i = 0; _i < 2; ++_i) \
        __builtin_amdgcn_global_load_lds((const unsigned*)((const char*)(gbase) + (voff)[_i]), (PG8_LAS unsigned*)(lds + (bufoff) + ldsw + _i * 8192), 16, 0, 0); } while (0)
#define PG8_LDA(dst, b, h) do { _Pragma("unroll") for (int m = 0; m < 4; ++m) _Pragma("unroll") for (int k = 0; k < 2; ++k) dst[m][k] = *(const PG8_LAS bf16x8*)(lds + PG8_SA(b, h) + aoff + m * 2048 + k * 1024); } while (0)
#define PG8_LDB(dst, b, h) do { if constexpr (BKN) { const unsigned ab_ = tbase + PG8_SB(b, h); _Pragma("unroll") for (int n = 0; n < 2; ++n) _Pragma("unroll") for (int k = 0; k < 2; ++k) { u32x2 lo_, hi_; \
            asm volatile("ds_read_b64_tr_b16 %0, %2 offset:%3\n\tds_read_b64_tr_b16 %1, %2 offset:%4" : "=&v"(lo_), "=&v"(hi_) : "v"(ab_), "n"(k * 8192 + n * 8), "n"(k * 8192 + n * 8 + 1024) : "memory"); \
            u32x4 w_; w_.x = lo_.x; w_.y = lo_.y; w_.z = hi_.x; w_.w = hi_.y; dst[n][k] = __builtin_bit_cast(bf16x8, w_); } } \
        else { _Pragma("unroll") for (int n = 0; n < 2; ++n) _Pragma("unroll") for (int k = 0; k < 2; ++k) dst[n][k] = *(const PG8_LAS bf16x8*)(lds + PG8_SB(b, h) + boff + n * 2048 + k * 1024); } } while (0)
#define PG8_WAIT_LB() do { if constexpr (BKN) asm volatile("s_waitcnt lgkmcnt(0)" : "+v"(B0[0][0]), "+v"(B0[0][1]), "+v"(B0[1][0]), "+v"(B0[1][1]), "+v"(B1[0][0]), "+v"(B1[0][1]), "+v"(B1[1][0]), "+v"(B1[1][1]) :: "memory"); \
        else asm volatile("s_waitcnt lgkmcnt(0)" ::: "memory"); } while (0)
#define PG8_MMA(ai, bj, At, Bt) do { __builtin_amdgcn_s_setprio(1); _Pragma("unroll") for (int m = 0; m < 4; ++m) _Pragma("unroll") for (int n = 0; n < 2; ++n) _Pragma("unroll") for (int k = 0; k < 2; ++k) \
        acc[ai][bj][m][n] = __builtin_amdgcn_mfma_f32_16x16x32_bf16(Bt[n][k], At[m][k], acc[ai][bj][m][n], 0, 0, 0); __builtin_amdgcn_s_setprio(0); } while (0)
#define PG8_WAIT_V(n) asm volatile("s_waitcnt vmcnt(" #n ")" ::: "memory")
#define PG8_WAIT_L(n) asm volatile("s_waitcnt lgkmcnt(" #n ")" ::: "memory")
#define PG8_BAR __builtin_amdgcn_s_barrier()
#define PG8_SCHED __builtin_amdgcn_sched_barrier(0)
    Unit cur, nxt; int ui = 0;
    if (!S.next(0, cur)) return;
    f32x4 acc[2][2][4][2];
#pragma unroll
    for (int a = 0; a < 2; ++a)
#pragma unroll
        for (int b = 0; b < 2; ++b)
#pragma unroll
            for (int m = 0; m < 4; ++m)
#pragma unroll
                for (int n = 0; n < 2; ++n) acc[a][b][m][n] = (f32x4){0.f, 0.f, 0.f, 0.f};
    bf16x8 At[4][2], B0[2][2], B1[2][2];
    const char* const bA = (const char*)g.A; const char* cB = BKN ? (const char*)g.Bt + (size_t)cur.e * g.bexp + (size_t)cur.pn * tstepB : (const char*)g.Bt + (size_t)cur.pb * tstepB;
    PG8_AROWS(vA, cur);
    PG8_STAGE(PG8_SB(0, 0), cB, voffB); PG8_STAGE(PG8_SB(0, 1), cB + hstepB, voffB); PG8_STAGE(PG8_SA(0, 0), bA, vA[0]); PG8_STAGE(PG8_SA(0, 1), bA, vA[1]);
    if (wr == 1) PG8_BAR;
    PG8_WAIT_V(2); PG8_BAR;
    PG8_STAGE(PG8_SB(1, 0), cB + kstepB, voffB); PG8_STAGE(PG8_SA(1, 0), bA + kstep, vA[0]); PG8_STAGE(PG8_SB(1, 1), cB + hstepB + kstepB, voffB);
    PG8_WAIT_V(6); PG8_BAR;
    for (;;) {
        const bool has_next = S.next(ui + 1, nxt);
        const char* nB = has_next ? (BKN ? (const char*)g.Bt + (size_t)nxt.e * g.bexp + (size_t)nxt.pn * tstepB : (const char*)g.Bt + (size_t)nxt.pb * tstepB) : cB;
        if (has_next) PG8_AROWS(vAn, nxt); else { vAn[0][0] = vA[0][0]; vAn[0][1] = vA[0][1]; vAn[1][0] = vA[1][0]; vAn[1][1] = vA[1][1]; }
        for (int t = 0; t < nt; t += 2) {
            const bool last = (t == nt - 2);
            const char* a1 = bA + (size_t)(t + 1) * kstep;
            const char* a2 = last ? bA : bA + (size_t)(t + 2) * kstep; const char* b2 = last ? nB : cB + (size_t)(t + 2) * kstepB;
            const char* a3 = a2 + kstep; const char* b3 = b2 + kstepB;
            unsigned w0[2], w1[2];
            w0[0] = last ? vAn[0][0] : vA[0][0]; w0[1] = last ? vAn[0][1] : vA[0][1]; w1[0] = last ? vAn[1][0] : vA[1][0]; w1[1] = last ? vAn[1][1] : vA[1][1];
            PG8_LDB(B0, 0, 0); PG8_LDB(B1, 0, 1); PG8_SCHED; PG8_LDA(At, 0, 0); PG8_STAGE(PG8_SA(1, 1), a1, vA[1]);
            PG8_WAIT_V(8); PG8_WAIT_LB(); PG8_BAR; PG8_MMA(0, 0, At, B0); PG8_MMA(0, 1, At, B1); PG8_BAR; PG8_SCHED;
            PG8_LDA(At, 0, 1); PG8_STAGE(PG8_SB(0, 0), b2, voffB); PG8_STAGE(PG8_SB(0, 1), b2 + hstepB, voffB); PG8_STAGE(PG8_SA(0, 0), a2, w0);
            PG8_WAIT_V(8); PG8_WAIT_L(0); PG8_BAR; PG8_MMA(1, 0, At, B0); PG8_MMA(1, 1, At, B1); PG8_BAR; PG8_SCHED;
            PG8_LDB(B0, 1, 0); PG8_LDB(B1, 1, 1); PG8_SCHED; PG8_LDA(At, 1, 0); PG8_STAGE(PG8_SA(0, 1), a2, w1);
            PG8_WAIT_V(8); PG8_WAIT_LB(); PG8_BAR; PG8_MMA(0, 0, At, B0); PG8_MMA(0, 1, At, B1); PG8_BAR; PG8_SCHED;
            PG8_LDA(At, 1, 1); PG8_STAGE(PG8_SB(1, 0), b3, voffB); PG8_STAGE(PG8_SB(1, 1), b3 + hstepB, voffB); PG8_STAGE(PG8_SA(1, 0), a3, w0);
            PG8_WAIT_V(8); PG8_WAIT_L(0); PG8_BAR; PG8_MMA(1, 0, At, B0); PG8_MMA(1, 1, At, B1); PG8_BAR; PG8_SCHED;
        }
        if constexpr (ALIGN_EPI) { if (wr == 0) PG8_BAR; }
        bool keep_ = false;
        { const bool pe_ = (PROBE_T == 200 && !BKN) || (PROBE_T == 201 && BKN) || (PROBE_T == 203 && BKN && g.ldb == 2048) || (PROBE_T == 204 && BKN && g.ldb == 1024) || (PROBE_T >= 210 && PROBE_T < 216 && !BKN && S.probe_id() == PROBE_T) || (PROBE_T == 216 && !BKN && S.probe_id() == 211 && cur.pn < 2) || (PROBE_T == 217 && !BKN && S.probe_id() == 211 && cur.pn >= 2) || (PROBE_T == 218 && !BKN && S.probe_id() == 211 && blockIdx.x >= 192) || (PROBE_T == 219 && !BKN && S.probe_id() == 211 && blockIdx.x < 128 && cur.pn >= 2);
          unsigned long long tpe_ = 0; if (pe_) tpe_ = __builtin_amdgcn_s_memrealtime();
          if constexpr (Sched::MID) { keep_ = S.keep(cur); if (keep_) E.mid(acc, cur, wr, wc, fr, fq); else E(acc, cur, wr, wc, fr, fq); } else E(acc, cur, wr, wc, fr, fq);
          if ((PROBE_T == 220 || (PROBE_T == 221 && wid == 0)) && !BKN && S.probe_id() == 211 && blockIdx.x >= 192) { const unsigned long long t1_ = __builtin_amdgcn_s_memrealtime(); while (__builtin_amdgcn_s_memrealtime() - t1_ < 2000ull) __builtin_amdgcn_s_sleep(8); }
          if (pe_) { const unsigned long long d_ = __builtin_amdgcn_s_memrealtime() - tpe_, t1_ = __builtin_amdgcn_s_memrealtime(); while (__builtin_amdgcn_s_memrealtime() - t1_ < (unsigned long long)PROBE_MULT * d_) __builtin_amdgcn_s_sleep(8); } } S.done(cur);
        if (!has_next) break;
        if (!keep_) {
#pragma unroll
        for (int a = 0; a < 2; ++a)
#pragma unroll
            for (int b = 0; b < 2; ++b)
#pragma unroll
                for (int m = 0; m < 4; ++m)
#pragma unroll
                    for (int n = 0; n < 2; ++n) acc[a][b][m][n] = (f32x4){0.f, 0.f, 0.f, 0.f};
        }
        cur = nxt; cB = nB; ++ui; vA[0][0] = vAn[0][0]; vA[0][1] = vAn[0][1]; vA[1][0] = vAn[1][0]; vA[1][1] = vAn[1][1];
        if constexpr (ALIGN_EPI) { if (wr == 1) PG8_BAR; }
    }
    PG8_WAIT_V(0);
    if constexpr (!ALIGN_EPI) { if (wr == 0) PG8_BAR; }
    PG8_BAR;
#undef PG8_AROWS
#undef PG8_SA
#undef PG8_SB
#undef PG8_STAGE
#undef PG8_LDA
#undef PG8_LDB
#undef PG8_WAIT_LB
#undef PG8_MMA
#undef PG8_WAIT_V
#undef PG8_WAIT_L
#undef PG8_BAR
#undef PG8_SCHED
}
}

constexpr int NB = 4, SEQ = 4096, NTOK = NB * SEQ, DM = 1024;
constexpr int NWAVES = 8, NTHR = 512;
constexpr int D_SSM = 512, NGRP = 32, NSTATE = 64, CH = 32  , NCH = SEQ / CH  , UGX_LD = 640, S5_ROWS = NB * NCH  ;
constexpr int NIN_PAD = 4608;
constexpr int NEXP = 32, TOPK_E = 4, DFF = 1024;
constexpr int NSEL = 256;
constexpr int MAX_MT = 288;
constexpr float RMS_EPS = 1e-5f;

constexpr size_t MiB = 1u << 20;
constexpr size_t WS_CTL = 0, CTL_ZERO_BYTES = 1 * MiB;
constexpr size_t WS_ROPE = 1 * MiB;
constexpr size_t WS_WIN = 2 * MiB;
constexpr size_t WS_WGLU = 11 * MiB;
constexpr size_t WS_WPS = 12 * MiB;
constexpr size_t WS_WPA = 13 * MiB;
constexpr size_t WS_WOUT = 14 * MiB;
constexpr size_t WS_MT = 16 * MiB;
constexpr size_t WS_WS = 36 * MiB;
constexpr size_t WS_A32 = 44 * MiB;
constexpr size_t WS_SBUF = 45 * MiB;
constexpr size_t WS_WI = 53 * MiB;
constexpr size_t WS_KI = 54 * MiB;
constexpr size_t WS_K = 56 * MiB;
constexpr size_t WS_V = 60 * MiB;
constexpr size_t WS_UGX = 64 * MiB;
constexpr size_t WS_Q = 84 * MiB;
constexpr size_t WS_QI = 100 * MiB;
constexpr size_t WS_GS = 132 * MiB;
constexpr size_t WS_GA = 164 * MiB;
constexpr size_t WS_XN = 196 * MiB;
constexpr size_t WS_YG = 228 * MiB;
constexpr size_t WS_YSSM = 244 * MiB;
constexpr size_t WS_YATT = 260 * MiB;
constexpr size_t WS_SEL = 276 * MiB;
constexpr size_t WS_MIXED = 284 * MiB;
constexpr size_t WS_X1 = 316 * MiB;
constexpr size_t WS_H2 = 380 * MiB;
constexpr size_t WS_TOPE = 412 * MiB;
constexpr size_t WS_TOPW = WS_TOPE + 256 * 1024;
constexpr size_t WS_TOPPOS = WS_TOPW + 256 * 1024;
constexpr size_t WS_ROWMAP = 413 * MiB;
constexpr size_t WS_WMI = 416 * MiB;
constexpr size_t WS_WMO = 544 * MiB;
constexpr size_t WS_ACT = 608 * MiB;
constexpr size_t WS_XP = 64 * MiB;
constexpr size_t WS_Y2 = 64 * MiB;
constexpr size_t WS_END = 752 * MiB;
static_assert(WS_XP + (size_t)MAX_MT * 256 * 1024 * 2 <= WS_YG, "XP overlay");
constexpr int CW_TMO = 0, CW_CODE = 1;
constexpr int CW_BAR = 4096;
constexpr int CW_ECNT = 16384;
constexpr int CW_UDONE = 16384 + 64;
constexpr int CW_YDONE = 16384 + 128;

constexpr int LDS_BYTES = 163840;
constexpr int MISC_OFF = 163840 - 2048;

#define GAS __attribute__((address_space(1)))
#define LAS __attribute__((address_space(3)))
typedef unsigned short bf16;
typedef unsigned short u16;
typedef unsigned v4u __attribute__((ext_vector_type(4)));
typedef unsigned v2u __attribute__((ext_vector_type(2)));
typedef float f32x4 __attribute__((ext_vector_type(4)));
typedef float f32x16 __attribute__((ext_vector_type(16)));
typedef short bf16x8 __attribute__((ext_vector_type(8)));
typedef GAS unsigned gu32;
#define RLX_AGENT __ATOMIC_RELAXED, __HIP_MEMORY_SCOPE_AGENT
#define LDS_WAIT() asm volatile("s_waitcnt lgkmcnt(0)" ::: "memory")
#define VM_WAIT() asm volatile("s_waitcnt vmcnt(0)" ::: "memory")
__device__ __forceinline__ unsigned f2bf(float f) { unsigned u = __builtin_bit_cast(unsigned, f); return (u + 0x7fffu + ((u >> 16) & 1u)) >> 16; }
__device__ __forceinline__ unsigned pk2(float lo, float hi) { return f2bf(lo) | (f2bf(hi) << 16); }
__device__ __forceinline__ float bf2f(unsigned b) { return __builtin_bit_cast(float, b << 16); }
__device__ __forceinline__ float bflo(unsigned w) { return __builtin_bit_cast(float, w << 16); }
__device__ __forceinline__ float bfhi(unsigned w) { return __builtin_bit_cast(float, w & 0xffff0000u); }
__device__ __forceinline__ float sigmoidf_(float x) { return __builtin_amdgcn_rcpf(1.0f + __builtin_amdgcn_exp2f(-1.4426950408889634f * x)); }
__device__ __forceinline__ float gelu_tanh(float x) { const float u = 0.7978845608028654f * (x + 0.044715f * x * x * x); const float e = __builtin_amdgcn_exp2f(2.8853900817779268f * u); const float t = 1.0f - 2.0f * __builtin_amdgcn_rcpf(e + 1.0f); return 0.5f * x * (1.0f + t); }

#define XB_TMO      128
#define XB_XCNT(j)  (256  + 64 * (j))
#define XB_XSUB(j)  (1280 + 64 * (j))
#define XB_XGEN(j)  (2304 + 64 * (j))
#define XB_TOP      3328
#define XB_TOPGEN   3392
#define XCD_BAR_WORDS 3456
#define XB_SPIN_CAP (1u << 18)
__device__ __forceinline__ unsigned xb_ld(unsigned* p)              { return __hip_atomic_load(p, __ATOMIC_RELAXED, __HIP_MEMORY_SCOPE_AGENT); }
__device__ __forceinline__ unsigned xb_add(unsigned* p, unsigned v) { return __hip_atomic_fetch_add(p, v, __ATOMIC_RELAXED, __HIP_MEMORY_SCOPE_AGENT); }
__device__ __forceinline__ unsigned xb_xcc_id() { return (unsigned)__builtin_amdgcn_s_getreg((3 << 11) | 20) & 0xFu; }
#define XB_SPIN(cond, bar) do { unsigned _sp = 0; while (cond) { __builtin_amdgcn_s_sleep(1); \
    if ((++_sp & 255u) == 0u) { if (xb_ld(&(bar)[XB_TMO])) break; if (_sp > XB_SPIN_CAP) { atomicAdd(&(bar)[XB_TMO], 1u); break; } } } } while (0)
struct XcdBarrier { unsigned* bar; unsigned x; volatile LAS unsigned* st; };
__device__ __forceinline__ XcdBarrier xcd_barrier_post(unsigned* bar, volatile LAS unsigned* st) {
    XcdBarrier b; b.bar = bar; b.x = xb_xcc_id(); b.st = st;
    if (threadIdx.x == 0) (void)xb_add(&bar[XB_XCNT(b.x)], 1u);
    return b;
}
__device__ __forceinline__ void xcd_barrier_complete(unsigned* bar, unsigned x, unsigned& nloc, unsigned& nx) {
    const unsigned G = gridDim.x * gridDim.y * gridDim.z;
    unsigned sum, cnt, mine, sp = 0u;
    for (;;) {
        sum = 0u; cnt = 0u; mine = 0u;
#pragma unroll
        for (unsigned j = 0; j < 16; ++j) { const unsigned c = xb_ld(&bar[XB_XCNT(j)]); sum += c; cnt += (c > 0u) ? 1u : 0u; mine = (j == x) ? c : mine; }
        if (sum == G) break;
        __builtin_amdgcn_s_sleep(1);
        if ((++sp & 255u) == 0u) { if (xb_ld(&bar[XB_TMO])) break; if (sp > XB_SPIN_CAP) { atomicAdd(&bar[XB_TMO], 1u); break; } }
    }
    nloc = mine > 0u ? mine : 1u; nx = cnt > 0u ? cnt : 1u;
}
__device__ __forceinline__ void xcd_barrier(const XcdBarrier& b) {
    asm volatile("s_waitcnt vmcnt(0)" ::: "memory");
    __syncthreads();
    if (threadIdx.x == 0) {
        unsigned* bar = b.bar;
        __builtin_amdgcn_s_waitcnt(0);
        unsigned nloc = b.st[0], nx = b.st[1];
        if (nloc == 0u) { xcd_barrier_complete(bar, b.x, nloc, nx); b.st[0] = nloc; b.st[1] = nx; }
        const unsigned old = xb_add(&bar[XB_XSUB(b.x)], 1u);
        const unsigned gen = old / nloc;
        if (old + 1u == (gen + 1u) * nloc) {
            __builtin_amdgcn_fence(__ATOMIC_RELEASE, "agent");
            asm volatile("s_waitcnt vmcnt(0)" ::: "memory");
            const unsigned og = xb_add(&bar[XB_TOP], 1u);
            const unsigned tg = og / nx;
            if (og + 1u == (tg + 1u) * nx) xb_add(&bar[XB_TOPGEN], 1u);
            else XB_SPIN(xb_ld(&bar[XB_TOPGEN]) == tg, bar);
            __builtin_amdgcn_fence(__ATOMIC_ACQUIRE, "agent");
            xb_add(&bar[XB_XGEN(b.x)], 1u);
            asm volatile("s_waitcnt vmcnt(0)" ::: "memory");
        } else {
            XB_SPIN(xb_ld(&bar[XB_XGEN(b.x)]) == gen, bar);
            __builtin_amdgcn_fence(__ATOMIC_ACQUIRE, "agent");
            asm volatile("s_waitcnt vmcnt(0)" ::: "memory");
        }
    }
    __syncthreads();
}

struct Frame {
    LAS unsigned char* lds;
    volatile LAS unsigned* MISC;
    gu32* ctl;
    int tid, lane, wave, G;
    unsigned char* ws;
    const float* in[25];
    float* out;
};
enum { I_X = 0, I_N1G, I_WIN, I_BGATE, I_LRE, I_LIM, I_LOGDT, I_BRE, I_BIM, I_CRE, I_CIM, I_SD, I_WGLU, I_BGLU, I_WPS, I_WPA, I_WOUT, I_N2G, I_WR, I_BR, I_WMI, I_BMI, I_WMO, I_BMO, I_NFG };

__device__ __forceinline__ float wave_sum(float v) {
#pragma unroll
    for (int o = 1; o < 64; o <<= 1) v += __shfl_xor(v, o);
    return v;
}

__device__ __forceinline__ int ropeperm(int p) { const int a = p >> 3, bb = p & 7; return bb < 4 ? 4 * a + bb : 32 + 4 * a + (bb - 4); }
__device__ __forceinline__ int win_src(int nd) {
    const int pn = nd >> 8, j = nd & 255;
    if (pn < 2) return nd;
    if (pn < 4) { const int i = nd - 512; return 512 + (i & ~63) + ropeperm(i & 63); }
    if (pn == 4) { if (j < 128) return 1024 + (j & ~63) + ropeperm(j & 63); return 1152 + (j - 128); }
    if (pn < 9) { const int i = nd - 1280; return 1280 + (i & ~63) + ropeperm(i & 63); }
    if (pn == 9) { if (j < 64) return 2304 + ropeperm(j); if (j < 80) return 2368 + (j - 64); return -1; }
    if (pn < 14) return 2384 + (nd - 2560);
    return 3408 + (nd - 3584);
}
struct TItem { const float* src; bf16* dst; int N, K; };
__device__ __forceinline__ void titem_load(const TItem& T, float (&tv)[32], int lane) {
#pragma unroll
    for (int i = 0; i < 32; ++i) { const int kk = 2 * i + (lane >> 5); tv[i] = T.src ? __builtin_nontemporal_load(T.src + (size_t)kk * T.N) : 0.f; }
}
__device__ __forceinline__ void titem_store(const TItem& T, const float (&tv)[32], LAS float* scr, int lane) {
#pragma unroll
    for (int i = 0; i < 32; ++i) { const int kk = 2 * i + (lane >> 5); scr[kk * 33 + (lane & 31)] = tv[i]; }
    LDS_WAIT(); asm volatile("" ::: "memory");
    const int c = lane & 7;
#pragma unroll
    for (int j = 0; j < 4; ++j) { const int n = (lane >> 3) + 8 * j; const LAS float* s = scr + (8 * c) * 33 + n;
        v4u o; o.x = pk2(s[0 * 33], s[1 * 33]); o.y = pk2(s[2 * 33], s[3 * 33]); o.z = pk2(s[4 * 33], s[5 * 33]); o.w = pk2(s[6 * 33], s[7 * 33]);
        *(GAS v4u*)(T.dst + (size_t)n * T.K + 8 * c) = o; }
    LDS_WAIT(); asm volatile("" ::: "memory");
}
__device__ __forceinline__ void rms_row_to_bf16(int lane, const float* xrow, const float* g, bf16* orow) {
    const GAS f32x4* xr = (const GAS f32x4*)xrow + lane; const GAS f32x4* gr = (const GAS f32x4*)g + lane;
    f32x4 v[4]; float s2 = 0.f;
#pragma unroll
    for (int j = 0; j < 4; ++j) { v[j] = xr[64 * j]; s2 += (v[j].x * v[j].x + v[j].y * v[j].y) + (v[j].z * v[j].z + v[j].w * v[j].w); }
    const float rstd = 1.0f / sqrtf(wave_sum(s2) * (1.f / DM) + RMS_EPS);
    GAS unsigned long long* o8 = (GAS unsigned long long*)orow + lane;
#pragma unroll
    for (int j = 0; j < 4; ++j) { const f32x4 gg = gr[64 * j];
        o8[64 * j] = (unsigned long long)pk2(v[j].x * rstd * gg.x, v[j].y * rstd * gg.y) | ((unsigned long long)pk2(v[j].z * rstd * gg.z, v[j].w * rstd * gg.w) << 32); }
}
__device__ __forceinline__ void p0_s5_group(Frame& F, int g) {
    LAS float* AP = (LAS float*)(F.lds);
    LAS float* BB = (LAS float*)(F.lds + 16896);
    LAS float* CC = (LAS float*)(F.lds + 25088);
    LAS float* KJ = (LAS float*)(F.lds + 33280);
    const float* lre = F.in[I_LRE] + g * 64; const float* lim = F.in[I_LIM] + g * 64;
    const double dt = exp((double)F.in[I_LOGDT][g]);
    __syncthreads();
    for (int idx = F.tid; idx < 33 * 64; idx += NTHR) { const int p = idx & 63, j = idx >> 6;
        const double lr = lre[p], li = lim[p]; const double mag = exp(j * lr * dt), ang = j * li * dt;
        AP[idx * 2] = (float)(mag * cos(ang)); AP[idx * 2 + 1] = (float)(mag * sin(ang)); }
    for (int idx = F.tid; idx < 1024; idx += NTHR) { const int p = idx >> 4;
        const double lr = lre[p], li = lim[p]; const double mag = exp(lr * dt), ang = li * dt; const double ar = mag * cos(ang), ai = mag * sin(ang);
        const double nr = ar - 1.0, ni = ai, den = lr * lr + li * li; const double zr = (nr * lr + ni * li) / den, zi = (ni * lr - nr * li) / den;
        const double br = F.in[I_BRE][g * 1024 + idx], bi = F.in[I_BIM][g * 1024 + idx];
        BB[idx * 2] = (float)(zr * br - zi * bi); BB[idx * 2 + 1] = (float)(zr * bi + zi * br); }
    for (int idx = F.tid; idx < 1024; idx += NTHR) { CC[idx * 2] = F.in[I_CRE][g * 1024 + idx]; CC[idx * 2 + 1] = F.in[I_CIM][g * 1024 + idx]; }
    __syncthreads();
    { const int j = F.tid >> 4, hp = F.tid & 15; float s[16];
#pragma unroll
      for (int h = 0; h < 16; ++h) s[h] = 0.f;
      for (int p = 0; p < 64; ++p) { const float cr = CC[(hp * 64 + p) * 2], ci = CC[(hp * 64 + p) * 2 + 1], ar = AP[(j * 64 + p) * 2], ai = AP[(j * 64 + p) * 2 + 1];
          const float er = cr * ar - ci * ai, ei = cr * ai + ci * ar;
#pragma unroll
          for (int h4 = 0; h4 < 8; ++h4) { const f32x4 bb = *(const LAS f32x4*)(BB + (p * 16 + 2 * h4) * 2); s[2 * h4] += er * bb[0] - ei * bb[1]; s[2 * h4 + 1] += er * bb[2] - ei * bb[3]; } }
#pragma unroll
      for (int h = 0; h < 16; ++h) KJ[(j * 16 + hp) * 16 + h] = s[h]; }
    __syncthreads();
    bf16* MT = (bf16*)(F.ws + WS_MT) + (size_t)g * 512 * 640;
    for (int ch = F.tid; ch < 512 * 80; ch += NTHR) { const int n = ch / 80, k0 = (ch % 80) * 8, tp = n >> 4, hp = n & 15; float v[8];
        if (k0 < 512) { const int sp = k0 >> 4, h0 = k0 & 15;
#pragma unroll
            for (int j = 0; j < 8; ++j) v[j] = (sp <= tp) ? KJ[((tp - sp) * 16 + hp) * 16 + h0 + j] : 0.f; }
        else { const bool im = k0 >= 576; const int p0 = k0 - (im ? 576 : 512);
#pragma unroll
            for (int j = 0; j < 8; ++j) { const int p = p0 + j; const float cr = CC[(hp * 64 + p) * 2], ci = CC[(hp * 64 + p) * 2 + 1], ar = AP[((tp + 1) * 64 + p) * 2], ai = AP[((tp + 1) * 64 + p) * 2 + 1];
                v[j] = im ? -(cr * ai + ci * ar) : (cr * ar - ci * ai); } }
        v4u o; o.x = pk2(v[0], v[1]); o.y = pk2(v[2], v[3]); o.z = pk2(v[4], v[5]); o.w = pk2(v[6], v[7]);
        *(GAS v4u*)(MT + (size_t)n * 640 + k0) = o; }
    bf16* WS = (bf16*)(F.ws + WS_WS) + (size_t)g * 256 * 512;
    for (int ch = F.tid; ch < 256 * 64; ch += NTHR) { const int n = ch >> 6, k0 = (ch & 63) * 8, sp = k0 >> 4, h0 = k0 & 15; float v[8];
#pragma unroll
        for (int j = 0; j < 8; ++j) { if (n < 128) { const int p = n & 63; const float ar = AP[((31 - sp) * 64 + p) * 2], ai = AP[((31 - sp) * 64 + p) * 2 + 1], br = BB[(p * 16 + h0 + j) * 2], bi = BB[(p * 16 + h0 + j) * 2 + 1];
                v[j] = (n < 64) ? (ar * br - ai * bi) : (ar * bi + ai * br); } else v[j] = 0.f; }
        v4u o; o.x = pk2(v[0], v[1]); o.y = pk2(v[2], v[3]); o.z = pk2(v[4], v[5]); o.w = pk2(v[6], v[7]);
        *(GAS v4u*)(WS + (size_t)n * 512 + k0) = o; }
    float* A32 = (float*)(F.ws + WS_A32) + g * 128;
    if (F.tid < 128) A32[F.tid] = AP[32 * 128 + F.tid];
    __syncthreads();
}
constexpr size_t MOE_N8_IN = (size_t)NEXP * 1024 * 2048 / 8, MOE_N8 = MOE_N8_IN + (size_t)NEXP * 1024 * 1024 / 8, MOE_N8A = (MOE_N8 / 10) * 9;
__device__ __forceinline__ void moe_convert(Frame& F, size_t lo8, size_t hi8, int vw0, int nvw, int vtotal) {
    const size_t vstride = (size_t)vtotal * NTHR;
    for (int vw = 0; vw < nvw; ++vw)
    for (size_t i0 = lo8 + (size_t)(vw0 + vw) * NTHR + F.tid; i0 < hi8; i0 += 4 * vstride) {
        f32x4 a[4], b[4];
#pragma unroll
        for (int u = 0; u < 4; ++u) { const size_t i = i0 + (size_t)u * vstride; if (i < hi8) { const float* s = (i < MOE_N8_IN) ? F.in[I_WMI] + i * 8 : F.in[I_WMO] + (i - MOE_N8_IN) * 8;
            a[u] = __builtin_nontemporal_load((const f32x4*)s); b[u] = __builtin_nontemporal_load((const f32x4*)s + 1); } }
#pragma unroll
        for (int u = 0; u < 4; ++u) { const size_t i = i0 + (size_t)u * vstride; if (i < hi8) { bf16* d = (i < MOE_N8_IN) ? (bf16*)(F.ws + WS_WMI) + i * 8 : (bf16*)(F.ws + WS_WMO) + (i - MOE_N8_IN) * 8;
            *(GAS v4u*)d = pg8::pack8(a[u], b[u]); } } }
}
__device__ __forceinline__ void p0_prologue(Frame& F) {
    const int NW = F.G - NGRP;
    const bool s5wg = (int)blockIdx.x >= NW;
    TPROBE_BEGIN(120);
    if (s5wg) p0_s5_group(F, (int)blockIdx.x - NW);
    TPROBE_END(120);
    TPROBE_BEGIN(121);
    if (!s5wg) {
    LAS float* scr = (LAS float*)(F.lds + F.wave * 16384);
    const int gw = blockIdx.x * NWAVES + F.wave, NGW = NW * NWAVES;
    { float* cosT = (float*)(F.ws + WS_ROPE); float* sinT = cosT + SEQ * 32;
      for (int i = blockIdx.x * NTHR + F.tid; i < SEQ * 32; i += NW * NTHR) { const int pos = i >> 5, k = i & 31;
          const double inv = pow(10000.0, -(double)k / 32.0); const double ang = (double)pos * (double)(float)inv;
          cosT[i] = (float)cos(ang); sinT[i] = (float)sin(ang); } }
    { const int lane = F.lane; f32x4 gg[4], va[4], vb[4];
#pragma unroll
      for (int j = 0; j < 4; ++j) gg[j] = ((const GAS f32x4*)F.in[I_N1G] + lane)[64 * j];
#define XN_LOAD(V, m_) do { _Pragma("unroll") for (int j = 0; j < 4; ++j) V[j] = ((const GAS f32x4*)(F.in[I_X] + (size_t)(m_) * DM) + lane)[64 * j]; } while (0)
#define XN_DO(V, m_) do { float s2 = 0.f; _Pragma("unroll") for (int j = 0; j < 4; ++j) s2 += (V[j].x * V[j].x + V[j].y * V[j].y) + (V[j].z * V[j].z + V[j].w * V[j].w); \
        const float rstd = 1.0f / sqrtf(wave_sum(s2) * (1.f / DM) + RMS_EPS); GAS unsigned long long* o8 = (GAS unsigned long long*)((bf16*)(F.ws + WS_XN) + (size_t)(m_) * DM) + lane; \
        _Pragma("unroll") for (int j = 0; j < 4; ++j) o8[64 * j] = (unsigned long long)pk2(V[j].x * rstd * gg[j].x, V[j].y * rstd * gg[j].y) | ((unsigned long long)pk2(V[j].z * rstd * gg[j].z, V[j].w * rstd * gg[j].w) << 32); } while (0)
      int m = gw; if (m < NTOK) XN_LOAD(va, m);
      for (; m < NTOK; m += 2 * NGW) { const int m1 = m + NGW, m2 = m1 + NGW;
          asm volatile("" ::: "memory"); if (m1 < NTOK) XN_LOAD(vb, m1); asm volatile("" ::: "memory");
          XN_DO(va, m);
          asm volatile("" ::: "memory"); if (m2 < NTOK) XN_LOAD(va, m2); asm volatile("" ::: "memory");
          if (m1 < NTOK) XN_DO(vb, m1); }
#undef XN_LOAD
#undef XN_DO
    }
    constexpr int I_IN = 16 * (NIN_PAD / 32), I_GLU = 8 * 16, I_PS = 8 * 32, I_PA = 8 * 32, I_OUT = 16 * 32;
    constexpr int NITEMS = I_IN + I_GLU + I_PS + I_PA + I_OUT;
    auto decode = [&](int it) -> TItem {
        int r = it; const float* W; bf16* WT; int K, N, ndb, map = 0;
        if (r < I_IN) { W = F.in[I_WIN]; K = DM; N = 4432; WT = (bf16*)(F.ws + WS_WIN); ndb = NIN_PAD / 32; map = 1; }
        else if ((r -= I_IN) < I_GLU) { W = F.in[I_WGLU]; K = 512; N = 512; WT = (bf16*)(F.ws + WS_WGLU); ndb = 16; }
        else if ((r -= I_GLU) < I_PS) { W = F.in[I_WPS]; K = 512; N = 1024; WT = (bf16*)(F.ws + WS_WPS); ndb = 32; }
        else if ((r -= I_PS) < I_PA) { W = F.in[I_WPA]; K = 512; N = 1024; WT = (bf16*)(F.ws + WS_WPA); ndb = 32; }
        else { r -= I_PA; W = F.in[I_WOUT]; K = 1024; N = 1024; WT = (bf16*)(F.ws + WS_WOUT); ndb = 32; }
        const int kb = r / ndb, nb = r % ndb, k0 = 64 * kb, n0 = 32 * nb; int sc = n0 + (F.lane & 31); if (map) sc = win_src(sc);
        TItem T; T.src = (sc >= 0) ? W + (size_t)k0 * N + sc : nullptr; T.dst = WT + (size_t)n0 * K + k0; T.N = N; T.K = K; return T; };
    { float tvA[32], tvB[32]; int it = gw;
      if (it < NITEMS) { TItem TA = decode(it); titem_load(TA, tvA, F.lane);
        for (;;) {
            const int it1 = it + NGW; const bool h1 = it1 < NITEMS; TItem TB = TA; if (h1) { TB = decode(it1); titem_load(TB, tvB, F.lane); }
            titem_store(TA, tvA, scr, F.lane); if (!h1) break;
            const int it2 = it1 + NGW; const bool h2 = it2 < NITEMS; if (h2) { TA = decode(it2); titem_load(TA, tvA, F.lane); }
            titem_store(TB, tvB, scr, F.lane); if (!h2) break;
            it = it2; } } }
    }
    TPROBE_END(121);
    TPROBE_BEGIN(122);
    moe_convert(F, 0, MOE_N8A, s5wg ? 4 * NW + 2 * ((int)blockIdx.x - NW) : 4 * (int)blockIdx.x, s5wg ? 2 : 4, 4 * NW + 2 * NGRP);
    TPROBE_END(122);
}

struct StaticOrder {
    int nM, nN, nwg, G, c;
    __device__ void init(int nM_, int nN_, int G_, int c_) { nM = nM_; nN = nN_; nwg = nM * nN; G = G_; c = c_; }
    __device__ bool tile(int i, int& pm, int& pn) const {
        const long L = (long)i * G + c; if (L >= nwg) return false;
        int wgid = (int)L; { const int q = nwg / pg8::NXCD, r = nwg % pg8::NXCD, xcd = wgid % pg8::NXCD, off = wgid / pg8::NXCD; wgid = (xcd < r ? xcd * (q + 1) : r * (q + 1) + (xcd - r) * q) + off; }
        const int nig = pg8::WGM * nN, gid = wgid / nig, fm = gid * pg8::WGM, gsz = (nM - fm) < pg8::WGM ? (nM - fm) : pg8::WGM;
        pm = fm + ((wgid % nig) % gsz); pn = (wgid % nig) / gsz; return true;
    }
    __device__ bool next(int i, pg8::Unit& u) const { int pm, pn; if (!tile(i, pm, pn)) return false; u.pm = pm; u.pn = pn; u.pa = pm; u.pb = pn; u.e = 0; return true; }
    __device__ __forceinline__ int arow(const pg8::Unit& u, int h, int R) const { return u.pa * 256 + h * 128 + R; }
    __device__ __forceinline__ void done(const pg8::Unit&) const {}
    __device__ __forceinline__ int probe_id() const { return 210; }
    static constexpr bool MID = false;
};
__device__ __forceinline__ void wg_wait_ge(Frame& F, int word, unsigned target) {
    if (F.tid == 0) { unsigned sp = 0;
        while (__hip_atomic_load((unsigned*)(F.ctl + word), RLX_AGENT) < target) { __builtin_amdgcn_s_sleep(2); if (++sp > (1u << 22)) { __hip_atomic_store((unsigned*)(F.ctl + CW_TMO), 1u, RLX_AGENT); break; } }
        __builtin_amdgcn_fence(__ATOMIC_ACQUIRE, "agent"); asm volatile("s_waitcnt vmcnt(0)" ::: "memory"); }
    __syncthreads();
}
__device__ __forceinline__ void wg_signal(Frame& F, int word) {
    asm volatile("s_waitcnt vmcnt(0)" ::: "memory"); __syncthreads();
    if (F.tid == 0) { __builtin_amdgcn_fence(__ATOMIC_RELEASE, "agent"); asm volatile("s_waitcnt vmcnt(0)" ::: "memory"); (void)__hip_atomic_fetch_add((unsigned*)(F.ctl + word), 1u, RLX_AGENT); }
}
struct InProjOrder {
    int G, c; unsigned* udone;
    __device__ bool next(int i, pg8::Unit& u) const { const int L = i * G + c; if (L >= 64 * (NIN_PAD / 256)) return false; u.pm = L & 63; u.pn = L >> 6; u.pa = u.pm; u.pb = u.pn; u.e = 0; return true; }
    __device__ __forceinline__ int arow(const pg8::Unit& u, int h, int R) const { return u.pa * 256 + h * 128 + R; }
    __device__ __forceinline__ void done(const pg8::Unit& u) const {
        if (u.pn < 2) { asm volatile("s_waitcnt vmcnt(0)" ::: "memory");
            if ((threadIdx.x & 63) == 0) (void)__hip_atomic_fetch_add(udone, 1u, RLX_AGENT); } }
    __device__ __forceinline__ int probe_id() const { return 211; }
    static constexpr bool MID = false;
};
struct S5StateOrder {
    int c;
    __device__ bool next(int i, pg8::Unit& u) const { if (i > 0 || c >= 64) return false; const int g = c >> 1, pm = c & 1; u.pm = pm; u.pn = 0; u.pa = g * 2 + pm; u.pb = g; u.e = g; return true; }
    __device__ __forceinline__ int arow(const pg8::Unit& u, int h, int R) const { return u.pa * 256 + h * 128 + R; }
    __device__ __forceinline__ void done(const pg8::Unit&) const {}
    __device__ __forceinline__ int probe_id() const { return 212; }
    static constexpr bool MID = false;
};
struct S5YOrder {
    int c;
    __device__ bool next(int i, pg8::Unit& u) const { if (i > 0 || c >= 128) return false; const int g = c >> 2, pm = (c >> 1) & 1, pn = c & 1; u.pm = pm; u.pn = pn; u.pa = g * 2 + pm; u.pb = g * 2 + pn; u.e = g; return true; }
    __device__ __forceinline__ int arow(const pg8::Unit& u, int h, int R) const { return u.pa * 256 + h * 128 + R; }
    __device__ __forceinline__ void done(const pg8::Unit&) const {}
    __device__ __forceinline__ int probe_id() const { return 213; }
    static constexpr bool MID = false;
};
struct MixOrder {
    StaticOrder so;
    __device__ bool next(int i, pg8::Unit& u) const { int pm, pn; if (!so.tile(i >> 1, pm, pn)) return false; const int h = i & 1; u.pm = pm; u.pn = pn; u.pa = pm + 64 * h; u.pb = pn + 4 * h; u.e = h; return true; }
    __device__ __forceinline__ int arow(const pg8::Unit& u, int h, int R) const { return u.pa * 256 + h * 128 + R; }
    __device__ __forceinline__ void done(const pg8::Unit&) const {}
    __device__ __forceinline__ int probe_id() const { return 214; }
    static constexpr bool MID = true;
    __device__ __forceinline__ bool keep(const pg8::Unit& u) const { return u.e == 0; }
};
struct MoeOrder {
    const volatile LAS int* te; const volatile LAS int* off; const volatile LAS int* cnt; const int* rowmap; int TT, NTN, c;
    __device__ bool next(int i, pg8::Unit& u) const {
        const int xcd = c & 7, j = c >> 3, mpx = 32 / NTN; const int mt = i * (8 * mpx) + xcd * mpx + j / NTN, pn = j % NTN;
        if (mt >= TT) return false; const int e = te[mt]; u.pm = mt; u.pn = pn; u.pa = mt; u.pb = e * NTN + pn; u.e = e; return true; }
    __device__ __forceinline__ int arow(const pg8::Unit& u, int h, int R) const {
        if (!rowmap) return u.pa * 256 + h * 128 + R;
        const int lr = u.pm * 256 - off[u.e] + h * 128 + R;
        return lr < cnt[u.e] ? rowmap[(size_t)u.e * NTOK + lr] : 0; }
    __device__ __forceinline__ void done(const pg8::Unit&) const {}
    __device__ __forceinline__ int probe_id() const { return 215; }
    static constexpr bool MID = false;
};

using pg8::f32x2; using pg8::u32x2; using pg8::pack8; using pg8::cvt_pk_bf16;
#define EPI_ROWS_BEGIN _Pragma("unroll") for (int ai = 0; ai < 2; ++ai) _Pragma("unroll") for (int m = 0; m < 4; ++m) { asm volatile("" ::: "memory"); const int row = u.pm * 256 + ai * 128 + wr * 64 + m * 16 + fr; (void)row;
#define EPI_COLS_BEGIN _Pragma("unroll") for (int bj = 0; bj < 2; ++bj) { const int ct = bj * 128 + wc * 32 + fq * 8; (void)ct; f32x4 v0 = acc[ai][bj][m][0], v1 = acc[ai][bj][m][1];
#define EPI_END } }
#define EPI_FENCE asm volatile("" ::: "memory")
#define EPI_ALLROWS _Pragma("unroll") for (int ai = 0; ai < 2; ++ai) _Pragma("unroll") for (int m = 0; m < 4; ++m)
#define EPI_ROW(ai, m) (u.pm * 256 + (ai) * 128 + wr * 64 + (m) * 16 + fr)
struct EpiInProj {
    static constexpr bool PERM = true;
    unsigned char* ws; const float* bgate;
    __device__ __forceinline__ void rope(f32x4& v0, f32x4& v1, const f32x4& c, const f32x4& s) const { const f32x4 o1 = v0 * c - v1 * s, o2 = v1 * c + v0 * s; v0 = o1; v1 = o2; }
    __device__ __forceinline__ unsigned pk8(const f32x4& v) const { unsigned w = 0; w = __builtin_amdgcn_cvt_pk_fp8_f32(v[0], v[1], w, false); w = __builtin_amdgcn_cvt_pk_fp8_f32(v[2], v[3], w, true); return w; }
    __device__ __forceinline__ void store_rope8(unsigned off, const f32x4& o1, const f32x4& o2) const { *(GAS unsigned*)(ws + off) = pk8(o1); *(GAS unsigned*)(ws + off + 32u) = pk8(o2); }
    __device__ __forceinline__ void store_rope(unsigned off, const f32x4& o1, const f32x4& o2) const {
        u32x2 a, b; a.x = cvt_pk_bf16(o1[0], o1[1]); a.y = cvt_pk_bf16(o1[2], o1[3]); b.x = cvt_pk_bf16(o2[0], o2[1]); b.y = cvt_pk_bf16(o2[2], o2[3]);
        *(GAS u32x2*)(ws + off) = a; *(GAS u32x2*)(ws + off + 64u) = b;
    }
    __device__ __forceinline__ void operator()(const f32x4 (&acc)[2][2][4][2], const pg8::Unit& u, int wr, int wc, int fr, int fq) const {
        asm volatile("" : "+v"(fr), "+v"(fq));
        const int pn = u.pn;
        f32x4 rc[2][4], rs[2][4];
        if (pn >= 2 && pn <= 9) { const int a = (wc & 1) * 4 + fq;
            EPI_ALLROWS { const unsigned o = (unsigned)WS_ROPE + (unsigned)((EPI_ROW(ai, m) & 4095) * 32 + 4 * a) * 4u; rc[ai][m] = *(const GAS f32x4*)(ws + o); rs[ai][m] = *(const GAS f32x4*)(ws + o + (unsigned)(SEQ * 32 * 4)); }
            EPI_FENCE; }
        if (pn < 2) {
            EPI_ROWS_BEGIN const int bb = row >> 12, cc = (row >> 5) & 127, sp = row & 31;
            EPI_COLS_BEGIN const int col = pn * 256 + ct, g = col >> 4, h0 = col & 15;
                { const unsigned uo_ = (unsigned)WS_UGX + (unsigned)((g * 512 + bb * 128 + cc) * UGX_LD + sp * 16 + h0) * 2u; const pg8::u32x4 ud_ = pack8(v0, v1);
                  asm volatile("global_store_dwordx4 %0, %1, %2 sc0 sc1\n\ts_nop 1" :: "v"(uo_), "v"(ud_), "s"(ws) : "memory"); }
            EPI_END
        } else if (pn < 4) {
            EPI_ROWS_BEGIN
            EPI_COLS_BEGIN const int j = (pn - 2) * 256 + ct, head = j >> 6, a = (j & 63) >> 3;
                rope(v0, v1, rc[ai][m], rs[ai][m]); store_rope8((unsigned)WS_Q + (unsigned)(row * 512 + head * 64 + 4 * a), v0, v1);
            EPI_END
        } else if (pn == 4) {
            EPI_ROWS_BEGIN
            EPI_COLS_BEGIN
                if (bj == 0) { const int head = ct >> 6, a = (ct & 63) >> 3; rope(v0, v1, rc[ai][m], rs[ai][m]); store_rope8((unsigned)WS_K + (unsigned)(row * 128 + head * 64 + 4 * a), v0, v1); }
                else { u32x2 w8; w8.x = pk8(v0); w8.y = pk8(v1); *(GAS u32x2*)(ws + ((unsigned)WS_V + (unsigned)(row * 128 + (ct - 128)))) = w8; }
            EPI_END
        } else if (pn < 9) {
            EPI_ROWS_BEGIN
            EPI_COLS_BEGIN const int j = (pn - 5) * 256 + ct, head = j >> 6, a = (j & 63) >> 3;
                rope(v0, v1, rc[ai][m], rs[ai][m]); store_rope((unsigned)WS_QI + (unsigned)(row * 1024 + head * 64 + 4 * a) * 2u, v0, v1);
            EPI_END
        } else if (pn == 9) {
            EPI_ROWS_BEGIN
            EPI_COLS_BEGIN
                if (bj == 0) { if (ct < 64) { const int a = ct >> 3; rope(v0, v1, rc[ai][m], rs[ai][m]); store_rope((unsigned)WS_KI + (unsigned)(row * 64 + 4 * a) * 2u, v0, v1); }
                    else if (ct < 80) { const unsigned o = (unsigned)WS_WI + (unsigned)(row * 16 + (ct - 64)) * 4u; *(GAS f32x4*)(ws + o) = v0 * 0.03125f; *(GAS f32x4*)(ws + o + 16u) = v1 * 0.03125f; } }
            EPI_END
        } else {
            const int br = pn >= 14; const unsigned gbase = br ? (unsigned)WS_GA : (unsigned)WS_GS; const float* bgp = bgate + br * 1024 + (pn - (br ? 14 : 10)) * 256 + wc * 32 + fq * 8;
            f32x4 bb[2][2];
#pragma unroll
            for (int bj = 0; bj < 2; ++bj) { bb[bj][0] = *(const GAS f32x4*)(bgp + bj * 128); bb[bj][1] = *(const GAS f32x4*)(bgp + bj * 128 + 4); }
            EPI_ROWS_BEGIN
            EPI_COLS_BEGIN const int col = (pn - (br ? 14 : 10)) * 256 + ct;
#pragma unroll
                for (int j = 0; j < 4; ++j) { v0[j] = sigmoidf_(v0[j] + bb[bj][0][j]); v1[j] = sigmoidf_(v1[j] + bb[bj][1][j]); }
                *(GAS v4u*)(ws + (gbase + (unsigned)(row * 1024 + col) * 2u)) = pack8(v0, v1);
            EPI_END
        }
    }
};
struct EpiS5State {
    static constexpr bool PERM = true;
    float* SB;
    __device__ __forceinline__ void operator()(const f32x4 (&acc)[2][2][4][2], const pg8::Unit& u, int wr, int wc, int fr, int fq) const {
        EPI_ROWS_BEGIN
        EPI_COLS_BEGIN
            if (bj == 0) { float* d = SB + ((size_t)u.e * 512 + row) * 128 + ct; *(GAS f32x4*)d = v0; *(GAS f32x4*)(d + 4) = v1; }
        EPI_END
    }
};
struct EpiS5Y {
    static constexpr bool PERM = true;
    const bf16* UGX; const float* Dsk; bf16* YG;
    __device__ __forceinline__ void operator()(const f32x4 (&acc)[2][2][4][2], const pg8::Unit& u, int wr, int wc, int fr, int fq) const {
        const int g = u.e;
        const f32x4 d0 = *(const GAS f32x4*)(Dsk + g * 16 + ((fq * 8) & 15)), d1 = *(const GAS f32x4*)(Dsk + g * 16 + ((fq * 8) & 15) + 4);
        v4u ux[2][4][2];
        EPI_ALLROWS {
#pragma unroll
            for (int bj = 0; bj < 2; ++bj) ux[ai][m][bj] = *(const GAS v4u*)(UGX + ((size_t)g * 512 + EPI_ROW(ai, m)) * UGX_LD + u.pn * 256 + bj * 128 + wc * 32 + fq * 8); }
        EPI_FENCE;
        EPI_ROWS_BEGIN const int bb = row >> 7, cc = row & 127;
        EPI_COLS_BEGIN const int n = u.pn * 256 + ct, tp = n >> 4, h0 = n & 15;
            const v4u uu = ux[ai][m][bj];
            v0[0] += d0[0] * bflo(uu.x); v0[1] += d0[1] * bfhi(uu.x); v0[2] += d0[2] * bflo(uu.y); v0[3] += d0[3] * bfhi(uu.y);
            v1[0] += d1[0] * bflo(uu.z); v1[1] += d1[1] * bfhi(uu.z); v1[2] += d1[2] * bflo(uu.w); v1[3] += d1[3] * bfhi(uu.w);
#pragma unroll
            for (int j = 0; j < 4; ++j) { v0[j] = gelu_tanh(v0[j]); v1[j] = gelu_tanh(v1[j]); }
            const int tok = bb * 4096 + cc * 32 + tp;
            *(GAS v4u*)(YG + (size_t)tok * 512 + g * 16 + h0) = pack8(v0, v1);
        EPI_END
    }
};
struct EpiGlu {
    static constexpr bool PERM = true;
    const bf16* YG; const float* bglu; bf16* YS;
    __device__ __forceinline__ void operator()(const f32x4 (&acc)[2][2][4][2], const pg8::Unit& u, int wr, int wc, int fr, int fq) const {
        f32x4 bb[2][2]; v4u yx[2][4][2];
#pragma unroll
        for (int bj = 0; bj < 2; ++bj) { const float* bp = bglu + u.pn * 256 + bj * 128 + wc * 32 + fq * 8; bb[bj][0] = *(const GAS f32x4*)bp; bb[bj][1] = *(const GAS f32x4*)(bp + 4); }
        EPI_ALLROWS {
#pragma unroll
            for (int bj = 0; bj < 2; ++bj) yx[ai][m][bj] = *(const GAS v4u*)(YG + (size_t)EPI_ROW(ai, m) * 512 + u.pn * 256 + bj * 128 + wc * 32 + fq * 8); }
        EPI_FENCE;
        EPI_ROWS_BEGIN
        EPI_COLS_BEGIN const int col = u.pn * 256 + ct;
            const v4u yy = yx[ai][m][bj];
            const f32x4 b0 = bb[bj][0], b1 = bb[bj][1];
            v0[0] = bflo(yy.x) * sigmoidf_(v0[0] + b0[0]); v0[1] = bfhi(yy.x) * sigmoidf_(v0[1] + b0[1]); v0[2] = bflo(yy.y) * sigmoidf_(v0[2] + b0[2]); v0[3] = bfhi(yy.y) * sigmoidf_(v0[3] + b0[3]);
            v1[0] = bflo(yy.z) * sigmoidf_(v1[0] + b1[0]); v1[1] = bfhi(yy.z) * sigmoidf_(v1[1] + b1[1]); v1[2] = bflo(yy.w) * sigmoidf_(v1[2] + b1[2]); v1[3] = bfhi(yy.w) * sigmoidf_(v1[3] + b1[3]);
            *(GAS v4u*)(YS + (size_t)row * 512 + col) = pack8(v0, v1);
        EPI_END
    }
};
struct EpiMix {
    static constexpr bool PERM = true;
    const bf16* GS; const bf16* GA; bf16* MX;
    __device__ __forceinline__ void mid(f32x4 (&acc)[2][2][4][2], const pg8::Unit& u, int wr, int wc, int fr, int fq) const {
#pragma unroll
        for (int ai = 0; ai < 2; ++ai) { v4u gs[4][2], ga[4][2];
#pragma unroll
            for (int m = 0; m < 4; ++m)
#pragma unroll
                for (int bj = 0; bj < 2; ++bj) { const size_t off = (size_t)EPI_ROW(ai, m) * 1024 + u.pn * 256 + bj * 128 + wc * 32 + fq * 8; gs[m][bj] = *(const GAS v4u*)(GS + off); ga[m][bj] = *(const GAS v4u*)(GA + off); }
            EPI_FENCE;
#pragma unroll
            for (int m = 0; m < 4; ++m)
#pragma unroll
                for (int bj = 0; bj < 2; ++bj) { const v4u s_ = gs[m][bj], a_ = ga[m][bj]; f32x4& v0 = acc[ai][bj][m][0]; f32x4& v1 = acc[ai][bj][m][1];
                    v0[0] *= bflo(s_.x) * __builtin_amdgcn_rcpf(bflo(a_.x)); v0[1] *= bfhi(s_.x) * __builtin_amdgcn_rcpf(bfhi(a_.x)); v0[2] *= bflo(s_.y) * __builtin_amdgcn_rcpf(bflo(a_.y)); v0[3] *= bfhi(s_.y) * __builtin_amdgcn_rcpf(bfhi(a_.y));
                    v1[0] *= bflo(s_.z) * __builtin_amdgcn_rcpf(bflo(a_.z)); v1[1] *= bfhi(s_.z) * __builtin_amdgcn_rcpf(bfhi(a_.z)); v1[2] *= bflo(s_.w) * __builtin_amdgcn_rcpf(bflo(a_.w)); v1[3] *= bfhi(s_.w) * __builtin_amdgcn_rcpf(bfhi(a_.w)); }
            EPI_FENCE; }
    }
    __device__ __forceinline__ void operator()(const f32x4 (&acc)[2][2][4][2], const pg8::Unit& u, int wr, int wc, int fr, int fq) const {
        v4u ga[2][4][2];
        EPI_ALLROWS {
#pragma unroll
            for (int bj = 0; bj < 2; ++bj) ga[ai][m][bj] = *(const GAS v4u*)(GA + (size_t)EPI_ROW(ai, m) * 1024 + u.pn * 256 + bj * 128 + wc * 32 + fq * 8); }
        EPI_FENCE;
        EPI_ROWS_BEGIN
        EPI_COLS_BEGIN const size_t off = (size_t)row * 1024 + u.pn * 256 + ct; const v4u gg = ga[ai][m][bj];
            v0[0] *= bflo(gg.x); v0[1] *= bfhi(gg.x); v0[2] *= bflo(gg.y); v0[3] *= bfhi(gg.y); v1[0] *= bflo(gg.z); v1[1] *= bfhi(gg.z); v1[2] *= bflo(gg.w); v1[3] *= bfhi(gg.w);
            *(GAS v4u*)(MX + off) = pack8(v0, v1);
        EPI_END
    }
};
struct EpiOut {
    static constexpr bool PERM = true;
    const float* X; bf16* X1;
    __device__ __forceinline__ void operator()(const f32x4 (&acc)[2][2][4][2], const pg8::Unit& u, int wr, int wc, int fr, int fq) const {
        f32x4 xr[4][2][2];
#pragma unroll
        for (int m = 0; m < 4; ++m)
#pragma unroll
            for (int bj = 0; bj < 2; ++bj) { const float* xp = X + (size_t)EPI_ROW(0, m) * 1024 + u.pn * 256 + bj * 128 + wc * 32 + fq * 8; xr[m][bj][0] = *(const GAS f32x4*)xp; xr[m][bj][1] = *(const GAS f32x4*)(xp + 4); }
        EPI_FENCE;
        EPI_ROWS_BEGIN
        EPI_COLS_BEGIN const size_t off = (size_t)row * 1024 + u.pn * 256 + ct;
            *(GAS v4u*)(X1 + off) = pack8(v0 + xr[m][bj][0], v1 + xr[m][bj][1]);
            if (ai == 0) { const float* xp = X + off + (size_t)128 * 1024; xr[m][bj][0] = *(const GAS f32x4*)xp; xr[m][bj][1] = *(const GAS f32x4*)(xp + 4); }
        EPI_END
    }
};
struct EpiMoe1 {
    static constexpr bool PERM = true;
    const float* bmi; bf16* ACT;
    __device__ __forceinline__ void operator()(const f32x4 (&acc)[2][2][4][2], const pg8::Unit& u, int wr, int wc, int fr, int fq) const {
        const float* bp = bmi + (size_t)u.e * 2048 + u.pn * 256 + wc * 32 + fq * 8;
        f32x4 bb[2][2];
#pragma unroll
        for (int bj = 0; bj < 2; ++bj) { bb[bj][0] = *(const GAS f32x4*)(bp + bj * 128); bb[bj][1] = *(const GAS f32x4*)(bp + bj * 128 + 4); }
        EPI_ROWS_BEGIN
        EPI_COLS_BEGIN const int col = u.pn * 256 + ct;
            v0 += bb[bj][0]; v1 += bb[bj][1]; float o[4];
#pragma unroll
            for (int j = 0; j < 4; ++j) { const float zg0 = (j < 2) ? v0[2 * j] : v1[2 * j - 4], zl0 = (j < 2) ? v0[2 * j + 1] : v1[2 * j - 3];
                const float zg = fminf(zg0, 7.0f), zl = fminf(fmaxf(zl0, -7.0f), 7.0f); o[j] = zg * __builtin_amdgcn_rcpf(1.0f + __builtin_amdgcn_exp2f(-2.4554669595930157f * zg)) * (zl + 1.0f); }
            u32x2 w; w.x = cvt_pk_bf16(o[0], o[1]); w.y = cvt_pk_bf16(o[2], o[3]);
            *(GAS u32x2*)(ACT + (size_t)row * 1024 + (col >> 1)) = w;
        EPI_END
    }
};
struct EpiMoe2 {
    static constexpr bool PERM = true;
    const float* bmo; bf16* Y2;
    __device__ __forceinline__ void operator()(const f32x4 (&acc)[2][2][4][2], const pg8::Unit& u, int wr, int wc, int fr, int fq) const {
        const float* bp = bmo + (size_t)u.e * 1024 + u.pn * 256 + wc * 32 + fq * 8;
        f32x4 bb[2][2];
#pragma unroll
        for (int bj = 0; bj < 2; ++bj) { bb[bj][0] = *(const GAS f32x4*)(bp + bj * 128); bb[bj][1] = *(const GAS f32x4*)(bp + bj * 128 + 4); }
        EPI_ROWS_BEGIN
        EPI_COLS_BEGIN const int col = u.pn * 256 + ct;
            v0 += bb[bj][0]; v1 += bb[bj][1];
            *(GAS v4u*)(Y2 + (size_t)row * 1024 + col) = pack8(v0, v1);
        EPI_END
    }
};

__device__ __forceinline__ unsigned f16key(unsigned bits) { return (bits & 0x8000u) ? (bits ^ 0xffffu) : (bits | 0x8000u); }
__device__ __forceinline__ void idx_phase(Frame& F) {
    LAS unsigned char* lds = F.lds;
    LAS u16* SC = (LAS u16*)lds;
    LAS unsigned char* KT = lds + 65536;
    LAS unsigned* HP = (LAS unsigned*)(lds + 147456);
    LAS unsigned char* OLB = lds + 147456 + 4096;
    const bf16* QI = (const bf16*)(F.ws + WS_QI); const bf16* KI = (const bf16*)(F.ws + WS_KI); const float* WI = (const float*)(F.ws + WS_WI);
    u16* SEL = (u16*)(F.ws + WS_SEL);
    const int tid = F.tid, lane = F.lane, wave = F.wave, qg = wave & 1, kq = wave >> 1, kgrp = lane >> 4, l15 = lane & 15;
    const int kx = l15 >> 1, cpos = lane & 7;
    const int dsw = ((wave & 1) * 4 + (lane >> 4)) & 7;
    bf16x8 qa[4][2]; float w[16];
#define IDX_UNIT(r_, b_, t0_) const int b_ = (r_) >> 1, t0_ = (((r_) & 1) ? 511 - (int)blockIdx.x : (int)blockIdx.x) * 8
#define IDX_DMA(kb_, st, bufi) do { _Pragma("unroll") for (int j_ = 0; j_ < 2; ++j_) { const int row_ = (j_ * 8 + wave) * 8 + (lane >> 3); \
        __builtin_amdgcn_global_load_lds((const unsigned*)((kb_) + ((size_t)(st) * 128 + row_) * 64 + ((cpos ^ dsw) << 3)), (LAS unsigned*)(KT + (bufi) * 16384 + (j_ * 8 + wave) * 1024), 16, 0, 0); } } while (0)
#define IDX_PREFETCH(r_) do { IDX_UNIT(r_, pb_, pt0_); if (pt0_ >= 256) { \
        const bf16* qp_ = QI + ((size_t)pb_ * SEQ + pt0_ + 4 * qg + (l15 >> 2)) * 1024 + (l15 & 3) * 64 + kgrp * 8; \
        _Pragma("unroll") for (int i = 0; i < 4; ++i) _Pragma("unroll") for (int ks = 0; ks < 2; ++ks) qa[i][ks] = *(const GAS bf16x8*)(qp_ + i * 256 + ks * 32); \
        const float* wp_ = WI + ((size_t)pb_ * SEQ + pt0_ + 4 * qg + kgrp) * 16; \
        _Pragma("unroll") for (int i = 0; i < 4; ++i) { const f32x4 x = *(const GAS f32x4*)(wp_ + 4 * i); w[4 * i] = x[0]; w[4 * i + 1] = x[1]; w[4 * i + 2] = x[2]; w[4 * i + 3] = x[3]; } \
        const bf16* pk_ = KI + (size_t)pb_ * SEQ * 64; const int pn_ = (pt0_ + 7) / 128 + 1; \
        IDX_DMA(pk_, 0, 0); if (1 < pn_) IDX_DMA(pk_, 1, 1); if (2 < pn_) IDX_DMA(pk_, 2, 2); if (3 < pn_) IDX_DMA(pk_, 3, 3); } } while (0)
    IDX_PREFETCH(0);
    for (int r = 0; r < 8; ++r) {
        IDX_UNIT(r, b, t0);
        __syncthreads();
        const int t = t0 + wave; const size_t tok = (size_t)b * SEQ + t;
        if (t0 < 256) {
            v2u x; const int k0 = lane * 4;
            x.x = (unsigned)(k0 <= t ? k0 : 0) | ((unsigned)(k0 + 1 <= t ? k0 + 1 : 0) << 16); x.y = (unsigned)(k0 + 2 <= t ? k0 + 2 : 0) | ((unsigned)(k0 + 3 <= t ? k0 + 3 : 0) << 16);
            *(GAS v2u*)(SEL + tok * NSEL + k0) = x;
            if (r + 1 < 8) IDX_PREFETCH(r + 1);
            continue;
        }
        HP[tid * 2] = 0u; HP[tid * 2 + 1] = 0u;
        const int nst = (t0 + 7) / 128 + 1;
        const int tq = t0 + 4 * qg + kgrp, qrow = 4 * qg + kgrp;
        const bf16* kbat = KI + (size_t)b * SEQ * 64;
        const unsigned hpq = (unsigned)(unsigned long)(HP + qrow * 128);
#define IDX_EPI1(kgl_, AC) do { float s0 = 0.f; \
            _Pragma("unroll") for (int i = 0; i < 4; ++i) _Pragma("unroll") for (int r_ = 0; r_ < 4; ++r_) { const float a0_ = AC[i][r_]; const int i0 = __builtin_bit_cast(int, a0_); const float m0 = __builtin_bit_cast(float, i0 > 0 ? i0 : 0); s0 += w[4 * i + r_] * m0; } \
            const _Float16 h0_ = (_Float16)s0; const unsigned key0_ = f16key(__builtin_bit_cast(unsigned short, h0_)); const int kg0 = (kgl_); \
            SC[qrow * 4096 + kg0] = (u16)key0_; \
            if (kg0 <= tq) { const unsigned bin = key0_ >> 8; const unsigned ha_ = hpq + ((bin >> 1) << 2), hv_ = (bin & 1u) ? 0x10000u : 1u; \
                asm volatile("ds_add_u32 %0, %1" :: "v"(ha_), "v"(hv_) : "memory"); } } while (0)
#define IDX_READ(BQ, kt2) do { _Pragma("unroll") for (int ks = 0; ks < 2; ++ks) BQ[ks] = *(const LAS bf16x8*)(kb + (kq * 32 + (kt2) * 16 + l15) * 128 + (((ks * 4 + kgrp) ^ kx) << 4)); } while (0)
#define IDX_MMA(AC, BQ) do { _Pragma("unroll") for (int i = 0; i < 4; ++i) { AC[i] = (f32x4){0.f, 0.f, 0.f, 0.f}; _Pragma("unroll") for (int ks = 0; ks < 2; ++ks) AC[i] = __builtin_amdgcn_mfma_f32_16x16x32_bf16(qa[i][ks], BQ[ks], AC[i], 0, 0, 0); } } while (0)
        bf16x8 bq0[2], bq1[2];
        f32x4 aA[4], aB[4];
#pragma unroll
        for (int i = 0; i < 4; ++i) { aA[i] = (f32x4){0.f, 0.f, 0.f, 0.f}; aB[i] = aA[i]; }
        int bcur = 0, bnew = 4;
        TPROBE_BEGIN(100);
        for (int st = 0; st < nst; ++st) {
            if (st + 3 < nst) asm volatile("s_waitcnt vmcnt(6)" ::: "memory"); else asm volatile("s_waitcnt vmcnt(0)" ::: "memory");
            __syncthreads();
            if (st + 4 < nst) IDX_DMA(kbat, st + 4, bnew);
            const LAS unsigned char* kb = KT + bcur * 16384;
            const int kbase_ = st * 128 + kq * 32 + l15;
            IDX_READ(bq0, 0);
            IDX_READ(bq1, 1); IDX_MMA(aA, bq0); if (st >= 1) IDX_EPI1(kbase_ - 128 + 16, aB);
            IDX_MMA(aB, bq1); IDX_EPI1(kbase_, aA);
            bcur = (bcur == 4) ? 0 : bcur + 1; bnew = (bnew == 4) ? 0 : bnew + 1;
        }
        IDX_EPI1((nst - 1) * 128 + kq * 32 + l15 + 16, aB);
#undef IDX_EPI1
#undef IDX_MMA
#undef IDX_READ
        __syncthreads();
        TPROBE_END(100);
        TPROBE_BEGIN(101);
        TPROBE_BEGIN(110);
        if (r + 1 < 8) IDX_PREFETCH(r + 1);
        const int n = t + 1, jj = lane, ql = wave;
        const LAS u16* sc = SC + ql * 4096;
        LAS unsigned* hp = HP + ql * 128;
        unsigned b1, need1;
        { const v2u wv = *(const LAS v2u*)(hp + 126 - 2 * jj); unsigned hb[4];
          hb[3] = wv.x & 0xffffu; hb[2] = wv.x >> 16; hb[1] = wv.y & 0xffffu; hb[0] = wv.y >> 16;
          const unsigned s4 = hb[0] + hb[1] + hb[2] + hb[3];
          unsigned pre = s4;
#pragma unroll
          for (int o = 1; o < 64; o <<= 1) { const unsigned x = __shfl_up(pre, o, 64); if (jj >= o) pre += x; }
          const unsigned long long bal = __ballot(pre >= 256u); const int js = __builtin_ctzll(bal);
          unsigned above = pre - s4, bb1 = 0, nd1 = 0; bool found = false;
#pragma unroll
          for (int i = 0; i < 4; ++i) { if (!found) { if (above + hb[i] >= 256u) { bb1 = 255 - (jj * 4 + i); nd1 = 256u - above; found = true; } else above += hb[i]; } }
          b1 = __shfl(bb1, js); need1 = __shfl(nd1, js); }
        TPROBE_END(110);
        TPROBE_BEGIN(111);
        LDS_WAIT(); __builtin_amdgcn_wave_barrier();
#define LDS_ST32(addr_, val_) asm volatile("ds_write_b32 %0, %1" :: "v"((unsigned)(addr_)), "v"((unsigned)(val_)) : "memory")
#define LDS_ST16(addr_, val_) asm volatile("ds_write_b16 %0, %1" :: "v"((unsigned)(addr_)), "v"((unsigned)(val_)) : "memory")
#define LDS_ADD32(addr_, val_) asm volatile("ds_add_u32 %0, %1" :: "v"((unsigned)(addr_)), "v"((unsigned)(val_)) : "memory")
        const unsigned hpw = (unsigned)(unsigned long)hp, scw = (unsigned)(unsigned long)sc;
        LDS_ST32(hpw + jj * 8, 0u); LDS_ST32(hpw + jj * 8 + 4, 0u);
        const int nit = (n + 511) >> 9;
        { const int base = (nit - 1) * 512 + jj * 8;
#pragma unroll
          for (int e = 0; e < 8; ++e) if (base + e >= n) LDS_ST16(scw + (base + e) * 2, 0u); }
        LDS_WAIT(); __builtin_amdgcn_wave_barrier();
        const unsigned B1 = b1 | (b1 << 16);
#pragma unroll 4
        for (int it = 0; it < nit; ++it) { const int base = it * 512 + jj * 8; const v4u x = *(const LAS v4u*)(sc + base);
#pragma unroll
            for (int i = 0; i < 4; ++i) { const unsigned d = (i == 0) ? x.x : (i == 1) ? x.y : (i == 2) ? x.z : x.w; const unsigned m = ((d >> 8) & 0x00ff00ffu) ^ B1;
                const unsigned l0 = d & 255u, l1 = (d >> 16) & 255u;
                LDS_ADD32(hpw + ((l0 >> 1) << 2), ((m & 0xffffu) == 0u) ? ((l0 & 1u) ? 0x10000u : 1u) : 0u);
                LDS_ADD32(hpw + ((l1 >> 1) << 2), ((m >> 16) == 0u) ? ((l1 & 1u) ? 0x10000u : 1u) : 0u); } }
        LDS_WAIT(); __builtin_amdgcn_wave_barrier();
        TPROBE_END(111);
        TPROBE_BEGIN(112);
        unsigned T, need2;
        { const v2u wv = *(const LAS v2u*)(hp + 126 - 2 * jj); unsigned hb[4];
          hb[3] = wv.x & 0xffffu; hb[2] = wv.x >> 16; hb[1] = wv.y & 0xffffu; hb[0] = wv.y >> 16;
          const unsigned s4 = hb[0] + hb[1] + hb[2] + hb[3];
          unsigned pre = s4;
#pragma unroll
          for (int o = 1; o < 64; o <<= 1) { const unsigned x = __shfl_up(pre, o, 64); if (jj >= o) pre += x; }
          const unsigned long long bal = __ballot(pre >= need1); const int js = __builtin_ctzll(bal);
          unsigned above = pre - s4, bb2 = 0, nd2 = 0; bool found = false;
#pragma unroll
          for (int i = 0; i < 4; ++i) { if (!found) { if (above + hb[i] >= need1) { bb2 = 255 - (jj * 4 + i); nd2 = need1 - above; found = true; } else above += hb[i]; } }
          const unsigned b2 = __shfl(bb2, js); need2 = __shfl(nd2, js); T = (b1 << 8) | b2; }
        TPROBE_END(112);
        TPROBE_BEGIN(113);
        const unsigned olw = (unsigned)(unsigned long)(OLB + ql * 512);
        const unsigned G = 256u - need2, Tp = T | (T << 16); unsigned cg = 0, tc = 0;
#pragma unroll 2
        for (int it = 0; it < nit; ++it) { const int base = it * 512 + jj * 8; const v4u x = *(const LAS v4u*)(sc + base);
            unsigned g[8], c = 0, anyeq = 0;
#pragma unroll
            for (int i = 0; i < 4; ++i) { const unsigned d = (i == 0) ? x.x : (i == 1) ? x.y : (i == 2) ? x.z : x.w;
                g[2 * i] = ((d & 0xffffu) > T) ? 1u : 0u; g[2 * i + 1] = ((d >> 16) > T) ? 1u : 0u; c += g[2 * i] + g[2 * i + 1];
                const unsigned q = d ^ Tp; anyeq |= (((q & 0xffffu) == 0u) || ((q >> 16) == 0u)) ? 1u : 0u; }
            const unsigned long long m0 = __ballot(c & 1u), m1 = __ballot(c & 2u), m2 = __ballot(c & 4u), m3 = __ballot(c & 8u);
            unsigned pos = cg + __builtin_amdgcn_mbcnt_hi((unsigned)(m0 >> 32), __builtin_amdgcn_mbcnt_lo((unsigned)m0, 0u)) + 2u * __builtin_amdgcn_mbcnt_hi((unsigned)(m1 >> 32), __builtin_amdgcn_mbcnt_lo((unsigned)m1, 0u))
                         + 4u * __builtin_amdgcn_mbcnt_hi((unsigned)(m2 >> 32), __builtin_amdgcn_mbcnt_lo((unsigned)m2, 0u)) + 8u * __builtin_amdgcn_mbcnt_hi((unsigned)(m3 >> 32), __builtin_amdgcn_mbcnt_lo((unsigned)m3, 0u));
            cg += (unsigned)__builtin_popcountll(m0) + 2u * (unsigned)__builtin_popcountll(m1) + 4u * (unsigned)__builtin_popcountll(m2) + 8u * (unsigned)__builtin_popcountll(m3);
#pragma unroll
            for (int e = 0; e < 8; ++e) { const unsigned a_ = olw + ((pos < 256u ? pos : 255u) << 1); if (g[e]) LDS_ST16(a_, base + e); pos += g[e]; }
            if (__ballot(anyeq) != 0ull) {
#pragma unroll
                for (int e = 0; e < 8; ++e) { const unsigned wd = (e < 2) ? x.x : (e < 4) ? x.y : (e < 6) ? x.z : x.w; const unsigned k = (e & 1) ? (wd >> 16) : (wd & 0xffffu);
                    const bool eq = k == T; const unsigned long long me = __ballot(eq);
                    const unsigned pe = tc + __builtin_amdgcn_mbcnt_hi((unsigned)(me >> 32), __builtin_amdgcn_mbcnt_lo((unsigned)me, 0u));
                    if (eq && pe < need2) LDS_ST16(olw + ((G + pe) << 1), base + e);
                    tc += (unsigned)__builtin_popcountll(me); } } }
#undef LDS_ST32
#undef LDS_ST16
#undef LDS_ADD32
        LDS_WAIT(); __builtin_amdgcn_wave_barrier();
        { const v2u x = *(const LAS v2u*)((LAS u16*)(OLB + ql * 512) + jj * 4); *(GAS v2u*)(SEL + tok * NSEL + jj * 4) = x; }
        TPROBE_END(113);
        TPROBE_END(101);
    }
#undef IDX_DMA
#undef IDX_PREFETCH
#undef IDX_UNIT
}

__device__ __forceinline__ void carry_phase(Frame& F) {
    const int gid = blockIdx.x * NTHR + F.tid; if (gid >= NGRP * NB * 64) return;
    const int p = gid & 63, b = (gid >> 6) & 3, g = gid >> 8;
    const float* A32 = (const float*)(F.ws + WS_A32) + g * 128; const float ar = A32[p * 2], ai = A32[p * 2 + 1];
    const float* SB = (const float*)(F.ws + WS_SBUF) + ((size_t)g * 512 + b * 128) * 128; bf16* UX = (bf16*)(F.ws + WS_UGX) + ((size_t)g * 512 + b * 128) * UGX_LD;
    float xr = 0.f, xi = 0.f;
    for (int c = 0; c < NCH; ++c) {
        UX[(size_t)c * UGX_LD + 512 + p] = (bf16)f2bf(xr); UX[(size_t)c * UGX_LD + 576 + p] = (bf16)f2bf(xi);
        const float sr = SB[c * 128 + p], si = SB[c * 128 + 64 + p];
        const float nr = ar * xr - ai * xi + sr, ni = ar * xi + ai * xr + si; xr = nr; xi = ni;
    }
}

template <int N> __device__ __forceinline__ void wait_vm() { asm volatile("s_waitcnt vmcnt(%0)" :: "n"(N) : "memory"); }
__device__ __forceinline__ unsigned pk_fp8x4(float a, float b, float c, float d) { unsigned w = 0; w = __builtin_amdgcn_cvt_pk_fp8_f32(a, b, w, false); w = __builtin_amdgcn_cvt_pk_fp8_f32(c, d, w, true); return w; }
__device__ __forceinline__ void attn_phase(Frame& F) {
    constexpr int WSTR = 20224;
    LAS unsigned char* RING = F.lds + F.wave * WSTR;
    LAS u16* SL = (LAS u16*)(RING + 16384);
    const unsigned char* Q8 = F.ws + WS_Q; const unsigned char* K8 = F.ws + WS_K; const unsigned char* V8 = F.ws + WS_V;
    const u16* SEL = (const u16*)(F.ws + WS_SEL); bf16* YA = (bf16*)(F.ws + WS_YATT);
    const int lane = F.lane, gw = blockIdx.x * NWAVES + F.wave;
    const int hd = lane & 15, kg = lane >> 4;
    const int l4 = lane >> 2, cpos = lane & 3;
    int kra[2];
#pragma unroll
    for (int ks = 0; ks < 2; ++ks) kra[ks] = hd * 64 + (((ks * 2 + (kg >> 1)) ^ ((hd >> 2) & 3)) << 4) + (kg & 1) * 8;
    unsigned tra[4];
    { const int r = hd >> 1, c = hd & 1, row = (r >> 2) * 16 + kg * 4 + (r & 3), f = (kg & 1) | ((r >> 2) << 1); const unsigned rb = (unsigned)(unsigned long)RING;
#pragma unroll
      for (int mt = 0; mt < 4; ++mt) tra[mt] = rb + row * 64 + ((mt ^ f) << 4) + c * 8; }
    const bool early = (int)blockIdx.x < 128; const int ew = blockIdx.x * NWAVES + F.wave, nitems = early ? 23 : 9;
    for (int k_ = 0; k_ < nitems; ++k_) { const int it = (k_ < 9) ? gw + 2048 * k_ : 18432 + ew + 1024 * (k_ - 9);
        const int tok = it >> 1, kvh = it & 1, t = tok & 4095; const size_t bbase = (size_t)(tok >> 12) * SEQ;
        const int nsel = (t + 1 < NSEL) ? t + 1 : NSEL;
        { const v2u x = *(const GAS v2u*)(SEL + (size_t)tok * NSEL + lane * 4); *(LAS v2u*)(SL + lane * 4) = x; }
        long qf[2];
#pragma unroll
        for (int ks = 0; ks < 2; ++ks) { if (hd < 4) qf[ks] = *(const GAS long*)(Q8 + (size_t)tok * 512 + (kvh * 4 + hd) * 64 + ks * 32 + kg * 8); else qf[ks] = 0; }
        asm volatile("s_waitcnt vmcnt(0)" : "+v"(qf[0]), "+v"(qf[1]) :: "memory");
        LDS_WAIT(); __builtin_amdgcn_wave_barrier();
        const unsigned char* kbp = K8 + bbase * 128 + kvh * 64; const unsigned char* vbp = V8 + bbase * 128 + kvh * 64;
        f32x4 sc[4][4]; f32x4 oacc[4];
#pragma unroll
        for (int c = 0; c < 4; ++c)
#pragma unroll
            for (int tl = 0; tl < 4; ++tl) sc[c][tl] = (f32x4){0.f, 0.f, 0.f, 0.f};
#pragma unroll
        for (int m = 0; m < 4; ++m) oacc[m] = (f32x4){0.f, 0.f, 0.f, 0.f};
        float inv = 1.0f;
#define ATT_ISSUE(s) do { const int c_ = (s) & 3; const bool isk_ = (s) < 4; const unsigned char* gb_ = isk_ ? kbp : vbp; int sel_[4]; \
            _Pragma("unroll") for (int j_ = 0; j_ < 4; ++j_) { const int ki_ = c_ * 64 + j_ * 16 + l4; sel_[j_] = (int)SL[ki_ < nsel ? ki_ : 0]; } \
            _Pragma("unroll") for (int j_ = 0; j_ < 4; ++j_) { const int f_ = isk_ ? ((l4 >> 2) & 3) : (((l4 >> 2) & 1) | ((j_ & 1) << 1)); \
                __builtin_amdgcn_global_load_lds((const unsigned*)(gb_ + (size_t)sel_[j_] * 128 + ((cpos ^ f_) << 4)), (LAS unsigned*)(RING + ((s) & 3) * 4096 + j_ * 1024), 16, 0, 0); } } while (0)
        ATT_ISSUE(0); ATT_ISSUE(1); ATT_ISSUE(2);
#pragma unroll
        for (int s = 0; s < 8; ++s) {
            if (s + 3 < 8) ATT_ISSUE(s + 3);
            if (s <= 4) wait_vm<12>(); else if (s == 5) wait_vm<8>(); else if (s == 6) wait_vm<4>(); else wait_vm<0>();
            const LAS unsigned char* buf = RING + (s & 3) * 4096;
            if (s < 4) {
#pragma unroll
                for (int tl = 0; tl < 4; ++tl)
#pragma unroll
                    for (int ks = 0; ks < 2; ++ks) { const long af = *(const LAS long*)(buf + tl * 1024 + kra[ks]);
                        sc[s][tl] = __builtin_amdgcn_mfma_f32_16x16x32_fp8_fp8(af, qf[ks], sc[s][tl], 0, 0, 0); }
                if (s == 3) {
                    float mx = -3.0e38f;
#pragma unroll
                    for (int c = 0; c < 4; ++c)
#pragma unroll
                        for (int tl = 0; tl < 4; ++tl)
#pragma unroll
                            for (int r = 0; r < 4; ++r) { const int key = c * 64 + tl * 16 + kg * 4 + r; const float v = (key < nsel) ? sc[c][tl][r] * 0.125f : -3.0e38f; sc[c][tl][r] = v; mx = fmaxf(mx, v); }
                    mx = fmaxf(mx, __shfl_xor(mx, 16)); mx = fmaxf(mx, __shfl_xor(mx, 32));
                    float sum = 0.f;
#pragma unroll
                    for (int c = 0; c < 4; ++c)
#pragma unroll
                        for (int tl = 0; tl < 4; ++tl)
#pragma unroll
                            for (int r = 0; r < 4; ++r) { const float e = __expf(sc[c][tl][r] - mx); sc[c][tl][r] = e; sum += e; }
                    sum += __shfl_xor(sum, 16); sum += __shfl_xor(sum, 32);
                    inv = 1.0f / sum;
                }
            } else {
                const int c = s - 4;
                v2u pw[2];
#pragma unroll
                for (int h2 = 0; h2 < 2; ++h2) { pw[h2].x = pk_fp8x4(sc[c][2 * h2][0], sc[c][2 * h2][1], sc[c][2 * h2][2], sc[c][2 * h2][3]); pw[h2].y = pk_fp8x4(sc[c][2 * h2 + 1][0], sc[c][2 * h2 + 1][1], sc[c][2 * h2 + 1][2], sc[c][2 * h2 + 1][3]); }
                v2u a[8];
                asm volatile("ds_read_b64_tr_b8 %0, %8 offset:%12\n\tds_read_b64_tr_b8 %1, %9 offset:%12\n\tds_read_b64_tr_b8 %2, %10 offset:%12\n\tds_read_b64_tr_b8 %3, %11 offset:%12\n\t"
                             "ds_read_b64_tr_b8 %4, %8 offset:%13\n\tds_read_b64_tr_b8 %5, %9 offset:%13\n\tds_read_b64_tr_b8 %6, %10 offset:%13\n\tds_read_b64_tr_b8 %7, %11 offset:%13\n\ts_waitcnt lgkmcnt(0)"
                             : "=&v"(a[0]), "=&v"(a[1]), "=&v"(a[2]), "=&v"(a[3]), "=&v"(a[4]), "=&v"(a[5]), "=&v"(a[6]), "=&v"(a[7])
                             : "v"(tra[0]), "v"(tra[1]), "v"(tra[2]), "v"(tra[3]), "n"((s & 3) * 4096), "n"((s & 3) * 4096 + 2048) : "memory");
#pragma unroll
                for (int h2 = 0; h2 < 2; ++h2)
#pragma unroll
                    for (int mt = 0; mt < 4; ++mt)
                        oacc[mt] = __builtin_amdgcn_mfma_f32_16x16x32_fp8_fp8(__builtin_bit_cast(long, a[4 * h2 + mt]), __builtin_bit_cast(long, pw[h2]), oacc[mt], 0, 0, 0);
            }
        }
#undef ATT_ISSUE
        if (hd < 4) {
            bf16* yo = YA + (size_t)tok * 512 + (kvh * 4 + hd) * 64 + kg * 4;
#pragma unroll
            for (int mt = 0; mt < 4; ++mt) { pg8::u32x2 w; w.x = pg8::cvt_pk_bf16(oacc[mt][0] * inv, oacc[mt][1] * inv); w.y = pg8::cvt_pk_bf16(oacc[mt][2] * inv, oacc[mt][3] * inv); *(GAS pg8::u32x2*)(yo + 16 * mt) = w; }
        }
        LDS_WAIT(); __builtin_amdgcn_wave_barrier();
    }
}

__device__ __forceinline__ void router_phase(Frame& F) {
    constexpr int HRS = 1028;
    LAS float* HR = (LAS float*)(F.lds);
    LAS float* PT = (LAS float*)(F.lds + 65792);
    LAS int* LE = (LAS int*)(F.lds + 82176);
    LAS int* LP = (LAS int*)(F.lds + 83200);
    LAS unsigned* LC = (LAS unsigned*)(F.lds + 84224);
    const bf16* X1 = (const bf16*)(F.ws + WS_X1); bf16* H2 = (bf16*)(F.ws + WS_H2);
    const float* WR = F.in[I_WR]; const float* BR = F.in[I_BR]; const float* G2 = F.in[I_N2G];
    int* TOPE = (int*)(F.ws + WS_TOPE); float* TOPW = (float*)(F.ws + WS_TOPW); int* TOPPOS = (int*)(F.ws + WS_TOPPOS); int* ROWMAP = (int*)(F.ws + WS_ROWMAP);
    const int tid = F.tid, lane = F.lane, wave = F.wave, e = lane & 31, dh = lane >> 5;
    float wb[32][2];
#pragma unroll
    for (int i = 0; i < 32; ++i)
#pragma unroll
        for (int t = 0; t < 2; ++t) wb[i][t] = WR[(size_t)(128 * wave + 4 * i + (lane >> 4)) * 32 + (lane & 15) + 16 * t];
    if (tid < 64) LC[tid] = 0u;
    const int tok0 = blockIdx.x * 64;
    v2u nv[2][4];
#pragma unroll
    for (int rr = 0; rr < 2; ++rr)
#pragma unroll
        for (int j = 0; j < 4; ++j) nv[rr][j] = ((const GAS v2u*)(X1 + (size_t)(tok0 + 2 * wave + rr) * DM) + lane)[64 * j];
    for (int bt = 0; bt < 4; ++bt) {
        __syncthreads();
#pragma unroll
        for (int rr = 0; rr < 2; ++rr) { const int lr = 2 * wave + rr, tok = tok0 + bt * 16 + lr;
            const GAS f32x4* gr = (const GAS f32x4*)G2 + lane;
            f32x4 v[4]; float s2 = 0.f;
#pragma unroll
            for (int j = 0; j < 4; ++j) { v[j] = (f32x4){bflo(nv[rr][j].x), bfhi(nv[rr][j].x), bflo(nv[rr][j].y), bfhi(nv[rr][j].y)}; s2 += (v[j].x * v[j].x + v[j].y * v[j].y) + (v[j].z * v[j].z + v[j].w * v[j].w); }
            const float rstd = 1.0f / sqrtf(wave_sum(s2) * (1.f / DM) + RMS_EPS);
            GAS unsigned long long* o8 = (GAS unsigned long long*)(H2 + (size_t)tok * DM) + lane;
#pragma unroll
            for (int j = 0; j < 4; ++j) { const f32x4 gg = gr[64 * j]; const f32x4 h = v[j] * rstd * gg;
                *(LAS f32x4*)(HR + lr * HRS + 256 * j + 4 * lane) = h;
                o8[64 * j] = (unsigned long long)pk2(h.x, h.y) | ((unsigned long long)pk2(h.z, h.w) << 32); } }
        if (bt + 1 < 4) {
#pragma unroll
            for (int rr = 0; rr < 2; ++rr)
#pragma unroll
                for (int j = 0; j < 4; ++j) nv[rr][j] = ((const GAS v2u*)(X1 + (size_t)(tok0 + (bt + 1) * 16 + 2 * wave + rr) * DM) + lane)[64 * j];
        }
        __syncthreads();
        { f32x4 d0 = {0.f, 0.f, 0.f, 0.f}, d1 = d0; const LAS float* hp = HR + (lane & 15) * HRS + 128 * wave + (lane >> 4);
#pragma unroll
          for (int i = 0; i < 32; ++i) { const float a = hp[4 * i]; d0 = __builtin_amdgcn_mfma_f32_16x16x4f32(a, wb[i][0], d0, 0, 0, 0); d1 = __builtin_amdgcn_mfma_f32_16x16x4f32(a, wb[i][1], d1, 0, 0, 0); }
#pragma unroll
          for (int r = 0; r < 4; ++r) { const int row = 4 * (lane >> 4) + r; PT[(row * 8 + wave) * 32 + (lane & 15)] = d0[r]; PT[(row * 8 + wave) * 32 + 16 + (lane & 15)] = d1[r]; } }
        __syncthreads();
        { const int lr = 2 * wave + dh, tl = bt * 16 + lr, tok = tok0 + tl; float lg = BR[e];
#pragma unroll
          for (int w8 = 0; w8 < 8; ++w8) lg += PT[(lr * 8 + w8) * 32 + e];
          float cur = lg; float tv[4]; int te[4];
#pragma unroll
          for (int k = 0; k < 4; ++k) { float mv = cur; int mi = e;
#pragma unroll
              for (int o = 1; o < 32; o <<= 1) { const float ov = __shfl_xor(mv, o); const int oi = __shfl_xor(mi, o); if (ov > mv || (ov == mv && oi < mi)) { mv = ov; mi = oi; } }
              tv[k] = mv; te[k] = mi; if (e == mi) cur = -3.0e38f; }
          const float e1 = __expf(tv[1] - tv[0]), e2 = __expf(tv[2] - tv[0]), e3 = __expf(tv[3] - tv[0]); const float inv = 1.0f / (1.0f + e1 + e2 + e3);
          if (e < 4) { const int ex = (e == 0) ? te[0] : (e == 1) ? te[1] : (e == 2) ? te[2] : te[3]; const float wv = ((e == 0) ? 1.0f : (e == 1) ? e1 : (e == 2) ? e2 : e3) * inv;
              TOPE[(size_t)tok * 4 + e] = ex; TOPW[(size_t)tok * 4 + e] = wv; LE[tl * 4 + e] = ex; LP[tl * 4 + e] = (int)atomicAdd((unsigned*)&LC[ex], 1u); } }
    }
    __syncthreads();
    if (tid < 32) LC[32 + tid] = __hip_atomic_fetch_add((unsigned*)(F.ctl + CW_ECNT) + tid, LC[tid], RLX_AGENT);
    __syncthreads();
    if (tid < 256) { const int ex = LE[tid], pos = (int)LC[32 + ex] + LP[tid], tok = tok0 + (tid >> 2); TOPPOS[(size_t)tok * 4 + (tid & 3)] = pos; ROWMAP[(size_t)ex * NTOK + pos] = tok; }
}

__device__ __forceinline__ int moe_tables(Frame& F, LAS int* OFF, LAS int* TE, bool build) {
    __syncthreads();
    if (build && F.tid == 0) { int cn[NEXP];
#pragma unroll
        for (int e = 0; e < NEXP; ++e) cn[e] = (int)__hip_atomic_load((unsigned*)(F.ctl + CW_ECNT) + e, RLX_AGENT);
        int acc = 0;
#pragma unroll
        for (int e = 0; e < NEXP; ++e) { const int c = cn[e], nt = (c + 255) >> 8; OFF[e] = acc * 256; OFF[33 + e] = c; for (int i = 0; i < nt; ++i) TE[acc + i] = e; acc += nt; }
        OFF[NEXP] = acc; }
    __syncthreads();
    return OFF[NEXP];
}
__device__ __forceinline__ void combine_phase(Frame& F, bool build) {
    LAS int* OFF = (LAS int*)(F.lds + MISC_OFF + 512); LAS int* TE = OFF + 72;
    (void)moe_tables(F, OFF, TE, build);
    const int* TOPE = (const int*)(F.ws + WS_TOPE); const int* TOPPOS = (const int*)(F.ws + WS_TOPPOS); const float* TOPW = (const float*)(F.ws + WS_TOPW);
    const bf16* X1 = (const bf16*)(F.ws + WS_X1); const bf16* Y2 = (const bf16*)(F.ws + WS_Y2); const float* GF = F.in[I_NFG];
    const int gw = blockIdx.x * NWAVES + F.wave, NGW = F.G * NWAVES, lane = F.lane;
    typedef int v4i __attribute__((ext_vector_type(4)));
    constexpr int NT = NTOK / (256 * NWAVES);
    f32x4 gg[4];
#pragma unroll
    for (int j = 0; j < 4; ++j) gg[j] = ((const GAS f32x4*)GF + lane)[64 * j];
    v4i re, rp; f32x4 rw;
    v2u xr[2][4], yr[2][4][4]; f32x4 wr[2];
#define CMB_REC(i_) do { const int t_ = gw + (i_) * NGW; re = *(const GAS v4i*)(TOPE + (size_t)t_ * 4); rp = *(const GAS v4i*)(TOPPOS + (size_t)t_ * 4); rw = *(const GAS f32x4*)(TOPW + (size_t)t_ * 4); } while (0)
#define CMB_ROWS(i_, b_) do { const int t_ = gw + (i_) * NGW; wr[b_] = rw; \
        _Pragma("unroll") for (int j = 0; j < 4; ++j) xr[b_][j] = ((const GAS v2u*)(X1 + (size_t)t_ * DM) + lane)[64 * j]; \
        _Pragma("unroll") for (int k = 0; k < 4; ++k) { const int slot = OFF[re[k]] + rp[k]; const GAS v2u* yp = (const GAS v2u*)(Y2 + (size_t)slot * DM) + lane; \
            _Pragma("unroll") for (int j = 0; j < 4; ++j) yr[b_][k][j] = yp[64 * j]; } } while (0)
    CMB_REC(0); CMB_ROWS(0, 0); if (NT > 1) CMB_REC(1);
#pragma unroll
    for (int i = 0; i < NT; ++i) { const int b = i & 1, tok = gw + i * NGW;
        asm volatile("" ::: "memory");
        if (i + 1 < NT) CMB_ROWS(i + 1, b ^ 1);
        if (i + 2 < NT) CMB_REC(i + 2);
        asm volatile("" ::: "memory");
        f32x4 v[4];
#pragma unroll
        for (int j = 0; j < 4; ++j) { const v2u x = xr[b][j]; v[j] = (f32x4){bflo(x.x), bfhi(x.x), bflo(x.y), bfhi(x.y)}; }
#pragma unroll
        for (int k = 0; k < 4; ++k) { const float wk = wr[b][k];
#pragma unroll
            for (int j = 0; j < 4; ++j) { const v2u y = yr[b][k][j]; v[j].x += wk * bflo(y.x); v[j].y += wk * bfhi(y.x); v[j].z += wk * bflo(y.y); v[j].w += wk * bfhi(y.y); } }
        float s2 = 0.f;
#pragma unroll
        for (int j = 0; j < 4; ++j) s2 += (v[j].x * v[j].x + v[j].y * v[j].y) + (v[j].z * v[j].z + v[j].w * v[j].w);
        const float rstd = 1.0f / sqrtf(wave_sum(s2) * (1.f / DM) + RMS_EPS);
#pragma unroll
        for (int j = 0; j < 4; ++j) ((GAS f32x4*)(F.out + (size_t)tok * DM) + lane)[64 * j] = v[j] * rstd * gg[j];
    }
#undef CMB_REC
#undef CMB_ROWS
}

__device__ __forceinline__ void ubench(Frame& F) {
    bf16x8 a = (bf16x8){1, 2, 3, 4, 5, 6, 7, 8}, b = (bf16x8){8, 7, 6, 5, 4, 3, 2, 1}; a[0] = (short)F.lane;
    float sink = 0.f;
    if (PROBE_DUP == 900) { f32x16 c0 = {0.f, 0.f, 0.f, 0.f, 0.f, 0.f, 0.f, 0.f, 0.f, 0.f, 0.f, 0.f, 0.f, 0.f, 0.f, 0.f}, c1 = c0;
        for (int i = 0; i < 2000; ++i) { c0 = __builtin_amdgcn_mfma_f32_32x32x16_bf16(a, b, c0, 0, 0, 0); c1 = __builtin_amdgcn_mfma_f32_32x32x16_bf16(a, b, c1, 0, 0, 0); }
        sink = c0[0] + c1[5]; }
    if (PROBE_DUP == 901) { f32x4 c0 = {0.f, 0.f, 0.f, 0.f}, c1 = c0, c2 = c0, c3 = c0;
        for (int i = 0; i < 2000; ++i) { c0 = __builtin_amdgcn_mfma_f32_16x16x32_bf16(a, b, c0, 0, 0, 0); c1 = __builtin_amdgcn_mfma_f32_16x16x32_bf16(a, b, c1, 0, 0, 0); c2 = __builtin_amdgcn_mfma_f32_16x16x32_bf16(a, b, c2, 0, 0, 0); c3 = __builtin_amdgcn_mfma_f32_16x16x32_bf16(a, b, c3, 0, 0, 0); }
        sink = c0[0] + c1[1] + c2[2] + c3[3]; }
    if (PROBE_DUP == 902) { float x0 = F.lane, x1 = 1.f, x2 = 2.f, x3 = 3.f, x4 = 4.f, x5 = 5.f, x6 = 6.f, x7 = 7.f; const float m = 1.0001f, d = 0.5f;
        for (int i = 0; i < 4000; ++i) { x0 = x0 * m + d; x1 = x1 * m + d; x2 = x2 * m + d; x3 = x3 * m + d; x4 = x4 * m + d; x5 = x5 * m + d; x6 = x6 * m + d; x7 = x7 * m + d; }
        sink = x0 + x1 + x2 + x3 + x4 + x5 + x6 + x7; }
    if (PROBE_DUP == 903) {
        f32x4 c[4]; float s = 0.f; float wv[16];
#pragma unroll
        for (int i = 0; i < 4; ++i) c[i] = (f32x4){0.f, 0.f, 0.f, 0.f};
#pragma unroll
        for (int i = 0; i < 16; ++i) wv[i] = 0.001f * (i + F.lane);
        for (int it = 0; it < 275; ++it) { f32x4 d[4];
#pragma unroll
            for (int i = 0; i < 4; ++i) { d[i] = (f32x4){0.f, 0.f, 0.f, 0.f}; d[i] = __builtin_amdgcn_mfma_f32_16x16x32_bf16(a, b, d[i], 0, 0, 0); d[i] = __builtin_amdgcn_mfma_f32_16x16x32_bf16(b, a, d[i], 0, 0, 0); }
            float t = 0.f;
#pragma unroll
            for (int i = 0; i < 4; ++i)
#pragma unroll
                for (int r = 0; r < 4; ++r) { const float x = c[i][r]; const int xi = __builtin_bit_cast(int, x); const float m = __builtin_bit_cast(float, xi > 0 ? xi : 0); t += wv[4 * i + r] * m; }
            float u = t;
#pragma unroll
            for (int k = 0; k < 12; ++k) u = u * 1.0001f + 0.5f;
            s += u; a[1] = (short)(it + (int)s);
#pragma unroll
            for (int i = 0; i < 4; ++i) c[i] = d[i]; }
        sink = s; }
    if (sink == 123.456f) ((float*)(F.ws + WS_SBUF))[F.tid] = sink;
}

constexpr int NPHASE = 10;
struct Args { const float* in[25]; float* out; unsigned char* ws; int ph_lo, ph_hi; };
__global__ void __launch_bounds__(NTHR, 2) fwd_kernel(Args args) {
    extern __shared__ __attribute__((aligned(16))) unsigned char lds[];
    Frame F;
    F.lds = (LAS unsigned char*)lds;
    F.MISC = (volatile LAS unsigned*)(F.lds + MISC_OFF);
    F.tid = threadIdx.x; F.lane = F.tid & 63; F.wave = __builtin_amdgcn_readfirstlane(F.tid >> 6); F.G = gridDim.x;
    F.ws = args.ws; F.ctl = (gu32*)(args.ws + WS_CTL); F.out = args.out;
#pragma unroll
    for (int i = 0; i < 25; ++i) F.in[i] = args.in[i];
    for (int u = F.tid; u < 2048 / 4; u += NTHR) ((LAS unsigned*)(F.lds + MISC_OFF))[u] = 0u;
    __syncthreads();
    XcdBarrier bar; bar.bar = (unsigned*)(F.ctl + CW_BAR); bar.x = 0; bar.st = nullptr;
    if (MK_N_LAUNCHES == 1) bar = xcd_barrier_post((unsigned*)(F.ctl + CW_BAR), F.MISC + 8);
    const int lo = args.ph_lo, hi = args.ph_hi;
#define IN(k) (lo <= (k) && (k) < hi)
#define SEAM(k) do { if (IN(k) && IN((k) + 1)) xcd_barrier(bar); } while (0)
    unsigned char* ws = F.ws; const int c = (int)blockIdx.x;

#define BODY_P0 { p0_prologue(F); if (PROBE_DUP >= 900) ubench(F); }
#define BODY_P1 { { pg8::Gemm g{(const bf16*)(ws + WS_XN), (const bf16*)(ws + WS_WIN), 1024, 1024, 1024, 0}; InProjOrder S{F.G, c, (unsigned*)(F.ctl + CW_UDONE)}; \
        EpiInProj E{ws, F.in[I_BGATE]}; pg8::gemm_phase<EpiInProj, InProjOrder>(F.lds, g, S, E); } \
        if (c >= 128 && c < 192) { wg_wait_ge(F, CW_UDONE, 128u * 8u); pg8::Gemm g{(const bf16*)(ws + WS_UGX), (const bf16*)(ws + WS_WS), UGX_LD, 512, 512, 0}; S5StateOrder S{c - 128}; EpiS5State E{(float*)(ws + WS_SBUF)}; \
          pg8::gemm_phase<EpiS5State, S5StateOrder>(F.lds, g, S, E); } \
        if (c >= 128) moe_convert(F, MOE_N8A, MOE_N8, (c < 192) ? c - 128 : 64 + 2 * (c - 192), (c < 192) ? 1 : 2, 192); }
#define BODY_P2 { carry_phase(F); idx_phase(F); if (PROBE_DUP == 102) { xcd_barrier(bar); idx_phase(F); } }
#define BODY_P3 { if (c >= 128) { { pg8::Gemm g{(const bf16*)(ws + WS_UGX), (const bf16*)(ws + WS_MT), UGX_LD, UGX_LD, 640, 0}; S5YOrder S{c - 128}; EpiS5Y E{(const bf16*)(ws + WS_UGX), F.in[I_SD], (bf16*)(ws + WS_YG)}; \
            pg8::gemm_phase<EpiS5Y, S5YOrder>(F.lds, g, S, E); } \
          wg_signal(F, CW_YDONE); wg_wait_ge(F, CW_YDONE, 128u); \
          { pg8::Gemm g{(const bf16*)(ws + WS_YG), (const bf16*)(ws + WS_WGLU), 512, 512, 512, 0}; StaticOrder S; S.init(NTOK / 256, 2, 128, c - 128); EpiGlu E{(const bf16*)(ws + WS_YG), F.in[I_BGLU], (bf16*)(ws + WS_YSSM)}; \
            pg8::gemm_phase<EpiGlu, StaticOrder>(F.lds, g, S, E); } } \
        attn_phase(F); }
#define BODY_P4 { pg8::Gemm g{(const bf16*)(ws + WS_YSSM), (const bf16*)(ws + WS_WPS), 512, 512, 512, 0}; MixOrder S; S.so.init(NTOK / 256, 4, F.G, c); \
        EpiMix E{(const bf16*)(ws + WS_GS), (const bf16*)(ws + WS_GA), (bf16*)(ws + WS_MIXED)}; pg8::gemm_phase<EpiMix, MixOrder>(F.lds, g, S, E); }
#define BODY_P5 { pg8::Gemm g{(const bf16*)(ws + WS_MIXED), (const bf16*)(ws + WS_WOUT), 1024, 1024, 1024, 0}; StaticOrder S; S.init(NTOK / 256, 4, F.G, c); EpiOut E{F.in[I_X], (bf16*)(ws + WS_X1)}; \
        pg8::gemm_phase<EpiOut, StaticOrder>(F.lds, g, S, E); }
#define BODY_P6 { router_phase(F); }
#define BODY_P7 { LAS int* OFF = (LAS int*)(F.lds + MISC_OFF + 512); LAS int* TE = OFF + 72; const int TT = moe_tables(F, OFF, TE, true); \
        pg8::Gemm g{(const bf16*)(ws + WS_H2), (const bf16*)(ws + WS_WMI), 1024, 2048, 1024, (size_t)1024 * 2048 * 2}; MoeOrder S{TE, OFF, OFF + 33, (const int*)(ws + WS_ROWMAP), TT, 8, c}; EpiMoe1 E{F.in[I_BMI], (bf16*)(ws + WS_ACT)}; \
        pg8::gemm_phase<EpiMoe1, MoeOrder, true, true>(F.lds, g, S, E); }
#define BODY_P8 { LAS int* OFF = (LAS int*)(F.lds + MISC_OFF + 512); LAS int* TE = OFF + 72; const int TT = moe_tables(F, OFF, TE, lo == 8); \
        pg8::Gemm g{(const bf16*)(ws + WS_ACT), (const bf16*)(ws + WS_WMO), 1024, 1024, 1024, (size_t)1024 * 1024 * 2}; MoeOrder S{TE, OFF, OFF + 33, nullptr, TT, 4, c}; EpiMoe2 E{F.in[I_BMO], (bf16*)(ws + WS_Y2)}; \
        pg8::gemm_phase<EpiMoe2, MoeOrder, true, true>(F.lds, g, S, E); }
#define BODY_P9 { combine_phase(F, lo == 9); }
#define PHASE(k, BODY) if (IN(k)) { TPROBE_BEGIN(k); BODY TPROBE_END(k); if (PROBE_DUP == (k)) { xcd_barrier(bar); BODY } } SEAM(k);
    PHASE(0, BODY_P0) PHASE(1, BODY_P1) PHASE(2, BODY_P2) PHASE(3, BODY_P3) PHASE(4, BODY_P4) PHASE(5, BODY_P5) PHASE(6, BODY_P6)
    PHASE(7, BODY_P7) PHASE(8, BODY_P8) PHASE(9, BODY_P9)
#undef IN
#undef SEAM
}

extern "C" void kernel_launch(void* const* d_in, const int* in_sizes, int n_in, void* d_out, int out_size, void* d_ws, size_t ws_size, hipStream_t stream) {
    static int grid = 0;
    if (grid == 0) {
        if (n_in != 25 || out_size != NTOK * DM || ws_size < WS_END) { fprintf(stderr, "kernel_launch: unexpected problem (n_in %d out %d ws %zu)\n", n_in, out_size, ws_size); grid = -1; return; }
        if (hipFuncSetAttribute((const void*)fwd_kernel, hipFuncAttributeMaxDynamicSharedMemorySize, LDS_BYTES) != hipSuccess) { fprintf(stderr, "kernel_launch: hipFuncSetAttribute failed\n"); grid = -1; return; }
        int per_cu = 0; (void)hipOccupancyMaxActiveBlocksPerMultiprocessor(&per_cu, (const void*)fwd_kernel, NTHR, LDS_BYTES); (void)hipGetLastError();
        grid = 256;
    }
    if (grid < 0) return;
    (void)hipMemsetAsync((char*)d_ws + WS_CTL, 0, CTL_ZERO_BYTES, stream);
    Args a{};
    for (int i = 0; i < 25; ++i) a.in[i] = (const float*)d_in[i];
    a.out = (float*)d_out; a.ws = (unsigned char*)d_ws;
    if (MK_N_LAUNCHES == 1) { a.ph_lo = 0; a.ph_hi = NPHASE; hipLaunchKernelGGL(fwd_kernel, dim3(grid), dim3(NTHR), LDS_BYTES, stream, a); }
    else for (int p = 0; p < NPHASE; ++p) { a.ph_lo = p; a.ph_hi = p + 1; hipLaunchKernelGGL(fwd_kernel, dim3(grid), dim3(NTHR), LDS_BYTES, stream, a); }
}
```

```cpp
#include <hip/hip_runtime.h>
#include <cstdio>
#include <cstdint>

#ifndef MK_N_LAUNCHES
#define MK_N_LAUNCHES 1
#endif
#ifndef PROBE_DUP
#define PROBE_DUP -1
#endif
#ifndef PROBE_MULT
#define PROBE_MULT 4
#endif
#ifndef PROBE_T
#define PROBE_T -1
#endif
#define TPROBE_BEGIN(id) unsigned long long tpb_##id = (PROBE_T == (id)) ? __builtin_amdgcn_s_memrealtime() : 0ull
#define TPROBE_END(id) do { if (PROBE_T == (id)) { const unsigned long long d_ = __builtin_amdgcn_s_memrealtime() - tpb_##id, t1_ = __builtin_amdgcn_s_memrealtime(); while (__builtin_amdgcn_s_memrealtime() - t1_ < 4ull * d_) __builtin_amdgcn_s_sleep(8); } } while (0)

namespace pg8 {
#define PG8_LAS __attribute__((address_space(3)))
typedef unsigned short bf16_t;
typedef short bf16x8 __attribute__((ext_vector_type(8)));
typedef float f32x4 __attribute__((ext_vector_type(4)));
typedef float f32x2 __attribute__((ext_vector_type(2)));
typedef unsigned u32x4 __attribute__((ext_vector_type(4)));
typedef unsigned u32x2 __attribute__((ext_vector_type(2)));
constexpr int BM = 256, BK = 64, HALF = 128, HTB = HALF * BK * 2, STAGE_BYTES = 8 * HTB, NXCD = 8, WGM = 8;

__host__ __device__ __forceinline__ int lds_byte(int r, int c) { const int st = (r >> 4) * 2 + (c >> 5), rr = r & 15, cc = c & 31, ob = rr * 64 + cc * 2; return st * 1024 + (ob ^ (((ob >> 9) & 1) << 5)); }
__host__ __device__ __forceinline__ void stage_rc(int b, int& R, int& C) { const int st = b / 1024, sb = b % 1024, swz = sb ^ (((sb >> 9) & 1) << 5); R = (st >> 1) * 16 + swz / 64; C = (st & 1) * 32 + (swz % 64) / 2; }
__host__ __device__ __forceinline__ int perm32(int rho) { const int n = rho >> 4, i = rho & 15; return 8 * (i >> 2) + 4 * n + (i & 3); }

struct Unit { int pm, pn, pa, pb, e; };
struct Gemm { const bf16_t* A; const bf16_t* Bt; int lda, ldb, K; size_t bexp; };

__device__ __forceinline__ unsigned cvt_pk_bf16(float lo, float hi) { unsigned r; asm volatile("v_cvt_pk_bf16_f32 %0, %1, %2" : "=v"(r) : "v"(lo), "v"(hi)); return r; }
__device__ __forceinline__ u32x4 pack8(const f32x4& v0, const f32x4& v1) { u32x4 w; w.x = cvt_pk_bf16(v0[0], v0[1]); w.y = cvt_pk_bf16(v0[2], v0[3]); w.z = cvt_pk_bf16(v1[0], v1[1]); w.w = cvt_pk_bf16(v1[2], v1[3]); return w; }

template <class Epi, class Sched, bool ALIGN_EPI = true, bool BKN = false, bool FP8 = false>
__device__ __forceinline__ void gemm_phase(PG8_LAS unsigned char* lds, const Gemm g, const Sched& S, const Epi& E) {
    const int tid = threadIdx.x, wid = __builtin_amdgcn_readfirstlane(tid >> 6), lane = tid & 63, wr = wid >> 2, wc = wid & 3, fr = lane & 15, fq = lane >> 4;
    const int K = g.K, nt = K / BK;
    unsigned voffB[2];
#pragma unroll
    for (int i = 0; i < 2; ++i) {
        if constexpr (BKN) { const int krow = (tid >> 4) + 32 * i, cp = tid & 15, fk = ((krow & 3) << 1) | (((krow >> 3) & 1) << 3); voffB[i] = (unsigned)(krow * g.ldb) * 2u + (unsigned)((cp ^ fk) << 4); }
        else { int R, C; stage_rc(tid * 16 + i * 8192, R, C); const int Rb = (R & ~31) + perm32(R & 31); voffB[i] = (unsigned)(Rb * g.ldb + C) * 2u; } }
    const size_t kstep = (size_t)(BK * 2);
    const size_t kstepB = BKN ? (size_t)BK * g.ldb * 2 : kstep;
    const size_t hstepB = BKN ? (size_t)256 : (size_t)HALF * g.ldb * 2;
    const size_t tstepB = BKN ? (size_t)512 : 2 * hstepB;
    const unsigned tbase = (unsigned)(unsigned long)lds + (unsigned)((8 * fq + (fr >> 2)) * 256 + (((4 * wc + (fr & 3)) ^ (((fr >> 2) << 1) | ((fq & 1) << 3))) << 4));
#define PG8_AROWS(VV, U) do { _Pragma("unroll") for (int i_ = 0; i_ < 2; ++i_) { int R_, C_; stage_rc((threadIdx.x & 511) * 16 + i_ * 8192, R_, C_); \
        _Pragma("unroll") for (int h_ = 0; h_ < 2; ++h_) VV[h_][i_] = (unsigned)(S.arow(U, h_, R_) * g.lda + C_) * 2u; } } while (0)
    unsigned vA[2][2], vAn[2][2];
    const unsigned ldsw = (unsigned)wid * 1024u;
    const int aoff = lds_byte(wr * 64 + fr, fq * 8), boff = lds_byte(wc * 32 + fr, fq * 8);
#define PG8_SA(b, h) (((b) * 2 + (h)) * HTB)
#define PG8_SB(b, h) ((4 + (b) * 2 + (h)) * HTB)
#define PG8_STAGE(bufoff, gbase, voff) do { _Pragma("unroll") for (int _i = 0; _i < 2; ++_i) \
        __builtin_amdgcn_global_load_lds((const unsigned*)((const char*)(gbase) + (voff)[_i]), (PG8_LAS unsigned*)(lds + (bufoff) + ldsw + _i * 8192), 16, 0, 0); } while (0)
#define PG8_LDA(dst, b, h) do { _Pragma("unroll") for (int m = 0; m < 4; ++m) _Pragma("unroll") for (int k = 0; k < 2; ++k) dst[m][k] = *(const PG8_LAS bf16x8*)(lds + PG8_SA(b, h) + aoff + m * 2048 + k * 1024); } while (0)
#define PG8_LDB(dst, b, h) do { if constexpr (BKN) { const unsigned ab_ = tbase + PG8_SB(b, h); _Pragma("unroll") for (int n = 0; n < 2; ++n) _Pragma("unroll") for (int k = 0; k < 2; ++k) { u32x2 lo_, hi_; \
            asm volatile("ds_read_b64_tr_b16 %0, %2 offset:%3\n\tds_read_b64_tr_b16 %1, %2 offset:%4" : "=&v"(lo_), "=&v"(hi_) : "v"(ab_), "n"(k * 8192 + n * 8), "n"(k * 8192 + n * 8 + 1024) : "memory"); \
            u32x4 w_; w_.x = lo_.x; w_.y = lo_.y; w_.z = hi_.x; w_.w = hi_.y; dst[n][k] = __builtin_bit_cast(bf16x8, w_); } } \
        else { _Pragma("unroll") for (int n = 0; n < 2; ++n) _Pragma("unroll") for (int k = 0; k < 2; ++k) dst[n][k] = *(const PG8_LAS bf16x8*)(lds + PG8_SB(b, h) + boff + n * 2048 + k * 1024); } } while (0)
#define PG8_WAIT_LB() do { if constexpr (BKN) asm volatile("s_waitcnt lgkmcnt(0)" : "+v"(B0[0][0]), "+v"(B0[0][1]), "+v"(B0[1][0]), "+v"(B0[1][1]), "+v"(B1[0][0]), "+v"(B1[0][1]), "+v"(B1[1][0]), "+v"(B1[1][1]) :: "memory"); \
        else asm volatile("s_waitcnt lgkmcnt(0)" ::: "memory"); } while (0)
#define PG8_MMA(ai, bj, At, Bt) do { __builtin_amdgcn_s_setprio(1); _Pragma("unroll") for (int m = 0; m < 4; ++m) _Pragma("unroll") for (int n = 0; n < 2; ++n) { \
        if constexpr (FP8) { typedef int v8i_ __attribute__((ext_vector_type(8))); typedef int v4i_ __attribute__((ext_vector_type(4))); \
            const v4i_ b0_ = __builtin_bit_cast(v4i_, Bt[n][0]), b1_ = __builtin_bit_cast(v4i_, Bt[n][1]), a0_ = __builtin_bit_cast(v4i_, At[m][0]), a1_ = __builtin_bit_cast(v4i_, At[m][1]); \
            const v8i_ b8_ = __builtin_shufflevector(b0_, b1_, 0, 1, 2, 3, 4, 5, 6, 7), a8_ = __builtin_shufflevector(a0_, a1_, 0, 1, 2, 3, 4, 5, 6, 7); \
            asm volatile("v_mfma_scale_f32_16x16x128_f8f6f4 %0, %1, %2, %0, %3, %3 op_sel_hi:[0,0,0]" : "+v"(acc[ai][bj][m][n]) : "v"(b8_), "v"(a8_), "v"(0x7F7F7F7F)); } \
        else { _Pragma("unroll") for (int k = 0; k < 2; ++k) acc[ai][bj][m][n] = __builtin_amdgcn_mfma_f32_16x16x32_bf16(Bt[n][k], At[m][k], acc[ai][bj][m][n], 0, 0, 0); } } __builtin_amdgcn_s_setprio(0); } while (0)
#define PG8_WAIT_V(n) asm volatile("s_waitcnt vmcnt(" #n ")" ::: "memory")
#define PG8_WAIT_L(n) asm volatile("s_waitcnt lgkmcnt(" #n ")" ::: "memory")
#define PG8_BAR __builtin_amdgcn_s_barrier()
#define PG8_SCHED __builtin_amdgcn_sched_barrier(0)
    Unit cur, nxt; int ui = 0;
    if (!S.next(0, cur)) return;
    f32x4 acc[2][2][4][2];
#pragma unroll
    for (int a = 0; a < 2; ++a)
#pragma unroll
        for (int b = 0; b < 2; ++b)
#pragma unroll
            for (int m = 0; m < 4; ++m)
#pragma unroll
                for (int n = 0; n < 2; ++n) acc[a][b][m][n] = (f32x4){0.f, 0.f, 0.f, 0.f};
    bf16x8 At[4][2], B0[2][2], B1[2][2];
    const char* const bA = (const char*)g.A; const char* cB = BKN ? (const char*)g.Bt + (size_t)cur.e * g.bexp + (size_t)cur.pn * tstepB : (const char*)g.Bt + (size_t)cur.pb * tstepB;
    PG8_AROWS(vA, cur);
    PG8_STAGE(PG8_SB(0, 0), cB, voffB); PG8_STAGE(PG8_SB(0, 1), cB + hstepB, voffB); PG8_STAGE(PG8_SA(0, 0), bA, vA[0]); PG8_STAGE(PG8_SA(0, 1), bA, vA[1]);
    if (wr == 1) PG8_BAR;
    PG8_WAIT_V(2); PG8_BAR;
    PG8_STAGE(PG8_SB(1, 0), cB + kstepB, voffB); PG8_STAGE(PG8_SA(1, 0), bA + kstep, vA[0]); PG8_STAGE(PG8_SB(1, 1), cB + hstepB + kstepB, voffB);
    PG8_WAIT_V(6); PG8_BAR;
    for (;;) {
        const bool has_next = S.next(ui + 1, nxt);
        const char* nB = has_next ? (BKN ? (const char*)g.Bt + (size_t)nxt.e * g.bexp + (size_t)nxt.pn * tstepB : (const char*)g.Bt + (size_t)nxt.pb * tstepB) : cB;
        if (has_next) PG8_AROWS(vAn, nxt); else { vAn[0][0] = vA[0][0]; vAn[0][1] = vA[0][1]; vAn[1][0] = vA[1][0]; vAn[1][1] = vA[1][1]; }
        for (int t = 0; t < nt; t += 2) {
            const bool last = (t == nt - 2);
            const char* a1 = bA + (size_t)(t + 1) * kstep;
            const char* a2 = last ? bA : bA + (size_t)(t + 2) * kstep; const char* b2 = last ? nB : cB + (size_t)(t + 2) * kstepB;
            const char* a3 = a2 + kstep; const char* b3 = b2 + kstepB;
            unsigned w0[2], w1[2];
            w0[0] = last ? vAn[0][0] : vA[0][0]; w0[1] = last ? vAn[0][1] : vA[0][1]; w1[0] = last ? vAn[1][0] : vA[1][0]; w1[1] = last ? vAn[1][1] : vA[1][1];
            PG8_LDB(B0, 0, 0); PG8_LDB(B1, 0, 1); PG8_SCHED; PG8_LDA(At, 0, 0); PG8_STAGE(PG8_SA(1, 1), a1, vA[1]);
            PG8_WAIT_V(8); PG8_WAIT_LB(); PG8_BAR; PG8_MMA(0, 0, At, B0); PG8_MMA(0, 1, At, B1); PG8_BAR; PG8_SCHED;
            PG8_LDA(At, 0, 1); PG8_STAGE(PG8_SB(0, 0), b2, voffB); PG8_STAGE(PG8_SB(0, 1), b2 + hstepB, voffB); PG8_STAGE(PG8_SA(0, 0), a2, w0);
            PG8_WAIT_V(8); PG8_WAIT_L(0); PG8_BAR; PG8_MMA(1, 0, At, B0); PG8_MMA(1, 1, At, B1); PG8_BAR; PG8_SCHED;
            PG8_LDB(B0, 1, 0); PG8_LDB(B1, 1, 1); PG8_SCHED; PG8_LDA(At, 1, 0); PG8_STAGE(PG8_SA(0, 1), a2, w1);
            PG8_WAIT_V(8); PG8_WAIT_LB(); PG8_BAR; PG8_MMA(0, 0, At, B0); PG8_MMA(0, 1, At, B1); PG8_BAR; PG8_SCHED;
            PG8_LDA(At, 1, 1); PG8_STAGE(PG8_SB(1, 0), b3, voffB); PG8_STAGE(PG8_SB(1, 1), b3 + hstepB, voffB); PG8_STAGE(PG8_SA(1, 0), a3, w0);
            PG8_WAIT_V(8); PG8_WAIT_L(0); PG8_BAR; PG8_MMA(1, 0, At, B0); PG8_MMA(1, 1, At, B1); PG8_BAR; PG8_SCHED;
        }
        if constexpr (ALIGN_EPI) { if (wr == 0) PG8_BAR; }
        bool keep_ = false;
        { const bool pe_ = (PROBE_T == 200 && !BKN) || (PROBE_T == 201 && BKN) || (PROBE_T == 203 && BKN && g.ldb == 2048) || (PROBE_T == 204 && BKN && g.ldb == 1024) || (PROBE_T >= 210 && PROBE_T < 216 && !BKN && S.probe_id() == PROBE_T) || (PROBE_T == 216 && !BKN && S.probe_id() == 211 && cur.pn < 2) || (PROBE_T == 217 && !BKN && S.probe_id() == 211 && cur.pn >= 2) || (PROBE_T == 218 && !BKN && S.probe_id() == 211 && blockIdx.x >= 192) || (PROBE_T == 219 && !BKN && S.probe_id() == 211 && blockIdx.x < 128 && cur.pn >= 2);
          unsigned long long tpe_ = 0; if (pe_) tpe_ = __builtin_amdgcn_s_memrealtime();
          if constexpr (Sched::MID) { keep_ = S.keep(cur); if (keep_) E.mid(acc, cur, wr, wc, fr, fq); else E(acc, cur, wr, wc, fr, fq); } else E(acc, cur, wr, wc, fr, fq);
          if ((PROBE_T == 220 || (PROBE_T == 221 && wid == 0)) && !BKN && S.probe_id() == 211 && blockIdx.x >= 192) { const unsigned long long t1_ = __builtin_amdgcn_s_memrealtime(); while (__builtin_amdgcn_s_memrealtime() - t1_ < 2000ull) __builtin_amdgcn_s_sleep(8); }
          if (pe_) { const unsigned long long d_ = __builtin_amdgcn_s_memrealtime() - tpe_, t1_ = __builtin_amdgcn_s_memrealtime(); while (__builtin_amdgcn_s_memrealtime() - t1_ < (unsigned long long)PROBE_MULT * d_) __builtin_amdgcn_s_sleep(8); } } S.done(cur);
        if (!has_next) break;
        if (!keep_) {
#pragma unroll
        for (int a = 0; a < 2; ++a)
#pragma unroll
            for (int b = 0; b < 2; ++b)
#pragma unroll
                for (int m = 0; m < 4; ++m)
#pragma unroll
                    for (int n = 0; n < 2; ++n) acc[a][b][m][n] = (f32x4){0.f, 0.f, 0.f, 0.f};
        }
        cur = nxt; cB = nB; ++ui; vA[0][0] = vAn[0][0]; vA[0][1] = vAn[0][1]; vA[1][0] = vAn[1][0]; vA[1][1] = vAn[1][1];
        if constexpr (ALIGN_EPI) { if (wr == 1) PG8_BAR; }
    }
    PG8_WAIT_V(0);
    if constexpr (!ALIGN_EPI) { if (wr == 0) PG8_BAR; }
    PG8_BAR;
#undef PG8_AROWS
#undef PG8_SA
#undef PG8_SB
#undef PG8_STAGE
#undef PG8_LDA
#undef PG8_LDB
#undef PG8_WAIT_LB
#undef PG8_MMA
#undef PG8_WAIT_V
#undef PG8_WAIT_L
#undef PG8_BAR
#undef PG8_SCHED
}
}

constexpr int NB = 4, SEQ = 4096, NTOK = NB * SEQ, DM = 1024;
constexpr int NWAVES = 8, NTHR = 512;
constexpr int D_SSM = 512, NGRP = 32, NSTATE = 64, CH = 32  , NCH = SEQ / CH  , UGX_LD = 640, S5_ROWS = NB * NCH  ;
constexpr int NIN_PAD = 4608;
constexpr int NEXP = 32, TOPK_E = 4, DFF = 1024;
constexpr int NSEL = 256;
constexpr int MAX_MT = 288;
constexpr float RMS_EPS = 1e-5f;

constexpr size_t MiB = 1u << 20;
constexpr size_t WS_CTL = 0, CTL_ZERO_BYTES = 1 * MiB;
constexpr size_t WS_ROPE = 1 * MiB;
constexpr size_t WS_WIN = 2 * MiB;
constexpr size_t WS_WGLU = 11 * MiB;
constexpr size_t WS_WPS = 12 * MiB;
constexpr size_t WS_WPA = 13 * MiB;
constexpr size_t WS_WOUT = 14 * MiB;
constexpr size_t WS_MT = 16 * MiB;
constexpr size_t WS_WS = 36 * MiB;
constexpr size_t WS_A32 = 44 * MiB;
constexpr size_t WS_SBUF = 45 * MiB;
constexpr size_t WS_WI = 53 * MiB;
constexpr size_t WS_KI = 54 * MiB;
constexpr size_t WS_K = 56 * MiB;
constexpr size_t WS_V = 60 * MiB;
constexpr size_t WS_UGX = 64 * MiB;
constexpr size_t WS_Q = 84 * MiB;
constexpr size_t WS_QI = 100 * MiB;
constexpr size_t WS_GS = 132 * MiB;
constexpr size_t WS_GA = 164 * MiB;
constexpr size_t WS_XN = 196 * MiB;
constexpr size_t WS_YG = 228 * MiB;
constexpr size_t WS_YSSM = 244 * MiB;
constexpr size_t WS_YATT = 260 * MiB;
constexpr size_t WS_SEL = 276 * MiB;
constexpr size_t WS_MIXED = 284 * MiB;
constexpr size_t WS_X1 = 316 * MiB;
constexpr size_t WS_H2 = 380 * MiB;
constexpr size_t WS_TOPE = 412 * MiB;
constexpr size_t WS_TOPW = WS_TOPE + 256 * 1024;
constexpr size_t WS_TOPPOS = WS_TOPW + 256 * 1024;
constexpr size_t WS_ROWMAP = 413 * MiB;
constexpr size_t WS_WMI = 416 * MiB;
constexpr size_t WS_WMO = 544 * MiB;
constexpr size_t WS_ACT = 608 * MiB;
constexpr size_t WS_XP = 64 * MiB;
constexpr size_t WS_Y2 = 64 * MiB;
constexpr size_t WS_END = 752 * MiB;
static_assert(WS_XP + (size_t)MAX_MT * 256 * 1024 * 2 <= WS_YG, "XP overlay");
constexpr int CW_TMO = 0, CW_CODE = 1;
constexpr int CW_BAR = 4096;
constexpr int CW_ECNT = 16384;
constexpr int CW_UDONE = 16384 + 64;
constexpr int CW_YDONE = 16384 + 128;

constexpr int LDS_BYTES = 163840;
constexpr int MISC_OFF = 163840 - 2048;

#define GAS __attribute__((address_space(1)))
#define LAS __attribute__((address_space(3)))
typedef unsigned short bf16;
typedef unsigned short u16;
typedef unsigned v4u __attribute__((ext_vector_type(4)));
typedef unsigned v2u __attribute__((ext_vector_type(2)));
typedef float f32x4 __attribute__((ext_vector_type(4)));
typedef float f32x16 __attribute__((ext_vector_type(16)));
typedef short bf16x8 __attribute__((ext_vector_type(8)));
typedef GAS unsigned gu32;
#define RLX_AGENT __ATOMIC_RELAXED, __HIP_MEMORY_SCOPE_AGENT
#define LDS_WAIT() asm volatile("s_waitcnt lgkmcnt(0)" ::: "memory")
#define VM_WAIT() asm volatile("s_waitcnt vmcnt(0)" ::: "memory")
__device__ __forceinline__ unsigned f2bf(float f) { unsigned u = __builtin_bit_cast(unsigned, f); return (u + 0x7fffu + ((u >> 16) & 1u)) >> 16; }
__device__ __forceinline__ unsigned pk2(float lo, float hi) { return f2bf(lo) | (f2bf(hi) << 16); }
__device__ __forceinline__ float bf2f(unsigned b) { return __builtin_bit_cast(float, b << 16); }
__device__ __forceinline__ float bflo(unsigned w) { return __builtin_bit_cast(float, w << 16); }
__device__ __forceinline__ float bfhi(unsigned w) { return __builtin_bit_cast(float, w & 0xffff0000u); }
__device__ __forceinline__ unsigned pk_fp8x4(float a, float b, float c, float d) { unsigned w = 0; w = __builtin_amdgcn_cvt_pk_fp8_f32(a, b, w, false); w = __builtin_amdgcn_cvt_pk_fp8_f32(c, d, w, true); return w; }
__device__ __forceinline__ float sigmoidf_(float x) { return __builtin_amdgcn_rcpf(1.0f + __builtin_amdgcn_exp2f(-1.4426950408889634f * x)); }
__device__ __forceinline__ float gelu_tanh(float x) { const float u = 0.7978845608028654f * (x + 0.044715f * x * x * x); const float e = __builtin_amdgcn_exp2f(2.8853900817779268f * u); const float t = 1.0f - 2.0f * __builtin_amdgcn_rcpf(e + 1.0f); return 0.5f * x * (1.0f + t); }

#define XB_TMO      128
#define XB_XCNT(j)  (256  + 64 * (j))
#define XB_XSUB(j)  (1280 + 64 * (j))
#define XB_XGEN(j)  (2304 + 64 * (j))
#define XB_TOP      3328
#define XB_TOPGEN   3392
#define XCD_BAR_WORDS 3456
#define XB_SPIN_CAP (1u << 18)
__device__ __forceinline__ unsigned xb_ld(unsigned* p)              { return __hip_atomic_load(p, __ATOMIC_RELAXED, __HIP_MEMORY_SCOPE_AGENT); }
__device__ __forceinline__ unsigned xb_add(unsigned* p, unsigned v) { return __hip_atomic_fetch_add(p, v, __ATOMIC_RELAXED, __HIP_MEMORY_SCOPE_AGENT); }
__device__ __forceinline__ unsigned xb_xcc_id() { return (unsigned)__builtin_amdgcn_s_getreg((3 << 11) | 20) & 0xFu; }
#define XB_SPIN(cond, bar) do { unsigned _sp = 0; while (cond) { __builtin_amdgcn_s_sleep(1); \
    if ((++_sp & 255u) == 0u) { if (xb_ld(&(bar)[XB_TMO])) break; if (_sp > XB_SPIN_CAP) { atomicAdd(&(bar)[XB_TMO], 1u); break; } } } } while (0)
struct XcdBarrier { unsigned* bar; unsigned x; volatile LAS unsigned* st; };
__device__ __forceinline__ XcdBarrier xcd_barrier_post(unsigned* bar, volatile LAS unsigned* st) {
    XcdBarrier b; b.bar = bar; b.x = xb_xcc_id(); b.st = st;
    if (threadIdx.x == 0) (void)xb_add(&bar[XB_XCNT(b.x)], 1u);
    return b;
}
__device__ __forceinline__ void xcd_barrier_complete(unsigned* bar, unsigned x, unsigned& nloc, unsigned& nx) {
    const unsigned G = gridDim.x * gridDim.y * gridDim.z;
    unsigned sum, cnt, mine, sp = 0u;
    for (;;) {
        sum = 0u; cnt = 0u; mine = 0u;
#pragma unroll
        for (unsigned j = 0; j < 16; ++j) { const unsigned c = xb_ld(&bar[XB_XCNT(j)]); sum += c; cnt += (c > 0u) ? 1u : 0u; mine = (j == x) ? c : mine; }
        if (sum == G) break;
        __builtin_amdgcn_s_sleep(1);
        if ((++sp & 255u) == 0u) { if (xb_ld(&bar[XB_TMO])) break; if (sp > XB_SPIN_CAP) { atomicAdd(&bar[XB_TMO], 1u); break; } }
    }
    nloc = mine > 0u ? mine : 1u; nx = cnt > 0u ? cnt : 1u;
}
__device__ __forceinline__ void xcd_barrier(const XcdBarrier& b) {
    asm volatile("s_waitcnt vmcnt(0)" ::: "memory");
    __syncthreads();
    if (threadIdx.x == 0) {
        unsigned* bar = b.bar;
        __builtin_amdgcn_s_waitcnt(0);
        unsigned nloc = b.st[0], nx = b.st[1];
        if (nloc == 0u) { xcd_barrier_complete(bar, b.x, nloc, nx); b.st[0] = nloc; b.st[1] = nx; }
        const unsigned old = xb_add(&bar[XB_XSUB(b.x)], 1u);
        const unsigned gen = old / nloc;
        if (old + 1u == (gen + 1u) * nloc) {
            __builtin_amdgcn_fence(__ATOMIC_RELEASE, "agent");
            asm volatile("s_waitcnt vmcnt(0)" ::: "memory");
            const unsigned og = xb_add(&bar[XB_TOP], 1u);
            const unsigned tg = og / nx;
            if (og + 1u == (tg + 1u) * nx) xb_add(&bar[XB_TOPGEN], 1u);
            else XB_SPIN(xb_ld(&bar[XB_TOPGEN]) == tg, bar);
            __builtin_amdgcn_fence(__ATOMIC_ACQUIRE, "agent");
            xb_add(&bar[XB_XGEN(b.x)], 1u);
            asm volatile("s_waitcnt vmcnt(0)" ::: "memory");
        } else {
            XB_SPIN(xb_ld(&bar[XB_XGEN(b.x)]) == gen, bar);
            __builtin_amdgcn_fence(__ATOMIC_ACQUIRE, "agent");
            asm volatile("s_waitcnt vmcnt(0)" ::: "memory");
        }
    }
    __syncthreads();
}

struct Frame {
    LAS unsigned char* lds;
    volatile LAS unsigned* MISC;
    gu32* ctl;
    int tid, lane, wave, G;
    unsigned char* ws;
    const float* in[25];
    float* out;
};
enum { I_X = 0, I_N1G, I_WIN, I_BGATE, I_LRE, I_LIM, I_LOGDT, I_BRE, I_BIM, I_CRE, I_CIM, I_SD, I_WGLU, I_BGLU, I_WPS, I_WPA, I_WOUT, I_N2G, I_WR, I_BR, I_WMI, I_BMI, I_WMO, I_BMO, I_NFG };

__device__ __forceinline__ float dpp_add(float v, int ctrl_sel) {
    const int x = __builtin_bit_cast(int, v); int y;
    if (ctrl_sel == 0) y = __builtin_amdgcn_update_dpp(x, x, 0xB1, 0xF, 0xF, false);
    else if (ctrl_sel == 1) y = __builtin_amdgcn_update_dpp(x, x, 0x4E, 0xF, 0xF, false);
    else if (ctrl_sel == 2) y = __builtin_amdgcn_update_dpp(x, x, 0x141, 0xF, 0xF, false);
    else y = __builtin_amdgcn_update_dpp(x, x, 0x140, 0xF, 0xF, false);
    return v + __builtin_bit_cast(float, y);
}
__device__ __forceinline__ float wave_sum(float v) {
    v = dpp_add(v, 0); v = dpp_add(v, 1); v = dpp_add(v, 2); v = dpp_add(v, 3);
    v += __shfl_xor(v, 16); v += __shfl_xor(v, 32);
    return v;
}

__device__ __forceinline__ int ropeperm(int p) { const int a = p >> 3, bb = p & 7; return bb < 4 ? 4 * a + bb : 32 + 4 * a + (bb - 4); }
__device__ __forceinline__ int win_src(int nd) {
    const int pn = nd >> 8, j = nd & 255;
    if (pn < 2) return nd;
    if (pn < 4) { const int i = nd - 512; return 512 + (i & ~63) + ropeperm(i & 63); }
    if (pn == 4) { if (j < 128) return 1024 + (j & ~63) + ropeperm(j & 63); return 1152 + (j - 128); }
    if (pn < 9) { const int i = nd - 1280; return 1280 + (i & ~63) + ropeperm(i & 63); }
    if (pn == 9) { if (j < 64) return 2304 + ropeperm(j); if (j < 80) return 2368 + (j - 64); return -1; }
    if (pn < 14) return 2384 + (nd - 2560);
    return 3408 + (nd - 3584);
}
struct TItem { const float* src; bf16* dst; int N, K; };
__device__ __forceinline__ void titem_load(const TItem& T, float (&tv)[32], int lane) {
#pragma unroll
    for (int i = 0; i < 32; ++i) { const int kk = 2 * i + (lane >> 5); tv[i] = T.src ? __builtin_nontemporal_load(T.src + (size_t)kk * T.N) : 0.f; }
}
__device__ __forceinline__ void titem_store(const TItem& T, const float (&tv)[32], LAS float* scr, int lane) {
#pragma unroll
    for (int i = 0; i < 32; ++i) { const int kk = 2 * i + (lane >> 5); scr[kk * 33 + (lane & 31)] = tv[i]; }
    LDS_WAIT(); asm volatile("" ::: "memory");
    const int c = lane & 7;
#pragma unroll
    for (int j = 0; j < 4; ++j) { const int n = (lane >> 3) + 8 * j; const LAS float* s = scr + (8 * c) * 33 + n;
        v4u o; o.x = pk2(s[0 * 33], s[1 * 33]); o.y = pk2(s[2 * 33], s[3 * 33]); o.z = pk2(s[4 * 33], s[5 * 33]); o.w = pk2(s[6 * 33], s[7 * 33]);
        *(GAS v4u*)(T.dst + (size_t)n * T.K + 8 * c) = o; }
    LDS_WAIT(); asm volatile("" ::: "memory");
}
__device__ __forceinline__ void rms_row_to_bf16(int lane, const float* xrow, const float* g, bf16* orow) {
    const GAS f32x4* xr = (const GAS f32x4*)xrow + lane; const GAS f32x4* gr = (const GAS f32x4*)g + lane;
    f32x4 v[4]; float s2 = 0.f;
#pragma unroll
    for (int j = 0; j < 4; ++j) { v[j] = xr[64 * j]; s2 += (v[j].x * v[j].x + v[j].y * v[j].y) + (v[j].z * v[j].z + v[j].w * v[j].w); }
    const float rstd = 1.0f / sqrtf(wave_sum(s2) * (1.f / DM) + RMS_EPS);
    GAS unsigned long long* o8 = (GAS unsigned long long*)orow + lane;
#pragma unroll
    for (int j = 0; j < 4; ++j) { const f32x4 gg = gr[64 * j];
        o8[64 * j] = (unsigned long long)pk2(v[j].x * rstd * gg.x, v[j].y * rstd * gg.y) | ((unsigned long long)pk2(v[j].z * rstd * gg.z, v[j].w * rstd * gg.w) << 32); }
}
__device__ __forceinline__ void p0_s5_group(Frame& F, int g, int half) {
    LAS float* AP = (LAS float*)(F.lds);
    LAS float* BB = (LAS float*)(F.lds + 16896);
    LAS float* CC = (LAS float*)(F.lds + 25088);
    LAS float* KJ = (LAS float*)(F.lds + 33280);
    const float* lre = F.in[I_LRE] + g * 64; const float* lim = F.in[I_LIM] + g * 64;
    const double dt = exp((double)F.in[I_LOGDT][g]);
    __syncthreads();
    for (int idx = F.tid; idx < 33 * 64; idx += NTHR) { const int p = idx & 63, j = idx >> 6;
        const double lr = lre[p], li = lim[p]; const double mag = exp(j * lr * dt), ang = j * li * dt;
        AP[idx * 2] = (float)(mag * cos(ang)); AP[idx * 2 + 1] = (float)(mag * sin(ang)); }
    for (int idx = F.tid; idx < 1024; idx += NTHR) { const int p = idx >> 4;
        const double lr = lre[p], li = lim[p]; const double mag = exp(lr * dt), ang = li * dt; const double ar = mag * cos(ang), ai = mag * sin(ang);
        const double nr = ar - 1.0, ni = ai, den = lr * lr + li * li; const double zr = (nr * lr + ni * li) / den, zi = (ni * lr - nr * li) / den;
        const double br = F.in[I_BRE][g * 1024 + idx], bi = F.in[I_BIM][g * 1024 + idx];
        BB[idx * 2] = (float)(zr * br - zi * bi); BB[idx * 2 + 1] = (float)(zr * bi + zi * br); }
    for (int idx = F.tid; idx < 1024; idx += NTHR) { CC[idx * 2] = F.in[I_CRE][g * 1024 + idx]; CC[idx * 2 + 1] = F.in[I_CIM][g * 1024 + idx]; }
    __syncthreads();
    { const int j = F.tid >> 4, hp = F.tid & 15; float s[16];
#pragma unroll
      for (int h = 0; h < 16; ++h) s[h] = 0.f;
      for (int p = 0; p < 64; ++p) { const float cr = CC[(hp * 64 + p) * 2], ci = CC[(hp * 64 + p) * 2 + 1], ar = AP[(j * 64 + p) * 2], ai = AP[(j * 64 + p) * 2 + 1];
          const float er = cr * ar - ci * ai, ei = cr * ai + ci * ar;
#pragma unroll
          for (int h4 = 0; h4 < 8; ++h4) { const f32x4 bb = *(const LAS f32x4*)(BB + (p * 16 + 2 * h4) * 2); s[2 * h4] += er * bb[0] - ei * bb[1]; s[2 * h4 + 1] += er * bb[2] - ei * bb[3]; } }
#pragma unroll
      for (int h = 0; h < 16; ++h) KJ[(j * 16 + hp) * 16 + h] = s[h]; }
    __syncthreads();
    bf16* MT = (bf16*)(F.ws + WS_MT) + (size_t)g * 512 * 640;
    for (int ch = F.tid + half * NTHR; ch < 512 * 80; ch += 2 * NTHR) { const int n = ch / 80, k0 = (ch % 80) * 8, tp = n >> 4, hp = n & 15; float v[8];
        if (k0 < 512) { const int sp = k0 >> 4, h0 = k0 & 15;
#pragma unroll
            for (int j = 0; j < 8; ++j) v[j] = (sp <= tp) ? KJ[((tp - sp) * 16 + hp) * 16 + h0 + j] : 0.f; }
        else { const bool im = k0 >= 576; const int p0 = k0 - (im ? 576 : 512);
#pragma unroll
            for (int j = 0; j < 8; ++j) { const int p = p0 + j; const float cr = CC[(hp * 64 + p) * 2], ci = CC[(hp * 64 + p) * 2 + 1], ar = AP[((tp + 1) * 64 + p) * 2], ai = AP[((tp + 1) * 64 + p) * 2 + 1];
                v[j] = im ? -(cr * ai + ci * ar) : (cr * ar - ci * ai); } }
        v4u o; o.x = pk2(v[0], v[1]); o.y = pk2(v[2], v[3]); o.z = pk2(v[4], v[5]); o.w = pk2(v[6], v[7]);
        *(GAS v4u*)(MT + (size_t)n * 640 + k0) = o; }
    bf16* WS = (bf16*)(F.ws + WS_WS) + (size_t)g * 256 * 512;
    for (int ch = F.tid + half * NTHR; ch < 256 * 64; ch += 2 * NTHR) { const int n = ch >> 6, k0 = (ch & 63) * 8, sp = k0 >> 4, h0 = k0 & 15; float v[8];
#pragma unroll
        for (int j = 0; j < 8; ++j) { if (n < 128) { const int p = n & 63; const float ar = AP[((31 - sp) * 64 + p) * 2], ai = AP[((31 - sp) * 64 + p) * 2 + 1], br = BB[(p * 16 + h0 + j) * 2], bi = BB[(p * 16 + h0 + j) * 2 + 1];
                v[j] = (n < 64) ? (ar * br - ai * bi) : (ar * bi + ai * br); } else v[j] = 0.f; }
        v4u o; o.x = pk2(v[0], v[1]); o.y = pk2(v[2], v[3]); o.z = pk2(v[4], v[5]); o.w = pk2(v[6], v[7]);
        *(GAS v4u*)(WS + (size_t)n * 512 + k0) = o; }
    float* A32 = (float*)(F.ws + WS_A32) + g * 128;
    if (half == 0 && F.tid < 128) A32[F.tid] = AP[32 * 128 + F.tid];
    __syncthreads();
}
constexpr int MOE_IT_IN = NEXP * 16 * 64, MOE_IT = MOE_IT_IN + NEXP * 16 * 32, MOE_ITA = 27848, MOE_ITB = 41984;
constexpr float WSC = 32.0f, ASC = 4.0f, YSC = 8.0f, GSC = 16.0f;
__device__ __forceinline__ void moe_item(Frame& F, int it, TItem& T) {
    int e, kb, nb, N; const float* W; unsigned char* D;
    if (it < MOE_IT_IN) { e = it >> 10; kb = ((it >> 7) & 7) * 2 + (it & 1); nb = (it >> 1) & 63; N = 2048;        W = F.in[I_WMI] + (size_t)e * 1024 * 2048; D = F.ws + WS_WMI + ((size_t)e * 2048 + 32 * nb) * 1024 + 64 * kb; }
    else { const int r = it - MOE_IT_IN; e = r >> 9; kb = ((r >> 6) & 7) * 2 + (r & 1); nb = (r >> 1) & 31; N = 1024; W = F.in[I_WMO] + (size_t)e * 1024 * 1024; D = F.ws + WS_WMO + ((size_t)e * 1024 + 32 * nb) * 1024 + 64 * kb; }
    T.src = W + (size_t)(64 * kb) * N + 32 * nb + (F.lane & 31); T.dst = (bf16*)D; T.N = N; T.K = 1024;
}
__device__ __forceinline__ void titem_store8(const TItem& T, const float (&tv)[32], LAS float* scr, int lane) {
#pragma unroll
    for (int i = 0; i < 32; ++i) { const int kk = 2 * i + (lane >> 5); scr[kk * 33 + (lane & 31)] = tv[i]; }
    LDS_WAIT(); asm volatile("" ::: "memory");
    const int c = lane & 7;
#pragma unroll
    for (int j = 0; j < 4; ++j) { const int n = (lane >> 3) + 8 * j; const LAS float* s = scr + (8 * c) * 33 + n;
        v2u o; unsigned w = 0; w = __builtin_amdgcn_cvt_pk_fp8_f32(s[0 * 33] * WSC, s[1 * 33] * WSC, w, false); w = __builtin_amdgcn_cvt_pk_fp8_f32(s[2 * 33] * WSC, s[3 * 33] * WSC, w, true); o.x = w;
        w = 0; w = __builtin_amdgcn_cvt_pk_fp8_f32(s[4 * 33] * WSC, s[5 * 33] * WSC, w, false); w = __builtin_amdgcn_cvt_pk_fp8_f32(s[6 * 33] * WSC, s[7 * 33] * WSC, w, true); o.y = w;
        *(GAS v2u*)((unsigned char*)T.dst + (size_t)n * 1024 + 8 * c) = o; }
    LDS_WAIT(); asm volatile("" ::: "memory");
}
__device__ __forceinline__ void moe_convert(Frame& F, int lo, int hi, int vw0, int nvw, int vtotal) {
    LAS float* scr = (LAS float*)(F.lds + F.wave * 16384);
    const int stride = vtotal * NWAVES;
    for (int vw = 0; vw < nvw; ++vw) { float tvA[32], tvB[32]; int it = lo + (vw0 + vw) * NWAVES + F.wave;
        if (it < hi) { TItem TA; moe_item(F, it, TA); titem_load(TA, tvA, F.lane);
            for (;;) {
                const int it1 = it + stride; const bool h1 = it1 < hi; TItem TB = TA; if (h1) { moe_item(F, it1, TB); titem_load(TB, tvB, F.lane); }
                titem_store8(TA, tvA, scr, F.lane); if (!h1) break;
                const int it2 = it1 + stride; const bool h2 = it2 < hi; if (h2) { moe_item(F, it2, TA); titem_load(TA, tvA, F.lane); }
                titem_store8(TB, tvB, scr, F.lane); if (!h2) break;
                it = it2; } } }
}
__device__ __forceinline__ void p0_prologue(Frame& F) {
    const int NS5 = 2 * NGRP, NW = F.G - NS5;
    const bool s5wg = (int)blockIdx.x >= NW;
    TPROBE_BEGIN(120);
    if (s5wg) p0_s5_group(F, ((int)blockIdx.x - NW) >> 1, ((int)blockIdx.x - NW) & 1);
    TPROBE_END(120);
    const bool conv_first = !s5wg && ((F.wave >> 1) & 1);
    if (conv_first) moe_convert(F, 0, MOE_ITA, 4 * (int)blockIdx.x, 4, 4 * NW + 3 * NS5);
    TPROBE_BEGIN(121);
    if (!s5wg) {
    LAS float* scr = (LAS float*)(F.lds + F.wave * 16384);
    const int gw = blockIdx.x * NWAVES + F.wave, NGW = NW * NWAVES;
    { float* cosT = (float*)(F.ws + WS_ROPE); float* sinT = cosT + SEQ * 32;
      for (int i = blockIdx.x * NTHR + F.tid; i < SEQ * 32; i += NW * NTHR) { const int pos = i >> 5, k = i & 31;
          const double inv = exp(-(double)k * (9.210340371976184 / 32.0))  ; const double ang = (double)pos * (double)(float)inv;
          cosT[i] = (float)cos(ang); sinT[i] = (float)sin(ang); } }
    { const int lane = F.lane; f32x4 gg[4], va[4], vb[4];
#pragma unroll
      for (int j = 0; j < 4; ++j) gg[j] = ((const GAS f32x4*)F.in[I_N1G] + lane)[64 * j];
#define XN_LOAD(V, m_) do { _Pragma("unroll") for (int j = 0; j < 4; ++j) V[j] = ((const GAS f32x4*)(F.in[I_X] + (size_t)(m_) * DM) + lane)[64 * j]; } while (0)
#define XN_DO(V, m_) do { float s2 = 0.f; _Pragma("unroll") for (int j = 0; j < 4; ++j) s2 += (V[j].x * V[j].x + V[j].y * V[j].y) + (V[j].z * V[j].z + V[j].w * V[j].w); \
        const float rstd = 1.0f / sqrtf(wave_sum(s2) * (1.f / DM) + RMS_EPS); GAS unsigned* o4 = (GAS unsigned*)(F.ws + WS_XN + (size_t)(m_) * DM) + lane; \
        _Pragma("unroll") for (int j = 0; j < 4; ++j) o4[64 * j] = pk_fp8x4(V[j].x * rstd * gg[j].x, V[j].y * rstd * gg[j].y, V[j].z * rstd * gg[j].z, V[j].w * rstd * gg[j].w); } while (0)
      int m = gw; if (m < NTOK) XN_LOAD(va, m);
      for (; m < NTOK; m += 2 * NGW) { const int m1 = m + NGW, m2 = m1 + NGW;
          asm volatile("" ::: "memory"); if (m1 < NTOK) XN_LOAD(vb, m1); asm volatile("" ::: "memory");
          XN_DO(va, m);
          asm volatile("" ::: "memory"); if (m2 < NTOK) XN_LOAD(va, m2); asm volatile("" ::: "memory");
          if (m1 < NTOK) XN_DO(vb, m1); }
#undef XN_LOAD
#undef XN_DO
    }
    constexpr int I_IN = 16 * (NIN_PAD / 32), I_GLU = 8 * 16, I_PS = 8 * 32, I_PA = 8 * 32, I_OUT = 16 * 32;
    constexpr int NITEMS = I_IN + I_GLU + I_PS + I_PA + I_OUT;
    auto decode = [&](int it) -> TItem {
        int r = it; const float* W; bf16* WT; int K, N, ndb, map = 0;
        if (r < I_IN) { W = F.in[I_WIN]; K = DM; N = 4432; WT = (bf16*)(F.ws + WS_WIN); ndb = NIN_PAD / 32; map = 1; }
        else if ((r -= I_IN) < I_GLU) { W = F.in[I_WGLU]; K = 512; N = 512; WT = (bf16*)(F.ws + WS_WGLU); ndb = 16; }
        else if ((r -= I_GLU) < I_PS) { W = F.in[I_WPS]; K = 512; N = 1024; WT = (bf16*)(F.ws + WS_WPS); ndb = 32; }
        else if ((r -= I_PS) < I_PA) { W = F.in[I_WPA]; K = 512; N = 1024; WT = (bf16*)(F.ws + WS_WPA); ndb = 32; }
        else { r -= I_PA; W = F.in[I_WOUT]; K = 1024; N = 1024; WT = (bf16*)(F.ws + WS_WOUT); ndb = 32; }
        const int kb = r / ndb, nb = r % ndb, k0 = 64 * kb, n0 = 32 * nb; int sc = n0 + (F.lane & 31); if (map) sc = win_src(sc);
        TItem T; T.src = (sc >= 0) ? W + (size_t)k0 * N + sc : nullptr; T.dst = (it < I_IN) ? (bf16*)((unsigned char*)WT + (size_t)n0 * 1024 + k0) : WT + (size_t)n0 * K + k0; T.N = N; T.K = K; return T; };
    { float tvA[32], tvB[32]; int it = gw;
      if (it < NITEMS) { TItem TA = decode(it); titem_load(TA, tvA, F.lane);
        for (;;) {
            const int it1 = it + NGW; const bool h1 = it1 < NITEMS; TItem TB = TA; if (h1) { TB = decode(it1); titem_load(TB, tvB, F.lane); }
            if (it < I_IN) titem_store8(TA, tvA, scr, F.lane); else titem_store(TA, tvA, scr, F.lane); if (!h1) break;
            const int it2 = it1 + NGW; const bool h2 = it2 < NITEMS; if (h2) { TA = decode(it2); titem_load(TA, tvA, F.lane); }
            if (it1 < I_IN) titem_store8(TB, tvB, scr, F.lane); else titem_store(TB, tvB, scr, F.lane); if (!h2) break;
            it = it2; } } }
    }
    TPROBE_END(121);
    TPROBE_BEGIN(122);
    if (!conv_first) moe_convert(F, 0, MOE_ITA, s5wg ? 4 * NW + 3 * ((int)blockIdx.x - NW) : 4 * (int)blockIdx.x, s5wg ? 3 : 4, 4 * NW + 3 * NS5);
    TPROBE_END(122);
}

struct StaticOrder {
    int nM, nN, nwg, G, c;
    __device__ void init(int nM_, int nN_, int G_, int c_) { nM = nM_; nN = nN_; nwg = nM * nN; G = G_; c = c_; }
    __device__ bool tile(int i, int& pm, int& pn) const {
        const long L = (long)i * G + c; if (L >= nwg) return false;
        int wgid = (int)L; { const int q = nwg / pg8::NXCD, r = nwg % pg8::NXCD, xcd = wgid % pg8::NXCD, off = wgid / pg8::NXCD; wgid = (xcd < r ? xcd * (q + 1) : r * (q + 1) + (xcd - r) * q) + off; }
        const int nig = pg8::WGM * nN, gid = wgid / nig, fm = gid * pg8::WGM, gsz = (nM - fm) < pg8::WGM ? (nM - fm) : pg8::WGM;
        pm = fm + ((wgid % nig) % gsz); pn = (wgid % nig) / gsz; return true;
    }
    __device__ bool next(int i, pg8::Unit& u) const { int pm, pn; if (!tile(i, pm, pn)) return false; u.pm = pm; u.pn = pn; u.pa = pm; u.pb = pn; u.e = 0; return true; }
    __device__ __forceinline__ int arow(const pg8::Unit& u, int h, int R) const { return u.pa * 256 + h * 128 + R; }
    __device__ __forceinline__ void done(const pg8::Unit&) const {}
    __device__ __forceinline__ int probe_id() const { return 210; }
    static constexpr bool MID = false;
};
__device__ __forceinline__ void wg_wait_ge(Frame& F, int word, unsigned target) {
    if (F.tid == 0) { unsigned sp = 0;
        while (__hip_atomic_load((unsigned*)(F.ctl + word), RLX_AGENT) < target) { __builtin_amdgcn_s_sleep(2); if (++sp > (1u << 22)) { __hip_atomic_store((unsigned*)(F.ctl + CW_TMO), 1u, RLX_AGENT); break; } }
        __builtin_amdgcn_fence(__ATOMIC_ACQUIRE, "agent"); asm volatile("s_waitcnt vmcnt(0)" ::: "memory"); }
    __syncthreads();
}
__device__ __forceinline__ void wg_signal(Frame& F, int word) {
    asm volatile("s_waitcnt vmcnt(0)" ::: "memory"); __syncthreads();
    if (F.tid == 0) { __builtin_amdgcn_fence(__ATOMIC_RELEASE, "agent"); asm volatile("s_waitcnt vmcnt(0)" ::: "memory"); (void)__hip_atomic_fetch_add((unsigned*)(F.ctl + word), 1u, RLX_AGENT); }
}
struct InProjOrder {
    int G, c; unsigned* udone;
    __device__ bool next(int i, pg8::Unit& u) const { const int L = i * G + c; if (L >= 64 * (NIN_PAD / 256)) return false; u.pm = L & 63; u.pn = L >> 6; u.pa = u.pm; u.pb = u.pn; u.e = 0; return true; }
    __device__ __forceinline__ int arow(const pg8::Unit& u, int h, int R) const { return u.pa * 256 + h * 128 + R; }
    __device__ __forceinline__ void done(const pg8::Unit& u) const {
        if (u.pn < 2) { asm volatile("s_waitcnt vmcnt(0)" ::: "memory");
            if ((threadIdx.x & 63) == 0) (void)__hip_atomic_fetch_add(udone, 1u, RLX_AGENT); } }
    __device__ __forceinline__ int probe_id() const { return 211; }
    static constexpr bool MID = false;
};
struct S5StateOrder {
    int c;
    __device__ bool next(int i, pg8::Unit& u) const { if (i > 0 || c >= 64) return false; const int g = c >> 1, pm = c & 1; u.pm = pm; u.pn = 0; u.pa = g * 2 + pm; u.pb = g; u.e = g; return true; }
    __device__ __forceinline__ int arow(const pg8::Unit& u, int h, int R) const { return u.pa * 256 + h * 128 + R; }
    __device__ __forceinline__ void done(const pg8::Unit&) const {}
    __device__ __forceinline__ int probe_id() const { return 212; }
    static constexpr bool MID = false;
};
struct S5YOrder {
    int c;
    __device__ bool next(int i, pg8::Unit& u) const { if (i > 0 || c >= 128) return false; const int g = c >> 2, pm = (c >> 1) & 1, pn = c & 1; u.pm = pm; u.pn = pn; u.pa = g * 2 + pm; u.pb = g * 2 + pn; u.e = g; return true; }
    __device__ __forceinline__ int arow(const pg8::Unit& u, int h, int R) const { return u.pa * 256 + h * 128 + R; }
    __device__ __forceinline__ void done(const pg8::Unit&) const {}
    __device__ __forceinline__ int probe_id() const { return 213; }
    static constexpr bool MID = false;
};
struct MixOrder {
    StaticOrder so;
    __device__ bool next(int i, pg8::Unit& u) const { int pm, pn; if (!so.tile(i >> 1, pm, pn)) return false; const int h = i & 1; u.pm = pm; u.pn = pn; u.pa = pm + 64 * h; u.pb = pn + 4 * h; u.e = h; return true; }
    __device__ __forceinline__ int arow(const pg8::Unit& u, int h, int R) const { return u.pa * 256 + h * 128 + R; }
    __device__ __forceinline__ void done(const pg8::Unit&) const {}
    __device__ __forceinline__ int probe_id() const { return 214; }
    static constexpr bool MID = true;
    __device__ __forceinline__ bool keep(const pg8::Unit& u) const { return u.e == 0; }
};
struct MoeOrder {
    const volatile LAS int* te; const volatile LAS int* off; const volatile LAS int* cnt; const int* rowmap; int TT, NTN, c, mode;
    __device__ bool next(int i, pg8::Unit& u) const {
        const int xcd = c & 7, j = c >> 3, mpx = 32 / NTN; int mt = i * (8 * mpx) + xcd * mpx + j / NTN; const int pn = j % NTN;
        if (mode == 1) { if (i > 0) return false; mt += 256; }
        if (mt >= TT) return false; const int e = te[mt];
        if (mode == 1 && e < 18) return false;
        if (mode == 2 && mt >= 256 && e >= 18) return false;
        u.pm = mt; u.pn = pn; u.pa = mt; u.pb = e * NTN + pn; u.e = e; return true; }
    __device__ __forceinline__ int arow(const pg8::Unit& u, int h, int R) const {
        if (!rowmap) return u.pa * 256 + h * 128 + R;
        const int lr = u.pm * 256 - off[u.e] + h * 128 + R;
        return lr < cnt[u.e] ? rowmap[(size_t)u.e * NTOK + lr] : 0; }
    __device__ __forceinline__ void done(const pg8::Unit&) const {}
    __device__ __forceinline__ int probe_id() const { return 215; }
    static constexpr bool MID = false;
};

using pg8::f32x2; using pg8::u32x2; using pg8::pack8; using pg8::cvt_pk_bf16;
#define EPI_ROWS_BEGIN _Pragma("unroll") for (int ai = 0; ai < 2; ++ai) _Pragma("unroll") for (int m = 0; m < 4; ++m) { asm volatile("" ::: "memory"); const int row = u.pm * 256 + ai * 128 + wr * 64 + m * 16 + fr; (void)row;
#define EPI_COLS_BEGIN _Pragma("unroll") for (int bj = 0; bj < 2; ++bj) { const int ct = bj * 128 + wc * 32 + fq * 8; (void)ct; f32x4 v0 = acc[ai][bj][m][0], v1 = acc[ai][bj][m][1];
#define EPI_END } }
#define EPI_FENCE asm volatile("" ::: "memory")
#define EPI_ALLROWS _Pragma("unroll") for (int ai = 0; ai < 2; ++ai) _Pragma("unroll") for (int m = 0; m < 4; ++m)
#define EPI_ROW(ai, m) (u.pm * 256 + (ai) * 128 + wr * 64 + (m) * 16 + fr)
struct EpiInProj {
    static constexpr bool PERM = true;
    unsigned char* ws; const float* bgate;
    __device__ __forceinline__ void rope(f32x4& v0, f32x4& v1, const f32x4& c, const f32x4& s) const { const f32x4 o1 = v0 * c - v1 * s, o2 = v1 * c + v0 * s; v0 = o1; v1 = o2; }
    __device__ __forceinline__ unsigned pk8(const f32x4& v) const { unsigned w = 0; w = __builtin_amdgcn_cvt_pk_fp8_f32(v[0], v[1], w, false); w = __builtin_amdgcn_cvt_pk_fp8_f32(v[2], v[3], w, true); return w; }
    __device__ __forceinline__ void store_rope8(unsigned off, const f32x4& o1, const f32x4& o2) const { *(GAS unsigned*)(ws + off) = pk8(o1); *(GAS unsigned*)(ws + off + 32u) = pk8(o2); }
    __device__ __forceinline__ void store_rope(unsigned off, const f32x4& o1, const f32x4& o2) const {
        u32x2 a, b; a.x = cvt_pk_bf16(o1[0], o1[1]); a.y = cvt_pk_bf16(o1[2], o1[3]); b.x = cvt_pk_bf16(o2[0], o2[1]); b.y = cvt_pk_bf16(o2[2], o2[3]);
        *(GAS u32x2*)(ws + off) = a; *(GAS u32x2*)(ws + off + 64u) = b;
    }
    __device__ __forceinline__ void operator()(const f32x4 (&acc)[2][2][4][2], const pg8::Unit& u, int wr, int wc, int fr, int fq) const {
        asm volatile("" : "+v"(fr), "+v"(fq));
        const int pn = u.pn;
        f32x4 rc[2][4], rs[2][4];
        if (pn >= 2 && pn <= 9) { const int a = (wc & 1) * 4 + fq;
            EPI_ALLROWS { const unsigned o = (unsigned)WS_ROPE + (unsigned)((EPI_ROW(ai, m) & 4095) * 32 + 4 * a) * 4u; rc[ai][m] = *(const GAS f32x4*)(ws + o); rs[ai][m] = *(const GAS f32x4*)(ws + o + (unsigned)(SEQ * 32 * 4)); }
            EPI_FENCE; }
        if (pn < 2) {
            EPI_ROWS_BEGIN const int bb = row >> 12, cc = (row >> 5) & 127, sp = row & 31;
            EPI_COLS_BEGIN v0 *= (1.0f / WSC); v1 *= (1.0f / WSC); const int col = pn * 256 + ct, g = col >> 4, h0 = col & 15;
                { const unsigned uo_ = (unsigned)WS_UGX + (unsigned)((g * 512 + bb * 128 + cc) * UGX_LD + sp * 16 + h0) * 2u; const pg8::u32x4 ud_ = pack8(v0, v1);
                  asm volatile("global_store_dwordx4 %0, %1, %2 sc0 sc1\n\ts_nop 1" :: "v"(uo_), "v"(ud_), "s"(ws) : "memory"); }
            EPI_END
        } else if (pn < 4) {
            EPI_ROWS_BEGIN
            EPI_COLS_BEGIN v0 *= (1.0f / WSC); v1 *= (1.0f / WSC); const int j = (pn - 2) * 256 + ct, head = j >> 6, a = (j & 63) >> 3;
                rope(v0, v1, rc[ai][m], rs[ai][m]); store_rope8((unsigned)WS_Q + (unsigned)(row * 512 + head * 64 + 4 * a), v0, v1);
            EPI_END
        } else if (pn == 4) {
            EPI_ROWS_BEGIN
            EPI_COLS_BEGIN v0 *= (1.0f / WSC); v1 *= (1.0f / WSC);
                if (bj == 0) { const int head = ct >> 6, a = (ct & 63) >> 3; rope(v0, v1, rc[ai][m], rs[ai][m]); store_rope8((unsigned)WS_K + (unsigned)(row * 128 + head * 64 + 4 * a), v0, v1); }
                else { u32x2 w8; w8.x = pk8(v0); w8.y = pk8(v1); *(GAS u32x2*)(ws + ((unsigned)WS_V + (unsigned)(row * 128 + (ct - 128)))) = w8; }
            EPI_END
        } else if (pn < 9) {
            EPI_ROWS_BEGIN
            EPI_COLS_BEGIN v0 *= (1.0f / WSC); v1 *= (1.0f / WSC); const int j = (pn - 5) * 256 + ct, head = j >> 6, a = (j & 63) >> 3;
                rope(v0, v1, rc[ai][m], rs[ai][m]); store_rope((unsigned)WS_QI + (unsigned)(row * 1024 + head * 64 + 4 * a) * 2u, v0, v1);
            EPI_END
        } else if (pn == 9) {
            EPI_ROWS_BEGIN
            EPI_COLS_BEGIN v0 *= (1.0f / WSC); v1 *= (1.0f / WSC);
                if (bj == 0) { if (ct < 64) { const int a = ct >> 3; rope(v0, v1, rc[ai][m], rs[ai][m]); store_rope((unsigned)WS_KI + (unsigned)(row * 64 + 4 * a) * 2u, v0, v1); }
                    else if (ct < 80) { const unsigned o = (unsigned)WS_WI + (unsigned)(row * 16 + (ct - 64)) * 4u; *(GAS f32x4*)(ws + o) = v0 * 0.03125f; *(GAS f32x4*)(ws + o + 16u) = v1 * 0.03125f; } }
            EPI_END
        } else {
            const int br = pn >= 14; const unsigned gbase = br ? (unsigned)WS_GA : (unsigned)WS_GS; const float* bgp = bgate + br * 1024 + (pn - (br ? 14 : 10)) * 256 + wc * 32 + fq * 8;
            f32x4 bb[2][2];
#pragma unroll
            for (int bj = 0; bj < 2; ++bj) { bb[bj][0] = *(const GAS f32x4*)(bgp + bj * 128); bb[bj][1] = *(const GAS f32x4*)(bgp + bj * 128 + 4); }
            EPI_ROWS_BEGIN
            EPI_COLS_BEGIN v0 *= (1.0f / WSC); v1 *= (1.0f / WSC); const int col = (pn - (br ? 14 : 10)) * 256 + ct;
#pragma unroll
                for (int j = 0; j < 4; ++j) { v0[j] = (v0[j] + bb[bj][0][j]) * GSC; v1[j] = (v1[j] + bb[bj][1][j]) * GSC; }
                { v2u w8; w8.x = pk_fp8x4(v0[0], v0[1], v0[2], v0[3]); w8.y = pk_fp8x4(v1[0], v1[1], v1[2], v1[3]); *(GAS v2u*)(ws + (gbase + (unsigned)(row * 1024 + col))) = w8; }
            EPI_END
        }
    }
};
struct EpiS5State {
    static constexpr bool PERM = true;
    float* SB;
    __device__ __forceinline__ void operator()(const f32x4 (&acc)[2][2][4][2], const pg8::Unit& u, int wr, int wc, int fr, int fq) const {
        EPI_ROWS_BEGIN
        EPI_COLS_BEGIN
            if (bj == 0) { float* d = SB + ((size_t)u.e * 512 + row) * 128 + ct; *(GAS f32x4*)d = v0; *(GAS f32x4*)(d + 4) = v1; }
        EPI_END
    }
};
struct EpiS5Y {
    static constexpr bool PERM = true;
    const bf16* UGX; const float* Dsk; bf16* YG;
    __device__ __forceinline__ void operator()(const f32x4 (&acc)[2][2][4][2], const pg8::Unit& u, int wr, int wc, int fr, int fq) const {
        const int g = u.e;
        const f32x4 d0 = *(const GAS f32x4*)(Dsk + g * 16 + ((fq * 8) & 15)), d1 = *(const GAS f32x4*)(Dsk + g * 16 + ((fq * 8) & 15) + 4);
        v4u ux[2][4][2];
        EPI_ALLROWS {
#pragma unroll
            for (int bj = 0; bj < 2; ++bj) ux[ai][m][bj] = *(const GAS v4u*)(UGX + ((size_t)g * 512 + EPI_ROW(ai, m)) * UGX_LD + u.pn * 256 + bj * 128 + wc * 32 + fq * 8); }
        EPI_FENCE;
        EPI_ROWS_BEGIN const int bb = row >> 7, cc = row & 127;
        EPI_COLS_BEGIN const int n = u.pn * 256 + ct, tp = n >> 4, h0 = n & 15;
            const v4u uu = ux[ai][m][bj];
            v0[0] += d0[0] * bflo(uu.x); v0[1] += d0[1] * bfhi(uu.x); v0[2] += d0[2] * bflo(uu.y); v0[3] += d0[3] * bfhi(uu.y);
            v1[0] += d1[0] * bflo(uu.z); v1[1] += d1[1] * bfhi(uu.z); v1[2] += d1[2] * bflo(uu.w); v1[3] += d1[3] * bfhi(uu.w);
#pragma unroll
            for (int j = 0; j < 4; ++j) { v0[j] = gelu_tanh(v0[j]); v1[j] = gelu_tanh(v1[j]); }
            const int tok = bb * 4096 + cc * 32 + tp;
            *(GAS v4u*)(YG + (size_t)tok * 512 + g * 16 + h0) = pack8(v0, v1);
        EPI_END
    }
};
struct EpiGlu {
    static constexpr bool PERM = true;
    const bf16* YG; const float* bglu; bf16* YS;
    __device__ __forceinline__ void operator()(const f32x4 (&acc)[2][2][4][2], const pg8::Unit& u, int wr, int wc, int fr, int fq) const {
        f32x4 bb[2][2]; v4u yx[2][4][2];
#pragma unroll
        for (int bj = 0; bj < 2; ++bj) { const float* bp = bglu + u.pn * 256 + bj * 128 + wc * 32 + fq * 8; bb[bj][0] = *(const GAS f32x4*)bp; bb[bj][1] = *(const GAS f32x4*)(bp + 4); }
        EPI_ALLROWS {
#pragma unroll
            for (int bj = 0; bj < 2; ++bj) yx[ai][m][bj] = *(const GAS v4u*)(YG + (size_t)EPI_ROW(ai, m) * 512 + u.pn * 256 + bj * 128 + wc * 32 + fq * 8); }
        EPI_FENCE;
        EPI_ROWS_BEGIN
        EPI_COLS_BEGIN const int col = u.pn * 256 + ct;
            const v4u yy = yx[ai][m][bj];
            const f32x4 b0 = bb[bj][0], b1 = bb[bj][1];
            v0[0] = bflo(yy.x) * sigmoidf_(v0[0] + b0[0]); v0[1] = bfhi(yy.x) * sigmoidf_(v0[1] + b0[1]); v0[2] = bflo(yy.y) * sigmoidf_(v0[2] + b0[2]); v0[3] = bfhi(yy.y) * sigmoidf_(v0[3] + b0[3]);
            v1[0] = bflo(yy.z) * sigmoidf_(v1[0] + b1[0]); v1[1] = bfhi(yy.z) * sigmoidf_(v1[1] + b1[1]); v1[2] = bflo(yy.w) * sigmoidf_(v1[2] + b1[2]); v1[3] = bfhi(yy.w) * sigmoidf_(v1[3] + b1[3]);
            *(GAS v4u*)(YS + (size_t)row * 512 + col) = pack8(v0, v1);
        EPI_END
    }
};
struct EpiMix {
    static constexpr bool PERM = true;
    const unsigned char* GS; const unsigned char* GA; bf16* MX;
    static __device__ __forceinline__ void dec8(const v2u w, float (&e)[8]) {
        const f32x2 a = __builtin_amdgcn_cvt_pk_f32_fp8(w.x, false), b = __builtin_amdgcn_cvt_pk_f32_fp8(w.x, true), c = __builtin_amdgcn_cvt_pk_f32_fp8(w.y, false), d = __builtin_amdgcn_cvt_pk_f32_fp8(w.y, true);
        constexpr float K = -1.4426950408889634f / GSC;
        e[0] = __builtin_amdgcn_exp2f(a[0] * K); e[1] = __builtin_amdgcn_exp2f(a[1] * K); e[2] = __builtin_amdgcn_exp2f(b[0] * K); e[3] = __builtin_amdgcn_exp2f(b[1] * K);
        e[4] = __builtin_amdgcn_exp2f(c[0] * K); e[5] = __builtin_amdgcn_exp2f(c[1] * K); e[6] = __builtin_amdgcn_exp2f(d[0] * K); e[7] = __builtin_amdgcn_exp2f(d[1] * K); }
    __device__ __forceinline__ void mid(f32x4 (&acc)[2][2][4][2], const pg8::Unit& u, int wr, int wc, int fr, int fq) const {
        v2u gs[2][4][2], ga[2][4][2];
        EPI_ALLROWS {
#pragma unroll
            for (int bj = 0; bj < 2; ++bj) { const size_t off = (size_t)EPI_ROW(ai, m) * 1024 + u.pn * 256 + bj * 128 + wc * 32 + fq * 8; gs[ai][m][bj] = *(const GAS v2u*)(GS + off); ga[ai][m][bj] = *(const GAS v2u*)(GA + off); } }
        EPI_FENCE;
        EPI_ALLROWS {
#pragma unroll
            for (int bj = 0; bj < 2; ++bj) { float es[8], ea[8]; dec8(gs[ai][m][bj], es); dec8(ga[ai][m][bj], ea); f32x4& v0 = acc[ai][bj][m][0]; f32x4& v1 = acc[ai][bj][m][1];
#pragma unroll
                for (int j = 0; j < 4; ++j) { v0[j] *= (1.0f + ea[j]) * __builtin_amdgcn_rcpf(1.0f + es[j]); v1[j] *= (1.0f + ea[4 + j]) * __builtin_amdgcn_rcpf(1.0f + es[4 + j]); } } }
    }
    __device__ __forceinline__ void operator()(const f32x4 (&acc)[2][2][4][2], const pg8::Unit& u, int wr, int wc, int fr, int fq) const {
        v2u ga[2][4][2];
        EPI_ALLROWS {
#pragma unroll
            for (int bj = 0; bj < 2; ++bj) ga[ai][m][bj] = *(const GAS v2u*)(GA + (size_t)EPI_ROW(ai, m) * 1024 + u.pn * 256 + bj * 128 + wc * 32 + fq * 8); }
        EPI_FENCE;
        EPI_ROWS_BEGIN
        EPI_COLS_BEGIN const size_t off = (size_t)row * 1024 + u.pn * 256 + ct; float ea[8]; dec8(ga[ai][m][bj], ea);
#pragma unroll
            for (int j = 0; j < 4; ++j) { v0[j] *= __builtin_amdgcn_rcpf(1.0f + ea[j]); v1[j] *= __builtin_amdgcn_rcpf(1.0f + ea[4 + j]); }
            *(GAS v4u*)(MX + off) = pack8(v0, v1);
        EPI_END
    }
};
struct EpiOut {
    static constexpr bool PERM = true;
    const float* X; bf16* X1;
    __device__ __forceinline__ void operator()(const f32x4 (&acc)[2][2][4][2], const pg8::Unit& u, int wr, int wc, int fr, int fq) const {
        f32x4 xr[4][2][2];
#pragma unroll
        for (int m = 0; m < 4; ++m)
#pragma unroll
            for (int bj = 0; bj < 2; ++bj) { const float* xp = X + (size_t)EPI_ROW(0, m) * 1024 + u.pn * 256 + bj * 128 + wc * 32 + fq * 8; xr[m][bj][0] = *(const GAS f32x4*)xp; xr[m][bj][1] = *(const GAS f32x4*)(xp + 4); }
        EPI_FENCE;
        EPI_ROWS_BEGIN
        EPI_COLS_BEGIN const size_t off = (size_t)row * 1024 + u.pn * 256 + ct;
            *(GAS v4u*)(X1 + off) = pack8(v0 + xr[m][bj][0], v1 + xr[m][bj][1]);
            if (ai == 0) { const float* xp = X + off + (size_t)128 * 1024; xr[m][bj][0] = *(const GAS f32x4*)xp; xr[m][bj][1] = *(const GAS f32x4*)(xp + 4); }
        EPI_END
    }
};
struct EpiMoe1 {
    static constexpr bool PERM = true;
    const float* bmi; unsigned char* ACT;
    __device__ __forceinline__ void operator()(const f32x4 (&acc)[2][2][4][2], const pg8::Unit& u, int wr, int wc, int fr, int fq) const {
        const float* bp = bmi + (size_t)u.e * 2048 + u.pn * 256 + wc * 32 + fq * 8;
        f32x4 bb[2][2];
#pragma unroll
        for (int bj = 0; bj < 2; ++bj) { bb[bj][0] = *(const GAS f32x4*)(bp + bj * 128); bb[bj][1] = *(const GAS f32x4*)(bp + bj * 128 + 4); }
        EPI_ROWS_BEGIN
        EPI_COLS_BEGIN const int col = u.pn * 256 + ct;
            v0 = v0 * (1.0f / WSC) + bb[bj][0]; v1 = v1 * (1.0f / WSC) + bb[bj][1]; float o[4];
#pragma unroll
            for (int j = 0; j < 4; ++j) { const float zg0 = (j < 2) ? v0[2 * j] : v1[2 * j - 4], zl0 = (j < 2) ? v0[2 * j + 1] : v1[2 * j - 3];
                const float zg = fminf(zg0, 7.0f), zl = fminf(fmaxf(zl0, -7.0f), 7.0f); o[j] = zg * __builtin_amdgcn_rcpf(1.0f + __builtin_amdgcn_exp2f(-2.4554669595930157f * zg)) * (zl * ASC + ASC); }
            *(GAS unsigned*)(ACT + (size_t)row * 1024 + (col >> 1)) = pk_fp8x4(o[0], o[1], o[2], o[3]);
        EPI_END
    }
};
struct EpiMoe2 {
    static constexpr bool PERM = true;
    const float* bmo; unsigned char* Y2;
    __device__ __forceinline__ void operator()(const f32x4 (&acc)[2][2][4][2], const pg8::Unit& u, int wr, int wc, int fr, int fq) const {
        const float* bp = bmo + (size_t)u.e * 1024 + u.pn * 256 + wc * 32 + fq * 8;
        f32x4 bb[2][2];
#pragma unroll
        for (int bj = 0; bj < 2; ++bj) { bb[bj][0] = *(const GAS f32x4*)(bp + bj * 128); bb[bj][1] = *(const GAS f32x4*)(bp + bj * 128 + 4); }
        EPI_ROWS_BEGIN
        EPI_COLS_BEGIN const int col = u.pn * 256 + ct;
            v0 = v0 * (1.0f / (WSC * ASC)) + bb[bj][0]; v1 = v1 * (1.0f / (WSC * ASC)) + bb[bj][1];
            v0 *= YSC; v1 *= YSC; v2u w8; w8.x = pk_fp8x4(v0[0], v0[1], v0[2], v0[3]); w8.y = pk_fp8x4(v1[0], v1[1], v1[2], v1[3]);
            *(GAS v2u*)(Y2 + (size_t)row * 1024 + col) = w8;
        EPI_END
    }
};

__device__ __forceinline__ unsigned f16key(unsigned bits) { return (bits & 0x8000u) ? (bits ^ 0xffffu) : (bits | 0x8000u); }
__device__ __forceinline__ void idx_phase(Frame& F) {
    LAS unsigned char* lds = F.lds;
    LAS u16* SC = (LAS u16*)lds;
    LAS unsigned char* KT = lds + 65536;
    LAS unsigned* HP = (LAS unsigned*)(lds + 147456);
    LAS unsigned char* OLB = lds + 147456 + 4096;
    const bf16* QI = (const bf16*)(F.ws + WS_QI); const bf16* KI = (const bf16*)(F.ws + WS_KI); const float* WI = (const float*)(F.ws + WS_WI);
    u16* SEL = (u16*)(F.ws + WS_SEL);
    const int tid = F.tid, lane = F.lane, wave = F.wave, qg = wave & 1, kq = wave >> 1, kgrp = lane >> 4, l15 = lane & 15;
    const int kx = l15 >> 1, cpos = lane & 7;
    const int dsw = ((wave & 1) * 4 + (lane >> 4)) & 7;
    bf16x8 qa[4][2]; float w[16];
#define IDX_UNIT(r_, b_, t0_) const int b_ = (r_) >> 1, t0_ = (((r_) & 1) ? 511 - (int)blockIdx.x : (int)blockIdx.x) * 8
#define IDX_DMA(kb_, st, bufi) do { _Pragma("unroll") for (int j_ = 0; j_ < 2; ++j_) { const int row_ = (j_ * 8 + wave) * 8 + (lane >> 3); \
        __builtin_amdgcn_global_load_lds((const unsigned*)((kb_) + ((size_t)(st) * 128 + row_) * 64 + ((cpos ^ dsw) << 3)), (LAS unsigned*)(KT + (bufi) * 16384 + (j_ * 8 + wave) * 1024), 16, 0, 0); } } while (0)
#define IDX_PREFETCH(r_) do { IDX_UNIT(r_, pb_, pt0_); if (pt0_ >= 256) { \
        const bf16* qp_ = QI + ((size_t)pb_ * SEQ + pt0_ + 4 * qg + (l15 >> 2)) * 1024 + (l15 & 3) * 64 + kgrp * 8; \
        _Pragma("unroll") for (int i = 0; i < 4; ++i) _Pragma("unroll") for (int ks = 0; ks < 2; ++ks) qa[i][ks] = *(const GAS bf16x8*)(qp_ + i * 256 + ks * 32); \
        const float* wp_ = WI + ((size_t)pb_ * SEQ + pt0_ + 4 * qg + kgrp) * 16; \
        _Pragma("unroll") for (int i = 0; i < 4; ++i) { const f32x4 x = *(const GAS f32x4*)(wp_ + 4 * i); w[4 * i] = x[0]; w[4 * i + 1] = x[1]; w[4 * i + 2] = x[2]; w[4 * i + 3] = x[3]; } \
        const bf16* pk_ = KI + (size_t)pb_ * SEQ * 64; const int pn_ = (pt0_ + 7) / 128 + 1; \
        IDX_DMA(pk_, 0, 0); if (1 < pn_) IDX_DMA(pk_, 1, 1); if (2 < pn_) IDX_DMA(pk_, 2, 2); if (3 < pn_) IDX_DMA(pk_, 3, 3); } } while (0)
    IDX_PREFETCH(0);
    for (int r = 0; r < 8; ++r) {
        IDX_UNIT(r, b, t0);
        __syncthreads();
        const int t = t0 + wave; const size_t tok = (size_t)b * SEQ + t;
        if (t0 < 256) {
            v2u x; const int k0 = lane * 4;
            x.x = (unsigned)(k0 <= t ? k0 : 0) | ((unsigned)(k0 + 1 <= t ? k0 + 1 : 0) << 16); x.y = (unsigned)(k0 + 2 <= t ? k0 + 2 : 0) | ((unsigned)(k0 + 3 <= t ? k0 + 3 : 0) << 16);
            *(GAS v2u*)(SEL + tok * NSEL + k0) = x;
            if (r + 1 < 8) IDX_PREFETCH(r + 1);
            continue;
        }
        HP[tid * 2] = 0u; HP[tid * 2 + 1] = 0u;
        const int nst = (t0 + 7) / 128 + 1;
        const int tq = t0 + 4 * qg + kgrp, qrow = 4 * qg + kgrp;
        const bf16* kbat = KI + (size_t)b * SEQ * 64;
        const unsigned hpq = (unsigned)(unsigned long)(HP + qrow * 128);
#define IDX_EPI1(kgl_, AC) do { float s0 = 0.f; \
            _Pragma("unroll") for (int i = 0; i < 4; ++i) _Pragma("unroll") for (int r_ = 0; r_ < 4; ++r_) { const float a0_ = AC[i][r_]; const int i0 = __builtin_bit_cast(int, a0_); const float m0 = __builtin_bit_cast(float, i0 > 0 ? i0 : 0); s0 += w[4 * i + r_] * m0; } \
            const _Float16 h0_ = (_Float16)s0; const unsigned key0_ = f16key(__builtin_bit_cast(unsigned short, h0_)); const int kg0 = (kgl_); \
            SC[qrow * 4096 + kg0] = (u16)key0_; \
            if (kg0 <= tq) { const unsigned bin = key0_ >> 8; const unsigned ha_ = hpq + ((bin >> 1) << 2), hv_ = (bin & 1u) ? 0x10000u : 1u; \
                asm volatile("ds_add_u32 %0, %1" :: "v"(ha_), "v"(hv_) : "memory"); } } while (0)
#define IDX_READ(BQ, kt2) do { _Pragma("unroll") for (int ks = 0; ks < 2; ++ks) BQ[ks] = *(const LAS bf16x8*)(kb + (kq * 32 + (kt2) * 16 + l15) * 128 + (((ks * 4 + kgrp) ^ kx) << 4)); } while (0)
#define IDX_MMA(AC, BQ) do { _Pragma("unroll") for (int i = 0; i < 4; ++i) { AC[i] = (f32x4){0.f, 0.f, 0.f, 0.f}; _Pragma("unroll") for (int ks = 0; ks < 2; ++ks) AC[i] = __builtin_amdgcn_mfma_f32_16x16x32_bf16(qa[i][ks], BQ[ks], AC[i], 0, 0, 0); } } while (0)
        bf16x8 bq0[2], bq1[2];
        f32x4 aA[4], aB[4];
#pragma unroll
        for (int i = 0; i < 4; ++i) { aA[i] = (f32x4){0.f, 0.f, 0.f, 0.f}; aB[i] = aA[i]; }
        int bcur = 0, bnew = 4;
        TPROBE_BEGIN(100);
        for (int st = 0; st < nst; ++st) {
            if (st + 3 < nst) asm volatile("s_waitcnt vmcnt(6)" ::: "memory"); else asm volatile("s_waitcnt vmcnt(0)" ::: "memory");
            __syncthreads();
            if (st + 4 < nst) IDX_DMA(kbat, st + 4, bnew);
            const LAS unsigned char* kb = KT + bcur * 16384;
            const int kbase_ = st * 128 + kq * 32 + l15;
            IDX_READ(bq0, 0);
            IDX_READ(bq1, 1); IDX_MMA(aA, bq0); if (st >= 1) IDX_EPI1(kbase_ - 128 + 16, aB);
            IDX_MMA(aB, bq1); IDX_EPI1(kbase_, aA);
            bcur = (bcur == 4) ? 0 : bcur + 1; bnew = (bnew == 4) ? 0 : bnew + 1;
        }
        IDX_EPI1((nst - 1) * 128 + kq * 32 + l15 + 16, aB);
#undef IDX_EPI1
#undef IDX_MMA
#undef IDX_READ
        __syncthreads();
        TPROBE_END(100);
        TPROBE_BEGIN(101);
        TPROBE_BEGIN(110);
        if (r + 1 < 8) IDX_PREFETCH(r + 1);
        const int n = t + 1, jj = lane, ql = wave;
        const LAS u16* sc = SC + ql * 4096;
        LAS unsigned* hp = HP + ql * 128;
        unsigned b1, need1;
        { const v2u wv = *(const LAS v2u*)(hp + 126 - 2 * jj); unsigned hb[4];
          hb[3] = wv.x & 0xffffu; hb[2] = wv.x >> 16; hb[1] = wv.y & 0xffffu; hb[0] = wv.y >> 16;
          const unsigned s4 = hb[0] + hb[1] + hb[2] + hb[3];
          unsigned pre = s4;
#pragma unroll
          for (int o = 1; o < 64; o <<= 1) { const unsigned x = __shfl_up(pre, o, 64); if (jj >= o) pre += x; }
          const unsigned long long bal = __ballot(pre >= 256u); const int js = __builtin_ctzll(bal);
          unsigned above = pre - s4, bb1 = 0, nd1 = 0; bool found = false;
#pragma unroll
          for (int i = 0; i < 4; ++i) { if (!found) { if (above + hb[i] >= 256u) { bb1 = 255 - (jj * 4 + i); nd1 = 256u - above; found = true; } else above += hb[i]; } }
          b1 = __shfl(bb1, js); need1 = __shfl(nd1, js); }
        TPROBE_END(110);
        TPROBE_BEGIN(111);
        LDS_WAIT(); __builtin_amdgcn_wave_barrier();
#define LDS_ST32(addr_, val_) asm volatile("ds_write_b32 %0, %1" :: "v"((unsigned)(addr_)), "v"((unsigned)(val_)) : "memory")
#define LDS_ST16(addr_, val_) asm volatile("ds_write_b16 %0, %1" :: "v"((unsigned)(addr_)), "v"((unsigned)(val_)) : "memory")
#define LDS_ADD32(addr_, val_) asm volatile("ds_add_u32 %0, %1" :: "v"((unsigned)(addr_)), "v"((unsigned)(val_)) : "memory")
        const unsigned hpw = (unsigned)(unsigned long)hp, scw = (unsigned)(unsigned long)sc;
        LDS_ST32(hpw + jj * 8, 0u); LDS_ST32(hpw + jj * 8 + 4, 0u);
        const int nit = (n + 511) >> 9;
        { const int base = (nit - 1) * 512 + jj * 8;
#pragma unroll
          for (int e = 0; e < 8; ++e) if (base + e >= n) LDS_ST16(scw + (base + e) * 2, 0u); }
        LDS_WAIT(); __builtin_amdgcn_wave_barrier();
        const unsigned B1 = b1 | (b1 << 16);
#pragma unroll 4
        for (int it = 0; it < nit; ++it) { const int base = it * 512 + jj * 8; const v4u x = *(const LAS v4u*)(sc + base);
#pragma unroll
            for (int i = 0; i < 4; ++i) { const unsigned d = (i == 0) ? x.x : (i == 1) ? x.y : (i == 2) ? x.z : x.w; const unsigned m = ((d >> 8) & 0x00ff00ffu) ^ B1;
                const unsigned l0 = d & 255u, l1 = (d >> 16) & 255u;
                LDS_ADD32(hpw + ((l0 >> 1) << 2), ((m & 0xffffu) == 0u) ? ((l0 & 1u) ? 0x10000u : 1u) : 0u);
                LDS_ADD32(hpw + ((l1 >> 1) << 2), ((m >> 16) == 0u) ? ((l1 & 1u) ? 0x10000u : 1u) : 0u); } }
        LDS_WAIT(); __builtin_amdgcn_wave_barrier();
        TPROBE_END(111);
        TPROBE_BEGIN(112);
        unsigned T, need2;
        { const v2u wv = *(const LAS v2u*)(hp + 126 - 2 * jj); unsigned hb[4];
          hb[3] = wv.x & 0xffffu; hb[2] = wv.x >> 16; hb[1] = wv.y & 0xffffu; hb[0] = wv.y >> 16;
          const unsigned s4 = hb[0] + hb[1] + hb[2] + hb[3];
          unsigned pre = s4;
#pragma unroll
          for (int o = 1; o < 64; o <<= 1) { const unsigned x = __shfl_up(pre, o, 64); if (jj >= o) pre += x; }
          const unsigned long long bal = __ballot(pre >= need1); const int js = __builtin_ctzll(bal);
          unsigned above = pre - s4, bb2 = 0, nd2 = 0; bool found = false;
#pragma unroll
          for (int i = 0; i < 4; ++i) { if (!found) { if (above + hb[i] >= need1) { bb2 = 255 - (jj * 4 + i); nd2 = need1 - above; found = true; } else above += hb[i]; } }
          const unsigned b2 = __shfl(bb2, js); need2 = __shfl(nd2, js); T = (b1 << 8) | b2; }
        TPROBE_END(112);
        TPROBE_BEGIN(113);
        const unsigned olw = (unsigned)(unsigned long)(OLB + ql * 512);
        const unsigned G = 256u - need2, Tp = T | (T << 16); unsigned cg = 0, tc = 0;
#pragma unroll 2
        for (int it = 0; it < nit; ++it) { const int base = it * 512 + jj * 8; const v4u x = *(const LAS v4u*)(sc + base);
            unsigned g[8], c = 0, anyeq = 0;
#pragma unroll
            for (int i = 0; i < 4; ++i) { const unsigned d = (i == 0) ? x.x : (i == 1) ? x.y : (i == 2) ? x.z : x.w;
                g[2 * i] = ((d & 0xffffu) > T) ? 1u : 0u; g[2 * i + 1] = ((d >> 16) > T) ? 1u : 0u; c += g[2 * i] + g[2 * i + 1];
                const unsigned q = d ^ Tp; anyeq |= (((q & 0xffffu) == 0u) || ((q >> 16) == 0u)) ? 1u : 0u; }
            const unsigned long long m0 = __ballot(c & 1u), m1 = __ballot(c & 2u), m2 = __ballot(c & 4u), m3 = __ballot(c & 8u);
            unsigned pos = cg + __builtin_amdgcn_mbcnt_hi((unsigned)(m0 >> 32), __builtin_amdgcn_mbcnt_lo((unsigned)m0, 0u)) + 2u * __builtin_amdgcn_mbcnt_hi((unsigned)(m1 >> 32), __builtin_amdgcn_mbcnt_lo((unsigned)m1, 0u))
                         + 4u * __builtin_amdgcn_mbcnt_hi((unsigned)(m2 >> 32), __builtin_amdgcn_mbcnt_lo((unsigned)m2, 0u)) + 8u * __builtin_amdgcn_mbcnt_hi((unsigned)(m3 >> 32), __builtin_amdgcn_mbcnt_lo((unsigned)m3, 0u));
            cg += (unsigned)__builtin_popcountll(m0) + 2u * (unsigned)__builtin_popcountll(m1) + 4u * (unsigned)__builtin_popcountll(m2) + 8u * (unsigned)__builtin_popcountll(m3);
#pragma unroll
            for (int e = 0; e < 8; ++e) { const unsigned a_ = olw + ((pos < 256u ? pos : 255u) << 1); if (g[e]) LDS_ST16(a_, base + e); pos += g[e]; }
            if (__ballot(anyeq) != 0ull) {
#pragma unroll
                for (int e = 0; e < 8; ++e) { const unsigned wd = (e < 2) ? x.x : (e < 4) ? x.y : (e < 6) ? x.z : x.w; const unsigned k = (e & 1) ? (wd >> 16) : (wd & 0xffffu);
                    const bool eq = k == T; const unsigned long long me = __ballot(eq);
                    const unsigned pe = tc + __builtin_amdgcn_mbcnt_hi((unsigned)(me >> 32), __builtin_amdgcn_mbcnt_lo((unsigned)me, 0u));
                    if (eq && pe < need2) LDS_ST16(olw + ((G + pe) << 1), base + e);
                    tc += (unsigned)__builtin_popcountll(me); } } }
#undef LDS_ST32
#undef LDS_ST16
#undef LDS_ADD32
        LDS_WAIT(); __builtin_amdgcn_wave_barrier();
        { const v2u x = *(const LAS v2u*)((LAS u16*)(OLB + ql * 512) + jj * 4); *(GAS v2u*)(SEL + tok * NSEL + jj * 4) = x; }
        TPROBE_END(113);
        TPROBE_END(101);
    }
#undef IDX_DMA
#undef IDX_PREFETCH
#undef IDX_UNIT
}

__device__ __forceinline__ void carry_phase(Frame& F) {
    const int gid = blockIdx.x * NTHR + F.tid; if (gid >= NGRP * NB * 64) return;
    const int p = gid & 63, b = (gid >> 6) & 3, g = gid >> 8;
    const float* A32 = (const float*)(F.ws + WS_A32) + g * 128; const float ar = A32[p * 2], ai = A32[p * 2 + 1];
    const float* SB = (const float*)(F.ws + WS_SBUF) + ((size_t)g * 512 + b * 128) * 128; bf16* UX = (bf16*)(F.ws + WS_UGX) + ((size_t)g * 512 + b * 128) * UGX_LD;
    float xr = 0.f, xi = 0.f;
    for (int c = 0; c < NCH; ++c) {
        UX[(size_t)c * UGX_LD + 512 + p] = (bf16)f2bf(xr); UX[(size_t)c * UGX_LD + 576 + p] = (bf16)f2bf(xi);
        const float sr = SB[c * 128 + p], si = SB[c * 128 + 64 + p];
        const float nr = ar * xr - ai * xi + sr, ni = ar * xi + ai * xr + si; xr = nr; xi = ni;
    }
}

template <int N> __device__ __forceinline__ void wait_vm() { asm volatile("s_waitcnt vmcnt(%0)" :: "n"(N) : "memory"); }
__device__ __forceinline__ void attn_phase(Frame& F) {
    constexpr int WSTR = 20224;
    LAS unsigned char* RING = F.lds + F.wave * WSTR;
    LAS u16* SL = (LAS u16*)(RING + 16384);
    const unsigned char* Q8 = F.ws + WS_Q; const unsigned char* K8 = F.ws + WS_K; const unsigned char* V8 = F.ws + WS_V;
    const u16* SEL = (const u16*)(F.ws + WS_SEL); bf16* YA = (bf16*)(F.ws + WS_YATT);
    const int lane = F.lane, gw = blockIdx.x * NWAVES + F.wave;
    const int hd = lane & 15, kg = lane >> 4;
    const int l4 = lane >> 2, cpos = lane & 3;
    int kra[2];
#pragma unroll
    for (int ks = 0; ks < 2; ++ks) kra[ks] = hd * 64 + (((ks * 2 + (kg >> 1)) ^ ((hd >> 2) & 3)) << 4) + (kg & 1) * 8;
    unsigned tra[4];
    { const int r = hd >> 1, c = hd & 1, row = (r >> 2) * 16 + kg * 4 + (r & 3), f = (kg & 1) | ((r >> 2) << 1); const unsigned rb = (unsigned)(unsigned long)RING;
#pragma unroll
      for (int mt = 0; mt < 4; ++mt) tra[mt] = rb + row * 64 + ((mt ^ f) << 4) + c * 8; }
    const bool early = (int)blockIdx.x < 128; const int ew = blockIdx.x * NWAVES + F.wave, nitems = early ? 23 : 9;
    for (int k_ = 0; k_ < nitems; ++k_) { const int it = (k_ < 9) ? gw + 2048 * k_ : 18432 + ew + 1024 * (k_ - 9);
        const int tok = it >> 1, kvh = it & 1, t = tok & 4095; const size_t bbase = (size_t)(tok >> 12) * SEQ;
        const int nsel = (t + 1 < NSEL) ? t + 1 : NSEL;
        { const v2u x = *(const GAS v2u*)(SEL + (size_t)tok * NSEL + lane * 4); *(LAS v2u*)(SL + lane * 4) = x; }
        long qf[2];
#pragma unroll
        for (int ks = 0; ks < 2; ++ks) { if (hd < 4) qf[ks] = *(const GAS long*)(Q8 + (size_t)tok * 512 + (kvh * 4 + hd) * 64 + ks * 32 + kg * 8); else qf[ks] = 0; }
        asm volatile("s_waitcnt vmcnt(0)" : "+v"(qf[0]), "+v"(qf[1]) :: "memory");
        LDS_WAIT(); __builtin_amdgcn_wave_barrier();
        const unsigned char* kbp = K8 + bbase * 128 + kvh * 64; const unsigned char* vbp = V8 + bbase * 128 + kvh * 64;
        f32x4 sc[4][4]; f32x4 oacc[4];
#pragma unroll
        for (int c = 0; c < 4; ++c)
#pragma unroll
            for (int tl = 0; tl < 4; ++tl) sc[c][tl] = (f32x4){0.f, 0.f, 0.f, 0.f};
#pragma unroll
        for (int m = 0; m < 4; ++m) oacc[m] = (f32x4){0.f, 0.f, 0.f, 0.f};
        float inv = 1.0f;
#define ATT_ISSUE(s) do { const int c_ = (s) & 3; const bool isk_ = (s) < 4; const unsigned char* gb_ = isk_ ? kbp : vbp; int sel_[4]; \
            _Pragma("unroll") for (int j_ = 0; j_ < 4; ++j_) { const int ki_ = c_ * 64 + j_ * 16 + l4; sel_[j_] = (int)SL[ki_ < nsel ? ki_ : 0]; } \
            _Pragma("unroll") for (int j_ = 0; j_ < 4; ++j_) { const int f_ = isk_ ? ((l4 >> 2) & 3) : (((l4 >> 2) & 1) | ((j_ & 1) << 1)); \
                __builtin_amdgcn_global_load_lds((const unsigned*)(gb_ + (size_t)sel_[j_] * 128 + ((cpos ^ f_) << 4)), (LAS unsigned*)(RING + ((s) & 3) * 4096 + j_ * 1024), 16, 0, 0); } } while (0)
        ATT_ISSUE(0); ATT_ISSUE(1); ATT_ISSUE(2);
#pragma unroll
        for (int s = 0; s < 8; ++s) {
            if (s + 3 < 8) ATT_ISSUE(s + 3);
            if (s <= 4) wait_vm<12>(); else if (s == 5) wait_vm<8>(); else if (s == 6) wait_vm<4>(); else wait_vm<0>();
            const LAS unsigned char* buf = RING + (s & 3) * 4096;
            if (s < 4) {
#pragma unroll
                for (int tl = 0; tl < 4; ++tl)
#pragma unroll
                    for (int ks = 0; ks < 2; ++ks) { const long af = *(const LAS long*)(buf + tl * 1024 + kra[ks]);
                        sc[s][tl] = __builtin_amdgcn_mfma_f32_16x16x32_fp8_fp8(af, qf[ks], sc[s][tl], 0, 0, 0); }
                if (s == 3) {
                    float mx = -3.0e38f;
#pragma unroll
                    for (int c = 0; c < 4; ++c)
#pragma unroll
                        for (int tl = 0; tl < 4; ++tl)
#pragma unroll
                            for (int r = 0; r < 4; ++r) { const int key = c * 64 + tl * 16 + kg * 4 + r; const float v = (key < nsel) ? sc[c][tl][r] * 0.125f : -3.0e38f; sc[c][tl][r] = v; mx = fmaxf(mx, v); }
                    mx = fmaxf(mx, __shfl_xor(mx, 16)); mx = fmaxf(mx, __shfl_xor(mx, 32));
                    float sum = 0.f;
#pragma unroll
                    for (int c = 0; c < 4; ++c)
#pragma unroll
                        for (int tl = 0; tl < 4; ++tl)
#pragma unroll
                            for (int r = 0; r < 4; ++r) { const float e = __expf(sc[c][tl][r] - mx); sc[c][tl][r] = e; sum += e; }
                    sum += __shfl_xor(sum, 16); sum += __shfl_xor(sum, 32);
                    inv = 1.0f / sum;
                }
            } else {
                const int c = s - 4;
                v2u pw[2];
#pragma unroll
                for (int h2 = 0; h2 < 2; ++h2) { pw[h2].x = pk_fp8x4(sc[c][2 * h2][0], sc[c][2 * h2][1], sc[c][2 * h2][2], sc[c][2 * h2][3]); pw[h2].y = pk_fp8x4(sc[c][2 * h2 + 1][0], sc[c][2 * h2 + 1][1], sc[c][2 * h2 + 1][2], sc[c][2 * h2 + 1][3]); }
                v2u a[8];
                asm volatile("ds_read_b64_tr_b8 %0, %8 offset:%12\n\tds_read_b64_tr_b8 %1, %9 offset:%12\n\tds_read_b64_tr_b8 %2, %10 offset:%12\n\tds_read_b64_tr_b8 %3, %11 offset:%12\n\t"
                             "ds_read_b64_tr_b8 %4, %8 offset:%13\n\tds_read_b64_tr_b8 %5, %9 offset:%13\n\tds_read_b64_tr_b8 %6, %10 offset:%13\n\tds_read_b64_tr_b8 %7, %11 offset:%13\n\ts_waitcnt lgkmcnt(0)"
                             : "=&v"(a[0]), "=&v"(a[1]), "=&v"(a[2]), "=&v"(a[3]), "=&v"(a[4]), "=&v"(a[5]), "=&v"(a[6]), "=&v"(a[7])
                             : "v"(tra[0]), "v"(tra[1]), "v"(tra[2]), "v"(tra[3]), "n"((s & 3) * 4096), "n"((s & 3) * 4096 + 2048) : "memory");
#pragma unroll
                for (int h2 = 0; h2 < 2; ++h2)
#pragma unroll
                    for (int mt = 0; mt < 4; ++mt)
                        oacc[mt] = __builtin_amdgcn_mfma_f32_16x16x32_fp8_fp8(__builtin_bit_cast(long, a[4 * h2 + mt]), __builtin_bit_cast(long, pw[h2]), oacc[mt], 0, 0, 0);
            }
        }
#undef ATT_ISSUE
        if (hd < 4) {
            bf16* yo = YA + (size_t)tok * 512 + (kvh * 4 + hd) * 64 + kg * 4;
#pragma unroll
            for (int mt = 0; mt < 4; ++mt) { pg8::u32x2 w; w.x = pg8::cvt_pk_bf16(oacc[mt][0] * inv, oacc[mt][1] * inv); w.y = pg8::cvt_pk_bf16(oacc[mt][2] * inv, oacc[mt][3] * inv); *(GAS pg8::u32x2*)(yo + 16 * mt) = w; }
        }
        LDS_WAIT(); __builtin_amdgcn_wave_barrier();
    }
}

__device__ __forceinline__ void router_phase(Frame& F) {
    constexpr int HRS = 1028;
    LAS float* HR = (LAS float*)(F.lds);
    LAS float* PT = (LAS float*)(F.lds + 65792);
    LAS int* LE = (LAS int*)(F.lds + 82176);
    LAS int* LP = (LAS int*)(F.lds + 83200);
    LAS unsigned* LC = (LAS unsigned*)(F.lds + 84224);
    const bf16* X1 = (const bf16*)(F.ws + WS_X1); bf16* H2 = (bf16*)(F.ws + WS_H2);
    const float* WR = F.in[I_WR]; const float* BR = F.in[I_BR]; const float* G2 = F.in[I_N2G];
    int* TOPE = (int*)(F.ws + WS_TOPE); float* TOPW = (float*)(F.ws + WS_TOPW); int* TOPPOS = (int*)(F.ws + WS_TOPPOS); int* ROWMAP = (int*)(F.ws + WS_ROWMAP);
    const int tid = F.tid, lane = F.lane, wave = F.wave, e = lane & 31, dh = lane >> 5;
    float wb[32][2];
#pragma unroll
    for (int i = 0; i < 32; ++i)
#pragma unroll
        for (int t = 0; t < 2; ++t) wb[i][t] = WR[(size_t)(128 * wave + 4 * i + (lane >> 4)) * 32 + (lane & 15) + 16 * t];
    if (tid < 64) LC[tid] = 0u;
    const int tok0 = blockIdx.x * 64;
    v2u nv[2][4];
#pragma unroll
    for (int rr = 0; rr < 2; ++rr)
#pragma unroll
        for (int j = 0; j < 4; ++j) nv[rr][j] = ((const GAS v2u*)(X1 + (size_t)(tok0 + 2 * wave + rr) * DM) + lane)[64 * j];
    for (int bt = 0; bt < 4; ++bt) {
        __syncthreads();
#pragma unroll
        for (int rr = 0; rr < 2; ++rr) { const int lr = 2 * wave + rr, tok = tok0 + bt * 16 + lr;
            const GAS f32x4* gr = (const GAS f32x4*)G2 + lane;
            f32x4 v[4]; float s2 = 0.f;
#pragma unroll
            for (int j = 0; j < 4; ++j) { v[j] = (f32x4){bflo(nv[rr][j].x), bfhi(nv[rr][j].x), bflo(nv[rr][j].y), bfhi(nv[rr][j].y)}; s2 += (v[j].x * v[j].x + v[j].y * v[j].y) + (v[j].z * v[j].z + v[j].w * v[j].w); }
            const float rstd = 1.0f / sqrtf(wave_sum(s2) * (1.f / DM) + RMS_EPS);
            GAS unsigned* o4 = (GAS unsigned*)((unsigned char*)H2 + (size_t)tok * DM) + lane;
#pragma unroll
            for (int j = 0; j < 4; ++j) { const f32x4 gg = gr[64 * j]; const f32x4 h = v[j] * rstd * gg;
                *(LAS f32x4*)(HR + lr * HRS + 256 * j + 4 * lane) = h;
                o4[64 * j] = pk_fp8x4(h.x, h.y, h.z, h.w); } }
        if (bt + 1 < 4) {
#pragma unroll
            for (int rr = 0; rr < 2; ++rr)
#pragma unroll
                for (int j = 0; j < 4; ++j) nv[rr][j] = ((const GAS v2u*)(X1 + (size_t)(tok0 + (bt + 1) * 16 + 2 * wave + rr) * DM) + lane)[64 * j];
        }
        __syncthreads();
        { f32x4 d0 = {0.f, 0.f, 0.f, 0.f}, d1 = d0; const LAS float* hp = HR + (lane & 15) * HRS + 128 * wave + (lane >> 4);
#pragma unroll
          for (int i = 0; i < 32; ++i) { const float a = hp[4 * i]; d0 = __builtin_amdgcn_mfma_f32_16x16x4f32(a, wb[i][0], d0, 0, 0, 0); d1 = __builtin_amdgcn_mfma_f32_16x16x4f32(a, wb[i][1], d1, 0, 0, 0); }
#pragma unroll
          for (int r = 0; r < 4; ++r) { const int row = 4 * (lane >> 4) + r; PT[(row * 8 + wave) * 32 + (lane & 15)] = d0[r]; PT[(row * 8 + wave) * 32 + 16 + (lane & 15)] = d1[r]; } }
        __syncthreads();
        { const int lr = 2 * wave + dh, tl = bt * 16 + lr, tok = tok0 + tl; float lg = BR[e];
#pragma unroll
          for (int w8 = 0; w8 < 8; ++w8) lg += PT[(lr * 8 + w8) * 32 + e];
          float cur = lg; float tv[4]; int te[4];
#pragma unroll
          for (int k = 0; k < 4; ++k) { float mv = cur; int mi = e;
#pragma unroll
              for (int o = 1; o < 32; o <<= 1) { const float ov = __shfl_xor(mv, o); const int oi = __shfl_xor(mi, o); if (ov > mv || (ov == mv && oi < mi)) { mv = ov; mi = oi; } }
              tv[k] = mv; te[k] = mi; if (e == mi) cur = -3.0e38f; }
          const float e1 = __expf(tv[1] - tv[0]), e2 = __expf(tv[2] - tv[0]), e3 = __expf(tv[3] - tv[0]); const float inv = 1.0f / (1.0f + e1 + e2 + e3);
          if (e < 4) { const int ex = (e == 0) ? te[0] : (e == 1) ? te[1] : (e == 2) ? te[2] : te[3]; const float wv = ((e == 0) ? 1.0f : (e == 1) ? e1 : (e == 2) ? e2 : e3) * inv;
              TOPE[(size_t)tok * 4 + e] = ex; TOPW[(size_t)tok * 4 + e] = wv; LE[tl * 4 + e] = ex; LP[tl * 4 + e] = (int)atomicAdd((unsigned*)&LC[ex], 1u); } }
    }
    __syncthreads();
    if (tid < 32) LC[32 + tid] = __hip_atomic_fetch_add((unsigned*)(F.ctl + CW_ECNT) + tid, LC[tid], RLX_AGENT);
    __syncthreads();
    if (tid < 256) { const int ex = LE[tid], pos = (int)LC[32 + ex] + LP[tid], tok = tok0 + (tid >> 2); TOPPOS[(size_t)tok * 4 + (tid & 3)] = pos; ROWMAP[(size_t)ex * NTOK + pos] = tok; }
}

__device__ __forceinline__ int moe_tables(Frame& F, LAS int* OFF, LAS int* TE, bool build) {
    __syncthreads();
    if (build && F.tid == 0) { int cn[NEXP];
#pragma unroll
        for (int e = 0; e < NEXP; ++e) cn[e] = (int)__hip_atomic_load((unsigned*)(F.ctl + CW_ECNT) + e, RLX_AGENT);
        int acc = 0;
#pragma unroll
        for (int e = 0; e < NEXP; ++e) { const int c = cn[e], nt = (c + 255) >> 8; OFF[e] = acc * 256; OFF[33 + e] = c; for (int i = 0; i < nt; ++i) TE[acc + i] = e; acc += nt; }
        OFF[NEXP] = acc; }
    __syncthreads();
    return OFF[NEXP];
}
__device__ __forceinline__ void combine_phase(Frame& F, bool build) {
    LAS int* OFF = (LAS int*)(F.lds + MISC_OFF + 512); LAS int* TE = OFF + 72;
    (void)moe_tables(F, OFF, TE, build);
    const int* TOPE = (const int*)(F.ws + WS_TOPE); const int* TOPPOS = (const int*)(F.ws + WS_TOPPOS); const float* TOPW = (const float*)(F.ws + WS_TOPW);
    const bf16* X1 = (const bf16*)(F.ws + WS_X1); const unsigned char* Y2 = F.ws + WS_Y2; const float* GF = F.in[I_NFG];
    const int gw = blockIdx.x * NWAVES + F.wave, NGW = F.G * NWAVES, lane = F.lane;
    typedef int v4i __attribute__((ext_vector_type(4)));
    constexpr int NT = NTOK / (256 * NWAVES);
    f32x4 gg[4];
#pragma unroll
    for (int j = 0; j < 4; ++j) gg[j] = ((const GAS f32x4*)GF + lane)[64 * j];
    v4i re, rp; f32x4 rw;
    v2u xr[2][4]; unsigned yr[2][4][4]; f32x4 wr[2];
#define CMB_REC(i_) do { const int t_ = gw + (i_) * NGW; re = *(const GAS v4i*)(TOPE + (size_t)t_ * 4); rp = *(const GAS v4i*)(TOPPOS + (size_t)t_ * 4); rw = *(const GAS f32x4*)(TOPW + (size_t)t_ * 4); } while (0)
#define CMB_ROWS(i_, b_) do { const int t_ = gw + (i_) * NGW; wr[b_] = rw; \
        _Pragma("unroll") for (int j = 0; j < 4; ++j) xr[b_][j] = ((const GAS v2u*)(X1 + (size_t)t_ * DM) + lane)[64 * j]; \
        _Pragma("unroll") for (int k = 0; k < 4; ++k) { const int slot = OFF[re[k]] + rp[k]; const GAS unsigned* yp = (const GAS unsigned*)(Y2 + (size_t)slot * DM) + lane; \
            _Pragma("unroll") for (int j = 0; j < 4; ++j) yr[b_][k][j] = yp[64 * j]; } } while (0)
    CMB_REC(0); CMB_ROWS(0, 0); if (NT > 1) CMB_REC(1);
#pragma unroll
    for (int i = 0; i < NT; ++i) { const int b = i & 1, tok = gw + i * NGW;
        asm volatile("" ::: "memory");
        if (i + 1 < NT) CMB_ROWS(i + 1, b ^ 1);
        if (i + 2 < NT) CMB_REC(i + 2);
        asm volatile("" ::: "memory");
        f32x4 v[4];
#pragma unroll
        for (int j = 0; j < 4; ++j) { const v2u x = xr[b][j]; v[j] = (f32x4){bflo(x.x), bfhi(x.x), bflo(x.y), bfhi(x.y)}; }
#pragma unroll
        for (int k = 0; k < 4; ++k) { const float wk = wr[b][k] * (1.0f / YSC);
#pragma unroll
            for (int j = 0; j < 4; ++j) { const unsigned y = yr[b][k][j]; const f32x2 lo = __builtin_amdgcn_cvt_pk_f32_fp8(y, false), hi = __builtin_amdgcn_cvt_pk_f32_fp8(y, true);
                v[j].x += wk * lo[0]; v[j].y += wk * lo[1]; v[j].z += wk * hi[0]; v[j].w += wk * hi[1]; } }
        float s2 = 0.f;
#pragma unroll
        for (int j = 0; j < 4; ++j) s2 += (v[j].x * v[j].x + v[j].y * v[j].y) + (v[j].z * v[j].z + v[j].w * v[j].w);
        const float rstd = 1.0f / sqrtf(wave_sum(s2) * (1.f / DM) + RMS_EPS);
#pragma unroll
        for (int j = 0; j < 4; ++j) ((GAS f32x4*)(F.out + (size_t)tok * DM) + lane)[64 * j] = v[j] * rstd * gg[j];
    }
#undef CMB_REC
#undef CMB_ROWS
}

__device__ __forceinline__ void ubench(Frame& F) {
    bf16x8 a = (bf16x8){1, 2, 3, 4, 5, 6, 7, 8}, b = (bf16x8){8, 7, 6, 5, 4, 3, 2, 1}; a[0] = (short)F.lane;
    float sink = 0.f;
    if (PROBE_DUP == 900) { f32x16 c0 = {0.f, 0.f, 0.f, 0.f, 0.f, 0.f, 0.f, 0.f, 0.f, 0.f, 0.f, 0.f, 0.f, 0.f, 0.f, 0.f}, c1 = c0;
        for (int i = 0; i < 2000; ++i) { c0 = __builtin_amdgcn_mfma_f32_32x32x16_bf16(a, b, c0, 0, 0, 0); c1 = __builtin_amdgcn_mfma_f32_32x32x16_bf16(a, b, c1, 0, 0, 0); }
        sink = c0[0] + c1[5]; }
    if (PROBE_DUP == 901) { f32x4 c0 = {0.f, 0.f, 0.f, 0.f}, c1 = c0, c2 = c0, c3 = c0;
        for (int i = 0; i < 2000; ++i) { c0 = __builtin_amdgcn_mfma_f32_16x16x32_bf16(a, b, c0, 0, 0, 0); c1 = __builtin_amdgcn_mfma_f32_16x16x32_bf16(a, b, c1, 0, 0, 0); c2 = __builtin_amdgcn_mfma_f32_16x16x32_bf16(a, b, c2, 0, 0, 0); c3 = __builtin_amdgcn_mfma_f32_16x16x32_bf16(a, b, c3, 0, 0, 0); }
        sink = c0[0] + c1[1] + c2[2] + c3[3]; }
    if (PROBE_DUP == 902) { float x0 = F.lane, x1 = 1.f, x2 = 2.f, x3 = 3.f, x4 = 4.f, x5 = 5.f, x6 = 6.f, x7 = 7.f; const float m = 1.0001f, d = 0.5f;
        for (int i = 0; i < 4000; ++i) { x0 = x0 * m + d; x1 = x1 * m + d; x2 = x2 * m + d; x3 = x3 * m + d; x4 = x4 * m + d; x5 = x5 * m + d; x6 = x6 * m + d; x7 = x7 * m + d; }
        sink = x0 + x1 + x2 + x3 + x4 + x5 + x6 + x7; }
    if (PROBE_DUP == 903) {
        f32x4 c[4]; float s = 0.f; float wv[16];
#pragma unroll
        for (int i = 0; i < 4; ++i) c[i] = (f32x4){0.f, 0.f, 0.f, 0.f};
#pragma unroll
        for (int i = 0; i < 16; ++i) wv[i] = 0.001f * (i + F.lane);
        for (int it = 0; it < 275; ++it) { f32x4 d[4];
#pragma unroll
            for (int i = 0; i < 4; ++i) { d[i] = (f32x4){0.f, 0.f, 0.f, 0.f}; d[i] = __builtin_amdgcn_mfma_f32_16x16x32_bf16(a, b, d[i], 0, 0, 0); d[i] = __builtin_amdgcn_mfma_f32_16x16x32_bf16(b, a, d[i], 0, 0, 0); }
            float t = 0.f;
#pragma unroll
            for (int i = 0; i < 4; ++i)
#pragma unroll
                for (int r = 0; r < 4; ++r) { const float x = c[i][r]; const int xi = __builtin_bit_cast(int, x); const float m = __builtin_bit_cast(float, xi > 0 ? xi : 0); t += wv[4 * i + r] * m; }
            float u = t;
#pragma unroll
            for (int k = 0; k < 12; ++k) u = u * 1.0001f + 0.5f;
            s += u; a[1] = (short)(it + (int)s);
#pragma unroll
            for (int i = 0; i < 4; ++i) c[i] = d[i]; }
        sink = s; }
    if (sink == 123.456f) ((float*)(F.ws + WS_SBUF))[F.tid] = sink;
}

constexpr int NPHASE = 10;
struct Args { const float* in[25]; float* out; unsigned char* ws; int ph_lo, ph_hi; };
__global__ void __launch_bounds__(NTHR, 2) fwd_kernel(Args args) {
    extern __shared__ __attribute__((aligned(16))) unsigned char lds[];
    Frame F;
    F.lds = (LAS unsigned char*)lds;
    F.MISC = (volatile LAS unsigned*)(F.lds + MISC_OFF);
    F.tid = threadIdx.x; F.lane = F.tid & 63; F.wave = __builtin_amdgcn_readfirstlane(F.tid >> 6); F.G = gridDim.x;
    F.ws = args.ws; F.ctl = (gu32*)(args.ws + WS_CTL); F.out = args.out;
#pragma unroll
    for (int i = 0; i < 25; ++i) F.in[i] = args.in[i];
    for (int u = F.tid; u < 2048 / 4; u += NTHR) ((LAS unsigned*)(F.lds + MISC_OFF))[u] = 0u;
    __syncthreads();
    XcdBarrier bar; bar.bar = (unsigned*)(F.ctl + CW_BAR); bar.x = 0; bar.st = nullptr;
    if (MK_N_LAUNCHES == 1) bar = xcd_barrier_post((unsigned*)(F.ctl + CW_BAR), F.MISC + 8);
    const int lo = args.ph_lo, hi = args.ph_hi;
#define IN(k) (lo <= (k) && (k) < hi)
#define SEAM(k) do { if (IN(k) && IN((k) + 1)) xcd_barrier(bar); } while (0)
    unsigned char* ws = F.ws; const int c = (int)blockIdx.x;

#define BODY_P0 { p0_prologue(F); if (PROBE_DUP >= 900) ubench(F); }
#define BODY_P1 { { pg8::Gemm g{(const bf16*)(ws + WS_XN), (const bf16*)(ws + WS_WIN), 512, 512, 512, 0}; InProjOrder S{F.G, c, (unsigned*)(F.ctl + CW_UDONE)}; \
        EpiInProj E{ws, F.in[I_BGATE]}; pg8::gemm_phase<EpiInProj, InProjOrder, true, false, true>(F.lds, g, S, E); } \
        if (c >= 128 && c < 192) { wg_wait_ge(F, CW_UDONE, 128u * 8u); pg8::Gemm g{(const bf16*)(ws + WS_UGX), (const bf16*)(ws + WS_WS), UGX_LD, 512, 512, 0}; S5StateOrder S{c - 128}; EpiS5State E{(float*)(ws + WS_SBUF)}; \
          pg8::gemm_phase<EpiS5State, S5StateOrder>(F.lds, g, S, E); } \
        if (c >= 128) moe_convert(F, MOE_ITA, MOE_IT_IN, (c < 192) ? c - 128 : 64 + 2 * (c - 192), (c < 192) ? 1 : 2, 192); }
#define BODY_P2 { carry_phase(F); idx_phase(F); if (PROBE_DUP == 102) { xcd_barrier(bar); idx_phase(F); } }
#define BODY_P3 { if (c >= 128) { { pg8::Gemm g{(const bf16*)(ws + WS_UGX), (const bf16*)(ws + WS_MT), UGX_LD, UGX_LD, 640, 0}; S5YOrder S{c - 128}; EpiS5Y E{(const bf16*)(ws + WS_UGX), F.in[I_SD], (bf16*)(ws + WS_YG)}; \
            pg8::gemm_phase<EpiS5Y, S5YOrder>(F.lds, g, S, E); } \
          wg_signal(F, CW_YDONE); wg_wait_ge(F, CW_YDONE, 128u); \
          { pg8::Gemm g{(const bf16*)(ws + WS_YG), (const bf16*)(ws + WS_WGLU), 512, 512, 512, 0}; StaticOrder S; S.init(NTOK / 256, 2, 128, c - 128); EpiGlu E{(const bf16*)(ws + WS_YG), F.in[I_BGLU], (bf16*)(ws + WS_YSSM)}; \
            pg8::gemm_phase<EpiGlu, StaticOrder>(F.lds, g, S, E); } } \
        attn_phase(F); }
#define BODY_P4 { pg8::Gemm g{(const bf16*)(ws + WS_YSSM), (const bf16*)(ws + WS_WPS), 512, 512, 512, 0}; MixOrder S; S.so.init(NTOK / 256, 4, F.G, c); \
        EpiMix E{ws + WS_GS, ws + WS_GA, (bf16*)(ws + WS_MIXED)}; pg8::gemm_phase<EpiMix, MixOrder>(F.lds, g, S, E); }
#define BODY_P5 { pg8::Gemm g{(const bf16*)(ws + WS_MIXED), (const bf16*)(ws + WS_WOUT), 1024, 1024, 1024, 0}; StaticOrder S; S.init(NTOK / 256, 4, F.G, c); EpiOut E{F.in[I_X], (bf16*)(ws + WS_X1)}; \
        pg8::gemm_phase<EpiOut, StaticOrder>(F.lds, g, S, E); }
#define BODY_P6 { router_phase(F); }
#define BODY_P7 { LAS int* OFF = (LAS int*)(F.lds + MISC_OFF + 512); LAS int* TE = OFF + 72; const int TT = moe_tables(F, OFF, TE, true); \
        pg8::Gemm g{(const bf16*)(ws + WS_H2), (const bf16*)(ws + WS_WMI), 512, 512, 512, 0}; MoeOrder S{TE, OFF, OFF + 33, (const int*)(ws + WS_ROWMAP), TT, 8, c, 0}; EpiMoe1 E{F.in[I_BMI], ws + WS_ACT}; \
        pg8::gemm_phase<EpiMoe1, MoeOrder, true, false, true>(F.lds, g, S, E); \
        if ((c & 7) >= 4) moe_convert(F, MOE_ITB, MOE_IT, (c >> 3) * 4 + (c & 7) - 4, 1, 128); }
#define BODY_P8 { LAS int* OFF = (LAS int*)(F.lds + MISC_OFF + 512); LAS int* TE = OFF + 72; const int TT = moe_tables(F, OFF, TE, lo == 8); \
        pg8::Gemm g{(const bf16*)(ws + WS_ACT), (const bf16*)(ws + WS_WMO), 512, 512, 512, 0}; EpiMoe2 E{F.in[I_BMO], ws + WS_Y2}; \
        { MoeOrder S{TE, OFF, OFF + 33, nullptr, TT, 4, c, 1}; pg8::gemm_phase<EpiMoe2, MoeOrder, true, false, true>(F.lds, g, S, E); }     \
        if ((c & 7) >= 2) moe_convert(F, MOE_IT_IN, MOE_ITB, (c >> 3) * 6 + (c & 7) - 2, 1, 192);                                          \
        xcd_barrier(bar); \
        { MoeOrder S{TE, OFF, OFF + 33, nullptr, TT, 4, c, 2}; pg8::gemm_phase<EpiMoe2, MoeOrder, true, false, true>(F.lds, g, S, E); } }
#define BODY_P9 { combine_phase(F, lo == 9); }
#define PHASE(k, BODY) if (IN(k)) { TPROBE_BEGIN(k); BODY TPROBE_END(k); if (PROBE_DUP == (k)) { xcd_barrier(bar); BODY } } SEAM(k);
    PHASE(0, BODY_P0) PHASE(1, BODY_P1) PHASE(2, BODY_P2) PHASE(3, BODY_P3) PHASE(4, BODY_P4) PHASE(5, BODY_P5) PHASE(6, BODY_P6)
    PHASE(7, BODY_P7) PHASE(8, BODY_P8) PHASE(9, BODY_P9)
#undef IN
#undef SEAM
}

extern "C" void kernel_launch(void* const* d_in, const int* in_sizes, int n_in, void* d_out, int out_size, void* d_ws, size_t ws_size, hipStream_t stream) {
    static int grid = 0;
    if (grid == 0) {
        if (n_in != 25 || out_size != NTOK * DM || ws_size < WS_END) { fprintf(stderr, "kernel_launch: unexpected problem (n_in %d out %d ws %zu)\n", n_in, out_size, ws_size); grid = -1; return; }
        if (hipFuncSetAttribute((const void*)fwd_kernel, hipFuncAttributeMaxDynamicSharedMemorySize, LDS_BYTES) != hipSuccess) { fprintf(stderr, "kernel_launch: hipFuncSetAttribute failed\n"); grid = -1; return; }
        int per_cu = 0; (void)hipOccupancyMaxActiveBlocksPerMultiprocessor(&per_cu, (const void*)fwd_kernel, NTHR, LDS_BYTES); (void)hipGetLastError();
        grid = 256;
    }
    if (grid < 0) return;
    (void)hipMemsetAsync((char*)d_ws + WS_CTL, 0, CTL_ZERO_BYTES, stream);
    Args a{};
    for (int i = 0; i < 25; ++i) a.in[i] = (const float*)d_in[i];
    a.out = (float*)d_out; a.ws = (unsigned char*)d_ws;
    if (MK_N_LAUNCHES == 1) { a.ph_lo = 0; a.ph_hi = NPHASE; hipLaunchKernelGGL(fwd_kernel, dim3(grid), dim3(NTHR), LDS_BYTES, stream, a); }
    else for (int p = 0; p < NPHASE; ++p) { a.ph_lo = p; a.ph_hi = p + 1; hipLaunchKernelGGL(fwd_kernel, dim3(grid), dim3(NTHR), LDS_BYTES, stream, a); }
}
```
